# Optimizing an MI355X kernel written in HIP

```python
import jax
import jax.numpy as jnp
from jax import lax
import numpy as np

D_MODEL = 1024
BATCH = 16
SEQ = 2048
DEPTH = 1

SB_HEAD_DIM = 64
SB_WIDTH = D_MODEL
SB_HEADS = SB_WIDTH // SB_HEAD_DIM
QUERY_BLOCK = 128
ML_HEADS = 4
ML_WIDTH = D_MODEL
ML_HEAD_DIM = ML_WIDTH // ML_HEADS
ML_CHUNK = 64
CONV_WIDTH = 4
N_EXPERTS = 32
TOP_K = 4
D_FF = D_MODEL
SWIGLU_LIMIT = 7.0
SWIGLU_ALPHA = 1.702
MOE_BLOCK = 128
N_MOD = 6
EPS = 1e-6
IN_SPLIT = (SB_WIDTH, SB_WIDTH, SB_WIDTH, 2 * ML_WIDTH, ML_WIDTH, ML_WIDTH, ML_HEADS, ML_HEADS, D_MODEL, D_MODEL)
N_IN = 3 * SB_WIDTH + 4 * ML_WIDTH + 2 * ML_HEADS + 2 * D_MODEL

kernel_name = "hybrid_stickbreak_mlstm_moe_adaln"


def rmsnorm(x, g):
    xf = x.astype(jnp.float32)
    y = xf * lax.rsqrt(jnp.mean(xf * xf, axis=-1, keepdims=True) + EPS)
    return (y * g.astype(jnp.float32)).astype(x.dtype)


def split_heads(t, n_heads):
    b, s, w = t.shape
    return t.reshape(b, s, n_heads, w // n_heads).transpose(0, 2, 1, 3)


def merge_heads(t):
    b, h, s, d = t.shape
    return t.transpose(0, 2, 1, 3).reshape(b, s, h * d)


def stick_breaking_attention(q, k, v):
    seq = q.shape[2]
    scale = q.shape[-1] ** -0.5
    outs = []
    for blk in range(seq // QUERY_BLOCK):
        t0 = blk * QUERY_BLOCK
        t1 = t0 + QUERY_BLOCK
        z = jnp.einsum('bhtd,bhsd->bhts', q[:, :, t0:t1], k[:, :, :t1],
                       preferred_element_type=jnp.float32) * scale
        strict = jnp.arange(t1)[None, :] < jnp.arange(t0, t1)[:, None]
        log_beta = jax.nn.log_sigmoid(z)
        log_keep = jnp.where(strict, jax.nn.log_sigmoid(-z), 0.0)
        between = lax.cumsum(log_keep, axis=3, reverse=True) - log_keep
        a = jnp.where(strict, jnp.exp(log_beta + between), 0.0)
        outs.append(jnp.einsum('bhts,bhsd->bhtd', a, v[:, :, :t1].astype(jnp.float32)))
    return jnp.concatenate(outs, axis=2).astype(v.dtype)


def causal_conv(x, w, b):
    width = w.shape[0]
    seq = x.shape[1]
    xp = jnp.pad(x, ((0, 0), (width - 1, 0), (0, 0)))
    y = b
    for tap in range(width):
        y = y + xp[:, tap:tap + seq] * w[tap]
    return y


def mlstm_chunkwise(q, k, v, i_pre, f_pre):
    f32 = jnp.float32
    bsz, nh, seq, dk = q.shape
    dv = v.shape[-1]
    L = ML_CHUNK
    nc = seq // L
    q = q.astype(f32)
    k = k.astype(f32) * (dk ** -0.5)
    v = v.astype(f32)
    ig = i_pre.astype(f32)
    lf = jax.nn.log_sigmoid(f_pre.astype(f32))

    def to_chunks(t):
        t = t.reshape(bsz, nh, nc, L, *t.shape[3:])
        return jnp.moveaxis(t, 2, 0)

    incl = jnp.tril(jnp.ones((L, L), dtype=bool))

    def step(carry, xs):
        c_mat, n_vec, m_prev = carry
        qc, kc, vc, ic, fc = xs
        b = jnp.cumsum(fc, axis=-1)
        d = jnp.where(incl, b[..., :, None] - b[..., None, :] + ic[..., None, :], -jnp.inf)
        m_row = jnp.maximum(b + m_prev[..., None], jnp.max(d, axis=-1))
        w_inter = jnp.exp(b + m_prev[..., None] - m_row)
        w_intra = jnp.exp(d - m_row[..., None])
        s = jnp.einsum('bhtd,bhsd->bhts', qc, kc) * w_intra
        num = (w_inter[..., None] * jnp.einsum('bhtd,bhde->bhte', qc, c_mat)
               + jnp.einsum('bhts,bhse->bhte', s, vc))
        den = w_inter * jnp.einsum('bhtd,bhd->bht', qc, n_vec) + jnp.sum(s, axis=-1)
        h = num / jnp.maximum(jnp.abs(den), jnp.exp(-m_row))[..., None]
        m_new = m_row[..., -1]
        decay = jnp.exp(b[..., -1] + m_prev - m_new)
        w_state = jnp.exp(b[..., -1:] - b + ic - m_new[..., None])
        wk = w_state[..., None] * kc
        c_new = decay[..., None, None] * c_mat + jnp.einsum('bhsd,bhse->bhde', wk, vc)
        n_new = decay[..., None] * n_vec + jnp.sum(wk, axis=2)
        return (c_new, n_new, m_new), h

    init = (jnp.zeros((bsz, nh, dk, dv), f32), jnp.zeros((bsz, nh, dk), f32), jnp.zeros((bsz, nh), f32))
    _, h = lax.scan(step, init, (to_chunks(q), to_chunks(k), to_chunks(v), to_chunks(ig), to_chunks(lf)))
    return jnp.moveaxis(h, 0, 2).reshape(bsz, nh, seq, dv)


def hybrid_mixer(h, w_in, conv_w, conv_b, b_i, b_f, norm_g, w_a, w_b, w_out):
    proj = h @ w_in
    cuts = np.cumsum(IN_SPLIT)[:-1].tolist()
    sb_q, sb_k, sb_v, ml_qk, ml_v, ml_o, ml_i, ml_f, g_a, g_b = jnp.split(proj, cuts, axis=-1)
    y_a = merge_heads(stick_breaking_attention(split_heads(sb_q, SB_HEADS), split_heads(sb_k, SB_HEADS),
                                               split_heads(sb_v, SB_HEADS)))
    ml_qk = jax.nn.silu(causal_conv(ml_qk, conv_w, conv_b))
    ml_q, ml_k = jnp.split(ml_qk, 2, axis=-1)
    i_pre = (ml_i + b_i).transpose(0, 2, 1)
    f_pre = (ml_f + b_f).transpose(0, 2, 1)
    hb = mlstm_chunkwise(split_heads(ml_q, ML_HEADS), split_heads(ml_k, ML_HEADS),
                         split_heads(ml_v, ML_HEADS), i_pre, f_pre)
    hb = rmsnorm(hb, norm_g.reshape(ML_HEADS, 1, ML_HEAD_DIM))
    y_b = merge_heads(hb).astype(h.dtype) * jax.nn.sigmoid(ml_o)
    merged = jax.nn.sigmoid(g_a) * (y_a @ w_a) + jax.nn.sigmoid(g_b) * (y_b @ w_b)
    return merged @ w_out


def clamped_swiglu_expert(xb, w1, b1, w2, b2):
    a = xb @ w1 + b1
    x_glu, x_lin = jnp.split(a, 2, axis=-1)
    x_glu = jnp.minimum(x_glu, SWIGLU_LIMIT)
    x_lin = jnp.clip(x_lin, -SWIGLU_LIMIT, SWIGLU_LIMIT)
    return ((x_lin + 1.0) * (x_glu * jax.nn.sigmoid(SWIGLU_ALPHA * x_glu))) @ w2 + b2


def routed_moe(h, router_w, router_b, w1, b1, w2, b2):
    bsz, seq, d = h.shape
    n_tok = bsz * seq
    n_assign = n_tok * TOP_K
    xt = h.reshape(n_tok, d)
    logits = (xt @ router_w + router_b).astype(jnp.float32)
    top_logit, top_idx = lax.top_k(logits, TOP_K)
    top_w = jax.nn.softmax(top_logit, axis=-1)
    flat_e = top_idx.reshape(-1)
    flat_tok = jnp.repeat(jnp.arange(n_tok, dtype=jnp.int32), TOP_K)
    flat_w = top_w.reshape(-1)
    order = jnp.argsort(flat_e)
    sorted_e = flat_e[order]
    counts = jnp.bincount(flat_e, length=N_EXPERTS)
    padded = (counts + MOE_BLOCK - 1) // MOE_BLOCK * MOE_BLOCK
    start = jnp.cumsum(counts) - counts
    pad_end = jnp.cumsum(padded)
    pad_start = pad_end - padded
    dest = pad_start[sorted_e] + jnp.arange(n_assign, dtype=jnp.int32) - start[sorted_e]
    n_rows = n_assign + N_EXPERTS * MOE_BLOCK
    n_blocks = n_rows // MOE_BLOCK
    row_tok = jnp.zeros((n_rows,), jnp.int32).at[dest].set(flat_tok[order])
    row_w = jnp.zeros((n_rows,), jnp.float32).at[dest].set(flat_w[order])
    block_e = jnp.minimum(jnp.searchsorted(pad_end, jnp.arange(n_blocks, dtype=jnp.int32) * MOE_BLOCK,
                                           side='right'), N_EXPERTS - 1)
    xs = xt[row_tok].reshape(n_blocks, MOE_BLOCK, d)

    def run_block(args):
        xb, e = args
        return clamped_swiglu_expert(xb, w1[e], b1[e], w2[e], b2[e])

    rows = lax.map(run_block, (xs, block_e)).reshape(n_rows, d)
    y = jnp.zeros((n_tok, d), h.dtype).at[row_tok].add((rows * row_w[:, None]).astype(h.dtype))
    return y.reshape(bsz, seq, d)


def setup_inputs(seed: int = 0) -> dict:
    key = jax.random.key(seed)
    ks = jax.random.split(key, 24)
    f32 = jnp.float32
    nrm = lambda k, shape, s: jax.random.normal(k, shape, f32) * s
    return {
        "x": nrm(ks[0], (BATCH, SEQ, D_MODEL), 1.0),
        "c": nrm(ks[1], (BATCH, D_MODEL), 1.0),
        "ada_w": nrm(ks[2], (DEPTH, D_MODEL, N_MOD * D_MODEL), 0.2 * D_MODEL ** -0.5),
        "ada_b": nrm(ks[3], (DEPTH, N_MOD * D_MODEL), 0.02),
        "norm1_g": 1.0 + nrm(ks[4], (DEPTH, D_MODEL), 0.02),
        "w_in": nrm(ks[5], (DEPTH, D_MODEL, N_IN), D_MODEL ** -0.5),
        "conv_w": nrm(ks[6], (DEPTH, CONV_WIDTH, 2 * ML_WIDTH), CONV_WIDTH ** -0.5),
        "conv_b": nrm(ks[7], (DEPTH, 2 * ML_WIDTH), 0.02),
        "ml_b_i": nrm(ks[8], (DEPTH, ML_HEADS), 0.1),
        "ml_b_f": jnp.broadcast_to(jnp.linspace(3.0, 6.0, ML_HEADS, dtype=f32), (DEPTH, ML_HEADS))
                   + nrm(ks[9], (DEPTH, ML_HEADS), 0.1),
        "ml_norm_g": 1.0 + nrm(ks[10], (DEPTH, ML_WIDTH), 0.02),
        "w_branch_a": nrm(ks[11], (DEPTH, SB_WIDTH, D_MODEL), SB_WIDTH ** -0.5),
        "w_branch_b": nrm(ks[12], (DEPTH, ML_WIDTH, D_MODEL), ML_WIDTH ** -0.5),
        "w_out": nrm(ks[13], (DEPTH, D_MODEL, D_MODEL), D_MODEL ** -0.5),
        "norm2_g": 1.0 + nrm(ks[14], (DEPTH, D_MODEL), 0.02),
        "router_w": nrm(ks[15], (DEPTH, D_MODEL, N_EXPERTS), D_MODEL ** -0.5),
        "router_b": nrm(ks[16], (DEPTH, N_EXPERTS), 0.01),
        "expert_w1": nrm(ks[17], (DEPTH, N_EXPERTS, D_MODEL, 2 * D_FF), D_MODEL ** -0.5),
        "expert_b1": nrm(ks[18], (DEPTH, N_EXPERTS, 2 * D_FF), 0.01),
        "expert_w2": nrm(ks[19], (DEPTH, N_EXPERTS, D_FF, D_MODEL), D_FF ** -0.5),
        "expert_b2": nrm(ks[20], (DEPTH, N_EXPERTS, D_MODEL), 0.01),
        "final_g": 1.0 + nrm(ks[21], (D_MODEL,), 0.02),
    }


def reference(x, c, ada_w, ada_b, norm1_g, w_in, conv_w, conv_b, ml_b_i, ml_b_f, ml_norm_g,
              w_branch_a, w_branch_b, w_out, norm2_g, router_w, router_b,
              expert_w1, expert_b1, expert_w2, expert_b2, final_g):
    for layer in range(DEPTH):
        mod = (jax.nn.silu(c) @ ada_w[layer] + ada_b[layer])[:, None, :]
        sh1, sc1, g1, sh2, sc2, g2 = jnp.split(mod, N_MOD, axis=-1)
        h = rmsnorm(x, norm1_g[layer]) * (1.0 + sc1) + sh1
        x = x + g1 * hybrid_mixer(h, w_in[layer], conv_w[layer], conv_b[layer], ml_b_i[layer], ml_b_f[layer],
                                  ml_norm_g[layer], w_branch_a[layer], w_branch_b[layer], w_out[layer])
        h = rmsnorm(x, norm2_g[layer]) * (1.0 + sc2) + sh2
        x = x + g2 * routed_moe(h, router_w[layer], router_b[layer], expert_w1[layer], expert_b1[layer],
                                expert_w2[layer], expert_b2[layer])
    return rmsnorm(x, final_g)
```

```cpp
#include <hip/hip_runtime.h>
#include <cstdio>
#include <cstdint>
namespace pg8 {
#define PG8_LAS __attribute__((address_space(3)))
typedef unsigned short bf16_t;
typedef short bf16x8 __attribute__((ext_vector_type(8)));
typedef float f32x4 __attribute__((ext_vector_type(4)));
typedef unsigned u32x4 __attribute__((ext_vector_type(4)));
constexpr int BM = 256, BK = 64, HALF = 128, HTB = HALF * BK * 2  , STAGE_BYTES = 8 * HTB, NXCD = 8, WGM = 8;

__host__ __device__ __forceinline__ int lds_byte(int r, int c) { const int st = (r >> 4) * 2 + (c >> 5), rr = r & 15, cc = c & 31, ob = rr * 64 + cc * 2; return st * 1024 + (ob ^ (((ob >> 9) & 1) << 5)); }
__host__ __device__ __forceinline__ void stage_rc(int b, int& R, int& C) { const int st = b / 1024, sb = b % 1024, swz = sb ^ (((sb >> 9) & 1) << 5); R = (st >> 1) * 16 + swz / 64; C = (st & 1) * 32 + (swz % 64) / 2; }
__host__ __device__ __forceinline__ int perm32(int rho) { const int n = rho >> 4, i = rho & 15; return 8 * (i >> 2) + 4 * n + (i & 3); }

struct Unit { int pm, pn; };
struct Gemm { const bf16_t* A; const bf16_t* Bt; int M, N, K; };

struct StaticOrder {
    int nM, nN, nwg, G, c;
    __host__ __device__ void init(int M, int N, int G_, int c_) { nM = M / BM; nN = N / BM; nwg = nM * nN; G = G_; c = c_; }
    __host__ __device__ bool next(int i, Unit& u) const {
        const long L = (long)i * G + c; if (L >= nwg) return false;
        int wgid = (int)L; { const int q = nwg / NXCD, r = nwg % NXCD, xcd = wgid % NXCD, off = wgid / NXCD; wgid = (xcd < r ? xcd * (q + 1) : r * (q + 1) + (xcd - r) * q) + off; }
        const int nig = WGM * nN, gid = wgid / nig, fm = gid * WGM, gsz = (nM - fm) < WGM ? (nM - fm) : WGM;
        u.pm = fm + ((wgid % nig) % gsz); u.pn = (wgid % nig) / gsz; return true;
    }
    __device__ __forceinline__ void a_ready(const Unit&) const {}
    __device__ __forceinline__ void done(const Unit&) const {}
};

__device__ __forceinline__ unsigned cvt_pk_bf16(float lo, float hi) { unsigned r; asm volatile("v_cvt_pk_bf16_f32 %0, %1, %2" : "=v"(r) : "v"(lo), "v"(hi)); return r; }
typedef float f32x2 __attribute__((ext_vector_type(2)));
__device__ __forceinline__ f32x2 gelu_pk(f32x2 v) {
    const f32x2 av = __builtin_elementwise_abs(v), d = av * 0.2316418882f + 1.0f;
    f32x2 t; t.x = __builtin_amdgcn_rcpf(d.x); t.y = __builtin_amdgcn_rcpf(d.y);
    f32x2 q = t * 0.5307027145f + (-0.7265760135f); q = q * t + 0.7107068705f; q = q * t + (-0.142248368f); q = q * t + 0.127414796f; q = q * t;
    const f32x2 s = (v * v) * (-0.72134752044f);
    f32x2 e; e.x = __builtin_amdgcn_exp2f(s.x); e.y = __builtin_amdgcn_exp2f(s.y);
    const f32x2 m = v * (q * e), r = v - m;
    f32x2 o; o.x = v.x < 0.f ? m.x : r.x; o.y = v.y < 0.f ? m.y : r.y; return o;
}

template <int ACT  > struct EpiBf16 {
    static constexpr bool PERM = true, AFTER_DRAIN = false; static_assert(ACT == 0 || ACT == 1, "EpiBf16: ACT is 0 (none) or 1 (gelu_pk)");
    bf16_t* O; int ldc; const float* bias; int split_cols; size_t split_stride; float scale0;
    __device__ __forceinline__ void operator()(const f32x4 (&acc)[2][2][4][2], const Unit& u, int wr, int wc, int fr, int fq) const {
        const int row0 = u.pm * BM + wr * 64 + fr; int colt = u.pn * BM; bf16_t* base = O;
        float sc = 1.f; if (split_cols) { const int t = colt / split_cols; base += (size_t)t * split_stride; colt -= t * split_cols; if (t == 0) sc = scale0; }
        const int col0 = colt + wc * 32 + 8 * fq, bcol0 = u.pn * BM + wc * 32 + 8 * fq;
        f32x4 bv[2][2];
#pragma unroll
        for (int bj = 0; bj < 2; ++bj)
#pragma unroll
            for (int n = 0; n < 2; ++n) bv[bj][n] = bias ? *(const f32x4*)(bias + bcol0 + bj * HALF + 4 * n) : (f32x4){0.f, 0.f, 0.f, 0.f};
#pragma unroll
        for (int ai = 0; ai < 2; ++ai)
#pragma unroll
            for (int m = 0; m < 4; ++m) { bf16_t* rowp = base + (size_t)(row0 + ai * HALF + m * 16) * ldc + col0;
#pragma unroll
                for (int bj = 0; bj < 2; ++bj) { f32x4 v0 = acc[ai][bj][m][0] + bv[bj][0], v1 = acc[ai][bj][m][1] + bv[bj][1];
                    if (ACT == 1) { f32x2 a = gelu_pk((f32x2){v0[0], v0[1]}), b = gelu_pk((f32x2){v0[2], v0[3]}), c = gelu_pk((f32x2){v1[0], v1[1]}), d = gelu_pk((f32x2){v1[2], v1[3]});
                        v0 = (f32x4){a.x, a.y, b.x, b.y}; v1 = (f32x4){c.x, c.y, d.x, d.y}; }
                    v0 = v0 * sc; v1 = v1 * sc; u32x4 w; w.x = cvt_pk_bf16(v0[0], v0[1]); w.y = cvt_pk_bf16(v0[2], v0[3]); w.z = cvt_pk_bf16(v1[0], v1[1]); w.w = cvt_pk_bf16(v1[2], v1[3]);
                    *(u32x4*)(rowp + bj * HALF) = w; } }
    }
};
template <class Epi, class Sched, bool ALIGN_EPI = false, bool SP2 = false>
__device__ __forceinline__ void gemm_phase(PG8_LAS unsigned char* lds, const Gemm g, const Sched& S, const Epi& E) {
    const int tid = threadIdx.x, wid = __builtin_amdgcn_readfirstlane(tid >> 6), lane = tid & 63, wr = wid >> 2, wc = wid & 3, fr = lane & 15, fq = lane >> 4;
    const int K = g.K, nt = K / BK;
    unsigned voffA[2], voffB[2];
#pragma unroll
    for (int i = 0; i < 2; ++i) { int R, C; stage_rc(tid * 16 + i * 8192, R, C); const int Rb = Epi::PERM ? ((R & ~31) + perm32(R & 31)) : R;
        voffA[i] = (unsigned)(R * K + C) * 2u; voffB[i] = (unsigned)(Rb * K + C) * 2u; }
    const size_t kstep = (size_t)(BK * 2);
    const size_t hstep = (size_t)HALF * K * 2;
    const size_t tstep = 2 * hstep;
    const unsigned ldsw = (unsigned)wid * 1024u;
    const int aoff = lds_byte(wr * 64 + fr, fq * 8), boff = lds_byte(wc * 32 + fr, fq * 8);
#define PG8_SA(b, h) (((b) * 2 + (h)) * HTB)
#define PG8_SB(b, h) ((4 + (b) * 2 + (h)) * HTB)
#define PG8_STAGE(bufoff, gbase, voff) do { _Pragma("unroll") for (int _i = 0; _i < 2; ++_i) \
        __builtin_amdgcn_global_load_lds((const unsigned*)((const char*)(gbase) + (voff)[_i]), (PG8_LAS unsigned*)(lds + (bufoff) + ldsw + _i * 8192), 16, 0, 0); } while (0)
#define PG8_LDA(dst, b, h) do { _Pragma("unroll") for (int m = 0; m < 4; ++m) _Pragma("unroll") for (int k = 0; k < 2; ++k) dst[m][k] = *(const PG8_LAS bf16x8*)(lds + PG8_SA(b, h) + aoff + m * 2048 + k * 1024); } while (0)
#define PG8_LDB(dst, b, h) do { _Pragma("unroll") for (int n = 0; n < 2; ++n) _Pragma("unroll") for (int k = 0; k < 2; ++k) dst[n][k] = *(const PG8_LAS bf16x8*)(lds + PG8_SB(b, h) + boff + n * 2048 + k * 1024); } while (0)
#define PG8_MMA(ai, bj, At, Bt) do { __builtin_amdgcn_s_setprio(1); _Pragma("unroll") for (int m = 0; m < 4; ++m) _Pragma("unroll") for (int n = 0; n < 2; ++n) _Pragma("unroll") for (int k = 0; k < 2; ++k) \
        acc[ai][bj][m][n] = __builtin_amdgcn_mfma_f32_16x16x32_bf16(Bt[n][k], At[m][k], acc[ai][bj][m][n], 0, 0, 0); __builtin_amdgcn_s_setprio(0); } while (0)
#define PG8_WAIT_V(n) asm volatile("s_waitcnt vmcnt(" #n ")" ::: "memory")
#define PG8_WAIT_L(n) asm volatile("s_waitcnt lgkmcnt(" #n ")" ::: "memory")
#define PG8_BAR __builtin_amdgcn_s_barrier()
#define PG8_SCHED __builtin_amdgcn_sched_barrier(0)
    Unit cur, nxt; int ui = 0;
    if (!S.next(0, cur)) return;
    f32x4 acc[2][2][4][2];
#pragma unroll
    for (int a = 0; a < 2; ++a)
#pragma unroll
        for (int b = 0; b < 2; ++b)
#pragma unroll
            for (int m = 0; m < 4; ++m)
#pragma unroll
                for (int n = 0; n < 2; ++n) acc[a][b][m][n] = (f32x4){0.f, 0.f, 0.f, 0.f};
    bf16x8 At[4][2], B0[2][2], B1[2][2];
    const char* cA = (const char*)g.A + (size_t)cur.pm * tstep; const char* cB = (const char*)g.Bt + (size_t)cur.pn * tstep;
    S.a_ready(cur);
    if constexpr (SP2) {
        PG8_STAGE(PG8_SB(0, 0), cB, voffB); PG8_STAGE(PG8_SB(0, 1), cB + hstep, voffB); PG8_STAGE(PG8_SA(0, 0), cA, voffA); PG8_STAGE(PG8_SA(0, 1), cA + hstep, voffA);
        if (wr == 1) PG8_BAR;
        PG8_WAIT_V(2); PG8_BAR;
        PG8_STAGE(PG8_SB(1, 0), cB + kstep, voffB); PG8_STAGE(PG8_SA(1, 0), cA + kstep, voffA); PG8_STAGE(PG8_SB(1, 1), cB + hstep + kstep, voffB);
        PG8_WAIT_V(6); PG8_BAR;
    } else {
        PG8_STAGE(PG8_SB(0, 0), cB, voffB); PG8_STAGE(PG8_SA(0, 0), cA, voffA); PG8_STAGE(PG8_SB(0, 1), cB + hstep, voffB); PG8_STAGE(PG8_SA(0, 1), cA + hstep, voffA);
        if (wr == 1) PG8_BAR;
        PG8_WAIT_V(4); PG8_BAR;
        PG8_STAGE(PG8_SB(1, 0), cB + kstep, voffB); PG8_STAGE(PG8_SA(1, 0), cA + kstep, voffA); PG8_STAGE(PG8_SB(1, 1), cB + hstep + kstep, voffB);
        PG8_WAIT_V(6); PG8_BAR;
    }
    for (;;) {
        const bool has_next = S.next(ui + 1, nxt);
        const char* nA = has_next ? (const char*)g.A + (size_t)nxt.pm * tstep : cA; const char* nB = has_next ? (const char*)g.Bt + (size_t)nxt.pn * tstep : cB;
        for (int t = 0; t < nt; t += 2) {
            const bool last = (t == nt - 2);
            const char* a1 = cA + (size_t)(t + 1) * kstep;
            const char* a2 = last ? nA : cA + (size_t)(t + 2) * kstep; const char* b2 = last ? nB : cB + (size_t)(t + 2) * kstep;
            const char* a3 = a2 + kstep; const char* b3 = b2 + kstep;
            if (last && has_next) S.a_ready(nxt);
            if constexpr (SP2) {
            PG8_LDB(B0, 0, 0); PG8_LDB(B1, 0, 1); PG8_SCHED; PG8_LDA(At, 0, 0); PG8_STAGE(PG8_SA(1, 1), a1 + hstep, voffA);
            PG8_WAIT_V(8); PG8_WAIT_L(0); PG8_BAR; PG8_MMA(0, 0, At, B0); PG8_MMA(0, 1, At, B1); PG8_BAR; PG8_SCHED;
            PG8_LDA(At, 0, 1); PG8_STAGE(PG8_SB(0, 0), b2, voffB); PG8_STAGE(PG8_SB(0, 1), b2 + hstep, voffB); PG8_STAGE(PG8_SA(0, 0), a2, voffA);
            PG8_WAIT_V(8); PG8_WAIT_L(0); PG8_BAR; PG8_MMA(1, 0, At, B0); PG8_MMA(1, 1, At, B1); PG8_BAR; PG8_SCHED;
            PG8_LDB(B0, 1, 0); PG8_LDB(B1, 1, 1); PG8_SCHED; PG8_LDA(At, 1, 0); PG8_STAGE(PG8_SA(0, 1), a2 + hstep, voffA);
            PG8_WAIT_V(8); PG8_WAIT_L(0); PG8_BAR; PG8_MMA(0, 0, At, B0); PG8_MMA(0, 1, At, B1); PG8_BAR; PG8_SCHED;
            PG8_LDA(At, 1, 1); PG8_STAGE(PG8_SB(1, 0), b3, voffB); PG8_STAGE(PG8_SB(1, 1), b3 + hstep, voffB); PG8_STAGE(PG8_SA(1, 0), a3, voffA);
            PG8_WAIT_V(8); PG8_WAIT_L(0); PG8_BAR; PG8_MMA(1, 0, At, B0); PG8_MMA(1, 1, At, B1); PG8_BAR; PG8_SCHED;
            } else {
            PG8_LDB(B0, 0, 0); PG8_SCHED; PG8_LDA(At, 0, 0); PG8_STAGE(PG8_SA(1, 1), a1 + hstep, voffA);
            PG8_WAIT_L(8); PG8_BAR; PG8_WAIT_L(0); PG8_MMA(0, 0, At, B0); PG8_BAR; PG8_SCHED;
            PG8_LDB(B1, 0, 1); PG8_STAGE(PG8_SB(0, 0), b2, voffB);
            PG8_BAR; PG8_WAIT_L(0); PG8_MMA(0, 1, At, B1); PG8_BAR;
            PG8_LDA(At, 0, 1); PG8_STAGE(PG8_SA(0, 0), a2, voffA);
            PG8_BAR; PG8_WAIT_L(0); PG8_MMA(1, 0, At, B0); PG8_BAR; PG8_SCHED;
            PG8_STAGE(PG8_SB(0, 1), b2 + hstep, voffB);
            PG8_WAIT_V(6); PG8_BAR; PG8_MMA(1, 1, At, B1); PG8_BAR;
            PG8_LDB(B0, 1, 0); PG8_SCHED; PG8_LDA(At, 1, 0); PG8_STAGE(PG8_SA(0, 1), a2 + hstep, voffA);
            PG8_WAIT_L(8); PG8_BAR; PG8_WAIT_L(0); PG8_MMA(0, 0, At, B0); PG8_BAR; PG8_SCHED;
            PG8_LDB(B1, 1, 1); PG8_STAGE(PG8_SB(1, 0), b3, voffB);
            PG8_BAR; PG8_WAIT_L(0); PG8_MMA(0, 1, At, B1); PG8_BAR;
            PG8_LDA(At, 1, 1); PG8_STAGE(PG8_SA(1, 0), a3, voffA);
            PG8_BAR; PG8_WAIT_L(0); PG8_MMA(1, 0, At, B0); PG8_BAR; PG8_SCHED;
            PG8_STAGE(PG8_SB(1, 1), b3 + hstep, voffB);
            PG8_WAIT_V(6); PG8_BAR; PG8_MMA(1, 1, At, B1); PG8_BAR;
            }
        }
        if constexpr (ALIGN_EPI) { if (wr == 0) PG8_BAR; }
        if constexpr (!Epi::AFTER_DRAIN) { E(acc, cur, wr, wc, fr, fq); S.done(cur); }
        if (!has_next) break;
#pragma unroll
        for (int a = 0; a < 2; ++a)
#pragma unroll
            for (int b = 0; b < 2; ++b)
#pragma unroll
                for (int m = 0; m < 4; ++m)
#pragma unroll
                    for (int n = 0; n < 2; ++n) acc[a][b][m][n] = (f32x4){0.f, 0.f, 0.f, 0.f};
        cur = nxt; cA = nA; cB = nB; ++ui;
        if constexpr (ALIGN_EPI) { if (wr == 1) PG8_BAR; }
    }
    PG8_WAIT_V(0);
    if constexpr (!ALIGN_EPI) { if (wr == 0) PG8_BAR; }
    PG8_BAR;
    if constexpr (Epi::AFTER_DRAIN) { E.fused(acc, cur, wr, wc, fr, fq, lds, wid, lane); S.done(cur); }
#undef PG8_SA
#undef PG8_SB
#undef PG8_STAGE
#undef PG8_LDA
#undef PG8_LDB
#undef PG8_MMA
#undef PG8_WAIT_V
#undef PG8_WAIT_L
#undef PG8_BAR
#undef PG8_SCHED
}
}
namespace pg8 {
__device__ __forceinline__ float bf_lo(unsigned w) { return __builtin_bit_cast(float, w << 16); }
__device__ __forceinline__ float bf_hi(unsigned w) { return __builtin_bit_cast(float, w & 0xffff0000u); }
__device__ __forceinline__ float sigmoid_f(float x) { return __builtin_amdgcn_rcpf(1.0f + __expf(-x)); }

template <bool ADD> struct EpiGate {
    static constexpr bool PERM = true, AFTER_DRAIN = false;
    const bf16_t* G; const bf16_t* Min; bf16_t* O;
    __device__ __forceinline__ void operator()(const f32x4 (&acc)[2][2][4][2], const Unit& u, int wr, int wc, int fr, int fq) const {
        const int row0 = u.pm * BM + wr * 64 + fr, col0 = u.pn * BM + wc * 32 + 8 * fq;
#pragma unroll
        for (int ai = 0; ai < 2; ++ai)
#pragma unroll
            for (int m = 0; m < 4; ++m) { const size_t off = (size_t)(row0 + ai * HALF + m * 16) * 1024 + col0;
#pragma unroll
                for (int bj = 0; bj < 2; ++bj) {
                    const u32x4 g = *(const u32x4*)(G + off + bj * HALF);
                    f32x4 v0 = acc[ai][bj][m][0], v1 = acc[ai][bj][m][1];
                    v0[0] *= sigmoid_f(bf_lo(g.x)); v0[1] *= sigmoid_f(bf_hi(g.x)); v0[2] *= sigmoid_f(bf_lo(g.y)); v0[3] *= sigmoid_f(bf_hi(g.y));
                    v1[0] *= sigmoid_f(bf_lo(g.z)); v1[1] *= sigmoid_f(bf_hi(g.z)); v1[2] *= sigmoid_f(bf_lo(g.w)); v1[3] *= sigmoid_f(bf_hi(g.w));
                    if (ADD) { const u32x4 p = *(const u32x4*)(Min + off + bj * HALF);
                        v0[0] += bf_lo(p.x); v0[1] += bf_hi(p.x); v0[2] += bf_lo(p.y); v0[3] += bf_hi(p.y);
                        v1[0] += bf_lo(p.z); v1[1] += bf_hi(p.z); v1[2] += bf_lo(p.w); v1[3] += bf_hi(p.w); }
                    u32x4 w; w.x = cvt_pk_bf16(v0[0], v0[1]); w.y = cvt_pk_bf16(v0[2], v0[3]); w.z = cvt_pk_bf16(v1[0], v1[1]); w.w = cvt_pk_bf16(v1[2], v1[3]);
                    *(u32x4*)(O + off + bj * HALF) = w; } }
    }
};

struct EpiResid {
    static constexpr bool PERM = false, AFTER_DRAIN = false;
    const float* X; const float* gate; float* out; int rows_per_batch; int gstride;
    __device__ __forceinline__ void operator()(const f32x4 (&acc)[2][2][4][2], const Unit& u, int wr, int wc, int fr, int fq) const {
        const int col0 = u.pn * BM + wc * 32 + 4 * fq;
#pragma unroll
        for (int ai = 0; ai < 2; ++ai)
#pragma unroll
            for (int m = 0; m < 4; ++m) { const int row = u.pm * BM + ai * HALF + wr * 64 + m * 16 + fr; const size_t off = (size_t)row * 1024 + col0;
                const float* gp = gate + (size_t)(row / rows_per_batch) * gstride + col0;
#pragma unroll
                for (int bj = 0; bj < 2; ++bj)
#pragma unroll
                    for (int n = 0; n < 2; ++n) { const f32x4 xv = *(const f32x4*)(X + off + bj * HALF + n * 16); const f32x4 gv = *(const f32x4*)(gp + bj * HALF + n * 16);
                        *(f32x4*)(out + off + bj * HALF + n * 16) = xv + gv * acc[ai][bj][m][n]; } }
    }
};

__device__ __forceinline__ float swiglu1(float g, float l) {
    g = fminf(g, 7.0f); l = fminf(fmaxf(l, -7.0f), 7.0f);
    return (l + 1.0f) * (g * __builtin_amdgcn_rcpf(1.0f + __expf(-1.702f * g)));
}
struct EpiSwiglu {
    static constexpr bool PERM = true, AFTER_DRAIN = false;
    const float* b1; bf16_t* O;
    __device__ __forceinline__ void operator()(const f32x4 (&acc)[2][2][4][2], const Unit& u, int wr, int wc, int fr, int fq) const {
        const int e = u.pn >> 3, pl = u.pn & 7, jc = wc * 32 + 8 * fq;
        const float* bg = b1 + (size_t)e * 2048 + 128 * pl + jc; const float* bl = bg + 1024;
        const f32x4 bg0 = *(const f32x4*)bg, bg1 = *(const f32x4*)(bg + 4), bl0 = *(const f32x4*)bl, bl1 = *(const f32x4*)(bl + 4);
        const int row0 = u.pm * BM + wr * 64 + fr;
#pragma unroll
        for (int ai = 0; ai < 2; ++ai)
#pragma unroll
            for (int m = 0; m < 4; ++m) {
                const f32x4 g0 = acc[ai][0][m][0] + bg0, g1 = acc[ai][0][m][1] + bg1, l0 = acc[ai][1][m][0] + bl0, l1 = acc[ai][1][m][1] + bl1;
                u32x4 w; w.x = cvt_pk_bf16(swiglu1(g0[0], l0[0]), swiglu1(g0[1], l0[1])); w.y = cvt_pk_bf16(swiglu1(g0[2], l0[2]), swiglu1(g0[3], l0[3]));
                w.z = cvt_pk_bf16(swiglu1(g1[0], l1[0]), swiglu1(g1[1], l1[1])); w.w = cvt_pk_bf16(swiglu1(g1[2], l1[2]), swiglu1(g1[3], l1[3]));
                *(u32x4*)(O + (size_t)(row0 + ai * HALF + m * 16) * 1024 + 128 * pl + jc) = w; }
    }
};

struct GroupedOrder {
    const PG8_LAS int* ts; int NT, G, c;
    __device__ __forceinline__ bool next(int i, Unit& u) const {
        const int total = __builtin_amdgcn_readfirstlane(ts[32]) * NT; const long L = (long)i * G + c; if (L >= total) return false;
        const int pm = (int)L / NT, pl = (int)L % NT; int e = 0;
#pragma unroll 1
        for (int j = 1; j < 32; ++j) e += (pm >= ts[j]) ? 1 : 0;
        u.pm = __builtin_amdgcn_readfirstlane(pm); u.pn = __builtin_amdgcn_readfirstlane(e * NT + pl); return true;
    }
    __device__ __forceinline__ void a_ready(const Unit&) const {}
    __device__ __forceinline__ void done(const Unit&) const {}
};
}
#define GAS __attribute__((address_space(1)))
#define LAS __attribute__((address_space(3)))
typedef unsigned short bf16;
typedef unsigned v4u __attribute__((ext_vector_type(4)));
typedef float f32x4 __attribute__((ext_vector_type(4)));
typedef short bf16x8 __attribute__((ext_vector_type(8)));
typedef GAS unsigned gu32;
typedef GAS unsigned long long gu64;
#define RLX_AGENT __ATOMIC_RELAXED, __HIP_MEMORY_SCOPE_AGENT
#define LDS_WAIT() asm volatile("s_waitcnt lgkmcnt(0)" ::: "memory")
#define VM_WAIT() asm volatile("s_waitcnt vmcnt(0)" ::: "memory")
__device__ __forceinline__ unsigned long long rt() { return __builtin_amdgcn_s_memrealtime(); }
__device__ __forceinline__ unsigned f2bf(float f) { unsigned u = __builtin_bit_cast(unsigned, f); return (u + 0x7fffu + ((u >> 16) & 1u)) >> 16; }
__device__ __forceinline__ unsigned pk2(float lo, float hi) { return f2bf(lo) | (f2bf(hi) << 16); }

#define XB_TMO      128
#define XB_XCNT(j)  (256  + 64 * (j))
#define XB_XSUB(j)  (1280 + 64 * (j))
#define XB_XGEN(j)  (2304 + 64 * (j))
#define XB_TOP      3328
#define XB_TOPGEN   3392
#define XCD_BAR_WORDS 3456
#define XB_SPIN_CAP (1u << 18)

__device__ __forceinline__ unsigned xb_ld(unsigned* p)              { return __hip_atomic_load(p, __ATOMIC_RELAXED, __HIP_MEMORY_SCOPE_AGENT); }
__device__ __forceinline__ unsigned xb_add(unsigned* p, unsigned v) { return __hip_atomic_fetch_add(p, v, __ATOMIC_RELAXED, __HIP_MEMORY_SCOPE_AGENT); }
__device__ __forceinline__ unsigned xb_xcc_id() { return (unsigned)__builtin_amdgcn_s_getreg((3 << 11) | 20) & 0xFu; }
#define XB_SPIN(cond, bar) do { unsigned _sp = 0; while (cond) { __builtin_amdgcn_s_sleep(1); \
    if ((++_sp & 255u) == 0u) { if (xb_ld(&(bar)[XB_TMO])) break; if (_sp > XB_SPIN_CAP) { atomicAdd(&(bar)[XB_TMO], 1u); break; } } } } while (0)

struct XcdBarrier {
    unsigned* bar; unsigned x;
    volatile LAS unsigned* st;
};

__device__ __forceinline__ XcdBarrier xcd_barrier_post(unsigned* bar, volatile LAS unsigned* st) {
    XcdBarrier b; b.bar = bar; b.x = xb_xcc_id(); b.st = st;
    if (threadIdx.x == 0) (void)xb_add(&bar[XB_XCNT(b.x)], 1u);
    return b;
}
__device__ __forceinline__ void xcd_barrier_complete(unsigned* bar, unsigned x, unsigned& nloc, unsigned& nx) {
    const unsigned G = gridDim.x * gridDim.y * gridDim.z;
    unsigned sum, cnt, mine, sp = 0u;
    for (;;) {
        sum = 0u; cnt = 0u; mine = 0u;
#pragma unroll
        for (unsigned j = 0; j < 16; ++j) { const unsigned c = xb_ld(&bar[XB_XCNT(j)]); sum += c; cnt += (c > 0u) ? 1u : 0u; mine = (j == x) ? c : mine; }
        if (sum == G) break;
        __builtin_amdgcn_s_sleep(1);
        if ((++sp & 255u) == 0u) { if (xb_ld(&bar[XB_TMO])) break; if (sp > XB_SPIN_CAP) { atomicAdd(&bar[XB_TMO], 1u); break; } }
    }
    nloc = mine > 0u ? mine : 1u; nx = cnt > 0u ? cnt : 1u;
}

__device__ __forceinline__ void xcd_barrier(const XcdBarrier& b) {
    asm volatile("s_waitcnt vmcnt(0)" ::: "memory");
    __syncthreads();
    if (threadIdx.x == 0) {
        unsigned* bar = b.bar;
        __builtin_amdgcn_s_waitcnt(0);
        unsigned nloc = b.st[0], nx = b.st[1];
        if (nloc == 0u) { xcd_barrier_complete(bar, b.x, nloc, nx); b.st[0] = nloc; b.st[1] = nx; }
        const unsigned old = xb_add(&bar[XB_XSUB(b.x)], 1u);
        const unsigned gen = old / nloc;
        if (old + 1u == (gen + 1u) * nloc) {
            __builtin_amdgcn_fence(__ATOMIC_RELEASE, "agent");
            asm volatile("s_waitcnt vmcnt(0)" ::: "memory");
            const unsigned og = xb_add(&bar[XB_TOP], 1u);
            const unsigned tg = og / nx;
            if (og + 1u == (tg + 1u) * nx) xb_add(&bar[XB_TOPGEN], 1u);
            else XB_SPIN(xb_ld(&bar[XB_TOPGEN]) == tg, bar);
            __builtin_amdgcn_fence(__ATOMIC_ACQUIRE, "agent");
            xb_add(&bar[XB_XGEN(b.x)], 1u);
            asm volatile("s_waitcnt vmcnt(0)" ::: "memory");
        } else {
            XB_SPIN(xb_ld(&bar[XB_XGEN(b.x)]) == gen, bar);
            __builtin_amdgcn_fence(__ATOMIC_ACQUIRE, "agent");
            asm volatile("s_waitcnt vmcnt(0)" ::: "memory");
        }
    }
    __syncthreads();
}

constexpr int NWAVES = 8;
constexpr int BATCH = 16, SEQ = 2048, D = 1024, T = BATCH * SEQ;
constexpr int NIN = 9224, NPROJ = 9216, NMOD = 6 * D;
constexpr int NE = 32, TOPK = 4;
constexpr int XS_ROWS = T * TOPK + NE * 256;
constexpr float EPS = 1e-6f;
constexpr float QSCALE = 0.125f * 1.4426950408889634f;

constexpr size_t MiB = 1u << 20;
constexpr size_t WS_CTL = 0, CTL_ZERO_BYTES = 1 * MiB;
constexpr size_t WS_MODP = 1 * MiB;
constexpr size_t WS_MOD = 3 * MiB;
constexpr size_t WS_IPRE = 4 * MiB, WS_LF = 4 * MiB + 512 * 1024;
constexpr size_t WS_TOKE = 5 * MiB, WS_TOKP = 5 * MiB + 512 * 1024, WS_TOKW = 6 * MiB, WS_TOKROW = 6 * MiB + 512 * 1024, WS_RSTD = 7 * MiB;
constexpr size_t WS_WIN = 8 * MiB, WS_WA = 26 * MiB, WS_WB = 28 * MiB, WS_WOUT = 30 * MiB, WS_W1 = 32 * MiB, WS_W2 = 160 * MiB;
constexpr size_t WS_H1 = 224 * MiB;
constexpr size_t WS_PROJ = 288 * MiB, SEG = 64 * MiB;
constexpr size_t WS_YB = 864 * MiB;
constexpr size_t WS_XS = 288 * MiB, WS_ACT = 560 * MiB;
constexpr size_t WS_END = 928 * MiB;
static_assert(WS_XS + (size_t)XS_ROWS * 2048 <= WS_ACT && WS_ACT + (size_t)XS_ROWS * 2048 <= WS_YB, "ws map");
constexpr int CW_TMO = 0, CW_BAR = 4096, CW_ECNT = 8192;

constexpr int RING_BYTES = 131072, LDS_BYTES = 147456, LDSCTL_OFF = 146432;
constexpr int LC_BAR = 0, LC_TS = 16, LC_LCNT = 64, LC_GBASE = 96, LC_PS = 128, LC_CNT = 160;

__device__ __forceinline__ unsigned long long karg(int i) { return ((const __attribute__((address_space(4))) unsigned long long*)__builtin_amdgcn_kernarg_segment_ptr())[i]; }
struct Frame {
    LAS unsigned char* lds; volatile LAS unsigned* LC;
    gu32* ctl; unsigned char* ws; int tid, lane, wave, vcu, G;
    __device__ __forceinline__ const float* x() const { return (const float*)karg(0); }
    __device__ __forceinline__ const float* c() const { return (const float*)karg(1); }
    __device__ __forceinline__ const float* ada_w() const { return (const float*)karg(2); }
    __device__ __forceinline__ const float* ada_b() const { return (const float*)karg(3); }
    __device__ __forceinline__ const float* norm1_g() const { return (const float*)karg(4); }
    __device__ __forceinline__ const float* w_in() const { return (const float*)karg(5); }
    __device__ __forceinline__ const float* conv_w() const { return (const float*)karg(6); }
    __device__ __forceinline__ const float* conv_b() const { return (const float*)karg(7); }
    __device__ __forceinline__ const float* b_i() const { return (const float*)karg(8); }
    __device__ __forceinline__ const float* b_f() const { return (const float*)karg(9); }
    __device__ __forceinline__ const float* ml_norm_g() const { return (const float*)karg(10); }
    __device__ __forceinline__ const float* w_a() const { return (const float*)karg(11); }
    __device__ __forceinline__ const float* w_b() const { return (const float*)karg(12); }
    __device__ __forceinline__ const float* w_out() const { return (const float*)karg(13); }
    __device__ __forceinline__ const float* norm2_g() const { return (const float*)karg(14); }
    __device__ __forceinline__ const float* router_w() const { return (const float*)karg(15); }
    __device__ __forceinline__ const float* router_b() const { return (const float*)karg(16); }
    __device__ __forceinline__ const float* w1() const { return (const float*)karg(17); }
    __device__ __forceinline__ const float* b1() const { return (const float*)karg(18); }
    __device__ __forceinline__ const float* w2() const { return (const float*)karg(19); }
    __device__ __forceinline__ const float* b2() const { return (const float*)karg(20); }
    __device__ __forceinline__ const float* final_g() const { return (const float*)karg(21); }
    __device__ __forceinline__ float* out() const { return (float*)karg(22); }
    __device__ __forceinline__ float* modp() const { return (float*)(ws + WS_MODP); }
    __device__ __forceinline__ float* mod() const { return (float*)(ws + WS_MOD); }
    __device__ __forceinline__ float* ipre() const { return (float*)(ws + WS_IPRE); }
    __device__ __forceinline__ float* lf() const { return (float*)(ws + WS_LF); }
    __device__ __forceinline__ float* tokw() const { return (float*)(ws + WS_TOKW); }
    __device__ __forceinline__ float* rstd2() const { return (float*)(ws + WS_RSTD); }
    __device__ __forceinline__ int* toke() const { return (int*)(ws + WS_TOKE); }
    __device__ __forceinline__ int* tokp() const { return (int*)(ws + WS_TOKP); }
    __device__ __forceinline__ int* tokrow() const { return (int*)(ws + WS_TOKROW); }
    __device__ __forceinline__ bf16* WIN_T() const { return (bf16*)(ws + WS_WIN); }
    __device__ __forceinline__ bf16* WA_T() const { return (bf16*)(ws + WS_WA); }
    __device__ __forceinline__ bf16* WB_T() const { return (bf16*)(ws + WS_WB); }
    __device__ __forceinline__ bf16* WOUT_T() const { return (bf16*)(ws + WS_WOUT); }
    __device__ __forceinline__ bf16* W1_T() const { return (bf16*)(ws + WS_W1); }
    __device__ __forceinline__ bf16* W2_T() const { return (bf16*)(ws + WS_W2); }
    __device__ __forceinline__ bf16* H1() const { return (bf16*)(ws + WS_H1); }
    __device__ __forceinline__ bf16* PROJ() const { return (bf16*)(ws + WS_PROJ); }
    __device__ __forceinline__ bf16* YA() const { return (bf16*)(ws + WS_H1); }
    __device__ __forceinline__ bf16* YB() const { return (bf16*)(ws + WS_YB); }
    __device__ __forceinline__ bf16* M1() const { return (bf16*)(ws + WS_PROJ); }
    __device__ __forceinline__ bf16* MERGED() const { return (bf16*)(ws + WS_PROJ + SEG); }
    __device__ __forceinline__ bf16* XS() const { return (bf16*)(ws + WS_XS); }
    __device__ __forceinline__ bf16* ACT() const { return (bf16*)(ws + WS_ACT); }
    __device__ __forceinline__ bf16* OUTR() const { return (bf16*)(ws + WS_XS); }
};

__device__ __forceinline__ float wave_sum(float v) {
#pragma unroll
    for (int o = 1; o < 64; o <<= 1) v += __shfl_xor(v, o);
    return v;
}
__device__ __forceinline__ float bf2f(unsigned short b) { return __builtin_bit_cast(float, (unsigned)b << 16); }
__device__ __forceinline__ float bflo(unsigned w) { return __builtin_bit_cast(float, w << 16); }
__device__ __forceinline__ float bfhi(unsigned w) { return __builtin_bit_cast(float, w & 0xffff0000u); }
__device__ __forceinline__ float log_sigmoid_f(float x) { return fminf(x, 0.f) - log1pf(expf(-fabsf(x))); }

struct MapIn { __device__ __forceinline__ long operator()(int n) const { return n < 7168 ? (long)n : (n < 7176 ? -1L : (n < NIN ? (long)(n - 8) : -1L)); } };
struct MapId { long off; __device__ __forceinline__ long operator()(int n) const { return off + n; } };
struct MapW1 { int e; __device__ __forceinline__ long operator()(int n) const { return (long)e * 2048 + ((n & 1023) >> 7) * 256 + (n >> 10) * 128 + (n & 127); } };

template <class Map> __device__ __forceinline__ void transpose_item(const float* W, int K, int N, bf16* WT, LAS float* scr, int item, int lane, Map map) {
    const int nblk = (N + 31) / 32, kb = item / nblk, nb = item % nblk, k0 = 64 * kb, n0 = 32 * nb;
    const int nn = n0 + (lane & 31);
#pragma unroll 8
    for (int i = 0; i < 32; ++i) { const int kk = 2 * i + (lane >> 5); scr[kk * 33 + (lane & 31)] = (nn < N) ? W[(size_t)(k0 + kk) * N + nn] : 0.f; }
    LDS_WAIT(); asm volatile("" ::: "memory");
    const int c = lane & 7;
#pragma unroll
    for (int j = 0; j < 4; ++j) { const int n = (lane >> 3) + 8 * j; const LAS float* s = scr + (8 * c) * 33 + n;
        v4u o; o.x = pk2(s[0 * 33], s[1 * 33]); o.y = pk2(s[2 * 33], s[3 * 33]); o.z = pk2(s[4 * 33], s[5 * 33]); o.w = pk2(s[6 * 33], s[7 * 33]);
        const long dr = map(n0 + n);
        if (dr >= 0) *(GAS v4u*)(WT + (size_t)dr * K + k0 + 8 * c) = o; }
    LDS_WAIT(); asm volatile("" ::: "memory");
}
__device__ __forceinline__ void mod_item(Frame& F, const LAS float* sil, int it) {
    const int j = it % 96, kq = it / 96, n = 64 * j + F.lane, k0 = 256 * kq;
    float acc[16];
#pragma unroll
    for (int b = 0; b < 16; ++b) acc[b] = 0.f;
    const float* w = F.ada_w() + (size_t)k0 * NMOD + n;
    const LAS f32x4* s = (const LAS f32x4*)sil + k0 * 4;
    for (int kk = 0; kk < 256; kk += 8) {
        float wv[8];
#pragma unroll
        for (int u = 0; u < 8; ++u) wv[u] = w[(size_t)(kk + u) * NMOD];
#pragma unroll
        for (int u = 0; u < 8; ++u) {
#pragma unroll
            for (int q = 0; q < 4; ++q) { const f32x4 sv = s[(kk + u) * 4 + q]; acc[4 * q + 0] += sv.x * wv[u]; acc[4 * q + 1] += sv.y * wv[u]; acc[4 * q + 2] += sv.z * wv[u]; acc[4 * q + 3] += sv.w * wv[u]; }
        }
    }
    float* o = F.modp() + (size_t)kq * 16 * NMOD + n;
#pragma unroll
    for (int b = 0; b < 16; ++b) o[(size_t)b * NMOD] = acc[b];
}
__device__ __forceinline__ void p0_prologue(Frame& F) {
    LAS float* sil = (LAS float*)F.lds;
    for (int idx = F.tid; idx < 16384; idx += 512) { const int b = idx >> 10, k = idx & 1023; const float v = F.c()[idx]; sil[k * 16 + b] = v / (1.0f + __expf(-v)); }
    __syncthreads();
    LAS float* scr = (LAS float*)(F.lds + 65536 + F.wave * 8704);
    const int gw = F.vcu * NWAVES + F.wave, NGW = F.G * NWAVES;
    constexpr int I_MOD = 384, I_IN = 16 * 289, I_SQ = 16 * 32, I_W1 = 32 * 16 * 64, I_W2 = 32 * 16 * 32;
    constexpr int NITEMS = I_MOD + I_IN + 3 * I_SQ + I_W1 + I_W2;
    for (int it = gw; it < NITEMS; it += NGW) {
        int r = it;
        if (r < I_MOD) { mod_item(F, sil, r); continue; } r -= I_MOD;
        if (r < I_IN) { transpose_item(F.w_in(), D, NIN, F.WIN_T(), scr, r, F.lane, MapIn{}); continue; } r -= I_IN;
        if (r < I_SQ) { transpose_item(F.w_a(), D, D, F.WA_T(), scr, r, F.lane, MapId{0}); continue; } r -= I_SQ;
        if (r < I_SQ) { transpose_item(F.w_b(), D, D, F.WB_T(), scr, r, F.lane, MapId{0}); continue; } r -= I_SQ;
        if (r < I_SQ) { transpose_item(F.w_out(), D, D, F.WOUT_T(), scr, r, F.lane, MapId{0}); continue; } r -= I_SQ;
        if (r < I_W1) { const int e = r >> 10; transpose_item(F.w1() + (size_t)e * D * 2048, D, 2048, F.W1_T(), scr, r & 1023, F.lane, MapW1{e}); continue; } r -= I_W1;
        { const int e = r >> 9; transpose_item(F.w2() + (size_t)e * D * D, D, D, F.W2_T(), scr, r & 511, F.lane, MapId{(long)e * 1024}); }
    }
}

__device__ __forceinline__ void p1_rows(Frame& F) {
    const int row0 = F.vcu * 128, b = row0 / SEQ, lane = F.lane;
    LAS float* wif = (LAS float*)F.lds;
    for (int idx = F.tid; idx < 8192; idx += 512) wif[idx] = F.w_in()[(size_t)(idx >> 3) * NIN + 7168 + (idx & 7)];
    for (int idx = F.vcu * 512 + F.tid; idx < 16 * NMOD; idx += F.G * 512) { float s = F.ada_b()[idx % NMOD];
#pragma unroll
        for (int kq = 0; kq < 4; ++kq) s += F.modp()[(size_t)kq * 16 * NMOD + idx];
        F.mod()[idx] = s; }
    f32x4 Av[4], Bv[4];
#pragma unroll
    for (int j = 0; j < 4; ++j) { const int col = 4 * lane + 256 * j;
        f32x4 sh = *(const f32x4*)(F.ada_b() + col), sc = *(const f32x4*)(F.ada_b() + D + col);
#pragma unroll
        for (int kq = 0; kq < 4; ++kq) { sh += *(const f32x4*)(F.modp() + ((size_t)kq * 16 + b) * NMOD + col); sc += *(const f32x4*)(F.modp() + ((size_t)kq * 16 + b) * NMOD + D + col); }
        const f32x4 g = *(const f32x4*)(F.norm1_g() + col); Av[j] = g * (sc + 1.0f); Bv[j] = sh; }
    __syncthreads();
    for (int r = 0; r < 16; ++r) {
        const int row = row0 + 16 * F.wave + r;
        const GAS f32x4* xr = (const GAS f32x4*)(F.x() + (size_t)row * D) + lane;
        f32x4 v[4]; float ss = 0.f;
#pragma unroll
        for (int j = 0; j < 4; ++j) { v[j] = xr[64 * j]; ss += (v[j].x * v[j].x + v[j].y * v[j].y) + (v[j].z * v[j].z + v[j].w * v[j].w); }
        const float rstd = 1.0f / sqrtf(wave_sum(ss) * (1.0f / D) + EPS);
        GAS unsigned long long* o8 = (GAS unsigned long long*)(F.H1() + (size_t)row * D) + lane;
        float p[8];
#pragma unroll
        for (int q = 0; q < 8; ++q) p[q] = 0.f;
#pragma unroll
        for (int j = 0; j < 4; ++j) { v[j] = v[j] * rstd * Av[j] + Bv[j];
            o8[64 * j] = (unsigned long long)pk2(v[j].x, v[j].y) | ((unsigned long long)pk2(v[j].z, v[j].w) << 32);
#pragma unroll
            for (int i = 0; i < 4; ++i) { const LAS f32x4* wp = (const LAS f32x4*)(wif + (4 * lane + 256 * j + i) * 8); const f32x4 w0 = wp[0], w1 = wp[1]; const float hv = v[j][i];
                p[0] += hv * w0.x; p[1] += hv * w0.y; p[2] += hv * w0.z; p[3] += hv * w0.w; p[4] += hv * w1.x; p[5] += hv * w1.y; p[6] += hv * w1.z; p[7] += hv * w1.w; } }
#pragma unroll
        for (int q = 0; q < 8; ++q) p[q] = wave_sum(p[q]);
        if (lane == 0) { const int t = row % SEQ;
#pragma unroll
            for (int hh = 0; hh < 4; ++hh) { F.ipre()[((size_t)b * 4 + hh) * SEQ + t] = p[hh] + F.b_i()[hh]; F.lf()[((size_t)b * 4 + hh) * SEQ + t] = log_sigmoid_f(p[4 + hh] + F.b_f()[hh]); } }
    }
}

__device__ __forceinline__ void attn_naive_item(Frame& F, int bh, int qblk) {
    const int b = bh >> 4, hd = bh & 15, t = qblk * 512 + F.tid;
    const bf16* Q = F.PROJ(); const bf16* K = F.PROJ() + SEG / 2; const bf16* V = F.PROJ() + SEG;
    const size_t rowb = (size_t)b * SEQ;
    float q[64], o[64];
    { const v4u* qp = (const v4u*)(Q + (rowb + t) * D + hd * 64);
#pragma unroll
      for (int i = 0; i < 8; ++i) { const v4u w = qp[i]; q[8 * i + 0] = bflo(w.x); q[8 * i + 1] = bfhi(w.x); q[8 * i + 2] = bflo(w.y); q[8 * i + 3] = bfhi(w.y); q[8 * i + 4] = bflo(w.z); q[8 * i + 5] = bfhi(w.z); q[8 * i + 6] = bflo(w.w); q[8 * i + 7] = bfhi(w.w); } }
#pragma unroll
    for (int i = 0; i < 64; ++i) o[i] = 0.f;
    float R = 0.f;
    LAS v4u* kt = (LAS v4u*)F.lds; LAS v4u* vt = (LAS v4u*)(F.lds + 8192);
    const int tmax_wave = qblk * 512 + F.wave * 64 + 63;
    for (int tile = qblk * 8 + 7; tile >= 0; --tile) {
        __syncthreads();
        { const int kr = F.tid >> 3, ch = F.tid & 7; const size_t g = (rowb + tile * 64 + kr) * D + hd * 64 + ch * 8;
          kt[F.tid] = *(const v4u*)(K + g); vt[F.tid] = *(const v4u*)(V + g); }
        __syncthreads();
        if (tile * 64 >= tmax_wave) continue;
        for (int s = 63; s >= 0; --s) {
            const int key = tile * 64 + s;
            float z = 0.f;
#pragma unroll
            for (int i = 0; i < 8; ++i) { const v4u w = kt[s * 8 + i]; z += q[8 * i + 0] * bflo(w.x) + q[8 * i + 1] * bfhi(w.x) + q[8 * i + 2] * bflo(w.y) + q[8 * i + 3] * bfhi(w.y) + q[8 * i + 4] * bflo(w.z) + q[8 * i + 5] * bfhi(w.z) + q[8 * i + 6] * bflo(w.w) + q[8 * i + 7] * bfhi(w.w); }
            const float lb = fminf(z, 0.f) - __builtin_amdgcn_logf(1.0f + __builtin_amdgcn_exp2f(-fabsf(z)));
            const bool act = key < t;
            const float a = act ? __builtin_amdgcn_exp2f(lb + R) : 0.f;
            R += act ? (lb - z) : 0.f;
#pragma unroll
            for (int i = 0; i < 8; ++i) { const v4u w = vt[s * 8 + i]; o[8 * i + 0] += a * bflo(w.x); o[8 * i + 1] += a * bfhi(w.x); o[8 * i + 2] += a * bflo(w.y); o[8 * i + 3] += a * bfhi(w.y); o[8 * i + 4] += a * bflo(w.z); o[8 * i + 5] += a * bfhi(w.z); o[8 * i + 6] += a * bflo(w.w); o[8 * i + 7] += a * bfhi(w.w); }
        }
    }
    v4u* op = (v4u*)(F.YA() + (rowb + t) * D + hd * 64);
#pragma unroll
    for (int i = 0; i < 8; ++i) { v4u w; w.x = pk2(o[8 * i + 0], o[8 * i + 1]); w.y = pk2(o[8 * i + 2], o[8 * i + 3]); w.z = pk2(o[8 * i + 4], o[8 * i + 5]); w.w = pk2(o[8 * i + 6], o[8 * i + 7]); op[i] = w; }
}

__device__ __forceinline__ void mlstm_naive_item(Frame& F, int bh) {
    const int b = bh >> 2, hh = bh & 3, tid = F.tid, e = tid & 255, half = tid >> 8;
    const bf16* MLQ = F.PROJ() + 3 * (SEG / 2); const bf16* MLK = F.PROJ() + 4 * (SEG / 2); const bf16* MLV = F.PROJ() + 5 * (SEG / 2); const bf16* MLO = F.PROJ() + 6 * (SEG / 2);
    LAS float* ql = (LAS float*)F.lds; LAS float* kl = ql + 8192; LAS float* vl = kl + 8192; LAS float* hl = vl + 8192;
    LAS float* part = hl + 8192;
    LAS float* red = part + 512;
    LAS float* il = red + 8; LAS float* fl = il + 32;
    const size_t rowb = (size_t)b * SEQ;
    float C[128];
#pragma unroll
    for (int i = 0; i < 128; ++i) C[i] = 0.f;
    float nreg = 0.f, m = 0.f;
    float cw[2][4], cb[2];
    { const int c = tid & 255;
#pragma unroll
      for (int z = 0; z < 2; ++z) { const int ch = z * 1024 + hh * 256 + c; cb[z] = F.conv_b()[ch];
#pragma unroll
          for (int tap = 0; tap < 4; ++tap) cw[z][tap] = F.conv_w()[tap * 2048 + ch]; } }
    for (int chunk = 0; chunk < SEQ / 32; ++chunk) {
        const int t0 = chunk * 32;
        __syncthreads();
        { const int c = tid & 255;
          for (int u = 0; u < 16; ++u) { const int tt = (tid >> 8) + 2 * u, t = t0 + tt; float yq = cb[0], yk = cb[1];
#pragma unroll
              for (int tap = 0; tap < 4; ++tap) { const int ts = t - 3 + tap; if (ts >= 0) { const size_t g = (rowb + ts) * D + hh * 256 + c; yq += cw[0][tap] * bf2f(MLQ[g]); yk += cw[1][tap] * bf2f(MLK[g]); } }
              ql[tt * 256 + c] = yq / (1.0f + __expf(-yq)); kl[tt * 256 + c] = (yk / (1.0f + __expf(-yk))) * 0.0625f;
              vl[tt * 256 + c] = bf2f(MLV[(rowb + t) * D + hh * 256 + c]); }
          if (tid < 32) { il[tid] = F.ipre()[((size_t)b * 4 + hh) * SEQ + t0 + tid]; fl[tid] = F.lf()[((size_t)b * 4 + hh) * SEQ + t0 + tid]; } }
        __syncthreads();
        for (int tt = 0; tt < 32; ++tt) {
            const float lfv = fl[tt], iv = il[tt];
            const float mn = fmaxf(lfv + m, iv), fp = __expf(lfv + m - mn), ip = __expf(iv - mn); m = mn;
            const float vv = vl[tt * 256 + e] * ip;
            const LAS f32x4* kq = (const LAS f32x4*)(kl + tt * 256 + 128 * half); const LAS f32x4* qq = (const LAS f32x4*)(ql + tt * 256 + 128 * half);
            float num = 0.f;
#pragma unroll
            for (int i = 0; i < 32; ++i) { const f32x4 kv = kq[i], qv = qq[i];
                C[4 * i + 0] = fp * C[4 * i + 0] + kv.x * vv; C[4 * i + 1] = fp * C[4 * i + 1] + kv.y * vv; C[4 * i + 2] = fp * C[4 * i + 2] + kv.z * vv; C[4 * i + 3] = fp * C[4 * i + 3] + kv.w * vv;
                num += (qv.x * C[4 * i + 0] + qv.y * C[4 * i + 1]) + (qv.z * C[4 * i + 2] + qv.w * C[4 * i + 3]); }
            const int buf = tt & 1;
            if (tid < 256) { nreg = fp * nreg + ip * kl[tt * 256 + tid]; const float pd = wave_sum(ql[tt * 256 + tid] * nreg); if (F.lane == 0) red[buf * 4 + F.wave] = pd; }
            else part[buf * 256 + e] = num;
            __syncthreads();
            if (tid < 256) { num += part[buf * 256 + e]; const float den = (red[buf * 4 + 0] + red[buf * 4 + 1]) + (red[buf * 4 + 2] + red[buf * 4 + 3]);
                hl[tt * 256 + e] = num / fmaxf(fabsf(den), __expf(-m)); }
        }
        __syncthreads();
        for (int r = 0; r < 4; ++r) { const int tt = 4 * F.wave + r; const size_t row = rowb + t0 + tt;
            const f32x4 hv = *(const LAS f32x4*)(hl + tt * 256 + 4 * F.lane);
            const float ss = wave_sum((hv.x * hv.x + hv.y * hv.y) + (hv.z * hv.z + hv.w * hv.w));
            const float rstd = 1.0f / sqrtf(ss * (1.0f / 256.0f) + EPS);
            const int col = hh * 256 + 4 * F.lane; const f32x4 g = *(const f32x4*)(F.ml_norm_g() + col);
            const unsigned long long ow = *(const unsigned long long*)(MLO + row * D + col);
            const float o0 = bflo((unsigned)ow), o1 = bfhi((unsigned)ow), o2 = bflo((unsigned)(ow >> 32)), o3 = bfhi((unsigned)(ow >> 32));
            const float y0 = hv.x * rstd * g.x / (1.0f + __expf(-o0)), y1 = hv.y * rstd * g.y / (1.0f + __expf(-o1)), y2 = hv.z * rstd * g.z / (1.0f + __expf(-o2)), y3 = hv.w * rstd * g.w / (1.0f + __expf(-o3));
            *(unsigned long long*)(F.YB() + row * D + col) = (unsigned long long)pk2(y0, y1) | ((unsigned long long)pk2(y2, y3) << 32); }
    }
}

__device__ __forceinline__ void p5a_route(Frame& F) {
    const int row0 = F.vcu * 128, b = row0 / SEQ, lane = F.lane, tid = F.tid;
    LAS float* wr = (LAS float*)F.lds;
    LAS int* le = (LAS int*)(F.lds + 131584); LAS int* lp = le + 512;
    LAS int* lcnt = (LAS int*)(F.LC + LC_LCNT); LAS int* gbase = (LAS int*)(F.LC + LC_GBASE);
    for (int idx = tid; idx < 32768; idx += 512) wr[(idx & 31) * 1028 + (idx >> 5)] = F.router_w()[idx];
    if (tid < 32) lcnt[tid] = 0;
    f32x4 Av[4], Bv[4];
#pragma unroll
    for (int j = 0; j < 4; ++j) { const int col = 4 * lane + 256 * j; const float* mb = F.mod() + (size_t)b * NMOD;
        const f32x4 g = *(const f32x4*)(F.norm2_g() + col); Av[j] = g * (*(const f32x4*)(mb + 4 * D + col) + 1.0f); Bv[j] = *(const f32x4*)(mb + 3 * D + col); }
    float rb[32];
#pragma unroll
    for (int e = 0; e < 32; ++e) rb[e] = F.router_b()[e];
    __syncthreads();
    for (int r = 0; r < 16; ++r) {
        const int rl = 16 * F.wave + r, row = row0 + rl;
        const GAS f32x4* xr = (const GAS f32x4*)(F.out() + (size_t)row * D) + lane;
        f32x4 v[4]; float ss = 0.f;
#pragma unroll
        for (int j = 0; j < 4; ++j) { v[j] = xr[64 * j]; ss += (v[j].x * v[j].x + v[j].y * v[j].y) + (v[j].z * v[j].z + v[j].w * v[j].w); }
        const float rstd = 1.0f / sqrtf(wave_sum(ss) * (1.0f / D) + EPS);
#pragma unroll
        for (int j = 0; j < 4; ++j) v[j] = v[j] * rstd * Av[j] + Bv[j];
        float p[32];
#pragma unroll
        for (int e = 0; e < 32; ++e) { float s = 0.f;
#pragma unroll
            for (int j = 0; j < 4; ++j) { const f32x4 w = *(const LAS f32x4*)(wr + e * 1028 + 4 * lane + 256 * j); s += (v[j].x * w.x + v[j].y * w.y) + (v[j].z * w.z + v[j].w * w.w); }
            p[e] = s; }
#pragma unroll
        for (int e = 0; e < 32; ++e) p[e] = wave_sum(p[e]) + rb[e];
        int sel[4]; float sv[4]; unsigned used = 0u;
#pragma unroll
        for (int k = 0; k < 4; ++k) { float best = -3.0e38f; int bi = 0;
#pragma unroll
            for (int e = 0; e < 32; ++e) { const bool cnd = (((used >> e) & 1u) == 0u) && (p[e] > best); best = cnd ? p[e] : best; bi = cnd ? e : bi; }
            sel[k] = bi; sv[k] = best; used |= 1u << bi; }
        const float e1 = __expf(sv[1] - sv[0]), e2 = __expf(sv[2] - sv[0]), e3 = __expf(sv[3] - sv[0]), inv = 1.0f / (1.0f + e1 + e2 + e3);
        if (lane < 4) { const int ek = lane == 0 ? sel[0] : lane == 1 ? sel[1] : lane == 2 ? sel[2] : sel[3];
            const float wk = (lane == 0 ? 1.0f : lane == 1 ? e1 : lane == 2 ? e2 : e3) * inv;
            const int pos = __hip_atomic_fetch_add(lcnt + ek, 1, __ATOMIC_RELAXED, __HIP_MEMORY_SCOPE_WORKGROUP);
            le[rl * 4 + lane] = ek; lp[rl * 4 + lane] = pos; F.tokw()[(size_t)row * 4 + lane] = wk; }
        if (lane == 0) F.rstd2()[row] = rstd;
    }
    __syncthreads();
    if (tid < 32) gbase[tid] = (int)__hip_atomic_fetch_add(F.ctl + CW_ECNT + 64 * tid, (unsigned)lcnt[tid], __ATOMIC_RELAXED, __HIP_MEMORY_SCOPE_AGENT);
    __syncthreads();
    { const int ek = le[tid]; F.toke()[(size_t)row0 * 4 + tid] = ek; F.tokp()[(size_t)row0 * 4 + tid] = lp[tid] + gbase[ek]; }
}

__device__ __forceinline__ void p5b_scatter(Frame& F) {
    const int row0 = F.vcu * 128, b = row0 / SEQ, lane = F.lane, tid = F.tid;
    LAS int* ts = (LAS int*)(F.LC + LC_TS); LAS int* ps = (LAS int*)(F.LC + LC_PS); LAS int* cn = (LAS int*)(F.LC + LC_CNT);
    if (tid < 32) cn[tid] = (int)__hip_atomic_load(F.ctl + CW_ECNT + 64 * tid, RLX_AGENT);
    __syncthreads();
    if (tid == 0) { int run = 0, trun = 0; for (int e = 0; e < 32; ++e) { ps[e] = run; ts[e] = trun; const int nt = (cn[e] + 255) >> 8; run += nt * 256; trun += nt; } ts[32] = trun; }
    f32x4 Av[4], Bv[4];
#pragma unroll
    for (int j = 0; j < 4; ++j) { const int col = 4 * lane + 256 * j; const float* mb = F.mod() + (size_t)b * NMOD;
        const f32x4 g = *(const f32x4*)(F.norm2_g() + col); Av[j] = g * (*(const f32x4*)(mb + 4 * D + col) + 1.0f); Bv[j] = *(const f32x4*)(mb + 3 * D + col); }
    __syncthreads();
    for (int r = 0; r < 16; ++r) {
        const int row = row0 + 16 * F.wave + r;
        const GAS f32x4* xr = (const GAS f32x4*)(F.out() + (size_t)row * D) + lane;
        const float rstd = F.rstd2()[row];
        unsigned long long w[4];
#pragma unroll
        for (int j = 0; j < 4; ++j) { const f32x4 v = xr[64 * j] * rstd * Av[j] + Bv[j]; w[j] = (unsigned long long)pk2(v.x, v.y) | ((unsigned long long)pk2(v.z, v.w) << 32); }
#pragma unroll
        for (int k = 0; k < 4; ++k) { const int ek = F.toke()[(size_t)row * 4 + k], dst = ps[ek] + F.tokp()[(size_t)row * 4 + k];
            GAS unsigned long long* o8 = (GAS unsigned long long*)(F.XS() + (size_t)dst * D) + lane;
#pragma unroll
            for (int j = 0; j < 4; ++j) o8[64 * j] = w[j];
            if (lane == 0) F.tokrow()[(size_t)row * 4 + k] = dst; }
    }
}

__device__ __forceinline__ void p8_combine(Frame& F, bool poison) {
    const int row0 = F.vcu * 128, b = row0 / SEQ, lane = F.lane;
    f32x4 G2[4], FG[4];
#pragma unroll
    for (int j = 0; j < 4; ++j) { const int col = 4 * lane + 256 * j; G2[j] = *(const f32x4*)(F.mod() + (size_t)b * NMOD + 5 * D + col); FG[j] = *(const f32x4*)(F.final_g() + col); }
    for (int r = 0; r < 16; ++r) {
        const int row = row0 + 16 * F.wave + r;
        GAS f32x4* xr = (GAS f32x4*)(F.out() + (size_t)row * D) + lane;
        f32x4 y[4];
#pragma unroll
        for (int j = 0; j < 4; ++j) y[j] = (f32x4){0.f, 0.f, 0.f, 0.f};
#pragma unroll
        for (int k = 0; k < 4; ++k) { const int src = F.tokrow()[(size_t)row * 4 + k]; const float wk = F.tokw()[(size_t)row * 4 + k];
            const GAS unsigned long long* s8 = (const GAS unsigned long long*)(F.OUTR() + (size_t)src * D) + lane;
#pragma unroll
            for (int j = 0; j < 4; ++j) { const unsigned long long w = s8[64 * j]; y[j].x += wk * bflo((unsigned)w); y[j].y += wk * bfhi((unsigned)w); y[j].z += wk * bflo((unsigned)(w >> 32)); y[j].w += wk * bfhi((unsigned)(w >> 32)); } }
        f32x4 v[4]; float ss = 0.f;
#pragma unroll
        for (int j = 0; j < 4; ++j) { v[j] = xr[64 * j] + G2[j] * y[j]; ss += (v[j].x * v[j].x + v[j].y * v[j].y) + (v[j].z * v[j].z + v[j].w * v[j].w); }
        const float rstd = 1.0f / sqrtf(wave_sum(ss) * (1.0f / D) + EPS);
        const float qn = __builtin_nanf("");
#pragma unroll
        for (int j = 0; j < 4; ++j) { f32x4 o = v[j] * rstd * FG[j]; if (poison) o = (f32x4){qn, qn, qn, qn}; xr[64 * j] = o; }
    }
}

struct Args { const float* in[22]; float* out; unsigned char* ws; };
__global__ void __launch_bounds__(NWAVES * 64, 2) mk_fwd(Args args) {
    extern __shared__ __attribute__((aligned(16))) unsigned char lds[];
    Frame F;
    F.lds = (LAS unsigned char*)lds; F.LC = (volatile LAS unsigned*)(F.lds + LDSCTL_OFF);
    F.tid = threadIdx.x; F.lane = F.tid & 63; F.wave = __builtin_amdgcn_readfirstlane(F.tid >> 6);
    F.G = gridDim.x; { const int bx = blockIdx.x; F.vcu = (F.G % 8 == 0) ? (bx % 8) * (F.G / 8) + bx / 8 : bx; }
    F.ws = (unsigned char*)karg(23);
    F.ctl = (gu32*)(F.ws + WS_CTL);
    for (int u = F.tid; u < (LDS_BYTES - LDSCTL_OFF) / 4; u += NWAVES * 64) ((LAS unsigned*)(F.lds + LDSCTL_OFF))[u] = 0u;
    __syncthreads();
    XcdBarrier bar = xcd_barrier_post((unsigned*)(F.ctl + CW_BAR), F.LC + LC_BAR);
#define GRID_BAR() xcd_barrier(bar)
    const int G = F.G, cid = (int)blockIdx.x;

    p0_prologue(F);
    GRID_BAR();
    p1_rows(F);
    GRID_BAR();
    { pg8::Gemm g{F.H1(), F.WIN_T(), T, NPROJ, D}; pg8::StaticOrder S; S.init(T, NPROJ, G, cid);
      pg8::EpiBf16<0> E{F.PROJ(), D, nullptr, D, SEG / 2, QSCALE};
      pg8::gemm_phase<pg8::EpiBf16<0>, pg8::StaticOrder, true, true>(F.lds, g, S, E); }
    GRID_BAR();
#if !defined(MK_SKIP_MIX)
    for (int it = F.vcu; it < 1024; it += G) attn_naive_item(F, it & 255, it >> 8);
    __syncthreads();
    for (int it = F.vcu; it < 64; it += G) mlstm_naive_item(F, it);
#endif
    GRID_BAR();
    { pg8::Gemm g{F.YA(), F.WA_T(), T, D, D}; pg8::StaticOrder S; S.init(T, D, G, cid);
      pg8::EpiGate<false> E{F.PROJ() + 7 * (SEG / 2), nullptr, F.M1()};
      pg8::gemm_phase<pg8::EpiGate<false>, pg8::StaticOrder, true, true>(F.lds, g, S, E); }
    VM_WAIT(); __syncthreads();
    { pg8::Gemm g{F.YB(), F.WB_T(), T, D, D}; pg8::StaticOrder S; S.init(T, D, G, cid);
      pg8::EpiGate<true> E{F.PROJ() + 8 * (SEG / 2), F.M1(), F.MERGED()};
      pg8::gemm_phase<pg8::EpiGate<true>, pg8::StaticOrder, true, true>(F.lds, g, S, E); }
    GRID_BAR();
    { pg8::Gemm g{F.MERGED(), F.WOUT_T(), T, D, D}; pg8::StaticOrder S; S.init(T, D, G, cid);
      pg8::EpiResid E{F.x(), F.mod() + 2 * D, F.out(), SEQ, NMOD};
      pg8::gemm_phase<pg8::EpiResid, pg8::StaticOrder, true, true>(F.lds, g, S, E); }
    GRID_BAR();
    p5a_route(F);
    GRID_BAR();
    p5b_scatter(F);
    GRID_BAR();
    { pg8::Gemm g{F.XS(), F.W1_T(), XS_ROWS, NE * 2048, D}; pg8::GroupedOrder S{(const LAS int*)(F.LC + LC_TS), 8, G, cid};
      pg8::EpiSwiglu E{F.b1(), F.ACT()};
      pg8::gemm_phase<pg8::EpiSwiglu, pg8::GroupedOrder, true, true>(F.lds, g, S, E); }
    GRID_BAR();
    { pg8::Gemm g{F.ACT(), F.W2_T(), XS_ROWS, NE * 1024, D}; pg8::GroupedOrder S{(const LAS int*)(F.LC + LC_TS), 4, G, cid};
      pg8::EpiBf16<0> E{F.OUTR(), D, F.b2(), D, 0, 1.0f};
      pg8::gemm_phase<pg8::EpiBf16<0>, pg8::GroupedOrder, true, true>(F.lds, g, S, E); }
    GRID_BAR();
    { const bool poison = __hip_atomic_load(F.ctl + CW_BAR + XB_TMO, RLX_AGENT) != 0u;
      p8_combine(F, poison); }
}

extern "C" void kernel_launch(void* const* d_in, const int* in_sizes, int n_in, void* d_out, int out_size, void* d_ws, size_t ws_size, hipStream_t stream) {
    static int grid = 0;
    if (grid == 0) {
        if (n_in != 22 || in_sizes[0] != T * D || out_size != T * D || ws_size < WS_END) { fprintf(stderr, "kernel_launch: unexpected shapes (n_in %d, in0 %d, out %d, ws %zu)\n", n_in, n_in > 0 ? in_sizes[0] : -1, out_size, ws_size); grid = -1; return; }
        int dev = 0, cus = 0, per_cu = 0;
        if (hipGetDevice(&dev) != hipSuccess || hipDeviceGetAttribute(&cus, hipDeviceAttributeMultiprocessorCount, dev) != hipSuccess) { grid = -1; return; }
        if (hipFuncSetAttribute((const void*)mk_fwd, hipFuncAttributeMaxDynamicSharedMemorySize, LDS_BYTES) != hipSuccess) { fprintf(stderr, "kernel_launch: hipFuncSetAttribute failed\n"); grid = -1; return; }
        if (hipOccupancyMaxActiveBlocksPerMultiprocessor(&per_cu, (const void*)mk_fwd, NWAVES * 64, LDS_BYTES) != hipSuccess || per_cu < 1) { fprintf(stderr, "kernel_launch: occupancy query says %d blocks per CU\n", per_cu); }
        (void)hipGetLastError();
        if (cus < 256) { fprintf(stderr, "kernel_launch: built for a 256-CU device, found %d CUs\n", cus); grid = -1; return; }
        grid = 256;
    }
    if (grid < 0) return;
    if (hipMemsetAsync((char*)d_ws + WS_CTL, 0, CTL_ZERO_BYTES, stream) != hipSuccess) return;
    Args a{};
    for (int i = 0; i < 22; ++i) a.in[i] = (const float*)d_in[i];
    a.out = (float*)d_out; a.ws = (unsigned char*)d_ws;
    hipLaunchKernelGGL(mk_fwd, dim3(grid), dim3(NWAVES * 64), LDS_BYTES, stream, a);
}
```

```cpp
#include <hip/hip_runtime.h>
#include <cstdio>
#include <cstdint>
namespace pg8 {
#define PG8_LAS __attribute__((address_space(3)))
typedef unsigned short bf16_t;
typedef short bf16x8 __attribute__((ext_vector_type(8)));
typedef float f32x4 __attribute__((ext_vector_type(4)));
typedef unsigned u32x4 __attribute__((ext_vector_type(4)));
constexpr int BM = 256, BK = 64, HALF = 128, HTB = HALF * BK * 2  , STAGE_BYTES = 8 * HTB, NXCD = 8, WGM = 8;

__host__ __device__ __forceinline__ int lds_byte(int r, int c) { const int st = (r >> 4) * 2 + (c >> 5), rr = r & 15, cc = c & 31, ob = rr * 64 + cc * 2; return st * 1024 + (ob ^ (((ob >> 9) & 1) << 5)); }
__host__ __device__ __forceinline__ void stage_rc(int b, int& R, int& C) { const int st = b / 1024, sb = b % 1024, swz = sb ^ (((sb >> 9) & 1) << 5); R = (st >> 1) * 16 + swz / 64; C = (st & 1) * 32 + (swz % 64) / 2; }
__host__ __device__ __forceinline__ int perm32(int rho) { const int n = rho >> 4, i = rho & 15; return 8 * (i >> 2) + 4 * n + (i & 3); }

struct Unit { int pm, pn; };
struct Gemm { const bf16_t* A; const bf16_t* Bt; int M, N, K; };

struct StaticOrder {
    int nM, nN, nwg, G, c;
    __host__ __device__ void init(int M, int N, int G_, int c_) { nM = M / BM; nN = N / BM; nwg = nM * nN; G = G_; c = c_; }
    __host__ __device__ bool next(int i, Unit& u) const {
        const long L = (long)i * G + c; if (L >= nwg) return false;
        int wgid = (int)L; { const int q = nwg / NXCD, r = nwg % NXCD, xcd = wgid % NXCD, off = wgid / NXCD; wgid = (xcd < r ? xcd * (q + 1) : r * (q + 1) + (xcd - r) * q) + off; }
        const int nig = WGM * nN, gid = wgid / nig, fm = gid * WGM, gsz = (nM - fm) < WGM ? (nM - fm) : WGM;
        u.pm = fm + ((wgid % nig) % gsz); u.pn = (wgid % nig) / gsz; return true;
    }
    __device__ __forceinline__ void a_ready(const Unit&) const {}
    __device__ __forceinline__ void done(const Unit&) const {}
};

__device__ __forceinline__ unsigned cvt_pk_bf16(float lo, float hi) { unsigned r; asm volatile("v_cvt_pk_bf16_f32 %0, %1, %2" : "=v"(r) : "v"(lo), "v"(hi)); return r; }
typedef float f32x2 __attribute__((ext_vector_type(2)));
__device__ __forceinline__ f32x2 gelu_pk(f32x2 v) {
    const f32x2 av = __builtin_elementwise_abs(v), d = av * 0.2316418882f + 1.0f;
    f32x2 t; t.x = __builtin_amdgcn_rcpf(d.x); t.y = __builtin_amdgcn_rcpf(d.y);
    f32x2 q = t * 0.5307027145f + (-0.7265760135f); q = q * t + 0.7107068705f; q = q * t + (-0.142248368f); q = q * t + 0.127414796f; q = q * t;
    const f32x2 s = (v * v) * (-0.72134752044f);
    f32x2 e; e.x = __builtin_amdgcn_exp2f(s.x); e.y = __builtin_amdgcn_exp2f(s.y);
    const f32x2 m = v * (q * e), r = v - m;
    f32x2 o; o.x = v.x < 0.f ? m.x : r.x; o.y = v.y < 0.f ? m.y : r.y; return o;
}

template <int ACT  > struct EpiBf16 {
    static constexpr bool PERM = true, AFTER_DRAIN = false; static_assert(ACT == 0 || ACT == 1, "EpiBf16: ACT is 0 (none) or 1 (gelu_pk)");
    bf16_t* O; int ldc; const float* bias; int split_cols; size_t split_stride; float scale0;
    __device__ __forceinline__ void operator()(const f32x4 (&acc)[2][2][4][2], const Unit& u, int wr, int wc, int fr, int fq) const {
        const int row0 = u.pm * BM + wr * 64 + fr; int colt = u.pn * BM; bf16_t* base = O;
        float sc = 1.f; if (split_cols) { const int t = colt / split_cols; base += (size_t)t * split_stride; colt -= t * split_cols; if (t == 0) sc = scale0; }
        const int col0 = colt + wc * 32 + 8 * fq, bcol0 = u.pn * BM + wc * 32 + 8 * fq;
        f32x4 bv[2][2];
#pragma unroll
        for (int bj = 0; bj < 2; ++bj)
#pragma unroll
            for (int n = 0; n < 2; ++n) bv[bj][n] = bias ? *(const f32x4*)(bias + bcol0 + bj * HALF + 4 * n) : (f32x4){0.f, 0.f, 0.f, 0.f};
#pragma unroll
        for (int ai = 0; ai < 2; ++ai)
#pragma unroll
            for (int m = 0; m < 4; ++m) { bf16_t* rowp = base + (size_t)(row0 + ai * HALF + m * 16) * ldc + col0;
#pragma unroll
                for (int bj = 0; bj < 2; ++bj) { f32x4 v0 = acc[ai][bj][m][0] + bv[bj][0], v1 = acc[ai][bj][m][1] + bv[bj][1];
                    if (ACT == 1) { f32x2 a = gelu_pk((f32x2){v0[0], v0[1]}), b = gelu_pk((f32x2){v0[2], v0[3]}), c = gelu_pk((f32x2){v1[0], v1[1]}), d = gelu_pk((f32x2){v1[2], v1[3]});
                        v0 = (f32x4){a.x, a.y, b.x, b.y}; v1 = (f32x4){c.x, c.y, d.x, d.y}; }
                    v0 = v0 * sc; v1 = v1 * sc; u32x4 w; w.x = cvt_pk_bf16(v0[0], v0[1]); w.y = cvt_pk_bf16(v0[2], v0[3]); w.z = cvt_pk_bf16(v1[0], v1[1]); w.w = cvt_pk_bf16(v1[2], v1[3]);
                    *(u32x4*)(rowp + bj * HALF) = w; } }
    }
};
template <class Epi, class Sched, bool ALIGN_EPI = false, bool SP2 = false, bool GATHER = false, bool MIDK = false>
__device__ __forceinline__ void gemm_phase(PG8_LAS unsigned char* lds, const Gemm g, const Sched& S, const Epi& E) {
    int tid_ = threadIdx.x; asm volatile("" : "+v"(tid_));
    const int tid = tid_, wid = __builtin_amdgcn_readfirstlane(tid >> 6), lane = tid & 63, wr = wid >> 2, wc = wid & 3, fr = lane & 15, fq = lane >> 4;
    const int K = g.K, nt = K / BK;
    unsigned voffA[2], voffB[2], vA0[2], vA1[2], vN0[2], vN1[2]; int Rr_[2], Cc_[2];
#pragma unroll
    for (int i = 0; i < 2; ++i) { int R, C; stage_rc(tid * 16 + i * 8192, R, C); const int Rb = Epi::PERM ? ((R & ~31) + perm32(R & 31)) : R;
        voffA[i] = (unsigned)(R * K + C) * 2u; voffB[i] = (unsigned)(Rb * K + C) * 2u; Rr_[i] = R; Cc_[i] = C; }
    const size_t kstep = (size_t)(BK * 2);
    const size_t hstep = (size_t)HALF * K * 2;
    const size_t tstep = 2 * hstep;
#pragma unroll
    for (int i = 0; i < 2; ++i) { vA0[i] = voffA[i]; vA1[i] = voffA[i] + (unsigned)hstep; vN0[i] = vA0[i]; vN1[i] = vA1[i]; }
#define PG8_GLOAD(u, v0, v1) do { _Pragma("unroll") for (int _i = 0; _i < 2; ++_i) { const int _t0 = S.rowtok[(u).pm * BM + Rr_[_i]], _t1 = S.rowtok[(u).pm * BM + HALF + Rr_[_i]]; \
        (v0)[_i] = (unsigned)_t0 * (unsigned)(K * 2) + (unsigned)(Cc_[_i] * 2); (v1)[_i] = (unsigned)_t1 * (unsigned)(K * 2) + (unsigned)(Cc_[_i] * 2); } } while (0)
    const unsigned ldsw = (unsigned)wid * 1024u;
    const int aoff = lds_byte(wr * 64 + fr, fq * 8), boff = lds_byte(wc * 32 + fr, fq * 8);
#define PG8_SA(b, h) (((b) * 2 + (h)) * HTB)
#define PG8_SB(b, h) ((4 + (b) * 2 + (h)) * HTB)
#define PG8_STAGE(bufoff, gbase, voff) do { _Pragma("unroll") for (int _i = 0; _i < 2; ++_i) \
        __builtin_amdgcn_global_load_lds((const unsigned*)((const char*)(gbase) + (voff)[_i]), (PG8_LAS unsigned*)(lds + (bufoff) + ldsw + _i * 8192), 16, 0, 0); } while (0)
#define PG8_LDA(dst, b, h) do { _Pragma("unroll") for (int m = 0; m < 4; ++m) _Pragma("unroll") for (int k = 0; k < 2; ++k) dst[m][k] = *(const PG8_LAS bf16x8*)(lds + PG8_SA(b, h) + aoff + m * 2048 + k * 1024); } while (0)
#define PG8_LDB(dst, b, h) do { _Pragma("unroll") for (int n = 0; n < 2; ++n) _Pragma("unroll") for (int k = 0; k < 2; ++k) dst[n][k] = *(const PG8_LAS bf16x8*)(lds + PG8_SB(b, h) + boff + n * 2048 + k * 1024); } while (0)
#define PG8_MMA(ai, bj, At, Bt) do { __builtin_amdgcn_s_setprio(1); _Pragma("unroll") for (int m = 0; m < 4; ++m) _Pragma("unroll") for (int n = 0; n < 2; ++n) _Pragma("unroll") for (int k = 0; k < 2; ++k) \
        acc[ai][bj][m][n] = __builtin_amdgcn_mfma_f32_16x16x32_bf16(Bt[n][k], At[m][k], acc[ai][bj][m][n], 0, 0, 0); __builtin_amdgcn_s_setprio(0); } while (0)
#define PG8_WAIT_V(n) asm volatile("s_waitcnt vmcnt(" #n ")" ::: "memory")
#define PG8_WAIT_L(n) asm volatile("s_waitcnt lgkmcnt(" #n ")" ::: "memory")
#define PG8_BAR __builtin_amdgcn_s_barrier()
#define PG8_SCHED __builtin_amdgcn_sched_barrier(0)
    Unit cur, nxt; int ui = 0;
    if (!S.next(0, cur)) return;
    f32x4 acc[2][2][4][2];
#pragma unroll
    for (int a = 0; a < 2; ++a)
#pragma unroll
        for (int b = 0; b < 2; ++b)
#pragma unroll
            for (int m = 0; m < 4; ++m)
#pragma unroll
                for (int n = 0; n < 2; ++n) acc[a][b][m][n] = (f32x4){0.f, 0.f, 0.f, 0.f};
    bf16x8 At[4][2], B0[2][2], B1[2][2];
    if constexpr (GATHER) PG8_GLOAD(cur, vA0, vA1);
    const char* cA = GATHER ? (const char*)g.A : (const char*)g.A + (size_t)cur.pm * tstep; const char* cB = (const char*)g.Bt + (size_t)cur.pn * tstep;
    S.a_ready(cur);
    if constexpr (SP2) {
        PG8_STAGE(PG8_SB(0, 0), cB, voffB); PG8_STAGE(PG8_SB(0, 1), cB + hstep, voffB); PG8_STAGE(PG8_SA(0, 0), cA, vA0); PG8_STAGE(PG8_SA(0, 1), cA, vA1);
        if (wr == 1) PG8_BAR;
        PG8_WAIT_V(2); PG8_BAR;
        PG8_STAGE(PG8_SB(1, 0), cB + kstep, voffB); PG8_STAGE(PG8_SA(1, 0), cA + kstep, vA0); PG8_STAGE(PG8_SB(1, 1), cB + hstep + kstep, voffB);
        PG8_WAIT_V(6); PG8_BAR;
    } else {
        PG8_STAGE(PG8_SB(0, 0), cB, voffB); PG8_STAGE(PG8_SA(0, 0), cA, vA0); PG8_STAGE(PG8_SB(0, 1), cB + hstep, voffB); PG8_STAGE(PG8_SA(0, 1), cA, vA1);
        if (wr == 1) PG8_BAR;
        PG8_WAIT_V(4); PG8_BAR;
        PG8_STAGE(PG8_SB(1, 0), cB + kstep, voffB); PG8_STAGE(PG8_SA(1, 0), cA + kstep, vA0); PG8_STAGE(PG8_SB(1, 1), cB + hstep + kstep, voffB);
        PG8_WAIT_V(6); PG8_BAR;
    }
    for (;;) {
        const bool has_next = S.next(ui + 1, nxt);
        if constexpr (GATHER) { if (has_next) PG8_GLOAD(nxt, vN0, vN1); else { _Pragma("unroll") for (int i = 0; i < 2; ++i) { vN0[i] = vA0[i]; vN1[i] = vA1[i]; } } }
        const char* nA = GATHER ? (const char*)g.A : (has_next ? (const char*)g.A + (size_t)nxt.pm * tstep : cA); const char* nB = has_next ? (const char*)g.Bt + (size_t)nxt.pn * tstep : cB;
        for (int t = 0; t < nt; t += 2) {
            const bool last = (t == nt - 2);
            if constexpr (MIDK) { if (t == nt / 2) E.mid(acc, cur, wr, wc, fr, fq); }
            const char* a1 = cA + (size_t)(t + 1) * kstep;
            const char* a2 = last ? nA : cA + (size_t)(t + 2) * kstep; const char* b2 = last ? nB : cB + (size_t)(t + 2) * kstep;
            const char* a3 = a2 + kstep; const char* b3 = b2 + kstep;
            unsigned vX0[2], vX1[2];
#pragma unroll
            for (int i = 0; i < 2; ++i) { vX0[i] = (GATHER && last) ? vN0[i] : vA0[i]; vX1[i] = (GATHER && last) ? vN1[i] : vA1[i]; }
            if (last && has_next) S.a_ready(nxt);
            if constexpr (SP2) {
            PG8_LDB(B0, 0, 0); PG8_LDB(B1, 0, 1); PG8_SCHED; PG8_LDA(At, 0, 0); PG8_STAGE(PG8_SA(1, 1), a1, vA1);
            PG8_WAIT_V(8); PG8_WAIT_L(0); PG8_BAR; PG8_MMA(0, 0, At, B0); PG8_MMA(0, 1, At, B1); PG8_BAR; PG8_SCHED;
            PG8_LDA(At, 0, 1); PG8_STAGE(PG8_SB(0, 0), b2, voffB); PG8_STAGE(PG8_SB(0, 1), b2 + hstep, voffB); PG8_STAGE(PG8_SA(0, 0), a2, vX0);
            PG8_WAIT_V(8); PG8_WAIT_L(0); PG8_BAR; PG8_MMA(1, 0, At, B0); PG8_MMA(1, 1, At, B1); PG8_BAR; PG8_SCHED;
            PG8_LDB(B0, 1, 0); PG8_LDB(B1, 1, 1); PG8_SCHED; PG8_LDA(At, 1, 0); PG8_STAGE(PG8_SA(0, 1), a2, vX1);
            PG8_WAIT_V(8); PG8_WAIT_L(0); PG8_BAR; PG8_MMA(0, 0, At, B0); PG8_MMA(0, 1, At, B1); PG8_BAR; PG8_SCHED;
            PG8_LDA(At, 1, 1); PG8_STAGE(PG8_SB(1, 0), b3, voffB); PG8_STAGE(PG8_SB(1, 1), b3 + hstep, voffB); PG8_STAGE(PG8_SA(1, 0), a3, vX0);
            PG8_WAIT_V(8); PG8_WAIT_L(0); PG8_BAR; PG8_MMA(1, 0, At, B0); PG8_MMA(1, 1, At, B1); PG8_BAR; PG8_SCHED;
            } else {
            PG8_LDB(B0, 0, 0); PG8_SCHED; PG8_LDA(At, 0, 0); PG8_STAGE(PG8_SA(1, 1), a1, vA1);
            PG8_WAIT_L(8); PG8_BAR; PG8_WAIT_L(0); PG8_MMA(0, 0, At, B0); PG8_BAR; PG8_SCHED;
            PG8_LDB(B1, 0, 1); PG8_STAGE(PG8_SB(0, 0), b2, voffB);
            PG8_BAR; PG8_WAIT_L(0); PG8_MMA(0, 1, At, B1); PG8_BAR;
            PG8_LDA(At, 0, 1); PG8_STAGE(PG8_SA(0, 0), a2, vX0);
            PG8_BAR; PG8_WAIT_L(0); PG8_MMA(1, 0, At, B0); PG8_BAR; PG8_SCHED;
            PG8_STAGE(PG8_SB(0, 1), b2 + hstep, voffB);
            PG8_WAIT_V(6); PG8_BAR; PG8_MMA(1, 1, At, B1); PG8_BAR;
            PG8_LDB(B0, 1, 0); PG8_SCHED; PG8_LDA(At, 1, 0); PG8_STAGE(PG8_SA(0, 1), a2, vX1);
            PG8_WAIT_L(8); PG8_BAR; PG8_WAIT_L(0); PG8_MMA(0, 0, At, B0); PG8_BAR; PG8_SCHED;
            PG8_LDB(B1, 1, 1); PG8_STAGE(PG8_SB(1, 0), b3, voffB);
            PG8_BAR; PG8_WAIT_L(0); PG8_MMA(0, 1, At, B1); PG8_BAR;
            PG8_LDA(At, 1, 1); PG8_STAGE(PG8_SA(1, 0), a3, vX0);
            PG8_BAR; PG8_WAIT_L(0); PG8_MMA(1, 0, At, B0); PG8_BAR; PG8_SCHED;
            PG8_STAGE(PG8_SB(1, 1), b3 + hstep, voffB);
            PG8_WAIT_V(6); PG8_BAR; PG8_MMA(1, 1, At, B1); PG8_BAR;
            }
        }
        if constexpr (ALIGN_EPI) { if (wr == 0) PG8_BAR; }
        if constexpr (!Epi::AFTER_DRAIN) { E(acc, cur, wr, wc, fr, fq); S.done(cur); }
        if (!has_next) break;
#pragma unroll
        for (int a = 0; a < 2; ++a)
#pragma unroll
            for (int b = 0; b < 2; ++b)
#pragma unroll
                for (int m = 0; m < 4; ++m)
#pragma unroll
                    for (int n = 0; n < 2; ++n) acc[a][b][m][n] = (f32x4){0.f, 0.f, 0.f, 0.f};
        cur = nxt; cA = nA; cB = nB; ++ui;
        if constexpr (GATHER) { _Pragma("unroll") for (int i = 0; i < 2; ++i) { vA0[i] = vN0[i]; vA1[i] = vN1[i]; } }
        if constexpr (ALIGN_EPI) { if (wr == 1) PG8_BAR; }
    }
    PG8_WAIT_V(0);
    if constexpr (!ALIGN_EPI) { if (wr == 0) PG8_BAR; }
    PG8_BAR;
    if constexpr (Epi::AFTER_DRAIN) { E.fused(acc, cur, wr, wc, fr, fq, lds, wid, lane); S.done(cur); }
#undef PG8_SA
#undef PG8_SB
#undef PG8_STAGE
#undef PG8_GLOAD
#undef PG8_LDA
#undef PG8_LDB
#undef PG8_MMA
#undef PG8_WAIT_V
#undef PG8_WAIT_L
#undef PG8_BAR
#undef PG8_SCHED
}
}
namespace pg8 {
__device__ __forceinline__ float bf_lo(unsigned w) { return __builtin_bit_cast(float, w << 16); }
__device__ __forceinline__ float bf_hi(unsigned w) { return __builtin_bit_cast(float, w & 0xffff0000u); }
__device__ __forceinline__ float sigmoid_f(float x) { return __builtin_amdgcn_rcpf(1.0f + __expf(-x)); }

struct EpiMerge {
    static constexpr bool PERM = true, AFTER_DRAIN = false;
    const bf16_t* GA; const bf16_t* GB; bf16_t* O;
    __device__ __forceinline__ void mid(f32x4 (&acc)[2][2][4][2], const Unit& u, int wr, int wc, int fr, int fq) const {
        asm volatile("" : "+v"(fr), "+v"(fq));
        const int row0 = u.pm * BM + wr * 64 + fr, col0 = u.pn * BM + wc * 32 + 8 * fq;
#pragma unroll
        for (int ai = 0; ai < 2; ++ai)
#pragma unroll
            for (int m = 0; m < 4; ++m) { const size_t off = (size_t)(row0 + ai * HALF + m * 16) * 1024 + col0;
#pragma unroll
                for (int bj = 0; bj < 2; ++bj) {
                    const u32x4 a = *(const u32x4*)(GA + off + bj * HALF), b = *(const u32x4*)(GB + off + bj * HALF);
#define PG8_RATIO(x, y) ((1.0f + __expf(-(y))) * __builtin_amdgcn_rcpf(1.0f + __expf(-(x))))
                    f32x4& v0 = acc[ai][bj][m][0]; f32x4& v1 = acc[ai][bj][m][1];
                    v0[0] *= PG8_RATIO(bf_lo(a.x), bf_lo(b.x)); v0[1] *= PG8_RATIO(bf_hi(a.x), bf_hi(b.x)); v0[2] *= PG8_RATIO(bf_lo(a.y), bf_lo(b.y)); v0[3] *= PG8_RATIO(bf_hi(a.y), bf_hi(b.y));
                    v1[0] *= PG8_RATIO(bf_lo(a.z), bf_lo(b.z)); v1[1] *= PG8_RATIO(bf_hi(a.z), bf_hi(b.z)); v1[2] *= PG8_RATIO(bf_lo(a.w), bf_lo(b.w)); v1[3] *= PG8_RATIO(bf_hi(a.w), bf_hi(b.w));
#undef PG8_RATIO
                }
                asm volatile("" ::: "memory"); }
    }
    __device__ __forceinline__ void operator()(const f32x4 (&acc)[2][2][4][2], const Unit& u, int wr, int wc, int fr, int fq) const {
        const int row0 = u.pm * BM + wr * 64 + fr, col0 = u.pn * BM + wc * 32 + 8 * fq;
#pragma unroll
        for (int ai = 0; ai < 2; ++ai)
#pragma unroll
            for (int m = 0; m < 4; ++m) { const size_t off = (size_t)(row0 + ai * HALF + m * 16) * 1024 + col0;
#pragma unroll
                for (int bj = 0; bj < 2; ++bj) {
                    const u32x4 g = *(const u32x4*)(GB + off + bj * HALF);
                    f32x4 v0 = acc[ai][bj][m][0], v1 = acc[ai][bj][m][1];
                    v0[0] *= sigmoid_f(bf_lo(g.x)); v0[1] *= sigmoid_f(bf_hi(g.x)); v0[2] *= sigmoid_f(bf_lo(g.y)); v0[3] *= sigmoid_f(bf_hi(g.y));
                    v1[0] *= sigmoid_f(bf_lo(g.z)); v1[1] *= sigmoid_f(bf_hi(g.z)); v1[2] *= sigmoid_f(bf_lo(g.w)); v1[3] *= sigmoid_f(bf_hi(g.w));
                    u32x4 w; w.x = cvt_pk_bf16(v0[0], v0[1]); w.y = cvt_pk_bf16(v0[2], v0[3]); w.z = cvt_pk_bf16(v1[0], v1[1]); w.w = cvt_pk_bf16(v1[2], v1[3]);
                    *(u32x4*)(O + off + bj * HALF) = w; } }
    }
};

struct EpiResid {
    static constexpr bool PERM = false, AFTER_DRAIN = false;
    const float* X; const float* gate; float* out; int rows_per_batch; int gstride;
    __device__ __forceinline__ void operator()(const f32x4 (&acc)[2][2][4][2], const Unit& u, int wr, int wc, int fr, int fq) const {
        const int col0 = u.pn * BM + wc * 32 + 4 * fq;
#pragma unroll
        for (int ai = 0; ai < 2; ++ai)
#pragma unroll
            for (int m = 0; m < 4; ++m) { const int row = u.pm * BM + ai * HALF + wr * 64 + m * 16 + fr; const size_t off = (size_t)row * 1024 + col0;
                const float* gp = gate + (size_t)(row / rows_per_batch) * gstride + col0;
#pragma unroll
                for (int bj = 0; bj < 2; ++bj)
#pragma unroll
                    for (int n = 0; n < 2; ++n) { const f32x4 xv = *(const f32x4*)(X + off + bj * HALF + n * 16); const f32x4 gv = *(const f32x4*)(gp + bj * HALF + n * 16);
                        *(f32x4*)(out + off + bj * HALF + n * 16) = xv + gv * acc[ai][bj][m][n]; } }
    }
};

__device__ __forceinline__ float swiglu1(float g, float l) {
    g = fminf(g, 7.0f); l = fminf(fmaxf(l, -7.0f), 7.0f);
    return (l + 1.0f) * (g * __builtin_amdgcn_rcpf(1.0f + __expf(-1.702f * g)));
}
struct EpiSwiglu {
    static constexpr bool PERM = true, AFTER_DRAIN = false;
    const float* b1; bf16_t* O;
    __device__ __forceinline__ void operator()(const f32x4 (&acc)[2][2][4][2], const Unit& u, int wr, int wc, int fr, int fq) const {
        const int e = u.pn >> 3, pl = u.pn & 7, jc = wc * 32 + 8 * fq;
        const float* bg = b1 + (size_t)e * 2048 + 128 * pl + jc; const float* bl = bg + 1024;
        const f32x4 bg0 = *(const f32x4*)bg, bg1 = *(const f32x4*)(bg + 4), bl0 = *(const f32x4*)bl, bl1 = *(const f32x4*)(bl + 4);
        const int row0 = u.pm * BM + wr * 64 + fr;
#pragma unroll
        for (int ai = 0; ai < 2; ++ai)
#pragma unroll
            for (int m = 0; m < 4; ++m) {
                const f32x4 g0 = acc[ai][0][m][0] + bg0, g1 = acc[ai][0][m][1] + bg1, l0 = acc[ai][1][m][0] + bl0, l1 = acc[ai][1][m][1] + bl1;
                u32x4 w; w.x = cvt_pk_bf16(swiglu1(g0[0], l0[0]), swiglu1(g0[1], l0[1])); w.y = cvt_pk_bf16(swiglu1(g0[2], l0[2]), swiglu1(g0[3], l0[3]));
                w.z = cvt_pk_bf16(swiglu1(g1[0], l1[0]), swiglu1(g1[1], l1[1])); w.w = cvt_pk_bf16(swiglu1(g1[2], l1[2]), swiglu1(g1[3], l1[3]));
                *(u32x4*)(O + (size_t)(row0 + ai * HALF + m * 16) * 1024 + 128 * pl + jc) = w; }
    }
};

struct GroupedOrder {
    const PG8_LAS int* ts; int NT, G, c; const int* rowtok;
    __device__ __forceinline__ bool next(int i, Unit& u) const {
        const int total = __builtin_amdgcn_readfirstlane(ts[32]) * NT; const long L = (long)i * G + c; if (L >= total) return false;
        const int pm = (int)L / NT, pl = (int)L % NT; int e = 0;
#pragma unroll 1
        for (int j = 1; j < 32; ++j) e += (pm >= ts[j]) ? 1 : 0;
        u.pm = __builtin_amdgcn_readfirstlane(pm); u.pn = __builtin_amdgcn_readfirstlane(e * NT + pl); return true;
    }
    __device__ __forceinline__ void a_ready(const Unit&) const {}
    __device__ __forceinline__ void done(const Unit&) const {}
};
}
#define GAS __attribute__((address_space(1)))
#define LAS __attribute__((address_space(3)))
typedef unsigned short bf16;
typedef unsigned v4u __attribute__((ext_vector_type(4)));
typedef float f32x4 __attribute__((ext_vector_type(4)));
typedef short bf16x8 __attribute__((ext_vector_type(8)));
typedef GAS unsigned gu32;
typedef GAS unsigned long long gu64;
#define RLX_AGENT __ATOMIC_RELAXED, __HIP_MEMORY_SCOPE_AGENT
#define LDS_WAIT() asm volatile("s_waitcnt lgkmcnt(0)" ::: "memory")
#define VM_WAIT() asm volatile("s_waitcnt vmcnt(0)" ::: "memory")
__device__ __forceinline__ unsigned long long rt() { return __builtin_amdgcn_s_memrealtime(); }
__device__ __forceinline__ unsigned f2bf(float f) { unsigned u = __builtin_bit_cast(unsigned, f); return (u + 0x7fffu + ((u >> 16) & 1u)) >> 16; }
typedef float f32x2_pk __attribute__((ext_vector_type(2))); typedef __bf16 bf16x2_pk __attribute__((ext_vector_type(2)));
__device__ __forceinline__ unsigned pk2(float lo, float hi) { const f32x2_pk v = {lo, hi}; return __builtin_bit_cast(unsigned, __builtin_convertvector(v, bf16x2_pk)); }

#define XB_TMO      128
#define XB_XCNT(j)  (256  + 64 * (j))
#define XB_XSUB(j)  (1280 + 64 * (j))
#define XB_XGEN(j)  (2304 + 64 * (j))
#define XB_TOP      3328
#define XB_TOPGEN   3392
#define XCD_BAR_WORDS 3456
#define XB_SPIN_CAP (1u << 18)

__device__ __forceinline__ unsigned xb_ld(unsigned* p)              { return __hip_atomic_load(p, __ATOMIC_RELAXED, __HIP_MEMORY_SCOPE_AGENT); }
__device__ __forceinline__ unsigned xb_add(unsigned* p, unsigned v) { return __hip_atomic_fetch_add(p, v, __ATOMIC_RELAXED, __HIP_MEMORY_SCOPE_AGENT); }
__device__ __forceinline__ unsigned xb_xcc_id() { return (unsigned)__builtin_amdgcn_s_getreg((3 << 11) | 20) & 0xFu; }
#define XB_SPIN(cond, bar) do { unsigned _sp = 0; while (cond) { __builtin_amdgcn_s_sleep(1); \
    if ((++_sp & 255u) == 0u) { if (xb_ld(&(bar)[XB_TMO])) break; if (_sp > XB_SPIN_CAP) { atomicAdd(&(bar)[XB_TMO], 1u); break; } } } } while (0)

struct XcdBarrier {
    unsigned* bar; unsigned x;
    volatile LAS unsigned* st;
};

__device__ __forceinline__ XcdBarrier xcd_barrier_post(unsigned* bar, volatile LAS unsigned* st) {
    XcdBarrier b; b.bar = bar; b.x = xb_xcc_id(); b.st = st;
    if (threadIdx.x == 0) (void)xb_add(&bar[XB_XCNT(b.x)], 1u);
    return b;
}
__device__ __forceinline__ void xcd_barrier_complete(unsigned* bar, unsigned x, unsigned& nloc, unsigned& nx) {
    const unsigned G = gridDim.x * gridDim.y * gridDim.z;
    unsigned sum, cnt, mine, sp = 0u;
    for (;;) {
        sum = 0u; cnt = 0u; mine = 0u;
#pragma unroll
        for (unsigned j = 0; j < 16; ++j) { const unsigned c = xb_ld(&bar[XB_XCNT(j)]); sum += c; cnt += (c > 0u) ? 1u : 0u; mine = (j == x) ? c : mine; }
        if (sum == G) break;
        __builtin_amdgcn_s_sleep(1);
        if ((++sp & 255u) == 0u) { if (xb_ld(&bar[XB_TMO])) break; if (sp > XB_SPIN_CAP) { atomicAdd(&bar[XB_TMO], 1u); break; } }
    }
    nloc = mine > 0u ? mine : 1u; nx = cnt > 0u ? cnt : 1u;
}

__device__ __forceinline__ void xcd_barrier(const XcdBarrier& b) {
    asm volatile("s_waitcnt vmcnt(0)" ::: "memory");
    __syncthreads();
    if (threadIdx.x == 0) {
        unsigned* bar = b.bar;
        __builtin_amdgcn_s_waitcnt(0);
        unsigned nloc = b.st[0], nx = b.st[1];
        if (nloc == 0u) { xcd_barrier_complete(bar, b.x, nloc, nx); b.st[0] = nloc; b.st[1] = nx; }
        const unsigned old = xb_add(&bar[XB_XSUB(b.x)], 1u);
        const unsigned gen = old / nloc;
        if (old + 1u == (gen + 1u) * nloc) {
            __builtin_amdgcn_fence(__ATOMIC_RELEASE, "agent");
            asm volatile("s_waitcnt vmcnt(0)" ::: "memory");
            const unsigned og = xb_add(&bar[XB_TOP], 1u);
            const unsigned tg = og / nx;
            if (og + 1u == (tg + 1u) * nx) xb_add(&bar[XB_TOPGEN], 1u);
            else XB_SPIN(xb_ld(&bar[XB_TOPGEN]) == tg, bar);
            __builtin_amdgcn_fence(__ATOMIC_ACQUIRE, "agent");
            xb_add(&bar[XB_XGEN(b.x)], 1u);
            asm volatile("s_waitcnt vmcnt(0)" ::: "memory");
        } else {
            XB_SPIN(xb_ld(&bar[XB_XGEN(b.x)]) == gen, bar);
            __builtin_amdgcn_fence(__ATOMIC_ACQUIRE, "agent");
            asm volatile("s_waitcnt vmcnt(0)" ::: "memory");
        }
    }
    __syncthreads();
}

constexpr int NWAVES = 8;
constexpr int BATCH = 16, SEQ = 2048, D = 1024, T = BATCH * SEQ;
constexpr int NIN = 9224, NPROJ = 9216, NMOD = 6 * D;
constexpr int NE = 32, TOPK = 4;
constexpr int XS_ROWS = T * TOPK + NE * 256;
constexpr float EPS = 1e-6f;
constexpr float ATT_RTHR = -120.0f;
constexpr float QSCALE = 0.125f * 1.4426950408889634f;

constexpr size_t MiB = 1u << 20;
constexpr size_t WS_CTL = 0, CTL_ZERO_BYTES = 1 * MiB;
constexpr size_t WS_MODP = 1 * MiB;
constexpr size_t WS_MOD = 3 * MiB;
constexpr size_t WS_IPRE = 4 * MiB, WS_LF = 4 * MiB + 512 * 1024;
constexpr size_t WS_TOKE = 5 * MiB, WS_TOKP = 5 * MiB + 512 * 1024, WS_TOKW = 6 * MiB, WS_TOKROW = 6 * MiB + 512 * 1024, WS_RSTD = 7 * MiB;
constexpr size_t WS_WIN = 8 * MiB, WS_WA = 26 * MiB, WS_WB = 28 * MiB, WS_WOUT = 30 * MiB, WS_W1 = 32 * MiB, WS_W2 = 160 * MiB;
constexpr size_t WS_H1 = 224 * MiB;
constexpr size_t WS_PROJ = 288 * MiB, SEG = 64 * MiB;
constexpr size_t WS_Y = 864 * MiB;
constexpr int YP = 2048;
constexpr size_t WS_XS = 288 * MiB, WS_ACT = 560 * MiB;
constexpr size_t WS_ROW2TOK = 7 * MiB + 128 * 1024;
constexpr size_t WS_GT = 992 * MiB;
constexpr size_t WS_END = 996 * MiB;
static_assert(WS_XS + (size_t)XS_ROWS * 2048 <= WS_ACT && WS_ACT + (size_t)XS_ROWS * 2048 <= WS_Y, "ws map");
constexpr int CW_TMO = 0, CW_BAR = 4096, CW_ECNT = 8192;

constexpr int RING_BYTES = 131072, LDS_BYTES = 147456, LDSCTL_OFF = 146432;
constexpr int LC_BAR = 0, LC_TS = 16, LC_LCNT = 64, LC_GBASE = 96, LC_PS = 128, LC_CNT = 160;

__device__ __forceinline__ unsigned long long karg(int i) { return ((const __attribute__((address_space(4))) unsigned long long*)__builtin_amdgcn_kernarg_segment_ptr())[i]; }
struct Frame {
    LAS unsigned char* lds; volatile LAS unsigned* LC;
    gu32* ctl; unsigned char* ws; int tid, lane, wave, vcu, G;
    __device__ __forceinline__ const float* x() const { return (const float*)(const GAS float*)karg(0); }
    __device__ __forceinline__ const float* c() const { return (const float*)(const GAS float*)karg(1); }
    __device__ __forceinline__ const float* ada_w() const { return (const float*)(const GAS float*)karg(2); }
    __device__ __forceinline__ const float* ada_b() const { return (const float*)(const GAS float*)karg(3); }
    __device__ __forceinline__ const float* norm1_g() const { return (const float*)(const GAS float*)karg(4); }
    __device__ __forceinline__ const float* w_in() const { return (const float*)(const GAS float*)karg(5); }
    __device__ __forceinline__ const float* conv_w() const { return (const float*)(const GAS float*)karg(6); }
    __device__ __forceinline__ const float* conv_b() const { return (const float*)(const GAS float*)karg(7); }
    __device__ __forceinline__ const float* b_i() const { return (const float*)(const GAS float*)karg(8); }
    __device__ __forceinline__ const float* b_f() const { return (const float*)(const GAS float*)karg(9); }
    __device__ __forceinline__ const float* ml_norm_g() const { return (const float*)(const GAS float*)karg(10); }
    __device__ __forceinline__ const float* w_a() const { return (const float*)(const GAS float*)karg(11); }
    __device__ __forceinline__ const float* w_b() const { return (const float*)(const GAS float*)karg(12); }
    __device__ __forceinline__ const float* w_out() const { return (const float*)(const GAS float*)karg(13); }
    __device__ __forceinline__ const float* norm2_g() const { return (const float*)(const GAS float*)karg(14); }
    __device__ __forceinline__ const float* router_w() const { return (const float*)(const GAS float*)karg(15); }
    __device__ __forceinline__ const float* router_b() const { return (const float*)(const GAS float*)karg(16); }
    __device__ __forceinline__ const float* w1() const { return (const float*)(const GAS float*)karg(17); }
    __device__ __forceinline__ const float* b1() const { return (const float*)(const GAS float*)karg(18); }
    __device__ __forceinline__ const float* w2() const { return (const float*)(const GAS float*)karg(19); }
    __device__ __forceinline__ const float* b2() const { return (const float*)(const GAS float*)karg(20); }
    __device__ __forceinline__ const float* final_g() const { return (const float*)(const GAS float*)karg(21); }
    __device__ __forceinline__ float* out() const { return (float*)(GAS float*)karg(22); }
    __device__ __forceinline__ float* modp() const { return (float*)(ws + WS_MODP); }
    __device__ __forceinline__ float* mod() const { return (float*)(ws + WS_MOD); }
    __device__ __forceinline__ float* ipre() const { return (float*)(ws + WS_IPRE); }
    __device__ __forceinline__ float* lf() const { return (float*)(ws + WS_LF); }
    __device__ __forceinline__ float* tokw() const { return (float*)(ws + WS_TOKW); }
    __device__ __forceinline__ float* rstd2() const { return (float*)(ws + WS_RSTD); }
    __device__ __forceinline__ int* toke() const { return (int*)(ws + WS_TOKE); }
    __device__ __forceinline__ int* tokp() const { return (int*)(ws + WS_TOKP); }
    __device__ __forceinline__ int* tokrow() const { return (int*)(ws + WS_TOKROW); }
    __device__ __forceinline__ bf16* WIN_T() const { return (bf16*)(ws + WS_WIN); }
    __device__ __forceinline__ bf16* WAB_T() const { return (bf16*)(ws + WS_WA); }
    __device__ __forceinline__ bf16* WOUT_T() const { return (bf16*)(ws + WS_WOUT); }
    __device__ __forceinline__ bf16* W1_T() const { return (bf16*)(ws + WS_W1); }
    __device__ __forceinline__ bf16* W2_T() const { return (bf16*)(ws + WS_W2); }
    __device__ __forceinline__ bf16* H1() const { return (bf16*)(ws + WS_H1); }
    __device__ __forceinline__ bf16* PROJ() const { return (bf16*)(ws + WS_PROJ); }
    __device__ __forceinline__ bf16* YA() const { return (bf16*)(ws + WS_Y); }
    __device__ __forceinline__ bf16* YB() const { return (bf16*)(ws + WS_Y) + 1024; }
    __device__ __forceinline__ bf16* MERGED() const { return (bf16*)(ws + WS_PROJ + SEG); }
    __device__ __forceinline__ bf16* XS() const { return (bf16*)(ws + WS_XS); }
    __device__ __forceinline__ bf16* ACT() const { return (bf16*)(ws + WS_ACT); }
    __device__ __forceinline__ bf16* OUTR() const { return (bf16*)(ws + WS_XS); }
    __device__ __forceinline__ bf16* H2() const { return (bf16*)(ws + WS_XS); }
    __device__ __forceinline__ int* row2tok() const { return (int*)(ws + WS_ROW2TOK); }
    __device__ __forceinline__ float* gt() const { return (float*)(ws + WS_GT); }
};

__device__ __forceinline__ int opq(int v) { asm volatile("" : "+v"(v)); return v; }
__device__ __forceinline__ float wave_sum(float v) {
#pragma unroll
    for (int o = 1; o < 64; o <<= 1) v += __shfl_xor(v, o);
    return v;
}
__device__ __forceinline__ float bf2f(unsigned short b) { return __builtin_bit_cast(float, (unsigned)b << 16); }
__device__ __forceinline__ float bflo(unsigned w) { return __builtin_bit_cast(float, w << 16); }
__device__ __forceinline__ float bfhi(unsigned w) { return __builtin_bit_cast(float, w & 0xffff0000u); }
__device__ __forceinline__ float log_sigmoid_f(float x) { return fminf(x, 0.f) - log1pf(expf(-fabsf(x))); }

struct MapIn { __device__ __forceinline__ long operator()(int n) const { return n < 7168 ? (long)n : (n < 7176 ? -1L : (n < NIN ? (long)(n - 8) : -1L)); } };
struct MapId { long off; __device__ __forceinline__ long operator()(int n) const { return off + n; } };
struct MapW1 { int e; __device__ __forceinline__ long operator()(int n) const { return (long)e * 2048 + ((n & 1023) >> 7) * 256 + (n >> 10) * 128 + (n & 127); } };

template <class Map> __device__ __forceinline__ void transpose_item(const float* W, int K, int N, bf16* WT, LAS float* scr, int item, int lane, Map map, int KP = 0, int koff = 0) {
    if (KP == 0) KP = K;
    const int nblk = (N + 31) / 32, kb = item / nblk, nb = item % nblk, k0 = 64 * kb, n0 = 32 * nb;
    const int n4 = 4 * (lane & 7), kr = lane >> 3;
    const bool ok = (n0 + n4 + 3) < N;
    f32x4 v[8];
#pragma unroll
    for (int i = 0; i < 8; ++i) v[i] = ok ? *(const f32x4*)(W + (size_t)(k0 + 8 * i + kr) * N + n0 + n4) : (f32x4){0.f, 0.f, 0.f, 0.f};
#pragma unroll
    for (int i = 0; i < 8; ++i) { LAS float* d = scr + (8 * i + kr) * 33 + n4; d[0] = v[i].x; d[1] = v[i].y; d[2] = v[i].z; d[3] = v[i].w; }
    LDS_WAIT(); asm volatile("" ::: "memory");
    const int c = lane & 7;
#pragma unroll
    for (int j = 0; j < 4; ++j) { const int n = (lane >> 3) + 8 * j; const LAS float* s = scr + (8 * c) * 33 + n;
        v4u o; o.x = pk2(s[0 * 33], s[1 * 33]); o.y = pk2(s[2 * 33], s[3 * 33]); o.z = pk2(s[4 * 33], s[5 * 33]); o.w = pk2(s[6 * 33], s[7 * 33]);
        const long dr = map(n0 + n);
        if (dr >= 0) *(GAS v4u*)(WT + (size_t)dr * KP + koff + k0 + 8 * c) = o; }
    LDS_WAIT(); asm volatile("" ::: "memory");
}
__device__ __forceinline__ void mod_item(Frame& F, const LAS float* sil, int it) {
    const int j = it % 96, kq = it / 96, n = 64 * j + F.lane, k0 = 256 * kq;
    float acc[16];
#pragma unroll
    for (int b = 0; b < 16; ++b) acc[b] = 0.f;
    const float* w = F.ada_w() + (size_t)k0 * NMOD + n;
    const LAS f32x4* s = (const LAS f32x4*)sil + k0 * 4;
    for (int kk = 0; kk < 256; kk += 8) {
        float wv[8];
#pragma unroll
        for (int u = 0; u < 8; ++u) wv[u] = w[(size_t)(kk + u) * NMOD];
#pragma unroll
        for (int u = 0; u < 8; ++u) {
#pragma unroll
            for (int q = 0; q < 4; ++q) { const f32x4 sv = s[(kk + u) * 4 + q]; acc[4 * q + 0] += sv.x * wv[u]; acc[4 * q + 1] += sv.y * wv[u]; acc[4 * q + 2] += sv.z * wv[u]; acc[4 * q + 3] += sv.w * wv[u]; }
        }
    }
    float* o = F.modp() + (size_t)kq * 16 * NMOD + n;
#pragma unroll
    for (int b = 0; b < 16; ++b) o[(size_t)b * NMOD] = acc[b];
}
__device__ __forceinline__ void p0_prologue(Frame& F) {
    LAS float* sil = (LAS float*)F.lds;
    for (int idx = F.tid; idx < 16384; idx += 512) { const int b = idx >> 10, k = idx & 1023; const float v = F.c()[idx]; sil[k * 16 + b] = v / (1.0f + __expf(-v)); }
    __syncthreads();
    LAS float* scr = (LAS float*)(F.lds + 65536 + F.wave * 8704);
    const int gw = F.vcu * NWAVES + F.wave, NGW = F.G * NWAVES;
    constexpr int I_MOD = 384, I_IN = 16 * 289, I_SQ = 16 * 32, I_W1 = 32 * 16 * 64, I_W2 = 32 * 16 * 32;
    constexpr int NITEMS = I_MOD + I_IN + 3 * I_SQ + I_W1 + I_W2;
    for (int it = gw; it < NITEMS; it += NGW) {
        int r = it;
        if (r < I_MOD) { mod_item(F, sil, r); continue; } r -= I_MOD;
        if (r < I_IN) { transpose_item(F.w_in(), D, NIN, F.WIN_T(), scr, r, F.lane, MapIn{}); continue; } r -= I_IN;
        if (r < I_SQ) { transpose_item(F.w_a(), D, D, F.WAB_T(), scr, r, F.lane, MapId{0}, 2 * D, 0); continue; } r -= I_SQ;
        if (r < I_SQ) { transpose_item(F.w_b(), D, D, F.WAB_T(), scr, r, F.lane, MapId{0}, 2 * D, D); continue; } r -= I_SQ;
        if (r < I_SQ) { transpose_item(F.w_out(), D, D, F.WOUT_T(), scr, r, F.lane, MapId{0}); continue; } r -= I_SQ;
        if (r < I_W1) { const int e = r >> 10; transpose_item(F.w1() + (size_t)e * D * 2048, D, 2048, F.W1_T(), scr, r & 1023, F.lane, MapW1{e}); continue; } r -= I_W1;
        { const int e = r >> 9; transpose_item(F.w2() + (size_t)e * D * D, D, D, F.W2_T(), scr, r & 511, F.lane, MapId{(long)e * 1024}); }
    }
}

__device__ __forceinline__ void p1_rows(Frame& F) {
    const int row0 = F.vcu * 128, b = row0 / SEQ, lane = opq(F.lane);
    LAS float* wif = (LAS float*)F.lds;
    for (int idx = F.tid; idx < 8192; idx += 512) wif[idx] = F.w_in()[(size_t)(idx >> 3) * NIN + 7168 + (idx & 7)];
    for (int idx = F.vcu * 512 + F.tid; idx < 16 * NMOD; idx += F.G * 512) { float s = F.ada_b()[idx % NMOD];
#pragma unroll
        for (int kq = 0; kq < 4; ++kq) s += F.modp()[(size_t)kq * 16 * NMOD + idx];
        F.mod()[idx] = s; }
    f32x4 Av[4], Bv[4];
#pragma unroll
    for (int j = 0; j < 4; ++j) { const int col = 4 * lane + 256 * j;
        f32x4 sh = *(const f32x4*)(F.ada_b() + col), sc = *(const f32x4*)(F.ada_b() + D + col);
#pragma unroll
        for (int kq = 0; kq < 4; ++kq) { sh += *(const f32x4*)(F.modp() + ((size_t)kq * 16 + b) * NMOD + col); sc += *(const f32x4*)(F.modp() + ((size_t)kq * 16 + b) * NMOD + D + col); }
        const f32x4 g = *(const f32x4*)(F.norm1_g() + col); Av[j] = g * (sc + 1.0f); Bv[j] = sh; }
    __syncthreads();
    for (int r = 0; r < 16; ++r) {
        const int row = row0 + 16 * F.wave + r;
        const GAS f32x4* xr = (const GAS f32x4*)(F.x() + (size_t)row * D) + lane;
        f32x4 v[4]; float ss = 0.f;
#pragma unroll
        for (int j = 0; j < 4; ++j) { v[j] = xr[64 * j]; ss += (v[j].x * v[j].x + v[j].y * v[j].y) + (v[j].z * v[j].z + v[j].w * v[j].w); }
        const float rstd = 1.0f / sqrtf(wave_sum(ss) * (1.0f / D) + EPS);
        GAS unsigned long long* o8 = (GAS unsigned long long*)(F.H1() + (size_t)row * D) + lane;
        float p[8];
#pragma unroll
        for (int q = 0; q < 8; ++q) p[q] = 0.f;
#pragma unroll
        for (int j = 0; j < 4; ++j) { v[j] = v[j] * rstd * Av[j] + Bv[j];
            o8[64 * j] = (unsigned long long)pk2(v[j].x, v[j].y) | ((unsigned long long)pk2(v[j].z, v[j].w) << 32);
#pragma unroll
            for (int i = 0; i < 4; ++i) { const LAS f32x4* wp = (const LAS f32x4*)(wif + (4 * lane + 256 * j + i) * 8); const f32x4 w0 = wp[0], w1 = wp[1]; const float hv = v[j][i];
                p[0] += hv * w0.x; p[1] += hv * w0.y; p[2] += hv * w0.z; p[3] += hv * w0.w; p[4] += hv * w1.x; p[5] += hv * w1.y; p[6] += hv * w1.z; p[7] += hv * w1.w; } }
#pragma unroll
        for (int q = 0; q < 8; ++q) p[q] = wave_sum(p[q]);
        if (lane == 0) { const int t = row % SEQ;
#pragma unroll
            for (int hh = 0; hh < 4; ++hh) { F.ipre()[((size_t)b * 4 + hh) * SEQ + t] = p[hh] + F.b_i()[hh]; F.lf()[((size_t)b * 4 + hh) * SEQ + t] = log_sigmoid_f(p[4 + hh] + F.b_f()[hh]); } }
    }
}


namespace ml {
typedef short bf16x8 __attribute__((ext_vector_type(8)));
typedef short s16x4 __attribute__((ext_vector_type(4)));
typedef float f32x16 __attribute__((ext_vector_type(16)));
typedef LAS const char* lcp;
typedef LAS char* lp_t;
constexpr int L = 64;
constexpr int O_QI = 0, O_KI = 33792, O_CB = 67584, O_VI = 102400, O_VW = 111616, O_PI = 120832, O_F = 130048;
constexpr int F_NV = 0, F_QNP = 256, F_RSP = 768, F_AT = 896, F_US = 960, F_WIN = 1024, F_EDEN = 1088, F_WST = 1152, F_RDEN = 1216, F_CW = 1280, F_CBIAS = 3328;
__device__ __forceinline__ int crow(int r, int hi) { return (r & 3) + 8 * (r >> 2) + 4 * hi; }
template <int PITCH, int XM> __device__ __forceinline__ int ioff(int row, int ch) { return XM ? PITCH * row + 16 * (ch ^ (row & XM)) : PITCH * row + 16 * ch; }
template <int PITCH, int XM> __device__ __forceinline__ bf16x8 frag_row(lcp img, int row0, int s, int lane) {
    return *(LAS const bf16x8*)(img + ioff<PITCH, XM>(row0 + (lane & 31), 2 * s + (lane >> 5)));
}
template <int PITCH, int XM> __device__ __forceinline__ bf16x8 frag_tr(lcp img, int k0, int ks, int col0, int lane) {
    const int h = lane >> 5, blk = (lane >> 4) & 1, q = (lane & 15) >> 2, p = lane & 3;
    const int r0 = k0 + 16 * ks + 8 * h + q, ch = (col0 >> 3) + 2 * blk + (p >> 1);
    typedef short v4i16_t __attribute__((ext_vector_type(4)));
    const s16x4 a = __builtin_bit_cast(s16x4, __builtin_amdgcn_ds_read_tr16_b64_v4i16((LAS v4i16_t*)(img + ioff<PITCH, XM>(r0, ch) + 8 * (p & 1))));
    const s16x4 b = __builtin_bit_cast(s16x4, __builtin_amdgcn_ds_read_tr16_b64_v4i16((LAS v4i16_t*)(img + ioff<PITCH, XM>(r0 + 4, ch) + 8 * (p & 1))));
    return (bf16x8){a[0], a[1], a[2], a[3], b[0], b[1], b[2], b[3]};
}
__device__ __forceinline__ float half_sum(float v) {
    const auto rr = __builtin_amdgcn_permlane32_swap(__builtin_bit_cast(unsigned, v), __builtin_bit_cast(unsigned, v), false, false);
    return __builtin_bit_cast(float, rr[0]) + __builtin_bit_cast(float, rr[1]);
}
__device__ __forceinline__ float silu_f(float y) { return y * __builtin_amdgcn_rcpf(1.0f + __expf(-y)); }

__device__ __forceinline__ void mlstm_unit(Frame& F, int unit) {
    const int bh = unit >> 2, sl = unit & 3, b = bh >> 2, hh = bh & 3, tid = opq(F.tid), lane = opq(F.lane), wave = F.wave, hi = lane >> 5, l31 = lane & 31;
    const bf16* MLQ = (const bf16*)F.out(); const bf16* MLK = MLQ + (size_t)T * D; const bf16* MLV = F.PROJ() + 5 * (SEG / 2);
    lp_t base = (lp_t)F.lds;
    LAS float* Fa = (LAS float*)(base + O_F);
    const size_t rowb = (size_t)b * SEQ;
    const float LOG2E = 1.4426950408889634f;
    __syncthreads();
    for (int i = tid; i < 34816 / 16; i += 512) ((LAS v4u*)(base + O_CB))[i] = (v4u){0u, 0u, 0u, 0u};
    if (tid < 256) Fa[F_NV + tid] = 0.f;
    f32x16 C0, C1, C2;
#pragma unroll
    for (int r = 0; r < 16; ++r) { C0[r] = 0.f; C1[r] = 0.f; C2[r] = 0.f; }
    if (tid < 64) *(LAS v4u*)(base + O_VW + 144 * tid + 128) = (v4u){0u, 0u, 0u, 0u};
    const int cg = tid & 31, rb = tid >> 5;
    v4u rawq[2][4], rawk[2][4], rawv[2]; float g_bb[2], g_us[2], g_pm[2]; float m_prev = 0.f;
#define ML_PREFETCH(T0, P) do { const int t0_ = (T0); \
        _Pragma("unroll") for (int i = 0; i < 4; ++i) { const unsigned g_ = (unsigned)(((int)rowb + t0_ + 4 * rb + i) * D + hh * 256 + cg * 8); \
            rawq[P][i] = *(const v4u*)(MLQ + g_); rawk[P][i] = *(const v4u*)(MLK + g_); } \
        rawv[P] = *(const v4u*)(MLV + (unsigned)(((int)rowb + t0_ + (tid >> 3)) * D + hh * 256 + 64 * sl + (tid & 7) * 8)); \
        { const float* gt_ = F.gt() + (unsigned)(((bh * (SEQ / L) + t0_ / L) * 3) * 64 + lane); g_bb[P] = gt_[0]; g_us[P] = gt_[64]; g_pm[P] = gt_[128]; } } while (0)
    ML_PREFETCH(0, 0); ML_PREFETCH(L, 1);
    __syncthreads();
    for (int chunk2 = 0; chunk2 < SEQ / L; chunk2 += 2) {
#pragma unroll
      for (int par = 0; par < 2; ++par) {
        const int chunk = chunk2 + par, t0 = chunk * L;
        const int tid = opq(F.tid), lane = tid & 63, hi = lane >> 5, l31 = lane & 31, cg = tid & 31, rb = tid >> 5, lo = lane;
        const float u = g_us[par], mm = g_bb[par] + fmaxf(m_prev, g_pm[par]), winter = __builtin_amdgcn_exp2f(g_bb[par] + m_prev - mm), at = g_bb[par] - mm, eden = __builtin_amdgcn_exp2f(-mm);
        const float bb63 = __builtin_bit_cast(float, __builtin_amdgcn_readlane(__builtin_bit_cast(int, g_bb[par]), 63)), mnew = __builtin_bit_cast(float, __builtin_amdgcn_readlane(__builtin_bit_cast(int, mm), 63));
        const float decay = __builtin_amdgcn_exp2f(bb63 + m_prev - mnew), wstate = __builtin_amdgcn_exp2f(bb63 - mnew + u); m_prev = mnew;
        if (wave == 0) { Fa[F_AT + lane] = at; Fa[F_US + lane] = u; Fa[F_WIN + lane] = winter; Fa[F_EDEN + lane] = eden; Fa[F_WST + lane] = wstate; }
#pragma unroll
        for (int j = 0; j < 4; ++j) { *(LAS v4u*)(base + O_QI + ioff<528, 0>(4 * rb + j, cg)) = rawq[par][j]; *(LAS v4u*)(base + O_KI + ioff<528, 0>(4 * rb + j, cg)) = rawk[par][j]; }
        { const int s = tid >> 3, ch = tid & 7; const v4u w = rawv[par];
          *(LAS v4u*)(base + O_VI + ioff<144, 0>(s, ch)) = w;
          const float ws = __shfl(wstate, s);
          v4u o; o.x = pk2(bflo(w.x) * ws, bfhi(w.x) * ws); o.y = pk2(bflo(w.y) * ws, bfhi(w.y) * ws); o.z = pk2(bflo(w.z) * ws, bfhi(w.z) * ws); o.w = pk2(bflo(w.w) * ws, bfhi(w.w) * ws);
          *(LAS v4u*)(base + O_VW + ioff<144, 0>(s, ch)) = o;
          if (ch == 0) *(LAS unsigned short*)(base + O_VW + 144 * s + 128) = (unsigned short)pk2(ws, 0.f); }
        __syncthreads();
        if (chunk + 2 < SEQ / L) ML_PREFETCH(t0 + 2 * L, par);
        __builtin_amdgcn_sched_barrier(0);
        f32x16 acc;
#pragma unroll
        for (int r = 0; r < 16; ++r) acc[r] = 0.f;
        const int wq = wave & 3, ta = wq >> 1, tb = wq & 1;
        if (wave < 4) {
#pragma unroll
            for (int kh = 0; kh < 2; ++kh) { bf16x8 fa[8], fb[8];
#pragma unroll
                for (int ks = 0; ks < 8; ++ks) { fa[ks] = frag_row<528, 0>(base + O_KI, 32 * tb, 8 * kh + ks, lo); fb[ks] = frag_row<528, 0>(base + O_QI, 32 * ta, 8 * kh + ks, lo); }
                __builtin_amdgcn_sched_barrier(0);
#pragma unroll
                for (int ks = 0; ks < 8; ++ks) acc = __builtin_amdgcn_mfma_f32_32x32x16_bf16(fa[ks], fb[ks], acc, 0, 0, 0);
                __builtin_amdgcn_sched_barrier(0); }
            const float at_l = __shfl(at, 32 * ta + l31); const int t = 32 * ta + l31; float rsum = 0.f;
#pragma unroll
            for (int g = 0; g < 4; ++g) { const int s0 = 32 * tb + 8 * g + 4 * hi; const f32x4 us4 = *(LAS const f32x4*)(Fa + F_US + s0); float p[4];
#pragma unroll
                for (int i = 0; i < 4; ++i) { p[i] = (s0 + i <= t) ? acc[4 * g + i] * __builtin_amdgcn_exp2f(at_l + us4[i]) : 0.f; rsum += p[i]; }
                *(LAS unsigned long long*)(base + O_PI + ioff<144, 0>(t, s0 >> 3) + 2 * (s0 & 7)) = (unsigned long long)pk2(p[0], p[1]) | ((unsigned long long)pk2(p[2], p[3]) << 32); }
            rsum = half_sum(rsum);
            if (hi == 0) Fa[F_RSP + tb * 64 + t] = rsum;
        } else {
#pragma unroll
            for (int kh = 0; kh < 2; ++kh) { bf16x8 fa[8], fb[8];
#pragma unroll
                for (int ks = 0; ks < 8; ++ks) { fa[ks] = frag_row<528, 0>(base + O_QI, 32 * ta, 8 * kh + ks, lo); fb[ks] = frag_tr<136, 0>(base + O_CB, 0, 8 * kh + ks, 32 * tb, lo); }
                __builtin_amdgcn_sched_barrier(0);
#pragma unroll
                for (int ks = 0; ks < 8; ++ks) acc = __builtin_amdgcn_mfma_f32_32x32x16_bf16(fa[ks], fb[ks], acc, 0, 0, 0);
                __builtin_amdgcn_sched_barrier(0); }
        }
        { float s = 0.f;
#pragma unroll
          for (int c = 0; c < 4; ++c) { const v4u w = *(LAS const v4u*)(base + O_QI + ioff<528, 0>(lane, 4 * wave + c)); const f32x4 n0 = *(LAS const f32x4*)(Fa + F_NV + 32 * wave + 8 * c), n1 = *(LAS const f32x4*)(Fa + F_NV + 32 * wave + 8 * c + 4);
              s += bflo(w.x) * n0.x + bfhi(w.x) * n0.y + bflo(w.y) * n0.z + bfhi(w.y) * n0.w + bflo(w.z) * n1.x + bfhi(w.z) * n1.y + bflo(w.w) * n1.z + bfhi(w.w) * n1.w; }
          Fa[F_QNP + wave * 64 + lane] = s; }
        __syncthreads();
        if (wave >= 4) {
            { const int t = 32 * ta + l31;
              const float den = Fa[F_WIN + t] * (((Fa[F_QNP + t] + Fa[F_QNP + 64 + t]) + (Fa[F_QNP + 128 + t] + Fa[F_QNP + 192 + t])) + ((Fa[F_QNP + 256 + t] + Fa[F_QNP + 320 + t]) + (Fa[F_QNP + 384 + t] + Fa[F_QNP + 448 + t])))
                                + Fa[F_RSP + t] + Fa[F_RSP + 64 + t];
              if (hi == 0) Fa[F_CW + 32 * (wave - 4) + l31] = 1.0f / fmaxf(fabsf(den), Fa[F_EDEN + t]); }
#pragma unroll
            for (int g = 0; g < 4; ++g) { const f32x4 w4 = *(LAS const f32x4*)(Fa + F_WIN + 32 * ta + 8 * g + 4 * hi); acc[4 * g] *= w4.x; acc[4 * g + 1] *= w4.y; acc[4 * g + 2] *= w4.z; acc[4 * g + 3] *= w4.w; }
            { bf16x8 fa[4], fb[4];
#pragma unroll
              for (int ks = 0; ks < 4; ++ks) { fa[ks] = frag_row<144, 0>(base + O_PI, 32 * ta, ks, lo); fb[ks] = frag_tr<144, 0>(base + O_VI, 0, ks, 32 * tb, lo); }
              __builtin_amdgcn_sched_barrier(0);
#pragma unroll
              for (int ks = 0; ks < 4; ++ks) acc = __builtin_amdgcn_mfma_f32_32x32x16_bf16(fa[ks], fb[ks], acc, 0, 0, 0); }
            bf16* dst = F.YB() + (rowb + t0 + 32 * ta) * YP + hh * 256 + 64 * sl + 32 * tb + l31;
#pragma unroll
            for (int g = 0; g < 4; ++g) { const f32x4 r4 = *(LAS const f32x4*)(Fa + F_CW + 32 * (wave - 4) + 8 * g + 4 * hi);
#pragma unroll
                for (int i = 0; i < 4; ++i) dst[(size_t)(8 * g + 4 * hi + i) * YP] = (bf16)pk2(acc[4 * g + i] * r4[i], 0.f); }
        }
#pragma unroll
        for (int r = 0; r < 16; ++r) { C0[r] *= decay; C1[r] *= decay; C2[r] *= decay; }
        { bf16x8 bk[4], v0[4], v1[4], v2[4];
#pragma unroll
          for (int ks = 0; ks < 4; ++ks) { bk[ks] = frag_tr<528, 0>(base + O_KI, 0, ks, 32 * wave, lo); v0[ks] = frag_tr<144, 0>(base + O_VW, 0, ks, 0, lo); v1[ks] = frag_tr<144, 0>(base + O_VW, 0, ks, 32, lo); v2[ks] = frag_tr<144, 0>(base + O_VW, 0, ks, 64, lo); }
          __builtin_amdgcn_sched_barrier(0);
#pragma unroll
          for (int ks = 0; ks < 4; ++ks) { C0 = __builtin_amdgcn_mfma_f32_32x32x16_bf16(v0[ks], bk[ks], C0, 0, 0, 0); C1 = __builtin_amdgcn_mfma_f32_32x32x16_bf16(v1[ks], bk[ks], C1, 0, 0, 0); C2 = __builtin_amdgcn_mfma_f32_32x32x16_bf16(v2[ks], bk[ks], C2, 0, 0, 0); }
          __builtin_amdgcn_sched_barrier(0); }
        { const int d = 32 * wave + l31;
#pragma unroll
          for (int g = 0; g < 4; ++g) { const int e0 = 8 * g + 4 * hi;
              *(LAS unsigned long long*)(base + O_CB + ioff<136, 0>(d, e0 >> 3) + 2 * (e0 & 7)) = (unsigned long long)pk2(C0[4 * g], C0[4 * g + 1]) | ((unsigned long long)pk2(C0[4 * g + 2], C0[4 * g + 3]) << 32);
              *(LAS unsigned long long*)(base + O_CB + ioff<136, 0>(d, (32 + e0) >> 3) + 2 * (e0 & 7)) = (unsigned long long)pk2(C1[4 * g], C1[4 * g + 1]) | ((unsigned long long)pk2(C1[4 * g + 2], C1[4 * g + 3]) << 32); }
          if (hi == 0) Fa[F_NV + d] = C2[0];
        }
        __syncthreads();
      }
    }
#undef ML_PREFETCH
}
}


__device__ __forceinline__ void mlstm_gates(Frame& F, int job) {
    const int lane = opq(F.lane); const float LOG2E = 1.4426950408889634f;
    const float lf2 = F.lf()[(size_t)job * ml::L + lane] * LOG2E, ii2 = F.ipre()[(size_t)job * ml::L + lane] * LOG2E;
    float bb = lf2;
#pragma unroll
    for (int o = 1; o < 64; o <<= 1) { const float v = __shfl_up(bb, o); bb += (lane >= o) ? v : 0.f; }
    const float u = ii2 - bb; float pm = u;
#pragma unroll
    for (int o = 1; o < 64; o <<= 1) { const float v = __shfl_up(pm, o); pm = (lane >= o) ? fmaxf(pm, v) : pm; }
    float* gt = F.gt() + (size_t)job * 3 * 64 + lane;
    gt[0] = bb; gt[64] = u; gt[128] = pm;
}

__device__ __forceinline__ void mlstm_conv_rows(Frame& F) {
    const int tid = opq(F.tid), cg = tid & 255, z = cg >> 7, c0 = (cg & 127) * 8, r0 = F.vcu * 128 + 64 * (tid >> 8);
    const bf16* src = F.PROJ() + (size_t)(3 + z) * (SEG / 2) + c0; bf16* dst = (bf16*)F.out() + (size_t)z * T * D + c0;
    float w[4][8], bs[8];
#pragma unroll
    for (int tap = 0; tap < 4; ++tap) { const f32x4 a0 = *(const f32x4*)(F.conv_w() + tap * 2048 + cg * 8), a1 = *(const f32x4*)(F.conv_w() + tap * 2048 + cg * 8 + 4);
        w[tap][0] = a0.x; w[tap][1] = a0.y; w[tap][2] = a0.z; w[tap][3] = a0.w; w[tap][4] = a1.x; w[tap][5] = a1.y; w[tap][6] = a1.z; w[tap][7] = a1.w; }
    { const f32x4 a0 = *(const f32x4*)(F.conv_b() + cg * 8), a1 = *(const f32x4*)(F.conv_b() + cg * 8 + 4);
      bs[0] = a0.x; bs[1] = a0.y; bs[2] = a0.z; bs[3] = a0.w; bs[4] = a1.x; bs[5] = a1.y; bs[6] = a1.z; bs[7] = a1.w; }
    const float osc = z ? 0.0625f : 1.0f;
    const bool seq_start = (r0 % SEQ) == 0;
    v4u x0, x1, x2;
    { const v4u zero = {0u, 0u, 0u, 0u};
      x0 = seq_start ? zero : *(const v4u*)(src + (size_t)(r0 - 3 + (seq_start ? 3 : 0)) * D);
      x1 = seq_start ? zero : *(const v4u*)(src + (size_t)(r0 - 2 + (seq_start ? 2 : 0)) * D);
      x2 = seq_start ? zero : *(const v4u*)(src + (size_t)(r0 - 1 + (seq_start ? 1 : 0)) * D); }
    for (int rr = 0; rr < 64; rr += 8) {
        v4u xs[8];
#pragma unroll
        for (int i = 0; i < 8; ++i) xs[i] = *(const v4u*)(src + (size_t)(r0 + rr + i) * D);
#pragma unroll
        for (int i = 0; i < 8; ++i) {
            const v4u x3 = xs[i]; float y[8];
#pragma unroll
            for (int c = 0; c < 8; ++c) y[c] = bs[c];
#define MK_TAP(tap, X) do { y[0] += w[tap][0] * bflo(X.x); y[1] += w[tap][1] * bfhi(X.x); y[2] += w[tap][2] * bflo(X.y); y[3] += w[tap][3] * bfhi(X.y); \
                           y[4] += w[tap][4] * bflo(X.z); y[5] += w[tap][5] * bfhi(X.z); y[6] += w[tap][6] * bflo(X.w); y[7] += w[tap][7] * bfhi(X.w); } while (0)
            MK_TAP(0, x0); MK_TAP(1, x1); MK_TAP(2, x2); MK_TAP(3, x3);
#undef MK_TAP
#pragma unroll
            for (int c = 0; c < 8; ++c) y[c] = ml::silu_f(y[c]) * osc;
            v4u o; o.x = pk2(y[0], y[1]); o.y = pk2(y[2], y[3]); o.z = pk2(y[4], y[5]); o.w = pk2(y[6], y[7]);
            *(v4u*)(dst + (size_t)(r0 + rr + i) * D) = o;
            x0 = x1; x1 = x2; x2 = x3;
        }
    }
}

__device__ __forceinline__ void mlstm_norm_rows(Frame& F) {
    const int row0 = F.vcu * 128, lane = opq(F.lane);
    const bf16* MLO = F.PROJ() + 6 * (SEG / 2);
    f32x4 G[4];
#pragma unroll
    for (int j = 0; j < 4; ++j) G[j] = *(const f32x4*)(F.ml_norm_g() + 256 * j + 4 * lane);
    for (int r = 0; r < 16; ++r) {
        const size_t row = (size_t)row0 + 16 * F.wave + r;
        GAS unsigned long long* hp = (GAS unsigned long long*)(F.YB() + row * YP) + lane; const GAS unsigned long long* op = (const GAS unsigned long long*)(MLO + row * D) + lane;
#pragma unroll
        for (int j = 0; j < 4; ++j) { const unsigned long long hw = hp[64 * j], ow = op[64 * j];
            const float h0 = bflo((unsigned)hw), h1 = bfhi((unsigned)hw), h2 = bflo((unsigned)(hw >> 32)), h3 = bfhi((unsigned)(hw >> 32));
            const float ss = wave_sum((h0 * h0 + h1 * h1) + (h2 * h2 + h3 * h3)); const float rstd = 1.0f / sqrtf(ss * (1.0f / 256.0f) + EPS);
            const float o0 = bflo((unsigned)ow), o1 = bfhi((unsigned)ow), o2 = bflo((unsigned)(ow >> 32)), o3 = bfhi((unsigned)(ow >> 32));
            const float y0 = h0 * rstd * G[j].x / (1.0f + __expf(-o0)), y1 = h1 * rstd * G[j].y / (1.0f + __expf(-o1)), y2 = h2 * rstd * G[j].z / (1.0f + __expf(-o2)), y3 = h3 * rstd * G[j].w / (1.0f + __expf(-o3));
            hp[64 * j] = (unsigned long long)pk2(y0, y1) | ((unsigned long long)pk2(y2, y3) << 32); }
    }
}

namespace at {
using ml::bf16x8; using ml::s16x4; using ml::f32x16; using ml::ioff; using ml::frag_row; using ml::lcp; using ml::lp_t;
typedef _Float16 f16x8 __attribute__((ext_vector_type(8)));
typedef _Float16 f16x2 __attribute__((ext_vector_type(2)));
typedef float f32x2 __attribute__((ext_vector_type(2)));
constexpr int O_KI = 0, O_VI = 8192, O_FLAG = 16384;
template <int PITCH, int XM> __device__ __forceinline__ bf16x8 frag_trp(lcp img, int ks, int col0, int lane) {
    const int h = lane >> 5, blk = (lane >> 4) & 1, q = (lane & 15) >> 2, p = lane & 3;
    const int r0 = 16 * ks + 4 * h + q, ch = (col0 >> 3) + 2 * blk + (p >> 1);
    typedef short v4i16_t __attribute__((ext_vector_type(4)));
    const s16x4 a = __builtin_bit_cast(s16x4, __builtin_amdgcn_ds_read_tr16_b64_v4i16((LAS v4i16_t*)(img + ioff<PITCH, XM>(r0, ch) + 8 * (p & 1))));
    const s16x4 b = __builtin_bit_cast(s16x4, __builtin_amdgcn_ds_read_tr16_b64_v4i16((LAS v4i16_t*)(img + ioff<PITCH, XM>(r0 + 8, ch) + 8 * (p & 1))));
    return (bf16x8){a[0], a[1], a[2], a[3], b[0], b[1], b[2], b[3]};
}
__device__ __forceinline__ unsigned pkh(float a, float b) { const f32x2 v = {a, b}; return __builtin_bit_cast(unsigned, __builtin_convertvector(v, f16x2)); }
__device__ __forceinline__ f16x8 h8(unsigned a, unsigned b, unsigned c, unsigned d) { const v4u v = {a, b, c, d}; return __builtin_bit_cast(f16x8, v); }
__device__ __forceinline__ bf16x8 b8(unsigned a, unsigned b, unsigned c, unsigned d) { const v4u v = {a, b, c, d}; return __builtin_bit_cast(bf16x8, v); }

__device__ __forceinline__ void attn_unit(Frame& F, int bh, int qb) {
    const int b = bh >> 4, hd = bh & 15, tid = opq(F.tid), lane = opq(F.lane), wave = F.wave, hi = lane >> 5, l31 = lane & 31;
    const bf16* Q = F.PROJ(); const bf16* K = F.PROJ() + SEG / 2; const bf16* V = F.PROJ() + SEG;
    lp_t base = (lp_t)F.lds;
    LAS volatile int* dflag = (LAS volatile int*)(base + O_FLAG);
    const size_t rowb = (size_t)b * SEQ; const int q0 = qb * 256, tw0 = q0 + 32 * wave, t = tw0 + l31;
    bf16x8 qr[4];
#pragma unroll
    for (int ks = 0; ks < 4; ++ks) qr[ks] = *(const bf16x8*)(Q + (rowb + t) * D + hd * 64 + 16 * ks + 8 * hi);
    unsigned uw[2][4];
#pragma unroll
    for (int sp = 0; sp < 2; ++sp)
#pragma unroll
        for (int jj = 0; jj < 4; ++jj) { const int j0 = 2 * jj, j1 = 2 * jj + 1;
            const int k0 = 16 * sp + 8 * (j0 >> 2) + 4 * hi + (j0 & 3), k1 = 16 * sp + 8 * (j1 >> 2) + 4 * hi + (j1 & 3);
            uw[sp][jj] = (k0 > l31 ? 0x3C00u : 0u) | (k1 > l31 ? 0x3C000000u : 0u); }
    const f16x8 U0 = h8(uw[0][0], uw[0][1], uw[0][2], uw[0][3]), U1 = h8(uw[1][0], uw[1][1], uw[1][2], uw[1][3]), ONES = h8(0x3C003C00u, 0x3C003C00u, 0x3C003C00u, 0x3C003C00u);
    f32x16 O0, O1;
#pragma unroll
    for (int r = 0; r < 16; ++r) { O0[r] = 0.f; O1[r] = 0.f; }
    float R = 0.f; bool wdone = false;
    v4u kreg, vreg;
    { const size_t g = (rowb + (qb * 4 + 3) * 64 + (tid >> 3)) * D + hd * 64 + (tid & 7) * 8; kreg = *(const v4u*)(K + g); vreg = *(const v4u*)(V + g); }
    __syncthreads();
    if (tid < 8) dflag[tid] = 0;
    for (int kt = qb * 4 + 3; kt >= 0; --kt) {
        __syncthreads();
        { int nd = 0;
#pragma unroll
          for (int w = 0; w < 8; ++w) nd += dflag[w];
          if (nd == 8) break; }
        { const int kr = tid >> 3, ch = tid & 7;
          *(LAS v4u*)(base + O_KI + ioff<128, 7>(kr, ch)) = kreg;
          *(LAS v4u*)(base + O_VI + ioff<128, 7>(kr, ch)) = vreg; }
        __syncthreads();
        if (kt > 0) { const size_t g = (rowb + (kt - 1) * 64 + (tid >> 3)) * D + hd * 64 + (tid & 7) * 8; kreg = *(const v4u*)(K + g); vreg = *(const v4u*)(V + g); }
        if (64 * kt >= tw0 + 32) continue;
        if (wdone) continue;
        int lo = lane; asm volatile("" : "+v"(lo));
        f32x16 p0, p1;
#pragma unroll
        for (int r = 0; r < 16; ++r) { p0[r] = 0.f; p1[r] = 0.f; }
#pragma unroll
        for (int ks = 0; ks < 4; ++ks) { p0 = __builtin_amdgcn_mfma_f32_32x32x16_bf16(frag_row<128, 7>(base + O_KI, 0, ks, lo), qr[ks], p0, 0, 0, 0);
                                         p1 = __builtin_amdgcn_mfma_f32_32x32x16_bf16(frag_row<128, 7>(base + O_KI, 32, ks, lo), qr[ks], p1, 0, 0, 0); }
        const bool diag = (64 * kt + 63 >= tw0);
        const int trel = t - 64 * kt;
        float lk00 = 0.f;
        unsigned lkw0[8], lkw1[8];
#pragma unroll
        for (int r = 0; r < 16; ++r) {
            const int key0 = ml::crow(r, hi);
            { const float z = p0[r], lb = fminf(z, 0.f) - __builtin_amdgcn_logf(1.0f + __builtin_amdgcn_exp2f(-fabsf(z))); float lk = lb - z; if (diag && !(key0 < trel)) lk = 0.f; p0[r] = lb; if (r == 0) lk00 = lk;
              if (r & 1) lkw0[r >> 1] = pkh(__builtin_bit_cast(float, lkw0[r >> 1]), lk); else lkw0[r >> 1] = __builtin_bit_cast(unsigned, lk); }
            { const float z = p1[r], lb = fminf(z, 0.f) - __builtin_amdgcn_logf(1.0f + __builtin_amdgcn_exp2f(-fabsf(z))); float lk = lb - z; if (diag && !(key0 + 32 < trel)) lk = 0.f; p1[r] = lb;
              if (r & 1) lkw1[r >> 1] = pkh(__builtin_bit_cast(float, lkw1[r >> 1]), lk); else lkw1[r >> 1] = __builtin_bit_cast(unsigned, lk); }
        }
        f32x16 bt1, bt0;
#pragma unroll
        for (int r = 0; r < 16; ++r) { bt1[r] = R; bt0[r] = R; }
        const f16x8 L10 = h8(lkw1[0], lkw1[1], lkw1[2], lkw1[3]), L11 = h8(lkw1[4], lkw1[5], lkw1[6], lkw1[7]), L00 = h8(lkw0[0], lkw0[1], lkw0[2], lkw0[3]), L01 = h8(lkw0[4], lkw0[5], lkw0[6], lkw0[7]);
        bt1 = __builtin_amdgcn_mfma_f32_32x32x16_f16(U0, L10, bt1, 0, 0, 0); bt1 = __builtin_amdgcn_mfma_f32_32x32x16_f16(U1, L11, bt1, 0, 0, 0);
        bt0 = __builtin_amdgcn_mfma_f32_32x32x16_f16(ONES, L10, bt0, 0, 0, 0); bt0 = __builtin_amdgcn_mfma_f32_32x32x16_f16(ONES, L11, bt0, 0, 0, 0);
        bt0 = __builtin_amdgcn_mfma_f32_32x32x16_f16(U0, L00, bt0, 0, 0, 0); bt0 = __builtin_amdgcn_mfma_f32_32x32x16_f16(U1, L01, bt0, 0, 0, 0);
        { const float v = bt0[0] + lk00;
          const auto rr = __builtin_amdgcn_permlane32_swap(__builtin_bit_cast(unsigned, v), __builtin_bit_cast(unsigned, v), false, false);
          R = __builtin_bit_cast(float, rr[0]); }
        unsigned aw0[8], aw1[8];
#pragma unroll
        for (int r = 0; r < 16; r += 2) {
            const int key0 = ml::crow(r, hi);
            float a00 = __builtin_amdgcn_exp2f(p0[r] + bt0[r]), a01 = __builtin_amdgcn_exp2f(p0[r + 1] + bt0[r + 1]), a10 = __builtin_amdgcn_exp2f(p1[r] + bt1[r]), a11 = __builtin_amdgcn_exp2f(p1[r + 1] + bt1[r + 1]);
            if (diag) { if (!(key0 < trel)) a00 = 0.f; if (!(key0 + 1 < trel)) a01 = 0.f; if (!(key0 + 32 < trel)) a10 = 0.f; if (!(key0 + 33 < trel)) a11 = 0.f; }
            aw0[r >> 1] = pk2(a00, a01); aw1[r >> 1] = pk2(a10, a11);
        }
        const bf16x8 A00 = b8(aw0[0], aw0[1], aw0[2], aw0[3]), A01 = b8(aw0[4], aw0[5], aw0[6], aw0[7]), A10 = b8(aw1[0], aw1[1], aw1[2], aw1[3]), A11 = b8(aw1[4], aw1[5], aw1[6], aw1[7]);
        O0 = __builtin_amdgcn_mfma_f32_32x32x16_bf16(A00, frag_trp<128, 7>(base + O_VI, 0, 0, lo), O0, 0, 0, 0);  O1 = __builtin_amdgcn_mfma_f32_32x32x16_bf16(A00, frag_trp<128, 7>(base + O_VI, 0, 32, lo), O1, 0, 0, 0);
        O0 = __builtin_amdgcn_mfma_f32_32x32x16_bf16(A01, frag_trp<128, 7>(base + O_VI, 1, 0, lo), O0, 0, 0, 0);  O1 = __builtin_amdgcn_mfma_f32_32x32x16_bf16(A01, frag_trp<128, 7>(base + O_VI, 1, 32, lo), O1, 0, 0, 0);
        O0 = __builtin_amdgcn_mfma_f32_32x32x16_bf16(A10, frag_trp<128, 7>(base + O_VI, 2, 0, lo), O0, 0, 0, 0);  O1 = __builtin_amdgcn_mfma_f32_32x32x16_bf16(A10, frag_trp<128, 7>(base + O_VI, 2, 32, lo), O1, 0, 0, 0);
        O0 = __builtin_amdgcn_mfma_f32_32x32x16_bf16(A11, frag_trp<128, 7>(base + O_VI, 3, 0, lo), O0, 0, 0, 0);  O1 = __builtin_amdgcn_mfma_f32_32x32x16_bf16(A11, frag_trp<128, 7>(base + O_VI, 3, 32, lo), O1, 0, 0, 0);
        if (__all(R < ATT_RTHR)) { wdone = true; if (lane == 0) dflag[wave] = 1; }
    }
    __syncthreads();
    bf16* dst = F.YA() + (rowb + tw0) * YP + hd * 64 + l31;
#pragma unroll
    for (int r = 0; r < 16; ++r) { const int q = ml::crow(r, hi); dst[(size_t)q * YP] = (bf16)pk2(O0[r], 0.f); dst[(size_t)q * YP + 32] = (bf16)pk2(O1[r], 0.f); }
}
}

__device__ __forceinline__ void p5a_route(Frame& F) {
    const int row0 = F.vcu * 128, b = row0 / SEQ, lane = opq(F.lane), tid = opq(F.tid);
    LAS float* wr = (LAS float*)F.lds;
    LAS int* le = (LAS int*)(F.lds + 131584); LAS int* lp = le + 512;
    LAS int* lcnt = (LAS int*)(F.LC + LC_LCNT); LAS int* gbase = (LAS int*)(F.LC + LC_GBASE);
    for (int idx = tid; idx < 32768; idx += 512) wr[(idx & 31) * 1028 + (idx >> 5)] = F.router_w()[idx];
    if (tid < 32) lcnt[tid] = 0;
    f32x4 Av[4], Bv[4];
#pragma unroll
    for (int j = 0; j < 4; ++j) { const int col = 4 * lane + 256 * j; const float* mb = F.mod() + (size_t)b * NMOD;
        const f32x4 g = *(const f32x4*)(F.norm2_g() + col); Av[j] = g * (*(const f32x4*)(mb + 4 * D + col) + 1.0f); Bv[j] = *(const f32x4*)(mb + 3 * D + col); }
    float rb[32];
#pragma unroll
    for (int e = 0; e < 32; ++e) rb[e] = F.router_b()[e];
    __syncthreads();
    for (int r = 0; r < 16; ++r) {
        const int rl = 16 * F.wave + r, row = row0 + rl;
        const GAS f32x4* xr = (const GAS f32x4*)(F.out() + (size_t)row * D) + lane;
        f32x4 v[4]; float ss = 0.f;
#pragma unroll
        for (int j = 0; j < 4; ++j) { v[j] = xr[64 * j]; ss += (v[j].x * v[j].x + v[j].y * v[j].y) + (v[j].z * v[j].z + v[j].w * v[j].w); }
        const float rstd = 1.0f / sqrtf(wave_sum(ss) * (1.0f / D) + EPS);
        { GAS unsigned long long* o8 = (GAS unsigned long long*)(F.H2() + (size_t)row * D) + lane;
#pragma unroll
          for (int j = 0; j < 4; ++j) { v[j] = v[j] * rstd * Av[j] + Bv[j]; o8[64 * j] = (unsigned long long)pk2(v[j].x, v[j].y) | ((unsigned long long)pk2(v[j].z, v[j].w) << 32); } }
        float p[32];
#pragma unroll
        for (int e = 0; e < 32; ++e) { float s = 0.f;
#pragma unroll
            for (int j = 0; j < 4; ++j) { const f32x4 w = *(const LAS f32x4*)(wr + e * 1028 + 4 * lane + 256 * j); s += (v[j].x * w.x + v[j].y * w.y) + (v[j].z * w.z + v[j].w * w.w); }
            p[e] = s; }
#pragma unroll
        for (int e = 0; e < 32; ++e) p[e] = wave_sum(p[e]) + rb[e];
        int sel[4]; float sv[4]; unsigned used = 0u;
#pragma unroll
        for (int k = 0; k < 4; ++k) { float best = -3.0e38f; int bi = 0;
#pragma unroll
            for (int e = 0; e < 32; ++e) { const bool cnd = (((used >> e) & 1u) == 0u) && (p[e] > best); best = cnd ? p[e] : best; bi = cnd ? e : bi; }
            sel[k] = bi; sv[k] = best; used |= 1u << bi; }
        const float e1 = __expf(sv[1] - sv[0]), e2 = __expf(sv[2] - sv[0]), e3 = __expf(sv[3] - sv[0]), inv = 1.0f / (1.0f + e1 + e2 + e3);
        if (lane < 4) { const int ek = lane == 0 ? sel[0] : lane == 1 ? sel[1] : lane == 2 ? sel[2] : sel[3];
            const float wk = (lane == 0 ? 1.0f : lane == 1 ? e1 : lane == 2 ? e2 : e3) * inv;
            const int pos = __hip_atomic_fetch_add(lcnt + ek, 1, __ATOMIC_RELAXED, __HIP_MEMORY_SCOPE_WORKGROUP);
            le[rl * 4 + lane] = ek; lp[rl * 4 + lane] = pos; F.tokw()[(size_t)row * 4 + lane] = wk; }
        if (lane == 0) F.rstd2()[row] = rstd;
    }
    __syncthreads();
    if (tid < 32) gbase[tid] = (int)__hip_atomic_fetch_add(F.ctl + CW_ECNT + 64 * tid, (unsigned)lcnt[tid], __ATOMIC_RELAXED, __HIP_MEMORY_SCOPE_AGENT);
    __syncthreads();
    { const int ek = le[tid]; F.toke()[(size_t)row0 * 4 + tid] = ek; F.tokp()[(size_t)row0 * 4 + tid] = lp[tid] + gbase[ek]; }
}

__device__ __forceinline__ void p5b_tables(Frame& F) {
    const int row0 = F.vcu * 128, tid = opq(F.tid);
    LAS int* ts = (LAS int*)(F.LC + LC_TS); LAS int* ps = (LAS int*)(F.LC + LC_PS); LAS int* cn = (LAS int*)(F.LC + LC_CNT);
    if (tid < 32) cn[tid] = (int)__hip_atomic_load(F.ctl + CW_ECNT + 64 * tid, RLX_AGENT);
    __syncthreads();
    if (tid == 0) { int run = 0, trun = 0; for (int e = 0; e < 32; ++e) { ps[e] = run; ts[e] = trun; const int nt = (cn[e] + 255) >> 8; run += nt * 256; trun += nt; } ts[32] = trun; }
    __syncthreads();
    { const size_t idx = (size_t)row0 * 4 + tid; const int ek = F.toke()[idx], dst = ps[ek] + F.tokp()[idx]; F.tokrow()[idx] = dst; F.row2tok()[dst] = row0 + (tid >> 2); }
    if (F.vcu < 32) { const int e = F.vcu, start = ps[e] + cn[e], end = ps[e] + (((cn[e] + 255) >> 8) << 8); for (int r = start + tid; r < end; r += 512) F.row2tok()[r] = 0; }
}

__device__ __forceinline__ void p8_combine(Frame& F, bool poison) {
    const int row0 = F.vcu * 128, b = row0 / SEQ, lane = opq(F.lane);
    f32x4 G2[4], FG[4];
#pragma unroll
    for (int j = 0; j < 4; ++j) { const int col = 4 * lane + 256 * j; G2[j] = *(const f32x4*)(F.mod() + (size_t)b * NMOD + 5 * D + col); FG[j] = *(const f32x4*)(F.final_g() + col); }
    for (int r = 0; r < 16; ++r) {
        const int row = row0 + 16 * F.wave + r;
        GAS f32x4* xr = (GAS f32x4*)(F.out() + (size_t)row * D) + lane;
        f32x4 y[4];
#pragma unroll
        for (int j = 0; j < 4; ++j) y[j] = (f32x4){0.f, 0.f, 0.f, 0.f};
#pragma unroll
        for (int k = 0; k < 4; ++k) { const int src = F.tokrow()[(size_t)row * 4 + k]; const float wk = F.tokw()[(size_t)row * 4 + k];
            const GAS unsigned long long* s8 = (const GAS unsigned long long*)(F.OUTR() + (size_t)src * D) + lane;
#pragma unroll
            for (int j = 0; j < 4; ++j) { const unsigned long long w = s8[64 * j]; y[j].x += wk * bflo((unsigned)w); y[j].y += wk * bfhi((unsigned)w); y[j].z += wk * bflo((unsigned)(w >> 32)); y[j].w += wk * bfhi((unsigned)(w >> 32)); } }
        f32x4 v[4]; float ss = 0.f;
#pragma unroll
        for (int j = 0; j < 4; ++j) { v[j] = xr[64 * j] + G2[j] * y[j]; ss += (v[j].x * v[j].x + v[j].y * v[j].y) + (v[j].z * v[j].z + v[j].w * v[j].w); }
        const float rstd = 1.0f / sqrtf(wave_sum(ss) * (1.0f / D) + EPS);
        const float qn = __builtin_nanf("");
#pragma unroll
        for (int j = 0; j < 4; ++j) { f32x4 o = v[j] * rstd * FG[j]; if (poison) o = (f32x4){qn, qn, qn, qn}; xr[64 * j] = o; }
    }
}

#ifndef MK_REP_G2
#define MK_REP_G2 1
#endif
#ifndef MK_REP_G4A
#define MK_REP_G4A 1
#endif
#ifndef MK_REP_G4C
#define MK_REP_G4C 1
#endif
#ifndef MK_REP_G6
#define MK_REP_G6 1
#endif
#ifndef MK_REP_G7
#define MK_REP_G7 1
#endif
#ifndef MK_REP_P0
#define MK_REP_P0 1
#endif
#ifndef MK_REP_P3
#define MK_REP_P3 1
#endif
struct Args { const float* in[22]; float* out; unsigned char* ws; };
__global__ void __launch_bounds__(NWAVES * 64, 2) mk_fwd(Args args) {
    extern __shared__ __attribute__((aligned(16))) unsigned char lds[];
    Frame F;
    F.lds = (LAS unsigned char*)lds; F.LC = (volatile LAS unsigned*)(F.lds + LDSCTL_OFF);
    F.tid = threadIdx.x; F.lane = F.tid & 63; F.wave = __builtin_amdgcn_readfirstlane(F.tid >> 6);
    F.G = gridDim.x; { const int bx = blockIdx.x; F.vcu = (F.G % 8 == 0) ? (bx % 8) * (F.G / 8) + bx / 8 : bx; }
    F.ws = (unsigned char*)(GAS unsigned char*)karg(23);
    F.ctl = (gu32*)(F.ws + WS_CTL);
    for (int u = F.tid; u < (LDS_BYTES - LDSCTL_OFF) / 4; u += NWAVES * 64) ((LAS unsigned*)(F.lds + LDSCTL_OFF))[u] = 0u;
    __syncthreads();
    XcdBarrier bar = xcd_barrier_post((unsigned*)(F.ctl + CW_BAR), F.LC + LC_BAR);
#define GRID_BAR() xcd_barrier(bar)
    const int G = F.G, cid = (int)blockIdx.x;

    for (int rep_ = 0; rep_ < MK_REP_P0; ++rep_) p0_prologue(F);
    GRID_BAR();
    p1_rows(F);
    GRID_BAR();
    { pg8::Gemm g{F.H1(), F.WIN_T(), T, NPROJ, D}; pg8::StaticOrder S; S.init(T, NPROJ, G, cid);
      pg8::EpiBf16<0> E{F.PROJ(), D, nullptr, D, SEG / 2, QSCALE};
      for (int rep_ = 0; rep_ < MK_REP_G2; ++rep_) pg8::gemm_phase<pg8::EpiBf16<0>, pg8::StaticOrder, true, true>(F.lds, g, S, E); }
    GRID_BAR();
    for (int job = F.vcu * NWAVES + F.wave; job < BATCH * 4 * (SEQ / 64); job += G * NWAVES) mlstm_gates(F, job);
    mlstm_conv_rows(F);
    GRID_BAR();
    for (int it = F.vcu; it < 256; it += G) ml::mlstm_unit(F, it);
    __syncthreads();
    for (int it = F.vcu; it < 2048; it += G) at::attn_unit(F, it & 255, it >> 8);
    GRID_BAR();
    mlstm_norm_rows(F);
    GRID_BAR();
    { pg8::Gemm g{F.YA(), F.WAB_T(), T, D, 2 * D}; pg8::StaticOrder S; S.init(T, D, G, cid);
      pg8::EpiMerge E{F.PROJ() + 7 * (SEG / 2), F.PROJ() + 8 * (SEG / 2), F.MERGED()};
      for (int rep_ = 0; rep_ < MK_REP_G4A; ++rep_) pg8::gemm_phase<pg8::EpiMerge, pg8::StaticOrder, true, true, false, true>(F.lds, g, S, E); }
    GRID_BAR();
    { pg8::Gemm g{F.MERGED(), F.WOUT_T(), T, D, D}; pg8::StaticOrder S; S.init(T, D, G, cid);
      pg8::EpiResid E{F.x(), F.mod() + 2 * D, F.out(), SEQ, NMOD};
      for (int rep_ = 0; rep_ < MK_REP_G4C; ++rep_) pg8::gemm_phase<pg8::EpiResid, pg8::StaticOrder, true, true>(F.lds, g, S, E); }
    GRID_BAR();
    p5a_route(F);
    GRID_BAR();
    p5b_tables(F);
    GRID_BAR();
    { pg8::Gemm g{F.H2(), F.W1_T(), T, NE * 2048, D}; pg8::GroupedOrder S{(const LAS int*)(F.LC + LC_TS), 8, G, cid, F.row2tok()};
      pg8::EpiSwiglu E{F.b1(), F.ACT()};
      for (int rep_ = 0; rep_ < MK_REP_G6; ++rep_) pg8::gemm_phase<pg8::EpiSwiglu, pg8::GroupedOrder, true, true, true>(F.lds, g, S, E); }
    GRID_BAR();
    { pg8::Gemm g{F.ACT(), F.W2_T(), XS_ROWS, NE * 1024, D}; pg8::GroupedOrder S{(const LAS int*)(F.LC + LC_TS), 4, G, cid, nullptr};
      pg8::EpiBf16<0> E{F.OUTR(), D, F.b2(), D, 0, 1.0f};
      for (int rep_ = 0; rep_ < MK_REP_G7; ++rep_) pg8::gemm_phase<pg8::EpiBf16<0>, pg8::GroupedOrder, true, true>(F.lds, g, S, E); }
    GRID_BAR();
    { const bool poison = __hip_atomic_load(F.ctl + CW_BAR + XB_TMO, RLX_AGENT) != 0u;
      p8_combine(F, poison); }
}

extern "C" void kernel_launch(void* const* d_in, const int* in_sizes, int n_in, void* d_out, int out_size, void* d_ws, size_t ws_size, hipStream_t stream) {
    static int grid = 0;
    if (grid == 0) {
        if (n_in != 22 || in_sizes[0] != T * D || out_size != T * D || ws_size < WS_END) { fprintf(stderr, "kernel_launch: unexpected shapes (n_in %d, in0 %d, out %d, ws %zu)\n", n_in, n_in > 0 ? in_sizes[0] : -1, out_size, ws_size); grid = -1; return; }
        int dev = 0, cus = 0, per_cu = 0;
        if (hipGetDevice(&dev) != hipSuccess || hipDeviceGetAttribute(&cus, hipDeviceAttributeMultiprocessorCount, dev) != hipSuccess) { grid = -1; return; }
        if (hipFuncSetAttribute((const void*)mk_fwd, hipFuncAttributeMaxDynamicSharedMemorySize, LDS_BYTES) != hipSuccess) { fprintf(stderr, "kernel_launch: hipFuncSetAttribute failed\n"); grid = -1; return; }
        if (hipOccupancyMaxActiveBlocksPerMultiprocessor(&per_cu, (const void*)mk_fwd, NWAVES * 64, LDS_BYTES) != hipSuccess || per_cu < 1) { fprintf(stderr, "kernel_launch: occupancy query says %d blocks per CU\n", per_cu); }
        (void)hipGetLastError();
        if (cus < 256) { fprintf(stderr, "kernel_launch: built for a 256-CU device, found %d CUs\n", cus); grid = -1; return; }
        grid = 256;
    }
    if (grid < 0) return;
    if (hipMemsetAsync((char*)d_ws + WS_CTL, 0, CTL_ZERO_BYTES, stream) != hipSuccess) return;
    Args a{};
    for (int i = 0; i < 22; ++i) a.in[i] = (const float*)d_in[i];
    a.out = (float*)d_out; a.ws = (unsigned char*)d_ws;
    hipLaunchKernelGGL(mk_fwd, dim3(grid), dim3(NWAVES * 64), LDS_BYTES, stream, a);
}
```

```cpp
#include <hip/hip_runtime.h>
#include <cstdio>
#include <cstdint>
namespace pg8 {
#define PG8_LAS __attribute__((address_space(3)))
typedef unsigned short bf16_t;
typedef short bf16x8 __attribute__((ext_vector_type(8)));
typedef float f32x4 __attribute__((ext_vector_type(4)));
typedef unsigned u32x4 __attribute__((ext_vector_type(4)));
constexpr int BM = 256, BK = 64, HALF = 128, HTB = HALF * BK * 2  , STAGE_BYTES = 8 * HTB, NXCD = 8, WGM = 8;

__host__ __device__ __forceinline__ int lds_byte(int r, int c) { const int st = (r >> 4) * 2 + (c >> 5), rr = r & 15, cc = c & 31, ob = rr * 64 + cc * 2; return st * 1024 + (ob ^ (((ob >> 9) & 1) << 5)); }
__host__ __device__ __forceinline__ void stage_rc(int b, int& R, int& C) { const int st = b / 1024, sb = b % 1024, swz = sb ^ (((sb >> 9) & 1) << 5); R = (st >> 1) * 16 + swz / 64; C = (st & 1) * 32 + (swz % 64) / 2; }
__host__ __device__ __forceinline__ int perm32(int rho) { const int n = rho >> 4, i = rho & 15; return 8 * (i >> 2) + 4 * n + (i & 3); }

struct Unit { int pm, pn; };
struct Gemm { const bf16_t* A; const bf16_t* Bt; int M, N, K; };

struct StaticOrder {
    int nM, nN, nwg, G, c;
    __host__ __device__ void init(int M, int N, int G_, int c_) { nM = M / BM; nN = N / BM; nwg = nM * nN; G = G_; c = c_; }
    __host__ __device__ bool next(int i, Unit& u) const {
        const long L = (long)i * G + c; if (L >= nwg) return false;
        int wgid = (int)L; { const int q = nwg / NXCD, r = nwg % NXCD, xcd = wgid % NXCD, off = wgid / NXCD; wgid = (xcd < r ? xcd * (q + 1) : r * (q + 1) + (xcd - r) * q) + off; }
        const int nig = WGM * nN, gid = wgid / nig, fm = gid * WGM, gsz = (nM - fm) < WGM ? (nM - fm) : WGM;
        u.pm = fm + ((wgid % nig) % gsz); u.pn = (wgid % nig) / gsz; return true;
    }
    __device__ __forceinline__ void a_ready(const Unit&) const {}
    __device__ __forceinline__ void done(const Unit&) const {}
};

__device__ __forceinline__ unsigned cvt_pk_bf16(float lo, float hi) { unsigned r; asm volatile("v_cvt_pk_bf16_f32 %0, %1, %2" : "=v"(r) : "v"(lo), "v"(hi)); return r; }
typedef float f32x2 __attribute__((ext_vector_type(2)));
__device__ __forceinline__ f32x2 gelu_pk(f32x2 v) {
    const f32x2 av = __builtin_elementwise_abs(v), d = av * 0.2316418882f + 1.0f;
    f32x2 t; t.x = __builtin_amdgcn_rcpf(d.x); t.y = __builtin_amdgcn_rcpf(d.y);
    f32x2 q = t * 0.5307027145f + (-0.7265760135f); q = q * t + 0.7107068705f; q = q * t + (-0.142248368f); q = q * t + 0.127414796f; q = q * t;
    const f32x2 s = (v * v) * (-0.72134752044f);
    f32x2 e; e.x = __builtin_amdgcn_exp2f(s.x); e.y = __builtin_amdgcn_exp2f(s.y);
    const f32x2 m = v * (q * e), r = v - m;
    f32x2 o; o.x = v.x < 0.f ? m.x : r.x; o.y = v.y < 0.f ? m.y : r.y; return o;
}

template <int ACT  > struct EpiBf16 {
    static constexpr bool PERM = true, AFTER_DRAIN = false; static_assert(ACT == 0 || ACT == 1, "EpiBf16: ACT is 0 (none) or 1 (gelu_pk)");
    bf16_t* O; int ldc; const float* bias; int split_cols; size_t split_stride; float scale0;
    __device__ __forceinline__ void operator()(const f32x4 (&acc)[2][2][4][2], const Unit& u, int wr, int wc, int fr, int fq) const {
        const int row0 = u.pm * BM + wr * 64 + fr; int colt = u.pn * BM; bf16_t* base = O;
        float sc = 1.f; if (split_cols) { const int t = colt / split_cols; base += (size_t)t * split_stride; colt -= t * split_cols; if (t == 0) sc = scale0; }
        const int col0 = colt + wc * 32 + 8 * fq, bcol0 = u.pn * BM + wc * 32 + 8 * fq;
        f32x4 bv[2][2];
#pragma unroll
        for (int bj = 0; bj < 2; ++bj)
#pragma unroll
            for (int n = 0; n < 2; ++n) bv[bj][n] = bias ? *(const f32x4*)(bias + bcol0 + bj * HALF + 4 * n) : (f32x4){0.f, 0.f, 0.f, 0.f};
#pragma unroll
        for (int ai = 0; ai < 2; ++ai)
#pragma unroll
            for (int m = 0; m < 4; ++m) { bf16_t* rowp = base + (size_t)(row0 + ai * HALF + m * 16) * ldc + col0;
#pragma unroll
                for (int bj = 0; bj < 2; ++bj) { f32x4 v0 = acc[ai][bj][m][0] + bv[bj][0], v1 = acc[ai][bj][m][1] + bv[bj][1];
                    if (ACT == 1) { f32x2 a = gelu_pk((f32x2){v0[0], v0[1]}), b = gelu_pk((f32x2){v0[2], v0[3]}), c = gelu_pk((f32x2){v1[0], v1[1]}), d = gelu_pk((f32x2){v1[2], v1[3]});
                        v0 = (f32x4){a.x, a.y, b.x, b.y}; v1 = (f32x4){c.x, c.y, d.x, d.y}; }
                    v0 = v0 * sc; v1 = v1 * sc; u32x4 w; w.x = cvt_pk_bf16(v0[0], v0[1]); w.y = cvt_pk_bf16(v0[2], v0[3]); w.z = cvt_pk_bf16(v1[0], v1[1]); w.w = cvt_pk_bf16(v1[2], v1[3]);
                    *(u32x4*)(rowp + bj * HALF) = w; } }
    }
};
template <class Epi, class Sched, bool ALIGN_EPI = false, bool SP2 = false, bool GATHER = false>
__device__ __forceinline__ void gemm_phase(PG8_LAS unsigned char* lds, const Gemm g, const Sched& S, const Epi& E) {
    int tid_ = threadIdx.x; asm volatile("" : "+v"(tid_));
    const int tid = tid_, wid = __builtin_amdgcn_readfirstlane(tid >> 6), lane = tid & 63, wr = wid >> 2, wc = wid & 3, fr = lane & 15, fq = lane >> 4;
    const int K = g.K, nt = K / BK;
    unsigned voffA[2], voffB[2], vA0[2], vA1[2], vN0[2], vN1[2]; int Rr_[2], Cc_[2];
#pragma unroll
    for (int i = 0; i < 2; ++i) { int R, C; stage_rc(tid * 16 + i * 8192, R, C); const int Rb = Epi::PERM ? ((R & ~31) + perm32(R & 31)) : R;
        voffA[i] = (unsigned)(R * K + C) * 2u; voffB[i] = (unsigned)(Rb * K + C) * 2u; Rr_[i] = R; Cc_[i] = C; }
    const size_t kstep = (size_t)(BK * 2);
    const size_t hstep = (size_t)HALF * K * 2;
    const size_t tstep = 2 * hstep;
#pragma unroll
    for (int i = 0; i < 2; ++i) { vA0[i] = voffA[i]; vA1[i] = voffA[i] + (unsigned)hstep; vN0[i] = vA0[i]; vN1[i] = vA1[i]; }
#define PG8_GLOAD(u, v0, v1) do { _Pragma("unroll") for (int _i = 0; _i < 2; ++_i) { const int _t0 = S.rowtok[(u).pm * BM + Rr_[_i]], _t1 = S.rowtok[(u).pm * BM + HALF + Rr_[_i]]; \
        (v0)[_i] = (unsigned)_t0 * (unsigned)(K * 2) + (unsigned)(Cc_[_i] * 2); (v1)[_i] = (unsigned)_t1 * (unsigned)(K * 2) + (unsigned)(Cc_[_i] * 2); } } while (0)
    const unsigned ldsw = (unsigned)wid * 1024u;
    const int aoff = lds_byte(wr * 64 + fr, fq * 8), boff = lds_byte(wc * 32 + fr, fq * 8);
#define PG8_SA(b, h) (((b) * 2 + (h)) * HTB)
#define PG8_SB(b, h) ((4 + (b) * 2 + (h)) * HTB)
#define PG8_STAGE(bufoff, gbase, voff) do { _Pragma("unroll") for (int _i = 0; _i < 2; ++_i) \
        __builtin_amdgcn_global_load_lds((const unsigned*)((const char*)(gbase) + (voff)[_i]), (PG8_LAS unsigned*)(lds + (bufoff) + ldsw + _i * 8192), 16, 0, 0); } while (0)
#define PG8_LDA(dst, b, h) do { _Pragma("unroll") for (int m = 0; m < 4; ++m) _Pragma("unroll") for (int k = 0; k < 2; ++k) dst[m][k] = *(const PG8_LAS bf16x8*)(lds + PG8_SA(b, h) + aoff + m * 2048 + k * 1024); } while (0)
#define PG8_LDB(dst, b, h) do { _Pragma("unroll") for (int n = 0; n < 2; ++n) _Pragma("unroll") for (int k = 0; k < 2; ++k) dst[n][k] = *(const PG8_LAS bf16x8*)(lds + PG8_SB(b, h) + boff + n * 2048 + k * 1024); } while (0)
#define PG8_MMA(ai, bj, At, Bt) do { __builtin_amdgcn_s_setprio(1); _Pragma("unroll") for (int m = 0; m < 4; ++m) _Pragma("unroll") for (int n = 0; n < 2; ++n) _Pragma("unroll") for (int k = 0; k < 2; ++k) \
        acc[ai][bj][m][n] = __builtin_amdgcn_mfma_f32_16x16x32_bf16(Bt[n][k], At[m][k], acc[ai][bj][m][n], 0, 0, 0); __builtin_amdgcn_s_setprio(0); } while (0)
#define PG8_WAIT_V(n) asm volatile("s_waitcnt vmcnt(" #n ")" ::: "memory")
#define PG8_WAIT_L(n) asm volatile("s_waitcnt lgkmcnt(" #n ")" ::: "memory")
#define PG8_BAR __builtin_amdgcn_s_barrier()
#define PG8_SCHED __builtin_amdgcn_sched_barrier(0)
    Unit cur, nxt; int ui = 0;
    if (!S.next(0, cur)) return;
    f32x4 acc[2][2][4][2];
#pragma unroll
    for (int a = 0; a < 2; ++a)
#pragma unroll
        for (int b = 0; b < 2; ++b)
#pragma unroll
            for (int m = 0; m < 4; ++m)
#pragma unroll
                for (int n = 0; n < 2; ++n) acc[a][b][m][n] = (f32x4){0.f, 0.f, 0.f, 0.f};
    bf16x8 At[4][2], B0[2][2], B1[2][2];
    if constexpr (GATHER) PG8_GLOAD(cur, vA0, vA1);
    const char* cA = GATHER ? (const char*)g.A : (const char*)g.A + (size_t)cur.pm * tstep; const char* cB = (const char*)g.Bt + (size_t)cur.pn * tstep;
    S.a_ready(cur);
    if constexpr (SP2) {
        PG8_STAGE(PG8_SB(0, 0), cB, voffB); PG8_STAGE(PG8_SB(0, 1), cB + hstep, voffB); PG8_STAGE(PG8_SA(0, 0), cA, vA0); PG8_STAGE(PG8_SA(0, 1), cA, vA1);
        if (wr == 1) PG8_BAR;
        PG8_WAIT_V(2); PG8_BAR;
        PG8_STAGE(PG8_SB(1, 0), cB + kstep, voffB); PG8_STAGE(PG8_SA(1, 0), cA + kstep, vA0); PG8_STAGE(PG8_SB(1, 1), cB + hstep + kstep, voffB);
        PG8_WAIT_V(6); PG8_BAR;
    } else {
        PG8_STAGE(PG8_SB(0, 0), cB, voffB); PG8_STAGE(PG8_SA(0, 0), cA, vA0); PG8_STAGE(PG8_SB(0, 1), cB + hstep, voffB); PG8_STAGE(PG8_SA(0, 1), cA, vA1);
        if (wr == 1) PG8_BAR;
        PG8_WAIT_V(4); PG8_BAR;
        PG8_STAGE(PG8_SB(1, 0), cB + kstep, voffB); PG8_STAGE(PG8_SA(1, 0), cA + kstep, vA0); PG8_STAGE(PG8_SB(1, 1), cB + hstep + kstep, voffB);
        PG8_WAIT_V(6); PG8_BAR;
    }
    for (;;) {
        const bool has_next = S.next(ui + 1, nxt);
        if constexpr (GATHER) { if (has_next) PG8_GLOAD(nxt, vN0, vN1); else { _Pragma("unroll") for (int i = 0; i < 2; ++i) { vN0[i] = vA0[i]; vN1[i] = vA1[i]; } } }
        const char* nA = GATHER ? (const char*)g.A : (has_next ? (const char*)g.A + (size_t)nxt.pm * tstep : cA); const char* nB = has_next ? (const char*)g.Bt + (size_t)nxt.pn * tstep : cB;
        for (int t = 0; t < nt; t += 2) {
            const bool last = (t == nt - 2);
            const char* a1 = cA + (size_t)(t + 1) * kstep;
            const char* a2 = last ? nA : cA + (size_t)(t + 2) * kstep; const char* b2 = last ? nB : cB + (size_t)(t + 2) * kstep;
            const char* a3 = a2 + kstep; const char* b3 = b2 + kstep;
            unsigned vX0[2], vX1[2];
#pragma unroll
            for (int i = 0; i < 2; ++i) { vX0[i] = (GATHER && last) ? vN0[i] : vA0[i]; vX1[i] = (GATHER && last) ? vN1[i] : vA1[i]; }
            if (last && has_next) S.a_ready(nxt);
            if constexpr (SP2) {
            PG8_LDB(B0, 0, 0); PG8_LDB(B1, 0, 1); PG8_SCHED; PG8_LDA(At, 0, 0); PG8_STAGE(PG8_SA(1, 1), a1, vA1);
            PG8_WAIT_V(8); PG8_WAIT_L(0); PG8_BAR; PG8_MMA(0, 0, At, B0); PG8_MMA(0, 1, At, B1); PG8_BAR; PG8_SCHED;
            PG8_LDA(At, 0, 1); PG8_STAGE(PG8_SB(0, 0), b2, voffB); PG8_STAGE(PG8_SB(0, 1), b2 + hstep, voffB); PG8_STAGE(PG8_SA(0, 0), a2, vX0);
            PG8_WAIT_V(8); PG8_WAIT_L(0); PG8_BAR; PG8_MMA(1, 0, At, B0); PG8_MMA(1, 1, At, B1); PG8_BAR; PG8_SCHED;
            PG8_LDB(B0, 1, 0); PG8_LDB(B1, 1, 1); PG8_SCHED; PG8_LDA(At, 1, 0); PG8_STAGE(PG8_SA(0, 1), a2, vX1);
            PG8_WAIT_V(8); PG8_WAIT_L(0); PG8_BAR; PG8_MMA(0, 0, At, B0); PG8_MMA(0, 1, At, B1); PG8_BAR; PG8_SCHED;
            PG8_LDA(At, 1, 1); PG8_STAGE(PG8_SB(1, 0), b3, voffB); PG8_STAGE(PG8_SB(1, 1), b3 + hstep, voffB); PG8_STAGE(PG8_SA(1, 0), a3, vX0);
            PG8_WAIT_V(8); PG8_WAIT_L(0); PG8_BAR; PG8_MMA(1, 0, At, B0); PG8_MMA(1, 1, At, B1); PG8_BAR; PG8_SCHED;
            } else {
            PG8_LDB(B0, 0, 0); PG8_SCHED; PG8_LDA(At, 0, 0); PG8_STAGE(PG8_SA(1, 1), a1, vA1);
            PG8_WAIT_L(8); PG8_BAR; PG8_WAIT_L(0); PG8_MMA(0, 0, At, B0); PG8_BAR; PG8_SCHED;
            PG8_LDB(B1, 0, 1); PG8_STAGE(PG8_SB(0, 0), b2, voffB);
            PG8_BAR; PG8_WAIT_L(0); PG8_MMA(0, 1, At, B1); PG8_BAR;
            PG8_LDA(At, 0, 1); PG8_STAGE(PG8_SA(0, 0), a2, vX0);
            PG8_BAR; PG8_WAIT_L(0); PG8_MMA(1, 0, At, B0); PG8_BAR; PG8_SCHED;
            PG8_STAGE(PG8_SB(0, 1), b2 + hstep, voffB);
            PG8_WAIT_V(6); PG8_BAR; PG8_MMA(1, 1, At, B1); PG8_BAR;
            PG8_LDB(B0, 1, 0); PG8_SCHED; PG8_LDA(At, 1, 0); PG8_STAGE(PG8_SA(0, 1), a2, vX1);
            PG8_WAIT_L(8); PG8_BAR; PG8_WAIT_L(0); PG8_MMA(0, 0, At, B0); PG8_BAR; PG8_SCHED;
            PG8_LDB(B1, 1, 1); PG8_STAGE(PG8_SB(1, 0), b3, voffB);
            PG8_BAR; PG8_WAIT_L(0); PG8_MMA(0, 1, At, B1); PG8_BAR;
            PG8_LDA(At, 1, 1); PG8_STAGE(PG8_SA(1, 0), a3, vX0);
            PG8_BAR; PG8_WAIT_L(0); PG8_MMA(1, 0, At, B0); PG8_BAR; PG8_SCHED;
            PG8_STAGE(PG8_SB(1, 1), b3 + hstep, voffB);
            PG8_WAIT_V(6); PG8_BAR; PG8_MMA(1, 1, At, B1); PG8_BAR;
            }
        }
        if constexpr (ALIGN_EPI) { if (wr == 0) PG8_BAR; }
        if constexpr (!Epi::AFTER_DRAIN) { E(acc, cur, wr, wc, fr, fq); S.done(cur); }
        if (!has_next) break;
#pragma unroll
        for (int a = 0; a < 2; ++a)
#pragma unroll
            for (int b = 0; b < 2; ++b)
#pragma unroll
                for (int m = 0; m < 4; ++m)
#pragma unroll
                    for (int n = 0; n < 2; ++n) acc[a][b][m][n] = (f32x4){0.f, 0.f, 0.f, 0.f};
        cur = nxt; cA = nA; cB = nB; ++ui;
        if constexpr (GATHER) { _Pragma("unroll") for (int i = 0; i < 2; ++i) { vA0[i] = vN0[i]; vA1[i] = vN1[i]; } }
        if constexpr (ALIGN_EPI) { if (wr == 1) PG8_BAR; }
    }
    PG8_WAIT_V(0);
    if constexpr (!ALIGN_EPI) { if (wr == 0) PG8_BAR; }
    PG8_BAR;
    if constexpr (Epi::AFTER_DRAIN) { E.fused(acc, cur, wr, wc, fr, fq, lds, wid, lane); S.done(cur); }
#undef PG8_SA
#undef PG8_SB
#undef PG8_STAGE
#undef PG8_GLOAD
#undef PG8_LDA
#undef PG8_LDB
#undef PG8_MMA
#undef PG8_WAIT_V
#undef PG8_WAIT_L
#undef PG8_BAR
#undef PG8_SCHED
}
}
namespace pg8 {
__device__ __forceinline__ float bf_lo(unsigned w) { return __builtin_bit_cast(float, w << 16); }
__device__ __forceinline__ float bf_hi(unsigned w) { return __builtin_bit_cast(float, w & 0xffff0000u); }
__device__ __forceinline__ float sigmoid_f(float x) { return __builtin_amdgcn_rcpf(1.0f + __expf(-x)); }

template <bool ADD> struct EpiGate {
    static constexpr bool PERM = true, AFTER_DRAIN = false;
    const bf16_t* G; const bf16_t* Min; bf16_t* O;
    __device__ __forceinline__ void operator()(const f32x4 (&acc)[2][2][4][2], const Unit& u, int wr, int wc, int fr, int fq) const {
        const int row0 = u.pm * BM + wr * 64 + fr, col0 = u.pn * BM + wc * 32 + 8 * fq;
#pragma unroll
        for (int ai = 0; ai < 2; ++ai)
#pragma unroll
            for (int m = 0; m < 4; ++m) { const size_t off = (size_t)(row0 + ai * HALF + m * 16) * 1024 + col0;
#pragma unroll
                for (int bj = 0; bj < 2; ++bj) {
                    const u32x4 g = *(const u32x4*)(G + off + bj * HALF);
                    f32x4 v0 = acc[ai][bj][m][0], v1 = acc[ai][bj][m][1];
                    v0[0] *= sigmoid_f(bf_lo(g.x)); v0[1] *= sigmoid_f(bf_hi(g.x)); v0[2] *= sigmoid_f(bf_lo(g.y)); v0[3] *= sigmoid_f(bf_hi(g.y));
                    v1[0] *= sigmoid_f(bf_lo(g.z)); v1[1] *= sigmoid_f(bf_hi(g.z)); v1[2] *= sigmoid_f(bf_lo(g.w)); v1[3] *= sigmoid_f(bf_hi(g.w));
                    if (ADD) { const u32x4 p = *(const u32x4*)(Min + off + bj * HALF);
                        v0[0] += bf_lo(p.x); v0[1] += bf_hi(p.x); v0[2] += bf_lo(p.y); v0[3] += bf_hi(p.y);
                        v1[0] += bf_lo(p.z); v1[1] += bf_hi(p.z); v1[2] += bf_lo(p.w); v1[3] += bf_hi(p.w); }
                    u32x4 w; w.x = cvt_pk_bf16(v0[0], v0[1]); w.y = cvt_pk_bf16(v0[2], v0[3]); w.z = cvt_pk_bf16(v1[0], v1[1]); w.w = cvt_pk_bf16(v1[2], v1[3]);
                    *(u32x4*)(O + off + bj * HALF) = w; } }
    }
};

struct EpiResid {
    static constexpr bool PERM = false, AFTER_DRAIN = false;
    const float* X; const float* gate; float* out; int rows_per_batch; int gstride;
    __device__ __forceinline__ void operator()(const f32x4 (&acc)[2][2][4][2], const Unit& u, int wr, int wc, int fr, int fq) const {
        const int col0 = u.pn * BM + wc * 32 + 4 * fq;
#pragma unroll
        for (int ai = 0; ai < 2; ++ai)
#pragma unroll
            for (int m = 0; m < 4; ++m) { const int row = u.pm * BM + ai * HALF + wr * 64 + m * 16 + fr; const size_t off = (size_t)row * 1024 + col0;
                const float* gp = gate + (size_t)(row / rows_per_batch) * gstride + col0;
#pragma unroll
                for (int bj = 0; bj < 2; ++bj)
#pragma unroll
                    for (int n = 0; n < 2; ++n) { const f32x4 xv = *(const f32x4*)(X + off + bj * HALF + n * 16); const f32x4 gv = *(const f32x4*)(gp + bj * HALF + n * 16);
                        *(f32x4*)(out + off + bj * HALF + n * 16) = xv + gv * acc[ai][bj][m][n]; } }
    }
};

__device__ __forceinline__ float swiglu1(float g, float l) {
    g = fminf(g, 7.0f); l = fminf(fmaxf(l, -7.0f), 7.0f);
    return (l + 1.0f) * (g * __builtin_amdgcn_rcpf(1.0f + __expf(-1.702f * g)));
}
struct EpiSwiglu {
    static constexpr bool PERM = true, AFTER_DRAIN = false;
    const float* b1; bf16_t* O;
    __device__ __forceinline__ void operator()(const f32x4 (&acc)[2][2][4][2], const Unit& u, int wr, int wc, int fr, int fq) const {
        const int e = u.pn >> 3, pl = u.pn & 7, jc = wc * 32 + 8 * fq;
        const float* bg = b1 + (size_t)e * 2048 + 128 * pl + jc; const float* bl = bg + 1024;
        const f32x4 bg0 = *(const f32x4*)bg, bg1 = *(const f32x4*)(bg + 4), bl0 = *(const f32x4*)bl, bl1 = *(const f32x4*)(bl + 4);
        const int row0 = u.pm * BM + wr * 64 + fr;
#pragma unroll
        for (int ai = 0; ai < 2; ++ai)
#pragma unroll
            for (int m = 0; m < 4; ++m) {
                const f32x4 g0 = acc[ai][0][m][0] + bg0, g1 = acc[ai][0][m][1] + bg1, l0 = acc[ai][1][m][0] + bl0, l1 = acc[ai][1][m][1] + bl1;
                u32x4 w; w.x = cvt_pk_bf16(swiglu1(g0[0], l0[0]), swiglu1(g0[1], l0[1])); w.y = cvt_pk_bf16(swiglu1(g0[2], l0[2]), swiglu1(g0[3], l0[3]));
                w.z = cvt_pk_bf16(swiglu1(g1[0], l1[0]), swiglu1(g1[1], l1[1])); w.w = cvt_pk_bf16(swiglu1(g1[2], l1[2]), swiglu1(g1[3], l1[3]));
                *(u32x4*)(O + (size_t)(row0 + ai * HALF + m * 16) * 1024 + 128 * pl + jc) = w; }
    }
};

struct GroupedOrder {
    const PG8_LAS int* ts; int NT, G, c; const int* rowtok;
    __device__ __forceinline__ bool next(int i, Unit& u) const {
        const int total = __builtin_amdgcn_readfirstlane(ts[32]) * NT; const long L = (long)i * G + c; if (L >= total) return false;
        const int pm = (int)L / NT, pl = (int)L % NT; int e = 0;
#pragma unroll 1
        for (int j = 1; j < 32; ++j) e += (pm >= ts[j]) ? 1 : 0;
        u.pm = __builtin_amdgcn_readfirstlane(pm); u.pn = __builtin_amdgcn_readfirstlane(e * NT + pl); return true;
    }
    __device__ __forceinline__ void a_ready(const Unit&) const {}
    __device__ __forceinline__ void done(const Unit&) const {}
};
}
#define GAS __attribute__((address_space(1)))
#define LAS __attribute__((address_space(3)))
typedef unsigned short bf16;
typedef unsigned v4u __attribute__((ext_vector_type(4)));
typedef float f32x4 __attribute__((ext_vector_type(4)));
typedef short bf16x8 __attribute__((ext_vector_type(8)));
typedef GAS unsigned gu32;
typedef GAS unsigned long long gu64;
#define RLX_AGENT __ATOMIC_RELAXED, __HIP_MEMORY_SCOPE_AGENT
#define LDS_WAIT() asm volatile("s_waitcnt lgkmcnt(0)" ::: "memory")
#define VM_WAIT() asm volatile("s_waitcnt vmcnt(0)" ::: "memory")
__device__ __forceinline__ unsigned long long rt() { return __builtin_amdgcn_s_memrealtime(); }
__device__ __forceinline__ unsigned f2bf(float f) { unsigned u = __builtin_bit_cast(unsigned, f); return (u + 0x7fffu + ((u >> 16) & 1u)) >> 16; }
typedef float f32x2_pk __attribute__((ext_vector_type(2))); typedef __bf16 bf16x2_pk __attribute__((ext_vector_type(2)));
__device__ __forceinline__ unsigned pk2(float lo, float hi) { const f32x2_pk v = {lo, hi}; return __builtin_bit_cast(unsigned, __builtin_convertvector(v, bf16x2_pk)); }

#define XB_TMO      128
#define XB_XCNT(j)  (256  + 64 * (j))
#define XB_XSUB(j)  (1280 + 64 * (j))
#define XB_XGEN(j)  (2304 + 64 * (j))
#define XB_TOP      3328
#define XB_TOPGEN   3392
#define XCD_BAR_WORDS 3456
#define XB_SPIN_CAP (1u << 18)

__device__ __forceinline__ unsigned xb_ld(unsigned* p)              { return __hip_atomic_load(p, __ATOMIC_RELAXED, __HIP_MEMORY_SCOPE_AGENT); }
__device__ __forceinline__ unsigned xb_add(unsigned* p, unsigned v) { return __hip_atomic_fetch_add(p, v, __ATOMIC_RELAXED, __HIP_MEMORY_SCOPE_AGENT); }
__device__ __forceinline__ unsigned xb_xcc_id() { return (unsigned)__builtin_amdgcn_s_getreg((3 << 11) | 20) & 0xFu; }
#define XB_SPIN(cond, bar) do { unsigned _sp = 0; while (cond) { __builtin_amdgcn_s_sleep(1); \
    if ((++_sp & 255u) == 0u) { if (xb_ld(&(bar)[XB_TMO])) break; if (_sp > XB_SPIN_CAP) { atomicAdd(&(bar)[XB_TMO], 1u); break; } } } } while (0)

struct XcdBarrier {
    unsigned* bar; unsigned x;
    volatile LAS unsigned* st;
};

__device__ __forceinline__ XcdBarrier xcd_barrier_post(unsigned* bar, volatile LAS unsigned* st) {
    XcdBarrier b; b.bar = bar; b.x = xb_xcc_id(); b.st = st;
    if (threadIdx.x == 0) (void)xb_add(&bar[XB_XCNT(b.x)], 1u);
    return b;
}
__device__ __forceinline__ void xcd_barrier_complete(unsigned* bar, unsigned x, unsigned& nloc, unsigned& nx) {
    const unsigned G = gridDim.x * gridDim.y * gridDim.z;
    unsigned sum, cnt, mine, sp = 0u;
    for (;;) {
        sum = 0u; cnt = 0u; mine = 0u;
#pragma unroll
        for (unsigned j = 0; j < 16; ++j) { const unsigned c = xb_ld(&bar[XB_XCNT(j)]); sum += c; cnt += (c > 0u) ? 1u : 0u; mine = (j == x) ? c : mine; }
        if (sum == G) break;
        __builtin_amdgcn_s_sleep(1);
        if ((++sp & 255u) == 0u) { if (xb_ld(&bar[XB_TMO])) break; if (sp > XB_SPIN_CAP) { atomicAdd(&bar[XB_TMO], 1u); break; } }
    }
    nloc = mine > 0u ? mine : 1u; nx = cnt > 0u ? cnt : 1u;
}

__device__ __forceinline__ void xcd_barrier(const XcdBarrier& b) {
    asm volatile("s_waitcnt vmcnt(0)" ::: "memory");
    __syncthreads();
    if (threadIdx.x == 0) {
        unsigned* bar = b.bar;
        __builtin_amdgcn_s_waitcnt(0);
        unsigned nloc = b.st[0], nx = b.st[1];
        if (nloc == 0u) { xcd_barrier_complete(bar, b.x, nloc, nx); b.st[0] = nloc; b.st[1] = nx; }
        const unsigned old = xb_add(&bar[XB_XSUB(b.x)], 1u);
        const unsigned gen = old / nloc;
        if (old + 1u == (gen + 1u) * nloc) {
            __builtin_amdgcn_fence(__ATOMIC_RELEASE, "agent");
            asm volatile("s_waitcnt vmcnt(0)" ::: "memory");
            const unsigned og = xb_add(&bar[XB_TOP], 1u);
            const unsigned tg = og / nx;
            if (og + 1u == (tg + 1u) * nx) xb_add(&bar[XB_TOPGEN], 1u);
            else XB_SPIN(xb_ld(&bar[XB_TOPGEN]) == tg, bar);
            __builtin_amdgcn_fence(__ATOMIC_ACQUIRE, "agent");
            xb_add(&bar[XB_XGEN(b.x)], 1u);
            asm volatile("s_waitcnt vmcnt(0)" ::: "memory");
        } else {
            XB_SPIN(xb_ld(&bar[XB_XGEN(b.x)]) == gen, bar);
            __builtin_amdgcn_fence(__ATOMIC_ACQUIRE, "agent");
            asm volatile("s_waitcnt vmcnt(0)" ::: "memory");
        }
    }
    __syncthreads();
}

constexpr int NWAVES = 8;
constexpr int BATCH = 16, SEQ = 2048, D = 1024, T = BATCH * SEQ;
constexpr int NIN = 9224, NPROJ = 9216, NMOD = 6 * D;
constexpr int NE = 32, TOPK = 4;
constexpr int XS_ROWS = T * TOPK + NE * 256;
constexpr float EPS = 1e-6f;
constexpr float ATT_RTHR = -120.0f;
constexpr float QSCALE = 0.125f * 1.4426950408889634f;

constexpr size_t MiB = 1u << 20;
constexpr size_t WS_CTL = 0, CTL_ZERO_BYTES = 1 * MiB;
constexpr size_t WS_MODP = 1 * MiB;
constexpr size_t WS_MOD = 3 * MiB;
constexpr size_t WS_IPRE = 4 * MiB, WS_LF = 4 * MiB + 512 * 1024;
constexpr size_t WS_TOKE = 5 * MiB, WS_TOKP = 5 * MiB + 512 * 1024, WS_TOKW = 6 * MiB, WS_TOKROW = 6 * MiB + 512 * 1024, WS_RSTD = 7 * MiB;
constexpr size_t WS_WIN = 8 * MiB, WS_WA = 26 * MiB, WS_WB = 28 * MiB, WS_WOUT = 30 * MiB, WS_W1 = 32 * MiB, WS_W2 = 160 * MiB;
constexpr size_t WS_H1 = 224 * MiB;
constexpr size_t WS_PROJ = 288 * MiB, SEG = 64 * MiB;
constexpr size_t WS_YB = 864 * MiB;
constexpr size_t WS_XS = 288 * MiB, WS_ACT = 560 * MiB;
constexpr size_t WS_ROW2TOK = 7 * MiB + 128 * 1024;
constexpr size_t WS_GT = 928 * MiB;
constexpr size_t WS_END = 932 * MiB;
static_assert(WS_XS + (size_t)XS_ROWS * 2048 <= WS_ACT && WS_ACT + (size_t)XS_ROWS * 2048 <= WS_YB, "ws map");
constexpr int CW_TMO = 0, CW_BAR = 4096, CW_ECNT = 8192;

constexpr int RING_BYTES = 131072, LDS_BYTES = 147456, LDSCTL_OFF = 146432;
constexpr int LC_BAR = 0, LC_TS = 16, LC_LCNT = 64, LC_GBASE = 96, LC_PS = 128, LC_CNT = 160;

__device__ __forceinline__ unsigned long long karg(int i) { return ((const __attribute__((address_space(4))) unsigned long long*)__builtin_amdgcn_kernarg_segment_ptr())[i]; }
struct Frame {
    LAS unsigned char* lds; volatile LAS unsigned* LC;
    gu32* ctl; unsigned char* ws; int tid, lane, wave, vcu, G;
    __device__ __forceinline__ const float* x() const { return (const float*)(const GAS float*)karg(0); }
    __device__ __forceinline__ const float* c() const { return (const float*)(const GAS float*)karg(1); }
    __device__ __forceinline__ const float* ada_w() const { return (const float*)(const GAS float*)karg(2); }
    __device__ __forceinline__ const float* ada_b() const { return (const float*)(const GAS float*)karg(3); }
    __device__ __forceinline__ const float* norm1_g() const { return (const float*)(const GAS float*)karg(4); }
    __device__ __forceinline__ const float* w_in() const { return (const float*)(const GAS float*)karg(5); }
    __device__ __forceinline__ const float* conv_w() const { return (const float*)(const GAS float*)karg(6); }
    __device__ __forceinline__ const float* conv_b() const { return (const float*)(const GAS float*)karg(7); }
    __device__ __forceinline__ const float* b_i() const { return (const float*)(const GAS float*)karg(8); }
    __device__ __forceinline__ const float* b_f() const { return (const float*)(const GAS float*)karg(9); }
    __device__ __forceinline__ const float* ml_norm_g() const { return (const float*)(const GAS float*)karg(10); }
    __device__ __forceinline__ const float* w_a() const { return (const float*)(const GAS float*)karg(11); }
    __device__ __forceinline__ const float* w_b() const { return (const float*)(const GAS float*)karg(12); }
    __device__ __forceinline__ const float* w_out() const { return (const float*)(const GAS float*)karg(13); }
    __device__ __forceinline__ const float* norm2_g() const { return (const float*)(const GAS float*)karg(14); }
    __device__ __forceinline__ const float* router_w() const { return (const float*)(const GAS float*)karg(15); }
    __device__ __forceinline__ const float* router_b() const { return (const float*)(const GAS float*)karg(16); }
    __device__ __forceinline__ const float* w1() const { return (const float*)(const GAS float*)karg(17); }
    __device__ __forceinline__ const float* b1() const { return (const float*)(const GAS float*)karg(18); }
    __device__ __forceinline__ const float* w2() const { return (const float*)(const GAS float*)karg(19); }
    __device__ __forceinline__ const float* b2() const { return (const float*)(const GAS float*)karg(20); }
    __device__ __forceinline__ const float* final_g() const { return (const float*)(const GAS float*)karg(21); }
    __device__ __forceinline__ float* out() const { return (float*)(GAS float*)karg(22); }
    __device__ __forceinline__ float* modp() const { return (float*)(ws + WS_MODP); }
    __device__ __forceinline__ float* mod() const { return (float*)(ws + WS_MOD); }
    __device__ __forceinline__ float* ipre() const { return (float*)(ws + WS_IPRE); }
    __device__ __forceinline__ float* lf() const { return (float*)(ws + WS_LF); }
    __device__ __forceinline__ float* tokw() const { return (float*)(ws + WS_TOKW); }
    __device__ __forceinline__ float* rstd2() const { return (float*)(ws + WS_RSTD); }
    __device__ __forceinline__ int* toke() const { return (int*)(ws + WS_TOKE); }
    __device__ __forceinline__ int* tokp() const { return (int*)(ws + WS_TOKP); }
    __device__ __forceinline__ int* tokrow() const { return (int*)(ws + WS_TOKROW); }
    __device__ __forceinline__ bf16* WIN_T() const { return (bf16*)(ws + WS_WIN); }
    __device__ __forceinline__ bf16* WA_T() const { return (bf16*)(ws + WS_WA); }
    __device__ __forceinline__ bf16* WB_T() const { return (bf16*)(ws + WS_WB); }
    __device__ __forceinline__ bf16* WOUT_T() const { return (bf16*)(ws + WS_WOUT); }
    __device__ __forceinline__ bf16* W1_T() const { return (bf16*)(ws + WS_W1); }
    __device__ __forceinline__ bf16* W2_T() const { return (bf16*)(ws + WS_W2); }
    __device__ __forceinline__ bf16* H1() const { return (bf16*)(ws + WS_H1); }
    __device__ __forceinline__ bf16* PROJ() const { return (bf16*)(ws + WS_PROJ); }
    __device__ __forceinline__ bf16* YA() const { return (bf16*)(ws + WS_H1); }
    __device__ __forceinline__ bf16* YB() const { return (bf16*)(ws + WS_YB); }
    __device__ __forceinline__ bf16* M1() const { return (bf16*)(ws + WS_PROJ); }
    __device__ __forceinline__ bf16* MERGED() const { return (bf16*)(ws + WS_PROJ + SEG); }
    __device__ __forceinline__ bf16* XS() const { return (bf16*)(ws + WS_XS); }
    __device__ __forceinline__ bf16* ACT() const { return (bf16*)(ws + WS_ACT); }
    __device__ __forceinline__ bf16* OUTR() const { return (bf16*)(ws + WS_XS); }
    __device__ __forceinline__ bf16* H2() const { return (bf16*)(ws + WS_XS); }
    __device__ __forceinline__ int* row2tok() const { return (int*)(ws + WS_ROW2TOK); }
    __device__ __forceinline__ float* gt() const { return (float*)(ws + WS_GT); }
};

__device__ __forceinline__ int opq(int v) { asm volatile("" : "+v"(v)); return v; }
__device__ __forceinline__ float wave_sum(float v) {
#pragma unroll
    for (int o = 1; o < 64; o <<= 1) v += __shfl_xor(v, o);
    return v;
}
__device__ __forceinline__ float bf2f(unsigned short b) { return __builtin_bit_cast(float, (unsigned)b << 16); }
__device__ __forceinline__ float bflo(unsigned w) { return __builtin_bit_cast(float, w << 16); }
__device__ __forceinline__ float bfhi(unsigned w) { return __builtin_bit_cast(float, w & 0xffff0000u); }
__device__ __forceinline__ float log_sigmoid_f(float x) { return fminf(x, 0.f) - log1pf(expf(-fabsf(x))); }

struct MapIn { __device__ __forceinline__ long operator()(int n) const { return n < 7168 ? (long)n : (n < 7176 ? -1L : (n < NIN ? (long)(n - 8) : -1L)); } };
struct MapId { long off; __device__ __forceinline__ long operator()(int n) const { return off + n; } };
struct MapW1 { int e; __device__ __forceinline__ long operator()(int n) const { return (long)e * 2048 + ((n & 1023) >> 7) * 256 + (n >> 10) * 128 + (n & 127); } };

template <class Map> __device__ __forceinline__ void transpose_item(const float* W, int K, int N, bf16* WT, LAS float* scr, int item, int lane, Map map) {
    const int nblk = (N + 31) / 32, kb = item / nblk, nb = item % nblk, k0 = 64 * kb, n0 = 32 * nb;
    const int n4 = 4 * (lane & 7), kr = lane >> 3;
    const bool ok = (n0 + n4 + 3) < N;
    f32x4 v[8];
#pragma unroll
    for (int i = 0; i < 8; ++i) v[i] = ok ? *(const f32x4*)(W + (size_t)(k0 + 8 * i + kr) * N + n0 + n4) : (f32x4){0.f, 0.f, 0.f, 0.f};
#pragma unroll
    for (int i = 0; i < 8; ++i) { LAS float* d = scr + (8 * i + kr) * 33 + n4; d[0] = v[i].x; d[1] = v[i].y; d[2] = v[i].z; d[3] = v[i].w; }
    LDS_WAIT(); asm volatile("" ::: "memory");
    const int c = lane & 7;
#pragma unroll
    for (int j = 0; j < 4; ++j) { const int n = (lane >> 3) + 8 * j; const LAS float* s = scr + (8 * c) * 33 + n;
        v4u o; o.x = pk2(s[0 * 33], s[1 * 33]); o.y = pk2(s[2 * 33], s[3 * 33]); o.z = pk2(s[4 * 33], s[5 * 33]); o.w = pk2(s[6 * 33], s[7 * 33]);
        const long dr = map(n0 + n);
        if (dr >= 0) *(GAS v4u*)(WT + (size_t)dr * K + k0 + 8 * c) = o; }
    LDS_WAIT(); asm volatile("" ::: "memory");
}
__device__ __forceinline__ void mod_item(Frame& F, const LAS float* sil, int it) {
    const int j = it % 96, kq = it / 96, n = 64 * j + F.lane, k0 = 256 * kq;
    float acc[16];
#pragma unroll
    for (int b = 0; b < 16; ++b) acc[b] = 0.f;
    const float* w = F.ada_w() + (size_t)k0 * NMOD + n;
    const LAS f32x4* s = (const LAS f32x4*)sil + k0 * 4;
    for (int kk = 0; kk < 256; kk += 8) {
        float wv[8];
#pragma unroll
        for (int u = 0; u < 8; ++u) wv[u] = w[(size_t)(kk + u) * NMOD];
#pragma unroll
        for (int u = 0; u < 8; ++u) {
#pragma unroll
            for (int q = 0; q < 4; ++q) { const f32x4 sv = s[(kk + u) * 4 + q]; acc[4 * q + 0] += sv.x * wv[u]; acc[4 * q + 1] += sv.y * wv[u]; acc[4 * q + 2] += sv.z * wv[u]; acc[4 * q + 3] += sv.w * wv[u]; }
        }
    }
    float* o = F.modp() + (size_t)kq * 16 * NMOD + n;
#pragma unroll
    for (int b = 0; b < 16; ++b) o[(size_t)b * NMOD] = acc[b];
}
__device__ __forceinline__ void p0_prologue(Frame& F) {
    LAS float* sil = (LAS float*)F.lds;
    for (int idx = F.tid; idx < 16384; idx += 512) { const int b = idx >> 10, k = idx & 1023; const float v = F.c()[idx]; sil[k * 16 + b] = v / (1.0f + __expf(-v)); }
    __syncthreads();
    LAS float* scr = (LAS float*)(F.lds + 65536 + F.wave * 8704);
    const int gw = F.vcu * NWAVES + F.wave, NGW = F.G * NWAVES;
    constexpr int I_MOD = 384, I_IN = 16 * 289, I_SQ = 16 * 32, I_W1 = 32 * 16 * 64, I_W2 = 32 * 16 * 32;
    constexpr int NITEMS = I_MOD + I_IN + 3 * I_SQ + I_W1 + I_W2;
    for (int it = gw; it < NITEMS; it += NGW) {
        int r = it;
        if (r < I_MOD) { mod_item(F, sil, r); continue; } r -= I_MOD;
        if (r < I_IN) { transpose_item(F.w_in(), D, NIN, F.WIN_T(), scr, r, F.lane, MapIn{}); continue; } r -= I_IN;
        if (r < I_SQ) { transpose_item(F.w_a(), D, D, F.WA_T(), scr, r, F.lane, MapId{0}); continue; } r -= I_SQ;
        if (r < I_SQ) { transpose_item(F.w_b(), D, D, F.WB_T(), scr, r, F.lane, MapId{0}); continue; } r -= I_SQ;
        if (r < I_SQ) { transpose_item(F.w_out(), D, D, F.WOUT_T(), scr, r, F.lane, MapId{0}); continue; } r -= I_SQ;
        if (r < I_W1) { const int e = r >> 10; transpose_item(F.w1() + (size_t)e * D * 2048, D, 2048, F.W1_T(), scr, r & 1023, F.lane, MapW1{e}); continue; } r -= I_W1;
        { const int e = r >> 9; transpose_item(F.w2() + (size_t)e * D * D, D, D, F.W2_T(), scr, r & 511, F.lane, MapId{(long)e * 1024}); }
    }
}

__device__ __forceinline__ void p1_rows(Frame& F) {
    const int row0 = F.vcu * 128, b = row0 / SEQ, lane = opq(F.lane);
    LAS float* wif = (LAS float*)F.lds;
    for (int idx = F.tid; idx < 8192; idx += 512) wif[idx] = F.w_in()[(size_t)(idx >> 3) * NIN + 7168 + (idx & 7)];
    for (int idx = F.vcu * 512 + F.tid; idx < 16 * NMOD; idx += F.G * 512) { float s = F.ada_b()[idx % NMOD];
#pragma unroll
        for (int kq = 0; kq < 4; ++kq) s += F.modp()[(size_t)kq * 16 * NMOD + idx];
        F.mod()[idx] = s; }
    f32x4 Av[4], Bv[4];
#pragma unroll
    for (int j = 0; j < 4; ++j) { const int col = 4 * lane + 256 * j;
        f32x4 sh = *(const f32x4*)(F.ada_b() + col), sc = *(const f32x4*)(F.ada_b() + D + col);
#pragma unroll
        for (int kq = 0; kq < 4; ++kq) { sh += *(const f32x4*)(F.modp() + ((size_t)kq * 16 + b) * NMOD + col); sc += *(const f32x4*)(F.modp() + ((size_t)kq * 16 + b) * NMOD + D + col); }
        const f32x4 g = *(const f32x4*)(F.norm1_g() + col); Av[j] = g * (sc + 1.0f); Bv[j] = sh; }
    __syncthreads();
    for (int r = 0; r < 16; ++r) {
        const int row = row0 + 16 * F.wave + r;
        const GAS f32x4* xr = (const GAS f32x4*)(F.x() + (size_t)row * D) + lane;
        f32x4 v[4]; float ss = 0.f;
#pragma unroll
        for (int j = 0; j < 4; ++j) { v[j] = xr[64 * j]; ss += (v[j].x * v[j].x + v[j].y * v[j].y) + (v[j].z * v[j].z + v[j].w * v[j].w); }
        const float rstd = 1.0f / sqrtf(wave_sum(ss) * (1.0f / D) + EPS);
        GAS unsigned long long* o8 = (GAS unsigned long long*)(F.H1() + (size_t)row * D) + lane;
        float p[8];
#pragma unroll
        for (int q = 0; q < 8; ++q) p[q] = 0.f;
#pragma unroll
        for (int j = 0; j < 4; ++j) { v[j] = v[j] * rstd * Av[j] + Bv[j];
            o8[64 * j] = (unsigned long long)pk2(v[j].x, v[j].y) | ((unsigned long long)pk2(v[j].z, v[j].w) << 32);
#pragma unroll
            for (int i = 0; i < 4; ++i) { const LAS f32x4* wp = (const LAS f32x4*)(wif + (4 * lane + 256 * j + i) * 8); const f32x4 w0 = wp[0], w1 = wp[1]; const float hv = v[j][i];
                p[0] += hv * w0.x; p[1] += hv * w0.y; p[2] += hv * w0.z; p[3] += hv * w0.w; p[4] += hv * w1.x; p[5] += hv * w1.y; p[6] += hv * w1.z; p[7] += hv * w1.w; } }
#pragma unroll
        for (int q = 0; q < 8; ++q) p[q] = wave_sum(p[q]);
        if (lane == 0) { const int t = row % SEQ;
#pragma unroll
            for (int hh = 0; hh < 4; ++hh) { F.ipre()[((size_t)b * 4 + hh) * SEQ + t] = p[hh] + F.b_i()[hh]; F.lf()[((size_t)b * 4 + hh) * SEQ + t] = log_sigmoid_f(p[4 + hh] + F.b_f()[hh]); } }
    }
}

__device__ __forceinline__ void attn_naive_item(Frame& F, int bh, int qblk) {
    const int b = bh >> 4, hd = bh & 15, t = qblk * 512 + F.tid;
    const bf16* Q = F.PROJ(); const bf16* K = F.PROJ() + SEG / 2; const bf16* V = F.PROJ() + SEG;
    const size_t rowb = (size_t)b * SEQ;
    float q[64], o[64];
    { const v4u* qp = (const v4u*)(Q + (rowb + t) * D + hd * 64);
#pragma unroll
      for (int i = 0; i < 8; ++i) { const v4u w = qp[i]; q[8 * i + 0] = bflo(w.x); q[8 * i + 1] = bfhi(w.x); q[8 * i + 2] = bflo(w.y); q[8 * i + 3] = bfhi(w.y); q[8 * i + 4] = bflo(w.z); q[8 * i + 5] = bfhi(w.z); q[8 * i + 6] = bflo(w.w); q[8 * i + 7] = bfhi(w.w); } }
#pragma unroll
    for (int i = 0; i < 64; ++i) o[i] = 0.f;
    float R = 0.f;
    LAS v4u* kt = (LAS v4u*)F.lds; LAS v4u* vt = (LAS v4u*)(F.lds + 8192);
    const int tmax_wave = qblk * 512 + F.wave * 64 + 63;
    bool wdone = false;
    LAS volatile int* dflag = (LAS volatile int*)(F.lds + 16384);
    if (F.tid < 8) dflag[F.tid] = 0;
    for (int tile = qblk * 8 + 7; tile >= 0; --tile) {
        __syncthreads();
        { int nd = 0;
#pragma unroll
          for (int w = 0; w < 8; ++w) nd += dflag[w];
          if (nd == 8) break; }
        { const int kr = F.tid >> 3, ch = F.tid & 7; const size_t g = (rowb + tile * 64 + kr) * D + hd * 64 + ch * 8;
          kt[F.tid] = *(const v4u*)(K + g); vt[F.tid] = *(const v4u*)(V + g); }
        __syncthreads();
        if (tile * 64 >= tmax_wave) continue;
        if (wdone) continue;
        for (int s = 63; s >= 0; --s) {
            const int key = tile * 64 + s;
            float z = 0.f;
#pragma unroll
            for (int i = 0; i < 8; ++i) { const v4u w = kt[s * 8 + i]; z += q[8 * i + 0] * bflo(w.x) + q[8 * i + 1] * bfhi(w.x) + q[8 * i + 2] * bflo(w.y) + q[8 * i + 3] * bfhi(w.y) + q[8 * i + 4] * bflo(w.z) + q[8 * i + 5] * bfhi(w.z) + q[8 * i + 6] * bflo(w.w) + q[8 * i + 7] * bfhi(w.w); }
            const float lb = fminf(z, 0.f) - __builtin_amdgcn_logf(1.0f + __builtin_amdgcn_exp2f(-fabsf(z)));
            const bool act = key < t;
            const float a = act ? __builtin_amdgcn_exp2f(lb + R) : 0.f;
            R += act ? (lb - z) : 0.f;
#pragma unroll
            for (int i = 0; i < 8; ++i) { const v4u w = vt[s * 8 + i]; o[8 * i + 0] += a * bflo(w.x); o[8 * i + 1] += a * bfhi(w.x); o[8 * i + 2] += a * bflo(w.y); o[8 * i + 3] += a * bfhi(w.y); o[8 * i + 4] += a * bflo(w.z); o[8 * i + 5] += a * bfhi(w.z); o[8 * i + 6] += a * bflo(w.w); o[8 * i + 7] += a * bfhi(w.w); }
        }
        if (__all(R < ATT_RTHR) && !wdone) { wdone = true; if (F.lane == 0) dflag[F.wave] = 1; }
    }
    __syncthreads();
    v4u* op = (v4u*)(F.YA() + (rowb + t) * D + hd * 64);
#pragma unroll
    for (int i = 0; i < 8; ++i) { v4u w; w.x = pk2(o[8 * i + 0], o[8 * i + 1]); w.y = pk2(o[8 * i + 2], o[8 * i + 3]); w.z = pk2(o[8 * i + 4], o[8 * i + 5]); w.w = pk2(o[8 * i + 6], o[8 * i + 7]); op[i] = w; }
}

__device__ __forceinline__ void mlstm_naive_item(Frame& F, int bh) {
    const int b = bh >> 2, hh = bh & 3, tid = opq(F.tid), e = tid & 255, half = tid >> 8;
    const bf16* MLQ = F.PROJ() + 3 * (SEG / 2); const bf16* MLK = F.PROJ() + 4 * (SEG / 2); const bf16* MLV = F.PROJ() + 5 * (SEG / 2); const bf16* MLO = F.PROJ() + 6 * (SEG / 2);
    LAS float* ql = (LAS float*)F.lds; LAS float* kl = ql + 8192; LAS float* vl = kl + 8192; LAS float* hl = vl + 8192;
    LAS float* part = hl + 8192;
    LAS float* red = part + 512;
    LAS float* il = red + 8; LAS float* fl = il + 32;
    const size_t rowb = (size_t)b * SEQ;
    float C[128];
#pragma unroll
    for (int i = 0; i < 128; ++i) C[i] = 0.f;
    float nreg = 0.f, m = 0.f;
    float cw[2][4], cb[2];
    { const int c = tid & 255;
#pragma unroll
      for (int z = 0; z < 2; ++z) { const int ch = z * 1024 + hh * 256 + c; cb[z] = F.conv_b()[ch];
#pragma unroll
          for (int tap = 0; tap < 4; ++tap) cw[z][tap] = F.conv_w()[tap * 2048 + ch]; } }
    for (int chunk = 0; chunk < SEQ / 32; ++chunk) {
        const int t0 = chunk * 32;
        __syncthreads();
        { const int c = tid & 255;
          for (int u = 0; u < 16; ++u) { const int tt = (tid >> 8) + 2 * u, t = t0 + tt; float yq = cb[0], yk = cb[1];
#pragma unroll
              for (int tap = 0; tap < 4; ++tap) { const int ts = t - 3 + tap; if (ts >= 0) { const size_t g = (rowb + ts) * D + hh * 256 + c; yq += cw[0][tap] * bf2f(MLQ[g]); yk += cw[1][tap] * bf2f(MLK[g]); } }
              ql[tt * 256 + c] = yq / (1.0f + __expf(-yq)); kl[tt * 256 + c] = (yk / (1.0f + __expf(-yk))) * 0.0625f;
              vl[tt * 256 + c] = bf2f(MLV[(rowb + t) * D + hh * 256 + c]); }
          if (tid < 32) { il[tid] = F.ipre()[((size_t)b * 4 + hh) * SEQ + t0 + tid]; fl[tid] = F.lf()[((size_t)b * 4 + hh) * SEQ + t0 + tid]; } }
        __syncthreads();
        for (int tt = 0; tt < 32; ++tt) {
            const float lfv = fl[tt], iv = il[tt];
            const float mn = fmaxf(lfv + m, iv), fp = __expf(lfv + m - mn), ip = __expf(iv - mn); m = mn;
            const float vv = vl[tt * 256 + e] * ip;
            const LAS f32x4* kq = (const LAS f32x4*)(kl + tt * 256 + 128 * half); const LAS f32x4* qq = (const LAS f32x4*)(ql + tt * 256 + 128 * half);
            float num = 0.f;
#pragma unroll
            for (int i = 0; i < 32; ++i) { const f32x4 kv = kq[i], qv = qq[i];
                C[4 * i + 0] = fp * C[4 * i + 0] + kv.x * vv; C[4 * i + 1] = fp * C[4 * i + 1] + kv.y * vv; C[4 * i + 2] = fp * C[4 * i + 2] + kv.z * vv; C[4 * i + 3] = fp * C[4 * i + 3] + kv.w * vv;
                num += (qv.x * C[4 * i + 0] + qv.y * C[4 * i + 1]) + (qv.z * C[4 * i + 2] + qv.w * C[4 * i + 3]); }
            const int buf = tt & 1;
            if (tid < 256) { nreg = fp * nreg + ip * kl[tt * 256 + tid]; const float pd = wave_sum(ql[tt * 256 + tid] * nreg); if (F.lane == 0) red[buf * 4 + F.wave] = pd; }
            else part[buf * 256 + e] = num;
            __syncthreads();
            if (tid < 256) { num += part[buf * 256 + e]; const float den = (red[buf * 4 + 0] + red[buf * 4 + 1]) + (red[buf * 4 + 2] + red[buf * 4 + 3]);
                hl[tt * 256 + e] = num / fmaxf(fabsf(den), __expf(-m)); }
        }
        __syncthreads();
        for (int r = 0; r < 4; ++r) { const int tt = 4 * F.wave + r; const size_t row = rowb + t0 + tt;
            const f32x4 hv = *(const LAS f32x4*)(hl + tt * 256 + 4 * F.lane);
            const float ss = wave_sum((hv.x * hv.x + hv.y * hv.y) + (hv.z * hv.z + hv.w * hv.w));
            const float rstd = 1.0f / sqrtf(ss * (1.0f / 256.0f) + EPS);
            const int col = hh * 256 + 4 * F.lane; const f32x4 g = *(const f32x4*)(F.ml_norm_g() + col);
            const unsigned long long ow = *(const unsigned long long*)(MLO + row * D + col);
            const float o0 = bflo((unsigned)ow), o1 = bfhi((unsigned)ow), o2 = bflo((unsigned)(ow >> 32)), o3 = bfhi((unsigned)(ow >> 32));
            const float y0 = hv.x * rstd * g.x / (1.0f + __expf(-o0)), y1 = hv.y * rstd * g.y / (1.0f + __expf(-o1)), y2 = hv.z * rstd * g.z / (1.0f + __expf(-o2)), y3 = hv.w * rstd * g.w / (1.0f + __expf(-o3));
            *(unsigned long long*)(F.YB() + row * D + col) = (unsigned long long)pk2(y0, y1) | ((unsigned long long)pk2(y2, y3) << 32); }
    }
}


namespace ml {
typedef short bf16x8 __attribute__((ext_vector_type(8)));
typedef short s16x4 __attribute__((ext_vector_type(4)));
typedef float f32x16 __attribute__((ext_vector_type(16)));
typedef LAS const char* lcp;
typedef LAS char* lp_t;
constexpr int L = 64;
constexpr int O_QI = 0, O_KI = 33792, O_CB = 67584, O_VI = 102400, O_VW = 111616, O_PI = 120832, O_F = 130048;
constexpr int F_NV = 0, F_QNP = 256, F_RSP = 768, F_AT = 896, F_US = 960, F_WIN = 1024, F_EDEN = 1088, F_WST = 1152, F_RDEN = 1216, F_CW = 1280, F_CBIAS = 3328;
__device__ __forceinline__ int crow(int r, int hi) { return (r & 3) + 8 * (r >> 2) + 4 * hi; }
template <int PITCH, int XM> __device__ __forceinline__ int ioff(int row, int ch) { return XM ? PITCH * row + 16 * (ch ^ (row & XM)) : PITCH * row + 16 * ch; }
template <int PITCH, int XM> __device__ __forceinline__ bf16x8 frag_row(lcp img, int row0, int s, int lane) {
    return *(LAS const bf16x8*)(img + ioff<PITCH, XM>(row0 + (lane & 31), 2 * s + (lane >> 5)));
}
template <int PITCH, int XM> __device__ __forceinline__ bf16x8 frag_tr(lcp img, int k0, int ks, int col0, int lane) {
    const int h = lane >> 5, blk = (lane >> 4) & 1, q = (lane & 15) >> 2, p = lane & 3;
    const int r0 = k0 + 16 * ks + 8 * h + q, ch = (col0 >> 3) + 2 * blk + (p >> 1);
    typedef short v4i16_t __attribute__((ext_vector_type(4)));
    const s16x4 a = __builtin_bit_cast(s16x4, __builtin_amdgcn_ds_read_tr16_b64_v4i16((LAS v4i16_t*)(img + ioff<PITCH, XM>(r0, ch) + 8 * (p & 1))));
    const s16x4 b = __builtin_bit_cast(s16x4, __builtin_amdgcn_ds_read_tr16_b64_v4i16((LAS v4i16_t*)(img + ioff<PITCH, XM>(r0 + 4, ch) + 8 * (p & 1))));
    return (bf16x8){a[0], a[1], a[2], a[3], b[0], b[1], b[2], b[3]};
}
__device__ __forceinline__ float half_sum(float v) {
    const auto rr = __builtin_amdgcn_permlane32_swap(__builtin_bit_cast(unsigned, v), __builtin_bit_cast(unsigned, v), false, false);
    return __builtin_bit_cast(float, rr[0]) + __builtin_bit_cast(float, rr[1]);
}
__device__ __forceinline__ float silu_f(float y) { return y * __builtin_amdgcn_rcpf(1.0f + __expf(-y)); }

__device__ __forceinline__ void mlstm_unit(Frame& F, int unit) {
    const int bh = unit >> 2, sl = unit & 3, b = bh >> 2, hh = bh & 3, tid = opq(F.tid), lane = opq(F.lane), wave = F.wave, hi = lane >> 5, l31 = lane & 31;
    const bf16* MLQ = (const bf16*)F.out(); const bf16* MLK = MLQ + (size_t)T * D; const bf16* MLV = F.PROJ() + 5 * (SEG / 2);
    lp_t base = (lp_t)F.lds;
    LAS float* Fa = (LAS float*)(base + O_F);
    const size_t rowb = (size_t)b * SEQ;
    const float LOG2E = 1.4426950408889634f;
    __syncthreads();
    for (int i = tid; i < 34816 / 16; i += 512) ((LAS v4u*)(base + O_CB))[i] = (v4u){0u, 0u, 0u, 0u};
    if (tid < 256) Fa[F_NV + tid] = 0.f;
    f32x16 C0, C1, C2;
#pragma unroll
    for (int r = 0; r < 16; ++r) { C0[r] = 0.f; C1[r] = 0.f; C2[r] = 0.f; }
    if (tid < 64) *(LAS v4u*)(base + O_VW + 144 * tid + 128) = (v4u){0u, 0u, 0u, 0u};
    const int cg = tid & 31, rb = tid >> 5;
    v4u rawq[2][4], rawk[2][4], rawv[2]; float g_bb[2], g_us[2], g_pm[2]; float m_prev = 0.f;
#define ML_PREFETCH(T0, P) do { const int t0_ = (T0); \
        _Pragma("unroll") for (int i = 0; i < 4; ++i) { const unsigned g_ = (unsigned)(((int)rowb + t0_ + 4 * rb + i) * D + hh * 256 + cg * 8); \
            rawq[P][i] = *(const v4u*)(MLQ + g_); rawk[P][i] = *(const v4u*)(MLK + g_); } \
        rawv[P] = *(const v4u*)(MLV + (unsigned)(((int)rowb + t0_ + (tid >> 3)) * D + hh * 256 + 64 * sl + (tid & 7) * 8)); \
        { const float* gt_ = F.gt() + (unsigned)(((bh * (SEQ / L) + t0_ / L) * 3) * 64 + lane); g_bb[P] = gt_[0]; g_us[P] = gt_[64]; g_pm[P] = gt_[128]; } } while (0)
    ML_PREFETCH(0, 0); ML_PREFETCH(L, 1);
    __syncthreads();
    for (int chunk2 = 0; chunk2 < SEQ / L; chunk2 += 2) {
#pragma unroll
      for (int par = 0; par < 2; ++par) {
        const int chunk = chunk2 + par, t0 = chunk * L;
        const int tid = opq(F.tid), lane = tid & 63, hi = lane >> 5, l31 = lane & 31, cg = tid & 31, rb = tid >> 5, lo = lane;
        const float u = g_us[par], mm = g_bb[par] + fmaxf(m_prev, g_pm[par]), winter = __builtin_amdgcn_exp2f(g_bb[par] + m_prev - mm), at = g_bb[par] - mm, eden = __builtin_amdgcn_exp2f(-mm);
        const float bb63 = __builtin_bit_cast(float, __builtin_amdgcn_readlane(__builtin_bit_cast(int, g_bb[par]), 63)), mnew = __builtin_bit_cast(float, __builtin_amdgcn_readlane(__builtin_bit_cast(int, mm), 63));
        const float decay = __builtin_amdgcn_exp2f(bb63 + m_prev - mnew), wstate = __builtin_amdgcn_exp2f(bb63 - mnew + u); m_prev = mnew;
        if (wave == 0) { Fa[F_AT + lane] = at; Fa[F_US + lane] = u; Fa[F_WIN + lane] = winter; Fa[F_EDEN + lane] = eden; Fa[F_WST + lane] = wstate; }
#pragma unroll
        for (int j = 0; j < 4; ++j) { *(LAS v4u*)(base + O_QI + ioff<528, 0>(4 * rb + j, cg)) = rawq[par][j]; *(LAS v4u*)(base + O_KI + ioff<528, 0>(4 * rb + j, cg)) = rawk[par][j]; }
        { const int s = tid >> 3, ch = tid & 7; const v4u w = rawv[par];
          *(LAS v4u*)(base + O_VI + ioff<144, 0>(s, ch)) = w;
          const float ws = __shfl(wstate, s);
          v4u o; o.x = pk2(bflo(w.x) * ws, bfhi(w.x) * ws); o.y = pk2(bflo(w.y) * ws, bfhi(w.y) * ws); o.z = pk2(bflo(w.z) * ws, bfhi(w.z) * ws); o.w = pk2(bflo(w.w) * ws, bfhi(w.w) * ws);
          *(LAS v4u*)(base + O_VW + ioff<144, 0>(s, ch)) = o;
          if (ch == 0) *(LAS unsigned short*)(base + O_VW + 144 * s + 128) = (unsigned short)pk2(ws, 0.f); }
        __syncthreads();
        if (chunk + 2 < SEQ / L) ML_PREFETCH(t0 + 2 * L, par);
        __builtin_amdgcn_sched_barrier(0);
        f32x16 acc;
#pragma unroll
        for (int r = 0; r < 16; ++r) acc[r] = 0.f;
        const int wq = wave & 3, ta = wq >> 1, tb = wq & 1;
        if (wave < 4) {
#pragma unroll
            for (int kh = 0; kh < 2; ++kh) { bf16x8 fa[8], fb[8];
#pragma unroll
                for (int ks = 0; ks < 8; ++ks) { fa[ks] = frag_row<528, 0>(base + O_KI, 32 * tb, 8 * kh + ks, lo); fb[ks] = frag_row<528, 0>(base + O_QI, 32 * ta, 8 * kh + ks, lo); }
                __builtin_amdgcn_sched_barrier(0);
#pragma unroll
                for (int ks = 0; ks < 8; ++ks) acc = __builtin_amdgcn_mfma_f32_32x32x16_bf16(fa[ks], fb[ks], acc, 0, 0, 0);
                __builtin_amdgcn_sched_barrier(0); }
            const float at_l = __shfl(at, 32 * ta + l31); const int t = 32 * ta + l31; float rsum = 0.f;
#pragma unroll
            for (int g = 0; g < 4; ++g) { const int s0 = 32 * tb + 8 * g + 4 * hi; const f32x4 us4 = *(LAS const f32x4*)(Fa + F_US + s0); float p[4];
#pragma unroll
                for (int i = 0; i < 4; ++i) { p[i] = (s0 + i <= t) ? acc[4 * g + i] * __builtin_amdgcn_exp2f(at_l + us4[i]) : 0.f; rsum += p[i]; }
                *(LAS unsigned long long*)(base + O_PI + ioff<144, 0>(t, s0 >> 3) + 2 * (s0 & 7)) = (unsigned long long)pk2(p[0], p[1]) | ((unsigned long long)pk2(p[2], p[3]) << 32); }
            rsum = half_sum(rsum);
            if (hi == 0) Fa[F_RSP + tb * 64 + t] = rsum;
        } else {
#pragma unroll
            for (int kh = 0; kh < 2; ++kh) { bf16x8 fa[8], fb[8];
#pragma unroll
                for (int ks = 0; ks < 8; ++ks) { fa[ks] = frag_row<528, 0>(base + O_QI, 32 * ta, 8 * kh + ks, lo); fb[ks] = frag_tr<136, 0>(base + O_CB, 0, 8 * kh + ks, 32 * tb, lo); }
                __builtin_amdgcn_sched_barrier(0);
#pragma unroll
                for (int ks = 0; ks < 8; ++ks) acc = __builtin_amdgcn_mfma_f32_32x32x16_bf16(fa[ks], fb[ks], acc, 0, 0, 0);
                __builtin_amdgcn_sched_barrier(0); }
        }
        { float s = 0.f;
#pragma unroll
          for (int c = 0; c < 4; ++c) { const v4u w = *(LAS const v4u*)(base + O_QI + ioff<528, 0>(lane, 4 * wave + c)); const f32x4 n0 = *(LAS const f32x4*)(Fa + F_NV + 32 * wave + 8 * c), n1 = *(LAS const f32x4*)(Fa + F_NV + 32 * wave + 8 * c + 4);
              s += bflo(w.x) * n0.x + bfhi(w.x) * n0.y + bflo(w.y) * n0.z + bfhi(w.y) * n0.w + bflo(w.z) * n1.x + bfhi(w.z) * n1.y + bflo(w.w) * n1.z + bfhi(w.w) * n1.w; }
          Fa[F_QNP + wave * 64 + lane] = s; }
        __syncthreads();
        if (wave >= 4) {
            { const int t = 32 * ta + l31;
              const float den = Fa[F_WIN + t] * (((Fa[F_QNP + t] + Fa[F_QNP + 64 + t]) + (Fa[F_QNP + 128 + t] + Fa[F_QNP + 192 + t])) + ((Fa[F_QNP + 256 + t] + Fa[F_QNP + 320 + t]) + (Fa[F_QNP + 384 + t] + Fa[F_QNP + 448 + t])))
                                + Fa[F_RSP + t] + Fa[F_RSP + 64 + t];
              if (hi == 0) Fa[F_CW + 32 * (wave - 4) + l31] = 1.0f / fmaxf(fabsf(den), Fa[F_EDEN + t]); }
#pragma unroll
            for (int g = 0; g < 4; ++g) { const f32x4 w4 = *(LAS const f32x4*)(Fa + F_WIN + 32 * ta + 8 * g + 4 * hi); acc[4 * g] *= w4.x; acc[4 * g + 1] *= w4.y; acc[4 * g + 2] *= w4.z; acc[4 * g + 3] *= w4.w; }
            { bf16x8 fa[4], fb[4];
#pragma unroll
              for (int ks = 0; ks < 4; ++ks) { fa[ks] = frag_row<144, 0>(base + O_PI, 32 * ta, ks, lo); fb[ks] = frag_tr<144, 0>(base + O_VI, 0, ks, 32 * tb, lo); }
              __builtin_amdgcn_sched_barrier(0);
#pragma unroll
              for (int ks = 0; ks < 4; ++ks) acc = __builtin_amdgcn_mfma_f32_32x32x16_bf16(fa[ks], fb[ks], acc, 0, 0, 0); }
            bf16* dst = F.YB() + (rowb + t0 + 32 * ta) * D + hh * 256 + 64 * sl + 32 * tb + l31;
#pragma unroll
            for (int g = 0; g < 4; ++g) { const f32x4 r4 = *(LAS const f32x4*)(Fa + F_CW + 32 * (wave - 4) + 8 * g + 4 * hi);
#pragma unroll
                for (int i = 0; i < 4; ++i) dst[(size_t)(8 * g + 4 * hi + i) * D] = (bf16)pk2(acc[4 * g + i] * r4[i], 0.f); }
        }
#pragma unroll
        for (int r = 0; r < 16; ++r) { C0[r] *= decay; C1[r] *= decay; C2[r] *= decay; }
        { bf16x8 bk[4], v0[4], v1[4], v2[4];
#pragma unroll
          for (int ks = 0; ks < 4; ++ks) { bk[ks] = frag_tr<528, 0>(base + O_KI, 0, ks, 32 * wave, lo); v0[ks] = frag_tr<144, 0>(base + O_VW, 0, ks, 0, lo); v1[ks] = frag_tr<144, 0>(base + O_VW, 0, ks, 32, lo); v2[ks] = frag_tr<144, 0>(base + O_VW, 0, ks, 64, lo); }
          __builtin_amdgcn_sched_barrier(0);
#pragma unroll
          for (int ks = 0; ks < 4; ++ks) { C0 = __builtin_amdgcn_mfma_f32_32x32x16_bf16(v0[ks], bk[ks], C0, 0, 0, 0); C1 = __builtin_amdgcn_mfma_f32_32x32x16_bf16(v1[ks], bk[ks], C1, 0, 0, 0); C2 = __builtin_amdgcn_mfma_f32_32x32x16_bf16(v2[ks], bk[ks], C2, 0, 0, 0); }
          __builtin_amdgcn_sched_barrier(0); }
        { const int d = 32 * wave + l31;
#pragma unroll
          for (int g = 0; g < 4; ++g) { const int e0 = 8 * g + 4 * hi;
              *(LAS unsigned long long*)(base + O_CB + ioff<136, 0>(d, e0 >> 3) + 2 * (e0 & 7)) = (unsigned long long)pk2(C0[4 * g], C0[4 * g + 1]) | ((unsigned long long)pk2(C0[4 * g + 2], C0[4 * g + 3]) << 32);
              *(LAS unsigned long long*)(base + O_CB + ioff<136, 0>(d, (32 + e0) >> 3) + 2 * (e0 & 7)) = (unsigned long long)pk2(C1[4 * g], C1[4 * g + 1]) | ((unsigned long long)pk2(C1[4 * g + 2], C1[4 * g + 3]) << 32); }
          if (hi == 0) Fa[F_NV + d] = C2[0];
        }
        __syncthreads();
      }
    }
#undef ML_PREFETCH
}
}


__device__ __forceinline__ void mlstm_gates(Frame& F, int job) {
    const int lane = opq(F.lane); const float LOG2E = 1.4426950408889634f;
    const float lf2 = F.lf()[(size_t)job * ml::L + lane] * LOG2E, ii2 = F.ipre()[(size_t)job * ml::L + lane] * LOG2E;
    float bb = lf2;
#pragma unroll
    for (int o = 1; o < 64; o <<= 1) { const float v = __shfl_up(bb, o); bb += (lane >= o) ? v : 0.f; }
    const float u = ii2 - bb; float pm = u;
#pragma unroll
    for (int o = 1; o < 64; o <<= 1) { const float v = __shfl_up(pm, o); pm = (lane >= o) ? fmaxf(pm, v) : pm; }
    float* gt = F.gt() + (size_t)job * 3 * 64 + lane;
    gt[0] = bb; gt[64] = u; gt[128] = pm;
}

__device__ __forceinline__ void mlstm_conv_rows(Frame& F) {
    const int tid = opq(F.tid), cg = tid & 255, z = cg >> 7, c0 = (cg & 127) * 8, r0 = F.vcu * 128 + 64 * (tid >> 8);
    const bf16* src = F.PROJ() + (size_t)(3 + z) * (SEG / 2) + c0; bf16* dst = (bf16*)F.out() + (size_t)z * T * D + c0;
    float w[4][8], bs[8];
#pragma unroll
    for (int tap = 0; tap < 4; ++tap) { const f32x4 a0 = *(const f32x4*)(F.conv_w() + tap * 2048 + cg * 8), a1 = *(const f32x4*)(F.conv_w() + tap * 2048 + cg * 8 + 4);
        w[tap][0] = a0.x; w[tap][1] = a0.y; w[tap][2] = a0.z; w[tap][3] = a0.w; w[tap][4] = a1.x; w[tap][5] = a1.y; w[tap][6] = a1.z; w[tap][7] = a1.w; }
    { const f32x4 a0 = *(const f32x4*)(F.conv_b() + cg * 8), a1 = *(const f32x4*)(F.conv_b() + cg * 8 + 4);
      bs[0] = a0.x; bs[1] = a0.y; bs[2] = a0.z; bs[3] = a0.w; bs[4] = a1.x; bs[5] = a1.y; bs[6] = a1.z; bs[7] = a1.w; }
    const float osc = z ? 0.0625f : 1.0f;
    const bool seq_start = (r0 % SEQ) == 0;
    v4u x0, x1, x2;
    { const v4u zero = {0u, 0u, 0u, 0u};
      x0 = seq_start ? zero : *(const v4u*)(src + (size_t)(r0 - 3 + (seq_start ? 3 : 0)) * D);
      x1 = seq_start ? zero : *(const v4u*)(src + (size_t)(r0 - 2 + (seq_start ? 2 : 0)) * D);
      x2 = seq_start ? zero : *(const v4u*)(src + (size_t)(r0 - 1 + (seq_start ? 1 : 0)) * D); }
    for (int rr = 0; rr < 64; rr += 8) {
        v4u xs[8];
#pragma unroll
        for (int i = 0; i < 8; ++i) xs[i] = *(const v4u*)(src + (size_t)(r0 + rr + i) * D);
#pragma unroll
        for (int i = 0; i < 8; ++i) {
            const v4u x3 = xs[i]; float y[8];
#pragma unroll
            for (int c = 0; c < 8; ++c) y[c] = bs[c];
#define MK_TAP(tap, X) do { y[0] += w[tap][0] * bflo(X.x); y[1] += w[tap][1] * bfhi(X.x); y[2] += w[tap][2] * bflo(X.y); y[3] += w[tap][3] * bfhi(X.y); \
                           y[4] += w[tap][4] * bflo(X.z); y[5] += w[tap][5] * bfhi(X.z); y[6] += w[tap][6] * bflo(X.w); y[7] += w[tap][7] * bfhi(X.w); } while (0)
            MK_TAP(0, x0); MK_TAP(1, x1); MK_TAP(2, x2); MK_TAP(3, x3);
#undef MK_TAP
#pragma unroll
            for (int c = 0; c < 8; ++c) y[c] = ml::silu_f(y[c]) * osc;
            v4u o; o.x = pk2(y[0], y[1]); o.y = pk2(y[2], y[3]); o.z = pk2(y[4], y[5]); o.w = pk2(y[6], y[7]);
            *(v4u*)(dst + (size_t)(r0 + rr + i) * D) = o;
            x0 = x1; x1 = x2; x2 = x3;
        }
    }
}

__device__ __forceinline__ void mlstm_norm_rows(Frame& F) {
    const int row0 = F.vcu * 128, lane = opq(F.lane);
    const bf16* MLO = F.PROJ() + 6 * (SEG / 2);
    f32x4 G[4];
#pragma unroll
    for (int j = 0; j < 4; ++j) G[j] = *(const f32x4*)(F.ml_norm_g() + 256 * j + 4 * lane);
    for (int r = 0; r < 16; ++r) {
        const size_t row = (size_t)row0 + 16 * F.wave + r;
        GAS unsigned long long* hp = (GAS unsigned long long*)(F.YB() + row * D) + lane; const GAS unsigned long long* op = (const GAS unsigned long long*)(MLO + row * D) + lane;
#pragma unroll
        for (int j = 0; j < 4; ++j) { const unsigned long long hw = hp[64 * j], ow = op[64 * j];
            const float h0 = bflo((unsigned)hw), h1 = bfhi((unsigned)hw), h2 = bflo((unsigned)(hw >> 32)), h3 = bfhi((unsigned)(hw >> 32));
            const float ss = wave_sum((h0 * h0 + h1 * h1) + (h2 * h2 + h3 * h3)); const float rstd = 1.0f / sqrtf(ss * (1.0f / 256.0f) + EPS);
            const float o0 = bflo((unsigned)ow), o1 = bfhi((unsigned)ow), o2 = bflo((unsigned)(ow >> 32)), o3 = bfhi((unsigned)(ow >> 32));
            const float y0 = h0 * rstd * G[j].x / (1.0f + __expf(-o0)), y1 = h1 * rstd * G[j].y / (1.0f + __expf(-o1)), y2 = h2 * rstd * G[j].z / (1.0f + __expf(-o2)), y3 = h3 * rstd * G[j].w / (1.0f + __expf(-o3));
            hp[64 * j] = (unsigned long long)pk2(y0, y1) | ((unsigned long long)pk2(y2, y3) << 32); }
    }
}

namespace at {
using ml::bf16x8; using ml::s16x4; using ml::f32x16; using ml::ioff; using ml::frag_row; using ml::lcp; using ml::lp_t;
typedef _Float16 f16x8 __attribute__((ext_vector_type(8)));
typedef _Float16 f16x2 __attribute__((ext_vector_type(2)));
typedef float f32x2 __attribute__((ext_vector_type(2)));
constexpr int O_KI = 0, O_VI = 8192, O_FLAG = 16384;
template <int PITCH, int XM> __device__ __forceinline__ bf16x8 frag_trp(lcp img, int ks, int col0, int lane) {
    const int h = lane >> 5, blk = (lane >> 4) & 1, q = (lane & 15) >> 2, p = lane & 3;
    const int r0 = 16 * ks + 4 * h + q, ch = (col0 >> 3) + 2 * blk + (p >> 1);
    typedef short v4i16_t __attribute__((ext_vector_type(4)));
    const s16x4 a = __builtin_bit_cast(s16x4, __builtin_amdgcn_ds_read_tr16_b64_v4i16((LAS v4i16_t*)(img + ioff<PITCH, XM>(r0, ch) + 8 * (p & 1))));
    const s16x4 b = __builtin_bit_cast(s16x4, __builtin_amdgcn_ds_read_tr16_b64_v4i16((LAS v4i16_t*)(img + ioff<PITCH, XM>(r0 + 8, ch) + 8 * (p & 1))));
    return (bf16x8){a[0], a[1], a[2], a[3], b[0], b[1], b[2], b[3]};
}
__device__ __forceinline__ unsigned pkh(float a, float b) { const f32x2 v = {a, b}; return __builtin_bit_cast(unsigned, __builtin_convertvector(v, f16x2)); }
__device__ __forceinline__ f16x8 h8(unsigned a, unsigned b, unsigned c, unsigned d) { const v4u v = {a, b, c, d}; return __builtin_bit_cast(f16x8, v); }
__device__ __forceinline__ bf16x8 b8(unsigned a, unsigned b, unsigned c, unsigned d) { const v4u v = {a, b, c, d}; return __builtin_bit_cast(bf16x8, v); }

__device__ __forceinline__ void attn_unit(Frame& F, int bh, int qb) {
    const int b = bh >> 4, hd = bh & 15, tid = opq(F.tid), lane = opq(F.lane), wave = F.wave, hi = lane >> 5, l31 = lane & 31, pr = wave >> 1, tp = tid & 127;
    const bf16* Q = F.PROJ(); const bf16* K = F.PROJ() + SEG / 2; const bf16* V = F.PROJ() + SEG;
    lp_t base = (lp_t)F.lds + pr * 16384;
    LAS volatile int* dflag = (LAS volatile int*)((lp_t)F.lds + 65536);
    const size_t rowb = (size_t)b * SEQ; const int q0 = qb * 256, tw0 = q0 + 32 * wave, t = tw0 + l31, kt0 = qb * 4 + pr;
    bf16x8 qr[4];
#pragma unroll
    for (int ks = 0; ks < 4; ++ks) qr[ks] = *(const bf16x8*)(Q + (rowb + t) * D + hd * 64 + 16 * ks + 8 * hi);
    unsigned uw[2][4];
#pragma unroll
    for (int sp = 0; sp < 2; ++sp)
#pragma unroll
        for (int jj = 0; jj < 4; ++jj) { const int j0 = 2 * jj, j1 = 2 * jj + 1;
            const int k0 = 16 * sp + 8 * (j0 >> 2) + 4 * hi + (j0 & 3), k1 = 16 * sp + 8 * (j1 >> 2) + 4 * hi + (j1 & 3);
            uw[sp][jj] = (k0 > l31 ? 0x3C00u : 0u) | (k1 > l31 ? 0x3C000000u : 0u); }
    const f16x8 U0 = h8(uw[0][0], uw[0][1], uw[0][2], uw[0][3]), U1 = h8(uw[1][0], uw[1][1], uw[1][2], uw[1][3]), ONES = h8(0x3C003C00u, 0x3C003C00u, 0x3C003C00u, 0x3C003C00u);
    f32x16 O0, O1;
#pragma unroll
    for (int r = 0; r < 16; ++r) { O0[r] = 0.f; O1[r] = 0.f; }
    float R = 0.f; bool wdone = false;
    v4u kreg[4], vreg[4];
#define AT_LOAD(KT) do { _Pragma("unroll") for (int j = 0; j < 4; ++j) { const size_t g = (rowb + (KT) * 64 + (tp >> 3) + 16 * j) * D + hd * 64 + (tp & 7) * 8; kreg[j] = *(const v4u*)(K + g); vreg[j] = *(const v4u*)(V + g); } } while (0)
    AT_LOAD(kt0);
    __syncthreads();
    if (tid < 8) dflag[tid] = 0;
    for (int it = 0; it <= qb * 4 + 3; ++it) {
        const int kt = kt0 - it;
        __syncthreads();
        { int nd = 0;
#pragma unroll
          for (int w = 0; w < 8; ++w) nd += dflag[w];
          if (nd == 8) break; }
        if (kt >= 0) {
#pragma unroll
            for (int j = 0; j < 4; ++j) { *(LAS v4u*)(base + O_KI + ioff<128, 7>((tp >> 3) + 16 * j, tp & 7)) = kreg[j]; *(LAS v4u*)(base + O_VI + ioff<128, 7>((tp >> 3) + 16 * j, tp & 7)) = vreg[j]; } }
        __syncthreads();
        if (kt > 0) AT_LOAD(kt - 1);
        if (kt < 0) { if (!wdone) { wdone = true; if (lane == 0) dflag[wave] = 1; } continue; }
        if (wdone) continue;
        int lo = lane; asm volatile("" : "+v"(lo));
        f32x16 p0, p1;
#pragma unroll
        for (int r = 0; r < 16; ++r) { p0[r] = 0.f; p1[r] = 0.f; }
#pragma unroll
        for (int ks = 0; ks < 4; ++ks) { p0 = __builtin_amdgcn_mfma_f32_32x32x16_bf16(frag_row<128, 7>(base + O_KI, 0, ks, lo), qr[ks], p0, 0, 0, 0);
                                         p1 = __builtin_amdgcn_mfma_f32_32x32x16_bf16(frag_row<128, 7>(base + O_KI, 32, ks, lo), qr[ks], p1, 0, 0, 0); }
        const bool diag = (it == 0);
        const int trel = t - 64 * kt;
        float lk00 = 0.f;
        unsigned lkw0[8], lkw1[8];
#pragma unroll
        for (int r = 0; r < 16; ++r) {
            const int key0 = ml::crow(r, hi);
            { const float z = p0[r], lb = fminf(z, 0.f) - __builtin_amdgcn_logf(1.0f + __builtin_amdgcn_exp2f(-fabsf(z))); float lk = lb - z; if (diag && !(key0 < trel)) lk = 0.f; p0[r] = lb; if (r == 0) lk00 = lk;
              if (r & 1) lkw0[r >> 1] = pkh(__builtin_bit_cast(float, lkw0[r >> 1]), lk); else lkw0[r >> 1] = __builtin_bit_cast(unsigned, lk); }
            { const float z = p1[r], lb = fminf(z, 0.f) - __builtin_amdgcn_logf(1.0f + __builtin_amdgcn_exp2f(-fabsf(z))); float lk = lb - z; if (diag && !(key0 + 32 < trel)) lk = 0.f; p1[r] = lb;
              if (r & 1) lkw1[r >> 1] = pkh(__builtin_bit_cast(float, lkw1[r >> 1]), lk); else lkw1[r >> 1] = __builtin_bit_cast(unsigned, lk); }
        }
        f32x16 bt1, bt0;
#pragma unroll
        for (int r = 0; r < 16; ++r) { bt1[r] = R; bt0[r] = R; }
        const f16x8 L10 = h8(lkw1[0], lkw1[1], lkw1[2], lkw1[3]), L11 = h8(lkw1[4], lkw1[5], lkw1[6], lkw1[7]), L00 = h8(lkw0[0], lkw0[1], lkw0[2], lkw0[3]), L01 = h8(lkw0[4], lkw0[5], lkw0[6], lkw0[7]);
        bt1 = __builtin_amdgcn_mfma_f32_32x32x16_f16(U0, L10, bt1, 0, 0, 0); bt1 = __builtin_amdgcn_mfma_f32_32x32x16_f16(U1, L11, bt1, 0, 0, 0);
        bt0 = __builtin_amdgcn_mfma_f32_32x32x16_f16(ONES, L10, bt0, 0, 0, 0); bt0 = __builtin_amdgcn_mfma_f32_32x32x16_f16(ONES, L11, bt0, 0, 0, 0);
        bt0 = __builtin_amdgcn_mfma_f32_32x32x16_f16(U0, L00, bt0, 0, 0, 0); bt0 = __builtin_amdgcn_mfma_f32_32x32x16_f16(U1, L01, bt0, 0, 0, 0);
        { const float v = bt0[0] + lk00;
          const auto rr = __builtin_amdgcn_permlane32_swap(__builtin_bit_cast(unsigned, v), __builtin_bit_cast(unsigned, v), false, false);
          R = __builtin_bit_cast(float, rr[0]); }
        unsigned aw0[8], aw1[8];
#pragma unroll
        for (int r = 0; r < 16; r += 2) {
            const int key0 = ml::crow(r, hi);
            float a00 = __builtin_amdgcn_exp2f(p0[r] + bt0[r]), a01 = __builtin_amdgcn_exp2f(p0[r + 1] + bt0[r + 1]), a10 = __builtin_amdgcn_exp2f(p1[r] + bt1[r]), a11 = __builtin_amdgcn_exp2f(p1[r + 1] + bt1[r + 1]);
            if (diag) { if (!(key0 < trel)) a00 = 0.f; if (!(key0 + 1 < trel)) a01 = 0.f; if (!(key0 + 32 < trel)) a10 = 0.f; if (!(key0 + 33 < trel)) a11 = 0.f; }
            aw0[r >> 1] = pk2(a00, a01); aw1[r >> 1] = pk2(a10, a11);
        }
        const bf16x8 A00 = b8(aw0[0], aw0[1], aw0[2], aw0[3]), A01 = b8(aw0[4], aw0[5], aw0[6], aw0[7]), A10 = b8(aw1[0], aw1[1], aw1[2], aw1[3]), A11 = b8(aw1[4], aw1[5], aw1[6], aw1[7]);
        O0 = __builtin_amdgcn_mfma_f32_32x32x16_bf16(A00, frag_trp<128, 7>(base + O_VI, 0, 0, lo), O0, 0, 0, 0);  O1 = __builtin_amdgcn_mfma_f32_32x32x16_bf16(A00, frag_trp<128, 7>(base + O_VI, 0, 32, lo), O1, 0, 0, 0);
        O0 = __builtin_amdgcn_mfma_f32_32x32x16_bf16(A01, frag_trp<128, 7>(base + O_VI, 1, 0, lo), O0, 0, 0, 0);  O1 = __builtin_amdgcn_mfma_f32_32x32x16_bf16(A01, frag_trp<128, 7>(base + O_VI, 1, 32, lo), O1, 0, 0, 0);
        O0 = __builtin_amdgcn_mfma_f32_32x32x16_bf16(A10, frag_trp<128, 7>(base + O_VI, 2, 0, lo), O0, 0, 0, 0);  O1 = __builtin_amdgcn_mfma_f32_32x32x16_bf16(A10, frag_trp<128, 7>(base + O_VI, 2, 32, lo), O1, 0, 0, 0);
        O0 = __builtin_amdgcn_mfma_f32_32x32x16_bf16(A11, frag_trp<128, 7>(base + O_VI, 3, 0, lo), O0, 0, 0, 0);  O1 = __builtin_amdgcn_mfma_f32_32x32x16_bf16(A11, frag_trp<128, 7>(base + O_VI, 3, 32, lo), O1, 0, 0, 0);
        if (__all(R < ATT_RTHR)) { wdone = true; if (lane == 0) dflag[wave] = 1; }
    }
#undef AT_LOAD
    __syncthreads();
    bf16* dst = F.YA() + (rowb + tw0) * D + hd * 64 + l31;
#pragma unroll
    for (int r = 0; r < 16; ++r) { const int q = ml::crow(r, hi); dst[(size_t)q * D] = (bf16)pk2(O0[r], 0.f); dst[(size_t)q * D + 32] = (bf16)pk2(O1[r], 0.f); }
}
}

__device__ __forceinline__ void p5a_route(Frame& F) {
    const int row0 = F.vcu * 128, b = row0 / SEQ, lane = opq(F.lane), tid = opq(F.tid);
    LAS float* wr = (LAS float*)F.lds;
    LAS int* le = (LAS int*)(F.lds + 131584); LAS int* lp = le + 512;
    LAS int* lcnt = (LAS int*)(F.LC + LC_LCNT); LAS int* gbase = (LAS int*)(F.LC + LC_GBASE);
    for (int idx = tid; idx < 32768; idx += 512) wr[(idx & 31) * 1028 + (idx >> 5)] = F.router_w()[idx];
    if (tid < 32) lcnt[tid] = 0;
    f32x4 Av[4], Bv[4];
#pragma unroll
    for (int j = 0; j < 4; ++j) { const int col = 4 * lane + 256 * j; const float* mb = F.mod() + (size_t)b * NMOD;
        const f32x4 g = *(const f32x4*)(F.norm2_g() + col); Av[j] = g * (*(const f32x4*)(mb + 4 * D + col) + 1.0f); Bv[j] = *(const f32x4*)(mb + 3 * D + col); }
    float rb[32];
#pragma unroll
    for (int e = 0; e < 32; ++e) rb[e] = F.router_b()[e];
    __syncthreads();
    for (int r = 0; r < 16; ++r) {
        const int rl = 16 * F.wave + r, row = row0 + rl;
        const GAS f32x4* xr = (const GAS f32x4*)(F.out() + (size_t)row * D) + lane;
        f32x4 v[4]; float ss = 0.f;
#pragma unroll
        for (int j = 0; j < 4; ++j) { v[j] = xr[64 * j]; ss += (v[j].x * v[j].x + v[j].y * v[j].y) + (v[j].z * v[j].z + v[j].w * v[j].w); }
        const float rstd = 1.0f / sqrtf(wave_sum(ss) * (1.0f / D) + EPS);
        { GAS unsigned long long* o8 = (GAS unsigned long long*)(F.H2() + (size_t)row * D) + lane;
#pragma unroll
          for (int j = 0; j < 4; ++j) { v[j] = v[j] * rstd * Av[j] + Bv[j]; o8[64 * j] = (unsigned long long)pk2(v[j].x, v[j].y) | ((unsigned long long)pk2(v[j].z, v[j].w) << 32); } }
        float p[32];
#pragma unroll
        for (int e = 0; e < 32; ++e) { float s = 0.f;
#pragma unroll
            for (int j = 0; j < 4; ++j) { const f32x4 w = *(const LAS f32x4*)(wr + e * 1028 + 4 * lane + 256 * j); s += (v[j].x * w.x + v[j].y * w.y) + (v[j].z * w.z + v[j].w * w.w); }
            p[e] = s; }
#pragma unroll
        for (int e = 0; e < 32; ++e) p[e] = wave_sum(p[e]) + rb[e];
        int sel[4]; float sv[4]; unsigned used = 0u;
#pragma unroll
        for (int k = 0; k < 4; ++k) { float best = -3.0e38f; int bi = 0;
#pragma unroll
            for (int e = 0; e < 32; ++e) { const bool cnd = (((used >> e) & 1u) == 0u) && (p[e] > best); best = cnd ? p[e] : best; bi = cnd ? e : bi; }
            sel[k] = bi; sv[k] = best; used |= 1u << bi; }
        const float e1 = __expf(sv[1] - sv[0]), e2 = __expf(sv[2] - sv[0]), e3 = __expf(sv[3] - sv[0]), inv = 1.0f / (1.0f + e1 + e2 + e3);
        if (lane < 4) { const int ek = lane == 0 ? sel[0] : lane == 1 ? sel[1] : lane == 2 ? sel[2] : sel[3];
            const float wk = (lane == 0 ? 1.0f : lane == 1 ? e1 : lane == 2 ? e2 : e3) * inv;
            const int pos = __hip_atomic_fetch_add(lcnt + ek, 1, __ATOMIC_RELAXED, __HIP_MEMORY_SCOPE_WORKGROUP);
            le[rl * 4 + lane] = ek; lp[rl * 4 + lane] = pos; F.tokw()[(size_t)row * 4 + lane] = wk; }
        if (lane == 0) F.rstd2()[row] = rstd;
    }
    __syncthreads();
    if (tid < 32) gbase[tid] = (int)__hip_atomic_fetch_add(F.ctl + CW_ECNT + 64 * tid, (unsigned)lcnt[tid], __ATOMIC_RELAXED, __HIP_MEMORY_SCOPE_AGENT);
    __syncthreads();
    { const int ek = le[tid]; F.toke()[(size_t)row0 * 4 + tid] = ek; F.tokp()[(size_t)row0 * 4 + tid] = lp[tid] + gbase[ek]; }
}

__device__ __forceinline__ void p5b_tables(Frame& F) {
    const int row0 = F.vcu * 128, tid = opq(F.tid);
    LAS int* ts = (LAS int*)(F.LC + LC_TS); LAS int* ps = (LAS int*)(F.LC + LC_PS); LAS int* cn = (LAS int*)(F.LC + LC_CNT);
    if (tid < 32) cn[tid] = (int)__hip_atomic_load(F.ctl + CW_ECNT + 64 * tid, RLX_AGENT);
    __syncthreads();
    if (tid == 0) { int run = 0, trun = 0; for (int e = 0; e < 32; ++e) { ps[e] = run; ts[e] = trun; const int nt = (cn[e] + 255) >> 8; run += nt * 256; trun += nt; } ts[32] = trun; }
    __syncthreads();
    { const size_t idx = (size_t)row0 * 4 + tid; const int ek = F.toke()[idx], dst = ps[ek] + F.tokp()[idx]; F.tokrow()[idx] = dst; F.row2tok()[dst] = row0 + (tid >> 2); }
    if (F.vcu < 32) { const int e = F.vcu, start = ps[e] + cn[e], end = ps[e] + (((cn[e] + 255) >> 8) << 8); for (int r = start + tid; r < end; r += 512) F.row2tok()[r] = 0; }
}

__device__ __forceinline__ void p8_combine(Frame& F, bool poison) {
    const int row0 = F.vcu * 128, b = row0 / SEQ, lane = opq(F.lane);
    f32x4 G2[4], FG[4];
#pragma unroll
    for (int j = 0; j < 4; ++j) { const int col = 4 * lane + 256 * j; G2[j] = *(const f32x4*)(F.mod() + (size_t)b * NMOD + 5 * D + col); FG[j] = *(const f32x4*)(F.final_g() + col); }
    for (int r = 0; r < 16; ++r) {
        const int row = row0 + 16 * F.wave + r;
        GAS f32x4* xr = (GAS f32x4*)(F.out() + (size_t)row * D) + lane;
        f32x4 y[4];
#pragma unroll
        for (int j = 0; j < 4; ++j) y[j] = (f32x4){0.f, 0.f, 0.f, 0.f};
#pragma unroll
        for (int k = 0; k < 4; ++k) { const int src = F.tokrow()[(size_t)row * 4 + k]; const float wk = F.tokw()[(size_t)row * 4 + k];
            const GAS unsigned long long* s8 = (const GAS unsigned long long*)(F.OUTR() + (size_t)src * D) + lane;
#pragma unroll
            for (int j = 0; j < 4; ++j) { const unsigned long long w = s8[64 * j]; y[j].x += wk * bflo((unsigned)w); y[j].y += wk * bfhi((unsigned)w); y[j].z += wk * bflo((unsigned)(w >> 32)); y[j].w += wk * bfhi((unsigned)(w >> 32)); } }
        f32x4 v[4]; float ss = 0.f;
#pragma unroll
        for (int j = 0; j < 4; ++j) { v[j] = xr[64 * j] + G2[j] * y[j]; ss += (v[j].x * v[j].x + v[j].y * v[j].y) + (v[j].z * v[j].z + v[j].w * v[j].w); }
        const float rstd = 1.0f / sqrtf(wave_sum(ss) * (1.0f / D) + EPS);
        const float qn = __builtin_nanf("");
#pragma unroll
        for (int j = 0; j < 4; ++j) { f32x4 o = v[j] * rstd * FG[j]; if (poison) o = (f32x4){qn, qn, qn, qn}; xr[64 * j] = o; }
    }
}

#ifndef MK_REP_G2
#define MK_REP_G2 1
#endif
#ifndef MK_REP_G4A
#define MK_REP_G4A 1
#endif
#ifndef MK_REP_G4B
#define MK_REP_G4B 1
#endif
#ifndef MK_REP_G4C
#define MK_REP_G4C 1
#endif
#ifndef MK_REP_G6
#define MK_REP_G6 1
#endif
#ifndef MK_REP_G7
#define MK_REP_G7 1
#endif
#ifndef MK_REP_P0
#define MK_REP_P0 1
#endif
#ifndef MK_REP_P3
#define MK_REP_P3 1
#endif
struct Args { const float* in[22]; float* out; unsigned char* ws; };
__global__ void __launch_bounds__(NWAVES * 64, 2) mk_fwd(Args args) {
    extern __shared__ __attribute__((aligned(16))) unsigned char lds[];
    Frame F;
    F.lds = (LAS unsigned char*)lds; F.LC = (volatile LAS unsigned*)(F.lds + LDSCTL_OFF);
    F.tid = threadIdx.x; F.lane = F.tid & 63; F.wave = __builtin_amdgcn_readfirstlane(F.tid >> 6);
    F.G = gridDim.x; { const int bx = blockIdx.x; F.vcu = (F.G % 8 == 0) ? (bx % 8) * (F.G / 8) + bx / 8 : bx; }
    F.ws = (unsigned char*)(GAS unsigned char*)karg(23);
    F.ctl = (gu32*)(F.ws + WS_CTL);
    for (int u = F.tid; u < (LDS_BYTES - LDSCTL_OFF) / 4; u += NWAVES * 64) ((LAS unsigned*)(F.lds + LDSCTL_OFF))[u] = 0u;
    __syncthreads();
    XcdBarrier bar = xcd_barrier_post((unsigned*)(F.ctl + CW_BAR), F.LC + LC_BAR);
#define GRID_BAR() xcd_barrier(bar)
    const int G = F.G, cid = (int)blockIdx.x;

    for (int rep_ = 0; rep_ < MK_REP_P0; ++rep_) p0_prologue(F);
    GRID_BAR();
    p1_rows(F);
    GRID_BAR();
    { pg8::Gemm g{F.H1(), F.WIN_T(), T, NPROJ, D}; pg8::StaticOrder S; S.init(T, NPROJ, G, cid);
      pg8::EpiBf16<0> E{F.PROJ(), D, nullptr, D, SEG / 2, QSCALE};
      for (int rep_ = 0; rep_ < MK_REP_G2; ++rep_) pg8::gemm_phase<pg8::EpiBf16<0>, pg8::StaticOrder, true, true>(F.lds, g, S, E); }
    GRID_BAR();
    for (int job = F.vcu * NWAVES + F.wave; job < BATCH * 4 * (SEQ / 64); job += G * NWAVES) mlstm_gates(F, job);
    mlstm_conv_rows(F);
    GRID_BAR();
#if defined(MK_NAIVE_MLSTM)
    for (int it = F.vcu; it < 1024; it += G) attn_naive_item(F, it & 255, it >> 8);
    __syncthreads();
    for (int it = F.vcu; it < 64; it += G) mlstm_naive_item(F, it);
#else
    for (int rep_ = 0; rep_ < MK_REP_P3; ++rep_) {
    for (int it = F.vcu; it < 256; it += G) ml::mlstm_unit(F, it);
    __syncthreads();
#if defined(MK_NAIVE_ATTN)
    for (int it = F.vcu; it < 1024; it += G) attn_naive_item(F, it & 255, it >> 8);
#else
    for (int it = F.vcu; it < 2048; it += G) at::attn_unit(F, it & 255, it >> 8);
#endif
    }
#endif
    GRID_BAR();
    { pg8::Gemm g{F.YA(), F.WA_T(), T, D, D}; pg8::StaticOrder S; S.init(T, D, G, cid);
      pg8::EpiGate<false> E{F.PROJ() + 7 * (SEG / 2), nullptr, F.M1()};
      for (int rep_ = 0; rep_ < MK_REP_G4A; ++rep_) pg8::gemm_phase<pg8::EpiGate<false>, pg8::StaticOrder, true, true>(F.lds, g, S, E); }
#if defined(MK_NAIVE_MLSTM)
    VM_WAIT(); __syncthreads();
#else
    __syncthreads();
    mlstm_norm_rows(F);
    GRID_BAR();
#endif
    { pg8::Gemm g{F.YB(), F.WB_T(), T, D, D}; pg8::StaticOrder S; S.init(T, D, G, cid);
      pg8::EpiGate<true> E{F.PROJ() + 8 * (SEG / 2), F.M1(), F.MERGED()};
      for (int rep_ = 0; rep_ < MK_REP_G4B; ++rep_) pg8::gemm_phase<pg8::EpiGate<true>, pg8::StaticOrder, true, true>(F.lds, g, S, E); }
    GRID_BAR();
    { pg8::Gemm g{F.MERGED(), F.WOUT_T(), T, D, D}; pg8::StaticOrder S; S.init(T, D, G, cid);
      pg8::EpiResid E{F.x(), F.mod() + 2 * D, F.out(), SEQ, NMOD};
      for (int rep_ = 0; rep_ < MK_REP_G4C; ++rep_) pg8::gemm_phase<pg8::EpiResid, pg8::StaticOrder, true, true>(F.lds, g, S, E); }
    GRID_BAR();
    p5a_route(F);
    GRID_BAR();
    p5b_tables(F);
    GRID_BAR();
    { pg8::Gemm g{F.H2(), F.W1_T(), T, NE * 2048, D}; pg8::GroupedOrder S{(const LAS int*)(F.LC + LC_TS), 8, G, cid, F.row2tok()};
      pg8::EpiSwiglu E{F.b1(), F.ACT()};
      for (int rep_ = 0; rep_ < MK_REP_G6; ++rep_) pg8::gemm_phase<pg8::EpiSwiglu, pg8::GroupedOrder, true, true, true>(F.lds, g, S, E); }
    GRID_BAR();
    { pg8::Gemm g{F.ACT(), F.W2_T(), XS_ROWS, NE * 1024, D}; pg8::GroupedOrder S{(const LAS int*)(F.LC + LC_TS), 4, G, cid, nullptr};
      pg8::EpiBf16<0> E{F.OUTR(), D, F.b2(), D, 0, 1.0f};
      for (int rep_ = 0; rep_ < MK_REP_G7; ++rep_) pg8::gemm_phase<pg8::EpiBf16<0>, pg8::GroupedOrder, true, true>(F.lds, g, S, E); }
    GRID_BAR();
    { const bool poison = __hip_atomic_load(F.ctl + CW_BAR + XB_TMO, RLX_AGENT) != 0u;
      p8_combine(F, poison); }
}

extern "C" void kernel_launch(void* const* d_in, const int* in_sizes, int n_in, void* d_out, int out_size, void* d_ws, size_t ws_size, hipStream_t stream) {
    static int grid = 0;
    if (grid == 0) {
        if (n_in != 22 || in_sizes[0] != T * D || out_size != T * D || ws_size < WS_END) { fprintf(stderr, "kernel_launch: unexpected shapes (n_in %d, in0 %d, out %d, ws %zu)\n", n_in, n_in > 0 ? in_sizes[0] : -1, out_size, ws_size); grid = -1; return; }
        int dev = 0, cus = 0, per_cu = 0;
        if (hipGetDevice(&dev) != hipSuccess || hipDeviceGetAttribute(&cus, hipDeviceAttributeMultiprocessorCount, dev) != hipSuccess) { grid = -1; return; }
        if (hipFuncSetAttribute((const void*)mk_fwd, hipFuncAttributeMaxDynamicSharedMemorySize, LDS_BYTES) != hipSuccess) { fprintf(stderr, "kernel_launch: hipFuncSetAttribute failed\n"); grid = -1; return; }
        if (hipOccupancyMaxActiveBlocksPerMultiprocessor(&per_cu, (const void*)mk_fwd, NWAVES * 64, LDS_BYTES) != hipSuccess || per_cu < 1) { fprintf(stderr, "kernel_launch: occupancy query says %d blocks per CU\n", per_cu); }
        (void)hipGetLastError();
        if (cus < 256) { fprintf(stderr, "kernel_launch: built for a 256-CU device, found %d CUs\n", cus); grid = -1; return; }
        grid = 256;
    }
    if (grid < 0) return;
    if (hipMemsetAsync((char*)d_ws + WS_CTL, 0, CTL_ZERO_BYTES, stream) != hipSuccess) return;
    Args a{};
    for (int i = 0; i < 22; ++i) a.in[i] = (const float*)d_in[i];
    a.out = (float*)d_out; a.ws = (unsigned char*)d_ws;
    hipLaunchKernelGGL(mk_fwd, dim3(grid), dim3(NWAVES * 64), LDS_BYTES, stream, a);
}
```

```cpp
#include <hip/hip_runtime.h>
#include <cstdio>
#include <cstdint>
namespace pg8 {
#define PG8_LAS __attribute__((address_space(3)))
typedef unsigned short bf16_t;
typedef short bf16x8 __attribute__((ext_vector_type(8)));
typedef float f32x4 __attribute__((ext_vector_type(4)));
typedef unsigned u32x4 __attribute__((ext_vector_type(4)));
constexpr int BM = 256, BK = 64, HALF = 128, HTB = HALF * BK * 2  , STAGE_BYTES = 8 * HTB, NXCD = 8, WGM = 8;

__host__ __device__ __forceinline__ int lds_byte(int r, int c) { const int st = (r >> 4) * 2 + (c >> 5), rr = r & 15, cc = c & 31, ob = rr * 64 + cc * 2; return st * 1024 + (ob ^ (((ob >> 9) & 1) << 5)); }
__host__ __device__ __forceinline__ void stage_rc(int b, int& R, int& C) { const int st = b / 1024, sb = b % 1024, swz = sb ^ (((sb >> 9) & 1) << 5); R = (st >> 1) * 16 + swz / 64; C = (st & 1) * 32 + (swz % 64) / 2; }
__host__ __device__ __forceinline__ int perm32(int rho) { const int n = rho >> 4, i = rho & 15; return 8 * (i >> 2) + 4 * n + (i & 3); }

struct Unit { int pm, pn; };
struct Gemm { const bf16_t* A; const bf16_t* Bt; int M, N, K; };

struct StaticOrder {
    int nM, nN, nwg, G, c;
    __host__ __device__ void init(int M, int N, int G_, int c_) { nM = M / BM; nN = N / BM; nwg = nM * nN; G = G_; c = c_; }
    __host__ __device__ bool next(int i, Unit& u) const {
        const long L = (long)i * G + c; if (L >= nwg) return false;
        int wgid = (int)L; { const int q = nwg / NXCD, r = nwg % NXCD, xcd = wgid % NXCD, off = wgid / NXCD; wgid = (xcd < r ? xcd * (q + 1) : r * (q + 1) + (xcd - r) * q) + off; }
        const int nig = WGM * nN, gid = wgid / nig, fm = gid * WGM, gsz = (nM - fm) < WGM ? (nM - fm) : WGM;
        u.pm = fm + ((wgid % nig) % gsz); u.pn = (wgid % nig) / gsz; return true;
    }
    __device__ __forceinline__ void a_ready(const Unit&) const {}
    __device__ __forceinline__ void done(const Unit&) const {}
};

__device__ __forceinline__ unsigned cvt_pk_bf16(float lo, float hi) { unsigned r; asm volatile("v_cvt_pk_bf16_f32 %0, %1, %2" : "=v"(r) : "v"(lo), "v"(hi)); return r; }
typedef float f32x2 __attribute__((ext_vector_type(2)));
__device__ __forceinline__ f32x2 gelu_pk(f32x2 v) {
    const f32x2 av = __builtin_elementwise_abs(v), d = av * 0.2316418882f + 1.0f;
    f32x2 t; t.x = __builtin_amdgcn_rcpf(d.x); t.y = __builtin_amdgcn_rcpf(d.y);
    f32x2 q = t * 0.5307027145f + (-0.7265760135f); q = q * t + 0.7107068705f; q = q * t + (-0.142248368f); q = q * t + 0.127414796f; q = q * t;
    const f32x2 s = (v * v) * (-0.72134752044f);
    f32x2 e; e.x = __builtin_amdgcn_exp2f(s.x); e.y = __builtin_amdgcn_exp2f(s.y);
    const f32x2 m = v * (q * e), r = v - m;
    f32x2 o; o.x = v.x < 0.f ? m.x : r.x; o.y = v.y < 0.f ? m.y : r.y; return o;
}

template <int ACT  > struct EpiBf16 {
    static constexpr bool PERM = true, AFTER_DRAIN = false; static_assert(ACT == 0 || ACT == 1, "EpiBf16: ACT is 0 (none) or 1 (gelu_pk)");
    bf16_t* O; int ldc; const float* bias; int split_cols; size_t split_stride; float scale0;
    __device__ __forceinline__ void operator()(const f32x4 (&acc)[2][2][4][2], const Unit& u, int wr, int wc, int fr, int fq) const {
        const int row0 = u.pm * BM + wr * 64 + fr; int colt = u.pn * BM; bf16_t* base = O;
        float sc = 1.f; if (split_cols) { const int t = colt / split_cols; base += (size_t)t * split_stride; colt -= t * split_cols; if (t == 0) sc = scale0; }
        const int col0 = colt + wc * 32 + 8 * fq, bcol0 = u.pn * BM + wc * 32 + 8 * fq;
        f32x4 bv[2][2];
#pragma unroll
        for (int bj = 0; bj < 2; ++bj)
#pragma unroll
            for (int n = 0; n < 2; ++n) bv[bj][n] = bias ? *(const f32x4*)(bias + bcol0 + bj * HALF + 4 * n) : (f32x4){0.f, 0.f, 0.f, 0.f};
#pragma unroll
        for (int ai = 0; ai < 2; ++ai)
#pragma unroll
            for (int m = 0; m < 4; ++m) { bf16_t* rowp = base + (size_t)(row0 + ai * HALF + m * 16) * ldc + col0;
#pragma unroll
                for (int bj = 0; bj < 2; ++bj) { f32x4 v0 = acc[ai][bj][m][0] + bv[bj][0], v1 = acc[ai][bj][m][1] + bv[bj][1];
                    if (ACT == 1) { f32x2 a = gelu_pk((f32x2){v0[0], v0[1]}), b = gelu_pk((f32x2){v0[2], v0[3]}), c = gelu_pk((f32x2){v1[0], v1[1]}), d = gelu_pk((f32x2){v1[2], v1[3]});
                        v0 = (f32x4){a.x, a.y, b.x, b.y}; v1 = (f32x4){c.x, c.y, d.x, d.y}; }
                    v0 = v0 * sc; v1 = v1 * sc; u32x4 w; w.x = cvt_pk_bf16(v0[0], v0[1]); w.y = cvt_pk_bf16(v0[2], v0[3]); w.z = cvt_pk_bf16(v1[0], v1[1]); w.w = cvt_pk_bf16(v1[2], v1[3]);
                    *(u32x4*)(rowp + bj * HALF) = w; } }
    }
};
template <class Epi, class Sched, bool ALIGN_EPI = false, bool SP2 = false, bool GATHER = false>
__device__ __forceinline__ void gemm_phase(PG8_LAS unsigned char* lds, const Gemm g, const Sched& S, const Epi& E) {
    int tid_ = threadIdx.x; asm volatile("" : "+v"(tid_));
    const int tid = tid_, wid = __builtin_amdgcn_readfirstlane(tid >> 6), lane = tid & 63, wr = wid >> 2, wc = wid & 3, fr = lane & 15, fq = lane >> 4;
    const int K = g.K, nt = K / BK;
    unsigned voffA[2], voffB[2], vA0[2], vA1[2], vN0[2], vN1[2]; int Rr_[2], Cc_[2];
#pragma unroll
    for (int i = 0; i < 2; ++i) { int R, C; stage_rc(tid * 16 + i * 8192, R, C); const int Rb = Epi::PERM ? ((R & ~31) + perm32(R & 31)) : R;
        voffA[i] = (unsigned)(R * K + C) * 2u; voffB[i] = (unsigned)(Rb * K + C) * 2u; Rr_[i] = R; Cc_[i] = C; }
    const size_t kstep = (size_t)(BK * 2);
    const size_t hstep = (size_t)HALF * K * 2;
    const size_t tstep = 2 * hstep;
#pragma unroll
    for (int i = 0; i < 2; ++i) { vA0[i] = voffA[i]; vA1[i] = voffA[i] + (unsigned)hstep; vN0[i] = vA0[i]; vN1[i] = vA1[i]; }
#define PG8_GLOAD(u, v0, v1) do { _Pragma("unroll") for (int _i = 0; _i < 2; ++_i) { const int _t0 = S.rowtok[(u).pm * BM + Rr_[_i]], _t1 = S.rowtok[(u).pm * BM + HALF + Rr_[_i]]; \
        (v0)[_i] = (unsigned)_t0 * (unsigned)(K * 2) + (unsigned)(Cc_[_i] * 2); (v1)[_i] = (unsigned)_t1 * (unsigned)(K * 2) + (unsigned)(Cc_[_i] * 2); } } while (0)
    const unsigned ldsw = (unsigned)wid * 1024u;
    const int aoff = lds_byte(wr * 64 + fr, fq * 8), boff = lds_byte(wc * 32 + fr, fq * 8);
#define PG8_SA(b, h) (((b) * 2 + (h)) * HTB)
#define PG8_SB(b, h) ((4 + (b) * 2 + (h)) * HTB)
#define PG8_STAGE(bufoff, gbase, voff) do { _Pragma("unroll") for (int _i = 0; _i < 2; ++_i) \
        __builtin_amdgcn_global_load_lds((const unsigned*)((const char*)(gbase) + (voff)[_i]), (PG8_LAS unsigned*)(lds + (bufoff) + ldsw + _i * 8192), 16, 0, 0); } while (0)
#define PG8_LDA(dst, b, h) do { _Pragma("unroll") for (int m = 0; m < 4; ++m) _Pragma("unroll") for (int k = 0; k < 2; ++k) dst[m][k] = *(const PG8_LAS bf16x8*)(lds + PG8_SA(b, h) + aoff + m * 2048 + k * 1024); } while (0)
#define PG8_LDB(dst, b, h) do { _Pragma("unroll") for (int n = 0; n < 2; ++n) _Pragma("unroll") for (int k = 0; k < 2; ++k) dst[n][k] = *(const PG8_LAS bf16x8*)(lds + PG8_SB(b, h) + boff + n * 2048 + k * 1024); } while (0)
#define PG8_MMA(ai, bj, At, Bt) do { __builtin_amdgcn_s_setprio(1); _Pragma("unroll") for (int m = 0; m < 4; ++m) _Pragma("unroll") for (int n = 0; n < 2; ++n) _Pragma("unroll") for (int k = 0; k < 2; ++k) \
        acc[ai][bj][m][n] = __builtin_amdgcn_mfma_f32_16x16x32_bf16(Bt[n][k], At[m][k], acc[ai][bj][m][n], 0, 0, 0); __builtin_amdgcn_s_setprio(0); } while (0)
#define PG8_WAIT_V(n) asm volatile("s_waitcnt vmcnt(" #n ")" ::: "memory")
#define PG8_WAIT_L(n) asm volatile("s_waitcnt lgkmcnt(" #n ")" ::: "memory")
#define PG8_BAR __builtin_amdgcn_s_barrier()
#define PG8_SCHED __builtin_amdgcn_sched_barrier(0)
    Unit cur, nxt; int ui = 0;
    if (!S.next(0, cur)) return;
    f32x4 acc[2][2][4][2];
#pragma unroll
    for (int a = 0; a < 2; ++a)
#pragma unroll
        for (int b = 0; b < 2; ++b)
#pragma unroll
            for (int m = 0; m < 4; ++m)
#pragma unroll
                for (int n = 0; n < 2; ++n) acc[a][b][m][n] = (f32x4){0.f, 0.f, 0.f, 0.f};
    bf16x8 At[4][2], B0[2][2], B1[2][2];
    if constexpr (GATHER) PG8_GLOAD(cur, vA0, vA1);
    const char* cA = GATHER ? (const char*)g.A : (const char*)g.A + (size_t)cur.pm * tstep; const char* cB = (const char*)g.Bt + (size_t)cur.pn * tstep;
    S.a_ready(cur);
    if constexpr (SP2) {
        PG8_STAGE(PG8_SB(0, 0), cB, voffB); PG8_STAGE(PG8_SB(0, 1), cB + hstep, voffB); PG8_STAGE(PG8_SA(0, 0), cA, vA0); PG8_STAGE(PG8_SA(0, 1), cA, vA1);
        if (wr == 1) PG8_BAR;
        PG8_WAIT_V(2); PG8_BAR;
        PG8_STAGE(PG8_SB(1, 0), cB + kstep, voffB); PG8_STAGE(PG8_SA(1, 0), cA + kstep, vA0); PG8_STAGE(PG8_SB(1, 1), cB + hstep + kstep, voffB);
        PG8_WAIT_V(6); PG8_BAR;
    } else {
        PG8_STAGE(PG8_SB(0, 0), cB, voffB); PG8_STAGE(PG8_SA(0, 0), cA, vA0); PG8_STAGE(PG8_SB(0, 1), cB + hstep, voffB); PG8_STAGE(PG8_SA(0, 1), cA, vA1);
        if (wr == 1) PG8_BAR;
        PG8_WAIT_V(4); PG8_BAR;
        PG8_STAGE(PG8_SB(1, 0), cB + kstep, voffB); PG8_STAGE(PG8_SA(1, 0), cA + kstep, vA0); PG8_STAGE(PG8_SB(1, 1), cB + hstep + kstep, voffB);
        PG8_WAIT_V(6); PG8_BAR;
    }
    for (;;) {
        const bool has_next = S.next(ui + 1, nxt);
        if constexpr (GATHER) { if (has_next) PG8_GLOAD(nxt, vN0, vN1); else { _Pragma("unroll") for (int i = 0; i < 2; ++i) { vN0[i] = vA0[i]; vN1[i] = vA1[i]; } } }
        const char* nA = GATHER ? (const char*)g.A : (has_next ? (const char*)g.A + (size_t)nxt.pm * tstep : cA); const char* nB = has_next ? (const char*)g.Bt + (size_t)nxt.pn * tstep : cB;
        for (int t = 0; t < nt; t += 2) {
            const bool last = (t == nt - 2);
            const char* a1 = cA + (size_t)(t + 1) * kstep;
            const char* a2 = last ? nA : cA + (size_t)(t + 2) * kstep; const char* b2 = last ? nB : cB + (size_t)(t + 2) * kstep;
            const char* a3 = a2 + kstep; const char* b3 = b2 + kstep;
            unsigned vX0[2], vX1[2];
#pragma unroll
            for (int i = 0; i < 2; ++i) { vX0[i] = (GATHER && last) ? vN0[i] : vA0[i]; vX1[i] = (GATHER && last) ? vN1[i] : vA1[i]; }
            if (last && has_next) S.a_ready(nxt);
            if constexpr (SP2) {
            PG8_LDB(B0, 0, 0); PG8_LDB(B1, 0, 1); PG8_SCHED; PG8_LDA(At, 0, 0); PG8_STAGE(PG8_SA(1, 1), a1, vA1);
            PG8_WAIT_V(8); PG8_WAIT_L(0); PG8_BAR; PG8_MMA(0, 0, At, B0); PG8_MMA(0, 1, At, B1); PG8_BAR; PG8_SCHED;
            PG8_LDA(At, 0, 1); PG8_STAGE(PG8_SB(0, 0), b2, voffB); PG8_STAGE(PG8_SB(0, 1), b2 + hstep, voffB); PG8_STAGE(PG8_SA(0, 0), a2, vX0);
            PG8_WAIT_V(8); PG8_WAIT_L(0); PG8_BAR; PG8_MMA(1, 0, At, B0); PG8_MMA(1, 1, At, B1); PG8_BAR; PG8_SCHED;
            PG8_LDB(B0, 1, 0); PG8_LDB(B1, 1, 1); PG8_SCHED; PG8_LDA(At, 1, 0); PG8_STAGE(PG8_SA(0, 1), a2, vX1);
            PG8_WAIT_V(8); PG8_WAIT_L(0); PG8_BAR; PG8_MMA(0, 0, At, B0); PG8_MMA(0, 1, At, B1); PG8_BAR; PG8_SCHED;
            PG8_LDA(At, 1, 1); PG8_STAGE(PG8_SB(1, 0), b3, voffB); PG8_STAGE(PG8_SB(1, 1), b3 + hstep, voffB); PG8_STAGE(PG8_SA(1, 0), a3, vX0);
            PG8_WAIT_V(8); PG8_WAIT_L(0); PG8_BAR; PG8_MMA(1, 0, At, B0); PG8_MMA(1, 1, At, B1); PG8_BAR; PG8_SCHED;
            } else {
            PG8_LDB(B0, 0, 0); PG8_SCHED; PG8_LDA(At, 0, 0); PG8_STAGE(PG8_SA(1, 1), a1, vA1);
            PG8_WAIT_L(8); PG8_BAR; PG8_WAIT_L(0); PG8_MMA(0, 0, At, B0); PG8_BAR; PG8_SCHED;
            PG8_LDB(B1, 0, 1); PG8_STAGE(PG8_SB(0, 0), b2, voffB);
            PG8_BAR; PG8_WAIT_L(0); PG8_MMA(0, 1, At, B1); PG8_BAR;
            PG8_LDA(At, 0, 1); PG8_STAGE(PG8_SA(0, 0), a2, vX0);
            PG8_BAR; PG8_WAIT_L(0); PG8_MMA(1, 0, At, B0); PG8_BAR; PG8_SCHED;
            PG8_STAGE(PG8_SB(0, 1), b2 + hstep, voffB);
            PG8_WAIT_V(6); PG8_BAR; PG8_MMA(1, 1, At, B1); PG8_BAR;
            PG8_LDB(B0, 1, 0); PG8_SCHED; PG8_LDA(At, 1, 0); PG8_STAGE(PG8_SA(0, 1), a2, vX1);
            PG8_WAIT_L(8); PG8_BAR; PG8_WAIT_L(0); PG8_MMA(0, 0, At, B0); PG8_BAR; PG8_SCHED;
            PG8_LDB(B1, 1, 1); PG8_STAGE(PG8_SB(1, 0), b3, voffB);
            PG8_BAR; PG8_WAIT_L(0); PG8_MMA(0, 1, At, B1); PG8_BAR;
            PG8_LDA(At, 1, 1); PG8_STAGE(PG8_SA(1, 0), a3, vX0);
            PG8_BAR; PG8_WAIT_L(0); PG8_MMA(1, 0, At, B0); PG8_BAR; PG8_SCHED;
            PG8_STAGE(PG8_SB(1, 1), b3 + hstep, voffB);
            PG8_WAIT_V(6); PG8_BAR; PG8_MMA(1, 1, At, B1); PG8_BAR;
            }
        }
        if constexpr (ALIGN_EPI) { if (wr == 0) PG8_BAR; }
        if constexpr (!Epi::AFTER_DRAIN) { E(acc, cur, wr, wc, fr, fq); S.done(cur); }
        if (!has_next) break;
#pragma unroll
        for (int a = 0; a < 2; ++a)
#pragma unroll
            for (int b = 0; b < 2; ++b)
#pragma unroll
                for (int m = 0; m < 4; ++m)
#pragma unroll
                    for (int n = 0; n < 2; ++n) acc[a][b][m][n] = (f32x4){0.f, 0.f, 0.f, 0.f};
        cur = nxt; cA = nA; cB = nB; ++ui;
        if constexpr (GATHER) { _Pragma("unroll") for (int i = 0; i < 2; ++i) { vA0[i] = vN0[i]; vA1[i] = vN1[i]; } }
        if constexpr (ALIGN_EPI) { if (wr == 1) PG8_BAR; }
    }
    PG8_WAIT_V(0);
    if constexpr (!ALIGN_EPI) { if (wr == 0) PG8_BAR; }
    PG8_BAR;
    if constexpr (Epi::AFTER_DRAIN) { E.fused(acc, cur, wr, wc, fr, fq, lds, wid, lane); S.done(cur); }
#undef PG8_SA
#undef PG8_SB
#undef PG8_STAGE
#undef PG8_GLOAD
#undef PG8_LDA
#undef PG8_LDB
#undef PG8_MMA
#undef PG8_WAIT_V
#undef PG8_WAIT_L
#undef PG8_BAR
#undef PG8_SCHED
}
}
namespace pg8 {
__device__ __forceinline__ float bf_lo(unsigned w) { return __builtin_bit_cast(float, w << 16); }
__device__ __forceinline__ float bf_hi(unsigned w) { return __builtin_bit_cast(float, w & 0xffff0000u); }
__device__ __forceinline__ float sigmoid_f(float x) { return __builtin_amdgcn_rcpf(1.0f + __expf(-x)); }

template <bool ADD> struct EpiGate {
    static constexpr bool PERM = true, AFTER_DRAIN = false;
    const bf16_t* G; const bf16_t* Min; bf16_t* O;
    __device__ __forceinline__ void operator()(const f32x4 (&acc)[2][2][4][2], const Unit& u, int wr, int wc, int fr, int fq) const {
        const int row0 = u.pm * BM + wr * 64 + fr, col0 = u.pn * BM + wc * 32 + 8 * fq;
#pragma unroll
        for (int ai = 0; ai < 2; ++ai)
#pragma unroll
            for (int m = 0; m < 4; ++m) { const size_t off = (size_t)(row0 + ai * HALF + m * 16) * 1024 + col0;
#pragma unroll
                for (int bj = 0; bj < 2; ++bj) {
                    const u32x4 g = *(const u32x4*)(G + off + bj * HALF);
                    f32x4 v0 = acc[ai][bj][m][0], v1 = acc[ai][bj][m][1];
                    v0[0] *= sigmoid_f(bf_lo(g.x)); v0[1] *= sigmoid_f(bf_hi(g.x)); v0[2] *= sigmoid_f(bf_lo(g.y)); v0[3] *= sigmoid_f(bf_hi(g.y));
                    v1[0] *= sigmoid_f(bf_lo(g.z)); v1[1] *= sigmoid_f(bf_hi(g.z)); v1[2] *= sigmoid_f(bf_lo(g.w)); v1[3] *= sigmoid_f(bf_hi(g.w));
                    if (ADD) { const u32x4 p = *(const u32x4*)(Min + off + bj * HALF);
                        v0[0] += bf_lo(p.x); v0[1] += bf_hi(p.x); v0[2] += bf_lo(p.y); v0[3] += bf_hi(p.y);
                        v1[0] += bf_lo(p.z); v1[1] += bf_hi(p.z); v1[2] += bf_lo(p.w); v1[3] += bf_hi(p.w); }
                    u32x4 w; w.x = cvt_pk_bf16(v0[0], v0[1]); w.y = cvt_pk_bf16(v0[2], v0[3]); w.z = cvt_pk_bf16(v1[0], v1[1]); w.w = cvt_pk_bf16(v1[2], v1[3]);
                    *(u32x4*)(O + off + bj * HALF) = w; } }
    }
};

struct EpiResid {
    static constexpr bool PERM = false, AFTER_DRAIN = false;
    const float* X; const float* gate; float* out; int rows_per_batch; int gstride;
    __device__ __forceinline__ void operator()(const f32x4 (&acc)[2][2][4][2], const Unit& u, int wr, int wc, int fr, int fq) const {
        const int col0 = u.pn * BM + wc * 32 + 4 * fq;
#pragma unroll
        for (int ai = 0; ai < 2; ++ai)
#pragma unroll
            for (int m = 0; m < 4; ++m) { const int row = u.pm * BM + ai * HALF + wr * 64 + m * 16 + fr; const size_t off = (size_t)row * 1024 + col0;
                const float* gp = gate + (size_t)(row / rows_per_batch) * gstride + col0;
#pragma unroll
                for (int bj = 0; bj < 2; ++bj)
#pragma unroll
                    for (int n = 0; n < 2; ++n) { const f32x4 xv = *(const f32x4*)(X + off + bj * HALF + n * 16); const f32x4 gv = *(const f32x4*)(gp + bj * HALF + n * 16);
                        *(f32x4*)(out + off + bj * HALF + n * 16) = xv + gv * acc[ai][bj][m][n]; } }
    }
};

__device__ __forceinline__ float swiglu1(float g, float l) {
    g = fminf(g, 7.0f); l = fminf(fmaxf(l, -7.0f), 7.0f);
    return (l + 1.0f) * (g * __builtin_amdgcn_rcpf(1.0f + __expf(-1.702f * g)));
}
struct EpiSwiglu {
    static constexpr bool PERM = true, AFTER_DRAIN = false;
    const float* b1; bf16_t* O;
    __device__ __forceinline__ void operator()(const f32x4 (&acc)[2][2][4][2], const Unit& u, int wr, int wc, int fr, int fq) const {
        const int e = u.pn >> 3, pl = u.pn & 7, jc = wc * 32 + 8 * fq;
        const float* bg = b1 + (size_t)e * 2048 + 128 * pl + jc; const float* bl = bg + 1024;
        const f32x4 bg0 = *(const f32x4*)bg, bg1 = *(const f32x4*)(bg + 4), bl0 = *(const f32x4*)bl, bl1 = *(const f32x4*)(bl + 4);
        const int row0 = u.pm * BM + wr * 64 + fr;
#pragma unroll
        for (int ai = 0; ai < 2; ++ai)
#pragma unroll
            for (int m = 0; m < 4; ++m) {
                const f32x4 g0 = acc[ai][0][m][0] + bg0, g1 = acc[ai][0][m][1] + bg1, l0 = acc[ai][1][m][0] + bl0, l1 = acc[ai][1][m][1] + bl1;
                u32x4 w; w.x = cvt_pk_bf16(swiglu1(g0[0], l0[0]), swiglu1(g0[1], l0[1])); w.y = cvt_pk_bf16(swiglu1(g0[2], l0[2]), swiglu1(g0[3], l0[3]));
                w.z = cvt_pk_bf16(swiglu1(g1[0], l1[0]), swiglu1(g1[1], l1[1])); w.w = cvt_pk_bf16(swiglu1(g1[2], l1[2]), swiglu1(g1[3], l1[3]));
                *(u32x4*)(O + (size_t)(row0 + ai * HALF + m * 16) * 1024 + 128 * pl + jc) = w; }
    }
};

struct GroupedOrder {
    const PG8_LAS int* ts; int NT, G, c; const int* rowtok;
    __device__ __forceinline__ bool next(int i, Unit& u) const {
        const int total = __builtin_amdgcn_readfirstlane(ts[32]) * NT; const long L = (long)i * G + c; if (L >= total) return false;
        const int pm = (int)L / NT, pl = (int)L % NT; int e = 0;
#pragma unroll 1
        for (int j = 1; j < 32; ++j) e += (pm >= ts[j]) ? 1 : 0;
        u.pm = __builtin_amdgcn_readfirstlane(pm); u.pn = __builtin_amdgcn_readfirstlane(e * NT + pl); return true;
    }
    __device__ __forceinline__ void a_ready(const Unit&) const {}
    __device__ __forceinline__ void done(const Unit&) const {}
};
}
#define GAS __attribute__((address_space(1)))
#define LAS __attribute__((address_space(3)))
typedef unsigned short bf16;
typedef unsigned v4u __attribute__((ext_vector_type(4)));
typedef float f32x4 __attribute__((ext_vector_type(4)));
typedef short bf16x8 __attribute__((ext_vector_type(8)));
typedef GAS unsigned gu32;
typedef GAS unsigned long long gu64;
#define RLX_AGENT __ATOMIC_RELAXED, __HIP_MEMORY_SCOPE_AGENT
#define LDS_WAIT() asm volatile("s_waitcnt lgkmcnt(0)" ::: "memory")
#define VM_WAIT() asm volatile("s_waitcnt vmcnt(0)" ::: "memory")
__device__ __forceinline__ unsigned long long rt() { return __builtin_amdgcn_s_memrealtime(); }
__device__ __forceinline__ unsigned f2bf(float f) { unsigned u = __builtin_bit_cast(unsigned, f); return (u + 0x7fffu + ((u >> 16) & 1u)) >> 16; }
typedef float f32x2_pk __attribute__((ext_vector_type(2))); typedef __bf16 bf16x2_pk __attribute__((ext_vector_type(2)));
__device__ __forceinline__ unsigned pk2(float lo, float hi) { const f32x2_pk v = {lo, hi}; return __builtin_bit_cast(unsigned, __builtin_convertvector(v, bf16x2_pk)); }

#define XB_TMO      128
#define XB_XCNT(j)  (256  + 64 * (j))
#define XB_XSUB(j)  (1280 + 64 * (j))
#define XB_XGEN(j)  (2304 + 64 * (j))
#define XB_TOP      3328
#define XB_TOPGEN   3392
#define XCD_BAR_WORDS 3456
#define XB_SPIN_CAP (1u << 18)

__device__ __forceinline__ unsigned xb_ld(unsigned* p)              { return __hip_atomic_load(p, __ATOMIC_RELAXED, __HIP_MEMORY_SCOPE_AGENT); }
__device__ __forceinline__ unsigned xb_add(unsigned* p, unsigned v) { return __hip_atomic_fetch_add(p, v, __ATOMIC_RELAXED, __HIP_MEMORY_SCOPE_AGENT); }
__device__ __forceinline__ unsigned xb_xcc_id() { return (unsigned)__builtin_amdgcn_s_getreg((3 << 11) | 20) & 0xFu; }
#define XB_SPIN(cond, bar) do { unsigned _sp = 0; while (cond) { __builtin_amdgcn_s_sleep(1); \
    if ((++_sp & 255u) == 0u) { if (xb_ld(&(bar)[XB_TMO])) break; if (_sp > XB_SPIN_CAP) { atomicAdd(&(bar)[XB_TMO], 1u); break; } } } } while (0)

struct XcdBarrier {
    unsigned* bar; unsigned x;
    volatile LAS unsigned* st;
};

__device__ __forceinline__ XcdBarrier xcd_barrier_post(unsigned* bar, volatile LAS unsigned* st) {
    XcdBarrier b; b.bar = bar; b.x = xb_xcc_id(); b.st = st;
    if (threadIdx.x == 0) (void)xb_add(&bar[XB_XCNT(b.x)], 1u);
    return b;
}
__device__ __forceinline__ void xcd_barrier_complete(unsigned* bar, unsigned x, unsigned& nloc, unsigned& nx) {
    const unsigned G = gridDim.x * gridDim.y * gridDim.z;
    unsigned sum, cnt, mine, sp = 0u;
    for (;;) {
        sum = 0u; cnt = 0u; mine = 0u;
#pragma unroll
        for (unsigned j = 0; j < 16; ++j) { const unsigned c = xb_ld(&bar[XB_XCNT(j)]); sum += c; cnt += (c > 0u) ? 1u : 0u; mine = (j == x) ? c : mine; }
        if (sum == G) break;
        __builtin_amdgcn_s_sleep(1);
        if ((++sp & 255u) == 0u) { if (xb_ld(&bar[XB_TMO])) break; if (sp > XB_SPIN_CAP) { atomicAdd(&bar[XB_TMO], 1u); break; } }
    }
    nloc = mine > 0u ? mine : 1u; nx = cnt > 0u ? cnt : 1u;
}

__device__ __forceinline__ void xcd_barrier(const XcdBarrier& b) {
    asm volatile("s_waitcnt vmcnt(0)" ::: "memory");
    __syncthreads();
    if (threadIdx.x == 0) {
        unsigned* bar = b.bar;
        __builtin_amdgcn_s_waitcnt(0);
        unsigned nloc = b.st[0], nx = b.st[1];
        if (nloc == 0u) { xcd_barrier_complete(bar, b.x, nloc, nx); b.st[0] = nloc; b.st[1] = nx; }
        const unsigned old = xb_add(&bar[XB_XSUB(b.x)], 1u);
        const unsigned gen = old / nloc;
        if (old + 1u == (gen + 1u) * nloc) {
            __builtin_amdgcn_fence(__ATOMIC_RELEASE, "agent");
            asm volatile("s_waitcnt vmcnt(0)" ::: "memory");
            const unsigned og = xb_add(&bar[XB_TOP], 1u);
            const unsigned tg = og / nx;
            if (og + 1u == (tg + 1u) * nx) xb_add(&bar[XB_TOPGEN], 1u);
            else XB_SPIN(xb_ld(&bar[XB_TOPGEN]) == tg, bar);
            __builtin_amdgcn_fence(__ATOMIC_ACQUIRE, "agent");
            xb_add(&bar[XB_XGEN(b.x)], 1u);
            asm volatile("s_waitcnt vmcnt(0)" ::: "memory");
        } else {
            XB_SPIN(xb_ld(&bar[XB_XGEN(b.x)]) == gen, bar);
            __builtin_amdgcn_fence(__ATOMIC_ACQUIRE, "agent");
            asm volatile("s_waitcnt vmcnt(0)" ::: "memory");
        }
    }
    __syncthreads();
}

constexpr int NWAVES = 8;
constexpr int BATCH = 16, SEQ = 2048, D = 1024, T = BATCH * SEQ;
constexpr int NIN = 9224, NPROJ = 9216, NMOD = 6 * D;
constexpr int NE = 32, TOPK = 4;
constexpr int XS_ROWS = T * TOPK + NE * 256;
constexpr float EPS = 1e-6f;
constexpr float ATT_RTHR = -120.0f;
constexpr float QSCALE = 0.125f * 1.4426950408889634f;

constexpr size_t MiB = 1u << 20;
constexpr size_t WS_CTL = 0, CTL_ZERO_BYTES = 1 * MiB;
constexpr size_t WS_MODP = 1 * MiB;
constexpr size_t WS_MOD = 3 * MiB;
constexpr size_t WS_IPRE = 4 * MiB, WS_LF = 4 * MiB + 512 * 1024;
constexpr size_t WS_TOKE = 5 * MiB, WS_TOKP = 5 * MiB + 512 * 1024, WS_TOKW = 6 * MiB, WS_TOKROW = 6 * MiB + 512 * 1024, WS_RSTD = 7 * MiB;
constexpr size_t WS_WIN = 8 * MiB, WS_WA = 26 * MiB, WS_WB = 28 * MiB, WS_WOUT = 30 * MiB, WS_W1 = 32 * MiB, WS_W2 = 160 * MiB;
constexpr size_t WS_H1 = 224 * MiB;
constexpr size_t WS_PROJ = 288 * MiB, SEG = 64 * MiB;
constexpr size_t WS_YB = 864 * MiB;
constexpr size_t WS_XS = 288 * MiB, WS_ACT = 560 * MiB;
constexpr size_t WS_ROW2TOK = 7 * MiB + 128 * 1024;
constexpr size_t WS_GT = 928 * MiB;
constexpr size_t WS_END = 932 * MiB;
static_assert(WS_XS + (size_t)XS_ROWS * 2048 <= WS_ACT && WS_ACT + (size_t)XS_ROWS * 2048 <= WS_YB, "ws map");
constexpr int CW_TMO = 0, CW_BAR = 4096, CW_ECNT = 8192;

constexpr int RING_BYTES = 131072, LDS_BYTES = 147456, LDSCTL_OFF = 146432;
constexpr int LC_BAR = 0, LC_TS = 16, LC_LCNT = 64, LC_GBASE = 96, LC_PS = 128, LC_CNT = 160;

__device__ __forceinline__ unsigned long long karg(int i) { return ((const __attribute__((address_space(4))) unsigned long long*)__builtin_amdgcn_kernarg_segment_ptr())[i]; }
struct Frame {
    LAS unsigned char* lds; volatile LAS unsigned* LC;
    gu32* ctl; unsigned char* ws; int tid, lane, wave, vcu, G;
    __device__ __forceinline__ const float* x() const { return (const float*)(const GAS float*)karg(0); }
    __device__ __forceinline__ const float* c() const { return (const float*)(const GAS float*)karg(1); }
    __device__ __forceinline__ const float* ada_w() const { return (const float*)(const GAS float*)karg(2); }
    __device__ __forceinline__ const float* ada_b() const { return (const float*)(const GAS float*)karg(3); }
    __device__ __forceinline__ const float* norm1_g() const { return (const float*)(const GAS float*)karg(4); }
    __device__ __forceinline__ const float* w_in() const { return (const float*)(const GAS float*)karg(5); }
    __device__ __forceinline__ const float* conv_w() const { return (const float*)(const GAS float*)karg(6); }
    __device__ __forceinline__ const float* conv_b() const { return (const float*)(const GAS float*)karg(7); }
    __device__ __forceinline__ const float* b_i() const { return (const float*)(const GAS float*)karg(8); }
    __device__ __forceinline__ const float* b_f() const { return (const float*)(const GAS float*)karg(9); }
    __device__ __forceinline__ const float* ml_norm_g() const { return (const float*)(const GAS float*)karg(10); }
    __device__ __forceinline__ const float* w_a() const { return (const float*)(const GAS float*)karg(11); }
    __device__ __forceinline__ const float* w_b() const { return (const float*)(const GAS float*)karg(12); }
    __device__ __forceinline__ const float* w_out() const { return (const float*)(const GAS float*)karg(13); }
    __device__ __forceinline__ const float* norm2_g() const { return (const float*)(const GAS float*)karg(14); }
    __device__ __forceinline__ const float* router_w() const { return (const float*)(const GAS float*)karg(15); }
    __device__ __forceinline__ const float* router_b() const { return (const float*)(const GAS float*)karg(16); }
    __device__ __forceinline__ const float* w1() const { return (const float*)(const GAS float*)karg(17); }
    __device__ __forceinline__ const float* b1() const { return (const float*)(const GAS float*)karg(18); }
    __device__ __forceinline__ const float* w2() const { return (const float*)(const GAS float*)karg(19); }
    __device__ __forceinline__ const float* b2() const { return (const float*)(const GAS float*)karg(20); }
    __device__ __forceinline__ const float* final_g() const { return (const float*)(const GAS float*)karg(21); }
    __device__ __forceinline__ float* out() const { return (float*)(GAS float*)karg(22); }
    __device__ __forceinline__ float* modp() const { return (float*)(ws + WS_MODP); }
    __device__ __forceinline__ float* mod() const { return (float*)(ws + WS_MOD); }
    __device__ __forceinline__ float* ipre() const { return (float*)(ws + WS_IPRE); }
    __device__ __forceinline__ float* lf() const { return (float*)(ws + WS_LF); }
    __device__ __forceinline__ float* tokw() const { return (float*)(ws + WS_TOKW); }
    __device__ __forceinline__ float* rstd2() const { return (float*)(ws + WS_RSTD); }
    __device__ __forceinline__ int* toke() const { return (int*)(ws + WS_TOKE); }
    __device__ __forceinline__ int* tokp() const { return (int*)(ws + WS_TOKP); }
    __device__ __forceinline__ int* tokrow() const { return (int*)(ws + WS_TOKROW); }
    __device__ __forceinline__ bf16* WIN_T() const { return (bf16*)(ws + WS_WIN); }
    __device__ __forceinline__ bf16* WA_T() const { return (bf16*)(ws + WS_WA); }
    __device__ __forceinline__ bf16* WB_T() const { return (bf16*)(ws + WS_WB); }
    __device__ __forceinline__ bf16* WOUT_T() const { return (bf16*)(ws + WS_WOUT); }
    __device__ __forceinline__ bf16* W1_T() const { return (bf16*)(ws + WS_W1); }
    __device__ __forceinline__ bf16* W2_T() const { return (bf16*)(ws + WS_W2); }
    __device__ __forceinline__ bf16* H1() const { return (bf16*)(ws + WS_H1); }
    __device__ __forceinline__ bf16* PROJ() const { return (bf16*)(ws + WS_PROJ); }
    __device__ __forceinline__ bf16* YA() const { return (bf16*)(ws + WS_H1); }
    __device__ __forceinline__ bf16* YB() const { return (bf16*)(ws + WS_YB); }
    __device__ __forceinline__ bf16* M1() const { return (bf16*)(ws + WS_PROJ); }
    __device__ __forceinline__ bf16* MERGED() const { return (bf16*)(ws + WS_PROJ + SEG); }
    __device__ __forceinline__ bf16* XS() const { return (bf16*)(ws + WS_XS); }
    __device__ __forceinline__ bf16* ACT() const { return (bf16*)(ws + WS_ACT); }
    __device__ __forceinline__ bf16* OUTR() const { return (bf16*)(ws + WS_XS); }
    __device__ __forceinline__ bf16* H2() const { return (bf16*)(ws + WS_XS); }
    __device__ __forceinline__ int* row2tok() const { return (int*)(ws + WS_ROW2TOK); }
    __device__ __forceinline__ float* gt() const { return (float*)(ws + WS_GT); }
};

__device__ __forceinline__ int opq(int v) { asm volatile("" : "+v"(v)); return v; }
__device__ __forceinline__ float wave_sum(float v) {
#pragma unroll
    for (int o = 1; o < 64; o <<= 1) v += __shfl_xor(v, o);
    return v;
}
__device__ __forceinline__ float bf2f(unsigned short b) { return __builtin_bit_cast(float, (unsigned)b << 16); }
__device__ __forceinline__ float bflo(unsigned w) { return __builtin_bit_cast(float, w << 16); }
__device__ __forceinline__ float bfhi(unsigned w) { return __builtin_bit_cast(float, w & 0xffff0000u); }
__device__ __forceinline__ float log_sigmoid_f(float x) { return fminf(x, 0.f) - log1pf(expf(-fabsf(x))); }

struct MapIn { __device__ __forceinline__ long operator()(int n) const { return n < 7168 ? (long)n : (n < 7176 ? -1L : (n < NIN ? (long)(n - 8) : -1L)); } };
struct MapId { long off; __device__ __forceinline__ long operator()(int n) const { return off + n; } };
struct MapW1 { int e; __device__ __forceinline__ long operator()(int n) const { return (long)e * 2048 + ((n & 1023) >> 7) * 256 + (n >> 10) * 128 + (n & 127); } };

template <class Map> __device__ __forceinline__ void transpose_item(const float* W, int K, int N, bf16* WT, LAS float* scr, int item, int lane, Map map) {
    const int nblk = (N + 31) / 32, kb = item / nblk, nb = item % nblk, k0 = 64 * kb, n0 = 32 * nb;
    const int n4 = 4 * (lane & 7), kr = lane >> 3;
    const bool ok = (n0 + n4 + 3) < N;
    f32x4 v[8];
#pragma unroll
    for (int i = 0; i < 8; ++i) v[i] = ok ? *(const f32x4*)(W + (size_t)(k0 + 8 * i + kr) * N + n0 + n4) : (f32x4){0.f, 0.f, 0.f, 0.f};
#pragma unroll
    for (int i = 0; i < 8; ++i) { LAS float* d = scr + (8 * i + kr) * 33 + n4; d[0] = v[i].x; d[1] = v[i].y; d[2] = v[i].z; d[3] = v[i].w; }
    LDS_WAIT(); asm volatile("" ::: "memory");
    const int c = lane & 7;
#pragma unroll
    for (int j = 0; j < 4; ++j) { const int n = (lane >> 3) + 8 * j; const LAS float* s = scr + (8 * c) * 33 + n;
        v4u o; o.x = pk2(s[0 * 33], s[1 * 33]); o.y = pk2(s[2 * 33], s[3 * 33]); o.z = pk2(s[4 * 33], s[5 * 33]); o.w = pk2(s[6 * 33], s[7 * 33]);
        const long dr = map(n0 + n);
        if (dr >= 0) *(GAS v4u*)(WT + (size_t)dr * K + k0 + 8 * c) = o; }
    LDS_WAIT(); asm volatile("" ::: "memory");
}
__device__ __forceinline__ void mod_item(Frame& F, const LAS float* sil, int it) {
    const int j = it % 96, kq = it / 96, n = 64 * j + F.lane, k0 = 256 * kq;
    float acc[16];
#pragma unroll
    for (int b = 0; b < 16; ++b) acc[b] = 0.f;
    const float* w = F.ada_w() + (size_t)k0 * NMOD + n;
    const LAS f32x4* s = (const LAS f32x4*)sil + k0 * 4;
    for (int kk = 0; kk < 256; kk += 8) {
        float wv[8];
#pragma unroll
        for (int u = 0; u < 8; ++u) wv[u] = w[(size_t)(kk + u) * NMOD];
#pragma unroll
        for (int u = 0; u < 8; ++u) {
#pragma unroll
            for (int q = 0; q < 4; ++q) { const f32x4 sv = s[(kk + u) * 4 + q]; acc[4 * q + 0] += sv.x * wv[u]; acc[4 * q + 1] += sv.y * wv[u]; acc[4 * q + 2] += sv.z * wv[u]; acc[4 * q + 3] += sv.w * wv[u]; }
        }
    }
    float* o = F.modp() + (size_t)kq * 16 * NMOD + n;
#pragma unroll
    for (int b = 0; b < 16; ++b) o[(size_t)b * NMOD] = acc[b];
}
__device__ __forceinline__ void p0_prologue(Frame& F) {
    LAS float* sil = (LAS float*)F.lds;
    for (int idx = F.tid; idx < 16384; idx += 512) { const int b = idx >> 10, k = idx & 1023; const float v = F.c()[idx]; sil[k * 16 + b] = v / (1.0f + __expf(-v)); }
    __syncthreads();
    LAS float* scr = (LAS float*)(F.lds + 65536 + F.wave * 8704);
    const int gw = F.vcu * NWAVES + F.wave, NGW = F.G * NWAVES;
    constexpr int I_MOD = 384, I_IN = 16 * 289, I_SQ = 16 * 32, I_W1 = 32 * 16 * 64, I_W2 = 32 * 16 * 32;
    constexpr int NITEMS = I_MOD + I_IN + 3 * I_SQ + I_W1 + I_W2;
    for (int it = gw; it < NITEMS; it += NGW) {
        int r = it;
        if (r < I_MOD) { mod_item(F, sil, r); continue; } r -= I_MOD;
        if (r < I_IN) { transpose_item(F.w_in(), D, NIN, F.WIN_T(), scr, r, F.lane, MapIn{}); continue; } r -= I_IN;
        if (r < I_SQ) { transpose_item(F.w_a(), D, D, F.WA_T(), scr, r, F.lane, MapId{0}); continue; } r -= I_SQ;
        if (r < I_SQ) { transpose_item(F.w_b(), D, D, F.WB_T(), scr, r, F.lane, MapId{0}); continue; } r -= I_SQ;
        if (r < I_SQ) { transpose_item(F.w_out(), D, D, F.WOUT_T(), scr, r, F.lane, MapId{0}); continue; } r -= I_SQ;
        if (r < I_W1) { const int e = r >> 10; transpose_item(F.w1() + (size_t)e * D * 2048, D, 2048, F.W1_T(), scr, r & 1023, F.lane, MapW1{e}); continue; } r -= I_W1;
        { const int e = r >> 9; transpose_item(F.w2() + (size_t)e * D * D, D, D, F.W2_T(), scr, r & 511, F.lane, MapId{(long)e * 1024}); }
    }
}

__device__ __forceinline__ void p1_rows(Frame& F) {
    const int row0 = F.vcu * 128, b = row0 / SEQ, lane = opq(F.lane);
    LAS float* wif = (LAS float*)F.lds;
    for (int idx = F.tid; idx < 8192; idx += 512) wif[idx] = F.w_in()[(size_t)(idx >> 3) * NIN + 7168 + (idx & 7)];
    for (int idx = F.vcu * 512 + F.tid; idx < 16 * NMOD; idx += F.G * 512) { float s = F.ada_b()[idx % NMOD];
#pragma unroll
        for (int kq = 0; kq < 4; ++kq) s += F.modp()[(size_t)kq * 16 * NMOD + idx];
        F.mod()[idx] = s; }
    f32x4 Av[4], Bv[4];
#pragma unroll
    for (int j = 0; j < 4; ++j) { const int col = 4 * lane + 256 * j;
        f32x4 sh = *(const f32x4*)(F.ada_b() + col), sc = *(const f32x4*)(F.ada_b() + D + col);
#pragma unroll
        for (int kq = 0; kq < 4; ++kq) { sh += *(const f32x4*)(F.modp() + ((size_t)kq * 16 + b) * NMOD + col); sc += *(const f32x4*)(F.modp() + ((size_t)kq * 16 + b) * NMOD + D + col); }
        const f32x4 g = *(const f32x4*)(F.norm1_g() + col); Av[j] = g * (sc + 1.0f); Bv[j] = sh; }
    __syncthreads();
    f32x4 nx[4];
    { const GAS f32x4* xr = (const GAS f32x4*)(F.x() + (size_t)(row0 + 16 * F.wave) * D) + lane;
#pragma unroll
      for (int j = 0; j < 4; ++j) nx[j] = xr[64 * j]; }
    for (int r = 0; r < 16; ++r) {
        const int row = row0 + 16 * F.wave + r;
        f32x4 v[4]; float ss = 0.f;
#pragma unroll
        for (int j = 0; j < 4; ++j) { v[j] = nx[j]; ss += (v[j].x * v[j].x + v[j].y * v[j].y) + (v[j].z * v[j].z + v[j].w * v[j].w); }
        if (r < 15) { const GAS f32x4* xr = (const GAS f32x4*)(F.x() + (size_t)(row + 1) * D) + lane;
#pragma unroll
            for (int j = 0; j < 4; ++j) nx[j] = xr[64 * j]; }
        const float rstd = 1.0f / sqrtf(wave_sum(ss) * (1.0f / D) + EPS);
        GAS unsigned long long* o8 = (GAS unsigned long long*)(F.H1() + (size_t)row * D) + lane;
        float p[8];
#pragma unroll
        for (int q = 0; q < 8; ++q) p[q] = 0.f;
#pragma unroll
        for (int j = 0; j < 4; ++j) { v[j] = v[j] * rstd * Av[j] + Bv[j];
            o8[64 * j] = (unsigned long long)pk2(v[j].x, v[j].y) | ((unsigned long long)pk2(v[j].z, v[j].w) << 32);
#pragma unroll
            for (int i = 0; i < 4; ++i) { const LAS f32x4* wp = (const LAS f32x4*)(wif + (4 * lane + 256 * j + i) * 8); const f32x4 w0 = wp[0], w1 = wp[1]; const float hv = v[j][i];
                p[0] += hv * w0.x; p[1] += hv * w0.y; p[2] += hv * w0.z; p[3] += hv * w0.w; p[4] += hv * w1.x; p[5] += hv * w1.y; p[6] += hv * w1.z; p[7] += hv * w1.w; } }
#pragma unroll
        for (int q = 0; q < 8; ++q) p[q] = wave_sum(p[q]);
        if (lane == 0) { const int t = row % SEQ;
#pragma unroll
            for (int hh = 0; hh < 4; ++hh) { F.ipre()[((size_t)b * 4 + hh) * SEQ + t] = p[hh] + F.b_i()[hh]; F.lf()[((size_t)b * 4 + hh) * SEQ + t] = log_sigmoid_f(p[4 + hh] + F.b_f()[hh]); } }
    }
}

__device__ __forceinline__ void attn_naive_item(Frame& F, int bh, int qblk) {
    const int b = bh >> 4, hd = bh & 15, t = qblk * 512 + F.tid;
    const bf16* Q = F.PROJ(); const bf16* K = F.PROJ() + SEG / 2; const bf16* V = F.PROJ() + SEG;
    const size_t rowb = (size_t)b * SEQ;
    float q[64], o[64];
    { const v4u* qp = (const v4u*)(Q + (rowb + t) * D + hd * 64);
#pragma unroll
      for (int i = 0; i < 8; ++i) { const v4u w = qp[i]; q[8 * i + 0] = bflo(w.x); q[8 * i + 1] = bfhi(w.x); q[8 * i + 2] = bflo(w.y); q[8 * i + 3] = bfhi(w.y); q[8 * i + 4] = bflo(w.z); q[8 * i + 5] = bfhi(w.z); q[8 * i + 6] = bflo(w.w); q[8 * i + 7] = bfhi(w.w); } }
#pragma unroll
    for (int i = 0; i < 64; ++i) o[i] = 0.f;
    float R = 0.f;
    LAS v4u* kt = (LAS v4u*)F.lds; LAS v4u* vt = (LAS v4u*)(F.lds + 8192);
    const int tmax_wave = qblk * 512 + F.wave * 64 + 63;
    bool wdone = false;
    LAS volatile int* dflag = (LAS volatile int*)(F.lds + 16384);
    if (F.tid < 8) dflag[F.tid] = 0;
    for (int tile = qblk * 8 + 7; tile >= 0; --tile) {
        __syncthreads();
        { int nd = 0;
#pragma unroll
          for (int w = 0; w < 8; ++w) nd += dflag[w];
          if (nd == 8) break; }
        { const int kr = F.tid >> 3, ch = F.tid & 7; const size_t g = (rowb + tile * 64 + kr) * D + hd * 64 + ch * 8;
          kt[F.tid] = *(const v4u*)(K + g); vt[F.tid] = *(const v4u*)(V + g); }
        __syncthreads();
        if (tile * 64 >= tmax_wave) continue;
        if (wdone) continue;
        for (int s = 63; s >= 0; --s) {
            const int key = tile * 64 + s;
            float z = 0.f;
#pragma unroll
            for (int i = 0; i < 8; ++i) { const v4u w = kt[s * 8 + i]; z += q[8 * i + 0] * bflo(w.x) + q[8 * i + 1] * bfhi(w.x) + q[8 * i + 2] * bflo(w.y) + q[8 * i + 3] * bfhi(w.y) + q[8 * i + 4] * bflo(w.z) + q[8 * i + 5] * bfhi(w.z) + q[8 * i + 6] * bflo(w.w) + q[8 * i + 7] * bfhi(w.w); }
            const float lb = fminf(z, 0.f) - __builtin_amdgcn_logf(1.0f + __builtin_amdgcn_exp2f(-fabsf(z)));
            const bool act = key < t;
            const float a = act ? __builtin_amdgcn_exp2f(lb + R) : 0.f;
            R += act ? (lb - z) : 0.f;
#pragma unroll
            for (int i = 0; i < 8; ++i) { const v4u w = vt[s * 8 + i]; o[8 * i + 0] += a * bflo(w.x); o[8 * i + 1] += a * bfhi(w.x); o[8 * i + 2] += a * bflo(w.y); o[8 * i + 3] += a * bfhi(w.y); o[8 * i + 4] += a * bflo(w.z); o[8 * i + 5] += a * bfhi(w.z); o[8 * i + 6] += a * bflo(w.w); o[8 * i + 7] += a * bfhi(w.w); }
        }
        if (__all(R < ATT_RTHR) && !wdone) { wdone = true; if (F.lane == 0) dflag[F.wave] = 1; }
    }
    __syncthreads();
    v4u* op = (v4u*)(F.YA() + (rowb + t) * D + hd * 64);
#pragma unroll
    for (int i = 0; i < 8; ++i) { v4u w; w.x = pk2(o[8 * i + 0], o[8 * i + 1]); w.y = pk2(o[8 * i + 2], o[8 * i + 3]); w.z = pk2(o[8 * i + 4], o[8 * i + 5]); w.w = pk2(o[8 * i + 6], o[8 * i + 7]); op[i] = w; }
}

__device__ __forceinline__ void mlstm_naive_item(Frame& F, int bh) {
    const int b = bh >> 2, hh = bh & 3, tid = opq(F.tid), e = tid & 255, half = tid >> 8;
    const bf16* MLQ = F.PROJ() + 3 * (SEG / 2); const bf16* MLK = F.PROJ() + 4 * (SEG / 2); const bf16* MLV = F.PROJ() + 5 * (SEG / 2); const bf16* MLO = F.PROJ() + 6 * (SEG / 2);
    LAS float* ql = (LAS float*)F.lds; LAS float* kl = ql + 8192; LAS float* vl = kl + 8192; LAS float* hl = vl + 8192;
    LAS float* part = hl + 8192;
    LAS float* red = part + 512;
    LAS float* il = red + 8; LAS float* fl = il + 32;
    const size_t rowb = (size_t)b * SEQ;
    float C[128];
#pragma unroll
    for (int i = 0; i < 128; ++i) C[i] = 0.f;
    float nreg = 0.f, m = 0.f;
    float cw[2][4], cb[2];
    { const int c = tid & 255;
#pragma unroll
      for (int z = 0; z < 2; ++z) { const int ch = z * 1024 + hh * 256 + c; cb[z] = F.conv_b()[ch];
#pragma unroll
          for (int tap = 0; tap < 4; ++tap) cw[z][tap] = F.conv_w()[tap * 2048 + ch]; } }
    for (int chunk = 0; chunk < SEQ / 32; ++chunk) {
        const int t0 = chunk * 32;
        __syncthreads();
        { const int c = tid & 255;
          for (int u = 0; u < 16; ++u) { const int tt = (tid >> 8) + 2 * u, t = t0 + tt; float yq = cb[0], yk = cb[1];
#pragma unroll
              for (int tap = 0; tap < 4; ++tap) { const int ts = t - 3 + tap; if (ts >= 0) { const size_t g = (rowb + ts) * D + hh * 256 + c; yq += cw[0][tap] * bf2f(MLQ[g]); yk += cw[1][tap] * bf2f(MLK[g]); } }
              ql[tt * 256 + c] = yq / (1.0f + __expf(-yq)); kl[tt * 256 + c] = (yk / (1.0f + __expf(-yk))) * 0.0625f;
              vl[tt * 256 + c] = bf2f(MLV[(rowb + t) * D + hh * 256 + c]); }
          if (tid < 32) { il[tid] = F.ipre()[((size_t)b * 4 + hh) * SEQ + t0 + tid]; fl[tid] = F.lf()[((size_t)b * 4 + hh) * SEQ + t0 + tid]; } }
        __syncthreads();
        for (int tt = 0; tt < 32; ++tt) {
            const float lfv = fl[tt], iv = il[tt];
            const float mn = fmaxf(lfv + m, iv), fp = __expf(lfv + m - mn), ip = __expf(iv - mn); m = mn;
            const float vv = vl[tt * 256 + e] * ip;
            const LAS f32x4* kq = (const LAS f32x4*)(kl + tt * 256 + 128 * half); const LAS f32x4* qq = (const LAS f32x4*)(ql + tt * 256 + 128 * half);
            float num = 0.f;
#pragma unroll
            for (int i = 0; i < 32; ++i) { const f32x4 kv = kq[i], qv = qq[i];
                C[4 * i + 0] = fp * C[4 * i + 0] + kv.x * vv; C[4 * i + 1] = fp * C[4 * i + 1] + kv.y * vv; C[4 * i + 2] = fp * C[4 * i + 2] + kv.z * vv; C[4 * i + 3] = fp * C[4 * i + 3] + kv.w * vv;
                num += (qv.x * C[4 * i + 0] + qv.y * C[4 * i + 1]) + (qv.z * C[4 * i + 2] + qv.w * C[4 * i + 3]); }
            const int buf = tt & 1;
            if (tid < 256) { nreg = fp * nreg + ip * kl[tt * 256 + tid]; const float pd = wave_sum(ql[tt * 256 + tid] * nreg); if (F.lane == 0) red[buf * 4 + F.wave] = pd; }
            else part[buf * 256 + e] = num;
            __syncthreads();
            if (tid < 256) { num += part[buf * 256 + e]; const float den = (red[buf * 4 + 0] + red[buf * 4 + 1]) + (red[buf * 4 + 2] + red[buf * 4 + 3]);
                hl[tt * 256 + e] = num / fmaxf(fabsf(den), __expf(-m)); }
        }
        __syncthreads();
        for (int r = 0; r < 4; ++r) { const int tt = 4 * F.wave + r; const size_t row = rowb + t0 + tt;
            const f32x4 hv = *(const LAS f32x4*)(hl + tt * 256 + 4 * F.lane);
            const float ss = wave_sum((hv.x * hv.x + hv.y * hv.y) + (hv.z * hv.z + hv.w * hv.w));
            const float rstd = 1.0f / sqrtf(ss * (1.0f / 256.0f) + EPS);
            const int col = hh * 256 + 4 * F.lane; const f32x4 g = *(const f32x4*)(F.ml_norm_g() + col);
            const unsigned long long ow = *(const unsigned long long*)(MLO + row * D + col);
            const float o0 = bflo((unsigned)ow), o1 = bfhi((unsigned)ow), o2 = bflo((unsigned)(ow >> 32)), o3 = bfhi((unsigned)(ow >> 32));
            const float y0 = hv.x * rstd * g.x / (1.0f + __expf(-o0)), y1 = hv.y * rstd * g.y / (1.0f + __expf(-o1)), y2 = hv.z * rstd * g.z / (1.0f + __expf(-o2)), y3 = hv.w * rstd * g.w / (1.0f + __expf(-o3));
            *(unsigned long long*)(F.YB() + row * D + col) = (unsigned long long)pk2(y0, y1) | ((unsigned long long)pk2(y2, y3) << 32); }
    }
}


namespace ml {
typedef short bf16x8 __attribute__((ext_vector_type(8)));
typedef short s16x4 __attribute__((ext_vector_type(4)));
typedef float f32x16 __attribute__((ext_vector_type(16)));
typedef LAS const char* lcp;
typedef LAS char* lp_t;
constexpr int L = 64;
constexpr int O_QI = 0, O_KI = 33792, O_CB = 67584, O_VI = 102400, O_VW = 111616, O_PI = 120832, O_F = 130048;
constexpr int F_NV = 0, F_QNP = 256, F_RSP = 768, F_AT = 896, F_US = 960, F_WIN = 1024, F_EDEN = 1088, F_WST = 1152, F_RDEN = 1216, F_CW = 1280, F_CBIAS = 3328;
__device__ __forceinline__ int crow(int r, int hi) { return (r & 3) + 8 * (r >> 2) + 4 * hi; }
template <int PITCH, int XM> __device__ __forceinline__ int ioff(int row, int ch) { return XM ? PITCH * row + 16 * (ch ^ (row & XM)) : PITCH * row + 16 * ch; }
template <int PITCH, int XM> __device__ __forceinline__ bf16x8 frag_row(lcp img, int row0, int s, int lane) {
    return *(LAS const bf16x8*)(img + ioff<PITCH, XM>(row0 + (lane & 31), 2 * s + (lane >> 5)));
}
template <int PITCH, int XM> __device__ __forceinline__ bf16x8 frag_tr(lcp img, int k0, int ks, int col0, int lane) {
    const int h = lane >> 5, blk = (lane >> 4) & 1, q = (lane & 15) >> 2, p = lane & 3;
    const int r0 = k0 + 16 * ks + 8 * h + q, ch = (col0 >> 3) + 2 * blk + (p >> 1);
    typedef short v4i16_t __attribute__((ext_vector_type(4)));
    const s16x4 a = __builtin_bit_cast(s16x4, __builtin_amdgcn_ds_read_tr16_b64_v4i16((LAS v4i16_t*)(img + ioff<PITCH, XM>(r0, ch) + 8 * (p & 1))));
    const s16x4 b = __builtin_bit_cast(s16x4, __builtin_amdgcn_ds_read_tr16_b64_v4i16((LAS v4i16_t*)(img + ioff<PITCH, XM>(r0 + 4, ch) + 8 * (p & 1))));
    return (bf16x8){a[0], a[1], a[2], a[3], b[0], b[1], b[2], b[3]};
}
__device__ __forceinline__ float half_sum(float v) {
    const auto rr = __builtin_amdgcn_permlane32_swap(__builtin_bit_cast(unsigned, v), __builtin_bit_cast(unsigned, v), false, false);
    return __builtin_bit_cast(float, rr[0]) + __builtin_bit_cast(float, rr[1]);
}
__device__ __forceinline__ float silu_f(float y) { return y * __builtin_amdgcn_rcpf(1.0f + __expf(-y)); }

__device__ __forceinline__ void mlstm_unit(Frame& F, int unit) {
    const int bh = unit >> 2, sl = unit & 3, b = bh >> 2, hh = bh & 3, tid = opq(F.tid), lane = opq(F.lane), wave = F.wave, hi = lane >> 5, l31 = lane & 31;
    const bf16* MLQ = (const bf16*)F.out(); const bf16* MLK = MLQ + (size_t)T * D; const bf16* MLV = F.PROJ() + 5 * (SEG / 2);
    lp_t base = (lp_t)F.lds;
    LAS float* Fa = (LAS float*)(base + O_F);
    const size_t rowb = (size_t)b * SEQ;
    const float LOG2E = 1.4426950408889634f;
    __syncthreads();
    for (int i = tid; i < 34816 / 16; i += 512) ((LAS v4u*)(base + O_CB))[i] = (v4u){0u, 0u, 0u, 0u};
    if (tid < 256) Fa[F_NV + tid] = 0.f;
    f32x16 C0, C1, C2;
#pragma unroll
    for (int r = 0; r < 16; ++r) { C0[r] = 0.f; C1[r] = 0.f; C2[r] = 0.f; }
    if (tid < 64) *(LAS v4u*)(base + O_VW + 144 * tid + 128) = (v4u){0u, 0u, 0u, 0u};
    const int cg = tid & 31, rb = tid >> 5;
    v4u rawq[2][4], rawk[2][4], rawv[2]; float g_bb[2], g_us[2], g_pm[2]; float m_prev = 0.f;
#define ML_PREFETCH(T0, P) do { const int t0_ = (T0); \
        _Pragma("unroll") for (int i = 0; i < 4; ++i) { const unsigned g_ = (unsigned)(((int)rowb + t0_ + 4 * rb + i) * D + hh * 256 + cg * 8); \
            rawq[P][i] = *(const v4u*)(MLQ + g_); rawk[P][i] = *(const v4u*)(MLK + g_); } \
        rawv[P] = *(const v4u*)(MLV + (unsigned)(((int)rowb + t0_ + (tid >> 3)) * D + hh * 256 + 64 * sl + (tid & 7) * 8)); \
        { const float* gt_ = F.gt() + (unsigned)(((bh * (SEQ / L) + t0_ / L) * 3) * 64 + lane); g_bb[P] = gt_[0]; g_us[P] = gt_[64]; g_pm[P] = gt_[128]; } } while (0)
    ML_PREFETCH(0, 0); ML_PREFETCH(L, 1);
    __syncthreads();
    for (int chunk2 = 0; chunk2 < SEQ / L; chunk2 += 2) {
#pragma unroll
      for (int par = 0; par < 2; ++par) {
        const int chunk = chunk2 + par, t0 = chunk * L;
        const int tid = opq(F.tid), lane = tid & 63, hi = lane >> 5, l31 = lane & 31, cg = tid & 31, rb = tid >> 5, lo = lane;
        const float u = g_us[par], mm = g_bb[par] + fmaxf(m_prev, g_pm[par]), winter = __builtin_amdgcn_exp2f(g_bb[par] + m_prev - mm), at = g_bb[par] - mm, eden = __builtin_amdgcn_exp2f(-mm);
        const float bb63 = __builtin_bit_cast(float, __builtin_amdgcn_readlane(__builtin_bit_cast(int, g_bb[par]), 63)), mnew = __builtin_bit_cast(float, __builtin_amdgcn_readlane(__builtin_bit_cast(int, mm), 63));
        const float decay = __builtin_amdgcn_exp2f(bb63 + m_prev - mnew), wstate = __builtin_amdgcn_exp2f(bb63 - mnew + u); m_prev = mnew;
        if (wave == 0) { Fa[F_AT + lane] = at; Fa[F_US + lane] = u; Fa[F_WIN + lane] = winter; Fa[F_EDEN + lane] = eden; Fa[F_WST + lane] = wstate; }
#pragma unroll
        for (int j = 0; j < 4; ++j) { *(LAS v4u*)(base + O_QI + ioff<528, 0>(4 * rb + j, cg)) = rawq[par][j]; *(LAS v4u*)(base + O_KI + ioff<528, 0>(4 * rb + j, cg)) = rawk[par][j]; }
        { const int s = tid >> 3, ch = tid & 7; const v4u w = rawv[par];
          *(LAS v4u*)(base + O_VI + ioff<144, 0>(s, ch)) = w;
          const float ws = __shfl(wstate, s);
          v4u o; o.x = pk2(bflo(w.x) * ws, bfhi(w.x) * ws); o.y = pk2(bflo(w.y) * ws, bfhi(w.y) * ws); o.z = pk2(bflo(w.z) * ws, bfhi(w.z) * ws); o.w = pk2(bflo(w.w) * ws, bfhi(w.w) * ws);
          *(LAS v4u*)(base + O_VW + ioff<144, 0>(s, ch)) = o;
          if (ch == 0) *(LAS unsigned short*)(base + O_VW + 144 * s + 128) = (unsigned short)pk2(ws, 0.f); }
        __syncthreads();
        if (chunk + 2 < SEQ / L) ML_PREFETCH(t0 + 2 * L, par);
        __builtin_amdgcn_sched_barrier(0);
        f32x16 acc;
#pragma unroll
        for (int r = 0; r < 16; ++r) acc[r] = 0.f;
        const int wq = wave & 3, ta = wq >> 1, tb = wq & 1;
        if (wave < 4) {
#pragma unroll
            for (int kh = 0; kh < 2; ++kh) { bf16x8 fa[8], fb[8];
#pragma unroll
                for (int ks = 0; ks < 8; ++ks) { fa[ks] = frag_row<528, 0>(base + O_KI, 32 * tb, 8 * kh + ks, lo); fb[ks] = frag_row<528, 0>(base + O_QI, 32 * ta, 8 * kh + ks, lo); }
                __builtin_amdgcn_sched_barrier(0);
#pragma unroll
                for (int ks = 0; ks < 8; ++ks) acc = __builtin_amdgcn_mfma_f32_32x32x16_bf16(fa[ks], fb[ks], acc, 0, 0, 0);
                __builtin_amdgcn_sched_barrier(0); }
            const float at_l = __shfl(at, 32 * ta + l31); const int t = 32 * ta + l31; float rsum = 0.f;
#pragma unroll
            for (int g = 0; g < 4; ++g) { const int s0 = 32 * tb + 8 * g + 4 * hi; const f32x4 us4 = *(LAS const f32x4*)(Fa + F_US + s0); float p[4];
#pragma unroll
                for (int i = 0; i < 4; ++i) { p[i] = (s0 + i <= t) ? acc[4 * g + i] * __builtin_amdgcn_exp2f(at_l + us4[i]) : 0.f; rsum += p[i]; }
                *(LAS unsigned long long*)(base + O_PI + ioff<144, 0>(t, s0 >> 3) + 2 * (s0 & 7)) = (unsigned long long)pk2(p[0], p[1]) | ((unsigned long long)pk2(p[2], p[3]) << 32); }
            rsum = half_sum(rsum);
            if (hi == 0) Fa[F_RSP + tb * 64 + t] = rsum;
        } else {
#pragma unroll
            for (int kh = 0; kh < 2; ++kh) { bf16x8 fa[8], fb[8];
#pragma unroll
                for (int ks = 0; ks < 8; ++ks) { fa[ks] = frag_row<528, 0>(base + O_QI, 32 * ta, 8 * kh + ks, lo); fb[ks] = frag_tr<136, 0>(base + O_CB, 0, 8 * kh + ks, 32 * tb, lo); }
                __builtin_amdgcn_sched_barrier(0);
#pragma unroll
                for (int ks = 0; ks < 8; ++ks) acc = __builtin_amdgcn_mfma_f32_32x32x16_bf16(fa[ks], fb[ks], acc, 0, 0, 0);
                __builtin_amdgcn_sched_barrier(0); }
        }
        { float s = 0.f;
#pragma unroll
          for (int c = 0; c < 4; ++c) { const v4u w = *(LAS const v4u*)(base + O_QI + ioff<528, 0>(lane, 4 * wave + c)); const f32x4 n0 = *(LAS const f32x4*)(Fa + F_NV + 32 * wave + 8 * c), n1 = *(LAS const f32x4*)(Fa + F_NV + 32 * wave + 8 * c + 4);
              s += bflo(w.x) * n0.x + bfhi(w.x) * n0.y + bflo(w.y) * n0.z + bfhi(w.y) * n0.w + bflo(w.z) * n1.x + bfhi(w.z) * n1.y + bflo(w.w) * n1.z + bfhi(w.w) * n1.w; }
          Fa[F_QNP + wave * 64 + lane] = s; }
        __syncthreads();
        if (wave >= 4) {
            { const int t = 32 * ta + l31;
              const float den = Fa[F_WIN + t] * (((Fa[F_QNP + t] + Fa[F_QNP + 64 + t]) + (Fa[F_QNP + 128 + t] + Fa[F_QNP + 192 + t])) + ((Fa[F_QNP + 256 + t] + Fa[F_QNP + 320 + t]) + (Fa[F_QNP + 384 + t] + Fa[F_QNP + 448 + t])))
                                + Fa[F_RSP + t] + Fa[F_RSP + 64 + t];
              if (hi == 0) Fa[F_CW + 32 * (wave - 4) + l31] = 1.0f / fmaxf(fabsf(den), Fa[F_EDEN + t]); }
#pragma unroll
            for (int g = 0; g < 4; ++g) { const f32x4 w4 = *(LAS const f32x4*)(Fa + F_WIN + 32 * ta + 8 * g + 4 * hi); acc[4 * g] *= w4.x; acc[4 * g + 1] *= w4.y; acc[4 * g + 2] *= w4.z; acc[4 * g + 3] *= w4.w; }
            { bf16x8 fa[4], fb[4];
#pragma unroll
              for (int ks = 0; ks < 4; ++ks) { fa[ks] = frag_row<144, 0>(base + O_PI, 32 * ta, ks, lo); fb[ks] = frag_tr<144, 0>(base + O_VI, 0, ks, 32 * tb, lo); }
              __builtin_amdgcn_sched_barrier(0);
#pragma unroll
              for (int ks = 0; ks < 4; ++ks) acc = __builtin_amdgcn_mfma_f32_32x32x16_bf16(fa[ks], fb[ks], acc, 0, 0, 0); }
            bf16* dst = F.YB() + (rowb + t0 + 32 * ta) * D + hh * 256 + 64 * sl + 32 * tb + l31;
#pragma unroll
            for (int g = 0; g < 4; ++g) { const f32x4 r4 = *(LAS const f32x4*)(Fa + F_CW + 32 * (wave - 4) + 8 * g + 4 * hi);
#pragma unroll
                for (int i = 0; i < 4; ++i) dst[(size_t)(8 * g + 4 * hi + i) * D] = (bf16)pk2(acc[4 * g + i] * r4[i], 0.f); }
        }
#pragma unroll
        for (int r = 0; r < 16; ++r) { C0[r] *= decay; C1[r] *= decay; C2[r] *= decay; }
        { bf16x8 bk[4], v0[4], v1[4], v2[4];
#pragma unroll
          for (int ks = 0; ks < 4; ++ks) { bk[ks] = frag_tr<528, 0>(base + O_KI, 0, ks, 32 * wave, lo); v0[ks] = frag_tr<144, 0>(base + O_VW, 0, ks, 0, lo); v1[ks] = frag_tr<144, 0>(base + O_VW, 0, ks, 32, lo); v2[ks] = frag_tr<144, 0>(base + O_VW, 0, ks, 64, lo); }
          __builtin_amdgcn_sched_barrier(0);
#pragma unroll
          for (int ks = 0; ks < 4; ++ks) { C0 = __builtin_amdgcn_mfma_f32_32x32x16_bf16(v0[ks], bk[ks], C0, 0, 0, 0); C1 = __builtin_amdgcn_mfma_f32_32x32x16_bf16(v1[ks], bk[ks], C1, 0, 0, 0); C2 = __builtin_amdgcn_mfma_f32_32x32x16_bf16(v2[ks], bk[ks], C2, 0, 0, 0); }
          __builtin_amdgcn_sched_barrier(0); }
        { const int d = 32 * wave + l31;
#pragma unroll
          for (int g = 0; g < 4; ++g) { const int e0 = 8 * g + 4 * hi;
              *(LAS unsigned long long*)(base + O_CB + ioff<136, 0>(d, e0 >> 3) + 2 * (e0 & 7)) = (unsigned long long)pk2(C0[4 * g], C0[4 * g + 1]) | ((unsigned long long)pk2(C0[4 * g + 2], C0[4 * g + 3]) << 32);
              *(LAS unsigned long long*)(base + O_CB + ioff<136, 0>(d, (32 + e0) >> 3) + 2 * (e0 & 7)) = (unsigned long long)pk2(C1[4 * g], C1[4 * g + 1]) | ((unsigned long long)pk2(C1[4 * g + 2], C1[4 * g + 3]) << 32); }
          if (hi == 0) Fa[F_NV + d] = C2[0];
        }
        __syncthreads();
      }
    }
#undef ML_PREFETCH
}
}


__device__ __forceinline__ void mlstm_gates(Frame& F, int job) {
    const int lane = opq(F.lane); const float LOG2E = 1.4426950408889634f;
    const float lf2 = F.lf()[(size_t)job * ml::L + lane] * LOG2E, ii2 = F.ipre()[(size_t)job * ml::L + lane] * LOG2E;
    float bb = lf2;
#pragma unroll
    for (int o = 1; o < 64; o <<= 1) { const float v = __shfl_up(bb, o); bb += (lane >= o) ? v : 0.f; }
    const float u = ii2 - bb; float pm = u;
#pragma unroll
    for (int o = 1; o < 64; o <<= 1) { const float v = __shfl_up(pm, o); pm = (lane >= o) ? fmaxf(pm, v) : pm; }
    float* gt = F.gt() + (size_t)job * 3 * 64 + lane;
    gt[0] = bb; gt[64] = u; gt[128] = pm;
}

__device__ __forceinline__ void mlstm_conv_rows(Frame& F) {
    const int tid = opq(F.tid), cg = tid & 255, z = cg >> 7, c0 = (cg & 127) * 8, r0 = F.vcu * 128 + 64 * (tid >> 8);
    const bf16* src = F.PROJ() + (size_t)(3 + z) * (SEG / 2) + c0; bf16* dst = (bf16*)F.out() + (size_t)z * T * D + c0;
    float w[4][8], bs[8];
#pragma unroll
    for (int tap = 0; tap < 4; ++tap) { const f32x4 a0 = *(const f32x4*)(F.conv_w() + tap * 2048 + cg * 8), a1 = *(const f32x4*)(F.conv_w() + tap * 2048 + cg * 8 + 4);
        w[tap][0] = a0.x; w[tap][1] = a0.y; w[tap][2] = a0.z; w[tap][3] = a0.w; w[tap][4] = a1.x; w[tap][5] = a1.y; w[tap][6] = a1.z; w[tap][7] = a1.w; }
    { const f32x4 a0 = *(const f32x4*)(F.conv_b() + cg * 8), a1 = *(const f32x4*)(F.conv_b() + cg * 8 + 4);
      bs[0] = a0.x; bs[1] = a0.y; bs[2] = a0.z; bs[3] = a0.w; bs[4] = a1.x; bs[5] = a1.y; bs[6] = a1.z; bs[7] = a1.w; }
    const float osc = z ? 0.0625f : 1.0f;
    const bool seq_start = (r0 % SEQ) == 0;
    v4u x0, x1, x2;
    { const v4u zero = {0u, 0u, 0u, 0u};
      x0 = seq_start ? zero : *(const v4u*)(src + (size_t)(r0 - 3 + (seq_start ? 3 : 0)) * D);
      x1 = seq_start ? zero : *(const v4u*)(src + (size_t)(r0 - 2 + (seq_start ? 2 : 0)) * D);
      x2 = seq_start ? zero : *(const v4u*)(src + (size_t)(r0 - 1 + (seq_start ? 1 : 0)) * D); }
    for (int rr = 0; rr < 64; rr += 8) {
        v4u xs[8];
#pragma unroll
        for (int i = 0; i < 8; ++i) xs[i] = *(const v4u*)(src + (size_t)(r0 + rr + i) * D);
#pragma unroll
        for (int i = 0; i < 8; ++i) {
            const v4u x3 = xs[i]; float y[8];
#pragma unroll
            for (int c = 0; c < 8; ++c) y[c] = bs[c];
#define MK_TAP(tap, X) do { y[0] += w[tap][0] * bflo(X.x); y[1] += w[tap][1] * bfhi(X.x); y[2] += w[tap][2] * bflo(X.y); y[3] += w[tap][3] * bfhi(X.y); \
                           y[4] += w[tap][4] * bflo(X.z); y[5] += w[tap][5] * bfhi(X.z); y[6] += w[tap][6] * bflo(X.w); y[7] += w[tap][7] * bfhi(X.w); } while (0)
            MK_TAP(0, x0); MK_TAP(1, x1); MK_TAP(2, x2); MK_TAP(3, x3);
#undef MK_TAP
#pragma unroll
            for (int c = 0; c < 8; ++c) y[c] = ml::silu_f(y[c]) * osc;
            v4u o; o.x = pk2(y[0], y[1]); o.y = pk2(y[2], y[3]); o.z = pk2(y[4], y[5]); o.w = pk2(y[6], y[7]);
            *(v4u*)(dst + (size_t)(r0 + rr + i) * D) = o;
            x0 = x1; x1 = x2; x2 = x3;
        }
    }
}

__device__ __forceinline__ void mlstm_norm_rows(Frame& F) {
    const int row0 = F.vcu * 128, lane = opq(F.lane);
    const bf16* MLO = F.PROJ() + 6 * (SEG / 2);
    f32x4 G[4];
#pragma unroll
    for (int j = 0; j < 4; ++j) G[j] = *(const f32x4*)(F.ml_norm_g() + 256 * j + 4 * lane);
    unsigned long long nh[4], no[4];
#define NR_LOAD(ROW) do { const size_t row_ = (ROW); const GAS unsigned long long* hp_ = (const GAS unsigned long long*)(F.YB() + row_ * D) + lane; const GAS unsigned long long* op_ = (const GAS unsigned long long*)(MLO + row_ * D) + lane; \
        _Pragma("unroll") for (int j = 0; j < 4; ++j) { nh[j] = hp_[64 * j]; no[j] = op_[64 * j]; } } while (0)
    NR_LOAD((size_t)row0 + 16 * F.wave);
    for (int r = 0; r < 16; ++r) {
        const size_t row = (size_t)row0 + 16 * F.wave + r;
        GAS unsigned long long* hp = (GAS unsigned long long*)(F.YB() + row * D) + lane;
        unsigned long long ch[4], co[4];
#pragma unroll
        for (int j = 0; j < 4; ++j) { ch[j] = nh[j]; co[j] = no[j]; }
        if (r < 15) NR_LOAD(row + 1);
#pragma unroll
        for (int j = 0; j < 4; ++j) { const unsigned long long hw = ch[j], ow = co[j];
            const float h0 = bflo((unsigned)hw), h1 = bfhi((unsigned)hw), h2 = bflo((unsigned)(hw >> 32)), h3 = bfhi((unsigned)(hw >> 32));
            const float ss = wave_sum((h0 * h0 + h1 * h1) + (h2 * h2 + h3 * h3)); const float rstd = 1.0f / sqrtf(ss * (1.0f / 256.0f) + EPS);
            const float o0 = bflo((unsigned)ow), o1 = bfhi((unsigned)ow), o2 = bflo((unsigned)(ow >> 32)), o3 = bfhi((unsigned)(ow >> 32));
            const float y0 = h0 * rstd * G[j].x / (1.0f + __expf(-o0)), y1 = h1 * rstd * G[j].y / (1.0f + __expf(-o1)), y2 = h2 * rstd * G[j].z / (1.0f + __expf(-o2)), y3 = h3 * rstd * G[j].w / (1.0f + __expf(-o3));
            hp[64 * j] = (unsigned long long)pk2(y0, y1) | ((unsigned long long)pk2(y2, y3) << 32); }
    }
#undef NR_LOAD
}

namespace at {
using ml::bf16x8; using ml::s16x4; using ml::f32x16; using ml::ioff; using ml::frag_row; using ml::lcp; using ml::lp_t;
typedef _Float16 f16x8 __attribute__((ext_vector_type(8)));
typedef _Float16 f16x2 __attribute__((ext_vector_type(2)));
typedef float f32x2 __attribute__((ext_vector_type(2)));
constexpr int O_KI = 0, O_VI = 8192, O_FLAG = 16384;
template <int PITCH, int XM> __device__ __forceinline__ bf16x8 frag_trp(lcp img, int ks, int col0, int lane) {
    const int h = lane >> 5, blk = (lane >> 4) & 1, q = (lane & 15) >> 2, p = lane & 3;
    const int r0 = 16 * ks + 4 * h + q, ch = (col0 >> 3) + 2 * blk + (p >> 1);
    typedef short v4i16_t __attribute__((ext_vector_type(4)));
    const s16x4 a = __builtin_bit_cast(s16x4, __builtin_amdgcn_ds_read_tr16_b64_v4i16((LAS v4i16_t*)(img + ioff<PITCH, XM>(r0, ch) + 8 * (p & 1))));
    const s16x4 b = __builtin_bit_cast(s16x4, __builtin_amdgcn_ds_read_tr16_b64_v4i16((LAS v4i16_t*)(img + ioff<PITCH, XM>(r0 + 8, ch) + 8 * (p & 1))));
    return (bf16x8){a[0], a[1], a[2], a[3], b[0], b[1], b[2], b[3]};
}
__device__ __forceinline__ unsigned pkh(float a, float b) { const f32x2 v = {a, b}; return __builtin_bit_cast(unsigned, __builtin_convertvector(v, f16x2)); }
__device__ __forceinline__ f16x8 h8(unsigned a, unsigned b, unsigned c, unsigned d) { const v4u v = {a, b, c, d}; return __builtin_bit_cast(f16x8, v); }
__device__ __forceinline__ bf16x8 b8(unsigned a, unsigned b, unsigned c, unsigned d) { const v4u v = {a, b, c, d}; return __builtin_bit_cast(bf16x8, v); }

__device__ __forceinline__ void attn_unit(Frame& F, int bh, int qb) {
    const int b = bh >> 4, hd = bh & 15, tid = opq(F.tid), lane = opq(F.lane), wave = F.wave, hi = lane >> 5, l31 = lane & 31, pr = wave >> 1, tp = tid & 127;
    const bf16* Q = F.PROJ(); const bf16* K = F.PROJ() + SEG / 2; const bf16* V = F.PROJ() + SEG;
    lp_t base = (lp_t)F.lds + pr * 16384;
    LAS volatile int* dflag = (LAS volatile int*)((lp_t)F.lds + 65536);
    const size_t rowb = (size_t)b * SEQ; const int q0 = qb * 256, tw0 = q0 + 32 * wave, t = tw0 + l31, kt0 = qb * 4 + pr;
    bf16x8 qr[4];
#pragma unroll
    for (int ks = 0; ks < 4; ++ks) qr[ks] = *(const bf16x8*)(Q + (rowb + t) * D + hd * 64 + 16 * ks + 8 * hi);
    unsigned uw[2][4];
#pragma unroll
    for (int sp = 0; sp < 2; ++sp)
#pragma unroll
        for (int jj = 0; jj < 4; ++jj) { const int j0 = 2 * jj, j1 = 2 * jj + 1;
            const int k0 = 16 * sp + 8 * (j0 >> 2) + 4 * hi + (j0 & 3), k1 = 16 * sp + 8 * (j1 >> 2) + 4 * hi + (j1 & 3);
            uw[sp][jj] = (k0 > l31 ? 0x3C00u : 0u) | (k1 > l31 ? 0x3C000000u : 0u); }
    const f16x8 U0 = h8(uw[0][0], uw[0][1], uw[0][2], uw[0][3]), U1 = h8(uw[1][0], uw[1][1], uw[1][2], uw[1][3]), ONES = h8(0x3C003C00u, 0x3C003C00u, 0x3C003C00u, 0x3C003C00u);
    f32x16 O0, O1;
#pragma unroll
    for (int r = 0; r < 16; ++r) { O0[r] = 0.f; O1[r] = 0.f; }
    float R = 0.f; bool wdone = false;
    v4u kreg[4], vreg[4];
#define AT_LOAD(KT) do { _Pragma("unroll") for (int j = 0; j < 4; ++j) { const size_t g = (rowb + (KT) * 64 + (tp >> 3) + 16 * j) * D + hd * 64 + (tp & 7) * 8; kreg[j] = *(const v4u*)(K + g); vreg[j] = *(const v4u*)(V + g); } } while (0)
    AT_LOAD(kt0);
    __syncthreads();
    if (tid < 8) dflag[tid] = 0;
    for (int it = 0; it <= qb * 4 + 3; ++it) {
        const int kt = kt0 - it;
        __syncthreads();
        { int nd = 0;
#pragma unroll
          for (int w = 0; w < 8; ++w) nd += dflag[w];
          if (nd == 8) break; }
        if (kt >= 0) {
#pragma unroll
            for (int j = 0; j < 4; ++j) { *(LAS v4u*)(base + O_KI + ioff<128, 7>((tp >> 3) + 16 * j, tp & 7)) = kreg[j]; *(LAS v4u*)(base + O_VI + ioff<128, 7>((tp >> 3) + 16 * j, tp & 7)) = vreg[j]; } }
        __syncthreads();
        if (kt > 0) AT_LOAD(kt - 1);
        if (kt < 0) { if (!wdone) { wdone = true; if (lane == 0) dflag[wave] = 1; } continue; }
        if (wdone) continue;
        int lo = lane; asm volatile("" : "+v"(lo));
        f32x16 p0, p1;
#pragma unroll
        for (int r = 0; r < 16; ++r) { p0[r] = 0.f; p1[r] = 0.f; }
#pragma unroll
        for (int ks = 0; ks < 4; ++ks) { p0 = __builtin_amdgcn_mfma_f32_32x32x16_bf16(frag_row<128, 7>(base + O_KI, 0, ks, lo), qr[ks], p0, 0, 0, 0);
                                         p1 = __builtin_amdgcn_mfma_f32_32x32x16_bf16(frag_row<128, 7>(base + O_KI, 32, ks, lo), qr[ks], p1, 0, 0, 0); }
        const bool diag = (it == 0);
        const int trel = t - 64 * kt;
        float lk00 = 0.f;
        unsigned lkw0[8], lkw1[8];
#pragma unroll
        for (int r = 0; r < 16; ++r) {
            const int key0 = ml::crow(r, hi);
            { const float z = p0[r], lb = fminf(z, 0.f) - __builtin_amdgcn_logf(1.0f + __builtin_amdgcn_exp2f(-fabsf(z))); float lk = lb - z; if (diag && !(key0 < trel)) lk = 0.f; p0[r] = lb; if (r == 0) lk00 = lk;
              if (r & 1) lkw0[r >> 1] = pkh(__builtin_bit_cast(float, lkw0[r >> 1]), lk); else lkw0[r >> 1] = __builtin_bit_cast(unsigned, lk); }
            { const float z = p1[r], lb = fminf(z, 0.f) - __builtin_amdgcn_logf(1.0f + __builtin_amdgcn_exp2f(-fabsf(z))); float lk = lb - z; if (diag && !(key0 + 32 < trel)) lk = 0.f; p1[r] = lb;
              if (r & 1) lkw1[r >> 1] = pkh(__builtin_bit_cast(float, lkw1[r >> 1]), lk); else lkw1[r >> 1] = __builtin_bit_cast(unsigned, lk); }
        }
        f32x16 bt1, bt0;
#pragma unroll
        for (int r = 0; r < 16; ++r) { bt1[r] = R; bt0[r] = R; }
        const f16x8 L10 = h8(lkw1[0], lkw1[1], lkw1[2], lkw1[3]), L11 = h8(lkw1[4], lkw1[5], lkw1[6], lkw1[7]), L00 = h8(lkw0[0], lkw0[1], lkw0[2], lkw0[3]), L01 = h8(lkw0[4], lkw0[5], lkw0[6], lkw0[7]);
        bt1 = __builtin_amdgcn_mfma_f32_32x32x16_f16(U0, L10, bt1, 0, 0, 0); bt1 = __builtin_amdgcn_mfma_f32_32x32x16_f16(U1, L11, bt1, 0, 0, 0);
        bt0 = __builtin_amdgcn_mfma_f32_32x32x16_f16(ONES, L10, bt0, 0, 0, 0); bt0 = __builtin_amdgcn_mfma_f32_32x32x16_f16(ONES, L11, bt0, 0, 0, 0);
        bt0 = __builtin_amdgcn_mfma_f32_32x32x16_f16(U0, L00, bt0, 0, 0, 0); bt0 = __builtin_amdgcn_mfma_f32_32x32x16_f16(U1, L01, bt0, 0, 0, 0);
        { const float v = bt0[0] + lk00;
          const auto rr = __builtin_amdgcn_permlane32_swap(__builtin_bit_cast(unsigned, v), __builtin_bit_cast(unsigned, v), false, false);
          R = __builtin_bit_cast(float, rr[0]); }
        unsigned aw0[8], aw1[8];
#pragma unroll
        for (int r = 0; r < 16; r += 2) {
            const int key0 = ml::crow(r, hi);
            float a00 = __builtin_amdgcn_exp2f(p0[r] + bt0[r]), a01 = __builtin_amdgcn_exp2f(p0[r + 1] + bt0[r + 1]), a10 = __builtin_amdgcn_exp2f(p1[r] + bt1[r]), a11 = __builtin_amdgcn_exp2f(p1[r + 1] + bt1[r + 1]);
            if (diag) { if (!(key0 < trel)) a00 = 0.f; if (!(key0 + 1 < trel)) a01 = 0.f; if (!(key0 + 32 < trel)) a10 = 0.f; if (!(key0 + 33 < trel)) a11 = 0.f; }
            aw0[r >> 1] = pk2(a00, a01); aw1[r >> 1] = pk2(a10, a11);
        }
        const bf16x8 A00 = b8(aw0[0], aw0[1], aw0[2], aw0[3]), A01 = b8(aw0[4], aw0[5], aw0[6], aw0[7]), A10 = b8(aw1[0], aw1[1], aw1[2], aw1[3]), A11 = b8(aw1[4], aw1[5], aw1[6], aw1[7]);
        O0 = __builtin_amdgcn_mfma_f32_32x32x16_bf16(A00, frag_trp<128, 7>(base + O_VI, 0, 0, lo), O0, 0, 0, 0);  O1 = __builtin_amdgcn_mfma_f32_32x32x16_bf16(A00, frag_trp<128, 7>(base + O_VI, 0, 32, lo), O1, 0, 0, 0);
        O0 = __builtin_amdgcn_mfma_f32_32x32x16_bf16(A01, frag_trp<128, 7>(base + O_VI, 1, 0, lo), O0, 0, 0, 0);  O1 = __builtin_amdgcn_mfma_f32_32x32x16_bf16(A01, frag_trp<128, 7>(base + O_VI, 1, 32, lo), O1, 0, 0, 0);
        O0 = __builtin_amdgcn_mfma_f32_32x32x16_bf16(A10, frag_trp<128, 7>(base + O_VI, 2, 0, lo), O0, 0, 0, 0);  O1 = __builtin_amdgcn_mfma_f32_32x32x16_bf16(A10, frag_trp<128, 7>(base + O_VI, 2, 32, lo), O1, 0, 0, 0);
        O0 = __builtin_amdgcn_mfma_f32_32x32x16_bf16(A11, frag_trp<128, 7>(base + O_VI, 3, 0, lo), O0, 0, 0, 0);  O1 = __builtin_amdgcn_mfma_f32_32x32x16_bf16(A11, frag_trp<128, 7>(base + O_VI, 3, 32, lo), O1, 0, 0, 0);
        if (__all(R < ATT_RTHR)) { wdone = true; if (lane == 0) dflag[wave] = 1; }
    }
#undef AT_LOAD
    __syncthreads();
    bf16* dst = F.YA() + (rowb + tw0) * D + hd * 64 + l31;
#pragma unroll
    for (int r = 0; r < 16; ++r) { const int q = ml::crow(r, hi); dst[(size_t)q * D] = (bf16)pk2(O0[r], 0.f); dst[(size_t)q * D + 32] = (bf16)pk2(O1[r], 0.f); }
}
}

__device__ __forceinline__ void p5a_route(Frame& F) {
    const int row0 = F.vcu * 128, b = row0 / SEQ, lane = opq(F.lane), tid = opq(F.tid);
    LAS float* wr = (LAS float*)F.lds;
    LAS int* le = (LAS int*)(F.lds + 131584); LAS int* lp = le + 512;
    LAS int* lcnt = (LAS int*)(F.LC + LC_LCNT); LAS int* gbase = (LAS int*)(F.LC + LC_GBASE);
    for (int idx = tid; idx < 32768; idx += 512) wr[(idx & 31) * 1028 + (idx >> 5)] = F.router_w()[idx];
    if (tid < 32) lcnt[tid] = 0;
    f32x4 Av[4], Bv[4];
#pragma unroll
    for (int j = 0; j < 4; ++j) { const int col = 4 * lane + 256 * j; const float* mb = F.mod() + (size_t)b * NMOD;
        const f32x4 g = *(const f32x4*)(F.norm2_g() + col); Av[j] = g * (*(const f32x4*)(mb + 4 * D + col) + 1.0f); Bv[j] = *(const f32x4*)(mb + 3 * D + col); }
    float rb[32];
#pragma unroll
    for (int e = 0; e < 32; ++e) rb[e] = F.router_b()[e];
    __syncthreads();
    f32x4 nx[4];
    { const GAS f32x4* xr = (const GAS f32x4*)(F.out() + (size_t)(row0 + 16 * F.wave) * D) + lane;
#pragma unroll
      for (int j = 0; j < 4; ++j) nx[j] = xr[64 * j]; }
    for (int r = 0; r < 16; ++r) {
        const int rl = 16 * F.wave + r, row = row0 + rl;
        f32x4 v[4]; float ss = 0.f;
#pragma unroll
        for (int j = 0; j < 4; ++j) { v[j] = nx[j]; ss += (v[j].x * v[j].x + v[j].y * v[j].y) + (v[j].z * v[j].z + v[j].w * v[j].w); }
        if (r < 15) { const GAS f32x4* xr = (const GAS f32x4*)(F.out() + (size_t)(row + 1) * D) + lane;
#pragma unroll
            for (int j = 0; j < 4; ++j) nx[j] = xr[64 * j]; }
        const float rstd = 1.0f / sqrtf(wave_sum(ss) * (1.0f / D) + EPS);
        { GAS unsigned long long* o8 = (GAS unsigned long long*)(F.H2() + (size_t)row * D) + lane;
#pragma unroll
          for (int j = 0; j < 4; ++j) { v[j] = v[j] * rstd * Av[j] + Bv[j]; o8[64 * j] = (unsigned long long)pk2(v[j].x, v[j].y) | ((unsigned long long)pk2(v[j].z, v[j].w) << 32); } }
        float p[32];
#pragma unroll
        for (int e = 0; e < 32; ++e) { float s = 0.f;
#pragma unroll
            for (int j = 0; j < 4; ++j) { const f32x4 w = *(const LAS f32x4*)(wr + e * 1028 + 4 * lane + 256 * j); s += (v[j].x * w.x + v[j].y * w.y) + (v[j].z * w.z + v[j].w * w.w); }
            p[e] = s; }
#pragma unroll
        for (int i = 0; i < 16; ++i) { const bool up = (lane & 32) != 0; const float send = up ? p[i] : p[i + 16], keep = up ? p[i + 16] : p[i]; p[i] = keep + __shfl_xor(send, 32); }
#pragma unroll
        for (int i = 0; i < 8; ++i) { const bool up = (lane & 16) != 0; const float send = up ? p[i] : p[i + 8], keep = up ? p[i + 8] : p[i]; p[i] = keep + __shfl_xor(send, 16); }
#pragma unroll
        for (int i = 0; i < 4; ++i) { const bool up = (lane & 8) != 0; const float send = up ? p[i] : p[i + 4], keep = up ? p[i + 4] : p[i]; p[i] = keep + __shfl_xor(send, 8); }
#pragma unroll
        for (int i = 0; i < 2; ++i) { const bool up = (lane & 4) != 0; const float send = up ? p[i] : p[i + 2], keep = up ? p[i + 2] : p[i]; p[i] = keep + __shfl_xor(send, 4); }
        { const bool up = (lane & 2) != 0; const float send = up ? p[0] : p[1], keep = up ? p[1] : p[0]; p[0] = keep + __shfl_xor(send, 2); }
        p[0] += __shfl_xor(p[0], 1);
        { LAS float* lg = (LAS float*)(F.lds + 135680) + F.wave * 32;
          if ((lane & 1) == 0) lg[lane >> 1] = p[0];
#pragma unroll
          for (int q = 0; q < 8; ++q) { const f32x4 t4 = *(const LAS f32x4*)(lg + 4 * q); p[4 * q] = t4.x + rb[4 * q]; p[4 * q + 1] = t4.y + rb[4 * q + 1]; p[4 * q + 2] = t4.z + rb[4 * q + 2]; p[4 * q + 3] = t4.w + rb[4 * q + 3]; } }
        int sel[4]; float sv[4]; unsigned used = 0u;
#pragma unroll
        for (int k = 0; k < 4; ++k) { float best = -3.0e38f; int bi = 0;
#pragma unroll
            for (int e = 0; e < 32; ++e) { const bool cnd = (((used >> e) & 1u) == 0u) && (p[e] > best); best = cnd ? p[e] : best; bi = cnd ? e : bi; }
            sel[k] = bi; sv[k] = best; used |= 1u << bi; }
        const float e1 = __expf(sv[1] - sv[0]), e2 = __expf(sv[2] - sv[0]), e3 = __expf(sv[3] - sv[0]), inv = 1.0f / (1.0f + e1 + e2 + e3);
        if (lane < 4) { const int ek = lane == 0 ? sel[0] : lane == 1 ? sel[1] : lane == 2 ? sel[2] : sel[3];
            const float wk = (lane == 0 ? 1.0f : lane == 1 ? e1 : lane == 2 ? e2 : e3) * inv;
            const int pos = __hip_atomic_fetch_add(lcnt + ek, 1, __ATOMIC_RELAXED, __HIP_MEMORY_SCOPE_WORKGROUP);
            le[rl * 4 + lane] = ek; lp[rl * 4 + lane] = pos; F.tokw()[(size_t)row * 4 + lane] = wk; }
        if (lane == 0) F.rstd2()[row] = rstd;
    }
    __syncthreads();
    if (tid < 32) gbase[tid] = (int)__hip_atomic_fetch_add(F.ctl + CW_ECNT + 64 * tid, (unsigned)lcnt[tid], __ATOMIC_RELAXED, __HIP_MEMORY_SCOPE_AGENT);
    __syncthreads();
    { const int ek = le[tid]; F.toke()[(size_t)row0 * 4 + tid] = ek; F.tokp()[(size_t)row0 * 4 + tid] = lp[tid] + gbase[ek]; }
}

__device__ __forceinline__ void p5b_tables(Frame& F) {
    const int row0 = F.vcu * 128, tid = opq(F.tid);
    LAS int* ts = (LAS int*)(F.LC + LC_TS); LAS int* ps = (LAS int*)(F.LC + LC_PS); LAS int* cn = (LAS int*)(F.LC + LC_CNT);
    if (tid < 32) cn[tid] = (int)__hip_atomic_load(F.ctl + CW_ECNT + 64 * tid, RLX_AGENT);
    __syncthreads();
    if (tid == 0) { int run = 0, trun = 0; for (int e = 0; e < 32; ++e) { ps[e] = run; ts[e] = trun; const int nt = (cn[e] + 255) >> 8; run += nt * 256; trun += nt; } ts[32] = trun; }
    __syncthreads();
    { const size_t idx = (size_t)row0 * 4 + tid; const int ek = F.toke()[idx], dst = ps[ek] + F.tokp()[idx]; F.tokrow()[idx] = dst; F.row2tok()[dst] = row0 + (tid >> 2); }
    if (F.vcu < 32) { const int e = F.vcu, start = ps[e] + cn[e], end = ps[e] + (((cn[e] + 255) >> 8) << 8); for (int r = start + tid; r < end; r += 512) F.row2tok()[r] = 0; }
}

__device__ __forceinline__ void p8_combine(Frame& F, bool poison) {
    const int row0 = F.vcu * 128, b = row0 / SEQ, lane = opq(F.lane);
    f32x4 G2[4], FG[4];
#pragma unroll
    for (int j = 0; j < 4; ++j) { const int col = 4 * lane + 256 * j; G2[j] = *(const f32x4*)(F.mod() + (size_t)b * NMOD + 5 * D + col); FG[j] = *(const f32x4*)(F.final_g() + col); }
    f32x4 nx[4]; unsigned long long ng[4][4]; float nw[4];
#define P8_LOAD(ROW) do { const size_t row_ = (ROW); const GAS f32x4* xr_ = (const GAS f32x4*)(F.out() + row_ * D) + lane; \
        _Pragma("unroll") for (int j = 0; j < 4; ++j) nx[j] = xr_[64 * j]; \
        _Pragma("unroll") for (int k = 0; k < 4; ++k) { const int src_ = F.tokrow()[row_ * 4 + k]; nw[k] = F.tokw()[row_ * 4 + k]; \
            const GAS unsigned long long* s8_ = (const GAS unsigned long long*)(F.OUTR() + (size_t)src_ * D) + lane; \
            _Pragma("unroll") for (int j = 0; j < 4; ++j) ng[k][j] = s8_[64 * j]; } } while (0)
    P8_LOAD((size_t)row0 + 16 * F.wave);
    for (int r = 0; r < 16; ++r) {
        const int row = row0 + 16 * F.wave + r;
        GAS f32x4* xr = (GAS f32x4*)(F.out() + (size_t)row * D) + lane;
        f32x4 y[4], xv[4];
#pragma unroll
        for (int j = 0; j < 4; ++j) { y[j] = (f32x4){0.f, 0.f, 0.f, 0.f}; xv[j] = nx[j]; }
#pragma unroll
        for (int k = 0; k < 4; ++k) { const float wk = nw[k];
#pragma unroll
            for (int j = 0; j < 4; ++j) { const unsigned long long w = ng[k][j]; y[j].x += wk * bflo((unsigned)w); y[j].y += wk * bfhi((unsigned)w); y[j].z += wk * bflo((unsigned)(w >> 32)); y[j].w += wk * bfhi((unsigned)(w >> 32)); } }
        if (r < 15) P8_LOAD((size_t)row + 1);
        f32x4 v[4]; float ss = 0.f;
#pragma unroll
        for (int j = 0; j < 4; ++j) { v[j] = xv[j] + G2[j] * y[j]; ss += (v[j].x * v[j].x + v[j].y * v[j].y) + (v[j].z * v[j].z + v[j].w * v[j].w); }
        const float rstd = 1.0f / sqrtf(wave_sum(ss) * (1.0f / D) + EPS);
        const float qn = __builtin_nanf("");
#pragma unroll
        for (int j = 0; j < 4; ++j) { f32x4 o = v[j] * rstd * FG[j]; if (poison) o = (f32x4){qn, qn, qn, qn}; xr[64 * j] = o; }
    }
#undef P8_LOAD
}

#ifndef MK_REP_G2
#define MK_REP_G2 1
#endif
#ifndef MK_REP_G4A
#define MK_REP_G4A 1
#endif
#ifndef MK_REP_G4B
#define MK_REP_G4B 1
#endif
#ifndef MK_REP_G4C
#define MK_REP_G4C 1
#endif
#ifndef MK_REP_G6
#define MK_REP_G6 1
#endif
#ifndef MK_REP_G7
#define MK_REP_G7 1
#endif
#ifndef MK_REP_P0
#define MK_REP_P0 1
#endif
#ifndef MK_REP_P3
#define MK_REP_P3 1
#endif
struct Args { const float* in[22]; float* out; unsigned char* ws; };
__global__ void __launch_bounds__(NWAVES * 64, 2) mk_fwd(Args args) {
    extern __shared__ __attribute__((aligned(16))) unsigned char lds[];
    Frame F;
    F.lds = (LAS unsigned char*)lds; F.LC = (volatile LAS unsigned*)(F.lds + LDSCTL_OFF);
    F.tid = threadIdx.x; F.lane = F.tid & 63; F.wave = __builtin_amdgcn_readfirstlane(F.tid >> 6);
    F.G = gridDim.x; { const int bx = blockIdx.x; F.vcu = (F.G % 8 == 0) ? (bx % 8) * (F.G / 8) + bx / 8 : bx; }
    F.ws = (unsigned char*)(GAS unsigned char*)karg(23);
    F.ctl = (gu32*)(F.ws + WS_CTL);
    for (int u = F.tid; u < (LDS_BYTES - LDSCTL_OFF) / 4; u += NWAVES * 64) ((LAS unsigned*)(F.lds + LDSCTL_OFF))[u] = 0u;
    __syncthreads();
    XcdBarrier bar = xcd_barrier_post((unsigned*)(F.ctl + CW_BAR), F.LC + LC_BAR);
#define GRID_BAR() xcd_barrier(bar)
    const int G = F.G, cid = (int)blockIdx.x;

    for (int rep_ = 0; rep_ < MK_REP_P0; ++rep_) p0_prologue(F);
    GRID_BAR();
    p1_rows(F);
    GRID_BAR();
    { pg8::Gemm g{F.H1(), F.WIN_T(), T, NPROJ, D}; pg8::StaticOrder S; S.init(T, NPROJ, G, cid);
      pg8::EpiBf16<0> E{F.PROJ(), D, nullptr, D, SEG / 2, QSCALE};
      for (int rep_ = 0; rep_ < MK_REP_G2; ++rep_) pg8::gemm_phase<pg8::EpiBf16<0>, pg8::StaticOrder, true, true>(F.lds, g, S, E); }
    GRID_BAR();
    for (int job = F.vcu * NWAVES + F.wave; job < BATCH * 4 * (SEQ / 64); job += G * NWAVES) mlstm_gates(F, job);
    mlstm_conv_rows(F);
    GRID_BAR();
#if defined(MK_NAIVE_MLSTM)
    for (int it = F.vcu; it < 1024; it += G) attn_naive_item(F, it & 255, it >> 8);
    __syncthreads();
    for (int it = F.vcu; it < 64; it += G) mlstm_naive_item(F, it);
#else
    for (int rep_ = 0; rep_ < MK_REP_P3; ++rep_) {
    for (int it = F.vcu; it < 256; it += G) ml::mlstm_unit(F, it);
    __syncthreads();
#if defined(MK_NAIVE_ATTN)
    for (int it = F.vcu; it < 1024; it += G) attn_naive_item(F, it & 255, it >> 8);
#else
    for (int it = F.vcu; it < 2048; it += G) at::attn_unit(F, it & 255, it >> 8);
#endif
    }
#endif
    GRID_BAR();
    { pg8::Gemm g{F.YA(), F.WA_T(), T, D, D}; pg8::StaticOrder S; S.init(T, D, G, cid);
      pg8::EpiGate<false> E{F.PROJ() + 7 * (SEG / 2), nullptr, F.M1()};
      for (int rep_ = 0; rep_ < MK_REP_G4A; ++rep_) pg8::gemm_phase<pg8::EpiGate<false>, pg8::StaticOrder, true, true>(F.lds, g, S, E); }
#if defined(MK_NAIVE_MLSTM)
    VM_WAIT(); __syncthreads();
#else
    __syncthreads();
    mlstm_norm_rows(F);
    GRID_BAR();
#endif
    { pg8::Gemm g{F.YB(), F.WB_T(), T, D, D}; pg8::StaticOrder S; S.init(T, D, G, cid);
      pg8::EpiGate<true> E{F.PROJ() + 8 * (SEG / 2), F.M1(), F.MERGED()};
      for (int rep_ = 0; rep_ < MK_REP_G4B; ++rep_) pg8::gemm_phase<pg8::EpiGate<true>, pg8::StaticOrder, true, true>(F.lds, g, S, E); }
    GRID_BAR();
    { pg8::Gemm g{F.MERGED(), F.WOUT_T(), T, D, D}; pg8::StaticOrder S; S.init(T, D, G, cid);
      pg8::EpiResid E{F.x(), F.mod() + 2 * D, F.out(), SEQ, NMOD};
      for (int rep_ = 0; rep_ < MK_REP_G4C; ++rep_) pg8::gemm_phase<pg8::EpiResid, pg8::StaticOrder, true, true>(F.lds, g, S, E); }
    GRID_BAR();
    p5a_route(F);
    GRID_BAR();
    p5b_tables(F);
    GRID_BAR();
    { pg8::Gemm g{F.H2(), F.W1_T(), T, NE * 2048, D}; pg8::GroupedOrder S{(const LAS int*)(F.LC + LC_TS), 8, G, cid, F.row2tok()};
      pg8::EpiSwiglu E{F.b1(), F.ACT()};
      for (int rep_ = 0; rep_ < MK_REP_G6; ++rep_) pg8::gemm_phase<pg8::EpiSwiglu, pg8::GroupedOrder, true, true, true>(F.lds, g, S, E); }
    GRID_BAR();
    { pg8::Gemm g{F.ACT(), F.W2_T(), XS_ROWS, NE * 1024, D}; pg8::GroupedOrder S{(const LAS int*)(F.LC + LC_TS), 4, G, cid, nullptr};
      pg8::EpiBf16<0> E{F.OUTR(), D, F.b2(), D, 0, 1.0f};
      for (int rep_ = 0; rep_ < MK_REP_G7; ++rep_) pg8::gemm_phase<pg8::EpiBf16<0>, pg8::GroupedOrder, true, true>(F.lds, g, S, E); }
    GRID_BAR();
    { const bool poison = __hip_atomic_load(F.ctl + CW_BAR + XB_TMO, RLX_AGENT) != 0u;
      p8_combine(F, poison); }
}

extern "C" void kernel_launch(void* const* d_in, const int* in_sizes, int n_in, void* d_out, int out_size, void* d_ws, size_t ws_size, hipStream_t stream) {
    static int grid = 0;
    if (grid == 0) {
        if (n_in != 22 || in_sizes[0] != T * D || out_size != T * D || ws_size < WS_END) { fprintf(stderr, "kernel_launch: unexpected shapes (n_in %d, in0 %d, out %d, ws %zu)\n", n_in, n_in > 0 ? in_sizes[0] : -1, out_size, ws_size); grid = -1; return; }
        int dev = 0, cus = 0, per_cu = 0;
        if (hipGetDevice(&dev) != hipSuccess || hipDeviceGetAttribute(&cus, hipDeviceAttributeMultiprocessorCount, dev) != hipSuccess) { grid = -1; return; }
        if (hipFuncSetAttribute((const void*)mk_fwd, hipFuncAttributeMaxDynamicSharedMemorySize, LDS_BYTES) != hipSuccess) { fprintf(stderr, "kernel_launch: hipFuncSetAttribute failed\n"); grid = -1; return; }
        if (hipOccupancyMaxActiveBlocksPerMultiprocessor(&per_cu, (const void*)mk_fwd, NWAVES * 64, LDS_BYTES) != hipSuccess || per_cu < 1) { fprintf(stderr, "kernel_launch: occupancy query says %d blocks per CU\n", per_cu); }
        (void)hipGetLastError();
        if (cus < 256) { fprintf(stderr, "kernel_launch: built for a 256-CU device, found %d CUs\n", cus); grid = -1; return; }
        grid = 256;
    }
    if (grid < 0) return;
    if (hipMemsetAsync((char*)d_ws + WS_CTL, 0, CTL_ZERO_BYTES, stream) != hipSuccess) return;
    Args a{};
    for (int i = 0; i < 22; ++i) a.in[i] = (const float*)d_in[i];
    a.out = (float*)d_out; a.ws = (unsigned char*)d_ws;
    hipLaunchKernelGGL(mk_fwd, dim3(grid), dim3(NWAVES * 64), LDS_BYTES, stream, a);
}
```

```cpp
#include <hip/hip_runtime.h>
#include <cstdio>
#include <cstdint>
namespace pg8 {
#define PG8_LAS __attribute__((address_space(3)))
typedef unsigned short bf16_t;
typedef short bf16x8 __attribute__((ext_vector_type(8)));
typedef float f32x4 __attribute__((ext_vector_type(4)));
typedef unsigned u32x4 __attribute__((ext_vector_type(4)));
constexpr int BM = 256, BK = 64, HALF = 128, HTB = HALF * BK * 2  , STAGE_BYTES = 8 * HTB, NXCD = 8, WGM = 8;

__host__ __device__ __forceinline__ int lds_byte(int r, int c) { const int st = (r >> 4) * 2 + (c >> 5), rr = r & 15, cc = c & 31, ob = rr * 64 + cc * 2; return st * 1024 + (ob ^ (((ob >> 9) & 1) << 5)); }
__host__ __device__ __forceinline__ void stage_rc(int b, int& R, int& C) { const int st = b / 1024, sb = b % 1024, swz = sb ^ (((sb >> 9) & 1) << 5); R = (st >> 1) * 16 + swz / 64; C = (st & 1) * 32 + (swz % 64) / 2; }
__host__ __device__ __forceinline__ int perm32(int rho) { const int n = rho >> 4, i = rho & 15; return 8 * (i >> 2) + 4 * n + (i & 3); }

struct Unit { int pm, pn; };
struct Gemm { const bf16_t* A; const bf16_t* Bt; int M, N, K; };

struct StaticOrder {
    int nM, nN, nwg, G, c;
    __host__ __device__ void init(int M, int N, int G_, int c_) { nM = M / BM; nN = N / BM; nwg = nM * nN; G = G_; c = c_; }
    __host__ __device__ bool next(int i, Unit& u) const {
        const long L = (long)i * G + c; if (L >= nwg) return false;
        int wgid = (int)L; { const int q = nwg / NXCD, r = nwg % NXCD, xcd = wgid % NXCD, off = wgid / NXCD; wgid = (xcd < r ? xcd * (q + 1) : r * (q + 1) + (xcd - r) * q) + off; }
        const int nig = WGM * nN, gid = wgid / nig, fm = gid * WGM, gsz = (nM - fm) < WGM ? (nM - fm) : WGM;
        u.pm = fm + ((wgid % nig) % gsz); u.pn = (wgid % nig) / gsz; return true;
    }
    __device__ __forceinline__ void a_ready(const Unit&) const {}
    __device__ __forceinline__ void done(const Unit&) const {}
};

__device__ __forceinline__ unsigned cvt_pk_bf16(float lo, float hi) { unsigned r; asm volatile("v_cvt_pk_bf16_f32 %0, %1, %2" : "=v"(r) : "v"(lo), "v"(hi)); return r; }
typedef float f32x2 __attribute__((ext_vector_type(2)));
__device__ __forceinline__ f32x2 gelu_pk(f32x2 v) {
    const f32x2 av = __builtin_elementwise_abs(v), d = av * 0.2316418882f + 1.0f;
    f32x2 t; t.x = __builtin_amdgcn_rcpf(d.x); t.y = __builtin_amdgcn_rcpf(d.y);
    f32x2 q = t * 0.5307027145f + (-0.7265760135f); q = q * t + 0.7107068705f; q = q * t + (-0.142248368f); q = q * t + 0.127414796f; q = q * t;
    const f32x2 s = (v * v) * (-0.72134752044f);
    f32x2 e; e.x = __builtin_amdgcn_exp2f(s.x); e.y = __builtin_amdgcn_exp2f(s.y);
    const f32x2 m = v * (q * e), r = v - m;
    f32x2 o; o.x = v.x < 0.f ? m.x : r.x; o.y = v.y < 0.f ? m.y : r.y; return o;
}

template <int ACT  > struct EpiBf16 {
    static constexpr bool PERM = true, AFTER_DRAIN = false; static_assert(ACT == 0 || ACT == 1, "EpiBf16: ACT is 0 (none) or 1 (gelu_pk)");
    bf16_t* O; int ldc; const float* bias; int split_cols; size_t split_stride; float scale0;
    __device__ __forceinline__ void operator()(const f32x4 (&acc)[2][2][4][2], const Unit& u, int wr, int wc, int fr, int fq) const {
        const int row0 = u.pm * BM + wr * 64 + fr; int colt = u.pn * BM; bf16_t* base = O;
        float sc = 1.f; if (split_cols) { const int t = colt / split_cols; base += (size_t)t * split_stride; colt -= t * split_cols; if (t == 0) sc = scale0; }
        const int col0 = colt + wc * 32 + 8 * fq, bcol0 = u.pn * BM + wc * 32 + 8 * fq;
        f32x4 bv[2][2];
#pragma unroll
        for (int bj = 0; bj < 2; ++bj)
#pragma unroll
            for (int n = 0; n < 2; ++n) bv[bj][n] = bias ? *(const f32x4*)(bias + bcol0 + bj * HALF + 4 * n) : (f32x4){0.f, 0.f, 0.f, 0.f};
#pragma unroll
        for (int ai = 0; ai < 2; ++ai)
#pragma unroll
            for (int m = 0; m < 4; ++m) { bf16_t* rowp = base + (size_t)(row0 + ai * HALF + m * 16) * ldc + col0;
#pragma unroll
                for (int bj = 0; bj < 2; ++bj) { f32x4 v0 = acc[ai][bj][m][0] + bv[bj][0], v1 = acc[ai][bj][m][1] + bv[bj][1];
                    if (ACT == 1) { f32x2 a = gelu_pk((f32x2){v0[0], v0[1]}), b = gelu_pk((f32x2){v0[2], v0[3]}), c = gelu_pk((f32x2){v1[0], v1[1]}), d = gelu_pk((f32x2){v1[2], v1[3]});
                        v0 = (f32x4){a.x, a.y, b.x, b.y}; v1 = (f32x4){c.x, c.y, d.x, d.y}; }
                    v0 = v0 * sc; v1 = v1 * sc; u32x4 w; w.x = cvt_pk_bf16(v0[0], v0[1]); w.y = cvt_pk_bf16(v0[2], v0[3]); w.z = cvt_pk_bf16(v1[0], v1[1]); w.w = cvt_pk_bf16(v1[2], v1[3]);
                    *(u32x4*)(rowp + bj * HALF) = w; } }
    }
};
template <class Epi, class Sched, bool ALIGN_EPI = false, bool SP2 = false, bool GATHER = false>
__device__ __forceinline__ void gemm_phase(PG8_LAS unsigned char* lds, const Gemm g, const Sched& S, const Epi& E) {
    int tid_ = threadIdx.x; asm volatile("" : "+v"(tid_));
    const int tid = tid_, wid = __builtin_amdgcn_readfirstlane(tid >> 6), lane = tid & 63, wr = wid >> 2, wc = wid & 3, fr = lane & 15, fq = lane >> 4;
    const int K = g.K, nt = K / BK;
    unsigned voffA[2], voffB[2], vA0[2], vA1[2], vN0[2], vN1[2]; int Rr_[2], Cc_[2];
#pragma unroll
    for (int i = 0; i < 2; ++i) { int R, C; stage_rc(tid * 16 + i * 8192, R, C); const int Rb = Epi::PERM ? ((R & ~31) + perm32(R & 31)) : R;
        voffA[i] = (unsigned)(R * K + C) * 2u; voffB[i] = (unsigned)(Rb * K + C) * 2u; Rr_[i] = R; Cc_[i] = C; }
    const size_t kstep = (size_t)(BK * 2);
    const size_t hstep = (size_t)HALF * K * 2;
    const size_t tstep = 2 * hstep;
#pragma unroll
    for (int i = 0; i < 2; ++i) { vA0[i] = voffA[i]; vA1[i] = voffA[i] + (unsigned)hstep; vN0[i] = vA0[i]; vN1[i] = vA1[i]; }
#define PG8_GLOAD(u, v0, v1) do { _Pragma("unroll") for (int _i = 0; _i < 2; ++_i) { const int _t0 = S.rowtok[(u).pm * BM + Rr_[_i]], _t1 = S.rowtok[(u).pm * BM + HALF + Rr_[_i]]; \
        (v0)[_i] = (unsigned)_t0 * (unsigned)(K * 2) + (unsigned)(Cc_[_i] * 2); (v1)[_i] = (unsigned)_t1 * (unsigned)(K * 2) + (unsigned)(Cc_[_i] * 2); } } while (0)
    const unsigned ldsw = (unsigned)wid * 1024u;
    const int aoff = lds_byte(wr * 64 + fr, fq * 8), boff = lds_byte(wc * 32 + fr, fq * 8);
#define PG8_SA(b, h) (((b) * 2 + (h)) * HTB)
#define PG8_SB(b, h) ((4 + (b) * 2 + (h)) * HTB)
#define PG8_STAGE(bufoff, gbase, voff) do { _Pragma("unroll") for (int _i = 0; _i < 2; ++_i) \
        __builtin_amdgcn_global_load_lds((const unsigned*)((const char*)(gbase) + (voff)[_i]), (PG8_LAS unsigned*)(lds + (bufoff) + ldsw + _i * 8192), 16, 0, 0); } while (0)
#define PG8_LDA(dst, b, h) do { _Pragma("unroll") for (int m = 0; m < 4; ++m) _Pragma("unroll") for (int k = 0; k < 2; ++k) dst[m][k] = *(const PG8_LAS bf16x8*)(lds + PG8_SA(b, h) + aoff + m * 2048 + k * 1024); } while (0)
#define PG8_LDB(dst, b, h) do { _Pragma("unroll") for (int n = 0; n < 2; ++n) _Pragma("unroll") for (int k = 0; k < 2; ++k) dst[n][k] = *(const PG8_LAS bf16x8*)(lds + PG8_SB(b, h) + boff + n * 2048 + k * 1024); } while (0)
#define PG8_MMA(ai, bj, At, Bt) do { __builtin_amdgcn_s_setprio(1); _Pragma("unroll") for (int m = 0; m < 4; ++m) _Pragma("unroll") for (int n = 0; n < 2; ++n) _Pragma("unroll") for (int k = 0; k < 2; ++k) \
        acc[ai][bj][m][n] = __builtin_amdgcn_mfma_f32_16x16x32_bf16(Bt[n][k], At[m][k], acc[ai][bj][m][n], 0, 0, 0); __builtin_amdgcn_s_setprio(0); } while (0)
#define PG8_WAIT_V(n) asm volatile("s_waitcnt vmcnt(" #n ")" ::: "memory")
#define PG8_WAIT_L(n) asm volatile("s_waitcnt lgkmcnt(" #n ")" ::: "memory")
#define PG8_BAR __builtin_amdgcn_s_barrier()
#define PG8_SCHED __builtin_amdgcn_sched_barrier(0)
    Unit cur, nxt; int ui = 0;
    if (!S.next(0, cur)) return;
    f32x4 acc[2][2][4][2];
#pragma unroll
    for (int a = 0; a < 2; ++a)
#pragma unroll
        for (int b = 0; b < 2; ++b)
#pragma unroll
            for (int m = 0; m < 4; ++m)
#pragma unroll
                for (int n = 0; n < 2; ++n) acc[a][b][m][n] = (f32x4){0.f, 0.f, 0.f, 0.f};
    bf16x8 At[4][2], B0[2][2], B1[2][2];
    if constexpr (GATHER) PG8_GLOAD(cur, vA0, vA1);
    const char* cA = GATHER ? (const char*)g.A : (const char*)g.A + (size_t)cur.pm * tstep; const char* cB = (const char*)g.Bt + (size_t)cur.pn * tstep;
    S.a_ready(cur);
    if constexpr (SP2) {
        PG8_STAGE(PG8_SB(0, 0), cB, voffB); PG8_STAGE(PG8_SB(0, 1), cB + hstep, voffB); PG8_STAGE(PG8_SA(0, 0), cA, vA0); PG8_STAGE(PG8_SA(0, 1), cA, vA1);
        if (wr == 1) PG8_BAR;
        PG8_WAIT_V(2); PG8_BAR;
        PG8_STAGE(PG8_SB(1, 0), cB + kstep, voffB); PG8_STAGE(PG8_SA(1, 0), cA + kstep, vA0); PG8_STAGE(PG8_SB(1, 1), cB + hstep + kstep, voffB);
        PG8_WAIT_V(6); PG8_BAR;
    } else {
        PG8_STAGE(PG8_SB(0, 0), cB, voffB); PG8_STAGE(PG8_SA(0, 0), cA, vA0); PG8_STAGE(PG8_SB(0, 1), cB + hstep, voffB); PG8_STAGE(PG8_SA(0, 1), cA, vA1);
        if (wr == 1) PG8_BAR;
        PG8_WAIT_V(4); PG8_BAR;
        PG8_STAGE(PG8_SB(1, 0), cB + kstep, voffB); PG8_STAGE(PG8_SA(1, 0), cA + kstep, vA0); PG8_STAGE(PG8_SB(1, 1), cB + hstep + kstep, voffB);
        PG8_WAIT_V(6); PG8_BAR;
    }
    for (;;) {
        const bool has_next = S.next(ui + 1, nxt);
        if constexpr (GATHER) { if (has_next) PG8_GLOAD(nxt, vN0, vN1); else { _Pragma("unroll") for (int i = 0; i < 2; ++i) { vN0[i] = vA0[i]; vN1[i] = vA1[i]; } } }
        const char* nA = GATHER ? (const char*)g.A : (has_next ? (const char*)g.A + (size_t)nxt.pm * tstep : cA); const char* nB = has_next ? (const char*)g.Bt + (size_t)nxt.pn * tstep : cB;
        for (int t = 0; t < nt; t += 2) {
            const bool last = (t == nt - 2);
            const char* a1 = cA + (size_t)(t + 1) * kstep;
            const char* a2 = last ? nA : cA + (size_t)(t + 2) * kstep; const char* b2 = last ? nB : cB + (size_t)(t + 2) * kstep;
            const char* a3 = a2 + kstep; const char* b3 = b2 + kstep;
            unsigned vX0[2], vX1[2];
#pragma unroll
            for (int i = 0; i < 2; ++i) { vX0[i] = (GATHER && last) ? vN0[i] : vA0[i]; vX1[i] = (GATHER && last) ? vN1[i] : vA1[i]; }
            if (last && has_next) S.a_ready(nxt);
            if constexpr (SP2) {
            PG8_LDB(B0, 0, 0); PG8_LDB(B1, 0, 1); PG8_SCHED; PG8_LDA(At, 0, 0); PG8_STAGE(PG8_SA(1, 1), a1, vA1);
            PG8_WAIT_V(8); PG8_WAIT_L(0); PG8_BAR; PG8_MMA(0, 0, At, B0); PG8_MMA(0, 1, At, B1); PG8_BAR; PG8_SCHED;
            PG8_LDA(At, 0, 1); PG8_STAGE(PG8_SB(0, 0), b2, voffB); PG8_STAGE(PG8_SB(0, 1), b2 + hstep, voffB); PG8_STAGE(PG8_SA(0, 0), a2, vX0);
            PG8_WAIT_V(8); PG8_WAIT_L(0); PG8_BAR; PG8_MMA(1, 0, At, B0); PG8_MMA(1, 1, At, B1); PG8_BAR; PG8_SCHED;
            PG8_LDB(B0, 1, 0); PG8_LDB(B1, 1, 1); PG8_SCHED; PG8_LDA(At, 1, 0); PG8_STAGE(PG8_SA(0, 1), a2, vX1);
            PG8_WAIT_V(8); PG8_WAIT_L(0); PG8_BAR; PG8_MMA(0, 0, At, B0); PG8_MMA(0, 1, At, B1); PG8_BAR; PG8_SCHED;
            PG8_LDA(At, 1, 1); PG8_STAGE(PG8_SB(1, 0), b3, voffB); PG8_STAGE(PG8_SB(1, 1), b3 + hstep, voffB); PG8_STAGE(PG8_SA(1, 0), a3, vX0);
            PG8_WAIT_V(8); PG8_WAIT_L(0); PG8_BAR; PG8_MMA(1, 0, At, B0); PG8_MMA(1, 1, At, B1); PG8_BAR; PG8_SCHED;
            } else {
            PG8_LDB(B0, 0, 0); PG8_SCHED; PG8_LDA(At, 0, 0); PG8_STAGE(PG8_SA(1, 1), a1, vA1);
            PG8_WAIT_L(8); PG8_BAR; PG8_WAIT_L(0); PG8_MMA(0, 0, At, B0); PG8_BAR; PG8_SCHED;
            PG8_LDB(B1, 0, 1); PG8_STAGE(PG8_SB(0, 0), b2, voffB);
            PG8_BAR; PG8_WAIT_L(0); PG8_MMA(0, 1, At, B1); PG8_BAR;
            PG8_LDA(At, 0, 1); PG8_STAGE(PG8_SA(0, 0), a2, vX0);
            PG8_BAR; PG8_WAIT_L(0); PG8_MMA(1, 0, At, B0); PG8_BAR; PG8_SCHED;
            PG8_STAGE(PG8_SB(0, 1), b2 + hstep, voffB);
            PG8_WAIT_V(6); PG8_BAR; PG8_MMA(1, 1, At, B1); PG8_BAR;
            PG8_LDB(B0, 1, 0); PG8_SCHED; PG8_LDA(At, 1, 0); PG8_STAGE(PG8_SA(0, 1), a2, vX1);
            PG8_WAIT_L(8); PG8_BAR; PG8_WAIT_L(0); PG8_MMA(0, 0, At, B0); PG8_BAR; PG8_SCHED;
            PG8_LDB(B1, 1, 1); PG8_STAGE(PG8_SB(1, 0), b3, voffB);
            PG8_BAR; PG8_WAIT_L(0); PG8_MMA(0, 1, At, B1); PG8_BAR;
            PG8_LDA(At, 1, 1); PG8_STAGE(PG8_SA(1, 0), a3, vX0);
            PG8_BAR; PG8_WAIT_L(0); PG8_MMA(1, 0, At, B0); PG8_BAR; PG8_SCHED;
            PG8_STAGE(PG8_SB(1, 1), b3 + hstep, voffB);
            PG8_WAIT_V(6); PG8_BAR; PG8_MMA(1, 1, At, B1); PG8_BAR;
            }
        }
        if constexpr (ALIGN_EPI) { if (wr == 0) PG8_BAR; }
        if constexpr (!Epi::AFTER_DRAIN) { E(acc, cur, wr, wc, fr, fq); S.done(cur); }
        if (!has_next) break;
#pragma unroll
        for (int a = 0; a < 2; ++a)
#pragma unroll
            for (int b = 0; b < 2; ++b)
#pragma unroll
                for (int m = 0; m < 4; ++m)
#pragma unroll
                    for (int n = 0; n < 2; ++n) acc[a][b][m][n] = (f32x4){0.f, 0.f, 0.f, 0.f};
        cur = nxt; cA = nA; cB = nB; ++ui;
        if constexpr (GATHER) { _Pragma("unroll") for (int i = 0; i < 2; ++i) { vA0[i] = vN0[i]; vA1[i] = vN1[i]; } }
        if constexpr (ALIGN_EPI) { if (wr == 1) PG8_BAR; }
    }
    PG8_WAIT_V(0);
    if constexpr (!ALIGN_EPI) { if (wr == 0) PG8_BAR; }
    PG8_BAR;
    if constexpr (Epi::AFTER_DRAIN) { E.fused(acc, cur, wr, wc, fr, fq, lds, wid, lane); S.done(cur); }
#undef PG8_SA
#undef PG8_SB
#undef PG8_STAGE
#undef PG8_GLOAD
#undef PG8_LDA
#undef PG8_LDB
#undef PG8_MMA
#undef PG8_WAIT_V
#undef PG8_WAIT_L
#undef PG8_BAR
#undef PG8_SCHED
}
}
namespace pg8 {
__device__ __forceinline__ float bf_lo(unsigned w) { return __builtin_bit_cast(float, w << 16); }
__device__ __forceinline__ float bf_hi(unsigned w) { return __builtin_bit_cast(float, w & 0xffff0000u); }
__device__ __forceinline__ float sigmoid_f(float x) { return __builtin_amdgcn_rcpf(1.0f + __expf(-x)); }

template <bool ADD> struct EpiGate {
    static constexpr bool PERM = true, AFTER_DRAIN = false;
    const bf16_t* G; const bf16_t* Min; bf16_t* O;
    __device__ __forceinline__ void operator()(const f32x4 (&acc)[2][2][4][2], const Unit& u, int wr, int wc, int fr, int fq) const {
        const int row0 = u.pm * BM + wr * 64 + fr, col0 = u.pn * BM + wc * 32 + 8 * fq;
#pragma unroll
        for (int ai = 0; ai < 2; ++ai)
#pragma unroll
            for (int m = 0; m < 4; ++m) { const size_t off = (size_t)(row0 + ai * HALF + m * 16) * 1024 + col0;
#pragma unroll
                for (int bj = 0; bj < 2; ++bj) {
                    const u32x4 g = *(const u32x4*)(G + off + bj * HALF);
                    f32x4 v0 = acc[ai][bj][m][0], v1 = acc[ai][bj][m][1];
                    v0[0] *= sigmoid_f(bf_lo(g.x)); v0[1] *= sigmoid_f(bf_hi(g.x)); v0[2] *= sigmoid_f(bf_lo(g.y)); v0[3] *= sigmoid_f(bf_hi(g.y));
                    v1[0] *= sigmoid_f(bf_lo(g.z)); v1[1] *= sigmoid_f(bf_hi(g.z)); v1[2] *= sigmoid_f(bf_lo(g.w)); v1[3] *= sigmoid_f(bf_hi(g.w));
                    if (ADD) { const u32x4 p = *(const u32x4*)(Min + off + bj * HALF);
                        v0[0] += bf_lo(p.x); v0[1] += bf_hi(p.x); v0[2] += bf_lo(p.y); v0[3] += bf_hi(p.y);
                        v1[0] += bf_lo(p.z); v1[1] += bf_hi(p.z); v1[2] += bf_lo(p.w); v1[3] += bf_hi(p.w); }
                    u32x4 w; w.x = cvt_pk_bf16(v0[0], v0[1]); w.y = cvt_pk_bf16(v0[2], v0[3]); w.z = cvt_pk_bf16(v1[0], v1[1]); w.w = cvt_pk_bf16(v1[2], v1[3]);
                    *(u32x4*)(O + off + bj * HALF) = w; } }
    }
};

struct EpiResid {
    static constexpr bool PERM = false, AFTER_DRAIN = false;
    const float* X; const float* gate; float* out; int rows_per_batch; int gstride;
    __device__ __forceinline__ void operator()(const f32x4 (&acc)[2][2][4][2], const Unit& u, int wr, int wc, int fr, int fq) const {
        const int col0 = u.pn * BM + wc * 32 + 4 * fq;
#pragma unroll
        for (int ai = 0; ai < 2; ++ai)
#pragma unroll
            for (int m = 0; m < 4; ++m) { const int row = u.pm * BM + ai * HALF + wr * 64 + m * 16 + fr; const size_t off = (size_t)row * 1024 + col0;
                const float* gp = gate + (size_t)(row / rows_per_batch) * gstride + col0;
#pragma unroll
                for (int bj = 0; bj < 2; ++bj)
#pragma unroll
                    for (int n = 0; n < 2; ++n) { const f32x4 xv = *(const f32x4*)(X + off + bj * HALF + n * 16); const f32x4 gv = *(const f32x4*)(gp + bj * HALF + n * 16);
                        *(f32x4*)(out + off + bj * HALF + n * 16) = xv + gv * acc[ai][bj][m][n]; } }
    }
};

__device__ __forceinline__ float swiglu1(float g, float l) {
    g = fminf(g, 7.0f); l = fminf(fmaxf(l, -7.0f), 7.0f);
    return (l + 1.0f) * (g * __builtin_amdgcn_rcpf(1.0f + __expf(-1.702f * g)));
}
struct EpiSwiglu {
    static constexpr bool PERM = true, AFTER_DRAIN = false;
    const float* b1; bf16_t* O;
    __device__ __forceinline__ void operator()(const f32x4 (&acc)[2][2][4][2], const Unit& u, int wr, int wc, int fr, int fq) const {
        const int e = u.pn >> 3, pl = u.pn & 7, jc = wc * 32 + 8 * fq;
        const float* bg = b1 + (size_t)e * 2048 + 128 * pl + jc; const float* bl = bg + 1024;
        const f32x4 bg0 = *(const f32x4*)bg, bg1 = *(const f32x4*)(bg + 4), bl0 = *(const f32x4*)bl, bl1 = *(const f32x4*)(bl + 4);
        const int row0 = u.pm * BM + wr * 64 + fr;
#pragma unroll
        for (int ai = 0; ai < 2; ++ai)
#pragma unroll
            for (int m = 0; m < 4; ++m) {
                const f32x4 g0 = acc[ai][0][m][0] + bg0, g1 = acc[ai][0][m][1] + bg1, l0 = acc[ai][1][m][0] + bl0, l1 = acc[ai][1][m][1] + bl1;
                u32x4 w; w.x = cvt_pk_bf16(swiglu1(g0[0], l0[0]), swiglu1(g0[1], l0[1])); w.y = cvt_pk_bf16(swiglu1(g0[2], l0[2]), swiglu1(g0[3], l0[3]));
                w.z = cvt_pk_bf16(swiglu1(g1[0], l1[0]), swiglu1(g1[1], l1[1])); w.w = cvt_pk_bf16(swiglu1(g1[2], l1[2]), swiglu1(g1[3], l1[3]));
                *(u32x4*)(O + (size_t)(row0 + ai * HALF + m * 16) * 1024 + 128 * pl + jc) = w; }
    }
};

struct GroupedOrder {
    const PG8_LAS int* ts; int NT, G, c; const int* rowtok;
    __device__ __forceinline__ bool next(int i, Unit& u) const {
        const int total = __builtin_amdgcn_readfirstlane(ts[32]) * NT; const long L = (long)i * G + c; if (L >= total) return false;
        const int pm = (int)L / NT, pl = (int)L % NT; int e = 0;
#pragma unroll 1
        for (int j = 1; j < 32; ++j) e += (pm >= ts[j]) ? 1 : 0;
        u.pm = __builtin_amdgcn_readfirstlane(pm); u.pn = __builtin_amdgcn_readfirstlane(e * NT + pl); return true;
    }
    __device__ __forceinline__ void a_ready(const Unit&) const {}
    __device__ __forceinline__ void done(const Unit&) const {}
};
}
#define GAS __attribute__((address_space(1)))
#define LAS __attribute__((address_space(3)))
typedef unsigned short bf16;
typedef unsigned v4u __attribute__((ext_vector_type(4)));
typedef float f32x4 __attribute__((ext_vector_type(4)));
typedef short bf16x8 __attribute__((ext_vector_type(8)));
typedef GAS unsigned gu32;
typedef GAS unsigned long long gu64;
#define RLX_AGENT __ATOMIC_RELAXED, __HIP_MEMORY_SCOPE_AGENT
#define LDS_WAIT() asm volatile("s_waitcnt lgkmcnt(0)" ::: "memory")
#define VM_WAIT() asm volatile("s_waitcnt vmcnt(0)" ::: "memory")
__device__ __forceinline__ unsigned long long rt() { return __builtin_amdgcn_s_memrealtime(); }
__device__ __forceinline__ unsigned f2bf(float f) { unsigned u = __builtin_bit_cast(unsigned, f); return (u + 0x7fffu + ((u >> 16) & 1u)) >> 16; }
typedef float f32x2_pk __attribute__((ext_vector_type(2))); typedef __bf16 bf16x2_pk __attribute__((ext_vector_type(2)));
__device__ __forceinline__ unsigned pk2(float lo, float hi) { const f32x2_pk v = {lo, hi}; return __builtin_bit_cast(unsigned, __builtin_convertvector(v, bf16x2_pk)); }

#define XB_TMO      128
#define XB_XCNT(j)  (256  + 64 * (j))
#define XB_XSUB(j)  (1280 + 64 * (j))
#define XB_XGEN(j)  (2304 + 64 * (j))
#define XB_TOP      3328
#define XB_TOPGEN   3392
#define XCD_BAR_WORDS 3456
#define XB_SPIN_CAP (1u << 18)

__device__ __forceinline__ unsigned xb_ld(unsigned* p)              { return __hip_atomic_load(p, __ATOMIC_RELAXED, __HIP_MEMORY_SCOPE_AGENT); }
__device__ __forceinline__ unsigned xb_add(unsigned* p, unsigned v) { return __hip_atomic_fetch_add(p, v, __ATOMIC_RELAXED, __HIP_MEMORY_SCOPE_AGENT); }
__device__ __forceinline__ unsigned xb_xcc_id() { return (unsigned)__builtin_amdgcn_s_getreg((3 << 11) | 20) & 0xFu; }
#define XB_SPIN(cond, bar) do { unsigned _sp = 0; while (cond) { __builtin_amdgcn_s_sleep(1); \
    if ((++_sp & 255u) == 0u) { if (xb_ld(&(bar)[XB_TMO])) break; if (_sp > XB_SPIN_CAP) { atomicAdd(&(bar)[XB_TMO], 1u); break; } } } } while (0)

struct XcdBarrier {
    unsigned* bar; unsigned x;
    volatile LAS unsigned* st;
};

__device__ __forceinline__ XcdBarrier xcd_barrier_post(unsigned* bar, volatile LAS unsigned* st) {
    XcdBarrier b; b.bar = bar; b.x = xb_xcc_id(); b.st = st;
    if (threadIdx.x == 0) (void)xb_add(&bar[XB_XCNT(b.x)], 1u);
    return b;
}
__device__ __forceinline__ void xcd_barrier_complete(unsigned* bar, unsigned x, unsigned& nloc, unsigned& nx) {
    const unsigned G = gridDim.x * gridDim.y * gridDim.z;
    unsigned sum, cnt, mine, sp = 0u;
    for (;;) {
        sum = 0u; cnt = 0u; mine = 0u;
#pragma unroll
        for (unsigned j = 0; j < 16; ++j) { const unsigned c = xb_ld(&bar[XB_XCNT(j)]); sum += c; cnt += (c > 0u) ? 1u : 0u; mine = (j == x) ? c : mine; }
        if (sum == G) break;
        __builtin_amdgcn_s_sleep(1);
        if ((++sp & 255u) == 0u) { if (xb_ld(&bar[XB_TMO])) break; if (sp > XB_SPIN_CAP) { atomicAdd(&bar[XB_TMO], 1u); break; } }
    }
    nloc = mine > 0u ? mine : 1u; nx = cnt > 0u ? cnt : 1u;
}

__device__ __forceinline__ void xcd_barrier(const XcdBarrier& b) {
    asm volatile("s_waitcnt vmcnt(0)" ::: "memory");
    __syncthreads();
    if (threadIdx.x == 0) {
        unsigned* bar = b.bar;
        __builtin_amdgcn_s_waitcnt(0);
        unsigned nloc = b.st[0], nx = b.st[1];
        if (nloc == 0u) { xcd_barrier_complete(bar, b.x, nloc, nx); b.st[0] = nloc; b.st[1] = nx; }
        const unsigned old = xb_add(&bar[XB_XSUB(b.x)], 1u);
        const unsigned gen = old / nloc;
        if (old + 1u == (gen + 1u) * nloc) {
            __builtin_amdgcn_fence(__ATOMIC_RELEASE, "agent");
            asm volatile("s_waitcnt vmcnt(0)" ::: "memory");
            const unsigned og = xb_add(&bar[XB_TOP], 1u);
            const unsigned tg = og / nx;
            if (og + 1u == (tg + 1u) * nx) xb_add(&bar[XB_TOPGEN], 1u);
            else XB_SPIN(xb_ld(&bar[XB_TOPGEN]) == tg, bar);
            __builtin_amdgcn_fence(__ATOMIC_ACQUIRE, "agent");
            xb_add(&bar[XB_XGEN(b.x)], 1u);
            asm volatile("s_waitcnt vmcnt(0)" ::: "memory");
        } else {
            XB_SPIN(xb_ld(&bar[XB_XGEN(b.x)]) == gen, bar);
            __builtin_amdgcn_fence(__ATOMIC_ACQUIRE, "agent");
            asm volatile("s_waitcnt vmcnt(0)" ::: "memory");
        }
    }
    __syncthreads();
}

constexpr int NWAVES = 8;
constexpr int BATCH = 16, SEQ = 2048, D = 1024, T = BATCH * SEQ;
constexpr int NIN = 9224, NPROJ = 9216, NMOD = 6 * D;
constexpr int NE = 32, TOPK = 4;
constexpr int XS_ROWS = T * TOPK + NE * 256;
constexpr float EPS = 1e-6f;
constexpr float ATT_RTHR = -120.0f;
constexpr float QSCALE = 0.125f * 1.4426950408889634f;

constexpr size_t MiB = 1u << 20;
constexpr size_t WS_CTL = 0, CTL_ZERO_BYTES = 1 * MiB;
constexpr size_t WS_MODP = 1 * MiB;
constexpr size_t WS_MOD = 3 * MiB;
constexpr size_t WS_IPRE = 4 * MiB, WS_LF = 4 * MiB + 512 * 1024;
constexpr size_t WS_TOKE = 5 * MiB, WS_TOKP = 5 * MiB + 512 * 1024, WS_TOKW = 6 * MiB, WS_TOKROW = 6 * MiB + 512 * 1024, WS_RSTD = 7 * MiB;
constexpr size_t WS_WIN = 8 * MiB, WS_WA = 26 * MiB, WS_WB = 28 * MiB, WS_WOUT = 30 * MiB, WS_W1 = 32 * MiB, WS_W2 = 160 * MiB;
constexpr size_t WS_H1 = 224 * MiB;
constexpr size_t WS_PROJ = 288 * MiB, SEG = 64 * MiB;
constexpr size_t WS_YB = 864 * MiB;
constexpr size_t WS_XS = 288 * MiB, WS_ACT = 560 * MiB;
constexpr size_t WS_ROW2TOK = 7 * MiB + 128 * 1024;
constexpr size_t WS_GT = 928 * MiB;
constexpr size_t WS_END = 932 * MiB;
static_assert(WS_XS + (size_t)XS_ROWS * 2048 <= WS_ACT && WS_ACT + (size_t)XS_ROWS * 2048 <= WS_YB, "ws map");
constexpr int CW_TMO = 0, CW_BAR = 4096, CW_ECNT = 8192;

constexpr int RING_BYTES = 131072, LDS_BYTES = 147456, LDSCTL_OFF = 146432;
constexpr int LC_BAR = 0, LC_TS = 16, LC_LCNT = 64, LC_GBASE = 96, LC_PS = 128, LC_CNT = 160;

__device__ __forceinline__ unsigned long long karg(int i) { return ((const __attribute__((address_space(4))) unsigned long long*)__builtin_amdgcn_kernarg_segment_ptr())[i]; }
struct Frame {
    LAS unsigned char* lds; volatile LAS unsigned* LC;
    gu32* ctl; unsigned char* ws; int tid, lane, wave, vcu, G;
    __device__ __forceinline__ const float* x() const { return (const float*)(const GAS float*)karg(0); }
    __device__ __forceinline__ const float* c() const { return (const float*)(const GAS float*)karg(1); }
    __device__ __forceinline__ const float* ada_w() const { return (const float*)(const GAS float*)karg(2); }
    __device__ __forceinline__ const float* ada_b() const { return (const float*)(const GAS float*)karg(3); }
    __device__ __forceinline__ const float* norm1_g() const { return (const float*)(const GAS float*)karg(4); }
    __device__ __forceinline__ const float* w_in() const { return (const float*)(const GAS float*)karg(5); }
    __device__ __forceinline__ const float* conv_w() const { return (const float*)(const GAS float*)karg(6); }
    __device__ __forceinline__ const float* conv_b() const { return (const float*)(const GAS float*)karg(7); }
    __device__ __forceinline__ const float* b_i() const { return (const float*)(const GAS float*)karg(8); }
    __device__ __forceinline__ const float* b_f() const { return (const float*)(const GAS float*)karg(9); }
    __device__ __forceinline__ const float* ml_norm_g() const { return (const float*)(const GAS float*)karg(10); }
    __device__ __forceinline__ const float* w_a() const { return (const float*)(const GAS float*)karg(11); }
    __device__ __forceinline__ const float* w_b() const { return (const float*)(const GAS float*)karg(12); }
    __device__ __forceinline__ const float* w_out() const { return (const float*)(const GAS float*)karg(13); }
    __device__ __forceinline__ const float* norm2_g() const { return (const float*)(const GAS float*)karg(14); }
    __device__ __forceinline__ const float* router_w() const { return (const float*)(const GAS float*)karg(15); }
    __device__ __forceinline__ const float* router_b() const { return (const float*)(const GAS float*)karg(16); }
    __device__ __forceinline__ const float* w1() const { return (const float*)(const GAS float*)karg(17); }
    __device__ __forceinline__ const float* b1() const { return (const float*)(const GAS float*)karg(18); }
    __device__ __forceinline__ const float* w2() const { return (const float*)(const GAS float*)karg(19); }
    __device__ __forceinline__ const float* b2() const { return (const float*)(const GAS float*)karg(20); }
    __device__ __forceinline__ const float* final_g() const { return (const float*)(const GAS float*)karg(21); }
    __device__ __forceinline__ float* out() const { return (float*)(GAS float*)karg(22); }
    __device__ __forceinline__ float* modp() const { return (float*)(ws + WS_MODP); }
    __device__ __forceinline__ float* mod() const { return (float*)(ws + WS_MOD); }
    __device__ __forceinline__ float* ipre() const { return (float*)(ws + WS_IPRE); }
    __device__ __forceinline__ float* lf() const { return (float*)(ws + WS_LF); }
    __device__ __forceinline__ float* tokw() const { return (float*)(ws + WS_TOKW); }
    __device__ __forceinline__ float* rstd2() const { return (float*)(ws + WS_RSTD); }
    __device__ __forceinline__ int* toke() const { return (int*)(ws + WS_TOKE); }
    __device__ __forceinline__ int* tokp() const { return (int*)(ws + WS_TOKP); }
    __device__ __forceinline__ int* tokrow() const { return (int*)(ws + WS_TOKROW); }
    __device__ __forceinline__ bf16* WIN_T() const { return (bf16*)(ws + WS_WIN); }
    __device__ __forceinline__ bf16* WA_T() const { return (bf16*)(ws + WS_WA); }
    __device__ __forceinline__ bf16* WB_T() const { return (bf16*)(ws + WS_WB); }
    __device__ __forceinline__ bf16* WOUT_T() const { return (bf16*)(ws + WS_WOUT); }
    __device__ __forceinline__ bf16* W1_T() const { return (bf16*)(ws + WS_W1); }
    __device__ __forceinline__ bf16* W2_T() const { return (bf16*)(ws + WS_W2); }
    __device__ __forceinline__ bf16* H1() const { return (bf16*)(ws + WS_H1); }
    __device__ __forceinline__ bf16* PROJ() const { return (bf16*)(ws + WS_PROJ); }
    __device__ __forceinline__ bf16* YA() const { return (bf16*)(ws + WS_H1); }
    __device__ __forceinline__ bf16* YB() const { return (bf16*)(ws + WS_YB); }
    __device__ __forceinline__ bf16* M1() const { return (bf16*)(ws + WS_PROJ); }
    __device__ __forceinline__ bf16* MERGED() const { return (bf16*)(ws + WS_PROJ + SEG); }
    __device__ __forceinline__ bf16* XS() const { return (bf16*)(ws + WS_XS); }
    __device__ __forceinline__ bf16* ACT() const { return (bf16*)(ws + WS_ACT); }
    __device__ __forceinline__ bf16* OUTR() const { return (bf16*)(ws + WS_XS); }
    __device__ __forceinline__ bf16* H2() const { return (bf16*)(ws + WS_XS); }
    __device__ __forceinline__ int* row2tok() const { return (int*)(ws + WS_ROW2TOK); }
    __device__ __forceinline__ float* gt() const { return (float*)(ws + WS_GT); }
};

__device__ __forceinline__ int opq(int v) { asm volatile("" : "+v"(v)); return v; }
__device__ __forceinline__ float wave_sum(float v) {
#pragma unroll
    for (int o = 1; o < 64; o <<= 1) v += __shfl_xor(v, o);
    return v;
}
__device__ __forceinline__ float bf2f(unsigned short b) { return __builtin_bit_cast(float, (unsigned)b << 16); }
__device__ __forceinline__ float bflo(unsigned w) { return __builtin_bit_cast(float, w << 16); }
__device__ __forceinline__ float bfhi(unsigned w) { return __builtin_bit_cast(float, w & 0xffff0000u); }
__device__ __forceinline__ float log_sigmoid_f(float x) { return fminf(x, 0.f) - log1pf(expf(-fabsf(x))); }

struct MapIn { __device__ __forceinline__ long operator()(int n) const { return n < 7168 ? (long)n : (n < 7176 ? -1L : (n < NIN ? (long)(n - 8) : -1L)); } };
struct MapId { long off; __device__ __forceinline__ long operator()(int n) const { return off + n; } };
struct MapW1 { int e; __device__ __forceinline__ long operator()(int n) const { return (long)e * 2048 + ((n & 1023) >> 7) * 256 + (n >> 10) * 128 + (n & 127); } };

template <class Map> __device__ __forceinline__ void transpose_item(const float* W, int K, int N, bf16* WT, LAS float* scr, int item, int lane, Map map) {
    const int nblk = (N + 31) / 32, kb = item / nblk, nb = item % nblk, k0 = 64 * kb, n0 = 32 * nb;
    const int n4 = 4 * (lane & 7), kr = lane >> 3;
    const bool ok = (n0 + n4 + 3) < N;
    f32x4 v[8];
#pragma unroll
    for (int i = 0; i < 8; ++i) v[i] = ok ? *(const f32x4*)(W + (size_t)(k0 + 8 * i + kr) * N + n0 + n4) : (f32x4){0.f, 0.f, 0.f, 0.f};
#pragma unroll
    for (int i = 0; i < 8; ++i) { LAS float* d = scr + (8 * i + kr) * 33 + n4; d[0] = v[i].x; d[1] = v[i].y; d[2] = v[i].z; d[3] = v[i].w; }
    LDS_WAIT(); asm volatile("" ::: "memory");
    const int c = lane & 7;
#pragma unroll
    for (int j = 0; j < 4; ++j) { const int n = (lane >> 3) + 8 * j; const LAS float* s = scr + (8 * c) * 33 + n;
        v4u o; o.x = pk2(s[0 * 33], s[1 * 33]); o.y = pk2(s[2 * 33], s[3 * 33]); o.z = pk2(s[4 * 33], s[5 * 33]); o.w = pk2(s[6 * 33], s[7 * 33]);
        const long dr = map(n0 + n);
        if (dr >= 0) *(GAS v4u*)(WT + (size_t)dr * K + k0 + 8 * c) = o; }
    LDS_WAIT(); asm volatile("" ::: "memory");
}
__device__ __forceinline__ void mod_item(Frame& F, const LAS float* sil, int it) {
    const int j = it % 96, kq = it / 96, n = 64 * j + F.lane, k0 = 256 * kq;
    float acc[16];
#pragma unroll
    for (int b = 0; b < 16; ++b) acc[b] = 0.f;
    const float* w = F.ada_w() + (size_t)k0 * NMOD + n;
    const LAS f32x4* s = (const LAS f32x4*)sil + k0 * 4;
    for (int kk = 0; kk < 256; kk += 8) {
        float wv[8];
#pragma unroll
        for (int u = 0; u < 8; ++u) wv[u] = w[(size_t)(kk + u) * NMOD];
#pragma unroll
        for (int u = 0; u < 8; ++u) {
#pragma unroll
            for (int q = 0; q < 4; ++q) { const f32x4 sv = s[(kk + u) * 4 + q]; acc[4 * q + 0] += sv.x * wv[u]; acc[4 * q + 1] += sv.y * wv[u]; acc[4 * q + 2] += sv.z * wv[u]; acc[4 * q + 3] += sv.w * wv[u]; }
        }
    }
    float* o = F.modp() + (size_t)kq * 16 * NMOD + n;
#pragma unroll
    for (int b = 0; b < 16; ++b) o[(size_t)b * NMOD] = acc[b];
}
__device__ __forceinline__ void p0_prologue(Frame& F) {
    LAS float* sil = (LAS float*)F.lds;
    for (int idx = F.tid; idx < 16384; idx += 512) { const int b = idx >> 10, k = idx & 1023; const float v = F.c()[idx]; sil[k * 16 + b] = v / (1.0f + __expf(-v)); }
    __syncthreads();
    LAS float* scr = (LAS float*)(F.lds + 65536 + F.wave * 8704);
    const int gw = F.vcu * NWAVES + F.wave, NGW = F.G * NWAVES;
    constexpr int I_MOD = 384, I_IN = 16 * 289, I_SQ = 16 * 32, I_W1 = 32 * 16 * 64, I_W2 = 32 * 16 * 32;
    constexpr int NITEMS = I_MOD + I_IN + 3 * I_SQ + I_W1 + I_W2;
    for (int it = gw; it < NITEMS; it += NGW) {
        int r = it;
        if (r < I_MOD) { mod_item(F, sil, r); continue; } r -= I_MOD;
        if (r < I_IN) { transpose_item(F.w_in(), D, NIN, F.WIN_T(), scr, r, F.lane, MapIn{}); continue; } r -= I_IN;
        if (r < I_SQ) { transpose_item(F.w_a(), D, D, F.WA_T(), scr, r, F.lane, MapId{0}); continue; } r -= I_SQ;
        if (r < I_SQ) { transpose_item(F.w_b(), D, D, F.WB_T(), scr, r, F.lane, MapId{0}); continue; } r -= I_SQ;
        if (r < I_SQ) { transpose_item(F.w_out(), D, D, F.WOUT_T(), scr, r, F.lane, MapId{0}); continue; } r -= I_SQ;
        if (r < I_W1) { const int e = r >> 10; transpose_item(F.w1() + (size_t)e * D * 2048, D, 2048, F.W1_T(), scr, r & 1023, F.lane, MapW1{e}); continue; } r -= I_W1;
        { const int e = r >> 9; transpose_item(F.w2() + (size_t)e * D * D, D, D, F.W2_T(), scr, r & 511, F.lane, MapId{(long)e * 1024}); }
    }
}

__device__ __forceinline__ void p1_rows(Frame& F) {
    const int row0 = F.vcu * 128, b = row0 / SEQ, lane = opq(F.lane);
    LAS float* wif = (LAS float*)F.lds;
    for (int idx = F.tid; idx < 8192; idx += 512) wif[idx] = F.w_in()[(size_t)(idx >> 3) * NIN + 7168 + (idx & 7)];
    for (int idx = F.vcu * 512 + F.tid; idx < 16 * NMOD; idx += F.G * 512) { float s = F.ada_b()[idx % NMOD];
#pragma unroll
        for (int kq = 0; kq < 4; ++kq) s += F.modp()[(size_t)kq * 16 * NMOD + idx];
        F.mod()[idx] = s; }
    f32x4 Av[4], Bv[4];
#pragma unroll
    for (int j = 0; j < 4; ++j) { const int col = 4 * lane + 256 * j;
        f32x4 sh = *(const f32x4*)(F.ada_b() + col), sc = *(const f32x4*)(F.ada_b() + D + col);
#pragma unroll
        for (int kq = 0; kq < 4; ++kq) { sh += *(const f32x4*)(F.modp() + ((size_t)kq * 16 + b) * NMOD + col); sc += *(const f32x4*)(F.modp() + ((size_t)kq * 16 + b) * NMOD + D + col); }
        const f32x4 g = *(const f32x4*)(F.norm1_g() + col); Av[j] = g * (sc + 1.0f); Bv[j] = sh; }
    __syncthreads();
    f32x4 nx[4];
    { const GAS f32x4* xr = (const GAS f32x4*)(F.x() + (size_t)(row0 + 16 * F.wave) * D) + lane;
#pragma unroll
      for (int j = 0; j < 4; ++j) nx[j] = xr[64 * j]; }
    for (int r = 0; r < 16; ++r) {
        const int row = row0 + 16 * F.wave + r;
        f32x4 v[4]; float ss = 0.f;
#pragma unroll
        for (int j = 0; j < 4; ++j) { v[j] = nx[j]; ss += (v[j].x * v[j].x + v[j].y * v[j].y) + (v[j].z * v[j].z + v[j].w * v[j].w); }
        if (r < 15) { const GAS f32x4* xr = (const GAS f32x4*)(F.x() + (size_t)(row + 1) * D) + lane;
#pragma unroll
            for (int j = 0; j < 4; ++j) nx[j] = xr[64 * j]; }
        const float rstd = 1.0f / sqrtf(wave_sum(ss) * (1.0f / D) + EPS);
        GAS unsigned long long* o8 = (GAS unsigned long long*)(F.H1() + (size_t)row * D) + lane;
        float p[8];
#pragma unroll
        for (int q = 0; q < 8; ++q) p[q] = 0.f;
#pragma unroll
        for (int j = 0; j < 4; ++j) { v[j] = v[j] * rstd * Av[j] + Bv[j];
            o8[64 * j] = (unsigned long long)pk2(v[j].x, v[j].y) | ((unsigned long long)pk2(v[j].z, v[j].w) << 32);
#pragma unroll
            for (int i = 0; i < 4; ++i) { const LAS f32x4* wp = (const LAS f32x4*)(wif + (4 * lane + 256 * j + i) * 8); const f32x4 w0 = wp[0], w1 = wp[1]; const float hv = v[j][i];
                p[0] += hv * w0.x; p[1] += hv * w0.y; p[2] += hv * w0.z; p[3] += hv * w0.w; p[4] += hv * w1.x; p[5] += hv * w1.y; p[6] += hv * w1.z; p[7] += hv * w1.w; } }
#pragma unroll
        for (int q = 0; q < 8; ++q) p[q] = wave_sum(p[q]);
        if (lane == 0) { const int t = row % SEQ;
#pragma unroll
            for (int hh = 0; hh < 4; ++hh) { F.ipre()[((size_t)b * 4 + hh) * SEQ + t] = p[hh] + F.b_i()[hh]; F.lf()[((size_t)b * 4 + hh) * SEQ + t] = log_sigmoid_f(p[4 + hh] + F.b_f()[hh]); } }
    }
}

__device__ __forceinline__ void attn_naive_item(Frame& F, int bh, int qblk) {
    const int b = bh >> 4, hd = bh & 15, t = qblk * 512 + F.tid;
    const bf16* Q = F.PROJ(); const bf16* K = F.PROJ() + SEG / 2; const bf16* V = F.PROJ() + SEG;
    const size_t rowb = (size_t)b * SEQ;
    float q[64], o[64];
    { const v4u* qp = (const v4u*)(Q + (rowb + t) * D + hd * 64);
#pragma unroll
      for (int i = 0; i < 8; ++i) { const v4u w = qp[i]; q[8 * i + 0] = bflo(w.x); q[8 * i + 1] = bfhi(w.x); q[8 * i + 2] = bflo(w.y); q[8 * i + 3] = bfhi(w.y); q[8 * i + 4] = bflo(w.z); q[8 * i + 5] = bfhi(w.z); q[8 * i + 6] = bflo(w.w); q[8 * i + 7] = bfhi(w.w); } }
#pragma unroll
    for (int i = 0; i < 64; ++i) o[i] = 0.f;
    float R = 0.f;
    LAS v4u* kt = (LAS v4u*)F.lds; LAS v4u* vt = (LAS v4u*)(F.lds + 8192);
    const int tmax_wave = qblk * 512 + F.wave * 64 + 63;
    bool wdone = false;
    LAS volatile int* dflag = (LAS volatile int*)(F.lds + 16384);
    if (F.tid < 8) dflag[F.tid] = 0;
    for (int tile = qblk * 8 + 7; tile >= 0; --tile) {
        __syncthreads();
        { int nd = 0;
#pragma unroll
          for (int w = 0; w < 8; ++w) nd += dflag[w];
          if (nd == 8) break; }
        { const int kr = F.tid >> 3, ch = F.tid & 7; const size_t g = (rowb + tile * 64 + kr) * D + hd * 64 + ch * 8;
          kt[F.tid] = *(const v4u*)(K + g); vt[F.tid] = *(const v4u*)(V + g); }
        __syncthreads();
        if (tile * 64 >= tmax_wave) continue;
        if (wdone) continue;
        for (int s = 63; s >= 0; --s) {
            const int key = tile * 64 + s;
            float z = 0.f;
#pragma unroll
            for (int i = 0; i < 8; ++i) { const v4u w = kt[s * 8 + i]; z += q[8 * i + 0] * bflo(w.x) + q[8 * i + 1] * bfhi(w.x) + q[8 * i + 2] * bflo(w.y) + q[8 * i + 3] * bfhi(w.y) + q[8 * i + 4] * bflo(w.z) + q[8 * i + 5] * bfhi(w.z) + q[8 * i + 6] * bflo(w.w) + q[8 * i + 7] * bfhi(w.w); }
            const float lb = fminf(z, 0.f) - __builtin_amdgcn_logf(1.0f + __builtin_amdgcn_exp2f(-fabsf(z)));
            const bool act = key < t;
            const float a = act ? __builtin_amdgcn_exp2f(lb + R) : 0.f;
            R += act ? (lb - z) : 0.f;
#pragma unroll
            for (int i = 0; i < 8; ++i) { const v4u w = vt[s * 8 + i]; o[8 * i + 0] += a * bflo(w.x); o[8 * i + 1] += a * bfhi(w.x); o[8 * i + 2] += a * bflo(w.y); o[8 * i + 3] += a * bfhi(w.y); o[8 * i + 4] += a * bflo(w.z); o[8 * i + 5] += a * bfhi(w.z); o[8 * i + 6] += a * bflo(w.w); o[8 * i + 7] += a * bfhi(w.w); }
        }
        if (__all(R < ATT_RTHR) && !wdone) { wdone = true; if (F.lane == 0) dflag[F.wave] = 1; }
    }
    __syncthreads();
    v4u* op = (v4u*)(F.YA() + (rowb + t) * D + hd * 64);
#pragma unroll
    for (int i = 0; i < 8; ++i) { v4u w; w.x = pk2(o[8 * i + 0], o[8 * i + 1]); w.y = pk2(o[8 * i + 2], o[8 * i + 3]); w.z = pk2(o[8 * i + 4], o[8 * i + 5]); w.w = pk2(o[8 * i + 6], o[8 * i + 7]); op[i] = w; }
}

__device__ __forceinline__ void mlstm_naive_item(Frame& F, int bh) {
    const int b = bh >> 2, hh = bh & 3, tid = opq(F.tid), e = tid & 255, half = tid >> 8;
    const bf16* MLQ = F.PROJ() + 3 * (SEG / 2); const bf16* MLK = F.PROJ() + 4 * (SEG / 2); const bf16* MLV = F.PROJ() + 5 * (SEG / 2); const bf16* MLO = F.PROJ() + 6 * (SEG / 2);
    LAS float* ql = (LAS float*)F.lds; LAS float* kl = ql + 8192; LAS float* vl = kl + 8192; LAS float* hl = vl + 8192;
    LAS float* part = hl + 8192;
    LAS float* red = part + 512;
    LAS float* il = red + 8; LAS float* fl = il + 32;
    const size_t rowb = (size_t)b * SEQ;
    float C[128];
#pragma unroll
    for (int i = 0; i < 128; ++i) C[i] = 0.f;
    float nreg = 0.f, m = 0.f;
    float cw[2][4], cb[2];
    { const int c = tid & 255;
#pragma unroll
      for (int z = 0; z < 2; ++z) { const int ch = z * 1024 + hh * 256 + c; cb[z] = F.conv_b()[ch];
#pragma unroll
          for (int tap = 0; tap < 4; ++tap) cw[z][tap] = F.conv_w()[tap * 2048 + ch]; } }
    for (int chunk = 0; chunk < SEQ / 32; ++chunk) {
        const int t0 = chunk * 32;
        __syncthreads();
        { const int c = tid & 255;
          for (int u = 0; u < 16; ++u) { const int tt = (tid >> 8) + 2 * u, t = t0 + tt; float yq = cb[0], yk = cb[1];
#pragma unroll
              for (int tap = 0; tap < 4; ++tap) { const int ts = t - 3 + tap; if (ts >= 0) { const size_t g = (rowb + ts) * D + hh * 256 + c; yq += cw[0][tap] * bf2f(MLQ[g]); yk += cw[1][tap] * bf2f(MLK[g]); } }
              ql[tt * 256 + c] = yq / (1.0f + __expf(-yq)); kl[tt * 256 + c] = (yk / (1.0f + __expf(-yk))) * 0.0625f;
              vl[tt * 256 + c] = bf2f(MLV[(rowb + t) * D + hh * 256 + c]); }
          if (tid < 32) { il[tid] = F.ipre()[((size_t)b * 4 + hh) * SEQ + t0 + tid]; fl[tid] = F.lf()[((size_t)b * 4 + hh) * SEQ + t0 + tid]; } }
        __syncthreads();
        for (int tt = 0; tt < 32; ++tt) {
            const float lfv = fl[tt], iv = il[tt];
            const float mn = fmaxf(lfv + m, iv), fp = __expf(lfv + m - mn), ip = __expf(iv - mn); m = mn;
            const float vv = vl[tt * 256 + e] * ip;
            const LAS f32x4* kq = (const LAS f32x4*)(kl + tt * 256 + 128 * half); const LAS f32x4* qq = (const LAS f32x4*)(ql + tt * 256 + 128 * half);
            float num = 0.f;
#pragma unroll
            for (int i = 0; i < 32; ++i) { const f32x4 kv = kq[i], qv = qq[i];
                C[4 * i + 0] = fp * C[4 * i + 0] + kv.x * vv; C[4 * i + 1] = fp * C[4 * i + 1] + kv.y * vv; C[4 * i + 2] = fp * C[4 * i + 2] + kv.z * vv; C[4 * i + 3] = fp * C[4 * i + 3] + kv.w * vv;
                num += (qv.x * C[4 * i + 0] + qv.y * C[4 * i + 1]) + (qv.z * C[4 * i + 2] + qv.w * C[4 * i + 3]); }
            const int buf = tt & 1;
            if (tid < 256) { nreg = fp * nreg + ip * kl[tt * 256 + tid]; const float pd = wave_sum(ql[tt * 256 + tid] * nreg); if (F.lane == 0) red[buf * 4 + F.wave] = pd; }
            else part[buf * 256 + e] = num;
            __syncthreads();
            if (tid < 256) { num += part[buf * 256 + e]; const float den = (red[buf * 4 + 0] + red[buf * 4 + 1]) + (red[buf * 4 + 2] + red[buf * 4 + 3]);
                hl[tt * 256 + e] = num / fmaxf(fabsf(den), __expf(-m)); }
        }
        __syncthreads();
        for (int r = 0; r < 4; ++r) { const int tt = 4 * F.wave + r; const size_t row = rowb + t0 + tt;
            const f32x4 hv = *(const LAS f32x4*)(hl + tt * 256 + 4 * F.lane);
            const float ss = wave_sum((hv.x * hv.x + hv.y * hv.y) + (hv.z * hv.z + hv.w * hv.w));
            const float rstd = 1.0f / sqrtf(ss * (1.0f / 256.0f) + EPS);
            const int col = hh * 256 + 4 * F.lane; const f32x4 g = *(const f32x4*)(F.ml_norm_g() + col);
            const unsigned long long ow = *(const unsigned long long*)(MLO + row * D + col);
            const float o0 = bflo((unsigned)ow), o1 = bfhi((unsigned)ow), o2 = bflo((unsigned)(ow >> 32)), o3 = bfhi((unsigned)(ow >> 32));
            const float y0 = hv.x * rstd * g.x / (1.0f + __expf(-o0)), y1 = hv.y * rstd * g.y / (1.0f + __expf(-o1)), y2 = hv.z * rstd * g.z / (1.0f + __expf(-o2)), y3 = hv.w * rstd * g.w / (1.0f + __expf(-o3));
            *(unsigned long long*)(F.YB() + row * D + col) = (unsigned long long)pk2(y0, y1) | ((unsigned long long)pk2(y2, y3) << 32); }
    }
}


namespace ml {
typedef short bf16x8 __attribute__((ext_vector_type(8)));
typedef short s16x4 __attribute__((ext_vector_type(4)));
typedef float f32x16 __attribute__((ext_vector_type(16)));
typedef LAS const char* lcp;
typedef LAS char* lp_t;
constexpr int L = 64;
constexpr int O_QI = 0, O_KI = 33792, O_CB = 67584, O_VI = 102400, O_VW = 111616, O_PI = 120832, O_F = 130048;
constexpr int F_NV = 0, F_QNP = 256, F_RSP = 768, F_AT = 896, F_US = 960, F_WIN = 1024, F_EDEN = 1088, F_WST = 1152, F_RDEN = 1216, F_CW = 1280, F_CBIAS = 3328;
__device__ __forceinline__ int crow(int r, int hi) { return (r & 3) + 8 * (r >> 2) + 4 * hi; }
template <int PITCH, int XM> __device__ __forceinline__ int ioff(int row, int ch) { return XM ? PITCH * row + 16 * (ch ^ (row & XM)) : PITCH * row + 16 * ch; }
template <int PITCH, int XM> __device__ __forceinline__ bf16x8 frag_row(lcp img, int row0, int s, int lane) {
    return *(LAS const bf16x8*)(img + ioff<PITCH, XM>(row0 + (lane & 31), 2 * s + (lane >> 5)));
}
template <int PITCH, int XM> __device__ __forceinline__ bf16x8 frag_tr(lcp img, int k0, int ks, int col0, int lane) {
    const int h = lane >> 5, blk = (lane >> 4) & 1, q = (lane & 15) >> 2, p = lane & 3;
    const int r0 = k0 + 16 * ks + 8 * h + q, ch = (col0 >> 3) + 2 * blk + (p >> 1);
    typedef short v4i16_t __attribute__((ext_vector_type(4)));
    const s16x4 a = __builtin_bit_cast(s16x4, __builtin_amdgcn_ds_read_tr16_b64_v4i16((LAS v4i16_t*)(img + ioff<PITCH, XM>(r0, ch) + 8 * (p & 1))));
    const s16x4 b = __builtin_bit_cast(s16x4, __builtin_amdgcn_ds_read_tr16_b64_v4i16((LAS v4i16_t*)(img + ioff<PITCH, XM>(r0 + 4, ch) + 8 * (p & 1))));
    return (bf16x8){a[0], a[1], a[2], a[3], b[0], b[1], b[2], b[3]};
}
__device__ __forceinline__ float half_sum(float v) {
    const auto rr = __builtin_amdgcn_permlane32_swap(__builtin_bit_cast(unsigned, v), __builtin_bit_cast(unsigned, v), false, false);
    return __builtin_bit_cast(float, rr[0]) + __builtin_bit_cast(float, rr[1]);
}
__device__ __forceinline__ float silu_f(float y) { return y * __builtin_amdgcn_rcpf(1.0f + __expf(-y)); }

__device__ __forceinline__ void mlstm_unit(Frame& F, int unit) {
    const int bh = unit >> 2, sl = unit & 3, b = bh >> 2, hh = bh & 3, tid = opq(F.tid), lane = opq(F.lane), wave = F.wave, hi = lane >> 5, l31 = lane & 31;
    const bf16* MLQ = (const bf16*)F.out(); const bf16* MLK = MLQ + (size_t)T * D; const bf16* MLV = F.PROJ() + 5 * (SEG / 2);
    lp_t base = (lp_t)F.lds;
    LAS float* Fa = (LAS float*)(base + O_F);
    const size_t rowb = (size_t)b * SEQ;
    const float LOG2E = 1.4426950408889634f;
    __syncthreads();
    for (int i = tid; i < 34816 / 16; i += 512) ((LAS v4u*)(base + O_CB))[i] = (v4u){0u, 0u, 0u, 0u};
    if (tid < 256) Fa[F_NV + tid] = 0.f;
    f32x16 C0, C1, C2;
#pragma unroll
    for (int r = 0; r < 16; ++r) { C0[r] = 0.f; C1[r] = 0.f; C2[r] = 0.f; }
    if (tid < 64) *(LAS v4u*)(base + O_VW + 144 * tid + 128) = (v4u){0u, 0u, 0u, 0u};
    const int cg = tid & 31, rb = tid >> 5;
    v4u rawq[2][4], rawk[2][4], rawv[2]; float g_bb[2], g_us[2], g_pm[2]; float m_prev = 0.f;
#define ML_PREFETCH(T0, P) do { const int t0_ = (T0); \
        _Pragma("unroll") for (int i = 0; i < 4; ++i) { const unsigned g_ = (unsigned)(((int)rowb + t0_ + 4 * rb + i) * D + hh * 256 + cg * 8); \
            rawq[P][i] = *(const v4u*)(MLQ + g_); rawk[P][i] = *(const v4u*)(MLK + g_); } \
        rawv[P] = *(const v4u*)(MLV + (unsigned)(((int)rowb + t0_ + (tid >> 3)) * D + hh * 256 + 64 * sl + (tid & 7) * 8)); \
        { const float* gt_ = F.gt() + (unsigned)(((bh * (SEQ / L) + t0_ / L) * 3) * 64 + lane); g_bb[P] = gt_[0]; g_us[P] = gt_[64]; g_pm[P] = gt_[128]; } } while (0)
    ML_PREFETCH(0, 0); ML_PREFETCH(L, 1);
    __syncthreads();
    for (int chunk2 = 0; chunk2 < SEQ / L; chunk2 += 2) {
#pragma unroll
      for (int par = 0; par < 2; ++par) {
        const int chunk = chunk2 + par, t0 = chunk * L;
        const int tid = opq(F.tid), lane = tid & 63, hi = lane >> 5, l31 = lane & 31, cg = tid & 31, rb = tid >> 5, lo = lane;
        const float u = g_us[par], mm = g_bb[par] + fmaxf(m_prev, g_pm[par]), winter = __builtin_amdgcn_exp2f(g_bb[par] + m_prev - mm), at = g_bb[par] - mm, eden = __builtin_amdgcn_exp2f(-mm);
        const float bb63 = __builtin_bit_cast(float, __builtin_amdgcn_readlane(__builtin_bit_cast(int, g_bb[par]), 63)), mnew = __builtin_bit_cast(float, __builtin_amdgcn_readlane(__builtin_bit_cast(int, mm), 63));
        const float decay = __builtin_amdgcn_exp2f(bb63 + m_prev - mnew), wstate = __builtin_amdgcn_exp2f(bb63 - mnew + u); m_prev = mnew;
        if (wave == 0) { Fa[F_AT + lane] = at; Fa[F_US + lane] = u; Fa[F_WIN + lane] = winter; Fa[F_EDEN + lane] = eden; Fa[F_WST + lane] = wstate; }
#pragma unroll
        for (int j = 0; j < 4; ++j) { *(LAS v4u*)(base + O_QI + ioff<528, 0>(4 * rb + j, cg)) = rawq[par][j]; *(LAS v4u*)(base + O_KI + ioff<528, 0>(4 * rb + j, cg)) = rawk[par][j]; }
        { const int s = tid >> 3, ch = tid & 7; const v4u w = rawv[par];
          *(LAS v4u*)(base + O_VI + ioff<144, 0>(s, ch)) = w;
          const float ws = __shfl(wstate, s);
          v4u o; o.x = pk2(bflo(w.x) * ws, bfhi(w.x) * ws); o.y = pk2(bflo(w.y) * ws, bfhi(w.y) * ws); o.z = pk2(bflo(w.z) * ws, bfhi(w.z) * ws); o.w = pk2(bflo(w.w) * ws, bfhi(w.w) * ws);
          *(LAS v4u*)(base + O_VW + ioff<144, 0>(s, ch)) = o;
          if (ch == 0) *(LAS unsigned short*)(base + O_VW + 144 * s + 128) = (unsigned short)pk2(ws, 0.f); }
        __syncthreads();
        if (chunk + 2 < SEQ / L) ML_PREFETCH(t0 + 2 * L, par);
        __builtin_amdgcn_sched_barrier(0);
        f32x16 acc;
#pragma unroll
        for (int r = 0; r < 16; ++r) acc[r] = 0.f;
        const int wq = wave & 3, ta = wq >> 1, tb = wq & 1;
        if (wave < 4) {
#pragma unroll
            for (int kh = 0; kh < 2; ++kh) { bf16x8 fa[8], fb[8];
#pragma unroll
                for (int ks = 0; ks < 8; ++ks) { fa[ks] = frag_row<528, 0>(base + O_KI, 32 * tb, 8 * kh + ks, lo); fb[ks] = frag_row<528, 0>(base + O_QI, 32 * ta, 8 * kh + ks, lo); }
                __builtin_amdgcn_sched_barrier(0);
#pragma unroll
                for (int ks = 0; ks < 8; ++ks) acc = __builtin_amdgcn_mfma_f32_32x32x16_bf16(fa[ks], fb[ks], acc, 0, 0, 0);
                __builtin_amdgcn_sched_barrier(0); }
            const float at_l = __shfl(at, 32 * ta + l31); const int t = 32 * ta + l31; float rsum = 0.f;
#pragma unroll
            for (int g = 0; g < 4; ++g) { const int s0 = 32 * tb + 8 * g + 4 * hi; const f32x4 us4 = *(LAS const f32x4*)(Fa + F_US + s0); float p[4];
#pragma unroll
                for (int i = 0; i < 4; ++i) { p[i] = (s0 + i <= t) ? acc[4 * g + i] * __builtin_amdgcn_exp2f(at_l + us4[i]) : 0.f; rsum += p[i]; }
                *(LAS unsigned long long*)(base + O_PI + ioff<144, 0>(t, s0 >> 3) + 2 * (s0 & 7)) = (unsigned long long)pk2(p[0], p[1]) | ((unsigned long long)pk2(p[2], p[3]) << 32); }
            rsum = half_sum(rsum);
            if (hi == 0) Fa[F_RSP + tb * 64 + t] = rsum;
        } else {
#pragma unroll
            for (int kh = 0; kh < 2; ++kh) { bf16x8 fa[8], fb[8];
#pragma unroll
                for (int ks = 0; ks < 8; ++ks) { fa[ks] = frag_row<528, 0>(base + O_QI, 32 * ta, 8 * kh + ks, lo); fb[ks] = frag_tr<136, 0>(base + O_CB, 0, 8 * kh + ks, 32 * tb, lo); }
                __builtin_amdgcn_sched_barrier(0);
#pragma unroll
                for (int ks = 0; ks < 8; ++ks) acc = __builtin_amdgcn_mfma_f32_32x32x16_bf16(fa[ks], fb[ks], acc, 0, 0, 0);
                __builtin_amdgcn_sched_barrier(0); }
        }
        { float s = 0.f;
#pragma unroll
          for (int c = 0; c < 4; ++c) { const v4u w = *(LAS const v4u*)(base + O_QI + ioff<528, 0>(lane, 4 * wave + c)); const f32x4 n0 = *(LAS const f32x4*)(Fa + F_NV + 32 * wave + 8 * c), n1 = *(LAS const f32x4*)(Fa + F_NV + 32 * wave + 8 * c + 4);
              s += bflo(w.x) * n0.x + bfhi(w.x) * n0.y + bflo(w.y) * n0.z + bfhi(w.y) * n0.w + bflo(w.z) * n1.x + bfhi(w.z) * n1.y + bflo(w.w) * n1.z + bfhi(w.w) * n1.w; }
          Fa[F_QNP + wave * 64 + lane] = s; }
        __syncthreads();
        if (wave >= 4) {
            { const int t = 32 * ta + l31;
              const float den = Fa[F_WIN + t] * (((Fa[F_QNP + t] + Fa[F_QNP + 64 + t]) + (Fa[F_QNP + 128 + t] + Fa[F_QNP + 192 + t])) + ((Fa[F_QNP + 256 + t] + Fa[F_QNP + 320 + t]) + (Fa[F_QNP + 384 + t] + Fa[F_QNP + 448 + t])))
                                + Fa[F_RSP + t] + Fa[F_RSP + 64 + t];
              if (hi == 0) Fa[F_CW + 32 * (wave - 4) + l31] = 1.0f / fmaxf(fabsf(den), Fa[F_EDEN + t]); }
#pragma unroll
            for (int g = 0; g < 4; ++g) { const f32x4 w4 = *(LAS const f32x4*)(Fa + F_WIN + 32 * ta + 8 * g + 4 * hi); acc[4 * g] *= w4.x; acc[4 * g + 1] *= w4.y; acc[4 * g + 2] *= w4.z; acc[4 * g + 3] *= w4.w; }
            { bf16x8 fa[4], fb[4];
#pragma unroll
              for (int ks = 0; ks < 4; ++ks) { fa[ks] = frag_row<144, 0>(base + O_PI, 32 * ta, ks, lo); fb[ks] = frag_tr<144, 0>(base + O_VI, 0, ks, 32 * tb, lo); }
              __builtin_amdgcn_sched_barrier(0);
#pragma unroll
              for (int ks = 0; ks < 4; ++ks) acc = __builtin_amdgcn_mfma_f32_32x32x16_bf16(fa[ks], fb[ks], acc, 0, 0, 0); }
            bf16* dst = F.YB() + (rowb + t0 + 32 * ta) * D + hh * 256 + 64 * sl + 32 * tb + l31;
#pragma unroll
            for (int g = 0; g < 4; ++g) { const f32x4 r4 = *(LAS const f32x4*)(Fa + F_CW + 32 * (wave - 4) + 8 * g + 4 * hi);
#pragma unroll
                for (int i = 0; i < 4; ++i) dst[(size_t)(8 * g + 4 * hi + i) * D] = (bf16)pk2(acc[4 * g + i] * r4[i], 0.f); }
        }
#pragma unroll
        for (int r = 0; r < 16; ++r) { C0[r] *= decay; C1[r] *= decay; C2[r] *= decay; }
        { bf16x8 bk[4], v0[4], v1[4], v2[4];
#pragma unroll
          for (int ks = 0; ks < 4; ++ks) { bk[ks] = frag_tr<528, 0>(base + O_KI, 0, ks, 32 * wave, lo); v0[ks] = frag_tr<144, 0>(base + O_VW, 0, ks, 0, lo); v1[ks] = frag_tr<144, 0>(base + O_VW, 0, ks, 32, lo); v2[ks] = frag_tr<144, 0>(base + O_VW, 0, ks, 64, lo); }
          __builtin_amdgcn_sched_barrier(0);
#pragma unroll
          for (int ks = 0; ks < 4; ++ks) { C0 = __builtin_amdgcn_mfma_f32_32x32x16_bf16(v0[ks], bk[ks], C0, 0, 0, 0); C1 = __builtin_amdgcn_mfma_f32_32x32x16_bf16(v1[ks], bk[ks], C1, 0, 0, 0); C2 = __builtin_amdgcn_mfma_f32_32x32x16_bf16(v2[ks], bk[ks], C2, 0, 0, 0); }
          __builtin_amdgcn_sched_barrier(0); }
        { const int d = 32 * wave + l31;
#pragma unroll
          for (int g = 0; g < 4; ++g) { const int e0 = 8 * g + 4 * hi;
              *(LAS unsigned long long*)(base + O_CB + ioff<136, 0>(d, e0 >> 3) + 2 * (e0 & 7)) = (unsigned long long)pk2(C0[4 * g], C0[4 * g + 1]) | ((unsigned long long)pk2(C0[4 * g + 2], C0[4 * g + 3]) << 32);
              *(LAS unsigned long long*)(base + O_CB + ioff<136, 0>(d, (32 + e0) >> 3) + 2 * (e0 & 7)) = (unsigned long long)pk2(C1[4 * g], C1[4 * g + 1]) | ((unsigned long long)pk2(C1[4 * g + 2], C1[4 * g + 3]) << 32); }
          if (hi == 0) Fa[F_NV + d] = C2[0];
        }
        __syncthreads();
      }
    }
#undef ML_PREFETCH
}
}


__device__ __forceinline__ void mlstm_gates(Frame& F, int job) {
    const int lane = opq(F.lane); const float LOG2E = 1.4426950408889634f;
    const float lf2 = F.lf()[(size_t)job * ml::L + lane] * LOG2E, ii2 = F.ipre()[(size_t)job * ml::L + lane] * LOG2E;
    float bb = lf2;
#pragma unroll
    for (int o = 1; o < 64; o <<= 1) { const float v = __shfl_up(bb, o); bb += (lane >= o) ? v : 0.f; }
    const float u = ii2 - bb; float pm = u;
#pragma unroll
    for (int o = 1; o < 64; o <<= 1) { const float v = __shfl_up(pm, o); pm = (lane >= o) ? fmaxf(pm, v) : pm; }
    float* gt = F.gt() + (size_t)job * 3 * 64 + lane;
    gt[0] = bb; gt[64] = u; gt[128] = pm;
}

__device__ __forceinline__ void mlstm_conv_rows(Frame& F) {
    const int tid = opq(F.tid), cg = tid & 255, z = cg >> 7, c0 = (cg & 127) * 8, r0 = F.vcu * 128 + 64 * (tid >> 8);
    const bf16* src = F.PROJ() + (size_t)(3 + z) * (SEG / 2) + c0; bf16* dst = (bf16*)F.out() + (size_t)z * T * D + c0;
    float w[4][8], bs[8];
#pragma unroll
    for (int tap = 0; tap < 4; ++tap) { const f32x4 a0 = *(const f32x4*)(F.conv_w() + tap * 2048 + cg * 8), a1 = *(const f32x4*)(F.conv_w() + tap * 2048 + cg * 8 + 4);
        w[tap][0] = a0.x; w[tap][1] = a0.y; w[tap][2] = a0.z; w[tap][3] = a0.w; w[tap][4] = a1.x; w[tap][5] = a1.y; w[tap][6] = a1.z; w[tap][7] = a1.w; }
    { const f32x4 a0 = *(const f32x4*)(F.conv_b() + cg * 8), a1 = *(const f32x4*)(F.conv_b() + cg * 8 + 4);
      bs[0] = a0.x; bs[1] = a0.y; bs[2] = a0.z; bs[3] = a0.w; bs[4] = a1.x; bs[5] = a1.y; bs[6] = a1.z; bs[7] = a1.w; }
    const float osc = z ? 0.0625f : 1.0f;
    const bool seq_start = (r0 % SEQ) == 0;
    v4u x0, x1, x2;
    { const v4u zero = {0u, 0u, 0u, 0u};
      x0 = seq_start ? zero : *(const v4u*)(src + (size_t)(r0 - 3 + (seq_start ? 3 : 0)) * D);
      x1 = seq_start ? zero : *(const v4u*)(src + (size_t)(r0 - 2 + (seq_start ? 2 : 0)) * D);
      x2 = seq_start ? zero : *(const v4u*)(src + (size_t)(r0 - 1 + (seq_start ? 1 : 0)) * D); }
    v4u nxs[8];
#pragma unroll
    for (int i = 0; i < 8; ++i) nxs[i] = *(const v4u*)(src + (size_t)(r0 + i) * D);
    for (int rr = 0; rr < 64; rr += 8) {
        v4u xs[8];
#pragma unroll
        for (int i = 0; i < 8; ++i) xs[i] = nxs[i];
        if (rr + 8 < 64) {
#pragma unroll
            for (int i = 0; i < 8; ++i) nxs[i] = *(const v4u*)(src + (size_t)(r0 + rr + 8 + i) * D); }
#pragma unroll
        for (int i = 0; i < 8; ++i) {
            const v4u x3 = xs[i]; float y[8];
#pragma unroll
            for (int c = 0; c < 8; ++c) y[c] = bs[c];
#define MK_TAP(tap, X) do { y[0] += w[tap][0] * bflo(X.x); y[1] += w[tap][1] * bfhi(X.x); y[2] += w[tap][2] * bflo(X.y); y[3] += w[tap][3] * bfhi(X.y); \
                           y[4] += w[tap][4] * bflo(X.z); y[5] += w[tap][5] * bfhi(X.z); y[6] += w[tap][6] * bflo(X.w); y[7] += w[tap][7] * bfhi(X.w); } while (0)
            MK_TAP(0, x0); MK_TAP(1, x1); MK_TAP(2, x2); MK_TAP(3, x3);
#undef MK_TAP
#pragma unroll
            for (int c = 0; c < 8; ++c) y[c] = ml::silu_f(y[c]) * osc;
            v4u o; o.x = pk2(y[0], y[1]); o.y = pk2(y[2], y[3]); o.z = pk2(y[4], y[5]); o.w = pk2(y[6], y[7]);
            *(v4u*)(dst + (size_t)(r0 + rr + i) * D) = o;
            x0 = x1; x1 = x2; x2 = x3;
        }
    }
}

__device__ __forceinline__ void mlstm_norm_rows(Frame& F) {
    const int row0 = F.vcu * 128, lane = opq(F.lane);
    const bf16* MLO = F.PROJ() + 6 * (SEG / 2);
    f32x4 G[4];
#pragma unroll
    for (int j = 0; j < 4; ++j) G[j] = *(const f32x4*)(F.ml_norm_g() + 256 * j + 4 * lane);
    unsigned long long nh[4], no[4];
#define NR_LOAD(ROW) do { const size_t row_ = (ROW); const GAS unsigned long long* hp_ = (const GAS unsigned long long*)(F.YB() + row_ * D) + lane; const GAS unsigned long long* op_ = (const GAS unsigned long long*)(MLO + row_ * D) + lane; \
        _Pragma("unroll") for (int j = 0; j < 4; ++j) { nh[j] = hp_[64 * j]; no[j] = op_[64 * j]; } } while (0)
    NR_LOAD((size_t)row0 + 16 * F.wave);
    for (int r = 0; r < 16; ++r) {
        const size_t row = (size_t)row0 + 16 * F.wave + r;
        GAS unsigned long long* hp = (GAS unsigned long long*)(F.YB() + row * D) + lane;
        unsigned long long ch[4], co[4];
#pragma unroll
        for (int j = 0; j < 4; ++j) { ch[j] = nh[j]; co[j] = no[j]; }
        if (r < 15) NR_LOAD(row + 1);
#pragma unroll
        for (int j = 0; j < 4; ++j) { const unsigned long long hw = ch[j], ow = co[j];
            const float h0 = bflo((unsigned)hw), h1 = bfhi((unsigned)hw), h2 = bflo((unsigned)(hw >> 32)), h3 = bfhi((unsigned)(hw >> 32));
            const float ss = wave_sum((h0 * h0 + h1 * h1) + (h2 * h2 + h3 * h3)); const float rstd = 1.0f / sqrtf(ss * (1.0f / 256.0f) + EPS);
            const float o0 = bflo((unsigned)ow), o1 = bfhi((unsigned)ow), o2 = bflo((unsigned)(ow >> 32)), o3 = bfhi((unsigned)(ow >> 32));
            const float y0 = h0 * rstd * G[j].x / (1.0f + __expf(-o0)), y1 = h1 * rstd * G[j].y / (1.0f + __expf(-o1)), y2 = h2 * rstd * G[j].z / (1.0f + __expf(-o2)), y3 = h3 * rstd * G[j].w / (1.0f + __expf(-o3));
            hp[64 * j] = (unsigned long long)pk2(y0, y1) | ((unsigned long long)pk2(y2, y3) << 32); }
    }
#undef NR_LOAD
}

namespace at {
using ml::bf16x8; using ml::s16x4; using ml::f32x16; using ml::ioff; using ml::frag_row; using ml::lcp; using ml::lp_t;
typedef _Float16 f16x8 __attribute__((ext_vector_type(8)));
typedef _Float16 f16x2 __attribute__((ext_vector_type(2)));
typedef float f32x2 __attribute__((ext_vector_type(2)));
constexpr int O_KI = 0, O_VI = 8192, O_FLAG = 16384;
template <int PITCH, int XM> __device__ __forceinline__ bf16x8 frag_trp(lcp img, int ks, int col0, int lane) {
    const int h = lane >> 5, blk = (lane >> 4) & 1, q = (lane & 15) >> 2, p = lane & 3;
    const int r0 = 16 * ks + 4 * h + q, ch = (col0 >> 3) + 2 * blk + (p >> 1);
    typedef short v4i16_t __attribute__((ext_vector_type(4)));
    const s16x4 a = __builtin_bit_cast(s16x4, __builtin_amdgcn_ds_read_tr16_b64_v4i16((LAS v4i16_t*)(img + ioff<PITCH, XM>(r0, ch) + 8 * (p & 1))));
    const s16x4 b = __builtin_bit_cast(s16x4, __builtin_amdgcn_ds_read_tr16_b64_v4i16((LAS v4i16_t*)(img + ioff<PITCH, XM>(r0 + 8, ch) + 8 * (p & 1))));
    return (bf16x8){a[0], a[1], a[2], a[3], b[0], b[1], b[2], b[3]};
}
__device__ __forceinline__ unsigned pkh(float a, float b) { const f32x2 v = {a, b}; return __builtin_bit_cast(unsigned, __builtin_convertvector(v, f16x2)); }
__device__ __forceinline__ f16x8 h8(unsigned a, unsigned b, unsigned c, unsigned d) { const v4u v = {a, b, c, d}; return __builtin_bit_cast(f16x8, v); }
__device__ __forceinline__ bf16x8 b8(unsigned a, unsigned b, unsigned c, unsigned d) { const v4u v = {a, b, c, d}; return __builtin_bit_cast(bf16x8, v); }

__device__ __forceinline__ void attn_unit(Frame& F, int bh, int qb) {
    const int b = bh >> 4, hd = bh & 15, tid = opq(F.tid), lane = opq(F.lane), wave = F.wave, hi = lane >> 5, l31 = lane & 31, pr = wave >> 1, tp = tid & 127;
    const bf16* Q = F.PROJ(); const bf16* K = F.PROJ() + SEG / 2; const bf16* V = F.PROJ() + SEG;
    lp_t base = (lp_t)F.lds + pr * 16384;
    LAS volatile int* dflag = (LAS volatile int*)((lp_t)F.lds + 65536);
    const size_t rowb = (size_t)b * SEQ; const int q0 = qb * 256, tw0 = q0 + 32 * wave, t = tw0 + l31, kt0 = qb * 4 + pr;
    bf16x8 qr[4];
#pragma unroll
    for (int ks = 0; ks < 4; ++ks) qr[ks] = *(const bf16x8*)(Q + (rowb + t) * D + hd * 64 + 16 * ks + 8 * hi);
    unsigned uw[2][4];
#pragma unroll
    for (int sp = 0; sp < 2; ++sp)
#pragma unroll
        for (int jj = 0; jj < 4; ++jj) { const int j0 = 2 * jj, j1 = 2 * jj + 1;
            const int k0 = 16 * sp + 8 * (j0 >> 2) + 4 * hi + (j0 & 3), k1 = 16 * sp + 8 * (j1 >> 2) + 4 * hi + (j1 & 3);
            uw[sp][jj] = (k0 > l31 ? 0x3C00u : 0u) | (k1 > l31 ? 0x3C000000u : 0u); }
    const f16x8 U0 = h8(uw[0][0], uw[0][1], uw[0][2], uw[0][3]), U1 = h8(uw[1][0], uw[1][1], uw[1][2], uw[1][3]), ONES = h8(0x3C003C00u, 0x3C003C00u, 0x3C003C00u, 0x3C003C00u);
    f32x16 O0, O1;
#pragma unroll
    for (int r = 0; r < 16; ++r) { O0[r] = 0.f; O1[r] = 0.f; }
    float R = 0.f; bool wdone = false;
    v4u kreg[4], vreg[4];
#define AT_LOAD(KT) do { _Pragma("unroll") for (int j = 0; j < 4; ++j) { const size_t g = (rowb + (KT) * 64 + (tp >> 3) + 16 * j) * D + hd * 64 + (tp & 7) * 8; kreg[j] = *(const v4u*)(K + g); vreg[j] = *(const v4u*)(V + g); } } while (0)
    AT_LOAD(kt0);
    __syncthreads();
    if (tid < 8) dflag[tid] = 0;
    for (int it = 0; it <= qb * 4 + 3; ++it) {
        const int kt = kt0 - it;
        __syncthreads();
        { int nd = 0;
#pragma unroll
          for (int w = 0; w < 8; ++w) nd += dflag[w];
          if (nd == 8) break; }
        if (kt >= 0) {
#pragma unroll
            for (int j = 0; j < 4; ++j) { *(LAS v4u*)(base + O_KI + ioff<128, 7>((tp >> 3) + 16 * j, tp & 7)) = kreg[j]; *(LAS v4u*)(base + O_VI + ioff<128, 7>((tp >> 3) + 16 * j, tp & 7)) = vreg[j]; } }
        __syncthreads();
        if (kt > 0) AT_LOAD(kt - 1);
        if (kt < 0) { if (!wdone) { wdone = true; if (lane == 0) dflag[wave] = 1; } continue; }
        if (wdone) continue;
        int lo = lane; asm volatile("" : "+v"(lo));
        f32x16 p0, p1;
#pragma unroll
        for (int r = 0; r < 16; ++r) { p0[r] = 0.f; p1[r] = 0.f; }
#pragma unroll
        for (int ks = 0; ks < 4; ++ks) { p0 = __builtin_amdgcn_mfma_f32_32x32x16_bf16(frag_row<128, 7>(base + O_KI, 0, ks, lo), qr[ks], p0, 0, 0, 0);
                                         p1 = __builtin_amdgcn_mfma_f32_32x32x16_bf16(frag_row<128, 7>(base + O_KI, 32, ks, lo), qr[ks], p1, 0, 0, 0); }
        const bool diag = (it == 0);
        const int trel = t - 64 * kt;
        float lk00 = 0.f;
        unsigned lkw0[8], lkw1[8];
#pragma unroll
        for (int r = 0; r < 16; ++r) {
            const int key0 = ml::crow(r, hi);
            { const float z = p0[r], lb = fminf(z, 0.f) - __builtin_amdgcn_logf(1.0f + __builtin_amdgcn_exp2f(-fabsf(z))); float lk = lb - z; if (diag && !(key0 < trel)) lk = 0.f; p0[r] = lb; if (r == 0) lk00 = lk;
              if (r & 1) lkw0[r >> 1] = pkh(__builtin_bit_cast(float, lkw0[r >> 1]), lk); else lkw0[r >> 1] = __builtin_bit_cast(unsigned, lk); }
            { const float z = p1[r], lb = fminf(z, 0.f) - __builtin_amdgcn_logf(1.0f + __builtin_amdgcn_exp2f(-fabsf(z))); float lk = lb - z; if (diag && !(key0 + 32 < trel)) lk = 0.f; p1[r] = lb;
              if (r & 1) lkw1[r >> 1] = pkh(__builtin_bit_cast(float, lkw1[r >> 1]), lk); else lkw1[r >> 1] = __builtin_bit_cast(unsigned, lk); }
        }
        f32x16 bt1, bt0;
#pragma unroll
        for (int r = 0; r < 16; ++r) { bt1[r] = R; bt0[r] = R; }
        const f16x8 L10 = h8(lkw1[0], lkw1[1], lkw1[2], lkw1[3]), L11 = h8(lkw1[4], lkw1[5], lkw1[6], lkw1[7]), L00 = h8(lkw0[0], lkw0[1], lkw0[2], lkw0[3]), L01 = h8(lkw0[4], lkw0[5], lkw0[6], lkw0[7]);
        bt1 = __builtin_amdgcn_mfma_f32_32x32x16_f16(U0, L10, bt1, 0, 0, 0); bt1 = __builtin_amdgcn_mfma_f32_32x32x16_f16(U1, L11, bt1, 0, 0, 0);
        bt0 = __builtin_amdgcn_mfma_f32_32x32x16_f16(ONES, L10, bt0, 0, 0, 0); bt0 = __builtin_amdgcn_mfma_f32_32x32x16_f16(ONES, L11, bt0, 0, 0, 0);
        bt0 = __builtin_amdgcn_mfma_f32_32x32x16_f16(U0, L00, bt0, 0, 0, 0); bt0 = __builtin_amdgcn_mfma_f32_32x32x16_f16(U1, L01, bt0, 0, 0, 0);
        { const float v = bt0[0] + lk00;
          const auto rr = __builtin_amdgcn_permlane32_swap(__builtin_bit_cast(unsigned, v), __builtin_bit_cast(unsigned, v), false, false);
          R = __builtin_bit_cast(float, rr[0]); }
        unsigned aw0[8], aw1[8];
#pragma unroll
        for (int r = 0; r < 16; r += 2) {
            const int key0 = ml::crow(r, hi);
            float a00 = __builtin_amdgcn_exp2f(p0[r] + bt0[r]), a01 = __builtin_amdgcn_exp2f(p0[r + 1] + bt0[r + 1]), a10 = __builtin_amdgcn_exp2f(p1[r] + bt1[r]), a11 = __builtin_amdgcn_exp2f(p1[r + 1] + bt1[r + 1]);
            if (diag) { if (!(key0 < trel)) a00 = 0.f; if (!(key0 + 1 < trel)) a01 = 0.f; if (!(key0 + 32 < trel)) a10 = 0.f; if (!(key0 + 33 < trel)) a11 = 0.f; }
            aw0[r >> 1] = pk2(a00, a01); aw1[r >> 1] = pk2(a10, a11);
        }
        const bf16x8 A00 = b8(aw0[0], aw0[1], aw0[2], aw0[3]), A01 = b8(aw0[4], aw0[5], aw0[6], aw0[7]), A10 = b8(aw1[0], aw1[1], aw1[2], aw1[3]), A11 = b8(aw1[4], aw1[5], aw1[6], aw1[7]);
        O0 = __builtin_amdgcn_mfma_f32_32x32x16_bf16(A00, frag_trp<128, 7>(base + O_VI, 0, 0, lo), O0, 0, 0, 0);  O1 = __builtin_amdgcn_mfma_f32_32x32x16_bf16(A00, frag_trp<128, 7>(base + O_VI, 0, 32, lo), O1, 0, 0, 0);
        O0 = __builtin_amdgcn_mfma_f32_32x32x16_bf16(A01, frag_trp<128, 7>(base + O_VI, 1, 0, lo), O0, 0, 0, 0);  O1 = __builtin_amdgcn_mfma_f32_32x32x16_bf16(A01, frag_trp<128, 7>(base + O_VI, 1, 32, lo), O1, 0, 0, 0);
        O0 = __builtin_amdgcn_mfma_f32_32x32x16_bf16(A10, frag_trp<128, 7>(base + O_VI, 2, 0, lo), O0, 0, 0, 0);  O1 = __builtin_amdgcn_mfma_f32_32x32x16_bf16(A10, frag_trp<128, 7>(base + O_VI, 2, 32, lo), O1, 0, 0, 0);
        O0 = __builtin_amdgcn_mfma_f32_32x32x16_bf16(A11, frag_trp<128, 7>(base + O_VI, 3, 0, lo), O0, 0, 0, 0);  O1 = __builtin_amdgcn_mfma_f32_32x32x16_bf16(A11, frag_trp<128, 7>(base + O_VI, 3, 32, lo), O1, 0, 0, 0);
        if (__all(R < ATT_RTHR)) { wdone = true; if (lane == 0) dflag[wave] = 1; }
    }
#undef AT_LOAD
    __syncthreads();
    bf16* dst = F.YA() + (rowb + tw0) * D + hd * 64 + l31;
#pragma unroll
    for (int r = 0; r < 16; ++r) { const int q = ml::crow(r, hi); dst[(size_t)q * D] = (bf16)pk2(O0[r], 0.f); dst[(size_t)q * D + 32] = (bf16)pk2(O1[r], 0.f); }
}
}

__device__ __forceinline__ void p5a_route(Frame& F) {
    const int row0 = F.vcu * 128, b = row0 / SEQ, lane = opq(F.lane), tid = opq(F.tid);
    LAS float* wr = (LAS float*)F.lds;
    LAS int* le = (LAS int*)(F.lds + 131584); LAS int* lp = le + 512;
    LAS int* lcnt = (LAS int*)(F.LC + LC_LCNT); LAS int* gbase = (LAS int*)(F.LC + LC_GBASE);
    for (int idx = tid; idx < 32768; idx += 512) wr[(idx & 31) * 1028 + (idx >> 5)] = F.router_w()[idx];
    if (tid < 32) lcnt[tid] = 0;
    f32x4 Av[4], Bv[4];
#pragma unroll
    for (int j = 0; j < 4; ++j) { const int col = 4 * lane + 256 * j; const float* mb = F.mod() + (size_t)b * NMOD;
        const f32x4 g = *(const f32x4*)(F.norm2_g() + col); Av[j] = g * (*(const f32x4*)(mb + 4 * D + col) + 1.0f); Bv[j] = *(const f32x4*)(mb + 3 * D + col); }
    float rb[32];
#pragma unroll
    for (int e = 0; e < 32; ++e) rb[e] = F.router_b()[e];
    __syncthreads();
    f32x4 nx[4];
    { const GAS f32x4* xr = (const GAS f32x4*)(F.out() + (size_t)(row0 + 16 * F.wave) * D) + lane;
#pragma unroll
      for (int j = 0; j < 4; ++j) nx[j] = xr[64 * j]; }
    for (int r = 0; r < 16; ++r) {
        const int rl = 16 * F.wave + r, row = row0 + rl;
        f32x4 v[4]; float ss = 0.f;
#pragma unroll
        for (int j = 0; j < 4; ++j) { v[j] = nx[j]; ss += (v[j].x * v[j].x + v[j].y * v[j].y) + (v[j].z * v[j].z + v[j].w * v[j].w); }
        if (r < 15) { const GAS f32x4* xr = (const GAS f32x4*)(F.out() + (size_t)(row + 1) * D) + lane;
#pragma unroll
            for (int j = 0; j < 4; ++j) nx[j] = xr[64 * j]; }
        const float rstd = 1.0f / sqrtf(wave_sum(ss) * (1.0f / D) + EPS);
        { GAS unsigned long long* o8 = (GAS unsigned long long*)(F.H2() + (size_t)row * D) + lane;
#pragma unroll
          for (int j = 0; j < 4; ++j) { v[j] = v[j] * rstd * Av[j] + Bv[j]; o8[64 * j] = (unsigned long long)pk2(v[j].x, v[j].y) | ((unsigned long long)pk2(v[j].z, v[j].w) << 32); } }
        float p[32];
#pragma unroll
        for (int e = 0; e < 32; ++e) { float s = 0.f;
#pragma unroll
            for (int j = 0; j < 4; ++j) { const f32x4 w = *(const LAS f32x4*)(wr + e * 1028 + 4 * lane + 256 * j); s += (v[j].x * w.x + v[j].y * w.y) + (v[j].z * w.z + v[j].w * w.w); }
            p[e] = s; }
#pragma unroll
        for (int i = 0; i < 16; ++i) { const bool up = (lane & 32) != 0; const float send = up ? p[i] : p[i + 16], keep = up ? p[i + 16] : p[i]; p[i] = keep + __shfl_xor(send, 32); }
#pragma unroll
        for (int i = 0; i < 8; ++i) { const bool up = (lane & 16) != 0; const float send = up ? p[i] : p[i + 8], keep = up ? p[i + 8] : p[i]; p[i] = keep + __shfl_xor(send, 16); }
#pragma unroll
        for (int i = 0; i < 4; ++i) { const bool up = (lane & 8) != 0; const float send = up ? p[i] : p[i + 4], keep = up ? p[i + 4] : p[i]; p[i] = keep + __shfl_xor(send, 8); }
#pragma unroll
        for (int i = 0; i < 2; ++i) { const bool up = (lane & 4) != 0; const float send = up ? p[i] : p[i + 2], keep = up ? p[i + 2] : p[i]; p[i] = keep + __shfl_xor(send, 4); }
        { const bool up = (lane & 2) != 0; const float send = up ? p[0] : p[1], keep = up ? p[1] : p[0]; p[0] = keep + __shfl_xor(send, 2); }
        p[0] += __shfl_xor(p[0], 1);
        { LAS float* lg = (LAS float*)(F.lds + 135680) + F.wave * 32;
          if ((lane & 1) == 0) lg[lane >> 1] = p[0];
#pragma unroll
          for (int q = 0; q < 8; ++q) { const f32x4 t4 = *(const LAS f32x4*)(lg + 4 * q); p[4 * q] = t4.x + rb[4 * q]; p[4 * q + 1] = t4.y + rb[4 * q + 1]; p[4 * q + 2] = t4.z + rb[4 * q + 2]; p[4 * q + 3] = t4.w + rb[4 * q + 3]; } }
        int sel[4]; float sv[4]; unsigned used = 0u;
#pragma unroll
        for (int k = 0; k < 4; ++k) { float best = -3.0e38f; int bi = 0;
#pragma unroll
            for (int e = 0; e < 32; ++e) { const bool cnd = (((used >> e) & 1u) == 0u) && (p[e] > best); best = cnd ? p[e] : best; bi = cnd ? e : bi; }
            sel[k] = bi; sv[k] = best; used |= 1u << bi; }
        const float e1 = __expf(sv[1] - sv[0]), e2 = __expf(sv[2] - sv[0]), e3 = __expf(sv[3] - sv[0]), inv = 1.0f / (1.0f + e1 + e2 + e3);
        if (lane < 4) { const int ek = lane == 0 ? sel[0] : lane == 1 ? sel[1] : lane == 2 ? sel[2] : sel[3];
            const float wk = (lane == 0 ? 1.0f : lane == 1 ? e1 : lane == 2 ? e2 : e3) * inv;
            const int pos = __hip_atomic_fetch_add(lcnt + ek, 1, __ATOMIC_RELAXED, __HIP_MEMORY_SCOPE_WORKGROUP);
            le[rl * 4 + lane] = ek; lp[rl * 4 + lane] = pos; F.tokw()[(size_t)row * 4 + lane] = wk; }
        if (lane == 0) F.rstd2()[row] = rstd;
    }
    __syncthreads();
    if (tid < 32) gbase[tid] = (int)__hip_atomic_fetch_add(F.ctl + CW_ECNT + 64 * tid, (unsigned)lcnt[tid], __ATOMIC_RELAXED, __HIP_MEMORY_SCOPE_AGENT);
    __syncthreads();
    { const int ek = le[tid]; F.toke()[(size_t)row0 * 4 + tid] = ek; F.tokp()[(size_t)row0 * 4 + tid] = lp[tid] + gbase[ek]; }
}

__device__ __forceinline__ void p5b_tables(Frame& F) {
    const int row0 = F.vcu * 128, tid = opq(F.tid);
    LAS int* ts = (LAS int*)(F.LC + LC_TS); LAS int* ps = (LAS int*)(F.LC + LC_PS); LAS int* cn = (LAS int*)(F.LC + LC_CNT);
    if (tid < 32) cn[tid] = (int)__hip_atomic_load(F.ctl + CW_ECNT + 64 * tid, RLX_AGENT);
    __syncthreads();
    if (tid == 0) { int run = 0, trun = 0; for (int e = 0; e < 32; ++e) { ps[e] = run; ts[e] = trun; const int nt = (cn[e] + 255) >> 8; run += nt * 256; trun += nt; } ts[32] = trun; }
    __syncthreads();
    { const size_t idx = (size_t)row0 * 4 + tid; const int ek = F.toke()[idx], dst = ps[ek] + F.tokp()[idx]; F.tokrow()[idx] = dst; F.row2tok()[dst] = row0 + (tid >> 2); }
    if (F.vcu < 32) { const int e = F.vcu, start = ps[e] + cn[e], end = ps[e] + (((cn[e] + 255) >> 8) << 8); for (int r = start + tid; r < end; r += 512) F.row2tok()[r] = 0; }
}

__device__ __forceinline__ void p8_combine(Frame& F, bool poison) {
    const int row0 = F.vcu * 128, b = row0 / SEQ, lane = opq(F.lane);
    f32x4 G2[4], FG[4];
#pragma unroll
    for (int j = 0; j < 4; ++j) { const int col = 4 * lane + 256 * j; G2[j] = *(const f32x4*)(F.mod() + (size_t)b * NMOD + 5 * D + col); FG[j] = *(const f32x4*)(F.final_g() + col); }
    f32x4 nx[4]; unsigned long long ng[4][4]; float nw[4];
#define P8_LOAD(ROW) do { const size_t row_ = (ROW); const GAS f32x4* xr_ = (const GAS f32x4*)(F.out() + row_ * D) + lane; \
        _Pragma("unroll") for (int j = 0; j < 4; ++j) nx[j] = xr_[64 * j]; \
        _Pragma("unroll") for (int k = 0; k < 4; ++k) { const int src_ = F.tokrow()[row_ * 4 + k]; nw[k] = F.tokw()[row_ * 4 + k]; \
            const GAS unsigned long long* s8_ = (const GAS unsigned long long*)(F.OUTR() + (size_t)src_ * D) + lane; \
            _Pragma("unroll") for (int j = 0; j < 4; ++j) ng[k][j] = s8_[64 * j]; } } while (0)
    P8_LOAD((size_t)row0 + 16 * F.wave);
    for (int r = 0; r < 16; ++r) {
        const int row = row0 + 16 * F.wave + r;
        GAS f32x4* xr = (GAS f32x4*)(F.out() + (size_t)row * D) + lane;
        f32x4 y[4], xv[4];
#pragma unroll
        for (int j = 0; j < 4; ++j) { y[j] = (f32x4){0.f, 0.f, 0.f, 0.f}; xv[j] = nx[j]; }
#pragma unroll
        for (int k = 0; k < 4; ++k) { const float wk = nw[k];
#pragma unroll
            for (int j = 0; j < 4; ++j) { const unsigned long long w = ng[k][j]; y[j].x += wk * bflo((unsigned)w); y[j].y += wk * bfhi((unsigned)w); y[j].z += wk * bflo((unsigned)(w >> 32)); y[j].w += wk * bfhi((unsigned)(w >> 32)); } }
        if (r < 15) P8_LOAD((size_t)row + 1);
        f32x4 v[4]; float ss = 0.f;
#pragma unroll
        for (int j = 0; j < 4; ++j) { v[j] = xv[j] + G2[j] * y[j]; ss += (v[j].x * v[j].x + v[j].y * v[j].y) + (v[j].z * v[j].z + v[j].w * v[j].w); }
        const float rstd = 1.0f / sqrtf(wave_sum(ss) * (1.0f / D) + EPS);
        const float qn = __builtin_nanf("");
#pragma unroll
        for (int j = 0; j < 4; ++j) { f32x4 o = v[j] * rstd * FG[j]; if (poison) o = (f32x4){qn, qn, qn, qn}; xr[64 * j] = o; }
    }
#undef P8_LOAD
}

#ifndef MK_REP_G2
#define MK_REP_G2 1
#endif
#ifndef MK_REP_G4A
#define MK_REP_G4A 1
#endif
#ifndef MK_REP_G4B
#define MK_REP_G4B 1
#endif
#ifndef MK_REP_G4C
#define MK_REP_G4C 1
#endif
#ifndef MK_REP_G6
#define MK_REP_G6 1
#endif
#ifndef MK_REP_G7
#define MK_REP_G7 1
#endif
#ifndef MK_REP_P0
#define MK_REP_P0 1
#endif
#ifndef MK_REP_P3
#define MK_REP_P3 1
#endif
struct Args { const float* in[22]; float* out; unsigned char* ws; };
__global__ void __launch_bounds__(NWAVES * 64, 2) mk_fwd(Args args) {
    extern __shared__ __attribute__((aligned(16))) unsigned char lds[];
    Frame F;
    F.lds = (LAS unsigned char*)lds; F.LC = (volatile LAS unsigned*)(F.lds + LDSCTL_OFF);
    F.tid = threadIdx.x; F.lane = F.tid & 63; F.wave = __builtin_amdgcn_readfirstlane(F.tid >> 6);
    F.G = gridDim.x; { const int bx = blockIdx.x; F.vcu = (F.G % 8 == 0) ? (bx % 8) * (F.G / 8) + bx / 8 : bx; }
    F.ws = (unsigned char*)(GAS unsigned char*)karg(23);
    F.ctl = (gu32*)(F.ws + WS_CTL);
    for (int u = F.tid; u < (LDS_BYTES - LDSCTL_OFF) / 4; u += NWAVES * 64) ((LAS unsigned*)(F.lds + LDSCTL_OFF))[u] = 0u;
    __syncthreads();
    XcdBarrier bar = xcd_barrier_post((unsigned*)(F.ctl + CW_BAR), F.LC + LC_BAR);
#define GRID_BAR() xcd_barrier(bar)
    const int G = F.G, cid = (int)blockIdx.x;

    for (int rep_ = 0; rep_ < MK_REP_P0; ++rep_) p0_prologue(F);
    GRID_BAR();
    p1_rows(F);
    GRID_BAR();
    { pg8::Gemm g{F.H1(), F.WIN_T(), T, NPROJ, D}; pg8::StaticOrder S; S.init(T, NPROJ, G, cid);
      pg8::EpiBf16<0> E{F.PROJ(), D, nullptr, D, SEG / 2, QSCALE};
      for (int rep_ = 0; rep_ < MK_REP_G2; ++rep_) pg8::gemm_phase<pg8::EpiBf16<0>, pg8::StaticOrder, true, true>(F.lds, g, S, E); }
    GRID_BAR();
    for (int job = F.vcu * NWAVES + F.wave; job < BATCH * 4 * (SEQ / 64); job += G * NWAVES) mlstm_gates(F, job);
    mlstm_conv_rows(F);
    GRID_BAR();
#if defined(MK_NAIVE_MLSTM)
    for (int it = F.vcu; it < 1024; it += G) attn_naive_item(F, it & 255, it >> 8);
    __syncthreads();
    for (int it = F.vcu; it < 64; it += G) mlstm_naive_item(F, it);
#else
    for (int rep_ = 0; rep_ < MK_REP_P3; ++rep_) {
    for (int it = F.vcu; it < 256; it += G) ml::mlstm_unit(F, it);
    __syncthreads();
#if defined(MK_NAIVE_ATTN)
    for (int it = F.vcu; it < 1024; it += G) attn_naive_item(F, it & 255, it >> 8);
#else
    for (int it = F.vcu; it < 2048; it += G) at::attn_unit(F, it & 255, it >> 8);
#endif
    }
#endif
    GRID_BAR();
    { pg8::Gemm g{F.YA(), F.WA_T(), T, D, D}; pg8::StaticOrder S; S.init(T, D, G, cid);
      pg8::EpiGate<false> E{F.PROJ() + 7 * (SEG / 2), nullptr, F.M1()};
      for (int rep_ = 0; rep_ < MK_REP_G4A; ++rep_) pg8::gemm_phase<pg8::EpiGate<false>, pg8::StaticOrder, true, true>(F.lds, g, S, E); }
#if defined(MK_NAIVE_MLSTM)
    VM_WAIT(); __syncthreads();
#else
    __syncthreads();
    mlstm_norm_rows(F);
    GRID_BAR();
#endif
    { pg8::Gemm g{F.YB(), F.WB_T(), T, D, D}; pg8::StaticOrder S; S.init(T, D, G, cid);
      pg8::EpiGate<true> E{F.PROJ() + 8 * (SEG / 2), F.M1(), F.MERGED()};
      for (int rep_ = 0; rep_ < MK_REP_G4B; ++rep_) pg8::gemm_phase<pg8::EpiGate<true>, pg8::StaticOrder, true, true>(F.lds, g, S, E); }
    GRID_BAR();
    { pg8::Gemm g{F.MERGED(), F.WOUT_T(), T, D, D}; pg8::StaticOrder S; S.init(T, D, G, cid);
      pg8::EpiResid E{F.x(), F.mod() + 2 * D, F.out(), SEQ, NMOD};
      for (int rep_ = 0; rep_ < MK_REP_G4C; ++rep_) pg8::gemm_phase<pg8::EpiResid, pg8::StaticOrder, true, true>(F.lds, g, S, E); }
    GRID_BAR();
    p5a_route(F);
    GRID_BAR();
    p5b_tables(F);
    GRID_BAR();
    { pg8::Gemm g{F.H2(), F.W1_T(), T, NE * 2048, D}; pg8::GroupedOrder S{(const LAS int*)(F.LC + LC_TS), 8, G, cid, F.row2tok()};
      pg8::EpiSwiglu E{F.b1(), F.ACT()};
      for (int rep_ = 0; rep_ < MK_REP_G6; ++rep_) pg8::gemm_phase<pg8::EpiSwiglu, pg8::GroupedOrder, true, true, true>(F.lds, g, S, E); }
    GRID_BAR();
    { pg8::Gemm g{F.ACT(), F.W2_T(), XS_ROWS, NE * 1024, D}; pg8::GroupedOrder S{(const LAS int*)(F.LC + LC_TS), 4, G, cid, nullptr};
      pg8::EpiBf16<0> E{F.OUTR(), D, F.b2(), D, 0, 1.0f};
      for (int rep_ = 0; rep_ < MK_REP_G7; ++rep_) pg8::gemm_phase<pg8::EpiBf16<0>, pg8::GroupedOrder, true, true>(F.lds, g, S, E); }
    GRID_BAR();
    { const bool poison = __hip_atomic_load(F.ctl + CW_BAR + XB_TMO, RLX_AGENT) != 0u;
      p8_combine(F, poison); }
}

extern "C" void kernel_launch(void* const* d_in, const int* in_sizes, int n_in, void* d_out, int out_size, void* d_ws, size_t ws_size, hipStream_t stream) {
    static int grid = 0;
    if (grid == 0) {
        if (n_in != 22 || in_sizes[0] != T * D || out_size != T * D || ws_size < WS_END) { fprintf(stderr, "kernel_launch: unexpected shapes (n_in %d, in0 %d, out %d, ws %zu)\n", n_in, n_in > 0 ? in_sizes[0] : -1, out_size, ws_size); grid = -1; return; }
        int dev = 0, cus = 0, per_cu = 0;
        if (hipGetDevice(&dev) != hipSuccess || hipDeviceGetAttribute(&cus, hipDeviceAttributeMultiprocessorCount, dev) != hipSuccess) { grid = -1; return; }
        if (hipFuncSetAttribute((const void*)mk_fwd, hipFuncAttributeMaxDynamicSharedMemorySize, LDS_BYTES) != hipSuccess) { fprintf(stderr, "kernel_launch: hipFuncSetAttribute failed\n"); grid = -1; return; }
        if (hipOccupancyMaxActiveBlocksPerMultiprocessor(&per_cu, (const void*)mk_fwd, NWAVES * 64, LDS_BYTES) != hipSuccess || per_cu < 1) { fprintf(stderr, "kernel_launch: occupancy query says %d blocks per CU\n", per_cu); }
        (void)hipGetLastError();
        if (cus < 256) { fprintf(stderr, "kernel_launch: built for a 256-CU device, found %d CUs\n", cus); grid = -1; return; }
        grid = 256;
    }
    if (grid < 0) return;
    if (hipMemsetAsync((char*)d_ws + WS_CTL, 0, CTL_ZERO_BYTES, stream) != hipSuccess) return;
    Args a{};
    for (int i = 0; i < 22; ++i) a.in[i] = (const float*)d_in[i];
    a.out = (float*)d_out; a.ws = (unsigned char*)d_ws;
    hipLaunchKernelGGL(mk_fwd, dim3(grid), dim3(NWAVES * 64), LDS_BYTES, stream, a);
}
```

```cpp
#include <hip/hip_runtime.h>
#include <cstdio>
#include <cstdint>
namespace pg8 {
#define PG8_LAS __attribute__((address_space(3)))
typedef unsigned short bf16_t;
typedef short bf16x8 __attribute__((ext_vector_type(8)));
typedef float f32x4 __attribute__((ext_vector_type(4)));
typedef unsigned u32x4 __attribute__((ext_vector_type(4)));
constexpr int BM = 256, BK = 64, HALF = 128, HTB = HALF * BK * 2  , STAGE_BYTES = 8 * HTB, NXCD = 8, WGM = 8;

__host__ __device__ __forceinline__ int lds_byte(int r, int c) { const int st = (r >> 4) * 2 + (c >> 5), rr = r & 15, cc = c & 31, ob = rr * 64 + cc * 2; return st * 1024 + (ob ^ (((ob >> 9) & 1) << 5)); }
__host__ __device__ __forceinline__ void stage_rc(int b, int& R, int& C) { const int st = b / 1024, sb = b % 1024, swz = sb ^ (((sb >> 9) & 1) << 5); R = (st >> 1) * 16 + swz / 64; C = (st & 1) * 32 + (swz % 64) / 2; }
__host__ __device__ __forceinline__ int perm32(int rho) { const int n = rho >> 4, i = rho & 15; return 8 * (i >> 2) + 4 * n + (i & 3); }

struct Unit { int pm, pn; };
struct Gemm { const bf16_t* A; const bf16_t* Bt; int M, N, K; };

struct StaticOrder {
    int nM, nN, nwg, G, c;
    __host__ __device__ void init(int M, int N, int G_, int c_) { nM = M / BM; nN = N / BM; nwg = nM * nN; G = G_; c = c_; }
    __host__ __device__ bool next(int i, Unit& u) const {
        const long L = (long)i * G + c; if (L >= nwg) return false;
        int wgid = (int)L; { const int q = nwg / NXCD, r = nwg % NXCD, xcd = wgid % NXCD, off = wgid / NXCD; wgid = (xcd < r ? xcd * (q + 1) : r * (q + 1) + (xcd - r) * q) + off; }
        const int nig = WGM * nN, gid = wgid / nig, fm = gid * WGM, gsz = (nM - fm) < WGM ? (nM - fm) : WGM;
        u.pm = fm + ((wgid % nig) % gsz); u.pn = (wgid % nig) / gsz; return true;
    }
    __device__ __forceinline__ void a_ready(const Unit&) const {}
    __device__ __forceinline__ void done(const Unit&) const {}
};

__device__ __forceinline__ unsigned cvt_pk_bf16(float lo, float hi) { unsigned r; asm volatile("v_cvt_pk_bf16_f32 %0, %1, %2" : "=v"(r) : "v"(lo), "v"(hi)); return r; }
typedef float f32x2 __attribute__((ext_vector_type(2)));
__device__ __forceinline__ f32x2 gelu_pk(f32x2 v) {
    const f32x2 av = __builtin_elementwise_abs(v), d = av * 0.2316418882f + 1.0f;
    f32x2 t; t.x = __builtin_amdgcn_rcpf(d.x); t.y = __builtin_amdgcn_rcpf(d.y);
    f32x2 q = t * 0.5307027145f + (-0.7265760135f); q = q * t + 0.7107068705f; q = q * t + (-0.142248368f); q = q * t + 0.127414796f; q = q * t;
    const f32x2 s = (v * v) * (-0.72134752044f);
    f32x2 e; e.x = __builtin_amdgcn_exp2f(s.x); e.y = __builtin_amdgcn_exp2f(s.y);
    const f32x2 m = v * (q * e), r = v - m;
    f32x2 o; o.x = v.x < 0.f ? m.x : r.x; o.y = v.y < 0.f ? m.y : r.y; return o;
}

template <int ACT  > struct EpiBf16 {
    static constexpr bool PERM = true, AFTER_DRAIN = false; static_assert(ACT == 0 || ACT == 1, "EpiBf16: ACT is 0 (none) or 1 (gelu_pk)");
    bf16_t* O; int ldc; const float* bias; int split_cols; size_t split_stride; float scale0;
    __device__ __forceinline__ void operator()(const f32x4 (&acc)[2][2][4][2], const Unit& u, int wr, int wc, int fr, int fq) const {
        const int row0 = u.pm * BM + wr * 64 + fr; int colt = u.pn * BM; bf16_t* base = O;
        float sc = 1.f; if (split_cols) { const int t = colt / split_cols; base += (size_t)t * split_stride; colt -= t * split_cols; if (t == 0) sc = scale0; }
        const int col0 = colt + wc * 32 + 8 * fq, bcol0 = u.pn * BM + wc * 32 + 8 * fq;
        f32x4 bv[2][2];
#pragma unroll
        for (int bj = 0; bj < 2; ++bj)
#pragma unroll
            for (int n = 0; n < 2; ++n) bv[bj][n] = bias ? *(const f32x4*)(bias + bcol0 + bj * HALF + 4 * n) : (f32x4){0.f, 0.f, 0.f, 0.f};
#pragma unroll
        for (int ai = 0; ai < 2; ++ai)
#pragma unroll
            for (int m = 0; m < 4; ++m) { bf16_t* rowp = base + (size_t)(row0 + ai * HALF + m * 16) * ldc + col0;
#pragma unroll
                for (int bj = 0; bj < 2; ++bj) { f32x4 v0 = acc[ai][bj][m][0] + bv[bj][0], v1 = acc[ai][bj][m][1] + bv[bj][1];
                    if (ACT == 1) { f32x2 a = gelu_pk((f32x2){v0[0], v0[1]}), b = gelu_pk((f32x2){v0[2], v0[3]}), c = gelu_pk((f32x2){v1[0], v1[1]}), d = gelu_pk((f32x2){v1[2], v1[3]});
                        v0 = (f32x4){a.x, a.y, b.x, b.y}; v1 = (f32x4){c.x, c.y, d.x, d.y}; }
                    v0 = v0 * sc; v1 = v1 * sc; u32x4 w; w.x = cvt_pk_bf16(v0[0], v0[1]); w.y = cvt_pk_bf16(v0[2], v0[3]); w.z = cvt_pk_bf16(v1[0], v1[1]); w.w = cvt_pk_bf16(v1[2], v1[3]);
                    __builtin_nontemporal_store(w, (u32x4*)(rowp + bj * HALF)); } }
    }
};
template <class Epi, class Sched, bool ALIGN_EPI = false, bool SP2 = false, bool GATHER = false>
__device__ __forceinline__ void gemm_phase(PG8_LAS unsigned char* lds, const Gemm g, const Sched& S, const Epi& E) {
    int tid_ = threadIdx.x; asm volatile("" : "+v"(tid_));
    const int tid = tid_, wid = __builtin_amdgcn_readfirstlane(tid >> 6), lane = tid & 63, wr = wid >> 2, wc = wid & 3, fr = lane & 15, fq = lane >> 4;
    const int K = g.K, nt = K / BK;
    unsigned voffA[2], voffB[2], vA0[2], vA1[2], vN0[2], vN1[2]; int Rr_[2], Cc_[2];
#pragma unroll
    for (int i = 0; i < 2; ++i) { int R, C; stage_rc(tid * 16 + i * 8192, R, C); const int Rb = Epi::PERM ? ((R & ~31) + perm32(R & 31)) : R;
        voffA[i] = (unsigned)(R * K + C) * 2u; voffB[i] = (unsigned)(Rb * K + C) * 2u; Rr_[i] = R; Cc_[i] = C; }
    const size_t kstep = (size_t)(BK * 2);
    const size_t hstep = (size_t)HALF * K * 2;
    const size_t tstep = 2 * hstep;
#pragma unroll
    for (int i = 0; i < 2; ++i) { vA0[i] = voffA[i]; vA1[i] = voffA[i] + (unsigned)hstep; vN0[i] = vA0[i]; vN1[i] = vA1[i]; }
#define PG8_GLOAD(u, v0, v1) do { _Pragma("unroll") for (int _i = 0; _i < 2; ++_i) { const int _t0 = S.rowtok[(u).pm * BM + Rr_[_i]], _t1 = S.rowtok[(u).pm * BM + HALF + Rr_[_i]]; \
        (v0)[_i] = (unsigned)_t0 * (unsigned)(K * 2) + (unsigned)(Cc_[_i] * 2); (v1)[_i] = (unsigned)_t1 * (unsigned)(K * 2) + (unsigned)(Cc_[_i] * 2); } } while (0)
    const unsigned ldsw = (unsigned)wid * 1024u;
    const int aoff = lds_byte(wr * 64 + fr, fq * 8), boff = lds_byte(wc * 32 + fr, fq * 8);
#define PG8_SA(b, h) (((b) * 2 + (h)) * HTB)
#define PG8_SB(b, h) ((4 + (b) * 2 + (h)) * HTB)
#define PG8_STAGE(bufoff, gbase, voff) do { _Pragma("unroll") for (int _i = 0; _i < 2; ++_i) \
        __builtin_amdgcn_global_load_lds((const unsigned*)((const char*)(gbase) + (voff)[_i]), (PG8_LAS unsigned*)(lds + (bufoff) + ldsw + _i * 8192), 16, 0, 0); } while (0)
#define PG8_LDA(dst, b, h) do { _Pragma("unroll") for (int m = 0; m < 4; ++m) _Pragma("unroll") for (int k = 0; k < 2; ++k) dst[m][k] = *(const PG8_LAS bf16x8*)(lds + PG8_SA(b, h) + aoff + m * 2048 + k * 1024); } while (0)
#define PG8_LDB(dst, b, h) do { _Pragma("unroll") for (int n = 0; n < 2; ++n) _Pragma("unroll") for (int k = 0; k < 2; ++k) dst[n][k] = *(const PG8_LAS bf16x8*)(lds + PG8_SB(b, h) + boff + n * 2048 + k * 1024); } while (0)
#define PG8_MMA(ai, bj, At, Bt) do { __builtin_amdgcn_s_setprio(1); _Pragma("unroll") for (int m = 0; m < 4; ++m) _Pragma("unroll") for (int n = 0; n < 2; ++n) _Pragma("unroll") for (int k = 0; k < 2; ++k) \
        acc[ai][bj][m][n] = __builtin_amdgcn_mfma_f32_16x16x32_bf16(Bt[n][k], At[m][k], acc[ai][bj][m][n], 0, 0, 0); __builtin_amdgcn_s_setprio(0); } while (0)
#define PG8_WAIT_V(n) asm volatile("s_waitcnt vmcnt(" #n ")" ::: "memory")
#define PG8_WAIT_L(n) asm volatile("s_waitcnt lgkmcnt(" #n ")" ::: "memory")
#define PG8_BAR __builtin_amdgcn_s_barrier()
#define PG8_SCHED __builtin_amdgcn_sched_barrier(0)
    Unit cur, nxt; int ui = 0;
    if (!S.next(0, cur)) return;
    f32x4 acc[2][2][4][2];
#pragma unroll
    for (int a = 0; a < 2; ++a)
#pragma unroll
        for (int b = 0; b < 2; ++b)
#pragma unroll
            for (int m = 0; m < 4; ++m)
#pragma unroll
                for (int n = 0; n < 2; ++n) acc[a][b][m][n] = (f32x4){0.f, 0.f, 0.f, 0.f};
    bf16x8 At[4][2], B0[2][2], B1[2][2];
    if constexpr (GATHER) PG8_GLOAD(cur, vA0, vA1);
    const char* cA = GATHER ? (const char*)g.A : (const char*)g.A + (size_t)cur.pm * tstep; const char* cB = (const char*)g.Bt + (size_t)cur.pn * tstep;
    S.a_ready(cur);
    if constexpr (SP2) {
        PG8_STAGE(PG8_SB(0, 0), cB, voffB); PG8_STAGE(PG8_SB(0, 1), cB + hstep, voffB); PG8_STAGE(PG8_SA(0, 0), cA, vA0); PG8_STAGE(PG8_SA(0, 1), cA, vA1);
        if (wr == 1) PG8_BAR;
        PG8_WAIT_V(2); PG8_BAR;
        PG8_STAGE(PG8_SB(1, 0), cB + kstep, voffB); PG8_STAGE(PG8_SA(1, 0), cA + kstep, vA0); PG8_STAGE(PG8_SB(1, 1), cB + hstep + kstep, voffB);
        PG8_WAIT_V(6); PG8_BAR;
    } else {
        PG8_STAGE(PG8_SB(0, 0), cB, voffB); PG8_STAGE(PG8_SA(0, 0), cA, vA0); PG8_STAGE(PG8_SB(0, 1), cB + hstep, voffB); PG8_STAGE(PG8_SA(0, 1), cA, vA1);
        if (wr == 1) PG8_BAR;
        PG8_WAIT_V(4); PG8_BAR;
        PG8_STAGE(PG8_SB(1, 0), cB + kstep, voffB); PG8_STAGE(PG8_SA(1, 0), cA + kstep, vA0); PG8_STAGE(PG8_SB(1, 1), cB + hstep + kstep, voffB);
        PG8_WAIT_V(6); PG8_BAR;
    }
    for (;;) {
        const bool has_next = S.next(ui + 1, nxt);
        if constexpr (GATHER) { if (has_next) PG8_GLOAD(nxt, vN0, vN1); else { _Pragma("unroll") for (int i = 0; i < 2; ++i) { vN0[i] = vA0[i]; vN1[i] = vA1[i]; } } }
        const char* nA = GATHER ? (const char*)g.A : (has_next ? (const char*)g.A + (size_t)nxt.pm * tstep : cA); const char* nB = has_next ? (const char*)g.Bt + (size_t)nxt.pn * tstep : cB;
        for (int t = 0; t < nt; t += 2) {
            const bool last = (t == nt - 2);
            const char* a1 = cA + (size_t)(t + 1) * kstep;
            const char* a2 = last ? nA : cA + (size_t)(t + 2) * kstep; const char* b2 = last ? nB : cB + (size_t)(t + 2) * kstep;
            const char* a3 = a2 + kstep; const char* b3 = b2 + kstep;
            unsigned vX0[2], vX1[2];
#pragma unroll
            for (int i = 0; i < 2; ++i) { vX0[i] = (GATHER && last) ? vN0[i] : vA0[i]; vX1[i] = (GATHER && last) ? vN1[i] : vA1[i]; }
            if (last && has_next) S.a_ready(nxt);
            if constexpr (SP2) {
            PG8_LDB(B0, 0, 0); PG8_LDB(B1, 0, 1); PG8_SCHED; PG8_LDA(At, 0, 0); PG8_STAGE(PG8_SA(1, 1), a1, vA1);
            PG8_WAIT_V(8); PG8_WAIT_L(0); PG8_BAR; PG8_MMA(0, 0, At, B0); PG8_MMA(0, 1, At, B1); PG8_BAR; PG8_SCHED;
            PG8_LDA(At, 0, 1); PG8_STAGE(PG8_SB(0, 0), b2, voffB); PG8_STAGE(PG8_SB(0, 1), b2 + hstep, voffB); PG8_STAGE(PG8_SA(0, 0), a2, vX0);
            PG8_WAIT_V(8); PG8_WAIT_L(0); PG8_BAR; PG8_MMA(1, 0, At, B0); PG8_MMA(1, 1, At, B1); PG8_BAR; PG8_SCHED;
            PG8_LDB(B0, 1, 0); PG8_LDB(B1, 1, 1); PG8_SCHED; PG8_LDA(At, 1, 0); PG8_STAGE(PG8_SA(0, 1), a2, vX1);
            PG8_WAIT_V(8); PG8_WAIT_L(0); PG8_BAR; PG8_MMA(0, 0, At, B0); PG8_MMA(0, 1, At, B1); PG8_BAR; PG8_SCHED;
            PG8_LDA(At, 1, 1); PG8_STAGE(PG8_SB(1, 0), b3, voffB); PG8_STAGE(PG8_SB(1, 1), b3 + hstep, voffB); PG8_STAGE(PG8_SA(1, 0), a3, vX0);
            PG8_WAIT_V(8); PG8_WAIT_L(0); PG8_BAR; PG8_MMA(1, 0, At, B0); PG8_MMA(1, 1, At, B1); PG8_BAR; PG8_SCHED;
            } else {
            PG8_LDB(B0, 0, 0); PG8_SCHED; PG8_LDA(At, 0, 0); PG8_STAGE(PG8_SA(1, 1), a1, vA1);
            PG8_WAIT_L(8); PG8_BAR; PG8_WAIT_L(0); PG8_MMA(0, 0, At, B0); PG8_BAR; PG8_SCHED;
            PG8_LDB(B1, 0, 1); PG8_STAGE(PG8_SB(0, 0), b2, voffB);
            PG8_BAR; PG8_WAIT_L(0); PG8_MMA(0, 1, At, B1); PG8_BAR;
            PG8_LDA(At, 0, 1); PG8_STAGE(PG8_SA(0, 0), a2, vX0);
            PG8_BAR; PG8_WAIT_L(0); PG8_MMA(1, 0, At, B0); PG8_BAR; PG8_SCHED;
            PG8_STAGE(PG8_SB(0, 1), b2 + hstep, voffB);
            PG8_WAIT_V(6); PG8_BAR; PG8_MMA(1, 1, At, B1); PG8_BAR;
            PG8_LDB(B0, 1, 0); PG8_SCHED; PG8_LDA(At, 1, 0); PG8_STAGE(PG8_SA(0, 1), a2, vX1);
            PG8_WAIT_L(8); PG8_BAR; PG8_WAIT_L(0); PG8_MMA(0, 0, At, B0); PG8_BAR; PG8_SCHED;
            PG8_LDB(B1, 1, 1); PG8_STAGE(PG8_SB(1, 0), b3, voffB);
            PG8_BAR; PG8_WAIT_L(0); PG8_MMA(0, 1, At, B1); PG8_BAR;
            PG8_LDA(At, 1, 1); PG8_STAGE(PG8_SA(1, 0), a3, vX0);
            PG8_BAR; PG8_WAIT_L(0); PG8_MMA(1, 0, At, B0); PG8_BAR; PG8_SCHED;
            PG8_STAGE(PG8_SB(1, 1), b3 + hstep, voffB);
            PG8_WAIT_V(6); PG8_BAR; PG8_MMA(1, 1, At, B1); PG8_BAR;
            }
        }
        if constexpr (ALIGN_EPI) { if (wr == 0) PG8_BAR; }
        if constexpr (!Epi::AFTER_DRAIN) { E(acc, cur, wr, wc, fr, fq); S.done(cur); }
        if (!has_next) break;
#pragma unroll
        for (int a = 0; a < 2; ++a)
#pragma unroll
            for (int b = 0; b < 2; ++b)
#pragma unroll
                for (int m = 0; m < 4; ++m)
#pragma unroll
                    for (int n = 0; n < 2; ++n) acc[a][b][m][n] = (f32x4){0.f, 0.f, 0.f, 0.f};
        cur = nxt; cA = nA; cB = nB; ++ui;
        if constexpr (GATHER) { _Pragma("unroll") for (int i = 0; i < 2; ++i) { vA0[i] = vN0[i]; vA1[i] = vN1[i]; } }
        if constexpr (ALIGN_EPI) { if (wr == 1) PG8_BAR; }
    }
    PG8_WAIT_V(0);
    if constexpr (!ALIGN_EPI) { if (wr == 0) PG8_BAR; }
    PG8_BAR;
    if constexpr (Epi::AFTER_DRAIN) { E.fused(acc, cur, wr, wc, fr, fq, lds, wid, lane); S.done(cur); }
#undef PG8_SA
#undef PG8_SB
#undef PG8_STAGE
#undef PG8_GLOAD
#undef PG8_LDA
#undef PG8_LDB
#undef PG8_MMA
#undef PG8_WAIT_V
#undef PG8_WAIT_L
#undef PG8_BAR
#undef PG8_SCHED
}
}
namespace pg8 {
__device__ __forceinline__ float bf_lo(unsigned w) { return __builtin_bit_cast(float, w << 16); }
__device__ __forceinline__ float bf_hi(unsigned w) { return __builtin_bit_cast(float, w & 0xffff0000u); }
__device__ __forceinline__ float sigmoid_f(float x) { return __builtin_amdgcn_rcpf(1.0f + __expf(-x)); }

template <bool ADD> struct EpiGate {
    static constexpr bool PERM = true, AFTER_DRAIN = false;
    const bf16_t* G; const bf16_t* Min; bf16_t* O;
    __device__ __forceinline__ void operator()(const f32x4 (&acc)[2][2][4][2], const Unit& u, int wr, int wc, int fr, int fq) const {
        const int row0 = u.pm * BM + wr * 64 + fr, col0 = u.pn * BM + wc * 32 + 8 * fq;
#pragma unroll
        for (int ai = 0; ai < 2; ++ai)
#pragma unroll
            for (int m = 0; m < 4; ++m) { const size_t off = (size_t)(row0 + ai * HALF + m * 16) * 1024 + col0;
#pragma unroll
                for (int bj = 0; bj < 2; ++bj) {
                    const u32x4 g = *(const u32x4*)(G + off + bj * HALF);
                    f32x4 v0 = acc[ai][bj][m][0], v1 = acc[ai][bj][m][1];
                    v0[0] *= sigmoid_f(bf_lo(g.x)); v0[1] *= sigmoid_f(bf_hi(g.x)); v0[2] *= sigmoid_f(bf_lo(g.y)); v0[3] *= sigmoid_f(bf_hi(g.y));
                    v1[0] *= sigmoid_f(bf_lo(g.z)); v1[1] *= sigmoid_f(bf_hi(g.z)); v1[2] *= sigmoid_f(bf_lo(g.w)); v1[3] *= sigmoid_f(bf_hi(g.w));
                    if (ADD) { const u32x4 p = *(const u32x4*)(Min + off + bj * HALF);
                        v0[0] += bf_lo(p.x); v0[1] += bf_hi(p.x); v0[2] += bf_lo(p.y); v0[3] += bf_hi(p.y);
                        v1[0] += bf_lo(p.z); v1[1] += bf_hi(p.z); v1[2] += bf_lo(p.w); v1[3] += bf_hi(p.w); }
                    u32x4 w; w.x = cvt_pk_bf16(v0[0], v0[1]); w.y = cvt_pk_bf16(v0[2], v0[3]); w.z = cvt_pk_bf16(v1[0], v1[1]); w.w = cvt_pk_bf16(v1[2], v1[3]);
                    __builtin_nontemporal_store(w, (u32x4*)(O + off + bj * HALF)); } }
    }
};

struct EpiResid {
    static constexpr bool PERM = false, AFTER_DRAIN = false;
    const float* X; const float* gate; float* out; int rows_per_batch; int gstride;
    __device__ __forceinline__ void operator()(const f32x4 (&acc)[2][2][4][2], const Unit& u, int wr, int wc, int fr, int fq) const {
        const int col0 = u.pn * BM + wc * 32 + 4 * fq;
#pragma unroll
        for (int ai = 0; ai < 2; ++ai)
#pragma unroll
            for (int m = 0; m < 4; ++m) { const int row = u.pm * BM + ai * HALF + wr * 64 + m * 16 + fr; const size_t off = (size_t)row * 1024 + col0;
                const float* gp = gate + (size_t)(row / rows_per_batch) * gstride + col0;
#pragma unroll
                for (int bj = 0; bj < 2; ++bj)
#pragma unroll
                    for (int n = 0; n < 2; ++n) { const f32x4 xv = *(const f32x4*)(X + off + bj * HALF + n * 16); const f32x4 gv = *(const f32x4*)(gp + bj * HALF + n * 16);
                        *(f32x4*)(out + off + bj * HALF + n * 16) = xv + gv * acc[ai][bj][m][n]; } }
    }
};

__device__ __forceinline__ float swiglu1(float g, float l) {
    g = fminf(g, 7.0f); l = fminf(fmaxf(l, -7.0f), 7.0f);
    return (l + 1.0f) * (g * __builtin_amdgcn_rcpf(1.0f + __expf(-1.702f * g)));
}
struct EpiSwiglu {
    static constexpr bool PERM = true, AFTER_DRAIN = false;
    const float* b1; bf16_t* O;
    __device__ __forceinline__ void operator()(const f32x4 (&acc)[2][2][4][2], const Unit& u, int wr, int wc, int fr, int fq) const {
        const int e = u.pn >> 3, pl = u.pn & 7, jc = wc * 32 + 8 * fq;
        const float* bg = b1 + (size_t)e * 2048 + 128 * pl + jc; const float* bl = bg + 1024;
        const f32x4 bg0 = *(const f32x4*)bg, bg1 = *(const f32x4*)(bg + 4), bl0 = *(const f32x4*)bl, bl1 = *(const f32x4*)(bl + 4);
        const int row0 = u.pm * BM + wr * 64 + fr;
#pragma unroll
        for (int ai = 0; ai < 2; ++ai)
#pragma unroll
            for (int m = 0; m < 4; ++m) {
                const f32x4 g0 = acc[ai][0][m][0] + bg0, g1 = acc[ai][0][m][1] + bg1, l0 = acc[ai][1][m][0] + bl0, l1 = acc[ai][1][m][1] + bl1;
                u32x4 w; w.x = cvt_pk_bf16(swiglu1(g0[0], l0[0]), swiglu1(g0[1], l0[1])); w.y = cvt_pk_bf16(swiglu1(g0[2], l0[2]), swiglu1(g0[3], l0[3]));
                w.z = cvt_pk_bf16(swiglu1(g1[0], l1[0]), swiglu1(g1[1], l1[1])); w.w = cvt_pk_bf16(swiglu1(g1[2], l1[2]), swiglu1(g1[3], l1[3]));
                __builtin_nontemporal_store(w, (u32x4*)(O + (size_t)(row0 + ai * HALF + m * 16) * 1024 + 128 * pl + jc)); }
    }
};

struct GroupedOrder {
    const PG8_LAS int* ts; int NT, G, c; const int* rowtok;
    __device__ __forceinline__ bool next(int i, Unit& u) const {
        const int total = __builtin_amdgcn_readfirstlane(ts[32]) * NT; const long L = (long)i * G + c; if (L >= total) return false;
        const int pm = (int)L / NT, pl = (int)L % NT; int e = 0;
#pragma unroll 1
        for (int j = 1; j < 32; ++j) e += (pm >= ts[j]) ? 1 : 0;
        u.pm = __builtin_amdgcn_readfirstlane(pm); u.pn = __builtin_amdgcn_readfirstlane(e * NT + pl); return true;
    }
    __device__ __forceinline__ void a_ready(const Unit&) const {}
    __device__ __forceinline__ void done(const Unit&) const {}
};
}
#define GAS __attribute__((address_space(1)))
#define LAS __attribute__((address_space(3)))
typedef unsigned short bf16;
typedef unsigned v4u __attribute__((ext_vector_type(4)));
typedef float f32x4 __attribute__((ext_vector_type(4)));
typedef short bf16x8 __attribute__((ext_vector_type(8)));
typedef GAS unsigned gu32;
typedef GAS unsigned long long gu64;
#define RLX_AGENT __ATOMIC_RELAXED, __HIP_MEMORY_SCOPE_AGENT
#define LDS_WAIT() asm volatile("s_waitcnt lgkmcnt(0)" ::: "memory")
#define VM_WAIT() asm volatile("s_waitcnt vmcnt(0)" ::: "memory")
__device__ __forceinline__ unsigned long long rt() { return __builtin_amdgcn_s_memrealtime(); }
__device__ __forceinline__ unsigned f2bf(float f) { unsigned u = __builtin_bit_cast(unsigned, f); return (u + 0x7fffu + ((u >> 16) & 1u)) >> 16; }
typedef float f32x2_pk __attribute__((ext_vector_type(2))); typedef __bf16 bf16x2_pk __attribute__((ext_vector_type(2)));
__device__ __forceinline__ unsigned pk2(float lo, float hi) { const f32x2_pk v = {lo, hi}; return __builtin_bit_cast(unsigned, __builtin_convertvector(v, bf16x2_pk)); }

#define XB_TMO      128
#define XB_XCNT(j)  (256  + 64 * (j))
#define XB_XSUB(j)  (1280 + 64 * (j))
#define XB_XGEN(j)  (2304 + 64 * (j))
#define XB_TOP      3328
#define XB_TOPGEN   3392
#define XCD_BAR_WORDS 3456
#define XB_SPIN_CAP (1u << 18)

__device__ __forceinline__ unsigned xb_ld(unsigned* p)              { return __hip_atomic_load(p, __ATOMIC_RELAXED, __HIP_MEMORY_SCOPE_AGENT); }
__device__ __forceinline__ unsigned xb_add(unsigned* p, unsigned v) { return __hip_atomic_fetch_add(p, v, __ATOMIC_RELAXED, __HIP_MEMORY_SCOPE_AGENT); }
__device__ __forceinline__ unsigned xb_xcc_id() { return (unsigned)__builtin_amdgcn_s_getreg((3 << 11) | 20) & 0xFu; }
#define XB_SPIN(cond, bar) do { unsigned _sp = 0; while (cond) { __builtin_amdgcn_s_sleep(1); \
    if ((++_sp & 255u) == 0u) { if (xb_ld(&(bar)[XB_TMO])) break; if (_sp > XB_SPIN_CAP) { atomicAdd(&(bar)[XB_TMO], 1u); break; } } } } while (0)

struct XcdBarrier {
    unsigned* bar; unsigned x;
    volatile LAS unsigned* st;
};

__device__ __forceinline__ XcdBarrier xcd_barrier_post(unsigned* bar, volatile LAS unsigned* st) {
    XcdBarrier b; b.bar = bar; b.x = xb_xcc_id(); b.st = st;
    if (threadIdx.x == 0) (void)xb_add(&bar[XB_XCNT(b.x)], 1u);
    return b;
}
__device__ __forceinline__ void xcd_barrier_complete(unsigned* bar, unsigned x, unsigned& nloc, unsigned& nx) {
    const unsigned G = gridDim.x * gridDim.y * gridDim.z;
    unsigned sum, cnt, mine, sp = 0u;
    for (;;) {
        sum = 0u; cnt = 0u; mine = 0u;
#pragma unroll
        for (unsigned j = 0; j < 16; ++j) { const unsigned c = xb_ld(&bar[XB_XCNT(j)]); sum += c; cnt += (c > 0u) ? 1u : 0u; mine = (j == x) ? c : mine; }
        if (sum == G) break;
        __builtin_amdgcn_s_sleep(1);
        if ((++sp & 255u) == 0u) { if (xb_ld(&bar[XB_TMO])) break; if (sp > XB_SPIN_CAP) { atomicAdd(&bar[XB_TMO], 1u); break; } }
    }
    nloc = mine > 0u ? mine : 1u; nx = cnt > 0u ? cnt : 1u;
}

__device__ __forceinline__ void xcd_barrier(const XcdBarrier& b) {
    asm volatile("s_waitcnt vmcnt(0)" ::: "memory");
    __syncthreads();
    if (threadIdx.x == 0) {
        unsigned* bar = b.bar;
        __builtin_amdgcn_s_waitcnt(0);
        unsigned nloc = b.st[0], nx = b.st[1];
        if (nloc == 0u) { xcd_barrier_complete(bar, b.x, nloc, nx); b.st[0] = nloc; b.st[1] = nx; }
        const unsigned old = xb_add(&bar[XB_XSUB(b.x)], 1u);
        const unsigned gen = old / nloc;
        if (old + 1u == (gen + 1u) * nloc) {
            __builtin_amdgcn_fence(__ATOMIC_RELEASE, "agent");
            asm volatile("s_waitcnt vmcnt(0)" ::: "memory");
            const unsigned og = xb_add(&bar[XB_TOP], 1u);
            const unsigned tg = og / nx;
            if (og + 1u == (tg + 1u) * nx) xb_add(&bar[XB_TOPGEN], 1u);
            else XB_SPIN(xb_ld(&bar[XB_TOPGEN]) == tg, bar);
            __builtin_amdgcn_fence(__ATOMIC_ACQUIRE, "agent");
            xb_add(&bar[XB_XGEN(b.x)], 1u);
            asm volatile("s_waitcnt vmcnt(0)" ::: "memory");
        } else {
            XB_SPIN(xb_ld(&bar[XB_XGEN(b.x)]) == gen, bar);
            __builtin_amdgcn_fence(__ATOMIC_ACQUIRE, "agent");
            asm volatile("s_waitcnt vmcnt(0)" ::: "memory");
        }
    }
    __syncthreads();
}

constexpr int NWAVES = 8;
constexpr int BATCH = 16, SEQ = 2048, D = 1024, T = BATCH * SEQ;
constexpr int NIN = 9224, NPROJ = 9216, NMOD = 6 * D;
constexpr int NE = 32, TOPK = 4;
constexpr int XS_ROWS = T * TOPK + NE * 256;
constexpr float EPS = 1e-6f;
constexpr float ATT_RTHR = -120.0f;
constexpr float QSCALE = 0.125f * 1.4426950408889634f;

constexpr size_t MiB = 1u << 20;
constexpr size_t WS_CTL = 0, CTL_ZERO_BYTES = 1 * MiB;
constexpr size_t WS_MODP = 1 * MiB;
constexpr size_t WS_MOD = 3 * MiB;
constexpr size_t WS_IPRE = 4 * MiB, WS_LF = 4 * MiB + 512 * 1024;
constexpr size_t WS_TOKE = 5 * MiB, WS_TOKP = 5 * MiB + 512 * 1024, WS_TOKW = 6 * MiB, WS_TOKROW = 6 * MiB + 512 * 1024, WS_RSTD = 7 * MiB;
constexpr size_t WS_WIN = 8 * MiB, WS_WA = 26 * MiB, WS_WB = 28 * MiB, WS_WOUT = 30 * MiB, WS_W1 = 32 * MiB, WS_W2 = 160 * MiB;
constexpr size_t WS_H1 = 224 * MiB;
constexpr size_t WS_PROJ = 288 * MiB, SEG = 64 * MiB;
constexpr size_t WS_YB = 864 * MiB;
constexpr size_t WS_XS = 288 * MiB, WS_ACT = 560 * MiB;
constexpr size_t WS_ROW2TOK = 7 * MiB + 128 * 1024;
constexpr size_t WS_GT = 928 * MiB;
constexpr size_t WS_END = 932 * MiB;
static_assert(WS_XS + (size_t)XS_ROWS * 2048 <= WS_ACT && WS_ACT + (size_t)XS_ROWS * 2048 <= WS_YB, "ws map");
constexpr int CW_TMO = 0, CW_BAR = 4096, CW_ECNT = 8192;

constexpr int RING_BYTES = 131072, LDS_BYTES = 147456, LDSCTL_OFF = 146432;
constexpr int LC_BAR = 0, LC_TS = 16, LC_LCNT = 64, LC_GBASE = 96, LC_PS = 128, LC_CNT = 160;

__device__ __forceinline__ unsigned long long karg(int i) { return ((const __attribute__((address_space(4))) unsigned long long*)__builtin_amdgcn_kernarg_segment_ptr())[i]; }
struct Frame {
    LAS unsigned char* lds; volatile LAS unsigned* LC;
    gu32* ctl; unsigned char* ws; int tid, lane, wave, vcu, G;
    __device__ __forceinline__ const float* x() const { return (const float*)(const GAS float*)karg(0); }
    __device__ __forceinline__ const float* c() const { return (const float*)(const GAS float*)karg(1); }
    __device__ __forceinline__ const float* ada_w() const { return (const float*)(const GAS float*)karg(2); }
    __device__ __forceinline__ const float* ada_b() const { return (const float*)(const GAS float*)karg(3); }
    __device__ __forceinline__ const float* norm1_g() const { return (const float*)(const GAS float*)karg(4); }
    __device__ __forceinline__ const float* w_in() const { return (const float*)(const GAS float*)karg(5); }
    __device__ __forceinline__ const float* conv_w() const { return (const float*)(const GAS float*)karg(6); }
    __device__ __forceinline__ const float* conv_b() const { return (const float*)(const GAS float*)karg(7); }
    __device__ __forceinline__ const float* b_i() const { return (const float*)(const GAS float*)karg(8); }
    __device__ __forceinline__ const float* b_f() const { return (const float*)(const GAS float*)karg(9); }
    __device__ __forceinline__ const float* ml_norm_g() const { return (const float*)(const GAS float*)karg(10); }
    __device__ __forceinline__ const float* w_a() const { return (const float*)(const GAS float*)karg(11); }
    __device__ __forceinline__ const float* w_b() const { return (const float*)(const GAS float*)karg(12); }
    __device__ __forceinline__ const float* w_out() const { return (const float*)(const GAS float*)karg(13); }
    __device__ __forceinline__ const float* norm2_g() const { return (const float*)(const GAS float*)karg(14); }
    __device__ __forceinline__ const float* router_w() const { return (const float*)(const GAS float*)karg(15); }
    __device__ __forceinline__ const float* router_b() const { return (const float*)(const GAS float*)karg(16); }
    __device__ __forceinline__ const float* w1() const { return (const float*)(const GAS float*)karg(17); }
    __device__ __forceinline__ const float* b1() const { return (const float*)(const GAS float*)karg(18); }
    __device__ __forceinline__ const float* w2() const { return (const float*)(const GAS float*)karg(19); }
    __device__ __forceinline__ const float* b2() const { return (const float*)(const GAS float*)karg(20); }
    __device__ __forceinline__ const float* final_g() const { return (const float*)(const GAS float*)karg(21); }
    __device__ __forceinline__ float* out() const { return (float*)(GAS float*)karg(22); }
    __device__ __forceinline__ float* modp() const { return (float*)(ws + WS_MODP); }
    __device__ __forceinline__ float* mod() const { return (float*)(ws + WS_MOD); }
    __device__ __forceinline__ float* ipre() const { return (float*)(ws + WS_IPRE); }
    __device__ __forceinline__ float* lf() const { return (float*)(ws + WS_LF); }
    __device__ __forceinline__ float* tokw() const { return (float*)(ws + WS_TOKW); }
    __device__ __forceinline__ float* rstd2() const { return (float*)(ws + WS_RSTD); }
    __device__ __forceinline__ int* toke() const { return (int*)(ws + WS_TOKE); }
    __device__ __forceinline__ int* tokp() const { return (int*)(ws + WS_TOKP); }
    __device__ __forceinline__ int* tokrow() const { return (int*)(ws + WS_TOKROW); }
    __device__ __forceinline__ bf16* WIN_T() const { return (bf16*)(ws + WS_WIN); }
    __device__ __forceinline__ bf16* WA_T() const { return (bf16*)(ws + WS_WA); }
    __device__ __forceinline__ bf16* WB_T() const { return (bf16*)(ws + WS_WB); }
    __device__ __forceinline__ bf16* WOUT_T() const { return (bf16*)(ws + WS_WOUT); }
    __device__ __forceinline__ bf16* W1_T() const { return (bf16*)(ws + WS_W1); }
    __device__ __forceinline__ bf16* W2_T() const { return (bf16*)(ws + WS_W2); }
    __device__ __forceinline__ bf16* H1() const { return (bf16*)(ws + WS_H1); }
    __device__ __forceinline__ bf16* PROJ() const { return (bf16*)(ws + WS_PROJ); }
    __device__ __forceinline__ bf16* YA() const { return (bf16*)(ws + WS_H1); }
    __device__ __forceinline__ bf16* YB() const { return (bf16*)(ws + WS_YB); }
    __device__ __forceinline__ bf16* M1() const { return (bf16*)(ws + WS_PROJ); }
    __device__ __forceinline__ bf16* MERGED() const { return (bf16*)(ws + WS_PROJ + SEG); }
    __device__ __forceinline__ bf16* XS() const { return (bf16*)(ws + WS_XS); }
    __device__ __forceinline__ bf16* ACT() const { return (bf16*)(ws + WS_ACT); }
    __device__ __forceinline__ bf16* OUTR() const { return (bf16*)(ws + WS_XS); }
    __device__ __forceinline__ bf16* H2() const { return (bf16*)(ws + WS_XS); }
    __device__ __forceinline__ int* row2tok() const { return (int*)(ws + WS_ROW2TOK); }
    __device__ __forceinline__ float* gt() const { return (float*)(ws + WS_GT); }
};

__device__ __forceinline__ int opq(int v) { asm volatile("" : "+v"(v)); return v; }
__device__ __forceinline__ float wave_sum(float v) {
#pragma unroll
    for (int o = 1; o < 64; o <<= 1) v += __shfl_xor(v, o);
    return v;
}
__device__ __forceinline__ float bf2f(unsigned short b) { return __builtin_bit_cast(float, (unsigned)b << 16); }
__device__ __forceinline__ float bflo(unsigned w) { return __builtin_bit_cast(float, w << 16); }
__device__ __forceinline__ float bfhi(unsigned w) { return __builtin_bit_cast(float, w & 0xffff0000u); }
__device__ __forceinline__ float log_sigmoid_f(float x) { return fminf(x, 0.f) - log1pf(expf(-fabsf(x))); }

struct MapIn { __device__ __forceinline__ long operator()(int n) const { return n < 7168 ? (long)n : (n < 7176 ? -1L : (n < NIN ? (long)(n - 8) : -1L)); } };
struct MapId { long off; __device__ __forceinline__ long operator()(int n) const { return off + n; } };
struct MapW1 { int e; __device__ __forceinline__ long operator()(int n) const { return (long)e * 2048 + ((n & 1023) >> 7) * 256 + (n >> 10) * 128 + (n & 127); } };

template <class Map> __device__ __forceinline__ void transpose_item(const float* W, int K, int N, bf16* WT, LAS float* scr, int item, int lane, Map map) {
    const int nblk = (N + 31) / 32, kb = item / nblk, nb = item % nblk, k0 = 64 * kb, n0 = 32 * nb;
    const int n4 = 4 * (lane & 7), kr = lane >> 3;
    const bool ok = (n0 + n4 + 3) < N;
    f32x4 v[8];
#pragma unroll
    for (int i = 0; i < 8; ++i) v[i] = ok ? *(const f32x4*)(W + (size_t)(k0 + 8 * i + kr) * N + n0 + n4) : (f32x4){0.f, 0.f, 0.f, 0.f};
#pragma unroll
    for (int i = 0; i < 8; ++i) { LAS float* d = scr + (8 * i + kr) * 33 + n4; d[0] = v[i].x; d[1] = v[i].y; d[2] = v[i].z; d[3] = v[i].w; }
    LDS_WAIT(); asm volatile("" ::: "memory");
    const int c = lane & 7;
#pragma unroll
    for (int j = 0; j < 4; ++j) { const int n = (lane >> 3) + 8 * j; const LAS float* s = scr + (8 * c) * 33 + n;
        v4u o; o.x = pk2(s[0 * 33], s[1 * 33]); o.y = pk2(s[2 * 33], s[3 * 33]); o.z = pk2(s[4 * 33], s[5 * 33]); o.w = pk2(s[6 * 33], s[7 * 33]);
        const long dr = map(n0 + n);
        if (dr >= 0) *(GAS v4u*)(WT + (size_t)dr * K + k0 + 8 * c) = o; }
    LDS_WAIT(); asm volatile("" ::: "memory");
}
__device__ __forceinline__ void mod_item(Frame& F, const LAS float* sil, int it) {
    const int j = it % 96, kq = it / 96, n = 64 * j + F.lane, k0 = 256 * kq;
    float acc[16];
#pragma unroll
    for (int b = 0; b < 16; ++b) acc[b] = 0.f;
    const float* w = F.ada_w() + (size_t)k0 * NMOD + n;
    const LAS f32x4* s = (const LAS f32x4*)sil + k0 * 4;
    for (int kk = 0; kk < 256; kk += 8) {
        float wv[8];
#pragma unroll
        for (int u = 0; u < 8; ++u) wv[u] = w[(size_t)(kk + u) * NMOD];
#pragma unroll
        for (int u = 0; u < 8; ++u) {
#pragma unroll
            for (int q = 0; q < 4; ++q) { const f32x4 sv = s[(kk + u) * 4 + q]; acc[4 * q + 0] += sv.x * wv[u]; acc[4 * q + 1] += sv.y * wv[u]; acc[4 * q + 2] += sv.z * wv[u]; acc[4 * q + 3] += sv.w * wv[u]; }
        }
    }
    float* o = F.modp() + (size_t)kq * 16 * NMOD + n;
#pragma unroll
    for (int b = 0; b < 16; ++b) o[(size_t)b * NMOD] = acc[b];
}
__device__ __forceinline__ void p0_prologue(Frame& F) {
    LAS float* sil = (LAS float*)F.lds;
    for (int idx = F.tid; idx < 16384; idx += 512) { const int b = idx >> 10, k = idx & 1023; const float v = F.c()[idx]; sil[k * 16 + b] = v / (1.0f + __expf(-v)); }
    __syncthreads();
    LAS float* scr = (LAS float*)(F.lds + 65536 + F.wave * 8704);
    const int gw = F.vcu * NWAVES + F.wave, NGW = F.G * NWAVES;
    constexpr int I_MOD = 384, I_IN = 16 * 289, I_SQ = 16 * 32, I_W1 = 32 * 16 * 64, I_W2 = 32 * 16 * 32;
    constexpr int NITEMS = I_MOD + I_IN + 3 * I_SQ + I_W1 + I_W2;
    for (int it = gw; it < NITEMS; it += NGW) {
        int r = it;
        if (r < I_MOD) { mod_item(F, sil, r); continue; } r -= I_MOD;
        if (r < I_IN) { transpose_item(F.w_in(), D, NIN, F.WIN_T(), scr, r, F.lane, MapIn{}); continue; } r -= I_IN;
        if (r < I_SQ) { transpose_item(F.w_a(), D, D, F.WA_T(), scr, r, F.lane, MapId{0}); continue; } r -= I_SQ;
        if (r < I_SQ) { transpose_item(F.w_b(), D, D, F.WB_T(), scr, r, F.lane, MapId{0}); continue; } r -= I_SQ;
        if (r < I_SQ) { transpose_item(F.w_out(), D, D, F.WOUT_T(), scr, r, F.lane, MapId{0}); continue; } r -= I_SQ;
        if (r < I_W1) { const int e = r >> 10; transpose_item(F.w1() + (size_t)e * D * 2048, D, 2048, F.W1_T(), scr, r & 1023, F.lane, MapW1{e}); continue; } r -= I_W1;
        { const int e = r >> 9; transpose_item(F.w2() + (size_t)e * D * D, D, D, F.W2_T(), scr, r & 511, F.lane, MapId{(long)e * 1024}); }
    }
}

__device__ __forceinline__ void p1_rows(Frame& F) {
    const int row0 = F.vcu * 128, b = row0 / SEQ, lane = opq(F.lane);
    LAS float* wif = (LAS float*)F.lds;
    for (int idx = F.tid; idx < 8192; idx += 512) wif[idx] = F.w_in()[(size_t)(idx >> 3) * NIN + 7168 + (idx & 7)];
    for (int idx = F.vcu * 512 + F.tid; idx < 16 * NMOD; idx += F.G * 512) { float s = F.ada_b()[idx % NMOD];
#pragma unroll
        for (int kq = 0; kq < 4; ++kq) s += F.modp()[(size_t)kq * 16 * NMOD + idx];
        F.mod()[idx] = s; }
    f32x4 Av[4], Bv[4];
#pragma unroll
    for (int j = 0; j < 4; ++j) { const int col = 4 * lane + 256 * j;
        f32x4 sh = *(const f32x4*)(F.ada_b() + col), sc = *(const f32x4*)(F.ada_b() + D + col);
#pragma unroll
        for (int kq = 0; kq < 4; ++kq) { sh += *(const f32x4*)(F.modp() + ((size_t)kq * 16 + b) * NMOD + col); sc += *(const f32x4*)(F.modp() + ((size_t)kq * 16 + b) * NMOD + D + col); }
        const f32x4 g = *(const f32x4*)(F.norm1_g() + col); Av[j] = g * (sc + 1.0f); Bv[j] = sh; }
    __syncthreads();
    f32x4 nx[4];
    { const GAS f32x4* xr = (const GAS f32x4*)(F.x() + (size_t)(row0 + 16 * F.wave) * D) + lane;
#pragma unroll
      for (int j = 0; j < 4; ++j) nx[j] = xr[64 * j]; }
    for (int r = 0; r < 16; ++r) {
        const int row = row0 + 16 * F.wave + r;
        f32x4 v[4]; float ss = 0.f;
#pragma unroll
        for (int j = 0; j < 4; ++j) { v[j] = nx[j]; ss += (v[j].x * v[j].x + v[j].y * v[j].y) + (v[j].z * v[j].z + v[j].w * v[j].w); }
        if (r < 15) { const GAS f32x4* xr = (const GAS f32x4*)(F.x() + (size_t)(row + 1) * D) + lane;
#pragma unroll
            for (int j = 0; j < 4; ++j) nx[j] = xr[64 * j]; }
        const float rstd = 1.0f / sqrtf(wave_sum(ss) * (1.0f / D) + EPS);
        GAS unsigned long long* o8 = (GAS unsigned long long*)(F.H1() + (size_t)row * D) + lane;
        float p[8];
#pragma unroll
        for (int q = 0; q < 8; ++q) p[q] = 0.f;
#pragma unroll
        for (int j = 0; j < 4; ++j) { v[j] = v[j] * rstd * Av[j] + Bv[j];
            o8[64 * j] = (unsigned long long)pk2(v[j].x, v[j].y) | ((unsigned long long)pk2(v[j].z, v[j].w) << 32);
#pragma unroll
            for (int i = 0; i < 4; ++i) { const LAS f32x4* wp = (const LAS f32x4*)(wif + (4 * lane + 256 * j + i) * 8); const f32x4 w0 = wp[0], w1 = wp[1]; const float hv = v[j][i];
                p[0] += hv * w0.x; p[1] += hv * w0.y; p[2] += hv * w0.z; p[3] += hv * w0.w; p[4] += hv * w1.x; p[5] += hv * w1.y; p[6] += hv * w1.z; p[7] += hv * w1.w; } }
#pragma unroll
        for (int q = 0; q < 8; ++q) p[q] = wave_sum(p[q]);
        if (lane == 0) { const int t = row % SEQ;
#pragma unroll
            for (int hh = 0; hh < 4; ++hh) { F.ipre()[((size_t)b * 4 + hh) * SEQ + t] = p[hh] + F.b_i()[hh]; F.lf()[((size_t)b * 4 + hh) * SEQ + t] = log_sigmoid_f(p[4 + hh] + F.b_f()[hh]); } }
    }
}

__device__ __forceinline__ void attn_naive_item(Frame& F, int bh, int qblk) {
    const int b = bh >> 4, hd = bh & 15, t = qblk * 512 + F.tid;
    const bf16* Q = F.PROJ(); const bf16* K = F.PROJ() + SEG / 2; const bf16* V = F.PROJ() + SEG;
    const size_t rowb = (size_t)b * SEQ;
    float q[64], o[64];
    { const v4u* qp = (const v4u*)(Q + (rowb + t) * D + hd * 64);
#pragma unroll
      for (int i = 0; i < 8; ++i) { const v4u w = qp[i]; q[8 * i + 0] = bflo(w.x); q[8 * i + 1] = bfhi(w.x); q[8 * i + 2] = bflo(w.y); q[8 * i + 3] = bfhi(w.y); q[8 * i + 4] = bflo(w.z); q[8 * i + 5] = bfhi(w.z); q[8 * i + 6] = bflo(w.w); q[8 * i + 7] = bfhi(w.w); } }
#pragma unroll
    for (int i = 0; i < 64; ++i) o[i] = 0.f;
    float R = 0.f;
    LAS v4u* kt = (LAS v4u*)F.lds; LAS v4u* vt = (LAS v4u*)(F.lds + 8192);
    const int tmax_wave = qblk * 512 + F.wave * 64 + 63;
    bool wdone = false;
    LAS volatile int* dflag = (LAS volatile int*)(F.lds + 16384);
    if (F.tid < 8) dflag[F.tid] = 0;
    for (int tile = qblk * 8 + 7; tile >= 0; --tile) {
        __syncthreads();
        { int nd = 0;
#pragma unroll
          for (int w = 0; w < 8; ++w) nd += dflag[w];
          if (nd == 8) break; }
        { const int kr = F.tid >> 3, ch = F.tid & 7; const size_t g = (rowb + tile * 64 + kr) * D + hd * 64 + ch * 8;
          kt[F.tid] = *(const v4u*)(K + g); vt[F.tid] = *(const v4u*)(V + g); }
        __syncthreads();
        if (tile * 64 >= tmax_wave) continue;
        if (wdone) continue;
        for (int s = 63; s >= 0; --s) {
            const int key = tile * 64 + s;
            float z = 0.f;
#pragma unroll
            for (int i = 0; i < 8; ++i) { const v4u w = kt[s * 8 + i]; z += q[8 * i + 0] * bflo(w.x) + q[8 * i + 1] * bfhi(w.x) + q[8 * i + 2] * bflo(w.y) + q[8 * i + 3] * bfhi(w.y) + q[8 * i + 4] * bflo(w.z) + q[8 * i + 5] * bfhi(w.z) + q[8 * i + 6] * bflo(w.w) + q[8 * i + 7] * bfhi(w.w); }
            const float lb = fminf(z, 0.f) - __builtin_amdgcn_logf(1.0f + __builtin_amdgcn_exp2f(-fabsf(z)));
            const bool act = key < t;
            const float a = act ? __builtin_amdgcn_exp2f(lb + R) : 0.f;
            R += act ? (lb - z) : 0.f;
#pragma unroll
            for (int i = 0; i < 8; ++i) { const v4u w = vt[s * 8 + i]; o[8 * i + 0] += a * bflo(w.x); o[8 * i + 1] += a * bfhi(w.x); o[8 * i + 2] += a * bflo(w.y); o[8 * i + 3] += a * bfhi(w.y); o[8 * i + 4] += a * bflo(w.z); o[8 * i + 5] += a * bfhi(w.z); o[8 * i + 6] += a * bflo(w.w); o[8 * i + 7] += a * bfhi(w.w); }
        }
        if (__all(R < ATT_RTHR) && !wdone) { wdone = true; if (F.lane == 0) dflag[F.wave] = 1; }
    }
    __syncthreads();
    v4u* op = (v4u*)(F.YA() + (rowb + t) * D + hd * 64);
#pragma unroll
    for (int i = 0; i < 8; ++i) { v4u w; w.x = pk2(o[8 * i + 0], o[8 * i + 1]); w.y = pk2(o[8 * i + 2], o[8 * i + 3]); w.z = pk2(o[8 * i + 4], o[8 * i + 5]); w.w = pk2(o[8 * i + 6], o[8 * i + 7]); op[i] = w; }
}

__device__ __forceinline__ void mlstm_naive_item(Frame& F, int bh) {
    const int b = bh >> 2, hh = bh & 3, tid = opq(F.tid), e = tid & 255, half = tid >> 8;
    const bf16* MLQ = F.PROJ() + 3 * (SEG / 2); const bf16* MLK = F.PROJ() + 4 * (SEG / 2); const bf16* MLV = F.PROJ() + 5 * (SEG / 2); const bf16* MLO = F.PROJ() + 6 * (SEG / 2);
    LAS float* ql = (LAS float*)F.lds; LAS float* kl = ql + 8192; LAS float* vl = kl + 8192; LAS float* hl = vl + 8192;
    LAS float* part = hl + 8192;
    LAS float* red = part + 512;
    LAS float* il = red + 8; LAS float* fl = il + 32;
    const size_t rowb = (size_t)b * SEQ;
    float C[128];
#pragma unroll
    for (int i = 0; i < 128; ++i) C[i] = 0.f;
    float nreg = 0.f, m = 0.f;
    float cw[2][4], cb[2];
    { const int c = tid & 255;
#pragma unroll
      for (int z = 0; z < 2; ++z) { const int ch = z * 1024 + hh * 256 + c; cb[z] = F.conv_b()[ch];
#pragma unroll
          for (int tap = 0; tap < 4; ++tap) cw[z][tap] = F.conv_w()[tap * 2048 + ch]; } }
    for (int chunk = 0; chunk < SEQ / 32; ++chunk) {
        const int t0 = chunk * 32;
        __syncthreads();
        { const int c = tid & 255;
          for (int u = 0; u < 16; ++u) { const int tt = (tid >> 8) + 2 * u, t = t0 + tt; float yq = cb[0], yk = cb[1];
#pragma unroll
              for (int tap = 0; tap < 4; ++tap) { const int ts = t - 3 + tap; if (ts >= 0) { const size_t g = (rowb + ts) * D + hh * 256 + c; yq += cw[0][tap] * bf2f(MLQ[g]); yk += cw[1][tap] * bf2f(MLK[g]); } }
              ql[tt * 256 + c] = yq / (1.0f + __expf(-yq)); kl[tt * 256 + c] = (yk / (1.0f + __expf(-yk))) * 0.0625f;
              vl[tt * 256 + c] = bf2f(MLV[(rowb + t) * D + hh * 256 + c]); }
          if (tid < 32) { il[tid] = F.ipre()[((size_t)b * 4 + hh) * SEQ + t0 + tid]; fl[tid] = F.lf()[((size_t)b * 4 + hh) * SEQ + t0 + tid]; } }
        __syncthreads();
        for (int tt = 0; tt < 32; ++tt) {
            const float lfv = fl[tt], iv = il[tt];
            const float mn = fmaxf(lfv + m, iv), fp = __expf(lfv + m - mn), ip = __expf(iv - mn); m = mn;
            const float vv = vl[tt * 256 + e] * ip;
            const LAS f32x4* kq = (const LAS f32x4*)(kl + tt * 256 + 128 * half); const LAS f32x4* qq = (const LAS f32x4*)(ql + tt * 256 + 128 * half);
            float num = 0.f;
#pragma unroll
            for (int i = 0; i < 32; ++i) { const f32x4 kv = kq[i], qv = qq[i];
                C[4 * i + 0] = fp * C[4 * i + 0] + kv.x * vv; C[4 * i + 1] = fp * C[4 * i + 1] + kv.y * vv; C[4 * i + 2] = fp * C[4 * i + 2] + kv.z * vv; C[4 * i + 3] = fp * C[4 * i + 3] + kv.w * vv;
                num += (qv.x * C[4 * i + 0] + qv.y * C[4 * i + 1]) + (qv.z * C[4 * i + 2] + qv.w * C[4 * i + 3]); }
            const int buf = tt & 1;
            if (tid < 256) { nreg = fp * nreg + ip * kl[tt * 256 + tid]; const float pd = wave_sum(ql[tt * 256 + tid] * nreg); if (F.lane == 0) red[buf * 4 + F.wave] = pd; }
            else part[buf * 256 + e] = num;
            __syncthreads();
            if (tid < 256) { num += part[buf * 256 + e]; const float den = (red[buf * 4 + 0] + red[buf * 4 + 1]) + (red[buf * 4 + 2] + red[buf * 4 + 3]);
                hl[tt * 256 + e] = num / fmaxf(fabsf(den), __expf(-m)); }
        }
        __syncthreads();
        for (int r = 0; r < 4; ++r) { const int tt = 4 * F.wave + r; const size_t row = rowb + t0 + tt;
            const f32x4 hv = *(const LAS f32x4*)(hl + tt * 256 + 4 * F.lane);
            const float ss = wave_sum((hv.x * hv.x + hv.y * hv.y) + (hv.z * hv.z + hv.w * hv.w));
            const float rstd = 1.0f / sqrtf(ss * (1.0f / 256.0f) + EPS);
            const int col = hh * 256 + 4 * F.lane; const f32x4 g = *(const f32x4*)(F.ml_norm_g() + col);
            const unsigned long long ow = *(const unsigned long long*)(MLO + row * D + col);
            const float o0 = bflo((unsigned)ow), o1 = bfhi((unsigned)ow), o2 = bflo((unsigned)(ow >> 32)), o3 = bfhi((unsigned)(ow >> 32));
            const float y0 = hv.x * rstd * g.x / (1.0f + __expf(-o0)), y1 = hv.y * rstd * g.y / (1.0f + __expf(-o1)), y2 = hv.z * rstd * g.z / (1.0f + __expf(-o2)), y3 = hv.w * rstd * g.w / (1.0f + __expf(-o3));
            *(unsigned long long*)(F.YB() + row * D + col) = (unsigned long long)pk2(y0, y1) | ((unsigned long long)pk2(y2, y3) << 32); }
    }
}


namespace ml {
typedef short bf16x8 __attribute__((ext_vector_type(8)));
typedef short s16x4 __attribute__((ext_vector_type(4)));
typedef float f32x16 __attribute__((ext_vector_type(16)));
typedef LAS const char* lcp;
typedef LAS char* lp_t;
constexpr int L = 64;
constexpr int O_QI = 0, O_KI = 33792, O_CB = 67584, O_VI = 102400, O_VW = 111616, O_PI = 120832, O_F = 130048;
constexpr int F_NV = 0, F_QNP = 256, F_RSP = 768, F_AT = 896, F_US = 960, F_WIN = 1024, F_EDEN = 1088, F_WST = 1152, F_RDEN = 1216, F_CW = 1280, F_CBIAS = 3328;
__device__ __forceinline__ int crow(int r, int hi) { return (r & 3) + 8 * (r >> 2) + 4 * hi; }
template <int PITCH, int XM> __device__ __forceinline__ int ioff(int row, int ch) { return XM ? PITCH * row + 16 * (ch ^ (row & XM)) : PITCH * row + 16 * ch; }
template <int PITCH, int XM> __device__ __forceinline__ bf16x8 frag_row(lcp img, int row0, int s, int lane) {
    return *(LAS const bf16x8*)(img + ioff<PITCH, XM>(row0 + (lane & 31), 2 * s + (lane >> 5)));
}
template <int PITCH, int XM> __device__ __forceinline__ bf16x8 frag_tr(lcp img, int k0, int ks, int col0, int lane) {
    const int h = lane >> 5, blk = (lane >> 4) & 1, q = (lane & 15) >> 2, p = lane & 3;
    const int r0 = k0 + 16 * ks + 8 * h + q, ch = (col0 >> 3) + 2 * blk + (p >> 1);
    typedef short v4i16_t __attribute__((ext_vector_type(4)));
    const s16x4 a = __builtin_bit_cast(s16x4, __builtin_amdgcn_ds_read_tr16_b64_v4i16((LAS v4i16_t*)(img + ioff<PITCH, XM>(r0, ch) + 8 * (p & 1))));
    const s16x4 b = __builtin_bit_cast(s16x4, __builtin_amdgcn_ds_read_tr16_b64_v4i16((LAS v4i16_t*)(img + ioff<PITCH, XM>(r0 + 4, ch) + 8 * (p & 1))));
    return (bf16x8){a[0], a[1], a[2], a[3], b[0], b[1], b[2], b[3]};
}
__device__ __forceinline__ float half_sum(float v) {
    const auto rr = __builtin_amdgcn_permlane32_swap(__builtin_bit_cast(unsigned, v), __builtin_bit_cast(unsigned, v), false, false);
    return __builtin_bit_cast(float, rr[0]) + __builtin_bit_cast(float, rr[1]);
}
__device__ __forceinline__ float silu_f(float y) { return y * __builtin_amdgcn_rcpf(1.0f + __expf(-y)); }

__device__ __forceinline__ void mlstm_unit(Frame& F, int unit) {
    const int bh = unit >> 2, sl = unit & 3, b = bh >> 2, hh = bh & 3, tid = opq(F.tid), lane = opq(F.lane), wave = F.wave, hi = lane >> 5, l31 = lane & 31;
    const bf16* MLQ = (const bf16*)F.out(); const bf16* MLK = MLQ + (size_t)T * D; const bf16* MLV = F.PROJ() + 5 * (SEG / 2);
    lp_t base = (lp_t)F.lds;
    LAS float* Fa = (LAS float*)(base + O_F);
    const size_t rowb = (size_t)b * SEQ;
    const float LOG2E = 1.4426950408889634f;
    __syncthreads();
    for (int i = tid; i < 34816 / 16; i += 512) ((LAS v4u*)(base + O_CB))[i] = (v4u){0u, 0u, 0u, 0u};
    if (tid < 256) Fa[F_NV + tid] = 0.f;
    f32x16 C0, C1, C2;
#pragma unroll
    for (int r = 0; r < 16; ++r) { C0[r] = 0.f; C1[r] = 0.f; C2[r] = 0.f; }
    if (tid < 64) *(LAS v4u*)(base + O_VW + 144 * tid + 128) = (v4u){0u, 0u, 0u, 0u};
    const int cg = tid & 31, rb = tid >> 5;
    v4u rawq[2][4], rawk[2][4], rawv[2]; float g_bb[2], g_us[2], g_pm[2]; float m_prev = 0.f;
#define ML_PREFETCH(T0, P) do { const int t0_ = (T0); \
        _Pragma("unroll") for (int i = 0; i < 4; ++i) { const unsigned g_ = (unsigned)(((int)rowb + t0_ + 4 * rb + i) * D + hh * 256 + cg * 8); \
            rawq[P][i] = *(const v4u*)(MLQ + g_); rawk[P][i] = *(const v4u*)(MLK + g_); } \
        rawv[P] = *(const v4u*)(MLV + (unsigned)(((int)rowb + t0_ + (tid >> 3)) * D + hh * 256 + 64 * sl + (tid & 7) * 8)); \
        { const float* gt_ = F.gt() + (unsigned)(((bh * (SEQ / L) + t0_ / L) * 3) * 64 + lane); g_bb[P] = gt_[0]; g_us[P] = gt_[64]; g_pm[P] = gt_[128]; } } while (0)
    ML_PREFETCH(0, 0); ML_PREFETCH(L, 1);
    __syncthreads();
    for (int chunk2 = 0; chunk2 < SEQ / L; chunk2 += 2) {
#pragma unroll
      for (int par = 0; par < 2; ++par) {
        const int chunk = chunk2 + par, t0 = chunk * L;
        const int tid = opq(F.tid), lane = tid & 63, hi = lane >> 5, l31 = lane & 31, cg = tid & 31, rb = tid >> 5, lo = lane;
        const float u = g_us[par], mm = g_bb[par] + fmaxf(m_prev, g_pm[par]), winter = __builtin_amdgcn_exp2f(g_bb[par] + m_prev - mm), at = g_bb[par] - mm, eden = __builtin_amdgcn_exp2f(-mm);
        const float bb63 = __builtin_bit_cast(float, __builtin_amdgcn_readlane(__builtin_bit_cast(int, g_bb[par]), 63)), mnew = __builtin_bit_cast(float, __builtin_amdgcn_readlane(__builtin_bit_cast(int, mm), 63));
        const float decay = __builtin_amdgcn_exp2f(bb63 + m_prev - mnew), wstate = __builtin_amdgcn_exp2f(bb63 - mnew + u); m_prev = mnew;
        if (wave == 0) { Fa[F_AT + lane] = at; Fa[F_US + lane] = u; Fa[F_WIN + lane] = winter; Fa[F_EDEN + lane] = eden; Fa[F_WST + lane] = wstate; }
#pragma unroll
        for (int j = 0; j < 4; ++j) { *(LAS v4u*)(base + O_QI + ioff<528, 0>(4 * rb + j, cg)) = rawq[par][j]; *(LAS v4u*)(base + O_KI + ioff<528, 0>(4 * rb + j, cg)) = rawk[par][j]; }
        { const int s = tid >> 3, ch = tid & 7; const v4u w = rawv[par];
          *(LAS v4u*)(base + O_VI + ioff<144, 0>(s, ch)) = w;
          const float ws = __shfl(wstate, s);
          v4u o; o.x = pk2(bflo(w.x) * ws, bfhi(w.x) * ws); o.y = pk2(bflo(w.y) * ws, bfhi(w.y) * ws); o.z = pk2(bflo(w.z) * ws, bfhi(w.z) * ws); o.w = pk2(bflo(w.w) * ws, bfhi(w.w) * ws);
          *(LAS v4u*)(base + O_VW + ioff<144, 0>(s, ch)) = o;
          if (ch == 0) *(LAS unsigned short*)(base + O_VW + 144 * s + 128) = (unsigned short)pk2(ws, 0.f); }
        __syncthreads();
        if (chunk + 2 < SEQ / L) ML_PREFETCH(t0 + 2 * L, par);
        __builtin_amdgcn_sched_barrier(0);
        f32x16 acc;
#pragma unroll
        for (int r = 0; r < 16; ++r) acc[r] = 0.f;
        const int wq = wave & 3, ta = wq >> 1, tb = wq & 1;
        if (wave < 4) {
#pragma unroll
            for (int kh = 0; kh < 2; ++kh) { bf16x8 fa[8], fb[8];
#pragma unroll
                for (int ks = 0; ks < 8; ++ks) { fa[ks] = frag_row<528, 0>(base + O_KI, 32 * tb, 8 * kh + ks, lo); fb[ks] = frag_row<528, 0>(base + O_QI, 32 * ta, 8 * kh + ks, lo); }
                __builtin_amdgcn_sched_barrier(0);
#pragma unroll
                for (int ks = 0; ks < 8; ++ks) acc = __builtin_amdgcn_mfma_f32_32x32x16_bf16(fa[ks], fb[ks], acc, 0, 0, 0);
                __builtin_amdgcn_sched_barrier(0); }
            const float at_l = __shfl(at, 32 * ta + l31); const int t = 32 * ta + l31; float rsum = 0.f;
#pragma unroll
            for (int g = 0; g < 4; ++g) { const int s0 = 32 * tb + 8 * g + 4 * hi; const f32x4 us4 = *(LAS const f32x4*)(Fa + F_US + s0); float p[4];
#pragma unroll
                for (int i = 0; i < 4; ++i) { p[i] = (s0 + i <= t) ? acc[4 * g + i] * __builtin_amdgcn_exp2f(at_l + us4[i]) : 0.f; rsum += p[i]; }
                *(LAS unsigned long long*)(base + O_PI + ioff<144, 0>(t, s0 >> 3) + 2 * (s0 & 7)) = (unsigned long long)pk2(p[0], p[1]) | ((unsigned long long)pk2(p[2], p[3]) << 32); }
            rsum = half_sum(rsum);
            if (hi == 0) Fa[F_RSP + tb * 64 + t] = rsum;
        } else {
#pragma unroll
            for (int kh = 0; kh < 2; ++kh) { bf16x8 fa[8], fb[8];
#pragma unroll
                for (int ks = 0; ks < 8; ++ks) { fa[ks] = frag_row<528, 0>(base + O_QI, 32 * ta, 8 * kh + ks, lo); fb[ks] = frag_tr<136, 0>(base + O_CB, 0, 8 * kh + ks, 32 * tb, lo); }
                __builtin_amdgcn_sched_barrier(0);
#pragma unroll
                for (int ks = 0; ks < 8; ++ks) acc = __builtin_amdgcn_mfma_f32_32x32x16_bf16(fa[ks], fb[ks], acc, 0, 0, 0);
                __builtin_amdgcn_sched_barrier(0); }
        }
        { float s = 0.f;
#pragma unroll
          for (int c = 0; c < 4; ++c) { const v4u w = *(LAS const v4u*)(base + O_QI + ioff<528, 0>(lane, 4 * wave + c)); const f32x4 n0 = *(LAS const f32x4*)(Fa + F_NV + 32 * wave + 8 * c), n1 = *(LAS const f32x4*)(Fa + F_NV + 32 * wave + 8 * c + 4);
              s += bflo(w.x) * n0.x + bfhi(w.x) * n0.y + bflo(w.y) * n0.z + bfhi(w.y) * n0.w + bflo(w.z) * n1.x + bfhi(w.z) * n1.y + bflo(w.w) * n1.z + bfhi(w.w) * n1.w; }
          Fa[F_QNP + wave * 64 + lane] = s; }
        __syncthreads();
        if (wave >= 4) {
            { const int t = 32 * ta + l31;
              const float den = Fa[F_WIN + t] * (((Fa[F_QNP + t] + Fa[F_QNP + 64 + t]) + (Fa[F_QNP + 128 + t] + Fa[F_QNP + 192 + t])) + ((Fa[F_QNP + 256 + t] + Fa[F_QNP + 320 + t]) + (Fa[F_QNP + 384 + t] + Fa[F_QNP + 448 + t])))
                                + Fa[F_RSP + t] + Fa[F_RSP + 64 + t];
              if (hi == 0) Fa[F_CW + 32 * (wave - 4) + l31] = 1.0f / fmaxf(fabsf(den), Fa[F_EDEN + t]); }
#pragma unroll
            for (int g = 0; g < 4; ++g) { const f32x4 w4 = *(LAS const f32x4*)(Fa + F_WIN + 32 * ta + 8 * g + 4 * hi); acc[4 * g] *= w4.x; acc[4 * g + 1] *= w4.y; acc[4 * g + 2] *= w4.z; acc[4 * g + 3] *= w4.w; }
            { bf16x8 fa[4], fb[4];
#pragma unroll
              for (int ks = 0; ks < 4; ++ks) { fa[ks] = frag_row<144, 0>(base + O_PI, 32 * ta, ks, lo); fb[ks] = frag_tr<144, 0>(base + O_VI, 0, ks, 32 * tb, lo); }
              __builtin_amdgcn_sched_barrier(0);
#pragma unroll
              for (int ks = 0; ks < 4; ++ks) acc = __builtin_amdgcn_mfma_f32_32x32x16_bf16(fa[ks], fb[ks], acc, 0, 0, 0); }
            bf16* dst = F.YB() + (rowb + t0 + 32 * ta) * D + hh * 256 + 64 * sl + 32 * tb + l31;
#pragma unroll
            for (int g = 0; g < 4; ++g) { const f32x4 r4 = *(LAS const f32x4*)(Fa + F_CW + 32 * (wave - 4) + 8 * g + 4 * hi);
#pragma unroll
                for (int i = 0; i < 4; ++i) dst[(size_t)(8 * g + 4 * hi + i) * D] = (bf16)pk2(acc[4 * g + i] * r4[i], 0.f); }
        }
#pragma unroll
        for (int r = 0; r < 16; ++r) { C0[r] *= decay; C1[r] *= decay; C2[r] *= decay; }
        { bf16x8 bk[4], v0[4], v1[4], v2[4];
#pragma unroll
          for (int ks = 0; ks < 4; ++ks) { bk[ks] = frag_tr<528, 0>(base + O_KI, 0, ks, 32 * wave, lo); v0[ks] = frag_tr<144, 0>(base + O_VW, 0, ks, 0, lo); v1[ks] = frag_tr<144, 0>(base + O_VW, 0, ks, 32, lo); v2[ks] = frag_tr<144, 0>(base + O_VW, 0, ks, 64, lo); }
          __builtin_amdgcn_sched_barrier(0);
#pragma unroll
          for (int ks = 0; ks < 4; ++ks) { C0 = __builtin_amdgcn_mfma_f32_32x32x16_bf16(v0[ks], bk[ks], C0, 0, 0, 0); C1 = __builtin_amdgcn_mfma_f32_32x32x16_bf16(v1[ks], bk[ks], C1, 0, 0, 0); C2 = __builtin_amdgcn_mfma_f32_32x32x16_bf16(v2[ks], bk[ks], C2, 0, 0, 0); }
          __builtin_amdgcn_sched_barrier(0); }
        { const int d = 32 * wave + l31;
#pragma unroll
          for (int g = 0; g < 4; ++g) { const int e0 = 8 * g + 4 * hi;
              *(LAS unsigned long long*)(base + O_CB + ioff<136, 0>(d, e0 >> 3) + 2 * (e0 & 7)) = (unsigned long long)pk2(C0[4 * g], C0[4 * g + 1]) | ((unsigned long long)pk2(C0[4 * g + 2], C0[4 * g + 3]) << 32);
              *(LAS unsigned long long*)(base + O_CB + ioff<136, 0>(d, (32 + e0) >> 3) + 2 * (e0 & 7)) = (unsigned long long)pk2(C1[4 * g], C1[4 * g + 1]) | ((unsigned long long)pk2(C1[4 * g + 2], C1[4 * g + 3]) << 32); }
          if (hi == 0) Fa[F_NV + d] = C2[0];
        }
        __syncthreads();
      }
    }
#undef ML_PREFETCH
}
}


__device__ __forceinline__ void mlstm_gates(Frame& F, int job) {
    const int lane = opq(F.lane); const float LOG2E = 1.4426950408889634f;
    const float lf2 = F.lf()[(size_t)job * ml::L + lane] * LOG2E, ii2 = F.ipre()[(size_t)job * ml::L + lane] * LOG2E;
    float bb = lf2;
#pragma unroll
    for (int o = 1; o < 64; o <<= 1) { const float v = __shfl_up(bb, o); bb += (lane >= o) ? v : 0.f; }
    const float u = ii2 - bb; float pm = u;
#pragma unroll
    for (int o = 1; o < 64; o <<= 1) { const float v = __shfl_up(pm, o); pm = (lane >= o) ? fmaxf(pm, v) : pm; }
    float* gt = F.gt() + (size_t)job * 3 * 64 + lane;
    gt[0] = bb; gt[64] = u; gt[128] = pm;
}

__device__ __forceinline__ void mlstm_conv_rows(Frame& F) {
    const int tid = opq(F.tid), cg = tid & 255, z = cg >> 7, c0 = (cg & 127) * 8, r0 = F.vcu * 128 + 64 * (tid >> 8);
    const bf16* src = F.PROJ() + (size_t)(3 + z) * (SEG / 2) + c0; bf16* dst = (bf16*)F.out() + (size_t)z * T * D + c0;
    float w[4][8], bs[8];
#pragma unroll
    for (int tap = 0; tap < 4; ++tap) { const f32x4 a0 = *(const f32x4*)(F.conv_w() + tap * 2048 + cg * 8), a1 = *(const f32x4*)(F.conv_w() + tap * 2048 + cg * 8 + 4);
        w[tap][0] = a0.x; w[tap][1] = a0.y; w[tap][2] = a0.z; w[tap][3] = a0.w; w[tap][4] = a1.x; w[tap][5] = a1.y; w[tap][6] = a1.z; w[tap][7] = a1.w; }
    { const f32x4 a0 = *(const f32x4*)(F.conv_b() + cg * 8), a1 = *(const f32x4*)(F.conv_b() + cg * 8 + 4);
      bs[0] = a0.x; bs[1] = a0.y; bs[2] = a0.z; bs[3] = a0.w; bs[4] = a1.x; bs[5] = a1.y; bs[6] = a1.z; bs[7] = a1.w; }
    const float osc = z ? 0.0625f : 1.0f;
    const bool seq_start = (r0 % SEQ) == 0;
    v4u x0, x1, x2;
    { const v4u zero = {0u, 0u, 0u, 0u};
      x0 = seq_start ? zero : *(const v4u*)(src + (size_t)(r0 - 3 + (seq_start ? 3 : 0)) * D);
      x1 = seq_start ? zero : *(const v4u*)(src + (size_t)(r0 - 2 + (seq_start ? 2 : 0)) * D);
      x2 = seq_start ? zero : *(const v4u*)(src + (size_t)(r0 - 1 + (seq_start ? 1 : 0)) * D); }
    v4u nxs[8];
#pragma unroll
    for (int i = 0; i < 8; ++i) nxs[i] = *(const v4u*)(src + (size_t)(r0 + i) * D);
    for (int rr = 0; rr < 64; rr += 8) {
        v4u xs[8];
#pragma unroll
        for (int i = 0; i < 8; ++i) xs[i] = nxs[i];
        if (rr + 8 < 64) {
#pragma unroll
            for (int i = 0; i < 8; ++i) nxs[i] = *(const v4u*)(src + (size_t)(r0 + rr + 8 + i) * D); }
#pragma unroll
        for (int i = 0; i < 8; ++i) {
            const v4u x3 = xs[i]; float y[8];
#pragma unroll
            for (int c = 0; c < 8; ++c) y[c] = bs[c];
#define MK_TAP(tap, X) do { y[0] += w[tap][0] * bflo(X.x); y[1] += w[tap][1] * bfhi(X.x); y[2] += w[tap][2] * bflo(X.y); y[3] += w[tap][3] * bfhi(X.y); \
                           y[4] += w[tap][4] * bflo(X.z); y[5] += w[tap][5] * bfhi(X.z); y[6] += w[tap][6] * bflo(X.w); y[7] += w[tap][7] * bfhi(X.w); } while (0)
            MK_TAP(0, x0); MK_TAP(1, x1); MK_TAP(2, x2); MK_TAP(3, x3);
#undef MK_TAP
#pragma unroll
            for (int c = 0; c < 8; ++c) y[c] = ml::silu_f(y[c]) * osc;
            v4u o; o.x = pk2(y[0], y[1]); o.y = pk2(y[2], y[3]); o.z = pk2(y[4], y[5]); o.w = pk2(y[6], y[7]);
            *(v4u*)(dst + (size_t)(r0 + rr + i) * D) = o;
            x0 = x1; x1 = x2; x2 = x3;
        }
    }
}

__device__ __forceinline__ void mlstm_norm_rows(Frame& F) {
    const int row0 = F.vcu * 128, lane = opq(F.lane);
    const bf16* MLO = F.PROJ() + 6 * (SEG / 2);
    f32x4 G[4];
#pragma unroll
    for (int j = 0; j < 4; ++j) G[j] = *(const f32x4*)(F.ml_norm_g() + 256 * j + 4 * lane);
    unsigned long long nh[4], no[4];
#define NR_LOAD(ROW) do { const size_t row_ = (ROW); const GAS unsigned long long* hp_ = (const GAS unsigned long long*)(F.YB() + row_ * D) + lane; const GAS unsigned long long* op_ = (const GAS unsigned long long*)(MLO + row_ * D) + lane; \
        _Pragma("unroll") for (int j = 0; j < 4; ++j) { nh[j] = hp_[64 * j]; no[j] = op_[64 * j]; } } while (0)
    NR_LOAD((size_t)row0 + 16 * F.wave);
    for (int r = 0; r < 16; ++r) {
        const size_t row = (size_t)row0 + 16 * F.wave + r;
        GAS unsigned long long* hp = (GAS unsigned long long*)(F.YB() + row * D) + lane;
        unsigned long long ch[4], co[4];
#pragma unroll
        for (int j = 0; j < 4; ++j) { ch[j] = nh[j]; co[j] = no[j]; }
        if (r < 15) NR_LOAD(row + 1);
#pragma unroll
        for (int j = 0; j < 4; ++j) { const unsigned long long hw = ch[j], ow = co[j];
            const float h0 = bflo((unsigned)hw), h1 = bfhi((unsigned)hw), h2 = bflo((unsigned)(hw >> 32)), h3 = bfhi((unsigned)(hw >> 32));
            const float ss = wave_sum((h0 * h0 + h1 * h1) + (h2 * h2 + h3 * h3)); const float rstd = 1.0f / sqrtf(ss * (1.0f / 256.0f) + EPS);
            const float o0 = bflo((unsigned)ow), o1 = bfhi((unsigned)ow), o2 = bflo((unsigned)(ow >> 32)), o3 = bfhi((unsigned)(ow >> 32));
            const float y0 = h0 * rstd * G[j].x / (1.0f + __expf(-o0)), y1 = h1 * rstd * G[j].y / (1.0f + __expf(-o1)), y2 = h2 * rstd * G[j].z / (1.0f + __expf(-o2)), y3 = h3 * rstd * G[j].w / (1.0f + __expf(-o3));
            hp[64 * j] = (unsigned long long)pk2(y0, y1) | ((unsigned long long)pk2(y2, y3) << 32); }
    }
#undef NR_LOAD
}

namespace at {
using ml::bf16x8; using ml::s16x4; using ml::f32x16; using ml::ioff; using ml::frag_row; using ml::lcp; using ml::lp_t;
typedef _Float16 f16x8 __attribute__((ext_vector_type(8)));
typedef _Float16 f16x2 __attribute__((ext_vector_type(2)));
typedef float f32x2 __attribute__((ext_vector_type(2)));
constexpr int O_KI = 0, O_VI = 8192, O_FLAG = 16384;
template <int PITCH, int XM> __device__ __forceinline__ bf16x8 frag_trp(lcp img, int ks, int col0, int lane) {
    const int h = lane >> 5, blk = (lane >> 4) & 1, q = (lane & 15) >> 2, p = lane & 3;
    const int r0 = 16 * ks + 4 * h + q, ch = (col0 >> 3) + 2 * blk + (p >> 1);
    typedef short v4i16_t __attribute__((ext_vector_type(4)));
    const s16x4 a = __builtin_bit_cast(s16x4, __builtin_amdgcn_ds_read_tr16_b64_v4i16((LAS v4i16_t*)(img + ioff<PITCH, XM>(r0, ch) + 8 * (p & 1))));
    const s16x4 b = __builtin_bit_cast(s16x4, __builtin_amdgcn_ds_read_tr16_b64_v4i16((LAS v4i16_t*)(img + ioff<PITCH, XM>(r0 + 8, ch) + 8 * (p & 1))));
    return (bf16x8){a[0], a[1], a[2], a[3], b[0], b[1], b[2], b[3]};
}
__device__ __forceinline__ unsigned pkh(float a, float b) { const f32x2 v = {a, b}; return __builtin_bit_cast(unsigned, __builtin_convertvector(v, f16x2)); }
__device__ __forceinline__ f16x8 h8(unsigned a, unsigned b, unsigned c, unsigned d) { const v4u v = {a, b, c, d}; return __builtin_bit_cast(f16x8, v); }
__device__ __forceinline__ bf16x8 b8(unsigned a, unsigned b, unsigned c, unsigned d) { const v4u v = {a, b, c, d}; return __builtin_bit_cast(bf16x8, v); }

__device__ __forceinline__ void attn_unit(Frame& F, int bh, int qb) {
    const int b = bh >> 4, hd = bh & 15, tid = opq(F.tid), lane = opq(F.lane), wave = F.wave, hi = lane >> 5, l31 = lane & 31, pr = wave >> 1, tp = tid & 127;
    const bf16* Q = F.PROJ(); const bf16* K = F.PROJ() + SEG / 2; const bf16* V = F.PROJ() + SEG;
    lp_t base = (lp_t)F.lds + pr * 16384;
    LAS volatile int* dflag = (LAS volatile int*)((lp_t)F.lds + 65536);
    const size_t rowb = (size_t)b * SEQ; const int q0 = qb * 256, tw0 = q0 + 32 * wave, t = tw0 + l31, kt0 = qb * 4 + pr;
    bf16x8 qr[4];
#pragma unroll
    for (int ks = 0; ks < 4; ++ks) qr[ks] = *(const bf16x8*)(Q + (rowb + t) * D + hd * 64 + 16 * ks + 8 * hi);
    unsigned uw[2][4];
#pragma unroll
    for (int sp = 0; sp < 2; ++sp)
#pragma unroll
        for (int jj = 0; jj < 4; ++jj) { const int j0 = 2 * jj, j1 = 2 * jj + 1;
            const int k0 = 16 * sp + 8 * (j0 >> 2) + 4 * hi + (j0 & 3), k1 = 16 * sp + 8 * (j1 >> 2) + 4 * hi + (j1 & 3);
            uw[sp][jj] = (k0 > l31 ? 0x3C00u : 0u) | (k1 > l31 ? 0x3C000000u : 0u); }
    const f16x8 U0 = h8(uw[0][0], uw[0][1], uw[0][2], uw[0][3]), U1 = h8(uw[1][0], uw[1][1], uw[1][2], uw[1][3]), ONES = h8(0x3C003C00u, 0x3C003C00u, 0x3C003C00u, 0x3C003C00u);
    f32x16 O0, O1;
#pragma unroll
    for (int r = 0; r < 16; ++r) { O0[r] = 0.f; O1[r] = 0.f; }
    float R = 0.f; bool wdone = false;
    v4u kreg[4], vreg[4];
#define AT_LOAD(KT) do { _Pragma("unroll") for (int j = 0; j < 4; ++j) { const size_t g = (rowb + (KT) * 64 + (tp >> 3) + 16 * j) * D + hd * 64 + (tp & 7) * 8; kreg[j] = *(const v4u*)(K + g); vreg[j] = *(const v4u*)(V + g); } } while (0)
    AT_LOAD(kt0);
    __syncthreads();
    if (tid < 8) dflag[tid] = 0;
    for (int it = 0; it <= qb * 4 + 3; ++it) {
        const int kt = kt0 - it;
        __syncthreads();
        { int nd = 0;
#pragma unroll
          for (int w = 0; w < 8; ++w) nd += dflag[w];
          if (nd == 8) break; }
        if (kt >= 0) {
#pragma unroll
            for (int j = 0; j < 4; ++j) { *(LAS v4u*)(base + O_KI + ioff<128, 7>((tp >> 3) + 16 * j, tp & 7)) = kreg[j]; *(LAS v4u*)(base + O_VI + ioff<128, 7>((tp >> 3) + 16 * j, tp & 7)) = vreg[j]; } }
        __syncthreads();
        if (kt > 0) AT_LOAD(kt - 1);
        if (kt < 0) { if (!wdone) { wdone = true; if (lane == 0) dflag[wave] = 1; } continue; }
        if (wdone) continue;
        int lo = lane; asm volatile("" : "+v"(lo));
        f32x16 p0, p1;
#pragma unroll
        for (int r = 0; r < 16; ++r) { p0[r] = 0.f; p1[r] = 0.f; }
#pragma unroll
        for (int ks = 0; ks < 4; ++ks) { p0 = __builtin_amdgcn_mfma_f32_32x32x16_bf16(frag_row<128, 7>(base + O_KI, 0, ks, lo), qr[ks], p0, 0, 0, 0);
                                         p1 = __builtin_amdgcn_mfma_f32_32x32x16_bf16(frag_row<128, 7>(base + O_KI, 32, ks, lo), qr[ks], p1, 0, 0, 0); }
        const bool diag = (it == 0);
        const int trel = t - 64 * kt;
        float lk00 = 0.f;
        unsigned lkw0[8], lkw1[8];
#pragma unroll
        for (int r = 0; r < 16; ++r) {
            const int key0 = ml::crow(r, hi);
            { const float z = p0[r], lb = fminf(z, 0.f) - __builtin_amdgcn_logf(1.0f + __builtin_amdgcn_exp2f(-fabsf(z))); float lk = lb - z; if (diag && !(key0 < trel)) lk = 0.f; p0[r] = lb; if (r == 0) lk00 = lk;
              if (r & 1) lkw0[r >> 1] = pkh(__builtin_bit_cast(float, lkw0[r >> 1]), lk); else lkw0[r >> 1] = __builtin_bit_cast(unsigned, lk); }
            { const float z = p1[r], lb = fminf(z, 0.f) - __builtin_amdgcn_logf(1.0f + __builtin_amdgcn_exp2f(-fabsf(z))); float lk = lb - z; if (diag && !(key0 + 32 < trel)) lk = 0.f; p1[r] = lb;
              if (r & 1) lkw1[r >> 1] = pkh(__builtin_bit_cast(float, lkw1[r >> 1]), lk); else lkw1[r >> 1] = __builtin_bit_cast(unsigned, lk); }
        }
        f32x16 bt1, bt0;
#pragma unroll
        for (int r = 0; r < 16; ++r) { bt1[r] = R; bt0[r] = R; }
        const f16x8 L10 = h8(lkw1[0], lkw1[1], lkw1[2], lkw1[3]), L11 = h8(lkw1[4], lkw1[5], lkw1[6], lkw1[7]), L00 = h8(lkw0[0], lkw0[1], lkw0[2], lkw0[3]), L01 = h8(lkw0[4], lkw0[5], lkw0[6], lkw0[7]);
        bt1 = __builtin_amdgcn_mfma_f32_32x32x16_f16(U0, L10, bt1, 0, 0, 0); bt1 = __builtin_amdgcn_mfma_f32_32x32x16_f16(U1, L11, bt1, 0, 0, 0);
        bt0 = __builtin_amdgcn_mfma_f32_32x32x16_f16(ONES, L10, bt0, 0, 0, 0); bt0 = __builtin_amdgcn_mfma_f32_32x32x16_f16(ONES, L11, bt0, 0, 0, 0);
        bt0 = __builtin_amdgcn_mfma_f32_32x32x16_f16(U0, L00, bt0, 0, 0, 0); bt0 = __builtin_amdgcn_mfma_f32_32x32x16_f16(U1, L01, bt0, 0, 0, 0);
        { const float v = bt0[0] + lk00;
          const auto rr = __builtin_amdgcn_permlane32_swap(__builtin_bit_cast(unsigned, v), __builtin_bit_cast(unsigned, v), false, false);
          R = __builtin_bit_cast(float, rr[0]); }
        unsigned aw0[8], aw1[8];
#pragma unroll
        for (int r = 0; r < 16; r += 2) {
            const int key0 = ml::crow(r, hi);
            float a00 = __builtin_amdgcn_exp2f(p0[r] + bt0[r]), a01 = __builtin_amdgcn_exp2f(p0[r + 1] + bt0[r + 1]), a10 = __builtin_amdgcn_exp2f(p1[r] + bt1[r]), a11 = __builtin_amdgcn_exp2f(p1[r + 1] + bt1[r + 1]);
            if (diag) { if (!(key0 < trel)) a00 = 0.f; if (!(key0 + 1 < trel)) a01 = 0.f; if (!(key0 + 32 < trel)) a10 = 0.f; if (!(key0 + 33 < trel)) a11 = 0.f; }
            aw0[r >> 1] = pk2(a00, a01); aw1[r >> 1] = pk2(a10, a11);
        }
        const bf16x8 A00 = b8(aw0[0], aw0[1], aw0[2], aw0[3]), A01 = b8(aw0[4], aw0[5], aw0[6], aw0[7]), A10 = b8(aw1[0], aw1[1], aw1[2], aw1[3]), A11 = b8(aw1[4], aw1[5], aw1[6], aw1[7]);
        O0 = __builtin_amdgcn_mfma_f32_32x32x16_bf16(A00, frag_trp<128, 7>(base + O_VI, 0, 0, lo), O0, 0, 0, 0);  O1 = __builtin_amdgcn_mfma_f32_32x32x16_bf16(A00, frag_trp<128, 7>(base + O_VI, 0, 32, lo), O1, 0, 0, 0);
        O0 = __builtin_amdgcn_mfma_f32_32x32x16_bf16(A01, frag_trp<128, 7>(base + O_VI, 1, 0, lo), O0, 0, 0, 0);  O1 = __builtin_amdgcn_mfma_f32_32x32x16_bf16(A01, frag_trp<128, 7>(base + O_VI, 1, 32, lo), O1, 0, 0, 0);
        O0 = __builtin_amdgcn_mfma_f32_32x32x16_bf16(A10, frag_trp<128, 7>(base + O_VI, 2, 0, lo), O0, 0, 0, 0);  O1 = __builtin_amdgcn_mfma_f32_32x32x16_bf16(A10, frag_trp<128, 7>(base + O_VI, 2, 32, lo), O1, 0, 0, 0);
        O0 = __builtin_amdgcn_mfma_f32_32x32x16_bf16(A11, frag_trp<128, 7>(base + O_VI, 3, 0, lo), O0, 0, 0, 0);  O1 = __builtin_amdgcn_mfma_f32_32x32x16_bf16(A11, frag_trp<128, 7>(base + O_VI, 3, 32, lo), O1, 0, 0, 0);
        if (__all(R < ATT_RTHR)) { wdone = true; if (lane == 0) dflag[wave] = 1; }
    }
#undef AT_LOAD
    __syncthreads();
    bf16* dst = F.YA() + (rowb + tw0) * D + hd * 64 + l31;
#pragma unroll
    for (int r = 0; r < 16; ++r) { const int q = ml::crow(r, hi); dst[(size_t)q * D] = (bf16)pk2(O0[r], 0.f); dst[(size_t)q * D + 32] = (bf16)pk2(O1[r], 0.f); }
}
}

__device__ __forceinline__ void p5a_route(Frame& F) {
    const int row0 = F.vcu * 128, b = row0 / SEQ, lane = opq(F.lane), tid = opq(F.tid);
    LAS float* wr = (LAS float*)F.lds;
    LAS int* le = (LAS int*)(F.lds + 131584); LAS int* lp = le + 512;
    LAS int* lcnt = (LAS int*)(F.LC + LC_LCNT); LAS int* gbase = (LAS int*)(F.LC + LC_GBASE);
    for (int idx = tid; idx < 32768; idx += 512) wr[(idx & 31) * 1028 + (idx >> 5)] = F.router_w()[idx];
    if (tid < 32) lcnt[tid] = 0;
    f32x4 Av[4], Bv[4];
#pragma unroll
    for (int j = 0; j < 4; ++j) { const int col = 4 * lane + 256 * j; const float* mb = F.mod() + (size_t)b * NMOD;
        const f32x4 g = *(const f32x4*)(F.norm2_g() + col); Av[j] = g * (*(const f32x4*)(mb + 4 * D + col) + 1.0f); Bv[j] = *(const f32x4*)(mb + 3 * D + col); }
    float rb[32];
#pragma unroll
    for (int e = 0; e < 32; ++e) rb[e] = F.router_b()[e];
    __syncthreads();
    f32x4 nx[4];
    { const GAS f32x4* xr = (const GAS f32x4*)(F.out() + (size_t)(row0 + 16 * F.wave) * D) + lane;
#pragma unroll
      for (int j = 0; j < 4; ++j) nx[j] = xr[64 * j]; }
    for (int r = 0; r < 16; ++r) {
        const int rl = 16 * F.wave + r, row = row0 + rl;
        f32x4 v[4]; float ss = 0.f;
#pragma unroll
        for (int j = 0; j < 4; ++j) { v[j] = nx[j]; ss += (v[j].x * v[j].x + v[j].y * v[j].y) + (v[j].z * v[j].z + v[j].w * v[j].w); }
        if (r < 15) { const GAS f32x4* xr = (const GAS f32x4*)(F.out() + (size_t)(row + 1) * D) + lane;
#pragma unroll
            for (int j = 0; j < 4; ++j) nx[j] = xr[64 * j]; }
        const float rstd = 1.0f / sqrtf(wave_sum(ss) * (1.0f / D) + EPS);
        { GAS unsigned long long* o8 = (GAS unsigned long long*)(F.H2() + (size_t)row * D) + lane;
#pragma unroll
          for (int j = 0; j < 4; ++j) { v[j] = v[j] * rstd * Av[j] + Bv[j]; o8[64 * j] = (unsigned long long)pk2(v[j].x, v[j].y) | ((unsigned long long)pk2(v[j].z, v[j].w) << 32); } }
        float p[32];
#pragma unroll
        for (int e = 0; e < 32; ++e) { float s = 0.f;
#pragma unroll
            for (int j = 0; j < 4; ++j) { const f32x4 w = *(const LAS f32x4*)(wr + e * 1028 + 4 * lane + 256 * j); s += (v[j].x * w.x + v[j].y * w.y) + (v[j].z * w.z + v[j].w * w.w); }
            p[e] = s; }
#pragma unroll
        for (int i = 0; i < 16; ++i) { const bool up = (lane & 32) != 0; const float send = up ? p[i] : p[i + 16], keep = up ? p[i + 16] : p[i]; p[i] = keep + __shfl_xor(send, 32); }
#pragma unroll
        for (int i = 0; i < 8; ++i) { const bool up = (lane & 16) != 0; const float send = up ? p[i] : p[i + 8], keep = up ? p[i + 8] : p[i]; p[i] = keep + __shfl_xor(send, 16); }
#pragma unroll
        for (int i = 0; i < 4; ++i) { const bool up = (lane & 8) != 0; const float send = up ? p[i] : p[i + 4], keep = up ? p[i + 4] : p[i]; p[i] = keep + __shfl_xor(send, 8); }
#pragma unroll
        for (int i = 0; i < 2; ++i) { const bool up = (lane & 4) != 0; const float send = up ? p[i] : p[i + 2], keep = up ? p[i + 2] : p[i]; p[i] = keep + __shfl_xor(send, 4); }
        { const bool up = (lane & 2) != 0; const float send = up ? p[0] : p[1], keep = up ? p[1] : p[0]; p[0] = keep + __shfl_xor(send, 2); }
        p[0] += __shfl_xor(p[0], 1);
        { LAS float* lg = (LAS float*)(F.lds + 135680) + F.wave * 32;
          if ((lane & 1) == 0) lg[lane >> 1] = p[0];
#pragma unroll
          for (int q = 0; q < 8; ++q) { const f32x4 t4 = *(const LAS f32x4*)(lg + 4 * q); p[4 * q] = t4.x + rb[4 * q]; p[4 * q + 1] = t4.y + rb[4 * q + 1]; p[4 * q + 2] = t4.z + rb[4 * q + 2]; p[4 * q + 3] = t4.w + rb[4 * q + 3]; } }
        int sel[4]; float sv[4]; unsigned used = 0u;
#pragma unroll
        for (int k = 0; k < 4; ++k) { float best = -3.0e38f; int bi = 0;
#pragma unroll
            for (int e = 0; e < 32; ++e) { const bool cnd = (((used >> e) & 1u) == 0u) && (p[e] > best); best = cnd ? p[e] : best; bi = cnd ? e : bi; }
            sel[k] = bi; sv[k] = best; used |= 1u << bi; }
        const float e1 = __expf(sv[1] - sv[0]), e2 = __expf(sv[2] - sv[0]), e3 = __expf(sv[3] - sv[0]), inv = 1.0f / (1.0f + e1 + e2 + e3);
        if (lane < 4) { const int ek = lane == 0 ? sel[0] : lane == 1 ? sel[1] : lane == 2 ? sel[2] : sel[3];
            const float wk = (lane == 0 ? 1.0f : lane == 1 ? e1 : lane == 2 ? e2 : e3) * inv;
            const int pos = __hip_atomic_fetch_add(lcnt + ek, 1, __ATOMIC_RELAXED, __HIP_MEMORY_SCOPE_WORKGROUP);
            le[rl * 4 + lane] = ek; lp[rl * 4 + lane] = pos; F.tokw()[(size_t)row * 4 + lane] = wk; }
        if (lane == 0) F.rstd2()[row] = rstd;
    }
    __syncthreads();
    if (tid < 32) gbase[tid] = (int)__hip_atomic_fetch_add(F.ctl + CW_ECNT + 64 * tid, (unsigned)lcnt[tid], __ATOMIC_RELAXED, __HIP_MEMORY_SCOPE_AGENT);
    __syncthreads();
    { const int ek = le[tid]; F.toke()[(size_t)row0 * 4 + tid] = ek; F.tokp()[(size_t)row0 * 4 + tid] = lp[tid] + gbase[ek]; }
}

__device__ __forceinline__ void p5b_tables(Frame& F) {
    const int row0 = F.vcu * 128, tid = opq(F.tid);
    LAS int* ts = (LAS int*)(F.LC + LC_TS); LAS int* ps = (LAS int*)(F.LC + LC_PS); LAS int* cn = (LAS int*)(F.LC + LC_CNT);
    if (tid < 32) cn[tid] = (int)__hip_atomic_load(F.ctl + CW_ECNT + 64 * tid, RLX_AGENT);
    __syncthreads();
    if (tid == 0) { int run = 0, trun = 0; for (int e = 0; e < 32; ++e) { ps[e] = run; ts[e] = trun; const int nt = (cn[e] + 255) >> 8; run += nt * 256; trun += nt; } ts[32] = trun; }
    __syncthreads();
    { const size_t idx = (size_t)row0 * 4 + tid; const int ek = F.toke()[idx], dst = ps[ek] + F.tokp()[idx]; F.tokrow()[idx] = dst; F.row2tok()[dst] = row0 + (tid >> 2); }
    if (F.vcu < 32) { const int e = F.vcu, start = ps[e] + cn[e], end = ps[e] + (((cn[e] + 255) >> 8) << 8); for (int r = start + tid; r < end; r += 512) F.row2tok()[r] = 0; }
}

__device__ __forceinline__ void p8_combine(Frame& F, bool poison) {
    const int row0 = F.vcu * 128, b = row0 / SEQ, lane = opq(F.lane);
    f32x4 G2[4], FG[4];
#pragma unroll
    for (int j = 0; j < 4; ++j) { const int col = 4 * lane + 256 * j; G2[j] = *(const f32x4*)(F.mod() + (size_t)b * NMOD + 5 * D + col); FG[j] = *(const f32x4*)(F.final_g() + col); }
    f32x4 nx[4]; unsigned long long ng[4][4]; float nw[4];
#define P8_LOAD(ROW) do { const size_t row_ = (ROW); const GAS f32x4* xr_ = (const GAS f32x4*)(F.out() + row_ * D) + lane; \
        _Pragma("unroll") for (int j = 0; j < 4; ++j) nx[j] = xr_[64 * j]; \
        _Pragma("unroll") for (int k = 0; k < 4; ++k) { const int src_ = F.tokrow()[row_ * 4 + k]; nw[k] = F.tokw()[row_ * 4 + k]; \
            const GAS unsigned long long* s8_ = (const GAS unsigned long long*)(F.OUTR() + (size_t)src_ * D) + lane; \
            _Pragma("unroll") for (int j = 0; j < 4; ++j) ng[k][j] = s8_[64 * j]; } } while (0)
    P8_LOAD((size_t)row0 + 16 * F.wave);
    for (int r = 0; r < 16; ++r) {
        const int row = row0 + 16 * F.wave + r;
        GAS f32x4* xr = (GAS f32x4*)(F.out() + (size_t)row * D) + lane;
        f32x4 y[4], xv[4];
#pragma unroll
        for (int j = 0; j < 4; ++j) { y[j] = (f32x4){0.f, 0.f, 0.f, 0.f}; xv[j] = nx[j]; }
#pragma unroll
        for (int k = 0; k < 4; ++k) { const float wk = nw[k];
#pragma unroll
            for (int j = 0; j < 4; ++j) { const unsigned long long w = ng[k][j]; y[j].x += wk * bflo((unsigned)w); y[j].y += wk * bfhi((unsigned)w); y[j].z += wk * bflo((unsigned)(w >> 32)); y[j].w += wk * bfhi((unsigned)(w >> 32)); } }
        if (r < 15) P8_LOAD((size_t)row + 1);
        f32x4 v[4]; float ss = 0.f;
#pragma unroll
        for (int j = 0; j < 4; ++j) { v[j] = xv[j] + G2[j] * y[j]; ss += (v[j].x * v[j].x + v[j].y * v[j].y) + (v[j].z * v[j].z + v[j].w * v[j].w); }
        const float rstd = 1.0f / sqrtf(wave_sum(ss) * (1.0f / D) + EPS);
        const float qn = __builtin_nanf("");
#pragma unroll
        for (int j = 0; j < 4; ++j) { f32x4 o = v[j] * rstd * FG[j]; if (poison) o = (f32x4){qn, qn, qn, qn}; xr[64 * j] = o; }
    }
#undef P8_LOAD
}

#ifndef MK_REP_G2
#define MK_REP_G2 1
#endif
#ifndef MK_REP_G4A
#define MK_REP_G4A 1
#endif
#ifndef MK_REP_G4B
#define MK_REP_G4B 1
#endif
#ifndef MK_REP_G4C
#define MK_REP_G4C 1
#endif
#ifndef MK_REP_G6
#define MK_REP_G6 1
#endif
#ifndef MK_REP_G7
#define MK_REP_G7 1
#endif
#ifndef MK_REP_P0
#define MK_REP_P0 1
#endif
#ifndef MK_REP_P3
#define MK_REP_P3 1
#endif
struct Args { const float* in[22]; float* out; unsigned char* ws; };
__global__ void __launch_bounds__(NWAVES * 64, 2) mk_fwd(Args args) {
    extern __shared__ __attribute__((aligned(16))) unsigned char lds[];
    Frame F;
    F.lds = (LAS unsigned char*)lds; F.LC = (volatile LAS unsigned*)(F.lds + LDSCTL_OFF);
    F.tid = threadIdx.x; F.lane = F.tid & 63; F.wave = __builtin_amdgcn_readfirstlane(F.tid >> 6);
    F.G = gridDim.x; { const int bx = blockIdx.x; F.vcu = (F.G % 8 == 0) ? (bx % 8) * (F.G / 8) + bx / 8 : bx; }
    F.ws = (unsigned char*)(GAS unsigned char*)karg(23);
    F.ctl = (gu32*)(F.ws + WS_CTL);
    for (int u = F.tid; u < (LDS_BYTES - LDSCTL_OFF) / 4; u += NWAVES * 64) ((LAS unsigned*)(F.lds + LDSCTL_OFF))[u] = 0u;
    __syncthreads();
    XcdBarrier bar = xcd_barrier_post((unsigned*)(F.ctl + CW_BAR), F.LC + LC_BAR);
#define GRID_BAR() xcd_barrier(bar)
    const int G = F.G, cid = (int)blockIdx.x;

    for (int rep_ = 0; rep_ < MK_REP_P0; ++rep_) p0_prologue(F);
    GRID_BAR();
    p1_rows(F);
    GRID_BAR();
    { pg8::Gemm g{F.H1(), F.WIN_T(), T, NPROJ, D}; pg8::StaticOrder S; S.init(T, NPROJ, G, cid);
      pg8::EpiBf16<0> E{F.PROJ(), D, nullptr, D, SEG / 2, QSCALE};
      for (int rep_ = 0; rep_ < MK_REP_G2; ++rep_) pg8::gemm_phase<pg8::EpiBf16<0>, pg8::StaticOrder, true, true>(F.lds, g, S, E); }
    GRID_BAR();
    for (int job = F.vcu * NWAVES + F.wave; job < BATCH * 4 * (SEQ / 64); job += G * NWAVES) mlstm_gates(F, job);
    mlstm_conv_rows(F);
    GRID_BAR();
#if defined(MK_NAIVE_MLSTM)
    for (int it = F.vcu; it < 1024; it += G) attn_naive_item(F, it & 255, it >> 8);
    __syncthreads();
    for (int it = F.vcu; it < 64; it += G) mlstm_naive_item(F, it);
#else
    for (int rep_ = 0; rep_ < MK_REP_P3; ++rep_) {
    for (int it = F.vcu; it < 256; it += G) ml::mlstm_unit(F, it);
    __syncthreads();
#if defined(MK_NAIVE_ATTN)
    for (int it = F.vcu; it < 1024; it += G) attn_naive_item(F, it & 255, it >> 8);
#else
    for (int it = F.vcu; it < 2048; it += G) at::attn_unit(F, it & 255, it >> 8);
#endif
    }
#endif
    GRID_BAR();
    { pg8::Gemm g{F.YA(), F.WA_T(), T, D, D}; pg8::StaticOrder S; S.init(T, D, G, cid);
      pg8::EpiGate<false> E{F.PROJ() + 7 * (SEG / 2), nullptr, F.M1()};
      for (int rep_ = 0; rep_ < MK_REP_G4A; ++rep_) pg8::gemm_phase<pg8::EpiGate<false>, pg8::StaticOrder, true, true>(F.lds, g, S, E); }
#if defined(MK_NAIVE_MLSTM)
    VM_WAIT(); __syncthreads();
#else
    __syncthreads();
    mlstm_norm_rows(F);
    GRID_BAR();
#endif
    { pg8::Gemm g{F.YB(), F.WB_T(), T, D, D}; pg8::StaticOrder S; S.init(T, D, G, cid);
      pg8::EpiGate<true> E{F.PROJ() + 8 * (SEG / 2), F.M1(), F.MERGED()};
      for (int rep_ = 0; rep_ < MK_REP_G4B; ++rep_) pg8::gemm_phase<pg8::EpiGate<true>, pg8::StaticOrder, true, true>(F.lds, g, S, E); }
    GRID_BAR();
    { pg8::Gemm g{F.MERGED(), F.WOUT_T(), T, D, D}; pg8::StaticOrder S; S.init(T, D, G, cid);
      pg8::EpiResid E{F.x(), F.mod() + 2 * D, F.out(), SEQ, NMOD};
      for (int rep_ = 0; rep_ < MK_REP_G4C; ++rep_) pg8::gemm_phase<pg8::EpiResid, pg8::StaticOrder, true, true>(F.lds, g, S, E); }
    GRID_BAR();
    p5a_route(F);
    GRID_BAR();
    p5b_tables(F);
    GRID_BAR();
    { pg8::Gemm g{F.H2(), F.W1_T(), T, NE * 2048, D}; pg8::GroupedOrder S{(const LAS int*)(F.LC + LC_TS), 8, G, cid, F.row2tok()};
      pg8::EpiSwiglu E{F.b1(), F.ACT()};
      for (int rep_ = 0; rep_ < MK_REP_G6; ++rep_) pg8::gemm_phase<pg8::EpiSwiglu, pg8::GroupedOrder, true, true, true>(F.lds, g, S, E); }
    GRID_BAR();
    { pg8::Gemm g{F.ACT(), F.W2_T(), XS_ROWS, NE * 1024, D}; pg8::GroupedOrder S{(const LAS int*)(F.LC + LC_TS), 4, G, cid, nullptr};
      pg8::EpiBf16<0> E{F.OUTR(), D, F.b2(), D, 0, 1.0f};
      for (int rep_ = 0; rep_ < MK_REP_G7; ++rep_) pg8::gemm_phase<pg8::EpiBf16<0>, pg8::GroupedOrder, true, true>(F.lds, g, S, E); }
    GRID_BAR();
    { const bool poison = __hip_atomic_load(F.ctl + CW_BAR + XB_TMO, RLX_AGENT) != 0u;
      p8_combine(F, poison); }
}

extern "C" void kernel_launch(void* const* d_in, const int* in_sizes, int n_in, void* d_out, int out_size, void* d_ws, size_t ws_size, hipStream_t stream) {
    static int grid = 0;
    if (grid == 0) {
        if (n_in != 22 || in_sizes[0] != T * D || out_size != T * D || ws_size < WS_END) { fprintf(stderr, "kernel_launch: unexpected shapes (n_in %d, in0 %d, out %d, ws %zu)\n", n_in, n_in > 0 ? in_sizes[0] : -1, out_size, ws_size); grid = -1; return; }
        int dev = 0, cus = 0, per_cu = 0;
        if (hipGetDevice(&dev) != hipSuccess || hipDeviceGetAttribute(&cus, hipDeviceAttributeMultiprocessorCount, dev) != hipSuccess) { grid = -1; return; }
        if (hipFuncSetAttribute((const void*)mk_fwd, hipFuncAttributeMaxDynamicSharedMemorySize, LDS_BYTES) != hipSuccess) { fprintf(stderr, "kernel_launch: hipFuncSetAttribute failed\n"); grid = -1; return; }
        if (hipOccupancyMaxActiveBlocksPerMultiprocessor(&per_cu, (const void*)mk_fwd, NWAVES * 64, LDS_BYTES) != hipSuccess || per_cu < 1) { fprintf(stderr, "kernel_launch: occupancy query says %d blocks per CU\n", per_cu); }
        (void)hipGetLastError();
        if (cus < 256) { fprintf(stderr, "kernel_launch: built for a 256-CU device, found %d CUs\n", cus); grid = -1; return; }
        grid = 256;
    }
    if (grid < 0) return;
    if (hipMemsetAsync((char*)d_ws + WS_CTL, 0, CTL_ZERO_BYTES, stream) != hipSuccess) return;
    Args a{};
    for (int i = 0; i < 22; ++i) a.in[i] = (const float*)d_in[i];
    a.out = (float*)d_out; a.ws = (unsigned char*)d_ws;
    hipLaunchKernelGGL(mk_fwd, dim3(grid), dim3(NWAVES * 64), LDS_BYTES, stream, a);
}
```

```cpp
#include <hip/hip_runtime.h>
#include <cstdio>
#include <cstdint>
namespace pg8 {
#define PG8_LAS __attribute__((address_space(3)))
typedef unsigned short bf16_t;
typedef short bf16x8 __attribute__((ext_vector_type(8)));
typedef float f32x4 __attribute__((ext_vector_type(4)));
typedef unsigned u32x4 __attribute__((ext_vector_type(4)));
typedef int i32x4_ __attribute__((ext_vector_type(4))); typedef int i32x8_ __attribute__((ext_vector_type(8)));
constexpr int BM = 256, BK = 64, HALF = 128, HTB = HALF * BK * 2  , STAGE_BYTES = 8 * HTB, NXCD = 8, WGM = 8;

__host__ __device__ __forceinline__ int lds_byte(int r, int c) { const int st = (r >> 4) * 2 + (c >> 5), rr = r & 15, cc = c & 31, ob = rr * 64 + cc * 2; return st * 1024 + (ob ^ (((ob >> 9) & 1) << 5)); }
__host__ __device__ __forceinline__ void stage_rc(int b, int& R, int& C) { const int st = b / 1024, sb = b % 1024, swz = sb ^ (((sb >> 9) & 1) << 5); R = (st >> 1) * 16 + swz / 64; C = (st & 1) * 32 + (swz % 64) / 2; }
__host__ __device__ __forceinline__ int perm32(int rho) { const int n = rho >> 4, i = rho & 15; return 8 * (i >> 2) + 4 * n + (i & 3); }

struct Unit { int pm, pn; };
struct Gemm { const bf16_t* A; const bf16_t* Bt; int M, N, K; };

struct StaticOrder {
    int nM, nN, nwg, G, c;
    __host__ __device__ void init(int M, int N, int G_, int c_) { nM = M / BM; nN = N / BM; nwg = nM * nN; G = G_; c = c_; }
    __host__ __device__ bool next(int i, Unit& u) const {
        const long L = (long)i * G + c; if (L >= nwg) return false;
        int wgid = (int)L; { const int q = nwg / NXCD, r = nwg % NXCD, xcd = wgid % NXCD, off = wgid / NXCD; wgid = (xcd < r ? xcd * (q + 1) : r * (q + 1) + (xcd - r) * q) + off; }
        const int nig = WGM * nN, gid = wgid / nig, fm = gid * WGM, gsz = (nM - fm) < WGM ? (nM - fm) : WGM;
        u.pm = fm + ((wgid % nig) % gsz); u.pn = (wgid % nig) / gsz; return true;
    }
    __device__ __forceinline__ void a_ready(const Unit&) const {}
    __device__ __forceinline__ void done(const Unit&) const {}
};

__device__ __forceinline__ unsigned cvt_pk_bf16(float lo, float hi) { unsigned r; asm volatile("v_cvt_pk_bf16_f32 %0, %1, %2" : "=v"(r) : "v"(lo), "v"(hi)); return r; }
typedef float f32x2 __attribute__((ext_vector_type(2)));
__device__ __forceinline__ f32x2 gelu_pk(f32x2 v) {
    const f32x2 av = __builtin_elementwise_abs(v), d = av * 0.2316418882f + 1.0f;
    f32x2 t; t.x = __builtin_amdgcn_rcpf(d.x); t.y = __builtin_amdgcn_rcpf(d.y);
    f32x2 q = t * 0.5307027145f + (-0.7265760135f); q = q * t + 0.7107068705f; q = q * t + (-0.142248368f); q = q * t + 0.127414796f; q = q * t;
    const f32x2 s = (v * v) * (-0.72134752044f);
    f32x2 e; e.x = __builtin_amdgcn_exp2f(s.x); e.y = __builtin_amdgcn_exp2f(s.y);
    const f32x2 m = v * (q * e), r = v - m;
    f32x2 o; o.x = v.x < 0.f ? m.x : r.x; o.y = v.y < 0.f ? m.y : r.y; return o;
}

template <int ACT  > struct EpiBf16 {
    static constexpr bool PERM = true, AFTER_DRAIN = false; static_assert(ACT == 0 || ACT == 1, "EpiBf16: ACT is 0 (none) or 1 (gelu_pk)");
    bf16_t* O; int ldc; const float* bias; int split_cols; size_t split_stride; float scale0;
    __device__ __forceinline__ void operator()(const f32x4 (&acc)[2][2][4][2], const Unit& u, int wr, int wc, int fr, int fq) const {
        const int row0 = u.pm * BM + wr * 64 + fr; int colt = u.pn * BM; bf16_t* base = O;
        float sc = 1.f; if (split_cols) { const int t = colt / split_cols; base += (size_t)t * split_stride; colt -= t * split_cols; if (t == 0) sc = scale0; }
        const int col0 = colt + wc * 32 + 8 * fq, bcol0 = u.pn * BM + wc * 32 + 8 * fq;
        f32x4 bv[2][2];
#pragma unroll
        for (int bj = 0; bj < 2; ++bj)
#pragma unroll
            for (int n = 0; n < 2; ++n) bv[bj][n] = bias ? *(const f32x4*)(bias + bcol0 + bj * HALF + 4 * n) : (f32x4){0.f, 0.f, 0.f, 0.f};
#pragma unroll
        for (int ai = 0; ai < 2; ++ai)
#pragma unroll
            for (int m = 0; m < 4; ++m) { bf16_t* rowp = base + (size_t)(row0 + ai * HALF + m * 16) * ldc + col0;
#pragma unroll
                for (int bj = 0; bj < 2; ++bj) { f32x4 v0 = acc[ai][bj][m][0] + bv[bj][0], v1 = acc[ai][bj][m][1] + bv[bj][1];
                    if (ACT == 1) { f32x2 a = gelu_pk((f32x2){v0[0], v0[1]}), b = gelu_pk((f32x2){v0[2], v0[3]}), c = gelu_pk((f32x2){v1[0], v1[1]}), d = gelu_pk((f32x2){v1[2], v1[3]});
                        v0 = (f32x4){a.x, a.y, b.x, b.y}; v1 = (f32x4){c.x, c.y, d.x, d.y}; }
                    v0 = v0 * sc; v1 = v1 * sc; u32x4 w; w.x = cvt_pk_bf16(v0[0], v0[1]); w.y = cvt_pk_bf16(v0[2], v0[3]); w.z = cvt_pk_bf16(v1[0], v1[1]); w.w = cvt_pk_bf16(v1[2], v1[3]);
                    __builtin_nontemporal_store(w, (u32x4*)(rowp + bj * HALF)); } }
    }
};
template <class Epi, class Sched, bool ALIGN_EPI = false, bool SP2 = false, bool GATHER = false, bool FP8 = false>
__device__ __forceinline__ void gemm_phase(PG8_LAS unsigned char* lds, const Gemm g, const Sched& S, const Epi& E) {
    int tid_ = threadIdx.x; asm volatile("" : "+v"(tid_));
    const int tid = tid_, wid = __builtin_amdgcn_readfirstlane(tid >> 6), lane = tid & 63, wr = wid >> 2, wc = wid & 3, fr = lane & 15, fq = lane >> 4;
    const int K = g.K, nt = K / BK;
    unsigned voffA[2], voffB[2], vA0[2], vA1[2], vN0[2], vN1[2]; int Rr_[2], Cc_[2];
#pragma unroll
    for (int i = 0; i < 2; ++i) { int R, C; stage_rc(tid * 16 + i * 8192, R, C); const int Rb = Epi::PERM ? ((R & ~31) + perm32(R & 31)) : R;
        voffA[i] = (unsigned)(R * K + C) * 2u; voffB[i] = (unsigned)(Rb * K + C) * 2u; Rr_[i] = R; Cc_[i] = C; }
    const size_t kstep = (size_t)(BK * 2);
    const size_t hstep = (size_t)HALF * K * 2;
    const size_t tstep = 2 * hstep;
#pragma unroll
    for (int i = 0; i < 2; ++i) { vA0[i] = voffA[i]; vA1[i] = voffA[i] + (unsigned)hstep; vN0[i] = vA0[i]; vN1[i] = vA1[i]; }
#define PG8_GLOAD(u, v0, v1) do { _Pragma("unroll") for (int _i = 0; _i < 2; ++_i) { const int _t0 = S.rowtok[(u).pm * BM + Rr_[_i]], _t1 = S.rowtok[(u).pm * BM + HALF + Rr_[_i]]; \
        (v0)[_i] = (unsigned)_t0 * (unsigned)(K * 2) + (unsigned)(Cc_[_i] * 2); (v1)[_i] = (unsigned)_t1 * (unsigned)(K * 2) + (unsigned)(Cc_[_i] * 2); } } while (0)
    const unsigned ldsw = (unsigned)wid * 1024u;
    const int aoff = lds_byte(wr * 64 + fr, fq * 8), boff = lds_byte(wc * 32 + fr, fq * 8);
#define PG8_SA(b, h) (((b) * 2 + (h)) * HTB)
#define PG8_SB(b, h) ((4 + (b) * 2 + (h)) * HTB)
#define PG8_STAGE(bufoff, gbase, voff) do { _Pragma("unroll") for (int _i = 0; _i < 2; ++_i) \
        __builtin_amdgcn_global_load_lds((const unsigned*)((const char*)(gbase) + (voff)[_i]), (PG8_LAS unsigned*)(lds + (bufoff) + ldsw + _i * 8192), 16, 0, 0); } while (0)
#define PG8_LDA(dst, b, h) do { _Pragma("unroll") for (int m = 0; m < 4; ++m) _Pragma("unroll") for (int k = 0; k < 2; ++k) dst[m][k] = *(const PG8_LAS bf16x8*)(lds + PG8_SA(b, h) + aoff + m * 2048 + k * 1024); } while (0)
#define PG8_LDB(dst, b, h) do { _Pragma("unroll") for (int n = 0; n < 2; ++n) _Pragma("unroll") for (int k = 0; k < 2; ++k) dst[n][k] = *(const PG8_LAS bf16x8*)(lds + PG8_SB(b, h) + boff + n * 2048 + k * 1024); } while (0)
#define PG8_MMA(ai, bj, At, Bt) do { __builtin_amdgcn_s_setprio(1); _Pragma("unroll") for (int m = 0; m < 4; ++m) _Pragma("unroll") for (int n = 0; n < 2; ++n) _Pragma("unroll") for (int k = 0; k < 2; ++k) \
        acc[ai][bj][m][n] = __builtin_amdgcn_mfma_f32_16x16x32_bf16(Bt[n][k], At[m][k], acc[ai][bj][m][n], 0, 0, 0); __builtin_amdgcn_s_setprio(0); } while (0)
#define PG8_CAT8(x0, x1) __builtin_shufflevector(__builtin_bit_cast(i32x4_, x0), __builtin_bit_cast(i32x4_, x1), 0, 1, 2, 3, 4, 5, 6, 7)
#define PG8_MFMA8(ACC, B8, A8) asm volatile("s_nop 1\n\tv_mfma_scale_f32_16x16x128_f8f6f4 %0, %1, %2, %0, %3, %3 op_sel_hi:[0,0,0]" : "+v"(ACC) : "v"(B8), "v"(A8), "v"(sc8_))
#define PG8_MMA8(ai, bj, At, Bt) do { i32x8_ a8_[4], b8_[2]; _Pragma("unroll") for (int m = 0; m < 4; ++m) a8_[m] = PG8_CAT8(At[m][0], At[m][1]); _Pragma("unroll") for (int n = 0; n < 2; ++n) b8_[n] = PG8_CAT8(Bt[n][0], Bt[n][1]); \
        __builtin_amdgcn_s_setprio(1); _Pragma("unroll") for (int m = 0; m < 4; ++m) _Pragma("unroll") for (int n = 0; n < 2; ++n) PG8_MFMA8(acc[ai][bj][m][n], b8_[n], a8_[m]); __builtin_amdgcn_s_setprio(0); } while (0)
#define PG8_MM(ai, bj, At, Bt) do { if constexpr (FP8) PG8_MMA8(ai, bj, At, Bt); else PG8_MMA(ai, bj, At, Bt); } while (0)
#define PG8_WAIT_V(n) asm volatile("s_waitcnt vmcnt(" #n ")" ::: "memory")
#define PG8_WAIT_L(n) asm volatile("s_waitcnt lgkmcnt(" #n ")" ::: "memory")
#define PG8_BAR __builtin_amdgcn_s_barrier()
#define PG8_SCHED __builtin_amdgcn_sched_barrier(0)
    const int sc8_ = 0x7F7F7F7F;
    Unit cur, nxt; int ui = 0;
    if (!S.next(0, cur)) return;
    f32x4 acc[2][2][4][2];
#pragma unroll
    for (int a = 0; a < 2; ++a)
#pragma unroll
        for (int b = 0; b < 2; ++b)
#pragma unroll
            for (int m = 0; m < 4; ++m)
#pragma unroll
                for (int n = 0; n < 2; ++n) acc[a][b][m][n] = (f32x4){0.f, 0.f, 0.f, 0.f};
    bf16x8 At[4][2], B0[2][2], B1[2][2];
    if constexpr (GATHER) PG8_GLOAD(cur, vA0, vA1);
    const char* cA = GATHER ? (const char*)g.A : (const char*)g.A + (size_t)cur.pm * tstep; const char* cB = (const char*)g.Bt + (size_t)cur.pn * tstep;
    S.a_ready(cur);
    if constexpr (SP2) {
        PG8_STAGE(PG8_SB(0, 0), cB, voffB); PG8_STAGE(PG8_SB(0, 1), cB + hstep, voffB); PG8_STAGE(PG8_SA(0, 0), cA, vA0); PG8_STAGE(PG8_SA(0, 1), cA, vA1);
        if (wr == 1) PG8_BAR;
        PG8_WAIT_V(2); PG8_BAR;
        PG8_STAGE(PG8_SB(1, 0), cB + kstep, voffB); PG8_STAGE(PG8_SA(1, 0), cA + kstep, vA0); PG8_STAGE(PG8_SB(1, 1), cB + hstep + kstep, voffB);
        PG8_WAIT_V(6); PG8_BAR;
    } else {
        PG8_STAGE(PG8_SB(0, 0), cB, voffB); PG8_STAGE(PG8_SA(0, 0), cA, vA0); PG8_STAGE(PG8_SB(0, 1), cB + hstep, voffB); PG8_STAGE(PG8_SA(0, 1), cA, vA1);
        if (wr == 1) PG8_BAR;
        PG8_WAIT_V(4); PG8_BAR;
        PG8_STAGE(PG8_SB(1, 0), cB + kstep, voffB); PG8_STAGE(PG8_SA(1, 0), cA + kstep, vA0); PG8_STAGE(PG8_SB(1, 1), cB + hstep + kstep, voffB);
        PG8_WAIT_V(6); PG8_BAR;
    }
    for (;;) {
        const bool has_next = S.next(ui + 1, nxt);
        if constexpr (GATHER) { if (has_next) PG8_GLOAD(nxt, vN0, vN1); else { _Pragma("unroll") for (int i = 0; i < 2; ++i) { vN0[i] = vA0[i]; vN1[i] = vA1[i]; } } }
        const char* nA = GATHER ? (const char*)g.A : (has_next ? (const char*)g.A + (size_t)nxt.pm * tstep : cA); const char* nB = has_next ? (const char*)g.Bt + (size_t)nxt.pn * tstep : cB;
        for (int t = 0; t < nt; t += 2) {
            const bool last = (t == nt - 2);
            const char* a1 = cA + (size_t)(t + 1) * kstep;
            const char* a2 = last ? nA : cA + (size_t)(t + 2) * kstep; const char* b2 = last ? nB : cB + (size_t)(t + 2) * kstep;
            const char* a3 = a2 + kstep; const char* b3 = b2 + kstep;
            unsigned vX0[2], vX1[2];
#pragma unroll
            for (int i = 0; i < 2; ++i) { vX0[i] = (GATHER && last) ? vN0[i] : vA0[i]; vX1[i] = (GATHER && last) ? vN1[i] : vA1[i]; }
            if (last && has_next) S.a_ready(nxt);
            if constexpr (SP2) {
            PG8_LDB(B0, 0, 0); PG8_LDB(B1, 0, 1); PG8_SCHED; PG8_LDA(At, 0, 0); PG8_STAGE(PG8_SA(1, 1), a1, vA1);
            PG8_WAIT_V(8); PG8_WAIT_L(0); PG8_BAR; PG8_MM(0, 0, At, B0); PG8_MM(0, 1, At, B1); PG8_BAR; PG8_SCHED;
            PG8_LDA(At, 0, 1); PG8_STAGE(PG8_SB(0, 0), b2, voffB); PG8_STAGE(PG8_SB(0, 1), b2 + hstep, voffB); PG8_STAGE(PG8_SA(0, 0), a2, vX0);
            PG8_WAIT_V(8); PG8_WAIT_L(0); PG8_BAR; PG8_MM(1, 0, At, B0); PG8_MM(1, 1, At, B1); PG8_BAR; PG8_SCHED;
            PG8_LDB(B0, 1, 0); PG8_LDB(B1, 1, 1); PG8_SCHED; PG8_LDA(At, 1, 0); PG8_STAGE(PG8_SA(0, 1), a2, vX1);
            PG8_WAIT_V(8); PG8_WAIT_L(0); PG8_BAR; PG8_MM(0, 0, At, B0); PG8_MM(0, 1, At, B1); PG8_BAR; PG8_SCHED;
            PG8_LDA(At, 1, 1); PG8_STAGE(PG8_SB(1, 0), b3, voffB); PG8_STAGE(PG8_SB(1, 1), b3 + hstep, voffB); PG8_STAGE(PG8_SA(1, 0), a3, vX0);
            PG8_WAIT_V(8); PG8_WAIT_L(0); PG8_BAR; PG8_MM(1, 0, At, B0); PG8_MM(1, 1, At, B1); PG8_BAR; PG8_SCHED;
            } else {
            PG8_LDB(B0, 0, 0); PG8_SCHED; PG8_LDA(At, 0, 0); PG8_STAGE(PG8_SA(1, 1), a1, vA1);
            PG8_WAIT_L(8); PG8_BAR; PG8_WAIT_L(0); PG8_MM(0, 0, At, B0); PG8_BAR; PG8_SCHED;
            PG8_LDB(B1, 0, 1); PG8_STAGE(PG8_SB(0, 0), b2, voffB);
            PG8_BAR; PG8_WAIT_L(0); PG8_MM(0, 1, At, B1); PG8_BAR;
            PG8_LDA(At, 0, 1); PG8_STAGE(PG8_SA(0, 0), a2, vX0);
            PG8_BAR; PG8_WAIT_L(0); PG8_MM(1, 0, At, B0); PG8_BAR; PG8_SCHED;
            PG8_STAGE(PG8_SB(0, 1), b2 + hstep, voffB);
            PG8_WAIT_V(6); PG8_BAR; PG8_MM(1, 1, At, B1); PG8_BAR;
            PG8_LDB(B0, 1, 0); PG8_SCHED; PG8_LDA(At, 1, 0); PG8_STAGE(PG8_SA(0, 1), a2, vX1);
            PG8_WAIT_L(8); PG8_BAR; PG8_WAIT_L(0); PG8_MM(0, 0, At, B0); PG8_BAR; PG8_SCHED;
            PG8_LDB(B1, 1, 1); PG8_STAGE(PG8_SB(1, 0), b3, voffB);
            PG8_BAR; PG8_WAIT_L(0); PG8_MM(0, 1, At, B1); PG8_BAR;
            PG8_LDA(At, 1, 1); PG8_STAGE(PG8_SA(1, 0), a3, vX0);
            PG8_BAR; PG8_WAIT_L(0); PG8_MM(1, 0, At, B0); PG8_BAR; PG8_SCHED;
            PG8_STAGE(PG8_SB(1, 1), b3 + hstep, voffB);
            PG8_WAIT_V(6); PG8_BAR; PG8_MM(1, 1, At, B1); PG8_BAR;
            }
        }
        if constexpr (ALIGN_EPI) { if (wr == 0) PG8_BAR; }
        if constexpr (FP8) asm volatile("s_nop 15\n\ts_nop 15" ::: "memory");
        if constexpr (!Epi::AFTER_DRAIN) { E(acc, cur, wr, wc, fr, fq); S.done(cur); }
        if (!has_next) break;
#pragma unroll
        for (int a = 0; a < 2; ++a)
#pragma unroll
            for (int b = 0; b < 2; ++b)
#pragma unroll
                for (int m = 0; m < 4; ++m)
#pragma unroll
                    for (int n = 0; n < 2; ++n) acc[a][b][m][n] = (f32x4){0.f, 0.f, 0.f, 0.f};
        cur = nxt; cA = nA; cB = nB; ++ui;
        if constexpr (GATHER) { _Pragma("unroll") for (int i = 0; i < 2; ++i) { vA0[i] = vN0[i]; vA1[i] = vN1[i]; } }
        if constexpr (ALIGN_EPI) { if (wr == 1) PG8_BAR; }
    }
    PG8_WAIT_V(0);
    if constexpr (!ALIGN_EPI) { if (wr == 0) PG8_BAR; }
    PG8_BAR;
    if constexpr (Epi::AFTER_DRAIN) { E.fused(acc, cur, wr, wc, fr, fq, lds, wid, lane); S.done(cur); }
#undef PG8_SA
#undef PG8_SB
#undef PG8_STAGE
#undef PG8_GLOAD
#undef PG8_LDA
#undef PG8_LDB
#undef PG8_MMA
#undef PG8_MMA8
#undef PG8_MFMA8
#undef PG8_MM
#undef PG8_CAT8
#undef PG8_WAIT_V
#undef PG8_WAIT_L
#undef PG8_BAR
#undef PG8_SCHED
}
}
namespace pg8 {
__device__ __forceinline__ float bf_lo(unsigned w) { return __builtin_bit_cast(float, w << 16); }
__device__ __forceinline__ float bf_hi(unsigned w) { return __builtin_bit_cast(float, w & 0xffff0000u); }
__device__ __forceinline__ float sigmoid_f(float x) { return __builtin_amdgcn_rcpf(1.0f + __expf(-x)); }

template <bool ADD> struct EpiGate {
    static constexpr bool PERM = true, AFTER_DRAIN = false;
    const bf16_t* G; const bf16_t* Min; bf16_t* O;
    __device__ __forceinline__ void operator()(const f32x4 (&acc)[2][2][4][2], const Unit& u, int wr, int wc, int fr, int fq) const {
        const int row0 = u.pm * BM + wr * 64 + fr, col0 = u.pn * BM + wc * 32 + 8 * fq;
#pragma unroll
        for (int ai = 0; ai < 2; ++ai)
#pragma unroll
            for (int m = 0; m < 4; ++m) { const size_t off = (size_t)(row0 + ai * HALF + m * 16) * 1024 + col0;
#pragma unroll
                for (int bj = 0; bj < 2; ++bj) {
                    const u32x4 g = *(const u32x4*)(G + off + bj * HALF);
                    f32x4 v0 = acc[ai][bj][m][0], v1 = acc[ai][bj][m][1];
                    v0[0] *= sigmoid_f(bf_lo(g.x)); v0[1] *= sigmoid_f(bf_hi(g.x)); v0[2] *= sigmoid_f(bf_lo(g.y)); v0[3] *= sigmoid_f(bf_hi(g.y));
                    v1[0] *= sigmoid_f(bf_lo(g.z)); v1[1] *= sigmoid_f(bf_hi(g.z)); v1[2] *= sigmoid_f(bf_lo(g.w)); v1[3] *= sigmoid_f(bf_hi(g.w));
                    if (ADD) { const u32x4 p = *(const u32x4*)(Min + off + bj * HALF);
                        v0[0] += bf_lo(p.x); v0[1] += bf_hi(p.x); v0[2] += bf_lo(p.y); v0[3] += bf_hi(p.y);
                        v1[0] += bf_lo(p.z); v1[1] += bf_hi(p.z); v1[2] += bf_lo(p.w); v1[3] += bf_hi(p.w); }
                    u32x4 w; w.x = cvt_pk_bf16(v0[0], v0[1]); w.y = cvt_pk_bf16(v0[2], v0[3]); w.z = cvt_pk_bf16(v1[0], v1[1]); w.w = cvt_pk_bf16(v1[2], v1[3]);
                    __builtin_nontemporal_store(w, (u32x4*)(O + off + bj * HALF)); } }
    }
};

struct EpiResid {
    static constexpr bool PERM = false, AFTER_DRAIN = false;
    const float* X; const float* gate; float* out; int rows_per_batch; int gstride;
    __device__ __forceinline__ void operator()(const f32x4 (&acc)[2][2][4][2], const Unit& u, int wr, int wc, int fr, int fq) const {
        const int col0 = u.pn * BM + wc * 32 + 4 * fq;
#pragma unroll
        for (int ai = 0; ai < 2; ++ai)
#pragma unroll
            for (int m = 0; m < 4; ++m) { const int row = u.pm * BM + ai * HALF + wr * 64 + m * 16 + fr; const size_t off = (size_t)row * 1024 + col0;
                const float* gp = gate + (size_t)(row / rows_per_batch) * gstride + col0;
#pragma unroll
                for (int bj = 0; bj < 2; ++bj)
#pragma unroll
                    for (int n = 0; n < 2; ++n) { const f32x4 xv = *(const f32x4*)(X + off + bj * HALF + n * 16); const f32x4 gv = *(const f32x4*)(gp + bj * HALF + n * 16);
                        *(f32x4*)(out + off + bj * HALF + n * 16) = xv + gv * acc[ai][bj][m][n]; } }
    }
};

__device__ __forceinline__ float swiglu1(float g, float l) {
    g = fminf(g, 7.0f); l = fminf(fmaxf(l, -7.0f), 7.0f);
    return (l + 1.0f) * (g * __builtin_amdgcn_rcpf(1.0f + __expf(-1.702f * g)));
}
__device__ __forceinline__ unsigned pk4_fp8(float a, float b, float c, float d) { int r = 0; r = __builtin_amdgcn_cvt_pk_fp8_f32(a, b, r, false); r = __builtin_amdgcn_cvt_pk_fp8_f32(c, d, r, true); return (unsigned)r; }
template <bool OUT8> struct EpiSwiglu {
    static constexpr bool PERM = true, AFTER_DRAIN = false;
    const float* b1; bf16_t* O; float ascale;
    __device__ __forceinline__ void operator()(const f32x4 (&acc)[2][2][4][2], const Unit& u, int wr, int wc, int fr, int fq) const {
        const int e = u.pn >> 3, pl = u.pn & 7, jc = wc * 32 + 8 * fq;
        const float* bg = b1 + (size_t)e * 2048 + 128 * pl + jc; const float* bl = bg + 1024;
        const f32x4 bg0 = *(const f32x4*)bg, bg1 = *(const f32x4*)(bg + 4), bl0 = *(const f32x4*)bl, bl1 = *(const f32x4*)(bl + 4);
        const int row0 = u.pm * BM + wr * 64 + fr;
#pragma unroll
        for (int ai = 0; ai < 2; ++ai)
#pragma unroll
            for (int m = 0; m < 4; ++m) {
                const f32x4 g0 = acc[ai][0][m][0] * ascale + bg0, g1 = acc[ai][0][m][1] * ascale + bg1, l0 = acc[ai][1][m][0] * ascale + bl0, l1 = acc[ai][1][m][1] * ascale + bl1;
                if constexpr (OUT8) { typedef unsigned u32x2_ __attribute__((ext_vector_type(2))); u32x2_ w;
                    w.x = pk4_fp8(swiglu1(g0[0], l0[0]), swiglu1(g0[1], l0[1]), swiglu1(g0[2], l0[2]), swiglu1(g0[3], l0[3])); w.y = pk4_fp8(swiglu1(g1[0], l1[0]), swiglu1(g1[1], l1[1]), swiglu1(g1[2], l1[2]), swiglu1(g1[3], l1[3]));
                    __builtin_nontemporal_store(w, (u32x2_*)((unsigned char*)O + (size_t)(row0 + ai * HALF + m * 16) * 1024 + 128 * pl + jc)); }
                else { u32x4 w; w.x = cvt_pk_bf16(swiglu1(g0[0], l0[0]), swiglu1(g0[1], l0[1])); w.y = cvt_pk_bf16(swiglu1(g0[2], l0[2]), swiglu1(g0[3], l0[3]));
                    w.z = cvt_pk_bf16(swiglu1(g1[0], l1[0]), swiglu1(g1[1], l1[1])); w.w = cvt_pk_bf16(swiglu1(g1[2], l1[2]), swiglu1(g1[3], l1[3]));
                    __builtin_nontemporal_store(w, (u32x4*)(O + (size_t)(row0 + ai * HALF + m * 16) * 1024 + 128 * pl + jc)); } }
    }
};

struct EpiOutS {
    static constexpr bool PERM = true, AFTER_DRAIN = false;
    bf16_t* O; const float* bias; float ascale;
    __device__ __forceinline__ void operator()(const f32x4 (&acc)[2][2][4][2], const Unit& u, int wr, int wc, int fr, int fq) const {
        const int row0 = u.pm * BM + wr * 64 + fr, col0 = (u.pn & 3) * BM + wc * 32 + 8 * fq, bcol0 = u.pn * BM + wc * 32 + 8 * fq;
        f32x4 bv[2][2];
#pragma unroll
        for (int bj = 0; bj < 2; ++bj)
#pragma unroll
            for (int n = 0; n < 2; ++n) bv[bj][n] = *(const f32x4*)(bias + bcol0 + bj * HALF + 4 * n);
#pragma unroll
        for (int ai = 0; ai < 2; ++ai)
#pragma unroll
            for (int m = 0; m < 4; ++m) { bf16_t* rowp = O + (size_t)(row0 + ai * HALF + m * 16) * 1024 + col0;
#pragma unroll
                for (int bj = 0; bj < 2; ++bj) { const f32x4 v0 = acc[ai][bj][m][0] * ascale + bv[bj][0], v1 = acc[ai][bj][m][1] * ascale + bv[bj][1];
                    u32x4 w; w.x = cvt_pk_bf16(v0[0], v0[1]); w.y = cvt_pk_bf16(v0[2], v0[3]); w.z = cvt_pk_bf16(v1[0], v1[1]); w.w = cvt_pk_bf16(v1[2], v1[3]);
                    __builtin_nontemporal_store(w, (u32x4*)(rowp + bj * HALF)); } }
    }
};

struct GroupedOrder {
    const PG8_LAS int* ts; int NT, G, c; const int* rowtok;
    __device__ __forceinline__ bool next(int i, Unit& u) const {
        const int total = __builtin_amdgcn_readfirstlane(ts[32]) * NT; const long L = (long)i * G + c; if (L >= total) return false;
        const int pm = (int)L / NT, pl = (int)L % NT; int e = 0;
#pragma unroll 1
        for (int j = 1; j < 32; ++j) e += (pm >= ts[j]) ? 1 : 0;
        u.pm = __builtin_amdgcn_readfirstlane(pm); u.pn = __builtin_amdgcn_readfirstlane(e * NT + pl); return true;
    }
    __device__ __forceinline__ void a_ready(const Unit&) const {}
    __device__ __forceinline__ void done(const Unit&) const {}
};
}
#define GAS __attribute__((address_space(1)))
#define LAS __attribute__((address_space(3)))
typedef unsigned short bf16;
typedef unsigned v4u __attribute__((ext_vector_type(4)));
typedef float f32x4 __attribute__((ext_vector_type(4)));
typedef short bf16x8 __attribute__((ext_vector_type(8)));
typedef GAS unsigned gu32;
typedef GAS unsigned long long gu64;
#define RLX_AGENT __ATOMIC_RELAXED, __HIP_MEMORY_SCOPE_AGENT
#define LDS_WAIT() asm volatile("s_waitcnt lgkmcnt(0)" ::: "memory")
#define VM_WAIT() asm volatile("s_waitcnt vmcnt(0)" ::: "memory")
__device__ __forceinline__ unsigned long long rt() { return __builtin_amdgcn_s_memrealtime(); }
__device__ __forceinline__ unsigned f2bf(float f) { unsigned u = __builtin_bit_cast(unsigned, f); return (u + 0x7fffu + ((u >> 16) & 1u)) >> 16; }
typedef float f32x2_pk __attribute__((ext_vector_type(2))); typedef __bf16 bf16x2_pk __attribute__((ext_vector_type(2)));
__device__ __forceinline__ unsigned pk2(float lo, float hi) { const f32x2_pk v = {lo, hi}; return __builtin_bit_cast(unsigned, __builtin_convertvector(v, bf16x2_pk)); }

#define XB_TMO      128
#define XB_XCNT(j)  (256  + 64 * (j))
#define XB_XSUB(j)  (1280 + 64 * (j))
#define XB_XGEN(j)  (2304 + 64 * (j))
#define XB_TOP      3328
#define XB_TOPGEN   3392
#define XCD_BAR_WORDS 3456
#define XB_SPIN_CAP (1u << 18)

__device__ __forceinline__ unsigned xb_ld(unsigned* p)              { return __hip_atomic_load(p, __ATOMIC_RELAXED, __HIP_MEMORY_SCOPE_AGENT); }
__device__ __forceinline__ unsigned xb_add(unsigned* p, unsigned v) { return __hip_atomic_fetch_add(p, v, __ATOMIC_RELAXED, __HIP_MEMORY_SCOPE_AGENT); }
__device__ __forceinline__ unsigned xb_xcc_id() { return (unsigned)__builtin_amdgcn_s_getreg((3 << 11) | 20) & 0xFu; }
#define XB_SPIN(cond, bar) do { unsigned _sp = 0; while (cond) { __builtin_amdgcn_s_sleep(1); \
    if ((++_sp & 255u) == 0u) { if (xb_ld(&(bar)[XB_TMO])) break; if (_sp > XB_SPIN_CAP) { atomicAdd(&(bar)[XB_TMO], 1u); break; } } } } while (0)

struct XcdBarrier {
    unsigned* bar; unsigned x;
    volatile LAS unsigned* st;
};

__device__ __forceinline__ XcdBarrier xcd_barrier_post(unsigned* bar, volatile LAS unsigned* st) {
    XcdBarrier b; b.bar = bar; b.x = xb_xcc_id(); b.st = st;
    if (threadIdx.x == 0) (void)xb_add(&bar[XB_XCNT(b.x)], 1u);
    return b;
}
__device__ __forceinline__ void xcd_barrier_complete(unsigned* bar, unsigned x, unsigned& nloc, unsigned& nx) {
    const unsigned G = gridDim.x * gridDim.y * gridDim.z;
    unsigned sum, cnt, mine, sp = 0u;
    for (;;) {
        sum = 0u; cnt = 0u; mine = 0u;
#pragma unroll
        for (unsigned j = 0; j < 16; ++j) { const unsigned c = xb_ld(&bar[XB_XCNT(j)]); sum += c; cnt += (c > 0u) ? 1u : 0u; mine = (j == x) ? c : mine; }
        if (sum == G) break;
        __builtin_amdgcn_s_sleep(1);
        if ((++sp & 255u) == 0u) { if (xb_ld(&bar[XB_TMO])) break; if (sp > XB_SPIN_CAP) { atomicAdd(&bar[XB_TMO], 1u); break; } }
    }
    nloc = mine > 0u ? mine : 1u; nx = cnt > 0u ? cnt : 1u;
}

__device__ __forceinline__ void xcd_barrier(const XcdBarrier& b) {
    asm volatile("s_waitcnt vmcnt(0)" ::: "memory");
    __syncthreads();
    if (threadIdx.x == 0) {
        unsigned* bar = b.bar;
        __builtin_amdgcn_s_waitcnt(0);
        unsigned nloc = b.st[0], nx = b.st[1];
        if (nloc == 0u) { xcd_barrier_complete(bar, b.x, nloc, nx); b.st[0] = nloc; b.st[1] = nx; }
        const unsigned old = xb_add(&bar[XB_XSUB(b.x)], 1u);
        const unsigned gen = old / nloc;
        if (old + 1u == (gen + 1u) * nloc) {
            __builtin_amdgcn_fence(__ATOMIC_RELEASE, "agent");
            asm volatile("s_waitcnt vmcnt(0)" ::: "memory");
            const unsigned og = xb_add(&bar[XB_TOP], 1u);
            const unsigned tg = og / nx;
            if (og + 1u == (tg + 1u) * nx) xb_add(&bar[XB_TOPGEN], 1u);
            else XB_SPIN(xb_ld(&bar[XB_TOPGEN]) == tg, bar);
            __builtin_amdgcn_fence(__ATOMIC_ACQUIRE, "agent");
            xb_add(&bar[XB_XGEN(b.x)], 1u);
            asm volatile("s_waitcnt vmcnt(0)" ::: "memory");
        } else {
            XB_SPIN(xb_ld(&bar[XB_XGEN(b.x)]) == gen, bar);
            __builtin_amdgcn_fence(__ATOMIC_ACQUIRE, "agent");
            asm volatile("s_waitcnt vmcnt(0)" ::: "memory");
        }
    }
    __syncthreads();
}

constexpr int NWAVES = 8;
constexpr int BATCH = 16, SEQ = 2048, D = 1024, T = BATCH * SEQ;
constexpr int NIN = 9224, NPROJ = 9216, NMOD = 6 * D;
constexpr int NE = 32, TOPK = 4;
constexpr int XS_ROWS = T * TOPK + NE * 256;
constexpr float EPS = 1e-6f;
constexpr float ATT_RTHR = -120.0f;
constexpr float W8SCALE = 64.0f;
constexpr float QSCALE = 0.125f * 1.4426950408889634f;

constexpr size_t MiB = 1u << 20;
constexpr size_t WS_CTL = 0, CTL_ZERO_BYTES = 1 * MiB;
constexpr size_t WS_MODP = 1 * MiB;
constexpr size_t WS_MOD = 3 * MiB;
constexpr size_t WS_IPRE = 4 * MiB, WS_LF = 4 * MiB + 512 * 1024;
constexpr size_t WS_TOKE = 5 * MiB, WS_TOKP = 5 * MiB + 512 * 1024, WS_TOKW = 6 * MiB, WS_TOKROW = 6 * MiB + 512 * 1024, WS_RSTD = 7 * MiB;
constexpr size_t WS_WIN = 8 * MiB, WS_WA = 26 * MiB, WS_WB = 28 * MiB, WS_WOUT = 30 * MiB, WS_W1 = 32 * MiB, WS_W2 = 160 * MiB;
constexpr size_t WS_H1 = 224 * MiB;
constexpr size_t WS_PROJ = 288 * MiB, SEG = 64 * MiB;
constexpr size_t WS_YB = 864 * MiB;
constexpr size_t WS_XS = 288 * MiB, WS_ACT = 560 * MiB;
constexpr size_t WS_ROW2TOK = 7 * MiB + 128 * 1024;
constexpr size_t WS_GT = 928 * MiB;
constexpr size_t WS_END = 932 * MiB;
static_assert(WS_XS + (size_t)XS_ROWS * 2048 <= WS_ACT && WS_ACT + (size_t)XS_ROWS * 2048 <= WS_YB, "ws map");
constexpr int CW_TMO = 0, CW_BAR = 4096, CW_ECNT = 8192;

constexpr int RING_BYTES = 131072, LDS_BYTES = 147456, LDSCTL_OFF = 146432;
constexpr int LC_BAR = 0, LC_TS = 16, LC_LCNT = 64, LC_GBASE = 96, LC_PS = 128, LC_CNT = 160;

__device__ __forceinline__ unsigned long long karg(int i) { return ((const __attribute__((address_space(4))) unsigned long long*)__builtin_amdgcn_kernarg_segment_ptr())[i]; }
struct Frame {
    LAS unsigned char* lds; volatile LAS unsigned* LC;
    gu32* ctl; unsigned char* ws; int tid, lane, wave, vcu, G;
    __device__ __forceinline__ const float* x() const { return (const float*)(const GAS float*)karg(0); }
    __device__ __forceinline__ const float* c() const { return (const float*)(const GAS float*)karg(1); }
    __device__ __forceinline__ const float* ada_w() const { return (const float*)(const GAS float*)karg(2); }
    __device__ __forceinline__ const float* ada_b() const { return (const float*)(const GAS float*)karg(3); }
    __device__ __forceinline__ const float* norm1_g() const { return (const float*)(const GAS float*)karg(4); }
    __device__ __forceinline__ const float* w_in() const { return (const float*)(const GAS float*)karg(5); }
    __device__ __forceinline__ const float* conv_w() const { return (const float*)(const GAS float*)karg(6); }
    __device__ __forceinline__ const float* conv_b() const { return (const float*)(const GAS float*)karg(7); }
    __device__ __forceinline__ const float* b_i() const { return (const float*)(const GAS float*)karg(8); }
    __device__ __forceinline__ const float* b_f() const { return (const float*)(const GAS float*)karg(9); }
    __device__ __forceinline__ const float* ml_norm_g() const { return (const float*)(const GAS float*)karg(10); }
    __device__ __forceinline__ const float* w_a() const { return (const float*)(const GAS float*)karg(11); }
    __device__ __forceinline__ const float* w_b() const { return (const float*)(const GAS float*)karg(12); }
    __device__ __forceinline__ const float* w_out() const { return (const float*)(const GAS float*)karg(13); }
    __device__ __forceinline__ const float* norm2_g() const { return (const float*)(const GAS float*)karg(14); }
    __device__ __forceinline__ const float* router_w() const { return (const float*)(const GAS float*)karg(15); }
    __device__ __forceinline__ const float* router_b() const { return (const float*)(const GAS float*)karg(16); }
    __device__ __forceinline__ const float* w1() const { return (const float*)(const GAS float*)karg(17); }
    __device__ __forceinline__ const float* b1() const { return (const float*)(const GAS float*)karg(18); }
    __device__ __forceinline__ const float* w2() const { return (const float*)(const GAS float*)karg(19); }
    __device__ __forceinline__ const float* b2() const { return (const float*)(const GAS float*)karg(20); }
    __device__ __forceinline__ const float* final_g() const { return (const float*)(const GAS float*)karg(21); }
    __device__ __forceinline__ float* out() const { return (float*)(GAS float*)karg(22); }
    __device__ __forceinline__ float* modp() const { return (float*)(ws + WS_MODP); }
    __device__ __forceinline__ float* mod() const { return (float*)(ws + WS_MOD); }
    __device__ __forceinline__ float* ipre() const { return (float*)(ws + WS_IPRE); }
    __device__ __forceinline__ float* lf() const { return (float*)(ws + WS_LF); }
    __device__ __forceinline__ float* tokw() const { return (float*)(ws + WS_TOKW); }
    __device__ __forceinline__ float* rstd2() const { return (float*)(ws + WS_RSTD); }
    __device__ __forceinline__ int* toke() const { return (int*)(ws + WS_TOKE); }
    __device__ __forceinline__ int* tokp() const { return (int*)(ws + WS_TOKP); }
    __device__ __forceinline__ int* tokrow() const { return (int*)(ws + WS_TOKROW); }
    __device__ __forceinline__ bf16* WIN_T() const { return (bf16*)(ws + WS_WIN); }
    __device__ __forceinline__ bf16* WA_T() const { return (bf16*)(ws + WS_WA); }
    __device__ __forceinline__ bf16* WB_T() const { return (bf16*)(ws + WS_WB); }
    __device__ __forceinline__ bf16* WOUT_T() const { return (bf16*)(ws + WS_WOUT); }
    __device__ __forceinline__ bf16* W1_T() const { return (bf16*)(ws + WS_W1); }
    __device__ __forceinline__ bf16* W2_T() const { return (bf16*)(ws + WS_W2); }
    __device__ __forceinline__ bf16* H1() const { return (bf16*)(ws + WS_H1); }
    __device__ __forceinline__ bf16* PROJ() const { return (bf16*)(ws + WS_PROJ); }
    __device__ __forceinline__ bf16* YA() const { return (bf16*)(ws + WS_H1); }
    __device__ __forceinline__ bf16* YB() const { return (bf16*)(ws + WS_YB); }
    __device__ __forceinline__ bf16* M1() const { return (bf16*)(ws + WS_PROJ); }
    __device__ __forceinline__ bf16* MERGED() const { return (bf16*)(ws + WS_PROJ + SEG); }
    __device__ __forceinline__ bf16* XS() const { return (bf16*)(ws + WS_XS); }
    __device__ __forceinline__ bf16* ACT() const { return (bf16*)(ws + WS_ACT); }
    __device__ __forceinline__ bf16* OUTR() const { return (bf16*)(ws + WS_XS); }
    __device__ __forceinline__ bf16* H2() const { return (bf16*)(ws + WS_XS); }
    __device__ __forceinline__ int* row2tok() const { return (int*)(ws + WS_ROW2TOK); }
    __device__ __forceinline__ float* gt() const { return (float*)(ws + WS_GT); }
};

__device__ __forceinline__ int opq(int v) { asm volatile("" : "+v"(v)); return v; }
__device__ __forceinline__ float wave_sum(float v) {
#pragma unroll
    for (int o = 1; o < 64; o <<= 1) v += __shfl_xor(v, o);
    return v;
}
__device__ __forceinline__ float bf2f(unsigned short b) { return __builtin_bit_cast(float, (unsigned)b << 16); }
__device__ __forceinline__ float bflo(unsigned w) { return __builtin_bit_cast(float, w << 16); }
__device__ __forceinline__ float bfhi(unsigned w) { return __builtin_bit_cast(float, w & 0xffff0000u); }
__device__ __forceinline__ float log_sigmoid_f(float x) { return fminf(x, 0.f) - log1pf(expf(-fabsf(x))); }

struct MapIn { __device__ __forceinline__ long operator()(int n) const { return n < 7168 ? (long)n : (n < 7176 ? -1L : (n < NIN ? (long)(n - 8) : -1L)); } };
struct MapId { long off; __device__ __forceinline__ long operator()(int n) const { return off + n; } };
struct MapW1 { int e; __device__ __forceinline__ long operator()(int n) const { return (long)e * 2048 + ((n & 1023) >> 7) * 256 + (n >> 10) * 128 + (n & 127); } };

template <class Map> __device__ __forceinline__ void transpose_item(const float* W, int K, int N, bf16* WT, LAS float* scr, int item, int lane, Map map, float scale8 = 0.f) {
    const int nblk = (N + 31) / 32, kb = item / nblk, nb = item % nblk, k0 = 64 * kb, n0 = 32 * nb;
    const int n4 = 4 * (lane & 7), kr = lane >> 3;
    const bool ok = (n0 + n4 + 3) < N;
    f32x4 v[8];
#pragma unroll
    for (int i = 0; i < 8; ++i) v[i] = ok ? *(const f32x4*)(W + (size_t)(k0 + 8 * i + kr) * N + n0 + n4) : (f32x4){0.f, 0.f, 0.f, 0.f};
#pragma unroll
    for (int i = 0; i < 8; ++i) { LAS float* d = scr + (8 * i + kr) * 33 + n4; d[0] = v[i].x; d[1] = v[i].y; d[2] = v[i].z; d[3] = v[i].w; }
    LDS_WAIT(); asm volatile("" ::: "memory");
    const int c = lane & 7;
#pragma unroll
    for (int j = 0; j < 4; ++j) { const int n = (lane >> 3) + 8 * j; const LAS float* s = scr + (8 * c) * 33 + n;
        const long dr = map(n0 + n);
        if (scale8 != 0.f) { typedef unsigned u32x2_ __attribute__((ext_vector_type(2))); u32x2_ o;
            o.x = pg8::pk4_fp8(s[0 * 33] * scale8, s[1 * 33] * scale8, s[2 * 33] * scale8, s[3 * 33] * scale8); o.y = pg8::pk4_fp8(s[4 * 33] * scale8, s[5 * 33] * scale8, s[6 * 33] * scale8, s[7 * 33] * scale8);
            if (dr >= 0) *(GAS u32x2_*)((unsigned char*)WT + (size_t)dr * K + k0 + 8 * c) = o; }
        else { v4u o; o.x = pk2(s[0 * 33], s[1 * 33]); o.y = pk2(s[2 * 33], s[3 * 33]); o.z = pk2(s[4 * 33], s[5 * 33]); o.w = pk2(s[6 * 33], s[7 * 33]);
            if (dr >= 0) *(GAS v4u*)(WT + (size_t)dr * K + k0 + 8 * c) = o; } }
    LDS_WAIT(); asm volatile("" ::: "memory");
}
__device__ __forceinline__ void mod_item(Frame& F, const LAS float* sil, int it) {
    const int j = it % 96, kq = it / 96, n = 64 * j + F.lane, k0 = 256 * kq;
    float acc[16];
#pragma unroll
    for (int b = 0; b < 16; ++b) acc[b] = 0.f;
    const float* w = F.ada_w() + (size_t)k0 * NMOD + n;
    const LAS f32x4* s = (const LAS f32x4*)sil + k0 * 4;
    for (int kk = 0; kk < 256; kk += 8) {
        float wv[8];
#pragma unroll
        for (int u = 0; u < 8; ++u) wv[u] = w[(size_t)(kk + u) * NMOD];
#pragma unroll
        for (int u = 0; u < 8; ++u) {
#pragma unroll
            for (int q = 0; q < 4; ++q) { const f32x4 sv = s[(kk + u) * 4 + q]; acc[4 * q + 0] += sv.x * wv[u]; acc[4 * q + 1] += sv.y * wv[u]; acc[4 * q + 2] += sv.z * wv[u]; acc[4 * q + 3] += sv.w * wv[u]; }
        }
    }
    float* o = F.modp() + (size_t)kq * 16 * NMOD + n;
#pragma unroll
    for (int b = 0; b < 16; ++b) o[(size_t)b * NMOD] = acc[b];
}
__device__ __forceinline__ void p0_prologue(Frame& F) {
    LAS float* sil = (LAS float*)F.lds;
    for (int idx = F.tid; idx < 16384; idx += 512) { const int b = idx >> 10, k = idx & 1023; const float v = F.c()[idx]; sil[k * 16 + b] = v / (1.0f + __expf(-v)); }
    __syncthreads();
    LAS float* scr = (LAS float*)(F.lds + 65536 + F.wave * 8704);
    const int gw = F.vcu * NWAVES + F.wave, NGW = F.G * NWAVES;
    constexpr int I_MOD = 384, I_IN = 16 * 289, I_SQ = 16 * 32, I_W1 = 32 * 16 * 64, I_W2 = 32 * 16 * 32;
    constexpr int NITEMS = I_MOD + I_IN + 3 * I_SQ + I_W1 + I_W2;
    for (int it = gw; it < NITEMS; it += NGW) {
        int r = it;
        if (r < I_MOD) { mod_item(F, sil, r); continue; } r -= I_MOD;
        if (r < I_IN) { transpose_item(F.w_in(), D, NIN, F.WIN_T(), scr, r, F.lane, MapIn{}); continue; } r -= I_IN;
        if (r < I_SQ) { transpose_item(F.w_a(), D, D, F.WA_T(), scr, r, F.lane, MapId{0}); continue; } r -= I_SQ;
        if (r < I_SQ) { transpose_item(F.w_b(), D, D, F.WB_T(), scr, r, F.lane, MapId{0}); continue; } r -= I_SQ;
        if (r < I_SQ) { transpose_item(F.w_out(), D, D, F.WOUT_T(), scr, r, F.lane, MapId{0}); continue; } r -= I_SQ;
        if (r < I_W1) { const int e = r >> 10; transpose_item(F.w1() + (size_t)e * D * 2048, D, 2048, F.W1_T(), scr, r & 1023, F.lane, MapW1{e}, W8SCALE); continue; } r -= I_W1;
        { const int e = r >> 9; transpose_item(F.w2() + (size_t)e * D * D, D, D, F.W2_T(), scr, r & 511, F.lane, MapId{(long)e * 1024}, W8SCALE); }
    }
}

__device__ __forceinline__ void p1_rows(Frame& F) {
    const int row0 = F.vcu * 128, b = row0 / SEQ, lane = opq(F.lane);
    LAS float* wif = (LAS float*)F.lds;
    for (int idx = F.tid; idx < 8192; idx += 512) wif[idx] = F.w_in()[(size_t)(idx >> 3) * NIN + 7168 + (idx & 7)];
    for (int idx = F.vcu * 512 + F.tid; idx < 16 * NMOD; idx += F.G * 512) { float s = F.ada_b()[idx % NMOD];
#pragma unroll
        for (int kq = 0; kq < 4; ++kq) s += F.modp()[(size_t)kq * 16 * NMOD + idx];
        F.mod()[idx] = s; }
    f32x4 Av[4], Bv[4];
#pragma unroll
    for (int j = 0; j < 4; ++j) { const int col = 4 * lane + 256 * j;
        f32x4 sh = *(const f32x4*)(F.ada_b() + col), sc = *(const f32x4*)(F.ada_b() + D + col);
#pragma unroll
        for (int kq = 0; kq < 4; ++kq) { sh += *(const f32x4*)(F.modp() + ((size_t)kq * 16 + b) * NMOD + col); sc += *(const f32x4*)(F.modp() + ((size_t)kq * 16 + b) * NMOD + D + col); }
        const f32x4 g = *(const f32x4*)(F.norm1_g() + col); Av[j] = g * (sc + 1.0f); Bv[j] = sh; }
    __syncthreads();
    f32x4 nx[4];
    { const GAS f32x4* xr = (const GAS f32x4*)(F.x() + (size_t)(row0 + 16 * F.wave) * D) + lane;
#pragma unroll
      for (int j = 0; j < 4; ++j) nx[j] = xr[64 * j]; }
    for (int r = 0; r < 16; ++r) {
        const int row = row0 + 16 * F.wave + r;
        f32x4 v[4]; float ss = 0.f;
#pragma unroll
        for (int j = 0; j < 4; ++j) { v[j] = nx[j]; ss += (v[j].x * v[j].x + v[j].y * v[j].y) + (v[j].z * v[j].z + v[j].w * v[j].w); }
        if (r < 15) { const GAS f32x4* xr = (const GAS f32x4*)(F.x() + (size_t)(row + 1) * D) + lane;
#pragma unroll
            for (int j = 0; j < 4; ++j) nx[j] = xr[64 * j]; }
        const float rstd = 1.0f / sqrtf(wave_sum(ss) * (1.0f / D) + EPS);
        GAS unsigned long long* o8 = (GAS unsigned long long*)(F.H1() + (size_t)row * D) + lane;
        float p[8];
#pragma unroll
        for (int q = 0; q < 8; ++q) p[q] = 0.f;
#pragma unroll
        for (int j = 0; j < 4; ++j) { v[j] = v[j] * rstd * Av[j] + Bv[j];
            o8[64 * j] = (unsigned long long)pk2(v[j].x, v[j].y) | ((unsigned long long)pk2(v[j].z, v[j].w) << 32);
#pragma unroll
            for (int i = 0; i < 4; ++i) { const LAS f32x4* wp = (const LAS f32x4*)(wif + (4 * lane + 256 * j + i) * 8); const f32x4 w0 = wp[0], w1 = wp[1]; const float hv = v[j][i];
                p[0] += hv * w0.x; p[1] += hv * w0.y; p[2] += hv * w0.z; p[3] += hv * w0.w; p[4] += hv * w1.x; p[5] += hv * w1.y; p[6] += hv * w1.z; p[7] += hv * w1.w; } }
#pragma unroll
        for (int q = 0; q < 8; ++q) p[q] = wave_sum(p[q]);
        if (lane == 0) { const int t = row % SEQ;
#pragma unroll
            for (int hh = 0; hh < 4; ++hh) { F.ipre()[((size_t)b * 4 + hh) * SEQ + t] = p[hh] + F.b_i()[hh]; F.lf()[((size_t)b * 4 + hh) * SEQ + t] = log_sigmoid_f(p[4 + hh] + F.b_f()[hh]); } }
    }
}

__device__ __forceinline__ void attn_naive_item(Frame& F, int bh, int qblk) {
    const int b = bh >> 4, hd = bh & 15, t = qblk * 512 + F.tid;
    const bf16* Q = F.PROJ(); const bf16* K = F.PROJ() + SEG / 2; const bf16* V = F.PROJ() + SEG;
    const size_t rowb = (size_t)b * SEQ;
    float q[64], o[64];
    { const v4u* qp = (const v4u*)(Q + (rowb + t) * D + hd * 64);
#pragma unroll
      for (int i = 0; i < 8; ++i) { const v4u w = qp[i]; q[8 * i + 0] = bflo(w.x); q[8 * i + 1] = bfhi(w.x); q[8 * i + 2] = bflo(w.y); q[8 * i + 3] = bfhi(w.y); q[8 * i + 4] = bflo(w.z); q[8 * i + 5] = bfhi(w.z); q[8 * i + 6] = bflo(w.w); q[8 * i + 7] = bfhi(w.w); } }
#pragma unroll
    for (int i = 0; i < 64; ++i) o[i] = 0.f;
    float R = 0.f;
    LAS v4u* kt = (LAS v4u*)F.lds; LAS v4u* vt = (LAS v4u*)(F.lds + 8192);
    const int tmax_wave = qblk * 512 + F.wave * 64 + 63;
    bool wdone = false;
    LAS volatile int* dflag = (LAS volatile int*)(F.lds + 16384);
    if (F.tid < 8) dflag[F.tid] = 0;
    for (int tile = qblk * 8 + 7; tile >= 0; --tile) {
        __syncthreads();
        { int nd = 0;
#pragma unroll
          for (int w = 0; w < 8; ++w) nd += dflag[w];
          if (nd == 8) break; }
        { const int kr = F.tid >> 3, ch = F.tid & 7; const size_t g = (rowb + tile * 64 + kr) * D + hd * 64 + ch * 8;
          kt[F.tid] = *(const v4u*)(K + g); vt[F.tid] = *(const v4u*)(V + g); }
        __syncthreads();
        if (tile * 64 >= tmax_wave) continue;
        if (wdone) continue;
        for (int s = 63; s >= 0; --s) {
            const int key = tile * 64 + s;
            float z = 0.f;
#pragma unroll
            for (int i = 0; i < 8; ++i) { const v4u w = kt[s * 8 + i]; z += q[8 * i + 0] * bflo(w.x) + q[8 * i + 1] * bfhi(w.x) + q[8 * i + 2] * bflo(w.y) + q[8 * i + 3] * bfhi(w.y) + q[8 * i + 4] * bflo(w.z) + q[8 * i + 5] * bfhi(w.z) + q[8 * i + 6] * bflo(w.w) + q[8 * i + 7] * bfhi(w.w); }
            const float lb = fminf(z, 0.f) - __builtin_amdgcn_logf(1.0f + __builtin_amdgcn_exp2f(-fabsf(z)));
            const bool act = key < t;
            const float a = act ? __builtin_amdgcn_exp2f(lb + R) : 0.f;
            R += act ? (lb - z) : 0.f;
#pragma unroll
            for (int i = 0; i < 8; ++i) { const v4u w = vt[s * 8 + i]; o[8 * i + 0] += a * bflo(w.x); o[8 * i + 1] += a * bfhi(w.x); o[8 * i + 2] += a * bflo(w.y); o[8 * i + 3] += a * bfhi(w.y); o[8 * i + 4] += a * bflo(w.z); o[8 * i + 5] += a * bfhi(w.z); o[8 * i + 6] += a * bflo(w.w); o[8 * i + 7] += a * bfhi(w.w); }
        }
        if (__all(R < ATT_RTHR) && !wdone) { wdone = true; if (F.lane == 0) dflag[F.wave] = 1; }
    }
    __syncthreads();
    v4u* op = (v4u*)(F.YA() + (rowb + t) * D + hd * 64);
#pragma unroll
    for (int i = 0; i < 8; ++i) { v4u w; w.x = pk2(o[8 * i + 0], o[8 * i + 1]); w.y = pk2(o[8 * i + 2], o[8 * i + 3]); w.z = pk2(o[8 * i + 4], o[8 * i + 5]); w.w = pk2(o[8 * i + 6], o[8 * i + 7]); op[i] = w; }
}

__device__ __forceinline__ void mlstm_naive_item(Frame& F, int bh) {
    const int b = bh >> 2, hh = bh & 3, tid = opq(F.tid), e = tid & 255, half = tid >> 8;
    const bf16* MLQ = F.PROJ() + 3 * (SEG / 2); const bf16* MLK = F.PROJ() + 4 * (SEG / 2); const bf16* MLV = F.PROJ() + 5 * (SEG / 2); const bf16* MLO = F.PROJ() + 6 * (SEG / 2);
    LAS float* ql = (LAS float*)F.lds; LAS float* kl = ql + 8192; LAS float* vl = kl + 8192; LAS float* hl = vl + 8192;
    LAS float* part = hl + 8192;
    LAS float* red = part + 512;
    LAS float* il = red + 8; LAS float* fl = il + 32;
    const size_t rowb = (size_t)b * SEQ;
    float C[128];
#pragma unroll
    for (int i = 0; i < 128; ++i) C[i] = 0.f;
    float nreg = 0.f, m = 0.f;
    float cw[2][4], cb[2];
    { const int c = tid & 255;
#pragma unroll
      for (int z = 0; z < 2; ++z) { const int ch = z * 1024 + hh * 256 + c; cb[z] = F.conv_b()[ch];
#pragma unroll
          for (int tap = 0; tap < 4; ++tap) cw[z][tap] = F.conv_w()[tap * 2048 + ch]; } }
    for (int chunk = 0; chunk < SEQ / 32; ++chunk) {
        const int t0 = chunk * 32;
        __syncthreads();
        { const int c = tid & 255;
          for (int u = 0; u < 16; ++u) { const int tt = (tid >> 8) + 2 * u, t = t0 + tt; float yq = cb[0], yk = cb[1];
#pragma unroll
              for (int tap = 0; tap < 4; ++tap) { const int ts = t - 3 + tap; if (ts >= 0) { const size_t g = (rowb + ts) * D + hh * 256 + c; yq += cw[0][tap] * bf2f(MLQ[g]); yk += cw[1][tap] * bf2f(MLK[g]); } }
              ql[tt * 256 + c] = yq / (1.0f + __expf(-yq)); kl[tt * 256 + c] = (yk / (1.0f + __expf(-yk))) * 0.0625f;
              vl[tt * 256 + c] = bf2f(MLV[(rowb + t) * D + hh * 256 + c]); }
          if (tid < 32) { il[tid] = F.ipre()[((size_t)b * 4 + hh) * SEQ + t0 + tid]; fl[tid] = F.lf()[((size_t)b * 4 + hh) * SEQ + t0 + tid]; } }
        __syncthreads();
        for (int tt = 0; tt < 32; ++tt) {
            const float lfv = fl[tt], iv = il[tt];
            const float mn = fmaxf(lfv + m, iv), fp = __expf(lfv + m - mn), ip = __expf(iv - mn); m = mn;
            const float vv = vl[tt * 256 + e] * ip;
            const LAS f32x4* kq = (const LAS f32x4*)(kl + tt * 256 + 128 * half); const LAS f32x4* qq = (const LAS f32x4*)(ql + tt * 256 + 128 * half);
            float num = 0.f;
#pragma unroll
            for (int i = 0; i < 32; ++i) { const f32x4 kv = kq[i], qv = qq[i];
                C[4 * i + 0] = fp * C[4 * i + 0] + kv.x * vv; C[4 * i + 1] = fp * C[4 * i + 1] + kv.y * vv; C[4 * i + 2] = fp * C[4 * i + 2] + kv.z * vv; C[4 * i + 3] = fp * C[4 * i + 3] + kv.w * vv;
                num += (qv.x * C[4 * i + 0] + qv.y * C[4 * i + 1]) + (qv.z * C[4 * i + 2] + qv.w * C[4 * i + 3]); }
            const int buf = tt & 1;
            if (tid < 256) { nreg = fp * nreg + ip * kl[tt * 256 + tid]; const float pd = wave_sum(ql[tt * 256 + tid] * nreg); if (F.lane == 0) red[buf * 4 + F.wave] = pd; }
            else part[buf * 256 + e] = num;
            __syncthreads();
            if (tid < 256) { num += part[buf * 256 + e]; const float den = (red[buf * 4 + 0] + red[buf * 4 + 1]) + (red[buf * 4 + 2] + red[buf * 4 + 3]);
                hl[tt * 256 + e] = num / fmaxf(fabsf(den), __expf(-m)); }
        }
        __syncthreads();
        for (int r = 0; r < 4; ++r) { const int tt = 4 * F.wave + r; const size_t row = rowb + t0 + tt;
            const f32x4 hv = *(const LAS f32x4*)(hl + tt * 256 + 4 * F.lane);
            const float ss = wave_sum((hv.x * hv.x + hv.y * hv.y) + (hv.z * hv.z + hv.w * hv.w));
            const float rstd = 1.0f / sqrtf(ss * (1.0f / 256.0f) + EPS);
            const int col = hh * 256 + 4 * F.lane; const f32x4 g = *(const f32x4*)(F.ml_norm_g() + col);
            const unsigned long long ow = *(const unsigned long long*)(MLO + row * D + col);
            const float o0 = bflo((unsigned)ow), o1 = bfhi((unsigned)ow), o2 = bflo((unsigned)(ow >> 32)), o3 = bfhi((unsigned)(ow >> 32));
            const float y0 = hv.x * rstd * g.x / (1.0f + __expf(-o0)), y1 = hv.y * rstd * g.y / (1.0f + __expf(-o1)), y2 = hv.z * rstd * g.z / (1.0f + __expf(-o2)), y3 = hv.w * rstd * g.w / (1.0f + __expf(-o3));
            *(unsigned long long*)(F.YB() + row * D + col) = (unsigned long long)pk2(y0, y1) | ((unsigned long long)pk2(y2, y3) << 32); }
    }
}


namespace ml {
typedef short bf16x8 __attribute__((ext_vector_type(8)));
typedef short s16x4 __attribute__((ext_vector_type(4)));
typedef float f32x16 __attribute__((ext_vector_type(16)));
typedef LAS const char* lcp;
typedef LAS char* lp_t;
constexpr int L = 64;
constexpr int O_QI = 0, O_KI = 33792, O_CB = 67584, O_VI = 102400, O_VW = 111616, O_PI = 120832, O_F = 130048;
constexpr int F_NV = 0, F_QNP = 256, F_RSP = 768, F_AT = 896, F_US = 960, F_WIN = 1024, F_EDEN = 1088, F_WST = 1152, F_RDEN = 1216, F_CW = 1280, F_CBIAS = 3328;
__device__ __forceinline__ int crow(int r, int hi) { return (r & 3) + 8 * (r >> 2) + 4 * hi; }
template <int PITCH, int XM> __device__ __forceinline__ int ioff(int row, int ch) { return XM ? PITCH * row + 16 * (ch ^ (row & XM)) : PITCH * row + 16 * ch; }
template <int PITCH, int XM> __device__ __forceinline__ bf16x8 frag_row(lcp img, int row0, int s, int lane) {
    return *(LAS const bf16x8*)(img + ioff<PITCH, XM>(row0 + (lane & 31), 2 * s + (lane >> 5)));
}
template <int PITCH, int XM> __device__ __forceinline__ bf16x8 frag_tr(lcp img, int k0, int ks, int col0, int lane) {
    const int h = lane >> 5, blk = (lane >> 4) & 1, q = (lane & 15) >> 2, p = lane & 3;
    const int r0 = k0 + 16 * ks + 8 * h + q, ch = (col0 >> 3) + 2 * blk + (p >> 1);
    typedef short v4i16_t __attribute__((ext_vector_type(4)));
    const s16x4 a = __builtin_bit_cast(s16x4, __builtin_amdgcn_ds_read_tr16_b64_v4i16((LAS v4i16_t*)(img + ioff<PITCH, XM>(r0, ch) + 8 * (p & 1))));
    const s16x4 b = __builtin_bit_cast(s16x4, __builtin_amdgcn_ds_read_tr16_b64_v4i16((LAS v4i16_t*)(img + ioff<PITCH, XM>(r0 + 4, ch) + 8 * (p & 1))));
    return (bf16x8){a[0], a[1], a[2], a[3], b[0], b[1], b[2], b[3]};
}
__device__ __forceinline__ float half_sum(float v) {
    const auto rr = __builtin_amdgcn_permlane32_swap(__builtin_bit_cast(unsigned, v), __builtin_bit_cast(unsigned, v), false, false);
    return __builtin_bit_cast(float, rr[0]) + __builtin_bit_cast(float, rr[1]);
}
__device__ __forceinline__ float silu_f(float y) { return y * __builtin_amdgcn_rcpf(1.0f + __expf(-y)); }

__device__ __forceinline__ void mlstm_unit(Frame& F, int unit) {
    const int bh = unit >> 2, sl = unit & 3, b = bh >> 2, hh = bh & 3, tid = opq(F.tid), lane = opq(F.lane), wave = F.wave, hi = lane >> 5, l31 = lane & 31;
    const bf16* MLQ = (const bf16*)F.out(); const bf16* MLK = MLQ + (size_t)T * D; const bf16* MLV = F.PROJ() + 5 * (SEG / 2);
    lp_t base = (lp_t)F.lds;
    LAS float* Fa = (LAS float*)(base + O_F);
    const size_t rowb = (size_t)b * SEQ;
    const float LOG2E = 1.4426950408889634f;
    __syncthreads();
    for (int i = tid; i < 34816 / 16; i += 512) ((LAS v4u*)(base + O_CB))[i] = (v4u){0u, 0u, 0u, 0u};
    if (tid < 256) Fa[F_NV + tid] = 0.f;
    f32x16 C0, C1, C2;
#pragma unroll
    for (int r = 0; r < 16; ++r) { C0[r] = 0.f; C1[r] = 0.f; C2[r] = 0.f; }
    if (tid < 64) *(LAS v4u*)(base + O_VW + 144 * tid + 128) = (v4u){0u, 0u, 0u, 0u};
    const int cg = tid & 31, rb = tid >> 5;
    v4u rawq[2][4], rawk[2][4], rawv[2]; float g_bb[2], g_us[2], g_pm[2]; float m_prev = 0.f;
#define ML_PREFETCH(T0, P) do { const int t0_ = (T0); \
        _Pragma("unroll") for (int i = 0; i < 4; ++i) { const unsigned g_ = (unsigned)(((int)rowb + t0_ + 4 * rb + i) * D + hh * 256 + cg * 8); \
            rawq[P][i] = *(const v4u*)(MLQ + g_); rawk[P][i] = *(const v4u*)(MLK + g_); } \
        rawv[P] = *(const v4u*)(MLV + (unsigned)(((int)rowb + t0_ + (tid >> 3)) * D + hh * 256 + 64 * sl + (tid & 7) * 8)); \
        { const float* gt_ = F.gt() + (unsigned)(((bh * (SEQ / L) + t0_ / L) * 3) * 64 + lane); g_bb[P] = gt_[0]; g_us[P] = gt_[64]; g_pm[P] = gt_[128]; } } while (0)
    ML_PREFETCH(0, 0); ML_PREFETCH(L, 1);
    __syncthreads();
    for (int chunk2 = 0; chunk2 < SEQ / L; chunk2 += 2) {
#pragma unroll
      for (int par = 0; par < 2; ++par) {
        const int chunk = chunk2 + par, t0 = chunk * L;
        const int tid = opq(F.tid), lane = tid & 63, hi = lane >> 5, l31 = lane & 31, cg = tid & 31, rb = tid >> 5, lo = lane;
        const float u = g_us[par], mm = g_bb[par] + fmaxf(m_prev, g_pm[par]), winter = __builtin_amdgcn_exp2f(g_bb[par] + m_prev - mm), at = g_bb[par] - mm, eden = __builtin_amdgcn_exp2f(-mm);
        const float bb63 = __builtin_bit_cast(float, __builtin_amdgcn_readlane(__builtin_bit_cast(int, g_bb[par]), 63)), mnew = __builtin_bit_cast(float, __builtin_amdgcn_readlane(__builtin_bit_cast(int, mm), 63));
        const float decay = __builtin_amdgcn_exp2f(bb63 + m_prev - mnew), wstate = __builtin_amdgcn_exp2f(bb63 - mnew + u); m_prev = mnew;
        if (wave == 0) { Fa[F_AT + lane] = at; Fa[F_US + lane] = u; Fa[F_WIN + lane] = winter; Fa[F_EDEN + lane] = eden; Fa[F_WST + lane] = wstate; }
#pragma unroll
        for (int j = 0; j < 4; ++j) { *(LAS v4u*)(base + O_QI + ioff<528, 0>(4 * rb + j, cg)) = rawq[par][j]; *(LAS v4u*)(base + O_KI + ioff<528, 0>(4 * rb + j, cg)) = rawk[par][j]; }
        { const int s = tid >> 3, ch = tid & 7; const v4u w = rawv[par];
          *(LAS v4u*)(base + O_VI + ioff<144, 0>(s, ch)) = w;
          const float ws = __shfl(wstate, s);
          v4u o; o.x = pk2(bflo(w.x) * ws, bfhi(w.x) * ws); o.y = pk2(bflo(w.y) * ws, bfhi(w.y) * ws); o.z = pk2(bflo(w.z) * ws, bfhi(w.z) * ws); o.w = pk2(bflo(w.w) * ws, bfhi(w.w) * ws);
          *(LAS v4u*)(base + O_VW + ioff<144, 0>(s, ch)) = o;
          if (ch == 0) *(LAS unsigned short*)(base + O_VW + 144 * s + 128) = (unsigned short)pk2(ws, 0.f); }
        __syncthreads();
        if (chunk + 2 < SEQ / L) ML_PREFETCH(t0 + 2 * L, par);
        __builtin_amdgcn_sched_barrier(0);
        f32x16 acc;
#pragma unroll
        for (int r = 0; r < 16; ++r) acc[r] = 0.f;
        const int wq = wave & 3, ta = wq >> 1, tb = wq & 1;
        if (wave < 4) {
#pragma unroll
            for (int kh = 0; kh < 2; ++kh) { bf16x8 fa[8], fb[8];
#pragma unroll
                for (int ks = 0; ks < 8; ++ks) { fa[ks] = frag_row<528, 0>(base + O_KI, 32 * tb, 8 * kh + ks, lo); fb[ks] = frag_row<528, 0>(base + O_QI, 32 * ta, 8 * kh + ks, lo); }
                __builtin_amdgcn_sched_barrier(0);
#pragma unroll
                for (int ks = 0; ks < 8; ++ks) acc = __builtin_amdgcn_mfma_f32_32x32x16_bf16(fa[ks], fb[ks], acc, 0, 0, 0);
                __builtin_amdgcn_sched_barrier(0); }
            const float at_l = __shfl(at, 32 * ta + l31); const int t = 32 * ta + l31; float rsum = 0.f;
#pragma unroll
            for (int g = 0; g < 4; ++g) { const int s0 = 32 * tb + 8 * g + 4 * hi; const f32x4 us4 = *(LAS const f32x4*)(Fa + F_US + s0); float p[4];
#pragma unroll
                for (int i = 0; i < 4; ++i) { p[i] = (s0 + i <= t) ? acc[4 * g + i] * __builtin_amdgcn_exp2f(at_l + us4[i]) : 0.f; rsum += p[i]; }
                *(LAS unsigned long long*)(base + O_PI + ioff<144, 0>(t, s0 >> 3) + 2 * (s0 & 7)) = (unsigned long long)pk2(p[0], p[1]) | ((unsigned long long)pk2(p[2], p[3]) << 32); }
            rsum = half_sum(rsum);
            if (hi == 0) Fa[F_RSP + tb * 64 + t] = rsum;
        } else {
#pragma unroll
            for (int kh = 0; kh < 2; ++kh) { bf16x8 fa[8], fb[8];
#pragma unroll
                for (int ks = 0; ks < 8; ++ks) { fa[ks] = frag_row<528, 0>(base + O_QI, 32 * ta, 8 * kh + ks, lo); fb[ks] = frag_tr<136, 0>(base + O_CB, 0, 8 * kh + ks, 32 * tb, lo); }
                __builtin_amdgcn_sched_barrier(0);
#pragma unroll
                for (int ks = 0; ks < 8; ++ks) acc = __builtin_amdgcn_mfma_f32_32x32x16_bf16(fa[ks], fb[ks], acc, 0, 0, 0);
                __builtin_amdgcn_sched_barrier(0); }
        }
        { float s = 0.f;
#pragma unroll
          for (int c = 0; c < 4; ++c) { const v4u w = *(LAS const v4u*)(base + O_QI + ioff<528, 0>(lane, 4 * wave + c)); const f32x4 n0 = *(LAS const f32x4*)(Fa + F_NV + 32 * wave + 8 * c), n1 = *(LAS const f32x4*)(Fa + F_NV + 32 * wave + 8 * c + 4);
              s += bflo(w.x) * n0.x + bfhi(w.x) * n0.y + bflo(w.y) * n0.z + bfhi(w.y) * n0.w + bflo(w.z) * n1.x + bfhi(w.z) * n1.y + bflo(w.w) * n1.z + bfhi(w.w) * n1.w; }
          Fa[F_QNP + wave * 64 + lane] = s; }
        __syncthreads();
        if (wave >= 4) {
            { const int t = 32 * ta + l31;
              const float den = Fa[F_WIN + t] * (((Fa[F_QNP + t] + Fa[F_QNP + 64 + t]) + (Fa[F_QNP + 128 + t] + Fa[F_QNP + 192 + t])) + ((Fa[F_QNP + 256 + t] + Fa[F_QNP + 320 + t]) + (Fa[F_QNP + 384 + t] + Fa[F_QNP + 448 + t])))
                                + Fa[F_RSP + t] + Fa[F_RSP + 64 + t];
              if (hi == 0) Fa[F_CW + 32 * (wave - 4) + l31] = 1.0f / fmaxf(fabsf(den), Fa[F_EDEN + t]); }
#pragma unroll
            for (int g = 0; g < 4; ++g) { const f32x4 w4 = *(LAS const f32x4*)(Fa + F_WIN + 32 * ta + 8 * g + 4 * hi); acc[4 * g] *= w4.x; acc[4 * g + 1] *= w4.y; acc[4 * g + 2] *= w4.z; acc[4 * g + 3] *= w4.w; }
            { bf16x8 fa[4], fb[4];
#pragma unroll
              for (int ks = 0; ks < 4; ++ks) { fa[ks] = frag_row<144, 0>(base + O_PI, 32 * ta, ks, lo); fb[ks] = frag_tr<144, 0>(base + O_VI, 0, ks, 32 * tb, lo); }
              __builtin_amdgcn_sched_barrier(0);
#pragma unroll
              for (int ks = 0; ks < 4; ++ks) acc = __builtin_amdgcn_mfma_f32_32x32x16_bf16(fa[ks], fb[ks], acc, 0, 0, 0); }
            bf16* dst = F.YB() + (rowb + t0 + 32 * ta) * D + hh * 256 + 64 * sl + 32 * tb + l31;
#pragma unroll
            for (int g = 0; g < 4; ++g) { const f32x4 r4 = *(LAS const f32x4*)(Fa + F_CW + 32 * (wave - 4) + 8 * g + 4 * hi);
#pragma unroll
                for (int i = 0; i < 4; ++i) dst[(size_t)(8 * g + 4 * hi + i) * D] = (bf16)pk2(acc[4 * g + i] * r4[i], 0.f); }
        }
#pragma unroll
        for (int r = 0; r < 16; ++r) { C0[r] *= decay; C1[r] *= decay; C2[r] *= decay; }
        { bf16x8 bk[4], v0[4], v1[4], v2[4];
#pragma unroll
          for (int ks = 0; ks < 4; ++ks) { bk[ks] = frag_tr<528, 0>(base + O_KI, 0, ks, 32 * wave, lo); v0[ks] = frag_tr<144, 0>(base + O_VW, 0, ks, 0, lo); v1[ks] = frag_tr<144, 0>(base + O_VW, 0, ks, 32, lo); v2[ks] = frag_tr<144, 0>(base + O_VW, 0, ks, 64, lo); }
          __builtin_amdgcn_sched_barrier(0);
#pragma unroll
          for (int ks = 0; ks < 4; ++ks) { C0 = __builtin_amdgcn_mfma_f32_32x32x16_bf16(v0[ks], bk[ks], C0, 0, 0, 0); C1 = __builtin_amdgcn_mfma_f32_32x32x16_bf16(v1[ks], bk[ks], C1, 0, 0, 0); C2 = __builtin_amdgcn_mfma_f32_32x32x16_bf16(v2[ks], bk[ks], C2, 0, 0, 0); }
          __builtin_amdgcn_sched_barrier(0); }
        { const int d = 32 * wave + l31;
#pragma unroll
          for (int g = 0; g < 4; ++g) { const int e0 = 8 * g + 4 * hi;
              *(LAS unsigned long long*)(base + O_CB + ioff<136, 0>(d, e0 >> 3) + 2 * (e0 & 7)) = (unsigned long long)pk2(C0[4 * g], C0[4 * g + 1]) | ((unsigned long long)pk2(C0[4 * g + 2], C0[4 * g + 3]) << 32);
              *(LAS unsigned long long*)(base + O_CB + ioff<136, 0>(d, (32 + e0) >> 3) + 2 * (e0 & 7)) = (unsigned long long)pk2(C1[4 * g], C1[4 * g + 1]) | ((unsigned long long)pk2(C1[4 * g + 2], C1[4 * g + 3]) << 32); }
          if (hi == 0) Fa[F_NV + d] = C2[0];
        }
        __syncthreads();
      }
    }
#undef ML_PREFETCH
}
}


__device__ __forceinline__ void mlstm_gates(Frame& F, int job) {
    const int lane = opq(F.lane); const float LOG2E = 1.4426950408889634f;
    const float lf2 = F.lf()[(size_t)job * ml::L + lane] * LOG2E, ii2 = F.ipre()[(size_t)job * ml::L + lane] * LOG2E;
    float bb = lf2;
#pragma unroll
    for (int o = 1; o < 64; o <<= 1) { const float v = __shfl_up(bb, o); bb += (lane >= o) ? v : 0.f; }
    const float u = ii2 - bb; float pm = u;
#pragma unroll
    for (int o = 1; o < 64; o <<= 1) { const float v = __shfl_up(pm, o); pm = (lane >= o) ? fmaxf(pm, v) : pm; }
    float* gt = F.gt() + (size_t)job * 3 * 64 + lane;
    gt[0] = bb; gt[64] = u; gt[128] = pm;
}

__device__ __forceinline__ void mlstm_conv_rows(Frame& F) {
    const int tid = opq(F.tid), cg = tid & 255, z = cg >> 7, c0 = (cg & 127) * 8, r0 = F.vcu * 128 + 64 * (tid >> 8);
    const bf16* src = F.PROJ() + (size_t)(3 + z) * (SEG / 2) + c0; bf16* dst = (bf16*)F.out() + (size_t)z * T * D + c0;
    float w[4][8], bs[8];
#pragma unroll
    for (int tap = 0; tap < 4; ++tap) { const f32x4 a0 = *(const f32x4*)(F.conv_w() + tap * 2048 + cg * 8), a1 = *(const f32x4*)(F.conv_w() + tap * 2048 + cg * 8 + 4);
        w[tap][0] = a0.x; w[tap][1] = a0.y; w[tap][2] = a0.z; w[tap][3] = a0.w; w[tap][4] = a1.x; w[tap][5] = a1.y; w[tap][6] = a1.z; w[tap][7] = a1.w; }
    { const f32x4 a0 = *(const f32x4*)(F.conv_b() + cg * 8), a1 = *(const f32x4*)(F.conv_b() + cg * 8 + 4);
      bs[0] = a0.x; bs[1] = a0.y; bs[2] = a0.z; bs[3] = a0.w; bs[4] = a1.x; bs[5] = a1.y; bs[6] = a1.z; bs[7] = a1.w; }
    const float osc = z ? 0.0625f : 1.0f;
    const bool seq_start = (r0 % SEQ) == 0;
    v4u x0, x1, x2;
    { const v4u zero = {0u, 0u, 0u, 0u};
      x0 = seq_start ? zero : *(const v4u*)(src + (size_t)(r0 - 3 + (seq_start ? 3 : 0)) * D);
      x1 = seq_start ? zero : *(const v4u*)(src + (size_t)(r0 - 2 + (seq_start ? 2 : 0)) * D);
      x2 = seq_start ? zero : *(const v4u*)(src + (size_t)(r0 - 1 + (seq_start ? 1 : 0)) * D); }
    v4u nxs[8];
#pragma unroll
    for (int i = 0; i < 8; ++i) nxs[i] = *(const v4u*)(src + (size_t)(r0 + i) * D);
    for (int rr = 0; rr < 64; rr += 8) {
        v4u xs[8];
#pragma unroll
        for (int i = 0; i < 8; ++i) xs[i] = nxs[i];
        if (rr + 8 < 64) {
#pragma unroll
            for (int i = 0; i < 8; ++i) nxs[i] = *(const v4u*)(src + (size_t)(r0 + rr + 8 + i) * D); }
#pragma unroll
        for (int i = 0; i < 8; ++i) {
            const v4u x3 = xs[i]; float y[8];
#pragma unroll
            for (int c = 0; c < 8; ++c) y[c] = bs[c];
#define MK_TAP(tap, X) do { y[0] += w[tap][0] * bflo(X.x); y[1] += w[tap][1] * bfhi(X.x); y[2] += w[tap][2] * bflo(X.y); y[3] += w[tap][3] * bfhi(X.y); \
                           y[4] += w[tap][4] * bflo(X.z); y[5] += w[tap][5] * bfhi(X.z); y[6] += w[tap][6] * bflo(X.w); y[7] += w[tap][7] * bfhi(X.w); } while (0)
            MK_TAP(0, x0); MK_TAP(1, x1); MK_TAP(2, x2); MK_TAP(3, x3);
#undef MK_TAP
#pragma unroll
            for (int c = 0; c < 8; ++c) y[c] = ml::silu_f(y[c]) * osc;
            v4u o; o.x = pk2(y[0], y[1]); o.y = pk2(y[2], y[3]); o.z = pk2(y[4], y[5]); o.w = pk2(y[6], y[7]);
            *(v4u*)(dst + (size_t)(r0 + rr + i) * D) = o;
            x0 = x1; x1 = x2; x2 = x3;
        }
    }
}

__device__ __forceinline__ void mlstm_norm_rows(Frame& F) {
    const int row0 = F.vcu * 128, lane = opq(F.lane);
    const bf16* MLO = F.PROJ() + 6 * (SEG / 2);
    f32x4 G[4];
#pragma unroll
    for (int j = 0; j < 4; ++j) G[j] = *(const f32x4*)(F.ml_norm_g() + 256 * j + 4 * lane);
    unsigned long long nh[4], no[4];
#define NR_LOAD(ROW) do { const size_t row_ = (ROW); const GAS unsigned long long* hp_ = (const GAS unsigned long long*)(F.YB() + row_ * D) + lane; const GAS unsigned long long* op_ = (const GAS unsigned long long*)(MLO + row_ * D) + lane; \
        _Pragma("unroll") for (int j = 0; j < 4; ++j) { nh[j] = hp_[64 * j]; no[j] = op_[64 * j]; } } while (0)
    NR_LOAD((size_t)row0 + 16 * F.wave);
    for (int r = 0; r < 16; ++r) {
        const size_t row = (size_t)row0 + 16 * F.wave + r;
        GAS unsigned long long* hp = (GAS unsigned long long*)(F.YB() + row * D) + lane;
        unsigned long long ch[4], co[4];
#pragma unroll
        for (int j = 0; j < 4; ++j) { ch[j] = nh[j]; co[j] = no[j]; }
        if (r < 15) NR_LOAD(row + 1);
#pragma unroll
        for (int j = 0; j < 4; ++j) { const unsigned long long hw = ch[j], ow = co[j];
            const float h0 = bflo((unsigned)hw), h1 = bfhi((unsigned)hw), h2 = bflo((unsigned)(hw >> 32)), h3 = bfhi((unsigned)(hw >> 32));
            const float ss = wave_sum((h0 * h0 + h1 * h1) + (h2 * h2 + h3 * h3)); const float rstd = 1.0f / sqrtf(ss * (1.0f / 256.0f) + EPS);
            const float o0 = bflo((unsigned)ow), o1 = bfhi((unsigned)ow), o2 = bflo((unsigned)(ow >> 32)), o3 = bfhi((unsigned)(ow >> 32));
            const float y0 = h0 * rstd * G[j].x / (1.0f + __expf(-o0)), y1 = h1 * rstd * G[j].y / (1.0f + __expf(-o1)), y2 = h2 * rstd * G[j].z / (1.0f + __expf(-o2)), y3 = h3 * rstd * G[j].w / (1.0f + __expf(-o3));
            hp[64 * j] = (unsigned long long)pk2(y0, y1) | ((unsigned long long)pk2(y2, y3) << 32); }
    }
#undef NR_LOAD
}

namespace at {
using ml::bf16x8; using ml::s16x4; using ml::f32x16; using ml::ioff; using ml::frag_row; using ml::lcp; using ml::lp_t;
typedef _Float16 f16x8 __attribute__((ext_vector_type(8)));
typedef _Float16 f16x2 __attribute__((ext_vector_type(2)));
typedef float f32x2 __attribute__((ext_vector_type(2)));
constexpr int O_KI = 0, O_VI = 8192, O_FLAG = 16384;
template <int PITCH, int XM> __device__ __forceinline__ bf16x8 frag_trp(lcp img, int ks, int col0, int lane) {
    const int h = lane >> 5, blk = (lane >> 4) & 1, q = (lane & 15) >> 2, p = lane & 3;
    const int r0 = 16 * ks + 4 * h + q, ch = (col0 >> 3) + 2 * blk + (p >> 1);
    typedef short v4i16_t __attribute__((ext_vector_type(4)));
    const s16x4 a = __builtin_bit_cast(s16x4, __builtin_amdgcn_ds_read_tr16_b64_v4i16((LAS v4i16_t*)(img + ioff<PITCH, XM>(r0, ch) + 8 * (p & 1))));
    const s16x4 b = __builtin_bit_cast(s16x4, __builtin_amdgcn_ds_read_tr16_b64_v4i16((LAS v4i16_t*)(img + ioff<PITCH, XM>(r0 + 8, ch) + 8 * (p & 1))));
    return (bf16x8){a[0], a[1], a[2], a[3], b[0], b[1], b[2], b[3]};
}
__device__ __forceinline__ unsigned pkh(float a, float b) { const f32x2 v = {a, b}; return __builtin_bit_cast(unsigned, __builtin_convertvector(v, f16x2)); }
__device__ __forceinline__ f16x8 h8(unsigned a, unsigned b, unsigned c, unsigned d) { const v4u v = {a, b, c, d}; return __builtin_bit_cast(f16x8, v); }
__device__ __forceinline__ bf16x8 b8(unsigned a, unsigned b, unsigned c, unsigned d) { const v4u v = {a, b, c, d}; return __builtin_bit_cast(bf16x8, v); }

__device__ __forceinline__ void attn_unit(Frame& F, int bh, int qb) {
    const int b = bh >> 4, hd = bh & 15, tid = opq(F.tid), lane = opq(F.lane), wave = F.wave, hi = lane >> 5, l31 = lane & 31, pr = wave >> 1, tp = tid & 127;
    const bf16* Q = F.PROJ(); const bf16* K = F.PROJ() + SEG / 2; const bf16* V = F.PROJ() + SEG;
    lp_t base = (lp_t)F.lds + pr * 16384;
    LAS volatile int* dflag = (LAS volatile int*)((lp_t)F.lds + 65536);
    const size_t rowb = (size_t)b * SEQ; const int q0 = qb * 256, tw0 = q0 + 32 * wave, t = tw0 + l31, kt0 = qb * 4 + pr;
    bf16x8 qr[4];
#pragma unroll
    for (int ks = 0; ks < 4; ++ks) qr[ks] = *(const bf16x8*)(Q + (rowb + t) * D + hd * 64 + 16 * ks + 8 * hi);
    unsigned uw[2][4];
#pragma unroll
    for (int sp = 0; sp < 2; ++sp)
#pragma unroll
        for (int jj = 0; jj < 4; ++jj) { const int j0 = 2 * jj, j1 = 2 * jj + 1;
            const int k0 = 16 * sp + 8 * (j0 >> 2) + 4 * hi + (j0 & 3), k1 = 16 * sp + 8 * (j1 >> 2) + 4 * hi + (j1 & 3);
            uw[sp][jj] = (k0 > l31 ? 0x3C00u : 0u) | (k1 > l31 ? 0x3C000000u : 0u); }
    const f16x8 U0 = h8(uw[0][0], uw[0][1], uw[0][2], uw[0][3]), U1 = h8(uw[1][0], uw[1][1], uw[1][2], uw[1][3]), ONES = h8(0x3C003C00u, 0x3C003C00u, 0x3C003C00u, 0x3C003C00u);
    f32x16 O0, O1;
#pragma unroll
    for (int r = 0; r < 16; ++r) { O0[r] = 0.f; O1[r] = 0.f; }
    float R = 0.f; bool wdone = false;
    v4u kreg[4], vreg[4];
#define AT_LOAD(KT) do { _Pragma("unroll") for (int j = 0; j < 4; ++j) { const size_t g = (rowb + (KT) * 64 + (tp >> 3) + 16 * j) * D + hd * 64 + (tp & 7) * 8; kreg[j] = *(const v4u*)(K + g); vreg[j] = *(const v4u*)(V + g); } } while (0)
    AT_LOAD(kt0);
    __syncthreads();
    if (tid < 8) dflag[tid] = 0;
    for (int it = 0; it <= qb * 4 + 3; ++it) {
        const int kt = kt0 - it;
        __syncthreads();
        { int nd = 0;
#pragma unroll
          for (int w = 0; w < 8; ++w) nd += dflag[w];
          if (nd == 8) break; }
        if (kt >= 0) {
#pragma unroll
            for (int j = 0; j < 4; ++j) { *(LAS v4u*)(base + O_KI + ioff<128, 7>((tp >> 3) + 16 * j, tp & 7)) = kreg[j]; *(LAS v4u*)(base + O_VI + ioff<128, 7>((tp >> 3) + 16 * j, tp & 7)) = vreg[j]; } }
        __syncthreads();
        if (kt > 0) AT_LOAD(kt - 1);
        if (kt < 0) { if (!wdone) { wdone = true; if (lane == 0) dflag[wave] = 1; } continue; }
        if (wdone) continue;
        int lo = lane; asm volatile("" : "+v"(lo));
        f32x16 p0, p1;
#pragma unroll
        for (int r = 0; r < 16; ++r) { p0[r] = 0.f; p1[r] = 0.f; }
#pragma unroll
        for (int ks = 0; ks < 4; ++ks) { p0 = __builtin_amdgcn_mfma_f32_32x32x16_bf16(frag_row<128, 7>(base + O_KI, 0, ks, lo), qr[ks], p0, 0, 0, 0);
                                         p1 = __builtin_amdgcn_mfma_f32_32x32x16_bf16(frag_row<128, 7>(base + O_KI, 32, ks, lo), qr[ks], p1, 0, 0, 0); }
        const bool diag = (it == 0);
        const int trel = t - 64 * kt;
        float lk00 = 0.f;
        unsigned lkw0[8], lkw1[8];
#pragma unroll
        for (int r = 0; r < 16; ++r) {
            const int key0 = ml::crow(r, hi);
            { const float z = p0[r], lb = fminf(z, 0.f) - __builtin_amdgcn_logf(1.0f + __builtin_amdgcn_exp2f(-fabsf(z))); float lk = lb - z; if (diag && !(key0 < trel)) lk = 0.f; p0[r] = lb; if (r == 0) lk00 = lk;
              if (r & 1) lkw0[r >> 1] = pkh(__builtin_bit_cast(float, lkw0[r >> 1]), lk); else lkw0[r >> 1] = __builtin_bit_cast(unsigned, lk); }
            { const float z = p1[r], lb = fminf(z, 0.f) - __builtin_amdgcn_logf(1.0f + __builtin_amdgcn_exp2f(-fabsf(z))); float lk = lb - z; if (diag && !(key0 + 32 < trel)) lk = 0.f; p1[r] = lb;
              if (r & 1) lkw1[r >> 1] = pkh(__builtin_bit_cast(float, lkw1[r >> 1]), lk); else lkw1[r >> 1] = __builtin_bit_cast(unsigned, lk); }
        }
        f32x16 bt1, bt0;
#pragma unroll
        for (int r = 0; r < 16; ++r) { bt1[r] = R; bt0[r] = R; }
        const f16x8 L10 = h8(lkw1[0], lkw1[1], lkw1[2], lkw1[3]), L11 = h8(lkw1[4], lkw1[5], lkw1[6], lkw1[7]), L00 = h8(lkw0[0], lkw0[1], lkw0[2], lkw0[3]), L01 = h8(lkw0[4], lkw0[5], lkw0[6], lkw0[7]);
        bt1 = __builtin_amdgcn_mfma_f32_32x32x16_f16(U0, L10, bt1, 0, 0, 0); bt1 = __builtin_amdgcn_mfma_f32_32x32x16_f16(U1, L11, bt1, 0, 0, 0);
        bt0 = __builtin_amdgcn_mfma_f32_32x32x16_f16(ONES, L10, bt0, 0, 0, 0); bt0 = __builtin_amdgcn_mfma_f32_32x32x16_f16(ONES, L11, bt0, 0, 0, 0);
        bt0 = __builtin_amdgcn_mfma_f32_32x32x16_f16(U0, L00, bt0, 0, 0, 0); bt0 = __builtin_amdgcn_mfma_f32_32x32x16_f16(U1, L01, bt0, 0, 0, 0);
        { const float v = bt0[0] + lk00;
          const auto rr = __builtin_amdgcn_permlane32_swap(__builtin_bit_cast(unsigned, v), __builtin_bit_cast(unsigned, v), false, false);
          R = __builtin_bit_cast(float, rr[0]); }
        unsigned aw0[8], aw1[8];
#pragma unroll
        for (int r = 0; r < 16; r += 2) {
            const int key0 = ml::crow(r, hi);
            float a00 = __builtin_amdgcn_exp2f(p0[r] + bt0[r]), a01 = __builtin_amdgcn_exp2f(p0[r + 1] + bt0[r + 1]), a10 = __builtin_amdgcn_exp2f(p1[r] + bt1[r]), a11 = __builtin_amdgcn_exp2f(p1[r + 1] + bt1[r + 1]);
            if (diag) { if (!(key0 < trel)) a00 = 0.f; if (!(key0 + 1 < trel)) a01 = 0.f; if (!(key0 + 32 < trel)) a10 = 0.f; if (!(key0 + 33 < trel)) a11 = 0.f; }
            aw0[r >> 1] = pk2(a00, a01); aw1[r >> 1] = pk2(a10, a11);
        }
        const bf16x8 A00 = b8(aw0[0], aw0[1], aw0[2], aw0[3]), A01 = b8(aw0[4], aw0[5], aw0[6], aw0[7]), A10 = b8(aw1[0], aw1[1], aw1[2], aw1[3]), A11 = b8(aw1[4], aw1[5], aw1[6], aw1[7]);
        O0 = __builtin_amdgcn_mfma_f32_32x32x16_bf16(A00, frag_trp<128, 7>(base + O_VI, 0, 0, lo), O0, 0, 0, 0);  O1 = __builtin_amdgcn_mfma_f32_32x32x16_bf16(A00, frag_trp<128, 7>(base + O_VI, 0, 32, lo), O1, 0, 0, 0);
        O0 = __builtin_amdgcn_mfma_f32_32x32x16_bf16(A01, frag_trp<128, 7>(base + O_VI, 1, 0, lo), O0, 0, 0, 0);  O1 = __builtin_amdgcn_mfma_f32_32x32x16_bf16(A01, frag_trp<128, 7>(base + O_VI, 1, 32, lo), O1, 0, 0, 0);
        O0 = __builtin_amdgcn_mfma_f32_32x32x16_bf16(A10, frag_trp<128, 7>(base + O_VI, 2, 0, lo), O0, 0, 0, 0);  O1 = __builtin_amdgcn_mfma_f32_32x32x16_bf16(A10, frag_trp<128, 7>(base + O_VI, 2, 32, lo), O1, 0, 0, 0);
        O0 = __builtin_amdgcn_mfma_f32_32x32x16_bf16(A11, frag_trp<128, 7>(base + O_VI, 3, 0, lo), O0, 0, 0, 0);  O1 = __builtin_amdgcn_mfma_f32_32x32x16_bf16(A11, frag_trp<128, 7>(base + O_VI, 3, 32, lo), O1, 0, 0, 0);
        if (__all(R < ATT_RTHR)) { wdone = true; if (lane == 0) dflag[wave] = 1; }
    }
#undef AT_LOAD
    __syncthreads();
    bf16* dst = F.YA() + (rowb + tw0) * D + hd * 64 + l31;
#pragma unroll
    for (int r = 0; r < 16; ++r) { const int q = ml::crow(r, hi); dst[(size_t)q * D] = (bf16)pk2(O0[r], 0.f); dst[(size_t)q * D + 32] = (bf16)pk2(O1[r], 0.f); }
}
}

__device__ __forceinline__ void p5a_route(Frame& F) {
    const int row0 = F.vcu * 128, b = row0 / SEQ, lane = opq(F.lane), tid = opq(F.tid);
    LAS float* wr = (LAS float*)F.lds;
    LAS int* le = (LAS int*)(F.lds + 131584); LAS int* lp = le + 512;
    LAS int* lcnt = (LAS int*)(F.LC + LC_LCNT); LAS int* gbase = (LAS int*)(F.LC + LC_GBASE);
    for (int idx = tid; idx < 32768; idx += 512) wr[(idx & 31) * 1028 + (idx >> 5)] = F.router_w()[idx];
    if (tid < 32) lcnt[tid] = 0;
    f32x4 Av[4], Bv[4];
#pragma unroll
    for (int j = 0; j < 4; ++j) { const int col = 4 * lane + 256 * j; const float* mb = F.mod() + (size_t)b * NMOD;
        const f32x4 g = *(const f32x4*)(F.norm2_g() + col); Av[j] = g * (*(const f32x4*)(mb + 4 * D + col) + 1.0f); Bv[j] = *(const f32x4*)(mb + 3 * D + col); }
    float rb[32];
#pragma unroll
    for (int e = 0; e < 32; ++e) rb[e] = F.router_b()[e];
    __syncthreads();
    f32x4 nx[4];
    { const GAS f32x4* xr = (const GAS f32x4*)(F.out() + (size_t)(row0 + 16 * F.wave) * D) + lane;
#pragma unroll
      for (int j = 0; j < 4; ++j) nx[j] = xr[64 * j]; }
    for (int r = 0; r < 16; ++r) {
        const int rl = 16 * F.wave + r, row = row0 + rl;
        f32x4 v[4]; float ss = 0.f;
#pragma unroll
        for (int j = 0; j < 4; ++j) { v[j] = nx[j]; ss += (v[j].x * v[j].x + v[j].y * v[j].y) + (v[j].z * v[j].z + v[j].w * v[j].w); }
        if (r < 15) { const GAS f32x4* xr = (const GAS f32x4*)(F.out() + (size_t)(row + 1) * D) + lane;
#pragma unroll
            for (int j = 0; j < 4; ++j) nx[j] = xr[64 * j]; }
        const float rstd = 1.0f / sqrtf(wave_sum(ss) * (1.0f / D) + EPS);
        { GAS unsigned* o4 = (GAS unsigned*)((unsigned char*)F.H2() + (size_t)row * D) + lane;
#pragma unroll
          for (int j = 0; j < 4; ++j) { v[j] = v[j] * rstd * Av[j] + Bv[j]; o4[64 * j] = pg8::pk4_fp8(v[j].x, v[j].y, v[j].z, v[j].w); } }
        float p[32];
#pragma unroll
        for (int e = 0; e < 32; ++e) { float s = 0.f;
#pragma unroll
            for (int j = 0; j < 4; ++j) { const f32x4 w = *(const LAS f32x4*)(wr + e * 1028 + 4 * lane + 256 * j); s += (v[j].x * w.x + v[j].y * w.y) + (v[j].z * w.z + v[j].w * w.w); }
            p[e] = s; }
#pragma unroll
        for (int i = 0; i < 16; ++i) { const bool up = (lane & 32) != 0; const float send = up ? p[i] : p[i + 16], keep = up ? p[i + 16] : p[i]; p[i] = keep + __shfl_xor(send, 32); }
#pragma unroll
        for (int i = 0; i < 8; ++i) { const bool up = (lane & 16) != 0; const float send = up ? p[i] : p[i + 8], keep = up ? p[i + 8] : p[i]; p[i] = keep + __shfl_xor(send, 16); }
#pragma unroll
        for (int i = 0; i < 4; ++i) { const bool up = (lane & 8) != 0; const float send = up ? p[i] : p[i + 4], keep = up ? p[i + 4] : p[i]; p[i] = keep + __shfl_xor(send, 8); }
#pragma unroll
        for (int i = 0; i < 2; ++i) { const bool up = (lane & 4) != 0; const float send = up ? p[i] : p[i + 2], keep = up ? p[i + 2] : p[i]; p[i] = keep + __shfl_xor(send, 4); }
        { const bool up = (lane & 2) != 0; const float send = up ? p[0] : p[1], keep = up ? p[1] : p[0]; p[0] = keep + __shfl_xor(send, 2); }
        p[0] += __shfl_xor(p[0], 1);
        { LAS float* lg = (LAS float*)(F.lds + 135680) + F.wave * 32;
          if ((lane & 1) == 0) lg[lane >> 1] = p[0];
#pragma unroll
          for (int q = 0; q < 8; ++q) { const f32x4 t4 = *(const LAS f32x4*)(lg + 4 * q); p[4 * q] = t4.x + rb[4 * q]; p[4 * q + 1] = t4.y + rb[4 * q + 1]; p[4 * q + 2] = t4.z + rb[4 * q + 2]; p[4 * q + 3] = t4.w + rb[4 * q + 3]; } }
        int sel[4]; float sv[4]; unsigned used = 0u;
#pragma unroll
        for (int k = 0; k < 4; ++k) { float best = -3.0e38f; int bi = 0;
#pragma unroll
            for (int e = 0; e < 32; ++e) { const bool cnd = (((used >> e) & 1u) == 0u) && (p[e] > best); best = cnd ? p[e] : best; bi = cnd ? e : bi; }
            sel[k] = bi; sv[k] = best; used |= 1u << bi; }
        const float e1 = __expf(sv[1] - sv[0]), e2 = __expf(sv[2] - sv[0]), e3 = __expf(sv[3] - sv[0]), inv = 1.0f / (1.0f + e1 + e2 + e3);
        if (lane < 4) { const int ek = lane == 0 ? sel[0] : lane == 1 ? sel[1] : lane == 2 ? sel[2] : sel[3];
            const float wk = (lane == 0 ? 1.0f : lane == 1 ? e1 : lane == 2 ? e2 : e3) * inv;
            const int pos = __hip_atomic_fetch_add(lcnt + ek, 1, __ATOMIC_RELAXED, __HIP_MEMORY_SCOPE_WORKGROUP);
            le[rl * 4 + lane] = ek; lp[rl * 4 + lane] = pos; F.tokw()[(size_t)row * 4 + lane] = wk; }
        if (lane == 0) F.rstd2()[row] = rstd;
    }
    __syncthreads();
    if (tid < 32) gbase[tid] = (int)__hip_atomic_fetch_add(F.ctl + CW_ECNT + 64 * tid, (unsigned)lcnt[tid], __ATOMIC_RELAXED, __HIP_MEMORY_SCOPE_AGENT);
    __syncthreads();
    { const int ek = le[tid]; F.toke()[(size_t)row0 * 4 + tid] = ek; F.tokp()[(size_t)row0 * 4 + tid] = lp[tid] + gbase[ek]; }
}

__device__ __forceinline__ void p5b_tables(Frame& F) {
    const int row0 = F.vcu * 128, tid = opq(F.tid);
    LAS int* ts = (LAS int*)(F.LC + LC_TS); LAS int* ps = (LAS int*)(F.LC + LC_PS); LAS int* cn = (LAS int*)(F.LC + LC_CNT);
    if (tid < 32) cn[tid] = (int)__hip_atomic_load(F.ctl + CW_ECNT + 64 * tid, RLX_AGENT);
    __syncthreads();
    if (tid == 0) { int run = 0, trun = 0; for (int e = 0; e < 32; ++e) { ps[e] = run; ts[e] = trun; const int nt = (cn[e] + 255) >> 8; run += nt * 256; trun += nt; } ts[32] = trun; }
    __syncthreads();
    { const size_t idx = (size_t)row0 * 4 + tid; const int ek = F.toke()[idx], dst = ps[ek] + F.tokp()[idx]; F.tokrow()[idx] = dst; F.row2tok()[dst] = row0 + (tid >> 2); }
    if (F.vcu < 32) { const int e = F.vcu, start = ps[e] + cn[e], end = ps[e] + (((cn[e] + 255) >> 8) << 8); for (int r = start + tid; r < end; r += 512) F.row2tok()[r] = 0; }
}

__device__ __forceinline__ void p8_combine(Frame& F, bool poison) {
    const int row0 = F.vcu * 128, b = row0 / SEQ, lane = opq(F.lane);
    f32x4 G2[4], FG[4];
#pragma unroll
    for (int j = 0; j < 4; ++j) { const int col = 4 * lane + 256 * j; G2[j] = *(const f32x4*)(F.mod() + (size_t)b * NMOD + 5 * D + col); FG[j] = *(const f32x4*)(F.final_g() + col); }
    f32x4 nx[4]; unsigned long long ng[4][4]; float nw[4];
#define P8_LOAD(ROW) do { const size_t row_ = (ROW); const GAS f32x4* xr_ = (const GAS f32x4*)(F.out() + row_ * D) + lane; \
        _Pragma("unroll") for (int j = 0; j < 4; ++j) nx[j] = xr_[64 * j]; \
        _Pragma("unroll") for (int k = 0; k < 4; ++k) { const int src_ = F.tokrow()[row_ * 4 + k]; nw[k] = F.tokw()[row_ * 4 + k]; \
            const GAS unsigned long long* s8_ = (const GAS unsigned long long*)(F.OUTR() + (size_t)src_ * D) + lane; \
            _Pragma("unroll") for (int j = 0; j < 4; ++j) ng[k][j] = s8_[64 * j]; } } while (0)
    P8_LOAD((size_t)row0 + 16 * F.wave);
    for (int r = 0; r < 16; ++r) {
        const int row = row0 + 16 * F.wave + r;
        GAS f32x4* xr = (GAS f32x4*)(F.out() + (size_t)row * D) + lane;
        f32x4 y[4], xv[4];
#pragma unroll
        for (int j = 0; j < 4; ++j) { y[j] = (f32x4){0.f, 0.f, 0.f, 0.f}; xv[j] = nx[j]; }
#pragma unroll
        for (int k = 0; k < 4; ++k) { const float wk = nw[k];
#pragma unroll
            for (int j = 0; j < 4; ++j) { const unsigned long long w = ng[k][j]; y[j].x += wk * bflo((unsigned)w); y[j].y += wk * bfhi((unsigned)w); y[j].z += wk * bflo((unsigned)(w >> 32)); y[j].w += wk * bfhi((unsigned)(w >> 32)); } }
        if (r < 15) P8_LOAD((size_t)row + 1);
        f32x4 v[4]; float ss = 0.f;
#pragma unroll
        for (int j = 0; j < 4; ++j) { v[j] = xv[j] + G2[j] * y[j]; ss += (v[j].x * v[j].x + v[j].y * v[j].y) + (v[j].z * v[j].z + v[j].w * v[j].w); }
        const float rstd = 1.0f / sqrtf(wave_sum(ss) * (1.0f / D) + EPS);
        const float qn = __builtin_nanf("");
#pragma unroll
        for (int j = 0; j < 4; ++j) { f32x4 o = v[j] * rstd * FG[j]; if (poison) o = (f32x4){qn, qn, qn, qn}; xr[64 * j] = o; }
    }
#undef P8_LOAD
}

#ifndef MK_REP_G2
#define MK_REP_G2 1
#endif
#ifndef MK_REP_G4A
#define MK_REP_G4A 1
#endif
#ifndef MK_REP_G4B
#define MK_REP_G4B 1
#endif
#ifndef MK_REP_G4C
#define MK_REP_G4C 1
#endif
#ifndef MK_REP_G6
#define MK_REP_G6 1
#endif
#ifndef MK_REP_G7
#define MK_REP_G7 1
#endif
#ifndef MK_REP_P0
#define MK_REP_P0 1
#endif
#ifndef MK_REP_P3
#define MK_REP_P3 1
#endif
struct Args { const float* in[22]; float* out; unsigned char* ws; };
__global__ void __launch_bounds__(NWAVES * 64, 2) mk_fwd(Args args) {
    extern __shared__ __attribute__((aligned(16))) unsigned char lds[];
    Frame F;
    F.lds = (LAS unsigned char*)lds; F.LC = (volatile LAS unsigned*)(F.lds + LDSCTL_OFF);
    F.tid = threadIdx.x; F.lane = F.tid & 63; F.wave = __builtin_amdgcn_readfirstlane(F.tid >> 6);
    F.G = gridDim.x; { const int bx = blockIdx.x; F.vcu = (F.G % 8 == 0) ? (bx % 8) * (F.G / 8) + bx / 8 : bx; }
    F.ws = (unsigned char*)(GAS unsigned char*)karg(23);
    F.ctl = (gu32*)(F.ws + WS_CTL);
    for (int u = F.tid; u < (LDS_BYTES - LDSCTL_OFF) / 4; u += NWAVES * 64) ((LAS unsigned*)(F.lds + LDSCTL_OFF))[u] = 0u;
    __syncthreads();
    XcdBarrier bar = xcd_barrier_post((unsigned*)(F.ctl + CW_BAR), F.LC + LC_BAR);
#define GRID_BAR() xcd_barrier(bar)
    const int G = F.G, cid = (int)blockIdx.x;

    for (int rep_ = 0; rep_ < MK_REP_P0; ++rep_) p0_prologue(F);
    GRID_BAR();
    p1_rows(F);
    GRID_BAR();
    { pg8::Gemm g{F.H1(), F.WIN_T(), T, NPROJ, D}; pg8::StaticOrder S; S.init(T, NPROJ, G, cid);
      pg8::EpiBf16<0> E{F.PROJ(), D, nullptr, D, SEG / 2, QSCALE};
      for (int rep_ = 0; rep_ < MK_REP_G2; ++rep_) pg8::gemm_phase<pg8::EpiBf16<0>, pg8::StaticOrder, true, true>(F.lds, g, S, E); }
    GRID_BAR();
    for (int job = F.vcu * NWAVES + F.wave; job < BATCH * 4 * (SEQ / 64); job += G * NWAVES) mlstm_gates(F, job);
    mlstm_conv_rows(F);
    GRID_BAR();
#if defined(MK_NAIVE_MLSTM)
    for (int it = F.vcu; it < 1024; it += G) attn_naive_item(F, it & 255, it >> 8);
    __syncthreads();
    for (int it = F.vcu; it < 64; it += G) mlstm_naive_item(F, it);
#else
    for (int rep_ = 0; rep_ < MK_REP_P3; ++rep_) {
    for (int it = F.vcu; it < 256; it += G) ml::mlstm_unit(F, it);
    __syncthreads();
#if defined(MK_NAIVE_ATTN)
    for (int it = F.vcu; it < 1024; it += G) attn_naive_item(F, it & 255, it >> 8);
#else
    for (int it = F.vcu; it < 2048; it += G) at::attn_unit(F, it & 255, it >> 8);
#endif
    }
#endif
    GRID_BAR();
    { pg8::Gemm g{F.YA(), F.WA_T(), T, D, D}; pg8::StaticOrder S; S.init(T, D, G, cid);
      pg8::EpiGate<false> E{F.PROJ() + 7 * (SEG / 2), nullptr, F.M1()};
      for (int rep_ = 0; rep_ < MK_REP_G4A; ++rep_) pg8::gemm_phase<pg8::EpiGate<false>, pg8::StaticOrder, true, true>(F.lds, g, S, E); }
#if defined(MK_NAIVE_MLSTM)
    VM_WAIT(); __syncthreads();
#else
    __syncthreads();
    mlstm_norm_rows(F);
    GRID_BAR();
#endif
    { pg8::Gemm g{F.YB(), F.WB_T(), T, D, D}; pg8::StaticOrder S; S.init(T, D, G, cid);
      pg8::EpiGate<true> E{F.PROJ() + 8 * (SEG / 2), F.M1(), F.MERGED()};
      for (int rep_ = 0; rep_ < MK_REP_G4B; ++rep_) pg8::gemm_phase<pg8::EpiGate<true>, pg8::StaticOrder, true, true>(F.lds, g, S, E); }
    GRID_BAR();
    { pg8::Gemm g{F.MERGED(), F.WOUT_T(), T, D, D}; pg8::StaticOrder S; S.init(T, D, G, cid);
      pg8::EpiResid E{F.x(), F.mod() + 2 * D, F.out(), SEQ, NMOD};
      for (int rep_ = 0; rep_ < MK_REP_G4C; ++rep_) pg8::gemm_phase<pg8::EpiResid, pg8::StaticOrder, true, true>(F.lds, g, S, E); }
    GRID_BAR();
    p5a_route(F);
    GRID_BAR();
    p5b_tables(F);
    GRID_BAR();
    { pg8::Gemm g{F.H2(), F.W1_T(), T, NE * 2048, D / 2}; pg8::GroupedOrder S{(const LAS int*)(F.LC + LC_TS), 8, G, cid, F.row2tok()};
      pg8::EpiSwiglu<true> E{F.b1(), F.ACT(), 1.0f / W8SCALE};
      for (int rep_ = 0; rep_ < MK_REP_G6; ++rep_) pg8::gemm_phase<pg8::EpiSwiglu<true>, pg8::GroupedOrder, true, true, true, true>(F.lds, g, S, E); }
    GRID_BAR();
    { pg8::Gemm g{F.ACT(), F.W2_T(), XS_ROWS, NE * 1024, D / 2}; pg8::GroupedOrder S{(const LAS int*)(F.LC + LC_TS), 4, G, cid, nullptr};
      pg8::EpiOutS E{F.OUTR(), F.b2(), 1.0f / W8SCALE};
      for (int rep_ = 0; rep_ < MK_REP_G7; ++rep_) pg8::gemm_phase<pg8::EpiOutS, pg8::GroupedOrder, true, true, false, true>(F.lds, g, S, E); }
    GRID_BAR();
    { const bool poison = __hip_atomic_load(F.ctl + CW_BAR + XB_TMO, RLX_AGENT) != 0u;
      p8_combine(F, poison); }
}

extern "C" void kernel_launch(void* const* d_in, const int* in_sizes, int n_in, void* d_out, int out_size, void* d_ws, size_t ws_size, hipStream_t stream) {
    static int grid = 0;
    if (grid == 0) {
        if (n_in != 22 || in_sizes[0] != T * D || out_size != T * D || ws_size < WS_END) { fprintf(stderr, "kernel_launch: unexpected shapes (n_in %d, in0 %d, out %d, ws %zu)\n", n_in, n_in > 0 ? in_sizes[0] : -1, out_size, ws_size); grid = -1; return; }
        int dev = 0, cus = 0, per_cu = 0;
        if (hipGetDevice(&dev) != hipSuccess || hipDeviceGetAttribute(&cus, hipDeviceAttributeMultiprocessorCount, dev) != hipSuccess) { grid = -1; return; }
        if (hipFuncSetAttribute((const void*)mk_fwd, hipFuncAttributeMaxDynamicSharedMemorySize, LDS_BYTES) != hipSuccess) { fprintf(stderr, "kernel_launch: hipFuncSetAttribute failed\n"); grid = -1; return; }
        if (hipOccupancyMaxActiveBlocksPerMultiprocessor(&per_cu, (const void*)mk_fwd, NWAVES * 64, LDS_BYTES) != hipSuccess || per_cu < 1) { fprintf(stderr, "kernel_launch: occupancy query says %d blocks per CU\n", per_cu); }
        (void)hipGetLastError();
        if (cus < 256) { fprintf(stderr, "kernel_launch: built for a 256-CU device, found %d CUs\n", cus); grid = -1; return; }
        grid = 256;
    }
    if (grid < 0) return;
    if (hipMemsetAsync((char*)d_ws + WS_CTL, 0, CTL_ZERO_BYTES, stream) != hipSuccess) return;
    Args a{};
    for (int i = 0; i < 22; ++i) a.in[i] = (const float*)d_in[i];
    a.out = (float*)d_out; a.ws = (unsigned char*)d_ws;
    hipLaunchKernelGGL(mk_fwd, dim3(grid), dim3(NWAVES * 64), LDS_BYTES, stream, a);
}
```

```cpp
#include <hip/hip_runtime.h>
#include <cstdio>
#include <cstdint>
namespace pg8 {
#define PG8_LAS __attribute__((address_space(3)))
typedef unsigned short bf16_t;
typedef short bf16x8 __attribute__((ext_vector_type(8)));
typedef float f32x4 __attribute__((ext_vector_type(4)));
typedef unsigned u32x4 __attribute__((ext_vector_type(4)));
typedef int i32x4_ __attribute__((ext_vector_type(4))); typedef int i32x8_ __attribute__((ext_vector_type(8)));
constexpr int BM = 256, BK = 64, HALF = 128, HTB = HALF * BK * 2  , STAGE_BYTES = 8 * HTB, NXCD = 8, WGM = 8;

__host__ __device__ __forceinline__ int lds_byte(int r, int c) { const int st = (r >> 4) * 2 + (c >> 5), rr = r & 15, cc = c & 31, ob = rr * 64 + cc * 2; return st * 1024 + (ob ^ (((ob >> 9) & 1) << 5)); }
__host__ __device__ __forceinline__ void stage_rc(int b, int& R, int& C) { const int st = b / 1024, sb = b % 1024, swz = sb ^ (((sb >> 9) & 1) << 5); R = (st >> 1) * 16 + swz / 64; C = (st & 1) * 32 + (swz % 64) / 2; }
__host__ __device__ __forceinline__ int perm32(int rho) { const int n = rho >> 4, i = rho & 15; return 8 * (i >> 2) + 4 * n + (i & 3); }

struct Unit { int pm, pn; };
struct Gemm { const bf16_t* A; const bf16_t* Bt; int M, N, K; };

struct StaticOrder {
    int nM, nN, nwg, G, c;
    __host__ __device__ void init(int M, int N, int G_, int c_) { nM = M / BM; nN = N / BM; nwg = nM * nN; G = G_; c = c_; }
    __host__ __device__ bool next(int i, Unit& u) const {
        const long L = (long)i * G + c; if (L >= nwg) return false;
        int wgid = (int)L; { const int q = nwg / NXCD, r = nwg % NXCD, xcd = wgid % NXCD, off = wgid / NXCD; wgid = (xcd < r ? xcd * (q + 1) : r * (q + 1) + (xcd - r) * q) + off; }
        const int nig = WGM * nN, gid = wgid / nig, fm = gid * WGM, gsz = (nM - fm) < WGM ? (nM - fm) : WGM;
        u.pm = fm + ((wgid % nig) % gsz); u.pn = (wgid % nig) / gsz; return true;
    }
    __device__ __forceinline__ void a_ready(const Unit&) const {}
    __device__ __forceinline__ void done(const Unit&) const {}
};

__device__ __forceinline__ unsigned cvt_pk_bf16(float lo, float hi) { unsigned r; asm volatile("v_cvt_pk_bf16_f32 %0, %1, %2" : "=v"(r) : "v"(lo), "v"(hi)); return r; }
typedef float f32x2 __attribute__((ext_vector_type(2)));
__device__ __forceinline__ f32x2 gelu_pk(f32x2 v) {
    const f32x2 av = __builtin_elementwise_abs(v), d = av * 0.2316418882f + 1.0f;
    f32x2 t; t.x = __builtin_amdgcn_rcpf(d.x); t.y = __builtin_amdgcn_rcpf(d.y);
    f32x2 q = t * 0.5307027145f + (-0.7265760135f); q = q * t + 0.7107068705f; q = q * t + (-0.142248368f); q = q * t + 0.127414796f; q = q * t;
    const f32x2 s = (v * v) * (-0.72134752044f);
    f32x2 e; e.x = __builtin_amdgcn_exp2f(s.x); e.y = __builtin_amdgcn_exp2f(s.y);
    const f32x2 m = v * (q * e), r = v - m;
    f32x2 o; o.x = v.x < 0.f ? m.x : r.x; o.y = v.y < 0.f ? m.y : r.y; return o;
}

template <int ACT  > struct EpiBf16 {
    static constexpr bool PERM = true, AFTER_DRAIN = false; static_assert(ACT == 0 || ACT == 1, "EpiBf16: ACT is 0 (none) or 1 (gelu_pk)");
    bf16_t* O; int ldc; const float* bias; int split_cols; size_t split_stride; float scale0; float ascale;
    __device__ __forceinline__ void operator()(const f32x4 (&acc)[2][2][4][2], const Unit& u, int wr, int wc, int fr, int fq) const {
        const int row0 = u.pm * BM + wr * 64 + fr; int colt = u.pn * BM; bf16_t* base = O;
        float sc = ascale; if (split_cols) { const int t = colt / split_cols; base += (size_t)t * split_stride; colt -= t * split_cols; if (t == 0) sc = scale0 * ascale; }
        const int col0 = colt + wc * 32 + 8 * fq, bcol0 = u.pn * BM + wc * 32 + 8 * fq;
        f32x4 bv[2][2];
#pragma unroll
        for (int bj = 0; bj < 2; ++bj)
#pragma unroll
            for (int n = 0; n < 2; ++n) bv[bj][n] = bias ? *(const f32x4*)(bias + bcol0 + bj * HALF + 4 * n) : (f32x4){0.f, 0.f, 0.f, 0.f};
#pragma unroll
        for (int ai = 0; ai < 2; ++ai)
#pragma unroll
            for (int m = 0; m < 4; ++m) { bf16_t* rowp = base + (size_t)(row0 + ai * HALF + m * 16) * ldc + col0;
#pragma unroll
                for (int bj = 0; bj < 2; ++bj) { f32x4 v0 = acc[ai][bj][m][0] + bv[bj][0], v1 = acc[ai][bj][m][1] + bv[bj][1];
                    if (ACT == 1) { f32x2 a = gelu_pk((f32x2){v0[0], v0[1]}), b = gelu_pk((f32x2){v0[2], v0[3]}), c = gelu_pk((f32x2){v1[0], v1[1]}), d = gelu_pk((f32x2){v1[2], v1[3]});
                        v0 = (f32x4){a.x, a.y, b.x, b.y}; v1 = (f32x4){c.x, c.y, d.x, d.y}; }
                    v0 = v0 * sc; v1 = v1 * sc; u32x4 w; w.x = cvt_pk_bf16(v0[0], v0[1]); w.y = cvt_pk_bf16(v0[2], v0[3]); w.z = cvt_pk_bf16(v1[0], v1[1]); w.w = cvt_pk_bf16(v1[2], v1[3]);
                    __builtin_nontemporal_store(w, (u32x4*)(rowp + bj * HALF)); } }
    }
};
template <class Epi, class Sched, bool ALIGN_EPI = false, bool SP2 = false, bool GATHER = false, bool FP8 = false>
__device__ __forceinline__ void gemm_phase(PG8_LAS unsigned char* lds, const Gemm g, const Sched& S, const Epi& E) {
    int tid_ = threadIdx.x; asm volatile("" : "+v"(tid_));
    const int tid = tid_, wid = __builtin_amdgcn_readfirstlane(tid >> 6), lane = tid & 63, wr = wid >> 2, wc = wid & 3, fr = lane & 15, fq = lane >> 4;
    const int K = g.K, nt = K / BK;
    unsigned voffA[2], voffB[2], vA0[2], vA1[2], vN0[2], vN1[2]; int Rr_[2], Cc_[2];
#pragma unroll
    for (int i = 0; i < 2; ++i) { int R, C; stage_rc(tid * 16 + i * 8192, R, C); const int Rb = Epi::PERM ? ((R & ~31) + perm32(R & 31)) : R;
        voffA[i] = (unsigned)(R * K + C) * 2u; voffB[i] = (unsigned)(Rb * K + C) * 2u; Rr_[i] = R; Cc_[i] = C; }
    const size_t kstep = (size_t)(BK * 2);
    const size_t hstep = (size_t)HALF * K * 2;
    const size_t tstep = 2 * hstep;
#pragma unroll
    for (int i = 0; i < 2; ++i) { vA0[i] = voffA[i]; vA1[i] = voffA[i] + (unsigned)hstep; vN0[i] = vA0[i]; vN1[i] = vA1[i]; }
#define PG8_GLOAD(u, v0, v1) do { _Pragma("unroll") for (int _i = 0; _i < 2; ++_i) { const int _t0 = S.rowtok[(u).pm * BM + Rr_[_i]], _t1 = S.rowtok[(u).pm * BM + HALF + Rr_[_i]]; \
        (v0)[_i] = (unsigned)_t0 * (unsigned)(K * 2) + (unsigned)(Cc_[_i] * 2); (v1)[_i] = (unsigned)_t1 * (unsigned)(K * 2) + (unsigned)(Cc_[_i] * 2); } } while (0)
    const unsigned ldsw = (unsigned)wid * 1024u;
    const int aoff = lds_byte(wr * 64 + fr, fq * 8), boff = lds_byte(wc * 32 + fr, fq * 8);
#define PG8_SA(b, h) (((b) * 2 + (h)) * HTB)
#define PG8_SB(b, h) ((4 + (b) * 2 + (h)) * HTB)
#define PG8_STAGE(bufoff, gbase, voff) do { _Pragma("unroll") for (int _i = 0; _i < 2; ++_i) \
        __builtin_amdgcn_global_load_lds((const unsigned*)((const char*)(gbase) + (voff)[_i]), (PG8_LAS unsigned*)(lds + (bufoff) + ldsw + _i * 8192), 16, 0, 0); } while (0)
#define PG8_LDA(dst, b, h) do { _Pragma("unroll") for (int m = 0; m < 4; ++m) _Pragma("unroll") for (int k = 0; k < 2; ++k) dst[m][k] = *(const PG8_LAS bf16x8*)(lds + PG8_SA(b, h) + aoff + m * 2048 + k * 1024); } while (0)
#define PG8_LDB(dst, b, h) do { _Pragma("unroll") for (int n = 0; n < 2; ++n) _Pragma("unroll") for (int k = 0; k < 2; ++k) dst[n][k] = *(const PG8_LAS bf16x8*)(lds + PG8_SB(b, h) + boff + n * 2048 + k * 1024); } while (0)
#define PG8_MMA(ai, bj, At, Bt) do { __builtin_amdgcn_s_setprio(1); _Pragma("unroll") for (int m = 0; m < 4; ++m) _Pragma("unroll") for (int n = 0; n < 2; ++n) _Pragma("unroll") for (int k = 0; k < 2; ++k) \
        acc[ai][bj][m][n] = __builtin_amdgcn_mfma_f32_16x16x32_bf16(Bt[n][k], At[m][k], acc[ai][bj][m][n], 0, 0, 0); __builtin_amdgcn_s_setprio(0); } while (0)
#define PG8_CAT8(x0, x1) __builtin_shufflevector(__builtin_bit_cast(i32x4_, x0), __builtin_bit_cast(i32x4_, x1), 0, 1, 2, 3, 4, 5, 6, 7)
#define PG8_MFMA8(ACC, B8, A8) asm volatile("s_nop 1\n\tv_mfma_scale_f32_16x16x128_f8f6f4 %0, %1, %2, %0, %3, %3 op_sel_hi:[0,0,0]" : "+v"(ACC) : "v"(B8), "v"(A8), "v"(sc8_))
#define PG8_MMA8(ai, bj, At, Bt) do { i32x8_ a8_[4], b8_[2]; _Pragma("unroll") for (int m = 0; m < 4; ++m) a8_[m] = PG8_CAT8(At[m][0], At[m][1]); _Pragma("unroll") for (int n = 0; n < 2; ++n) b8_[n] = PG8_CAT8(Bt[n][0], Bt[n][1]); \
        __builtin_amdgcn_s_setprio(1); _Pragma("unroll") for (int m = 0; m < 4; ++m) _Pragma("unroll") for (int n = 0; n < 2; ++n) PG8_MFMA8(acc[ai][bj][m][n], b8_[n], a8_[m]); __builtin_amdgcn_s_setprio(0); } while (0)
#define PG8_MM(ai, bj, At, Bt) do { if constexpr (FP8) PG8_MMA8(ai, bj, At, Bt); else PG8_MMA(ai, bj, At, Bt); } while (0)
#define PG8_WAIT_V(n) asm volatile("s_waitcnt vmcnt(" #n ")" ::: "memory")
#define PG8_WAIT_L(n) asm volatile("s_waitcnt lgkmcnt(" #n ")" ::: "memory")
#define PG8_BAR __builtin_amdgcn_s_barrier()
#define PG8_SCHED __builtin_amdgcn_sched_barrier(0)
    const int sc8_ = 0x7F7F7F7F;
    Unit cur, nxt; int ui = 0;
    if (!S.next(0, cur)) return;
    f32x4 acc[2][2][4][2];
#pragma unroll
    for (int a = 0; a < 2; ++a)
#pragma unroll
        for (int b = 0; b < 2; ++b)
#pragma unroll
            for (int m = 0; m < 4; ++m)
#pragma unroll
                for (int n = 0; n < 2; ++n) acc[a][b][m][n] = (f32x4){0.f, 0.f, 0.f, 0.f};
    bf16x8 At[4][2], B0[2][2], B1[2][2];
    if constexpr (GATHER) PG8_GLOAD(cur, vA0, vA1);
    const char* cA = GATHER ? (const char*)g.A : (const char*)g.A + (size_t)cur.pm * tstep; const char* cB = (const char*)g.Bt + (size_t)cur.pn * tstep;
    S.a_ready(cur);
    if constexpr (SP2) {
        PG8_STAGE(PG8_SB(0, 0), cB, voffB); PG8_STAGE(PG8_SB(0, 1), cB + hstep, voffB); PG8_STAGE(PG8_SA(0, 0), cA, vA0); PG8_STAGE(PG8_SA(0, 1), cA, vA1);
        if (wr == 1) PG8_BAR;
        PG8_WAIT_V(2); PG8_BAR;
        PG8_STAGE(PG8_SB(1, 0), cB + kstep, voffB); PG8_STAGE(PG8_SA(1, 0), cA + kstep, vA0); PG8_STAGE(PG8_SB(1, 1), cB + hstep + kstep, voffB);
        PG8_WAIT_V(6); PG8_BAR;
    } else {
        PG8_STAGE(PG8_SB(0, 0), cB, voffB); PG8_STAGE(PG8_SA(0, 0), cA, vA0); PG8_STAGE(PG8_SB(0, 1), cB + hstep, voffB); PG8_STAGE(PG8_SA(0, 1), cA, vA1);
        if (wr == 1) PG8_BAR;
        PG8_WAIT_V(4); PG8_BAR;
        PG8_STAGE(PG8_SB(1, 0), cB + kstep, voffB); PG8_STAGE(PG8_SA(1, 0), cA + kstep, vA0); PG8_STAGE(PG8_SB(1, 1), cB + hstep + kstep, voffB);
        PG8_WAIT_V(6); PG8_BAR;
    }
    for (;;) {
        const bool has_next = S.next(ui + 1, nxt);
        if constexpr (GATHER) { if (has_next) PG8_GLOAD(nxt, vN0, vN1); else { _Pragma("unroll") for (int i = 0; i < 2; ++i) { vN0[i] = vA0[i]; vN1[i] = vA1[i]; } } }
        const char* nA = GATHER ? (const char*)g.A : (has_next ? (const char*)g.A + (size_t)nxt.pm * tstep : cA); const char* nB = has_next ? (const char*)g.Bt + (size_t)nxt.pn * tstep : cB;
        for (int t = 0; t < nt; t += 2) {
            const bool last = (t == nt - 2);
            const char* a1 = cA + (size_t)(t + 1) * kstep;
            const char* a2 = last ? nA : cA + (size_t)(t + 2) * kstep; const char* b2 = last ? nB : cB + (size_t)(t + 2) * kstep;
            const char* a3 = a2 + kstep; const char* b3 = b2 + kstep;
            unsigned vX0[2], vX1[2];
#pragma unroll
            for (int i = 0; i < 2; ++i) { vX0[i] = (GATHER && last) ? vN0[i] : vA0[i]; vX1[i] = (GATHER && last) ? vN1[i] : vA1[i]; }
            if (last && has_next) S.a_ready(nxt);
            if constexpr (SP2) {
            PG8_LDB(B0, 0, 0); PG8_LDB(B1, 0, 1); PG8_SCHED; PG8_LDA(At, 0, 0); PG8_STAGE(PG8_SA(1, 1), a1, vA1);
            PG8_WAIT_V(8); PG8_WAIT_L(0); PG8_BAR; PG8_MM(0, 0, At, B0); PG8_MM(0, 1, At, B1); PG8_BAR; PG8_SCHED;
            PG8_LDA(At, 0, 1); PG8_STAGE(PG8_SB(0, 0), b2, voffB); PG8_STAGE(PG8_SB(0, 1), b2 + hstep, voffB); PG8_STAGE(PG8_SA(0, 0), a2, vX0);
            PG8_WAIT_V(8); PG8_WAIT_L(0); PG8_BAR; PG8_MM(1, 0, At, B0); PG8_MM(1, 1, At, B1); PG8_BAR; PG8_SCHED;
            PG8_LDB(B0, 1, 0); PG8_LDB(B1, 1, 1); PG8_SCHED; PG8_LDA(At, 1, 0); PG8_STAGE(PG8_SA(0, 1), a2, vX1);
            PG8_WAIT_V(8); PG8_WAIT_L(0); PG8_BAR; PG8_MM(0, 0, At, B0); PG8_MM(0, 1, At, B1); PG8_BAR; PG8_SCHED;
            PG8_LDA(At, 1, 1); PG8_STAGE(PG8_SB(1, 0), b3, voffB); PG8_STAGE(PG8_SB(1, 1), b3 + hstep, voffB); PG8_STAGE(PG8_SA(1, 0), a3, vX0);
            PG8_WAIT_V(8); PG8_WAIT_L(0); PG8_BAR; PG8_MM(1, 0, At, B0); PG8_MM(1, 1, At, B1); PG8_BAR; PG8_SCHED;
            } else {
            PG8_LDB(B0, 0, 0); PG8_SCHED; PG8_LDA(At, 0, 0); PG8_STAGE(PG8_SA(1, 1), a1, vA1);
            PG8_WAIT_L(8); PG8_BAR; PG8_WAIT_L(0); PG8_MM(0, 0, At, B0); PG8_BAR; PG8_SCHED;
            PG8_LDB(B1, 0, 1); PG8_STAGE(PG8_SB(0, 0), b2, voffB);
            PG8_BAR; PG8_WAIT_L(0); PG8_MM(0, 1, At, B1); PG8_BAR;
            PG8_LDA(At, 0, 1); PG8_STAGE(PG8_SA(0, 0), a2, vX0);
            PG8_BAR; PG8_WAIT_L(0); PG8_MM(1, 0, At, B0); PG8_BAR; PG8_SCHED;
            PG8_STAGE(PG8_SB(0, 1), b2 + hstep, voffB);
            PG8_WAIT_V(6); PG8_BAR; PG8_MM(1, 1, At, B1); PG8_BAR;
            PG8_LDB(B0, 1, 0); PG8_SCHED; PG8_LDA(At, 1, 0); PG8_STAGE(PG8_SA(0, 1), a2, vX1);
            PG8_WAIT_L(8); PG8_BAR; PG8_WAIT_L(0); PG8_MM(0, 0, At, B0); PG8_BAR; PG8_SCHED;
            PG8_LDB(B1, 1, 1); PG8_STAGE(PG8_SB(1, 0), b3, voffB);
            PG8_BAR; PG8_WAIT_L(0); PG8_MM(0, 1, At, B1); PG8_BAR;
            PG8_LDA(At, 1, 1); PG8_STAGE(PG8_SA(1, 0), a3, vX0);
            PG8_BAR; PG8_WAIT_L(0); PG8_MM(1, 0, At, B0); PG8_BAR; PG8_SCHED;
            PG8_STAGE(PG8_SB(1, 1), b3 + hstep, voffB);
            PG8_WAIT_V(6); PG8_BAR; PG8_MM(1, 1, At, B1); PG8_BAR;
            }
        }
        if constexpr (ALIGN_EPI) { if (wr == 0) PG8_BAR; }
        if constexpr (FP8) asm volatile("s_nop 15\n\ts_nop 15" ::: "memory");
        if constexpr (!Epi::AFTER_DRAIN) { E(acc, cur, wr, wc, fr, fq); S.done(cur); }
        if (!has_next) break;
#pragma unroll
        for (int a = 0; a < 2; ++a)
#pragma unroll
            for (int b = 0; b < 2; ++b)
#pragma unroll
                for (int m = 0; m < 4; ++m)
#pragma unroll
                    for (int n = 0; n < 2; ++n) acc[a][b][m][n] = (f32x4){0.f, 0.f, 0.f, 0.f};
        cur = nxt; cA = nA; cB = nB; ++ui;
        if constexpr (GATHER) { _Pragma("unroll") for (int i = 0; i < 2; ++i) { vA0[i] = vN0[i]; vA1[i] = vN1[i]; } }
        if constexpr (ALIGN_EPI) { if (wr == 1) PG8_BAR; }
    }
    PG8_WAIT_V(0);
    if constexpr (!ALIGN_EPI) { if (wr == 0) PG8_BAR; }
    PG8_BAR;
    if constexpr (Epi::AFTER_DRAIN) { E.fused(acc, cur, wr, wc, fr, fq, lds, wid, lane); S.done(cur); }
#undef PG8_SA
#undef PG8_SB
#undef PG8_STAGE
#undef PG8_GLOAD
#undef PG8_LDA
#undef PG8_LDB
#undef PG8_MMA
#undef PG8_MMA8
#undef PG8_MFMA8
#undef PG8_MM
#undef PG8_CAT8
#undef PG8_WAIT_V
#undef PG8_WAIT_L
#undef PG8_BAR
#undef PG8_SCHED
}
}
namespace pg8 {
__device__ __forceinline__ float bf_lo(unsigned w) { return __builtin_bit_cast(float, w << 16); }
__device__ __forceinline__ float bf_hi(unsigned w) { return __builtin_bit_cast(float, w & 0xffff0000u); }
__device__ __forceinline__ float sigmoid_f(float x) { return __builtin_amdgcn_rcpf(1.0f + __expf(-x)); }

template <bool ADD> struct EpiGate {
    static constexpr bool PERM = true, AFTER_DRAIN = false;
    const bf16_t* G; const bf16_t* Min; bf16_t* O;
    __device__ __forceinline__ void operator()(const f32x4 (&acc)[2][2][4][2], const Unit& u, int wr, int wc, int fr, int fq) const {
        const int row0 = u.pm * BM + wr * 64 + fr, col0 = u.pn * BM + wc * 32 + 8 * fq;
#pragma unroll
        for (int ai = 0; ai < 2; ++ai)
#pragma unroll
            for (int m = 0; m < 4; ++m) { const size_t off = (size_t)(row0 + ai * HALF + m * 16) * 1024 + col0;
#pragma unroll
                for (int bj = 0; bj < 2; ++bj) {
                    const u32x4 g = *(const u32x4*)(G + off + bj * HALF);
                    f32x4 v0 = acc[ai][bj][m][0], v1 = acc[ai][bj][m][1];
                    v0[0] *= sigmoid_f(bf_lo(g.x)); v0[1] *= sigmoid_f(bf_hi(g.x)); v0[2] *= sigmoid_f(bf_lo(g.y)); v0[3] *= sigmoid_f(bf_hi(g.y));
                    v1[0] *= sigmoid_f(bf_lo(g.z)); v1[1] *= sigmoid_f(bf_hi(g.z)); v1[2] *= sigmoid_f(bf_lo(g.w)); v1[3] *= sigmoid_f(bf_hi(g.w));
                    if (ADD) { const u32x4 p = *(const u32x4*)(Min + off + bj * HALF);
                        v0[0] += bf_lo(p.x); v0[1] += bf_hi(p.x); v0[2] += bf_lo(p.y); v0[3] += bf_hi(p.y);
                        v1[0] += bf_lo(p.z); v1[1] += bf_hi(p.z); v1[2] += bf_lo(p.w); v1[3] += bf_hi(p.w); }
                    u32x4 w; w.x = cvt_pk_bf16(v0[0], v0[1]); w.y = cvt_pk_bf16(v0[2], v0[3]); w.z = cvt_pk_bf16(v1[0], v1[1]); w.w = cvt_pk_bf16(v1[2], v1[3]);
                    __builtin_nontemporal_store(w, (u32x4*)(O + off + bj * HALF)); } }
    }
};

struct EpiResid {
    static constexpr bool PERM = false, AFTER_DRAIN = false;
    const float* X; const float* gate; float* out; int rows_per_batch; int gstride;
    __device__ __forceinline__ void operator()(const f32x4 (&acc)[2][2][4][2], const Unit& u, int wr, int wc, int fr, int fq) const {
        const int col0 = u.pn * BM + wc * 32 + 4 * fq;
#pragma unroll
        for (int ai = 0; ai < 2; ++ai)
#pragma unroll
            for (int m = 0; m < 4; ++m) { const int row = u.pm * BM + ai * HALF + wr * 64 + m * 16 + fr; const size_t off = (size_t)row * 1024 + col0;
                const float* gp = gate + (size_t)(row / rows_per_batch) * gstride + col0;
#pragma unroll
                for (int bj = 0; bj < 2; ++bj)
#pragma unroll
                    for (int n = 0; n < 2; ++n) { const f32x4 xv = *(const f32x4*)(X + off + bj * HALF + n * 16); const f32x4 gv = *(const f32x4*)(gp + bj * HALF + n * 16);
                        *(f32x4*)(out + off + bj * HALF + n * 16) = xv + gv * acc[ai][bj][m][n]; } }
    }
};

__device__ __forceinline__ float swiglu1(float g, float l) {
    g = fminf(g, 7.0f); l = fminf(fmaxf(l, -7.0f), 7.0f);
    return (l + 1.0f) * (g * __builtin_amdgcn_rcpf(1.0f + __expf(-1.702f * g)));
}
__device__ __forceinline__ unsigned pk4_fp8(float a, float b, float c, float d) { int r = 0; r = __builtin_amdgcn_cvt_pk_fp8_f32(a, b, r, false); r = __builtin_amdgcn_cvt_pk_fp8_f32(c, d, r, true); return (unsigned)r; }
template <bool OUT8> struct EpiSwiglu {
    static constexpr bool PERM = true, AFTER_DRAIN = false;
    const float* b1; bf16_t* O; float ascale;
    __device__ __forceinline__ void operator()(const f32x4 (&acc)[2][2][4][2], const Unit& u, int wr, int wc, int fr, int fq) const {
        const int e = u.pn >> 3, pl = u.pn & 7, jc = wc * 32 + 8 * fq;
        const float* bg = b1 + (size_t)e * 2048 + 128 * pl + jc; const float* bl = bg + 1024;
        const f32x4 bg0 = *(const f32x4*)bg, bg1 = *(const f32x4*)(bg + 4), bl0 = *(const f32x4*)bl, bl1 = *(const f32x4*)(bl + 4);
        const int row0 = u.pm * BM + wr * 64 + fr;
#pragma unroll
        for (int ai = 0; ai < 2; ++ai)
#pragma unroll
            for (int m = 0; m < 4; ++m) {
                const f32x4 g0 = acc[ai][0][m][0] * ascale + bg0, g1 = acc[ai][0][m][1] * ascale + bg1, l0 = acc[ai][1][m][0] * ascale + bl0, l1 = acc[ai][1][m][1] * ascale + bl1;
                if constexpr (OUT8) { typedef unsigned u32x2_ __attribute__((ext_vector_type(2))); u32x2_ w;
                    w.x = pk4_fp8(swiglu1(g0[0], l0[0]), swiglu1(g0[1], l0[1]), swiglu1(g0[2], l0[2]), swiglu1(g0[3], l0[3])); w.y = pk4_fp8(swiglu1(g1[0], l1[0]), swiglu1(g1[1], l1[1]), swiglu1(g1[2], l1[2]), swiglu1(g1[3], l1[3]));
                    __builtin_nontemporal_store(w, (u32x2_*)((unsigned char*)O + (size_t)(row0 + ai * HALF + m * 16) * 1024 + 128 * pl + jc)); }
                else { u32x4 w; w.x = cvt_pk_bf16(swiglu1(g0[0], l0[0]), swiglu1(g0[1], l0[1])); w.y = cvt_pk_bf16(swiglu1(g0[2], l0[2]), swiglu1(g0[3], l0[3]));
                    w.z = cvt_pk_bf16(swiglu1(g1[0], l1[0]), swiglu1(g1[1], l1[1])); w.w = cvt_pk_bf16(swiglu1(g1[2], l1[2]), swiglu1(g1[3], l1[3]));
                    __builtin_nontemporal_store(w, (u32x4*)(O + (size_t)(row0 + ai * HALF + m * 16) * 1024 + 128 * pl + jc)); } }
    }
};

struct EpiOutS {
    static constexpr bool PERM = true, AFTER_DRAIN = false;
    bf16_t* O; const float* bias; float ascale;
    __device__ __forceinline__ void operator()(const f32x4 (&acc)[2][2][4][2], const Unit& u, int wr, int wc, int fr, int fq) const {
        const int row0 = u.pm * BM + wr * 64 + fr, col0 = (u.pn & 3) * BM + wc * 32 + 8 * fq, bcol0 = u.pn * BM + wc * 32 + 8 * fq;
        f32x4 bv[2][2];
#pragma unroll
        for (int bj = 0; bj < 2; ++bj)
#pragma unroll
            for (int n = 0; n < 2; ++n) bv[bj][n] = *(const f32x4*)(bias + bcol0 + bj * HALF + 4 * n);
#pragma unroll
        for (int ai = 0; ai < 2; ++ai)
#pragma unroll
            for (int m = 0; m < 4; ++m) { bf16_t* rowp = O + (size_t)(row0 + ai * HALF + m * 16) * 1024 + col0;
#pragma unroll
                for (int bj = 0; bj < 2; ++bj) { const f32x4 v0 = acc[ai][bj][m][0] * ascale + bv[bj][0], v1 = acc[ai][bj][m][1] * ascale + bv[bj][1];
                    u32x4 w; w.x = cvt_pk_bf16(v0[0], v0[1]); w.y = cvt_pk_bf16(v0[2], v0[3]); w.z = cvt_pk_bf16(v1[0], v1[1]); w.w = cvt_pk_bf16(v1[2], v1[3]);
                    __builtin_nontemporal_store(w, (u32x4*)(rowp + bj * HALF)); } }
    }
};

struct GroupedOrder {
    const PG8_LAS int* ts; int NT, G, c; const int* rowtok;
    __device__ __forceinline__ bool next(int i, Unit& u) const {
        const int total = __builtin_amdgcn_readfirstlane(ts[32]) * NT; const long L = (long)i * G + c; if (L >= total) return false;
        const int pm = (int)L / NT, pl = (int)L % NT; int e = 0;
#pragma unroll 1
        for (int j = 1; j < 32; ++j) e += (pm >= ts[j]) ? 1 : 0;
        u.pm = __builtin_amdgcn_readfirstlane(pm); u.pn = __builtin_amdgcn_readfirstlane(e * NT + pl); return true;
    }
    __device__ __forceinline__ void a_ready(const Unit&) const {}
    __device__ __forceinline__ void done(const Unit&) const {}
};
}
#define GAS __attribute__((address_space(1)))
#define LAS __attribute__((address_space(3)))
typedef unsigned short bf16;
typedef unsigned v4u __attribute__((ext_vector_type(4)));
typedef float f32x4 __attribute__((ext_vector_type(4)));
typedef short bf16x8 __attribute__((ext_vector_type(8)));
typedef GAS unsigned gu32;
typedef GAS unsigned long long gu64;
#define RLX_AGENT __ATOMIC_RELAXED, __HIP_MEMORY_SCOPE_AGENT
#define LDS_WAIT() asm volatile("s_waitcnt lgkmcnt(0)" ::: "memory")
#define VM_WAIT() asm volatile("s_waitcnt vmcnt(0)" ::: "memory")
__device__ __forceinline__ unsigned long long rt() { return __builtin_amdgcn_s_memrealtime(); }
__device__ __forceinline__ unsigned f2bf(float f) { unsigned u = __builtin_bit_cast(unsigned, f); return (u + 0x7fffu + ((u >> 16) & 1u)) >> 16; }
typedef float f32x2_pk __attribute__((ext_vector_type(2))); typedef __bf16 bf16x2_pk __attribute__((ext_vector_type(2)));
__device__ __forceinline__ unsigned pk2(float lo, float hi) { const f32x2_pk v = {lo, hi}; return __builtin_bit_cast(unsigned, __builtin_convertvector(v, bf16x2_pk)); }

#define XB_TMO      128
#define XB_XCNT(j)  (256  + 64 * (j))
#define XB_XSUB(j)  (1280 + 64 * (j))
#define XB_XGEN(j)  (2304 + 64 * (j))
#define XB_TOP      3328
#define XB_TOPGEN   3392
#define XCD_BAR_WORDS 3456
#define XB_SPIN_CAP (1u << 18)

__device__ __forceinline__ unsigned xb_ld(unsigned* p)              { return __hip_atomic_load(p, __ATOMIC_RELAXED, __HIP_MEMORY_SCOPE_AGENT); }
__device__ __forceinline__ unsigned xb_add(unsigned* p, unsigned v) { return __hip_atomic_fetch_add(p, v, __ATOMIC_RELAXED, __HIP_MEMORY_SCOPE_AGENT); }
__device__ __forceinline__ unsigned xb_xcc_id() { return (unsigned)__builtin_amdgcn_s_getreg((3 << 11) | 20) & 0xFu; }
#define XB_SPIN(cond, bar) do { unsigned _sp = 0; while (cond) { __builtin_amdgcn_s_sleep(1); \
    if ((++_sp & 255u) == 0u) { if (xb_ld(&(bar)[XB_TMO])) break; if (_sp > XB_SPIN_CAP) { atomicAdd(&(bar)[XB_TMO], 1u); break; } } } } while (0)

struct XcdBarrier {
    unsigned* bar; unsigned x;
    volatile LAS unsigned* st;
};

__device__ __forceinline__ XcdBarrier xcd_barrier_post(unsigned* bar, volatile LAS unsigned* st) {
    XcdBarrier b; b.bar = bar; b.x = xb_xcc_id(); b.st = st;
    if (threadIdx.x == 0) (void)xb_add(&bar[XB_XCNT(b.x)], 1u);
    return b;
}
__device__ __forceinline__ void xcd_barrier_complete(unsigned* bar, unsigned x, unsigned& nloc, unsigned& nx) {
    const unsigned G = gridDim.x * gridDim.y * gridDim.z;
    unsigned sum, cnt, mine, sp = 0u;
    for (;;) {
        sum = 0u; cnt = 0u; mine = 0u;
#pragma unroll
        for (unsigned j = 0; j < 16; ++j) { const unsigned c = xb_ld(&bar[XB_XCNT(j)]); sum += c; cnt += (c > 0u) ? 1u : 0u; mine = (j == x) ? c : mine; }
        if (sum == G) break;
        __builtin_amdgcn_s_sleep(1);
        if ((++sp & 255u) == 0u) { if (xb_ld(&bar[XB_TMO])) break; if (sp > XB_SPIN_CAP) { atomicAdd(&bar[XB_TMO], 1u); break; } }
    }
    nloc = mine > 0u ? mine : 1u; nx = cnt > 0u ? cnt : 1u;
}

__device__ __forceinline__ void xcd_barrier(const XcdBarrier& b) {
    asm volatile("s_waitcnt vmcnt(0)" ::: "memory");
    __syncthreads();
    if (threadIdx.x == 0) {
        unsigned* bar = b.bar;
        __builtin_amdgcn_s_waitcnt(0);
        unsigned nloc = b.st[0], nx = b.st[1];
        if (nloc == 0u) { xcd_barrier_complete(bar, b.x, nloc, nx); b.st[0] = nloc; b.st[1] = nx; }
        const unsigned old = xb_add(&bar[XB_XSUB(b.x)], 1u);
        const unsigned gen = old / nloc;
        if (old + 1u == (gen + 1u) * nloc) {
            __builtin_amdgcn_fence(__ATOMIC_RELEASE, "agent");
            asm volatile("s_waitcnt vmcnt(0)" ::: "memory");
            const unsigned og = xb_add(&bar[XB_TOP], 1u);
            const unsigned tg = og / nx;
            if (og + 1u == (tg + 1u) * nx) xb_add(&bar[XB_TOPGEN], 1u);
            else XB_SPIN(xb_ld(&bar[XB_TOPGEN]) == tg, bar);
            __builtin_amdgcn_fence(__ATOMIC_ACQUIRE, "agent");
            xb_add(&bar[XB_XGEN(b.x)], 1u);
            asm volatile("s_waitcnt vmcnt(0)" ::: "memory");
        } else {
            XB_SPIN(xb_ld(&bar[XB_XGEN(b.x)]) == gen, bar);
            __builtin_amdgcn_fence(__ATOMIC_ACQUIRE, "agent");
            asm volatile("s_waitcnt vmcnt(0)" ::: "memory");
        }
    }
    __syncthreads();
}

constexpr int NWAVES = 8;
constexpr int BATCH = 16, SEQ = 2048, D = 1024, T = BATCH * SEQ;
constexpr int NIN = 9224, NPROJ = 9216, NMOD = 6 * D;
constexpr int NE = 32, TOPK = 4;
constexpr int XS_ROWS = T * TOPK + NE * 256;
constexpr float EPS = 1e-6f;
constexpr float ATT_RTHR = -120.0f;
constexpr float W8SCALE = 64.0f;
constexpr float QSCALE = 0.125f * 1.4426950408889634f;

constexpr size_t MiB = 1u << 20;
constexpr size_t WS_CTL = 0, CTL_ZERO_BYTES = 1 * MiB;
constexpr size_t WS_MODP = 1 * MiB;
constexpr size_t WS_MOD = 3 * MiB;
constexpr size_t WS_IPRE = 4 * MiB, WS_LF = 4 * MiB + 512 * 1024;
constexpr size_t WS_TOKE = 5 * MiB, WS_TOKP = 5 * MiB + 512 * 1024, WS_TOKW = 6 * MiB, WS_TOKROW = 6 * MiB + 512 * 1024, WS_RSTD = 7 * MiB;
constexpr size_t WS_WIN = 8 * MiB, WS_WA = 26 * MiB, WS_WB = 28 * MiB, WS_WOUT = 30 * MiB, WS_W1 = 32 * MiB, WS_W2 = 160 * MiB;
constexpr size_t WS_H1 = 224 * MiB;
constexpr size_t WS_PROJ = 288 * MiB, SEG = 64 * MiB;
constexpr size_t WS_YB = 864 * MiB;
constexpr size_t WS_XS = 288 * MiB, WS_ACT = 560 * MiB;
constexpr size_t WS_ROW2TOK = 7 * MiB + 128 * 1024;
constexpr size_t WS_GT = 928 * MiB;
constexpr size_t WS_END = 932 * MiB;
static_assert(WS_XS + (size_t)XS_ROWS * 2048 <= WS_ACT && WS_ACT + (size_t)XS_ROWS * 2048 <= WS_YB, "ws map");
constexpr int CW_TMO = 0, CW_BAR = 4096, CW_ECNT = 8192;

constexpr int RING_BYTES = 131072, LDS_BYTES = 147456, LDSCTL_OFF = 146432;
constexpr int LC_BAR = 0, LC_TS = 16, LC_LCNT = 64, LC_GBASE = 96, LC_PS = 128, LC_CNT = 160;

__device__ __forceinline__ unsigned long long karg(int i) { return ((const __attribute__((address_space(4))) unsigned long long*)__builtin_amdgcn_kernarg_segment_ptr())[i]; }
struct Frame {
    LAS unsigned char* lds; volatile LAS unsigned* LC;
    gu32* ctl; unsigned char* ws; int tid, lane, wave, vcu, G;
    __device__ __forceinline__ const float* x() const { return (const float*)(const GAS float*)karg(0); }
    __device__ __forceinline__ const float* c() const { return (const float*)(const GAS float*)karg(1); }
    __device__ __forceinline__ const float* ada_w() const { return (const float*)(const GAS float*)karg(2); }
    __device__ __forceinline__ const float* ada_b() const { return (const float*)(const GAS float*)karg(3); }
    __device__ __forceinline__ const float* norm1_g() const { return (const float*)(const GAS float*)karg(4); }
    __device__ __forceinline__ const float* w_in() const { return (const float*)(const GAS float*)karg(5); }
    __device__ __forceinline__ const float* conv_w() const { return (const float*)(const GAS float*)karg(6); }
    __device__ __forceinline__ const float* conv_b() const { return (const float*)(const GAS float*)karg(7); }
    __device__ __forceinline__ const float* b_i() const { return (const float*)(const GAS float*)karg(8); }
    __device__ __forceinline__ const float* b_f() const { return (const float*)(const GAS float*)karg(9); }
    __device__ __forceinline__ const float* ml_norm_g() const { return (const float*)(const GAS float*)karg(10); }
    __device__ __forceinline__ const float* w_a() const { return (const float*)(const GAS float*)karg(11); }
    __device__ __forceinline__ const float* w_b() const { return (const float*)(const GAS float*)karg(12); }
    __device__ __forceinline__ const float* w_out() const { return (const float*)(const GAS float*)karg(13); }
    __device__ __forceinline__ const float* norm2_g() const { return (const float*)(const GAS float*)karg(14); }
    __device__ __forceinline__ const float* router_w() const { return (const float*)(const GAS float*)karg(15); }
    __device__ __forceinline__ const float* router_b() const { return (const float*)(const GAS float*)karg(16); }
    __device__ __forceinline__ const float* w1() const { return (const float*)(const GAS float*)karg(17); }
    __device__ __forceinline__ const float* b1() const { return (const float*)(const GAS float*)karg(18); }
    __device__ __forceinline__ const float* w2() const { return (const float*)(const GAS float*)karg(19); }
    __device__ __forceinline__ const float* b2() const { return (const float*)(const GAS float*)karg(20); }
    __device__ __forceinline__ const float* final_g() const { return (const float*)(const GAS float*)karg(21); }
    __device__ __forceinline__ float* out() const { return (float*)(GAS float*)karg(22); }
    __device__ __forceinline__ float* modp() const { return (float*)(ws + WS_MODP); }
    __device__ __forceinline__ float* mod() const { return (float*)(ws + WS_MOD); }
    __device__ __forceinline__ float* ipre() const { return (float*)(ws + WS_IPRE); }
    __device__ __forceinline__ float* lf() const { return (float*)(ws + WS_LF); }
    __device__ __forceinline__ float* tokw() const { return (float*)(ws + WS_TOKW); }
    __device__ __forceinline__ float* rstd2() const { return (float*)(ws + WS_RSTD); }
    __device__ __forceinline__ int* toke() const { return (int*)(ws + WS_TOKE); }
    __device__ __forceinline__ int* tokp() const { return (int*)(ws + WS_TOKP); }
    __device__ __forceinline__ int* tokrow() const { return (int*)(ws + WS_TOKROW); }
    __device__ __forceinline__ bf16* WIN_T() const { return (bf16*)(ws + WS_WIN); }
    __device__ __forceinline__ bf16* WA_T() const { return (bf16*)(ws + WS_WA); }
    __device__ __forceinline__ bf16* WB_T() const { return (bf16*)(ws + WS_WB); }
    __device__ __forceinline__ bf16* WOUT_T() const { return (bf16*)(ws + WS_WOUT); }
    __device__ __forceinline__ bf16* W1_T() const { return (bf16*)(ws + WS_W1); }
    __device__ __forceinline__ bf16* W2_T() const { return (bf16*)(ws + WS_W2); }
    __device__ __forceinline__ bf16* H1() const { return (bf16*)(ws + WS_H1); }
    __device__ __forceinline__ bf16* PROJ() const { return (bf16*)(ws + WS_PROJ); }
    __device__ __forceinline__ bf16* YA() const { return (bf16*)(ws + WS_H1); }
    __device__ __forceinline__ bf16* YB() const { return (bf16*)(ws + WS_YB); }
    __device__ __forceinline__ bf16* M1() const { return (bf16*)(ws + WS_PROJ); }
    __device__ __forceinline__ bf16* MERGED() const { return (bf16*)(ws + WS_PROJ + SEG); }
    __device__ __forceinline__ bf16* XS() const { return (bf16*)(ws + WS_XS); }
    __device__ __forceinline__ bf16* ACT() const { return (bf16*)(ws + WS_ACT); }
    __device__ __forceinline__ bf16* OUTR() const { return (bf16*)(ws + WS_XS); }
    __device__ __forceinline__ bf16* H2() const { return (bf16*)(ws + WS_XS); }
    __device__ __forceinline__ int* row2tok() const { return (int*)(ws + WS_ROW2TOK); }
    __device__ __forceinline__ float* gt() const { return (float*)(ws + WS_GT); }
};

__device__ __forceinline__ int opq(int v) { asm volatile("" : "+v"(v)); return v; }
__device__ __forceinline__ float wave_sum(float v) {
#pragma unroll
    for (int o = 1; o < 64; o <<= 1) v += __shfl_xor(v, o);
    return v;
}
__device__ __forceinline__ float bf2f(unsigned short b) { return __builtin_bit_cast(float, (unsigned)b << 16); }
__device__ __forceinline__ float bflo(unsigned w) { return __builtin_bit_cast(float, w << 16); }
__device__ __forceinline__ float bfhi(unsigned w) { return __builtin_bit_cast(float, w & 0xffff0000u); }
__device__ __forceinline__ float log_sigmoid_f(float x) { return fminf(x, 0.f) - log1pf(expf(-fabsf(x))); }

struct MapIn { __device__ __forceinline__ long operator()(int n) const { return n < 7168 ? (long)n : (n < 7176 ? -1L : (n < NIN ? (long)(n - 8) : -1L)); } };
struct MapId { long off; __device__ __forceinline__ long operator()(int n) const { return off + n; } };
struct MapW1 { int e; __device__ __forceinline__ long operator()(int n) const { return (long)e * 2048 + ((n & 1023) >> 7) * 256 + (n >> 10) * 128 + (n & 127); } };

template <class Map> __device__ __forceinline__ void transpose_item(const float* W, int K, int N, bf16* WT, LAS float* scr, int item, int lane, Map map, float scale8 = 0.f) {
    const int nblk = (N + 31) / 32, kb = item / nblk, nb = item % nblk, k0 = 64 * kb, n0 = 32 * nb;
    const int n4 = 4 * (lane & 7), kr = lane >> 3;
    const bool ok = (n0 + n4 + 3) < N;
    f32x4 v[8];
#pragma unroll
    for (int i = 0; i < 8; ++i) v[i] = ok ? *(const f32x4*)(W + (size_t)(k0 + 8 * i + kr) * N + n0 + n4) : (f32x4){0.f, 0.f, 0.f, 0.f};
#pragma unroll
    for (int i = 0; i < 8; ++i) { LAS float* d = scr + (8 * i + kr) * 33 + n4; d[0] = v[i].x; d[1] = v[i].y; d[2] = v[i].z; d[3] = v[i].w; }
    LDS_WAIT(); asm volatile("" ::: "memory");
    const int c = lane & 7;
#pragma unroll
    for (int j = 0; j < 4; ++j) { const int n = (lane >> 3) + 8 * j; const LAS float* s = scr + (8 * c) * 33 + n;
        const long dr = map(n0 + n);
        if (scale8 != 0.f) { typedef unsigned u32x2_ __attribute__((ext_vector_type(2))); u32x2_ o;
            o.x = pg8::pk4_fp8(s[0 * 33] * scale8, s[1 * 33] * scale8, s[2 * 33] * scale8, s[3 * 33] * scale8); o.y = pg8::pk4_fp8(s[4 * 33] * scale8, s[5 * 33] * scale8, s[6 * 33] * scale8, s[7 * 33] * scale8);
            if (dr >= 0) *(GAS u32x2_*)((unsigned char*)WT + (size_t)dr * K + k0 + 8 * c) = o; }
        else { v4u o; o.x = pk2(s[0 * 33], s[1 * 33]); o.y = pk2(s[2 * 33], s[3 * 33]); o.z = pk2(s[4 * 33], s[5 * 33]); o.w = pk2(s[6 * 33], s[7 * 33]);
            if (dr >= 0) *(GAS v4u*)(WT + (size_t)dr * K + k0 + 8 * c) = o; } }
    LDS_WAIT(); asm volatile("" ::: "memory");
}
__device__ __forceinline__ void mod_item(Frame& F, const LAS float* sil, int it) {
    const int j = it % 96, kq = it / 96, n = 64 * j + F.lane, k0 = 256 * kq;
    float acc[16];
#pragma unroll
    for (int b = 0; b < 16; ++b) acc[b] = 0.f;
    const float* w = F.ada_w() + (size_t)k0 * NMOD + n;
    const LAS f32x4* s = (const LAS f32x4*)sil + k0 * 4;
    for (int kk = 0; kk < 256; kk += 8) {
        float wv[8];
#pragma unroll
        for (int u = 0; u < 8; ++u) wv[u] = w[(size_t)(kk + u) * NMOD];
#pragma unroll
        for (int u = 0; u < 8; ++u) {
#pragma unroll
            for (int q = 0; q < 4; ++q) { const f32x4 sv = s[(kk + u) * 4 + q]; acc[4 * q + 0] += sv.x * wv[u]; acc[4 * q + 1] += sv.y * wv[u]; acc[4 * q + 2] += sv.z * wv[u]; acc[4 * q + 3] += sv.w * wv[u]; }
        }
    }
    float* o = F.modp() + (size_t)kq * 16 * NMOD + n;
#pragma unroll
    for (int b = 0; b < 16; ++b) o[(size_t)b * NMOD] = acc[b];
}
__device__ __forceinline__ void p0_prologue(Frame& F) {
    LAS float* sil = (LAS float*)F.lds;
    for (int idx = F.tid; idx < 16384; idx += 512) { const int b = idx >> 10, k = idx & 1023; const float v = F.c()[idx]; sil[k * 16 + b] = v / (1.0f + __expf(-v)); }
    __syncthreads();
    LAS float* scr = (LAS float*)(F.lds + 65536 + F.wave * 8704);
    const int gw = F.vcu * NWAVES + F.wave, NGW = F.G * NWAVES;
    constexpr int I_MOD = 384, I_IN = 16 * 289, I_SQ = 16 * 32, I_W1 = 32 * 16 * 64, I_W2 = 32 * 16 * 32;
    constexpr int NITEMS = I_MOD + I_IN + 3 * I_SQ + I_W1 + I_W2;
    for (int it = gw; it < NITEMS; it += NGW) {
        int r = it;
        if (r < I_MOD) { mod_item(F, sil, r); continue; } r -= I_MOD;
        if (r < I_IN) { transpose_item(F.w_in(), D, NIN, F.WIN_T(), scr, r, F.lane, MapIn{}, W8SCALE); continue; } r -= I_IN;
        if (r < I_SQ) { transpose_item(F.w_a(), D, D, F.WA_T(), scr, r, F.lane, MapId{0}); continue; } r -= I_SQ;
        if (r < I_SQ) { transpose_item(F.w_b(), D, D, F.WB_T(), scr, r, F.lane, MapId{0}); continue; } r -= I_SQ;
        if (r < I_SQ) { transpose_item(F.w_out(), D, D, F.WOUT_T(), scr, r, F.lane, MapId{0}); continue; } r -= I_SQ;
        if (r < I_W1) { const int e = r >> 10; transpose_item(F.w1() + (size_t)e * D * 2048, D, 2048, F.W1_T(), scr, r & 1023, F.lane, MapW1{e}, W8SCALE); continue; } r -= I_W1;
        { const int e = r >> 9; transpose_item(F.w2() + (size_t)e * D * D, D, D, F.W2_T(), scr, r & 511, F.lane, MapId{(long)e * 1024}, W8SCALE); }
    }
}

__device__ __forceinline__ void p1_rows(Frame& F) {
    const int row0 = F.vcu * 128, b = row0 / SEQ, lane = opq(F.lane);
    LAS float* wif = (LAS float*)F.lds;
    for (int idx = F.tid; idx < 8192; idx += 512) wif[idx] = F.w_in()[(size_t)(idx >> 3) * NIN + 7168 + (idx & 7)];
    for (int idx = F.vcu * 512 + F.tid; idx < 16 * NMOD; idx += F.G * 512) { float s = F.ada_b()[idx % NMOD];
#pragma unroll
        for (int kq = 0; kq < 4; ++kq) s += F.modp()[(size_t)kq * 16 * NMOD + idx];
        F.mod()[idx] = s; }
    f32x4 Av[4], Bv[4];
#pragma unroll
    for (int j = 0; j < 4; ++j) { const int col = 4 * lane + 256 * j;
        f32x4 sh = *(const f32x4*)(F.ada_b() + col), sc = *(const f32x4*)(F.ada_b() + D + col);
#pragma unroll
        for (int kq = 0; kq < 4; ++kq) { sh += *(const f32x4*)(F.modp() + ((size_t)kq * 16 + b) * NMOD + col); sc += *(const f32x4*)(F.modp() + ((size_t)kq * 16 + b) * NMOD + D + col); }
        const f32x4 g = *(const f32x4*)(F.norm1_g() + col); Av[j] = g * (sc + 1.0f); Bv[j] = sh; }
    __syncthreads();
    f32x4 nx[4];
    { const GAS f32x4* xr = (const GAS f32x4*)(F.x() + (size_t)(row0 + 16 * F.wave) * D) + lane;
#pragma unroll
      for (int j = 0; j < 4; ++j) nx[j] = xr[64 * j]; }
    for (int r = 0; r < 16; ++r) {
        const int row = row0 + 16 * F.wave + r;
        f32x4 v[4]; float ss = 0.f;
#pragma unroll
        for (int j = 0; j < 4; ++j) { v[j] = nx[j]; ss += (v[j].x * v[j].x + v[j].y * v[j].y) + (v[j].z * v[j].z + v[j].w * v[j].w); }
        if (r < 15) { const GAS f32x4* xr = (const GAS f32x4*)(F.x() + (size_t)(row + 1) * D) + lane;
#pragma unroll
            for (int j = 0; j < 4; ++j) nx[j] = xr[64 * j]; }
        const float rstd = 1.0f / sqrtf(wave_sum(ss) * (1.0f / D) + EPS);
        GAS unsigned* o4 = (GAS unsigned*)((unsigned char*)F.H1() + (size_t)row * D) + lane;
        float p[8];
#pragma unroll
        for (int q = 0; q < 8; ++q) p[q] = 0.f;
#pragma unroll
        for (int j = 0; j < 4; ++j) { v[j] = v[j] * rstd * Av[j] + Bv[j];
            o4[64 * j] = pg8::pk4_fp8(v[j].x, v[j].y, v[j].z, v[j].w);
#pragma unroll
            for (int i = 0; i < 4; ++i) { const LAS f32x4* wp = (const LAS f32x4*)(wif + (4 * lane + 256 * j + i) * 8); const f32x4 w0 = wp[0], w1 = wp[1]; const float hv = v[j][i];
                p[0] += hv * w0.x; p[1] += hv * w0.y; p[2] += hv * w0.z; p[3] += hv * w0.w; p[4] += hv * w1.x; p[5] += hv * w1.y; p[6] += hv * w1.z; p[7] += hv * w1.w; } }
#pragma unroll
        for (int q = 0; q < 8; ++q) p[q] = wave_sum(p[q]);
        if (lane == 0) { const int t = row % SEQ;
#pragma unroll
            for (int hh = 0; hh < 4; ++hh) { F.ipre()[((size_t)b * 4 + hh) * SEQ + t] = p[hh] + F.b_i()[hh]; F.lf()[((size_t)b * 4 + hh) * SEQ + t] = log_sigmoid_f(p[4 + hh] + F.b_f()[hh]); } }
    }
}

__device__ __forceinline__ void attn_naive_item(Frame& F, int bh, int qblk) {
    const int b = bh >> 4, hd = bh & 15, t = qblk * 512 + F.tid;
    const bf16* Q = F.PROJ(); const bf16* K = F.PROJ() + SEG / 2; const bf16* V = F.PROJ() + SEG;
    const size_t rowb = (size_t)b * SEQ;
    float q[64], o[64];
    { const v4u* qp = (const v4u*)(Q + (rowb + t) * D + hd * 64);
#pragma unroll
      for (int i = 0; i < 8; ++i) { const v4u w = qp[i]; q[8 * i + 0] = bflo(w.x); q[8 * i + 1] = bfhi(w.x); q[8 * i + 2] = bflo(w.y); q[8 * i + 3] = bfhi(w.y); q[8 * i + 4] = bflo(w.z); q[8 * i + 5] = bfhi(w.z); q[8 * i + 6] = bflo(w.w); q[8 * i + 7] = bfhi(w.w); } }
#pragma unroll
    for (int i = 0; i < 64; ++i) o[i] = 0.f;
    float R = 0.f;
    LAS v4u* kt = (LAS v4u*)F.lds; LAS v4u* vt = (LAS v4u*)(F.lds + 8192);
    const int tmax_wave = qblk * 512 + F.wave * 64 + 63;
    bool wdone = false;
    LAS volatile int* dflag = (LAS volatile int*)(F.lds + 16384);
    if (F.tid < 8) dflag[F.tid] = 0;
    for (int tile = qblk * 8 + 7; tile >= 0; --tile) {
        __syncthreads();
        { int nd = 0;
#pragma unroll
          for (int w = 0; w < 8; ++w) nd += dflag[w];
          if (nd == 8) break; }
        { const int kr = F.tid >> 3, ch = F.tid & 7; const size_t g = (rowb + tile * 64 + kr) * D + hd * 64 + ch * 8;
          kt[F.tid] = *(const v4u*)(K + g); vt[F.tid] = *(const v4u*)(V + g); }
        __syncthreads();
        if (tile * 64 >= tmax_wave) continue;
        if (wdone) continue;
        for (int s = 63; s >= 0; --s) {
            const int key = tile * 64 + s;
            float z = 0.f;
#pragma unroll
            for (int i = 0; i < 8; ++i) { const v4u w = kt[s * 8 + i]; z += q[8 * i + 0] * bflo(w.x) + q[8 * i + 1] * bfhi(w.x) + q[8 * i + 2] * bflo(w.y) + q[8 * i + 3] * bfhi(w.y) + q[8 * i + 4] * bflo(w.z) + q[8 * i + 5] * bfhi(w.z) + q[8 * i + 6] * bflo(w.w) + q[8 * i + 7] * bfhi(w.w); }
            const float lb = fminf(z, 0.f) - __builtin_amdgcn_logf(1.0f + __builtin_amdgcn_exp2f(-fabsf(z)));
            const bool act = key < t;
            const float a = act ? __builtin_amdgcn_exp2f(lb + R) : 0.f;
            R += act ? (lb - z) : 0.f;
#pragma unroll
            for (int i = 0; i < 8; ++i) { const v4u w = vt[s * 8 + i]; o[8 * i + 0] += a * bflo(w.x); o[8 * i + 1] += a * bfhi(w.x); o[8 * i + 2] += a * bflo(w.y); o[8 * i + 3] += a * bfhi(w.y); o[8 * i + 4] += a * bflo(w.z); o[8 * i + 5] += a * bfhi(w.z); o[8 * i + 6] += a * bflo(w.w); o[8 * i + 7] += a * bfhi(w.w); }
        }
        if (__all(R < ATT_RTHR) && !wdone) { wdone = true; if (F.lane == 0) dflag[F.wave] = 1; }
    }
    __syncthreads();
    v4u* op = (v4u*)(F.YA() + (rowb + t) * D + hd * 64);
#pragma unroll
    for (int i = 0; i < 8; ++i) { v4u w; w.x = pk2(o[8 * i + 0], o[8 * i + 1]); w.y = pk2(o[8 * i + 2], o[8 * i + 3]); w.z = pk2(o[8 * i + 4], o[8 * i + 5]); w.w = pk2(o[8 * i + 6], o[8 * i + 7]); op[i] = w; }
}

__device__ __forceinline__ void mlstm_naive_item(Frame& F, int bh) {
    const int b = bh >> 2, hh = bh & 3, tid = opq(F.tid), e = tid & 255, half = tid >> 8;
    const bf16* MLQ = F.PROJ() + 3 * (SEG / 2); const bf16* MLK = F.PROJ() + 4 * (SEG / 2); const bf16* MLV = F.PROJ() + 5 * (SEG / 2); const bf16* MLO = F.PROJ() + 6 * (SEG / 2);
    LAS float* ql = (LAS float*)F.lds; LAS float* kl = ql + 8192; LAS float* vl = kl + 8192; LAS float* hl = vl + 8192;
    LAS float* part = hl + 8192;
    LAS float* red = part + 512;
    LAS float* il = red + 8; LAS float* fl = il + 32;
    const size_t rowb = (size_t)b * SEQ;
    float C[128];
#pragma unroll
    for (int i = 0; i < 128; ++i) C[i] = 0.f;
    float nreg = 0.f, m = 0.f;
    float cw[2][4], cb[2];
    { const int c = tid & 255;
#pragma unroll
      for (int z = 0; z < 2; ++z) { const int ch = z * 1024 + hh * 256 + c; cb[z] = F.conv_b()[ch];
#pragma unroll
          for (int tap = 0; tap < 4; ++tap) cw[z][tap] = F.conv_w()[tap * 2048 + ch]; } }
    for (int chunk = 0; chunk < SEQ / 32; ++chunk) {
        const int t0 = chunk * 32;
        __syncthreads();
        { const int c = tid & 255;
          for (int u = 0; u < 16; ++u) { const int tt = (tid >> 8) + 2 * u, t = t0 + tt; float yq = cb[0], yk = cb[1];
#pragma unroll
              for (int tap = 0; tap < 4; ++tap) { const int ts = t - 3 + tap; if (ts >= 0) { const size_t g = (rowb + ts) * D + hh * 256 + c; yq += cw[0][tap] * bf2f(MLQ[g]); yk += cw[1][tap] * bf2f(MLK[g]); } }
              ql[tt * 256 + c] = yq / (1.0f + __expf(-yq)); kl[tt * 256 + c] = (yk / (1.0f + __expf(-yk))) * 0.0625f;
              vl[tt * 256 + c] = bf2f(MLV[(rowb + t) * D + hh * 256 + c]); }
          if (tid < 32) { il[tid] = F.ipre()[((size_t)b * 4 + hh) * SEQ + t0 + tid]; fl[tid] = F.lf()[((size_t)b * 4 + hh) * SEQ + t0 + tid]; } }
        __syncthreads();
        for (int tt = 0; tt < 32; ++tt) {
            const float lfv = fl[tt], iv = il[tt];
            const float mn = fmaxf(lfv + m, iv), fp = __expf(lfv + m - mn), ip = __expf(iv - mn); m = mn;
            const float vv = vl[tt * 256 + e] * ip;
            const LAS f32x4* kq = (const LAS f32x4*)(kl + tt * 256 + 128 * half); const LAS f32x4* qq = (const LAS f32x4*)(ql + tt * 256 + 128 * half);
            float num = 0.f;
#pragma unroll
            for (int i = 0; i < 32; ++i) { const f32x4 kv = kq[i], qv = qq[i];
                C[4 * i + 0] = fp * C[4 * i + 0] + kv.x * vv; C[4 * i + 1] = fp * C[4 * i + 1] + kv.y * vv; C[4 * i + 2] = fp * C[4 * i + 2] + kv.z * vv; C[4 * i + 3] = fp * C[4 * i + 3] + kv.w * vv;
                num += (qv.x * C[4 * i + 0] + qv.y * C[4 * i + 1]) + (qv.z * C[4 * i + 2] + qv.w * C[4 * i + 3]); }
            const int buf = tt & 1;
            if (tid < 256) { nreg = fp * nreg + ip * kl[tt * 256 + tid]; const float pd = wave_sum(ql[tt * 256 + tid] * nreg); if (F.lane == 0) red[buf * 4 + F.wave] = pd; }
            else part[buf * 256 + e] = num;
            __syncthreads();
            if (tid < 256) { num += part[buf * 256 + e]; const float den = (red[buf * 4 + 0] + red[buf * 4 + 1]) + (red[buf * 4 + 2] + red[buf * 4 + 3]);
                hl[tt * 256 + e] = num / fmaxf(fabsf(den), __expf(-m)); }
        }
        __syncthreads();
        for (int r = 0; r < 4; ++r) { const int tt = 4 * F.wave + r; const size_t row = rowb + t0 + tt;
            const f32x4 hv = *(const LAS f32x4*)(hl + tt * 256 + 4 * F.lane);
            const float ss = wave_sum((hv.x * hv.x + hv.y * hv.y) + (hv.z * hv.z + hv.w * hv.w));
            const float rstd = 1.0f / sqrtf(ss * (1.0f / 256.0f) + EPS);
            const int col = hh * 256 + 4 * F.lane; const f32x4 g = *(const f32x4*)(F.ml_norm_g() + col);
            const unsigned long long ow = *(const unsigned long long*)(MLO + row * D + col);
            const float o0 = bflo((unsigned)ow), o1 = bfhi((unsigned)ow), o2 = bflo((unsigned)(ow >> 32)), o3 = bfhi((unsigned)(ow >> 32));
            const float y0 = hv.x * rstd * g.x / (1.0f + __expf(-o0)), y1 = hv.y * rstd * g.y / (1.0f + __expf(-o1)), y2 = hv.z * rstd * g.z / (1.0f + __expf(-o2)), y3 = hv.w * rstd * g.w / (1.0f + __expf(-o3));
            *(unsigned long long*)(F.YB() + row * D + col) = (unsigned long long)pk2(y0, y1) | ((unsigned long long)pk2(y2, y3) << 32); }
    }
}


namespace ml {
typedef short bf16x8 __attribute__((ext_vector_type(8)));
typedef short s16x4 __attribute__((ext_vector_type(4)));
typedef float f32x16 __attribute__((ext_vector_type(16)));
typedef LAS const char* lcp;
typedef LAS char* lp_t;
constexpr int L = 64;
constexpr int O_QI = 0, O_KI = 33792, O_CB = 67584, O_VI = 102400, O_VW = 111616, O_PI = 120832, O_F = 130048;
constexpr int F_NV = 0, F_QNP = 256, F_RSP = 768, F_AT = 896, F_US = 960, F_WIN = 1024, F_EDEN = 1088, F_WST = 1152, F_RDEN = 1216, F_CW = 1280, F_CBIAS = 3328;
__device__ __forceinline__ int crow(int r, int hi) { return (r & 3) + 8 * (r >> 2) + 4 * hi; }
template <int PITCH, int XM> __device__ __forceinline__ int ioff(int row, int ch) { return XM ? PITCH * row + 16 * (ch ^ (row & XM)) : PITCH * row + 16 * ch; }
template <int PITCH, int XM> __device__ __forceinline__ bf16x8 frag_row(lcp img, int row0, int s, int lane) {
    return *(LAS const bf16x8*)(img + ioff<PITCH, XM>(row0 + (lane & 31), 2 * s + (lane >> 5)));
}
template <int PITCH, int XM> __device__ __forceinline__ bf16x8 frag_tr(lcp img, int k0, int ks, int col0, int lane) {
    const int h = lane >> 5, blk = (lane >> 4) & 1, q = (lane & 15) >> 2, p = lane & 3;
    const int r0 = k0 + 16 * ks + 8 * h + q, ch = (col0 >> 3) + 2 * blk + (p >> 1);
    typedef short v4i16_t __attribute__((ext_vector_type(4)));
    const s16x4 a = __builtin_bit_cast(s16x4, __builtin_amdgcn_ds_read_tr16_b64_v4i16((LAS v4i16_t*)(img + ioff<PITCH, XM>(r0, ch) + 8 * (p & 1))));
    const s16x4 b = __builtin_bit_cast(s16x4, __builtin_amdgcn_ds_read_tr16_b64_v4i16((LAS v4i16_t*)(img + ioff<PITCH, XM>(r0 + 4, ch) + 8 * (p & 1))));
    return (bf16x8){a[0], a[1], a[2], a[3], b[0], b[1], b[2], b[3]};
}
__device__ __forceinline__ float half_sum(float v) {
    const auto rr = __builtin_amdgcn_permlane32_swap(__builtin_bit_cast(unsigned, v), __builtin_bit_cast(unsigned, v), false, false);
    return __builtin_bit_cast(float, rr[0]) + __builtin_bit_cast(float, rr[1]);
}
__device__ __forceinline__ float silu_f(float y) { return y * __builtin_amdgcn_rcpf(1.0f + __expf(-y)); }

__device__ __forceinline__ void mlstm_unit(Frame& F, int unit) {
    const int bh = unit >> 2, sl = unit & 3, b = bh >> 2, hh = bh & 3, tid = opq(F.tid), lane = opq(F.lane), wave = F.wave, hi = lane >> 5, l31 = lane & 31;
    const bf16* MLQ = (const bf16*)F.out(); const bf16* MLK = MLQ + (size_t)T * D; const bf16* MLV = F.PROJ() + 5 * (SEG / 2);
    lp_t base = (lp_t)F.lds;
    LAS float* Fa = (LAS float*)(base + O_F);
    const size_t rowb = (size_t)b * SEQ;
    const float LOG2E = 1.4426950408889634f;
    __syncthreads();
    for (int i = tid; i < 34816 / 16; i += 512) ((LAS v4u*)(base + O_CB))[i] = (v4u){0u, 0u, 0u, 0u};
    if (tid < 256) Fa[F_NV + tid] = 0.f;
    f32x16 C0, C1, C2;
#pragma unroll
    for (int r = 0; r < 16; ++r) { C0[r] = 0.f; C1[r] = 0.f; C2[r] = 0.f; }
    if (tid < 64) *(LAS v4u*)(base + O_VW + 144 * tid + 128) = (v4u){0u, 0u, 0u, 0u};
    const int cg = tid & 31, rb = tid >> 5;
    v4u rawq[2][4], rawk[2][4], rawv[2]; float g_bb[2], g_us[2], g_pm[2]; float m_prev = 0.f;
#define ML_PREFETCH(T0, P) do { const int t0_ = (T0); \
        _Pragma("unroll") for (int i = 0; i < 4; ++i) { const unsigned g_ = (unsigned)(((int)rowb + t0_ + 4 * rb + i) * D + hh * 256 + cg * 8); \
            rawq[P][i] = *(const v4u*)(MLQ + g_); rawk[P][i] = *(const v4u*)(MLK + g_); } \
        rawv[P] = *(const v4u*)(MLV + (unsigned)(((int)rowb + t0_ + (tid >> 3)) * D + hh * 256 + 64 * sl + (tid & 7) * 8)); \
        { const float* gt_ = F.gt() + (unsigned)(((bh * (SEQ / L) + t0_ / L) * 3) * 64 + lane); g_bb[P] = gt_[0]; g_us[P] = gt_[64]; g_pm[P] = gt_[128]; } } while (0)
    ML_PREFETCH(0, 0); ML_PREFETCH(L, 1);
    __syncthreads();
    for (int chunk2 = 0; chunk2 < SEQ / L; chunk2 += 2) {
#pragma unroll
      for (int par = 0; par < 2; ++par) {
        const int chunk = chunk2 + par, t0 = chunk * L;
        const int tid = opq(F.tid), lane = tid & 63, hi = lane >> 5, l31 = lane & 31, cg = tid & 31, rb = tid >> 5, lo = lane;
        const float u = g_us[par], mm = g_bb[par] + fmaxf(m_prev, g_pm[par]), winter = __builtin_amdgcn_exp2f(g_bb[par] + m_prev - mm), at = g_bb[par] - mm, eden = __builtin_amdgcn_exp2f(-mm);
        const float bb63 = __builtin_bit_cast(float, __builtin_amdgcn_readlane(__builtin_bit_cast(int, g_bb[par]), 63)), mnew = __builtin_bit_cast(float, __builtin_amdgcn_readlane(__builtin_bit_cast(int, mm), 63));
        const float decay = __builtin_amdgcn_exp2f(bb63 + m_prev - mnew), wstate = __builtin_amdgcn_exp2f(bb63 - mnew + u); m_prev = mnew;
        if (wave == 0) { Fa[F_AT + lane] = at; Fa[F_US + lane] = u; Fa[F_WIN + lane] = winter; Fa[F_EDEN + lane] = eden; Fa[F_WST + lane] = wstate; }
#pragma unroll
        for (int j = 0; j < 4; ++j) { *(LAS v4u*)(base + O_QI + ioff<528, 0>(4 * rb + j, cg)) = rawq[par][j]; *(LAS v4u*)(base + O_KI + ioff<528, 0>(4 * rb + j, cg)) = rawk[par][j]; }
        { const int s = tid >> 3, ch = tid & 7; const v4u w = rawv[par];
          *(LAS v4u*)(base + O_VI + ioff<144, 0>(s, ch)) = w;
          const float ws = __shfl(wstate, s);
          v4u o; o.x = pk2(bflo(w.x) * ws, bfhi(w.x) * ws); o.y = pk2(bflo(w.y) * ws, bfhi(w.y) * ws); o.z = pk2(bflo(w.z) * ws, bfhi(w.z) * ws); o.w = pk2(bflo(w.w) * ws, bfhi(w.w) * ws);
          *(LAS v4u*)(base + O_VW + ioff<144, 0>(s, ch)) = o;
          if (ch == 0) *(LAS unsigned short*)(base + O_VW + 144 * s + 128) = (unsigned short)pk2(ws, 0.f); }
        __syncthreads();
        if (chunk + 2 < SEQ / L) ML_PREFETCH(t0 + 2 * L, par);
        __builtin_amdgcn_sched_barrier(0);
        f32x16 acc;
#pragma unroll
        for (int r = 0; r < 16; ++r) acc[r] = 0.f;
        const int wq = wave & 3, ta = wq >> 1, tb = wq & 1;
        if (wave < 4) {
#pragma unroll
            for (int kh = 0; kh < 2; ++kh) { bf16x8 fa[8], fb[8];
#pragma unroll
                for (int ks = 0; ks < 8; ++ks) { fa[ks] = frag_row<528, 0>(base + O_KI, 32 * tb, 8 * kh + ks, lo); fb[ks] = frag_row<528, 0>(base + O_QI, 32 * ta, 8 * kh + ks, lo); }
                __builtin_amdgcn_sched_barrier(0);
#pragma unroll
                for (int ks = 0; ks < 8; ++ks) acc = __builtin_amdgcn_mfma_f32_32x32x16_bf16(fa[ks], fb[ks], acc, 0, 0, 0);
                __builtin_amdgcn_sched_barrier(0); }
            const float at_l = __shfl(at, 32 * ta + l31); const int t = 32 * ta + l31; float rsum = 0.f;
#pragma unroll
            for (int g = 0; g < 4; ++g) { const int s0 = 32 * tb + 8 * g + 4 * hi; const f32x4 us4 = *(LAS const f32x4*)(Fa + F_US + s0); float p[4];
#pragma unroll
                for (int i = 0; i < 4; ++i) { p[i] = (s0 + i <= t) ? acc[4 * g + i] * __builtin_amdgcn_exp2f(at_l + us4[i]) : 0.f; rsum += p[i]; }
                *(LAS unsigned long long*)(base + O_PI + ioff<144, 0>(t, s0 >> 3) + 2 * (s0 & 7)) = (unsigned long long)pk2(p[0], p[1]) | ((unsigned long long)pk2(p[2], p[3]) << 32); }
            rsum = half_sum(rsum);
            if (hi == 0) Fa[F_RSP + tb * 64 + t] = rsum;
        } else {
#pragma unroll
            for (int kh = 0; kh < 2; ++kh) { bf16x8 fa[8], fb[8];
#pragma unroll
                for (int ks = 0; ks < 8; ++ks) { fa[ks] = frag_row<528, 0>(base + O_QI, 32 * ta, 8 * kh + ks, lo); fb[ks] = frag_tr<136, 0>(base + O_CB, 0, 8 * kh + ks, 32 * tb, lo); }
                __builtin_amdgcn_sched_barrier(0);
#pragma unroll
                for (int ks = 0; ks < 8; ++ks) acc = __builtin_amdgcn_mfma_f32_32x32x16_bf16(fa[ks], fb[ks], acc, 0, 0, 0);
                __builtin_amdgcn_sched_barrier(0); }
        }
        { float s = 0.f;
#pragma unroll
          for (int c = 0; c < 4; ++c) { const v4u w = *(LAS const v4u*)(base + O_QI + ioff<528, 0>(lane, 4 * wave + c)); const f32x4 n0 = *(LAS const f32x4*)(Fa + F_NV + 32 * wave + 8 * c), n1 = *(LAS const f32x4*)(Fa + F_NV + 32 * wave + 8 * c + 4);
              s += bflo(w.x) * n0.x + bfhi(w.x) * n0.y + bflo(w.y) * n0.z + bfhi(w.y) * n0.w + bflo(w.z) * n1.x + bfhi(w.z) * n1.y + bflo(w.w) * n1.z + bfhi(w.w) * n1.w; }
          Fa[F_QNP + wave * 64 + lane] = s; }
        __syncthreads();
        if (wave >= 4) {
            { const int t = 32 * ta + l31;
              const float den = Fa[F_WIN + t] * (((Fa[F_QNP + t] + Fa[F_QNP + 64 + t]) + (Fa[F_QNP + 128 + t] + Fa[F_QNP + 192 + t])) + ((Fa[F_QNP + 256 + t] + Fa[F_QNP + 320 + t]) + (Fa[F_QNP + 384 + t] + Fa[F_QNP + 448 + t])))
                                + Fa[F_RSP + t] + Fa[F_RSP + 64 + t];
              if (hi == 0) Fa[F_CW + 32 * (wave - 4) + l31] = 1.0f / fmaxf(fabsf(den), Fa[F_EDEN + t]); }
#pragma unroll
            for (int g = 0; g < 4; ++g) { const f32x4 w4 = *(LAS const f32x4*)(Fa + F_WIN + 32 * ta + 8 * g + 4 * hi); acc[4 * g] *= w4.x; acc[4 * g + 1] *= w4.y; acc[4 * g + 2] *= w4.z; acc[4 * g + 3] *= w4.w; }
            { bf16x8 fa[4], fb[4];
#pragma unroll
              for (int ks = 0; ks < 4; ++ks) { fa[ks] = frag_row<144, 0>(base + O_PI, 32 * ta, ks, lo); fb[ks] = frag_tr<144, 0>(base + O_VI, 0, ks, 32 * tb, lo); }
              __builtin_amdgcn_sched_barrier(0);
#pragma unroll
              for (int ks = 0; ks < 4; ++ks) acc = __builtin_amdgcn_mfma_f32_32x32x16_bf16(fa[ks], fb[ks], acc, 0, 0, 0); }
            bf16* dst = F.YB() + (rowb + t0 + 32 * ta) * D + hh * 256 + 64 * sl + 32 * tb + l31;
#pragma unroll
            for (int g = 0; g < 4; ++g) { const f32x4 r4 = *(LAS const f32x4*)(Fa + F_CW + 32 * (wave - 4) + 8 * g + 4 * hi);
#pragma unroll
                for (int i = 0; i < 4; ++i) dst[(size_t)(8 * g + 4 * hi + i) * D] = (bf16)pk2(acc[4 * g + i] * r4[i], 0.f); }
        }
#pragma unroll
        for (int r = 0; r < 16; ++r) { C0[r] *= decay; C1[r] *= decay; C2[r] *= decay; }
        { bf16x8 bk[4], v0[4], v1[4], v2[4];
#pragma unroll
          for (int ks = 0; ks < 4; ++ks) { bk[ks] = frag_tr<528, 0>(base + O_KI, 0, ks, 32 * wave, lo); v0[ks] = frag_tr<144, 0>(base + O_VW, 0, ks, 0, lo); v1[ks] = frag_tr<144, 0>(base + O_VW, 0, ks, 32, lo); v2[ks] = frag_tr<144, 0>(base + O_VW, 0, ks, 64, lo); }
          __builtin_amdgcn_sched_barrier(0);
#pragma unroll
          for (int ks = 0; ks < 4; ++ks) { C0 = __builtin_amdgcn_mfma_f32_32x32x16_bf16(v0[ks], bk[ks], C0, 0, 0, 0); C1 = __builtin_amdgcn_mfma_f32_32x32x16_bf16(v1[ks], bk[ks], C1, 0, 0, 0); C2 = __builtin_amdgcn_mfma_f32_32x32x16_bf16(v2[ks], bk[ks], C2, 0, 0, 0); }
          __builtin_amdgcn_sched_barrier(0); }
        { const int d = 32 * wave + l31;
#pragma unroll
          for (int g = 0; g < 4; ++g) { const int e0 = 8 * g + 4 * hi;
              *(LAS unsigned long long*)(base + O_CB + ioff<136, 0>(d, e0 >> 3) + 2 * (e0 & 7)) = (unsigned long long)pk2(C0[4 * g], C0[4 * g + 1]) | ((unsigned long long)pk2(C0[4 * g + 2], C0[4 * g + 3]) << 32);
              *(LAS unsigned long long*)(base + O_CB + ioff<136, 0>(d, (32 + e0) >> 3) + 2 * (e0 & 7)) = (unsigned long long)pk2(C1[4 * g], C1[4 * g + 1]) | ((unsigned long long)pk2(C1[4 * g + 2], C1[4 * g + 3]) << 32); }
          if (hi == 0) Fa[F_NV + d] = C2[0];
        }
        __syncthreads();
      }
    }
#undef ML_PREFETCH
}
}


__device__ __forceinline__ void mlstm_gates(Frame& F, int job) {
    const int lane = opq(F.lane); const float LOG2E = 1.4426950408889634f;
    const float lf2 = F.lf()[(size_t)job * ml::L + lane] * LOG2E, ii2 = F.ipre()[(size_t)job * ml::L + lane] * LOG2E;
    float bb = lf2;
#pragma unroll
    for (int o = 1; o < 64; o <<= 1) { const float v = __shfl_up(bb, o); bb += (lane >= o) ? v : 0.f; }
    const float u = ii2 - bb; float pm = u;
#pragma unroll
    for (int o = 1; o < 64; o <<= 1) { const float v = __shfl_up(pm, o); pm = (lane >= o) ? fmaxf(pm, v) : pm; }
    float* gt = F.gt() + (size_t)job * 3 * 64 + lane;
    gt[0] = bb; gt[64] = u; gt[128] = pm;
}

__device__ __forceinline__ void mlstm_conv_rows(Frame& F) {
    const int tid = opq(F.tid), cg = tid & 255, z = cg >> 7, c0 = (cg & 127) * 8, r0 = F.vcu * 128 + 64 * (tid >> 8);
    const bf16* src = F.PROJ() + (size_t)(3 + z) * (SEG / 2) + c0; bf16* dst = (bf16*)F.out() + (size_t)z * T * D + c0;
    float w[4][8], bs[8];
#pragma unroll
    for (int tap = 0; tap < 4; ++tap) { const f32x4 a0 = *(const f32x4*)(F.conv_w() + tap * 2048 + cg * 8), a1 = *(const f32x4*)(F.conv_w() + tap * 2048 + cg * 8 + 4);
        w[tap][0] = a0.x; w[tap][1] = a0.y; w[tap][2] = a0.z; w[tap][3] = a0.w; w[tap][4] = a1.x; w[tap][5] = a1.y; w[tap][6] = a1.z; w[tap][7] = a1.w; }
    { const f32x4 a0 = *(const f32x4*)(F.conv_b() + cg * 8), a1 = *(const f32x4*)(F.conv_b() + cg * 8 + 4);
      bs[0] = a0.x; bs[1] = a0.y; bs[2] = a0.z; bs[3] = a0.w; bs[4] = a1.x; bs[5] = a1.y; bs[6] = a1.z; bs[7] = a1.w; }
    const float osc = z ? 0.0625f : 1.0f;
    const bool seq_start = (r0 % SEQ) == 0;
    v4u x0, x1, x2;
    { const v4u zero = {0u, 0u, 0u, 0u};
      x0 = seq_start ? zero : *(const v4u*)(src + (size_t)(r0 - 3 + (seq_start ? 3 : 0)) * D);
      x1 = seq_start ? zero : *(const v4u*)(src + (size_t)(r0 - 2 + (seq_start ? 2 : 0)) * D);
      x2 = seq_start ? zero : *(const v4u*)(src + (size_t)(r0 - 1 + (seq_start ? 1 : 0)) * D); }
    v4u nxs[8];
#pragma unroll
    for (int i = 0; i < 8; ++i) nxs[i] = *(const v4u*)(src + (size_t)(r0 + i) * D);
    for (int rr = 0; rr < 64; rr += 8) {
        v4u xs[8];
#pragma unroll
        for (int i = 0; i < 8; ++i) xs[i] = nxs[i];
        if (rr + 8 < 64) {
#pragma unroll
            for (int i = 0; i < 8; ++i) nxs[i] = *(const v4u*)(src + (size_t)(r0 + rr + 8 + i) * D); }
#pragma unroll
        for (int i = 0; i < 8; ++i) {
            const v4u x3 = xs[i]; float y[8];
#pragma unroll
            for (int c = 0; c < 8; ++c) y[c] = bs[c];
#define MK_TAP(tap, X) do { y[0] += w[tap][0] * bflo(X.x); y[1] += w[tap][1] * bfhi(X.x); y[2] += w[tap][2] * bflo(X.y); y[3] += w[tap][3] * bfhi(X.y); \
                           y[4] += w[tap][4] * bflo(X.z); y[5] += w[tap][5] * bfhi(X.z); y[6] += w[tap][6] * bflo(X.w); y[7] += w[tap][7] * bfhi(X.w); } while (0)
            MK_TAP(0, x0); MK_TAP(1, x1); MK_TAP(2, x2); MK_TAP(3, x3);
#undef MK_TAP
#pragma unroll
            for (int c = 0; c < 8; ++c) y[c] = ml::silu_f(y[c]) * osc;
            v4u o; o.x = pk2(y[0], y[1]); o.y = pk2(y[2], y[3]); o.z = pk2(y[4], y[5]); o.w = pk2(y[6], y[7]);
            *(v4u*)(dst + (size_t)(r0 + rr + i) * D) = o;
            x0 = x1; x1 = x2; x2 = x3;
        }
    }
}

__device__ __forceinline__ void mlstm_norm_rows(Frame& F) {
    const int row0 = F.vcu * 128, lane = opq(F.lane);
    const bf16* MLO = F.PROJ() + 6 * (SEG / 2);
    f32x4 G[4];
#pragma unroll
    for (int j = 0; j < 4; ++j) G[j] = *(const f32x4*)(F.ml_norm_g() + 256 * j + 4 * lane);
    unsigned long long nh[4], no[4];
#define NR_LOAD(ROW) do { const size_t row_ = (ROW); const GAS unsigned long long* hp_ = (const GAS unsigned long long*)(F.YB() + row_ * D) + lane; const GAS unsigned long long* op_ = (const GAS unsigned long long*)(MLO + row_ * D) + lane; \
        _Pragma("unroll") for (int j = 0; j < 4; ++j) { nh[j] = hp_[64 * j]; no[j] = op_[64 * j]; } } while (0)
    NR_LOAD((size_t)row0 + 16 * F.wave);
    for (int r = 0; r < 16; ++r) {
        const size_t row = (size_t)row0 + 16 * F.wave + r;
        GAS unsigned long long* hp = (GAS unsigned long long*)(F.YB() + row * D) + lane;
        unsigned long long ch[4], co[4];
#pragma unroll
        for (int j = 0; j < 4; ++j) { ch[j] = nh[j]; co[j] = no[j]; }
        if (r < 15) NR_LOAD(row + 1);
#pragma unroll
        for (int j = 0; j < 4; ++j) { const unsigned long long hw = ch[j], ow = co[j];
            const float h0 = bflo((unsigned)hw), h1 = bfhi((unsigned)hw), h2 = bflo((unsigned)(hw >> 32)), h3 = bfhi((unsigned)(hw >> 32));
            const float ss = wave_sum((h0 * h0 + h1 * h1) + (h2 * h2 + h3 * h3)); const float rstd = 1.0f / sqrtf(ss * (1.0f / 256.0f) + EPS);
            const float o0 = bflo((unsigned)ow), o1 = bfhi((unsigned)ow), o2 = bflo((unsigned)(ow >> 32)), o3 = bfhi((unsigned)(ow >> 32));
            const float y0 = h0 * rstd * G[j].x / (1.0f + __expf(-o0)), y1 = h1 * rstd * G[j].y / (1.0f + __expf(-o1)), y2 = h2 * rstd * G[j].z / (1.0f + __expf(-o2)), y3 = h3 * rstd * G[j].w / (1.0f + __expf(-o3));
            hp[64 * j] = (unsigned long long)pk2(y0, y1) | ((unsigned long long)pk2(y2, y3) << 32); }
    }
#undef NR_LOAD
}

namespace at {
using ml::bf16x8; using ml::s16x4; using ml::f32x16; using ml::ioff; using ml::frag_row; using ml::lcp; using ml::lp_t;
typedef _Float16 f16x8 __attribute__((ext_vector_type(8)));
typedef _Float16 f16x2 __attribute__((ext_vector_type(2)));
typedef float f32x2 __attribute__((ext_vector_type(2)));
constexpr int O_KI = 0, O_VI = 8192, O_FLAG = 16384;
template <int PITCH, int XM> __device__ __forceinline__ bf16x8 frag_trp(lcp img, int ks, int col0, int lane) {
    const int h = lane >> 5, blk = (lane >> 4) & 1, q = (lane & 15) >> 2, p = lane & 3;
    const int r0 = 16 * ks + 4 * h + q, ch = (col0 >> 3) + 2 * blk + (p >> 1);
    typedef short v4i16_t __attribute__((ext_vector_type(4)));
    const s16x4 a = __builtin_bit_cast(s16x4, __builtin_amdgcn_ds_read_tr16_b64_v4i16((LAS v4i16_t*)(img + ioff<PITCH, XM>(r0, ch) + 8 * (p & 1))));
    const s16x4 b = __builtin_bit_cast(s16x4, __builtin_amdgcn_ds_read_tr16_b64_v4i16((LAS v4i16_t*)(img + ioff<PITCH, XM>(r0 + 8, ch) + 8 * (p & 1))));
    return (bf16x8){a[0], a[1], a[2], a[3], b[0], b[1], b[2], b[3]};
}
__device__ __forceinline__ unsigned pkh(float a, float b) { const f32x2 v = {a, b}; return __builtin_bit_cast(unsigned, __builtin_convertvector(v, f16x2)); }
__device__ __forceinline__ f16x8 h8(unsigned a, unsigned b, unsigned c, unsigned d) { const v4u v = {a, b, c, d}; return __builtin_bit_cast(f16x8, v); }
__device__ __forceinline__ bf16x8 b8(unsigned a, unsigned b, unsigned c, unsigned d) { const v4u v = {a, b, c, d}; return __builtin_bit_cast(bf16x8, v); }

__device__ __forceinline__ void attn_unit(Frame& F, int bh, int qb) {
    const int b = bh >> 4, hd = bh & 15, tid = opq(F.tid), lane = opq(F.lane), wave = F.wave, hi = lane >> 5, l31 = lane & 31, pr = wave >> 1, tp = tid & 127;
    const bf16* Q = F.PROJ(); const bf16* K = F.PROJ() + SEG / 2; const bf16* V = F.PROJ() + SEG;
    lp_t base = (lp_t)F.lds + pr * 16384;
    LAS volatile int* dflag = (LAS volatile int*)((lp_t)F.lds + 65536);
    const size_t rowb = (size_t)b * SEQ; const int q0 = qb * 256, tw0 = q0 + 32 * wave, t = tw0 + l31, kt0 = qb * 4 + pr;
    bf16x8 qr[4];
#pragma unroll
    for (int ks = 0; ks < 4; ++ks) qr[ks] = *(const bf16x8*)(Q + (rowb + t) * D + hd * 64 + 16 * ks + 8 * hi);
    unsigned uw[2][4];
#pragma unroll
    for (int sp = 0; sp < 2; ++sp)
#pragma unroll
        for (int jj = 0; jj < 4; ++jj) { const int j0 = 2 * jj, j1 = 2 * jj + 1;
            const int k0 = 16 * sp + 8 * (j0 >> 2) + 4 * hi + (j0 & 3), k1 = 16 * sp + 8 * (j1 >> 2) + 4 * hi + (j1 & 3);
            uw[sp][jj] = (k0 > l31 ? 0x3C00u : 0u) | (k1 > l31 ? 0x3C000000u : 0u); }
    const f16x8 U0 = h8(uw[0][0], uw[0][1], uw[0][2], uw[0][3]), U1 = h8(uw[1][0], uw[1][1], uw[1][2], uw[1][3]), ONES = h8(0x3C003C00u, 0x3C003C00u, 0x3C003C00u, 0x3C003C00u);
    f32x16 O0, O1;
#pragma unroll
    for (int r = 0; r < 16; ++r) { O0[r] = 0.f; O1[r] = 0.f; }
    float R = 0.f; bool wdone = false;
    v4u kreg[4], vreg[4];
#define AT_LOAD(KT) do { _Pragma("unroll") for (int j = 0; j < 4; ++j) { const size_t g = (rowb + (KT) * 64 + (tp >> 3) + 16 * j) * D + hd * 64 + (tp & 7) * 8; kreg[j] = *(const v4u*)(K + g); vreg[j] = *(const v4u*)(V + g); } } while (0)
    AT_LOAD(kt0);
    __syncthreads();
    if (tid < 8) dflag[tid] = 0;
    for (int it = 0; it <= qb * 4 + 3; ++it) {
        const int kt = kt0 - it;
        __syncthreads();
        { int nd = 0;
#pragma unroll
          for (int w = 0; w < 8; ++w) nd += dflag[w];
          if (nd == 8) break; }
        if (kt >= 0) {
#pragma unroll
            for (int j = 0; j < 4; ++j) { *(LAS v4u*)(base + O_KI + ioff<128, 7>((tp >> 3) + 16 * j, tp & 7)) = kreg[j]; *(LAS v4u*)(base + O_VI + ioff<128, 7>((tp >> 3) + 16 * j, tp & 7)) = vreg[j]; } }
        __syncthreads();
        if (kt > 0) AT_LOAD(kt - 1);
        if (kt < 0) { if (!wdone) { wdone = true; if (lane == 0) dflag[wave] = 1; } continue; }
        if (wdone) continue;
        int lo = lane; asm volatile("" : "+v"(lo));
        f32x16 p0, p1;
#pragma unroll
        for (int r = 0; r < 16; ++r) { p0[r] = 0.f; p1[r] = 0.f; }
#pragma unroll
        for (int ks = 0; ks < 4; ++ks) { p0 = __builtin_amdgcn_mfma_f32_32x32x16_bf16(frag_row<128, 7>(base + O_KI, 0, ks, lo), qr[ks], p0, 0, 0, 0);
                                         p1 = __builtin_amdgcn_mfma_f32_32x32x16_bf16(frag_row<128, 7>(base + O_KI, 32, ks, lo), qr[ks], p1, 0, 0, 0); }
        const bool diag = (it == 0);
        const int trel = t - 64 * kt;
        float lk00 = 0.f;
        unsigned lkw0[8], lkw1[8];
#pragma unroll
        for (int r = 0; r < 16; ++r) {
            const int key0 = ml::crow(r, hi);
            { const float z = p0[r], lb = fminf(z, 0.f) - __builtin_amdgcn_logf(1.0f + __builtin_amdgcn_exp2f(-fabsf(z))); float lk = lb - z; if (diag && !(key0 < trel)) lk = 0.f; p0[r] = lb; if (r == 0) lk00 = lk;
              if (r & 1) lkw0[r >> 1] = pkh(__builtin_bit_cast(float, lkw0[r >> 1]), lk); else lkw0[r >> 1] = __builtin_bit_cast(unsigned, lk); }
            { const float z = p1[r], lb = fminf(z, 0.f) - __builtin_amdgcn_logf(1.0f + __builtin_amdgcn_exp2f(-fabsf(z))); float lk = lb - z; if (diag && !(key0 + 32 < trel)) lk = 0.f; p1[r] = lb;
              if (r & 1) lkw1[r >> 1] = pkh(__builtin_bit_cast(float, lkw1[r >> 1]), lk); else lkw1[r >> 1] = __builtin_bit_cast(unsigned, lk); }
        }
        f32x16 bt1, bt0;
#pragma unroll
        for (int r = 0; r < 16; ++r) { bt1[r] = R; bt0[r] = R; }
        const f16x8 L10 = h8(lkw1[0], lkw1[1], lkw1[2], lkw1[3]), L11 = h8(lkw1[4], lkw1[5], lkw1[6], lkw1[7]), L00 = h8(lkw0[0], lkw0[1], lkw0[2], lkw0[3]), L01 = h8(lkw0[4], lkw0[5], lkw0[6], lkw0[7]);
        bt1 = __builtin_amdgcn_mfma_f32_32x32x16_f16(U0, L10, bt1, 0, 0, 0); bt1 = __builtin_amdgcn_mfma_f32_32x32x16_f16(U1, L11, bt1, 0, 0, 0);
        bt0 = __builtin_amdgcn_mfma_f32_32x32x16_f16(ONES, L10, bt0, 0, 0, 0); bt0 = __builtin_amdgcn_mfma_f32_32x32x16_f16(ONES, L11, bt0, 0, 0, 0);
        bt0 = __builtin_amdgcn_mfma_f32_32x32x16_f16(U0, L00, bt0, 0, 0, 0); bt0 = __builtin_amdgcn_mfma_f32_32x32x16_f16(U1, L01, bt0, 0, 0, 0);
        { const float v = bt0[0] + lk00;
          const auto rr = __builtin_amdgcn_permlane32_swap(__builtin_bit_cast(unsigned, v), __builtin_bit_cast(unsigned, v), false, false);
          R = __builtin_bit_cast(float, rr[0]); }
        unsigned aw0[8], aw1[8];
#pragma unroll
        for (int r = 0; r < 16; r += 2) {
            const int key0 = ml::crow(r, hi);
            float a00 = __builtin_amdgcn_exp2f(p0[r] + bt0[r]), a01 = __builtin_amdgcn_exp2f(p0[r + 1] + bt0[r + 1]), a10 = __builtin_amdgcn_exp2f(p1[r] + bt1[r]), a11 = __builtin_amdgcn_exp2f(p1[r + 1] + bt1[r + 1]);
            if (diag) { if (!(key0 < trel)) a00 = 0.f; if (!(key0 + 1 < trel)) a01 = 0.f; if (!(key0 + 32 < trel)) a10 = 0.f; if (!(key0 + 33 < trel)) a11 = 0.f; }
            aw0[r >> 1] = pk2(a00, a01); aw1[r >> 1] = pk2(a10, a11);
        }
        const bf16x8 A00 = b8(aw0[0], aw0[1], aw0[2], aw0[3]), A01 = b8(aw0[4], aw0[5], aw0[6], aw0[7]), A10 = b8(aw1[0], aw1[1], aw1[2], aw1[3]), A11 = b8(aw1[4], aw1[5], aw1[6], aw1[7]);
        O0 = __builtin_amdgcn_mfma_f32_32x32x16_bf16(A00, frag_trp<128, 7>(base + O_VI, 0, 0, lo), O0, 0, 0, 0);  O1 = __builtin_amdgcn_mfma_f32_32x32x16_bf16(A00, frag_trp<128, 7>(base + O_VI, 0, 32, lo), O1, 0, 0, 0);
        O0 = __builtin_amdgcn_mfma_f32_32x32x16_bf16(A01, frag_trp<128, 7>(base + O_VI, 1, 0, lo), O0, 0, 0, 0);  O1 = __builtin_amdgcn_mfma_f32_32x32x16_bf16(A01, frag_trp<128, 7>(base + O_VI, 1, 32, lo), O1, 0, 0, 0);
        O0 = __builtin_amdgcn_mfma_f32_32x32x16_bf16(A10, frag_trp<128, 7>(base + O_VI, 2, 0, lo), O0, 0, 0, 0);  O1 = __builtin_amdgcn_mfma_f32_32x32x16_bf16(A10, frag_trp<128, 7>(base + O_VI, 2, 32, lo), O1, 0, 0, 0);
        O0 = __builtin_amdgcn_mfma_f32_32x32x16_bf16(A11, frag_trp<128, 7>(base + O_VI, 3, 0, lo), O0, 0, 0, 0);  O1 = __builtin_amdgcn_mfma_f32_32x32x16_bf16(A11, frag_trp<128, 7>(base + O_VI, 3, 32, lo), O1, 0, 0, 0);
        if (__all(R < ATT_RTHR)) { wdone = true; if (lane == 0) dflag[wave] = 1; }
    }
#undef AT_LOAD
    __syncthreads();
    bf16* dst = F.YA() + (rowb + tw0) * D + hd * 64 + l31;
#pragma unroll
    for (int r = 0; r < 16; ++r) { const int q = ml::crow(r, hi); dst[(size_t)q * D] = (bf16)pk2(O0[r], 0.f); dst[(size_t)q * D + 32] = (bf16)pk2(O1[r], 0.f); }
}
}

__device__ __forceinline__ void p5a_route(Frame& F) {
    const int row0 = F.vcu * 128, b = row0 / SEQ, lane = opq(F.lane), tid = opq(F.tid);
    LAS float* wr = (LAS float*)F.lds;
    LAS int* le = (LAS int*)(F.lds + 131584); LAS int* lp = le + 512;
    LAS int* lcnt = (LAS int*)(F.LC + LC_LCNT); LAS int* gbase = (LAS int*)(F.LC + LC_GBASE);
    for (int idx = tid; idx < 32768; idx += 512) wr[(idx & 31) * 1028 + (idx >> 5)] = F.router_w()[idx];
    if (tid < 32) lcnt[tid] = 0;
    f32x4 Av[4], Bv[4];
#pragma unroll
    for (int j = 0; j < 4; ++j) { const int col = 4 * lane + 256 * j; const float* mb = F.mod() + (size_t)b * NMOD;
        const f32x4 g = *(const f32x4*)(F.norm2_g() + col); Av[j] = g * (*(const f32x4*)(mb + 4 * D + col) + 1.0f); Bv[j] = *(const f32x4*)(mb + 3 * D + col); }
    float rb[32];
#pragma unroll
    for (int e = 0; e < 32; ++e) rb[e] = F.router_b()[e];
    __syncthreads();
    f32x4 nx[4];
    { const GAS f32x4* xr = (const GAS f32x4*)(F.out() + (size_t)(row0 + 16 * F.wave) * D) + lane;
#pragma unroll
      for (int j = 0; j < 4; ++j) nx[j] = xr[64 * j]; }
    for (int r = 0; r < 16; ++r) {
        const int rl = 16 * F.wave + r, row = row0 + rl;
        f32x4 v[4]; float ss = 0.f;
#pragma unroll
        for (int j = 0; j < 4; ++j) { v[j] = nx[j]; ss += (v[j].x * v[j].x + v[j].y * v[j].y) + (v[j].z * v[j].z + v[j].w * v[j].w); }
        if (r < 15) { const GAS f32x4* xr = (const GAS f32x4*)(F.out() + (size_t)(row + 1) * D) + lane;
#pragma unroll
            for (int j = 0; j < 4; ++j) nx[j] = xr[64 * j]; }
        const float rstd = 1.0f / sqrtf(wave_sum(ss) * (1.0f / D) + EPS);
        { GAS unsigned* o4 = (GAS unsigned*)((unsigned char*)F.H2() + (size_t)row * D) + lane;
#pragma unroll
          for (int j = 0; j < 4; ++j) { v[j] = v[j] * rstd * Av[j] + Bv[j]; o4[64 * j] = pg8::pk4_fp8(v[j].x, v[j].y, v[j].z, v[j].w); } }
        float p[32];
#pragma unroll
        for (int e = 0; e < 32; ++e) { float s = 0.f;
#pragma unroll
            for (int j = 0; j < 4; ++j) { const f32x4 w = *(const LAS f32x4*)(wr + e * 1028 + 4 * lane + 256 * j); s += (v[j].x * w.x + v[j].y * w.y) + (v[j].z * w.z + v[j].w * w.w); }
            p[e] = s; }
#pragma unroll
        for (int i = 0; i < 16; ++i) { const bool up = (lane & 32) != 0; const float send = up ? p[i] : p[i + 16], keep = up ? p[i + 16] : p[i]; p[i] = keep + __shfl_xor(send, 32); }
#pragma unroll
        for (int i = 0; i < 8; ++i) { const bool up = (lane & 16) != 0; const float send = up ? p[i] : p[i + 8], keep = up ? p[i + 8] : p[i]; p[i] = keep + __shfl_xor(send, 16); }
#pragma unroll
        for (int i = 0; i < 4; ++i) { const bool up = (lane & 8) != 0; const float send = up ? p[i] : p[i + 4], keep = up ? p[i + 4] : p[i]; p[i] = keep + __shfl_xor(send, 8); }
#pragma unroll
        for (int i = 0; i < 2; ++i) { const bool up = (lane & 4) != 0; const float send = up ? p[i] : p[i + 2], keep = up ? p[i + 2] : p[i]; p[i] = keep + __shfl_xor(send, 4); }
        { const bool up = (lane & 2) != 0; const float send = up ? p[0] : p[1], keep = up ? p[1] : p[0]; p[0] = keep + __shfl_xor(send, 2); }
        p[0] += __shfl_xor(p[0], 1);
        { LAS float* lg = (LAS float*)(F.lds + 135680) + F.wave * 32;
          if ((lane & 1) == 0) lg[lane >> 1] = p[0];
#pragma unroll
          for (int q = 0; q < 8; ++q) { const f32x4 t4 = *(const LAS f32x4*)(lg + 4 * q); p[4 * q] = t4.x + rb[4 * q]; p[4 * q + 1] = t4.y + rb[4 * q + 1]; p[4 * q + 2] = t4.z + rb[4 * q + 2]; p[4 * q + 3] = t4.w + rb[4 * q + 3]; } }
        int sel[4]; float sv[4]; unsigned used = 0u;
#pragma unroll
        for (int k = 0; k < 4; ++k) { float best = -3.0e38f; int bi = 0;
#pragma unroll
            for (int e = 0; e < 32; ++e) { const bool cnd = (((used >> e) & 1u) == 0u) && (p[e] > best); best = cnd ? p[e] : best; bi = cnd ? e : bi; }
            sel[k] = bi; sv[k] = best; used |= 1u << bi; }
        const float e1 = __expf(sv[1] - sv[0]), e2 = __expf(sv[2] - sv[0]), e3 = __expf(sv[3] - sv[0]), inv = 1.0f / (1.0f + e1 + e2 + e3);
        if (lane < 4) { const int ek = lane == 0 ? sel[0] : lane == 1 ? sel[1] : lane == 2 ? sel[2] : sel[3];
            const float wk = (lane == 0 ? 1.0f : lane == 1 ? e1 : lane == 2 ? e2 : e3) * inv;
            const int pos = __hip_atomic_fetch_add(lcnt + ek, 1, __ATOMIC_RELAXED, __HIP_MEMORY_SCOPE_WORKGROUP);
            le[rl * 4 + lane] = ek; lp[rl * 4 + lane] = pos; F.tokw()[(size_t)row * 4 + lane] = wk; }
        if (lane == 0) F.rstd2()[row] = rstd;
    }
    __syncthreads();
    if (tid < 32) gbase[tid] = (int)__hip_atomic_fetch_add(F.ctl + CW_ECNT + 64 * tid, (unsigned)lcnt[tid], __ATOMIC_RELAXED, __HIP_MEMORY_SCOPE_AGENT);
    __syncthreads();
    { const int ek = le[tid]; F.toke()[(size_t)row0 * 4 + tid] = ek; F.tokp()[(size_t)row0 * 4 + tid] = lp[tid] + gbase[ek]; }
}

__device__ __forceinline__ void p5b_tables(Frame& F) {
    const int row0 = F.vcu * 128, tid = opq(F.tid);
    LAS int* ts = (LAS int*)(F.LC + LC_TS); LAS int* ps = (LAS int*)(F.LC + LC_PS); LAS int* cn = (LAS int*)(F.LC + LC_CNT);
    if (tid < 32) cn[tid] = (int)__hip_atomic_load(F.ctl + CW_ECNT + 64 * tid, RLX_AGENT);
    __syncthreads();
    if (tid == 0) { int run = 0, trun = 0; for (int e = 0; e < 32; ++e) { ps[e] = run; ts[e] = trun; const int nt = (cn[e] + 255) >> 8; run += nt * 256; trun += nt; } ts[32] = trun; }
    __syncthreads();
    { const size_t idx = (size_t)row0 * 4 + tid; const int ek = F.toke()[idx], dst = ps[ek] + F.tokp()[idx]; F.tokrow()[idx] = dst; F.row2tok()[dst] = row0 + (tid >> 2); }
    if (F.vcu < 32) { const int e = F.vcu, start = ps[e] + cn[e], end = ps[e] + (((cn[e] + 255) >> 8) << 8); for (int r = start + tid; r < end; r += 512) F.row2tok()[r] = 0; }
}

__device__ __forceinline__ void p8_combine(Frame& F, bool poison) {
    const int row0 = F.vcu * 128, b = row0 / SEQ, lane = opq(F.lane);
    f32x4 G2[4], FG[4];
#pragma unroll
    for (int j = 0; j < 4; ++j) { const int col = 4 * lane + 256 * j; G2[j] = *(const f32x4*)(F.mod() + (size_t)b * NMOD + 5 * D + col); FG[j] = *(const f32x4*)(F.final_g() + col); }
    f32x4 nx[4]; unsigned long long ng[4][4]; float nw[4];
#define P8_LOAD(ROW) do { const size_t row_ = (ROW); const GAS f32x4* xr_ = (const GAS f32x4*)(F.out() + row_ * D) + lane; \
        _Pragma("unroll") for (int j = 0; j < 4; ++j) nx[j] = xr_[64 * j]; \
        _Pragma("unroll") for (int k = 0; k < 4; ++k) { const int src_ = F.tokrow()[row_ * 4 + k]; nw[k] = F.tokw()[row_ * 4 + k]; \
            const GAS unsigned long long* s8_ = (const GAS unsigned long long*)(F.OUTR() + (size_t)src_ * D) + lane; \
            _Pragma("unroll") for (int j = 0; j < 4; ++j) ng[k][j] = s8_[64 * j]; } } while (0)
    P8_LOAD((size_t)row0 + 16 * F.wave);
    for (int r = 0; r < 16; ++r) {
        const int row = row0 + 16 * F.wave + r;
        GAS f32x4* xr = (GAS f32x4*)(F.out() + (size_t)row * D) + lane;
        f32x4 y[4], xv[4];
#pragma unroll
        for (int j = 0; j < 4; ++j) { y[j] = (f32x4){0.f, 0.f, 0.f, 0.f}; xv[j] = nx[j]; }
#pragma unroll
        for (int k = 0; k < 4; ++k) { const float wk = nw[k];
#pragma unroll
            for (int j = 0; j < 4; ++j) { const unsigned long long w = ng[k][j]; y[j].x += wk * bflo((unsigned)w); y[j].y += wk * bfhi((unsigned)w); y[j].z += wk * bflo((unsigned)(w >> 32)); y[j].w += wk * bfhi((unsigned)(w >> 32)); } }
        if (r < 15) P8_LOAD((size_t)row + 1);
        f32x4 v[4]; float ss = 0.f;
#pragma unroll
        for (int j = 0; j < 4; ++j) { v[j] = xv[j] + G2[j] * y[j]; ss += (v[j].x * v[j].x + v[j].y * v[j].y) + (v[j].z * v[j].z + v[j].w * v[j].w); }
        const float rstd = 1.0f / sqrtf(wave_sum(ss) * (1.0f / D) + EPS);
        const float qn = __builtin_nanf("");
#pragma unroll
        for (int j = 0; j < 4; ++j) { f32x4 o = v[j] * rstd * FG[j]; if (poison) o = (f32x4){qn, qn, qn, qn}; xr[64 * j] = o; }
    }
#undef P8_LOAD
}

#ifndef MK_REP_G2
#define MK_REP_G2 1
#endif
#ifndef MK_REP_G4A
#define MK_REP_G4A 1
#endif
#ifndef MK_REP_G4B
#define MK_REP_G4B 1
#endif
#ifndef MK_REP_G4C
#define MK_REP_G4C 1
#endif
#ifndef MK_REP_G6
#define MK_REP_G6 1
#endif
#ifndef MK_REP_G7
#define MK_REP_G7 1
#endif
#ifndef MK_REP_P0
#define MK_REP_P0 1
#endif
#ifndef MK_REP_P3
#define MK_REP_P3 1
#endif
struct Args { const float* in[22]; float* out; unsigned char* ws; };
__global__ void __launch_bounds__(NWAVES * 64, 2) mk_fwd(Args args) {
    extern __shared__ __attribute__((aligned(16))) unsigned char lds[];
    Frame F;
    F.lds = (LAS unsigned char*)lds; F.LC = (volatile LAS unsigned*)(F.lds + LDSCTL_OFF);
    F.tid = threadIdx.x; F.lane = F.tid & 63; F.wave = __builtin_amdgcn_readfirstlane(F.tid >> 6);
    F.G = gridDim.x; { const int bx = blockIdx.x; F.vcu = (F.G % 8 == 0) ? (bx % 8) * (F.G / 8) + bx / 8 : bx; }
    F.ws = (unsigned char*)(GAS unsigned char*)karg(23);
    F.ctl = (gu32*)(F.ws + WS_CTL);
    for (int u = F.tid; u < (LDS_BYTES - LDSCTL_OFF) / 4; u += NWAVES * 64) ((LAS unsigned*)(F.lds + LDSCTL_OFF))[u] = 0u;
    __syncthreads();
    XcdBarrier bar = xcd_barrier_post((unsigned*)(F.ctl + CW_BAR), F.LC + LC_BAR);
#define GRID_BAR() xcd_barrier(bar)
    const int G = F.G, cid = (int)blockIdx.x;

    for (int rep_ = 0; rep_ < MK_REP_P0; ++rep_) p0_prologue(F);
    GRID_BAR();
    p1_rows(F);
    GRID_BAR();
    { pg8::Gemm g{F.H1(), F.WIN_T(), T, NPROJ, D / 2}; pg8::StaticOrder S; S.init(T, NPROJ, G, cid);
      pg8::EpiBf16<0> E{F.PROJ(), D, nullptr, D, SEG / 2, QSCALE, 1.0f / W8SCALE};
      for (int rep_ = 0; rep_ < MK_REP_G2; ++rep_) pg8::gemm_phase<pg8::EpiBf16<0>, pg8::StaticOrder, true, true, false, true>(F.lds, g, S, E); }
    GRID_BAR();
    for (int job = F.vcu * NWAVES + F.wave; job < BATCH * 4 * (SEQ / 64); job += G * NWAVES) mlstm_gates(F, job);
    mlstm_conv_rows(F);
    GRID_BAR();
#if defined(MK_NAIVE_MLSTM)
    for (int it = F.vcu; it < 1024; it += G) attn_naive_item(F, it & 255, it >> 8);
    __syncthreads();
    for (int it = F.vcu; it < 64; it += G) mlstm_naive_item(F, it);
#else
    for (int rep_ = 0; rep_ < MK_REP_P3; ++rep_) {
    for (int it = F.vcu; it < 256; it += G) ml::mlstm_unit(F, it);
    __syncthreads();
#if defined(MK_NAIVE_ATTN)
    for (int it = F.vcu; it < 1024; it += G) attn_naive_item(F, it & 255, it >> 8);
#else
    for (int it = F.vcu; it < 2048; it += G) at::attn_unit(F, it & 255, it >> 8);
#endif
    }
#endif
    GRID_BAR();
    { pg8::Gemm g{F.YA(), F.WA_T(), T, D, D}; pg8::StaticOrder S; S.init(T, D, G, cid);
      pg8::EpiGate<false> E{F.PROJ() + 7 * (SEG / 2), nullptr, F.M1()};
      for (int rep_ = 0; rep_ < MK_REP_G4A; ++rep_) pg8::gemm_phase<pg8::EpiGate<false>, pg8::StaticOrder, true, true>(F.lds, g, S, E); }
#if defined(MK_NAIVE_MLSTM)
    VM_WAIT(); __syncthreads();
#else
    __syncthreads();
    mlstm_norm_rows(F);
    GRID_BAR();
#endif
    { pg8::Gemm g{F.YB(), F.WB_T(), T, D, D}; pg8::StaticOrder S; S.init(T, D, G, cid);
      pg8::EpiGate<true> E{F.PROJ() + 8 * (SEG / 2), F.M1(), F.MERGED()};
      for (int rep_ = 0; rep_ < MK_REP_G4B; ++rep_) pg8::gemm_phase<pg8::EpiGate<true>, pg8::StaticOrder, true, true>(F.lds, g, S, E); }
    GRID_BAR();
    { pg8::Gemm g{F.MERGED(), F.WOUT_T(), T, D, D}; pg8::StaticOrder S; S.init(T, D, G, cid);
      pg8::EpiResid E{F.x(), F.mod() + 2 * D, F.out(), SEQ, NMOD};
      for (int rep_ = 0; rep_ < MK_REP_G4C; ++rep_) pg8::gemm_phase<pg8::EpiResid, pg8::StaticOrder, true, true>(F.lds, g, S, E); }
    GRID_BAR();
    p5a_route(F);
    GRID_BAR();
    p5b_tables(F);
    GRID_BAR();
    { pg8::Gemm g{F.H2(), F.W1_T(), T, NE * 2048, D / 2}; pg8::GroupedOrder S{(const LAS int*)(F.LC + LC_TS), 8, G, cid, F.row2tok()};
      pg8::EpiSwiglu<true> E{F.b1(), F.ACT(), 1.0f / W8SCALE};
      for (int rep_ = 0; rep_ < MK_REP_G6; ++rep_) pg8::gemm_phase<pg8::EpiSwiglu<true>, pg8::GroupedOrder, true, true, true, true>(F.lds, g, S, E); }
    GRID_BAR();
    { pg8::Gemm g{F.ACT(), F.W2_T(), XS_ROWS, NE * 1024, D / 2}; pg8::GroupedOrder S{(const LAS int*)(F.LC + LC_TS), 4, G, cid, nullptr};
      pg8::EpiOutS E{F.OUTR(), F.b2(), 1.0f / W8SCALE};
      for (int rep_ = 0; rep_ < MK_REP_G7; ++rep_) pg8::gemm_phase<pg8::EpiOutS, pg8::GroupedOrder, true, true, false, true>(F.lds, g, S, E); }
    GRID_BAR();
    { const bool poison = __hip_atomic_load(F.ctl + CW_BAR + XB_TMO, RLX_AGENT) != 0u;
      p8_combine(F, poison); }
}

extern "C" void kernel_launch(void* const* d_in, const int* in_sizes, int n_in, void* d_out, int out_size, void* d_ws, size_t ws_size, hipStream_t stream) {
    static int grid = 0;
    if (grid == 0) {
        if (n_in != 22 || in_sizes[0] != T * D || out_size != T * D || ws_size < WS_END) { fprintf(stderr, "kernel_launch: unexpected shapes (n_in %d, in0 %d, out %d, ws %zu)\n", n_in, n_in > 0 ? in_sizes[0] : -1, out_size, ws_size); grid = -1; return; }
        int dev = 0, cus = 0, per_cu = 0;
        if (hipGetDevice(&dev) != hipSuccess || hipDeviceGetAttribute(&cus, hipDeviceAttributeMultiprocessorCount, dev) != hipSuccess) { grid = -1; return; }
        if (hipFuncSetAttribute((const void*)mk_fwd, hipFuncAttributeMaxDynamicSharedMemorySize, LDS_BYTES) != hipSuccess) { fprintf(stderr, "kernel_launch: hipFuncSetAttribute failed\n"); grid = -1; return; }
        if (hipOccupancyMaxActiveBlocksPerMultiprocessor(&per_cu, (const void*)mk_fwd, NWAVES * 64, LDS_BYTES) != hipSuccess || per_cu < 1) { fprintf(stderr, "kernel_launch: occupancy query says %d blocks per CU\n", per_cu); }
        (void)hipGetLastError();
        if (cus < 256) { fprintf(stderr, "kernel_launch: built for a 256-CU device, found %d CUs\n", cus); grid = -1; return; }
        grid = 256;
    }
    if (grid < 0) return;
    if (hipMemsetAsync((char*)d_ws + WS_CTL, 0, CTL_ZERO_BYTES, stream) != hipSuccess) return;
    Args a{};
    for (int i = 0; i < 22; ++i) a.in[i] = (const float*)d_in[i];
    a.out = (float*)d_out; a.ws = (unsigned char*)d_ws;
    hipLaunchKernelGGL(mk_fwd, dim3(grid), dim3(NWAVES * 64), LDS_BYTES, stream, a);
}
```

```cpp
#include <hip/hip_runtime.h>
#include <cstdio>
#include <cstdint>
namespace pg8 {
#define PG8_LAS __attribute__((address_space(3)))
typedef unsigned short bf16_t;
typedef short bf16x8 __attribute__((ext_vector_type(8)));
typedef float f32x4 __attribute__((ext_vector_type(4)));
typedef unsigned u32x4 __attribute__((ext_vector_type(4)));
typedef int i32x4_ __attribute__((ext_vector_type(4))); typedef int i32x8_ __attribute__((ext_vector_type(8)));
constexpr int BM = 256, BK = 64, HALF = 128, HTB = HALF * BK * 2  , STAGE_BYTES = 8 * HTB, NXCD = 8, WGM = 8;

__host__ __device__ __forceinline__ int lds_byte(int r, int c) { const int st = (r >> 4) * 2 + (c >> 5), rr = r & 15, cc = c & 31, ob = rr * 64 + cc * 2; return st * 1024 + (ob ^ (((ob >> 9) & 1) << 5)); }
__host__ __device__ __forceinline__ void stage_rc(int b, int& R, int& C) { const int st = b / 1024, sb = b % 1024, swz = sb ^ (((sb >> 9) & 1) << 5); R = (st >> 1) * 16 + swz / 64; C = (st & 1) * 32 + (swz % 64) / 2; }
__host__ __device__ __forceinline__ int perm32(int rho) { const int n = rho >> 4, i = rho & 15; return 8 * (i >> 2) + 4 * n + (i & 3); }

struct Unit { int pm, pn; };
struct Gemm { const bf16_t* A; const bf16_t* Bt; int M, N, K; };

struct StaticOrder {
    int nM, nN, nwg, G, c;
    __host__ __device__ void init(int M, int N, int G_, int c_) { nM = M / BM; nN = N / BM; nwg = nM * nN; G = G_; c = c_; }
    __host__ __device__ bool next(int i, Unit& u) const {
        const long L = (long)i * G + c; if (L >= nwg) return false;
        int wgid = (int)L; { const int q = nwg / NXCD, r = nwg % NXCD, xcd = wgid % NXCD, off = wgid / NXCD; wgid = (xcd < r ? xcd * (q + 1) : r * (q + 1) + (xcd - r) * q) + off; }
        const int nig = WGM * nN, gid = wgid / nig, fm = gid * WGM, gsz = (nM - fm) < WGM ? (nM - fm) : WGM;
        u.pm = fm + ((wgid % nig) % gsz); u.pn = (wgid % nig) / gsz; return true;
    }
    __device__ __forceinline__ void a_ready(const Unit&) const {}
    __device__ __forceinline__ void done(const Unit&) const {}
};

__device__ __forceinline__ unsigned cvt_pk_bf16(float lo, float hi) { unsigned r; asm volatile("v_cvt_pk_bf16_f32 %0, %1, %2" : "=v"(r) : "v"(lo), "v"(hi)); return r; }
typedef float f32x2 __attribute__((ext_vector_type(2)));
__device__ __forceinline__ f32x2 gelu_pk(f32x2 v) {
    const f32x2 av = __builtin_elementwise_abs(v), d = av * 0.2316418882f + 1.0f;
    f32x2 t; t.x = __builtin_amdgcn_rcpf(d.x); t.y = __builtin_amdgcn_rcpf(d.y);
    f32x2 q = t * 0.5307027145f + (-0.7265760135f); q = q * t + 0.7107068705f; q = q * t + (-0.142248368f); q = q * t + 0.127414796f; q = q * t;
    const f32x2 s = (v * v) * (-0.72134752044f);
    f32x2 e; e.x = __builtin_amdgcn_exp2f(s.x); e.y = __builtin_amdgcn_exp2f(s.y);
    const f32x2 m = v * (q * e), r = v - m;
    f32x2 o; o.x = v.x < 0.f ? m.x : r.x; o.y = v.y < 0.f ? m.y : r.y; return o;
}

template <int ACT  > struct EpiBf16 {
    static constexpr bool PERM = true, AFTER_DRAIN = false; static_assert(ACT == 0 || ACT == 1, "EpiBf16: ACT is 0 (none) or 1 (gelu_pk)");
    bf16_t* O; int ldc; const float* bias; int split_cols; size_t split_stride; float scale0; float ascale;
    __device__ __forceinline__ void operator()(const f32x4 (&acc)[2][2][4][2], const Unit& u, int wr, int wc, int fr, int fq) const {
        const int row0 = u.pm * BM + wr * 64 + fr; int colt = u.pn * BM; bf16_t* base = O;
        float sc = ascale; if (split_cols) { const int t = colt / split_cols; base += (size_t)t * split_stride; colt -= t * split_cols; if (t == 0) sc = scale0 * ascale; }
        const int col0 = colt + wc * 32 + 8 * fq, bcol0 = u.pn * BM + wc * 32 + 8 * fq;
        f32x4 bv[2][2];
#pragma unroll
        for (int bj = 0; bj < 2; ++bj)
#pragma unroll
            for (int n = 0; n < 2; ++n) bv[bj][n] = bias ? *(const f32x4*)(bias + bcol0 + bj * HALF + 4 * n) : (f32x4){0.f, 0.f, 0.f, 0.f};
#pragma unroll
        for (int ai = 0; ai < 2; ++ai)
#pragma unroll
            for (int m = 0; m < 4; ++m) { bf16_t* rowp = base + (size_t)(row0 + ai * HALF + m * 16) * ldc + col0;
#pragma unroll
                for (int bj = 0; bj < 2; ++bj) { f32x4 v0 = acc[ai][bj][m][0] + bv[bj][0], v1 = acc[ai][bj][m][1] + bv[bj][1];
                    if (ACT == 1) { f32x2 a = gelu_pk((f32x2){v0[0], v0[1]}), b = gelu_pk((f32x2){v0[2], v0[3]}), c = gelu_pk((f32x2){v1[0], v1[1]}), d = gelu_pk((f32x2){v1[2], v1[3]});
                        v0 = (f32x4){a.x, a.y, b.x, b.y}; v1 = (f32x4){c.x, c.y, d.x, d.y}; }
                    v0 = v0 * sc; v1 = v1 * sc; u32x4 w; w.x = cvt_pk_bf16(v0[0], v0[1]); w.y = cvt_pk_bf16(v0[2], v0[3]); w.z = cvt_pk_bf16(v1[0], v1[1]); w.w = cvt_pk_bf16(v1[2], v1[3]);
                    __builtin_nontemporal_store(w, (u32x4*)(rowp + bj * HALF)); } }
    }
};
template <class Epi, class Sched, bool ALIGN_EPI = false, bool SP2 = false, bool GATHER = false, bool FP8 = false>
__device__ __forceinline__ void gemm_phase(PG8_LAS unsigned char* lds, const Gemm g, const Sched& S, const Epi& E) {
    int tid_ = threadIdx.x; asm volatile("" : "+v"(tid_));
    const int tid = tid_, wid = __builtin_amdgcn_readfirstlane(tid >> 6), lane = tid & 63, wr = wid >> 2, wc = wid & 3, fr = lane & 15, fq = lane >> 4;
    const int K = g.K, nt = K / BK;
    unsigned voffA[2], voffB[2], vA0[2], vA1[2], vN0[2], vN1[2]; int Rr_[2], Cc_[2];
#pragma unroll
    for (int i = 0; i < 2; ++i) { int R, C; stage_rc(tid * 16 + i * 8192, R, C); const int Rb = Epi::PERM ? ((R & ~31) + perm32(R & 31)) : R;
        voffA[i] = (unsigned)(R * K + C) * 2u; voffB[i] = (unsigned)(Rb * K + C) * 2u; Rr_[i] = R; Cc_[i] = C; }
    const size_t kstep = (size_t)(BK * 2);
    const size_t hstep = (size_t)HALF * K * 2;
    const size_t tstep = 2 * hstep;
#pragma unroll
    for (int i = 0; i < 2; ++i) { vA0[i] = voffA[i]; vA1[i] = voffA[i] + (unsigned)hstep; vN0[i] = vA0[i]; vN1[i] = vA1[i]; }
#define PG8_GLOAD(u, v0, v1) do { _Pragma("unroll") for (int _i = 0; _i < 2; ++_i) { const int _t0 = S.rowtok[(u).pm * BM + Rr_[_i]], _t1 = S.rowtok[(u).pm * BM + HALF + Rr_[_i]]; \
        (v0)[_i] = (unsigned)_t0 * (unsigned)(K * 2) + (unsigned)(Cc_[_i] * 2); (v1)[_i] = (unsigned)_t1 * (unsigned)(K * 2) + (unsigned)(Cc_[_i] * 2); } } while (0)
    const unsigned ldsw = (unsigned)wid * 1024u;
    const int aoff = lds_byte(wr * 64 + fr, fq * 8), boff = lds_byte(wc * 32 + fr, fq * 8);
#define PG8_SA(b, h) (((b) * 2 + (h)) * HTB)
#define PG8_SB(b, h) ((4 + (b) * 2 + (h)) * HTB)
#define PG8_STAGE(bufoff, gbase, voff) do { _Pragma("unroll") for (int _i = 0; _i < 2; ++_i) \
        __builtin_amdgcn_global_load_lds((const unsigned*)((const char*)(gbase) + (voff)[_i]), (PG8_LAS unsigned*)(lds + (bufoff) + ldsw + _i * 8192), 16, 0, 0); } while (0)
#define PG8_LDA(dst, b, h) do { _Pragma("unroll") for (int m = 0; m < 4; ++m) _Pragma("unroll") for (int k = 0; k < 2; ++k) dst[m][k] = *(const PG8_LAS bf16x8*)(lds + PG8_SA(b, h) + aoff + m * 2048 + k * 1024); } while (0)
#define PG8_LDB(dst, b, h) do { _Pragma("unroll") for (int n = 0; n < 2; ++n) _Pragma("unroll") for (int k = 0; k < 2; ++k) dst[n][k] = *(const PG8_LAS bf16x8*)(lds + PG8_SB(b, h) + boff + n * 2048 + k * 1024); } while (0)
#define PG8_MMA(ai, bj, At, Bt) do { __builtin_amdgcn_s_setprio(1); _Pragma("unroll") for (int m = 0; m < 4; ++m) _Pragma("unroll") for (int n = 0; n < 2; ++n) _Pragma("unroll") for (int k = 0; k < 2; ++k) \
        acc[ai][bj][m][n] = __builtin_amdgcn_mfma_f32_16x16x32_bf16(Bt[n][k], At[m][k], acc[ai][bj][m][n], 0, 0, 0); __builtin_amdgcn_s_setprio(0); } while (0)
#define PG8_CAT8(x0, x1) __builtin_shufflevector(__builtin_bit_cast(i32x4_, x0), __builtin_bit_cast(i32x4_, x1), 0, 1, 2, 3, 4, 5, 6, 7)
#define PG8_MFMA8(ACC, B8, A8) asm volatile("s_nop 1\n\tv_mfma_scale_f32_16x16x128_f8f6f4 %0, %1, %2, %0, %3, %3 op_sel_hi:[0,0,0]" : "+v"(ACC) : "v"(B8), "v"(A8), "v"(sc8_))
#define PG8_MMA8(ai, bj, At, Bt) do { i32x8_ a8_[4], b8_[2]; _Pragma("unroll") for (int m = 0; m < 4; ++m) a8_[m] = PG8_CAT8(At[m][0], At[m][1]); _Pragma("unroll") for (int n = 0; n < 2; ++n) b8_[n] = PG8_CAT8(Bt[n][0], Bt[n][1]); \
        __builtin_amdgcn_s_setprio(1); _Pragma("unroll") for (int m = 0; m < 4; ++m) _Pragma("unroll") for (int n = 0; n < 2; ++n) PG8_MFMA8(acc[ai][bj][m][n], b8_[n], a8_[m]); __builtin_amdgcn_s_setprio(0); } while (0)
#define PG8_MM(ai, bj, At, Bt) do { if constexpr (FP8) PG8_MMA8(ai, bj, At, Bt); else PG8_MMA(ai, bj, At, Bt); } while (0)
#define PG8_WAIT_V(n) asm volatile("s_waitcnt vmcnt(" #n ")" ::: "memory")
#define PG8_WAIT_L(n) asm volatile("s_waitcnt lgkmcnt(" #n ")" ::: "memory")
#define PG8_BAR __builtin_amdgcn_s_barrier()
#define PG8_SCHED __builtin_amdgcn_sched_barrier(0)
    const int sc8_ = 0x7F7F7F7F;
    Unit cur, nxt; int ui = 0;
    if (!S.next(0, cur)) return;
    f32x4 acc[2][2][4][2];
#pragma unroll
    for (int a = 0; a < 2; ++a)
#pragma unroll
        for (int b = 0; b < 2; ++b)
#pragma unroll
            for (int m = 0; m < 4; ++m)
#pragma unroll
                for (int n = 0; n < 2; ++n) acc[a][b][m][n] = (f32x4){0.f, 0.f, 0.f, 0.f};
    bf16x8 At[4][2], B0[2][2], B1[2][2];
    if constexpr (GATHER) PG8_GLOAD(cur, vA0, vA1);
    const char* cA = GATHER ? (const char*)g.A : (const char*)g.A + (size_t)cur.pm * tstep; const char* cB = (const char*)g.Bt + (size_t)cur.pn * tstep;
    S.a_ready(cur);
    if constexpr (SP2) {
        PG8_STAGE(PG8_SB(0, 0), cB, voffB); PG8_STAGE(PG8_SB(0, 1), cB + hstep, voffB); PG8_STAGE(PG8_SA(0, 0), cA, vA0); PG8_STAGE(PG8_SA(0, 1), cA, vA1);
        if (wr == 1) PG8_BAR;
        PG8_WAIT_V(2); PG8_BAR;
        PG8_STAGE(PG8_SB(1, 0), cB + kstep, voffB); PG8_STAGE(PG8_SA(1, 0), cA + kstep, vA0); PG8_STAGE(PG8_SB(1, 1), cB + hstep + kstep, voffB);
        PG8_WAIT_V(6); PG8_BAR;
    } else {
        PG8_STAGE(PG8_SB(0, 0), cB, voffB); PG8_STAGE(PG8_SA(0, 0), cA, vA0); PG8_STAGE(PG8_SB(0, 1), cB + hstep, voffB); PG8_STAGE(PG8_SA(0, 1), cA, vA1);
        if (wr == 1) PG8_BAR;
        PG8_WAIT_V(4); PG8_BAR;
        PG8_STAGE(PG8_SB(1, 0), cB + kstep, voffB); PG8_STAGE(PG8_SA(1, 0), cA + kstep, vA0); PG8_STAGE(PG8_SB(1, 1), cB + hstep + kstep, voffB);
        PG8_WAIT_V(6); PG8_BAR;
    }
    for (;;) {
        const bool has_next = S.next(ui + 1, nxt);
        if constexpr (GATHER) { if (has_next) PG8_GLOAD(nxt, vN0, vN1); else { _Pragma("unroll") for (int i = 0; i < 2; ++i) { vN0[i] = vA0[i]; vN1[i] = vA1[i]; } } }
        const char* nA = GATHER ? (const char*)g.A : (has_next ? (const char*)g.A + (size_t)nxt.pm * tstep : cA); const char* nB = has_next ? (const char*)g.Bt + (size_t)nxt.pn * tstep : cB;
        for (int t = 0; t < nt; t += 2) {
            const bool last = (t == nt - 2);
            const char* a1 = cA + (size_t)(t + 1) * kstep;
            const char* a2 = last ? nA : cA + (size_t)(t + 2) * kstep; const char* b2 = last ? nB : cB + (size_t)(t + 2) * kstep;
            const char* a3 = a2 + kstep; const char* b3 = b2 + kstep;
            unsigned vX0[2], vX1[2];
#pragma unroll
            for (int i = 0; i < 2; ++i) { vX0[i] = (GATHER && last) ? vN0[i] : vA0[i]; vX1[i] = (GATHER && last) ? vN1[i] : vA1[i]; }
            if (last && has_next) S.a_ready(nxt);
            if constexpr (SP2) {
            PG8_LDB(B0, 0, 0); PG8_LDB(B1, 0, 1); PG8_SCHED; PG8_LDA(At, 0, 0); PG8_STAGE(PG8_SA(1, 1), a1, vA1);
            PG8_WAIT_V(8); PG8_WAIT_L(0); PG8_BAR; PG8_MM(0, 0, At, B0); PG8_MM(0, 1, At, B1); PG8_BAR; PG8_SCHED;
            PG8_LDA(At, 0, 1); PG8_STAGE(PG8_SB(0, 0), b2, voffB); PG8_STAGE(PG8_SB(0, 1), b2 + hstep, voffB); PG8_STAGE(PG8_SA(0, 0), a2, vX0);
            PG8_WAIT_V(8); PG8_WAIT_L(0); PG8_BAR; PG8_MM(1, 0, At, B0); PG8_MM(1, 1, At, B1); PG8_BAR; PG8_SCHED;
            PG8_LDB(B0, 1, 0); PG8_LDB(B1, 1, 1); PG8_SCHED; PG8_LDA(At, 1, 0); PG8_STAGE(PG8_SA(0, 1), a2, vX1);
            PG8_WAIT_V(8); PG8_WAIT_L(0); PG8_BAR; PG8_MM(0, 0, At, B0); PG8_MM(0, 1, At, B1); PG8_BAR; PG8_SCHED;
            PG8_LDA(At, 1, 1); PG8_STAGE(PG8_SB(1, 0), b3, voffB); PG8_STAGE(PG8_SB(1, 1), b3 + hstep, voffB); PG8_STAGE(PG8_SA(1, 0), a3, vX0);
            PG8_WAIT_V(8); PG8_WAIT_L(0); PG8_BAR; PG8_MM(1, 0, At, B0); PG8_MM(1, 1, At, B1); PG8_BAR; PG8_SCHED;
            } else {
            PG8_LDB(B0, 0, 0); PG8_SCHED; PG8_LDA(At, 0, 0); PG8_STAGE(PG8_SA(1, 1), a1, vA1);
            PG8_WAIT_L(8); PG8_BAR; PG8_WAIT_L(0); PG8_MM(0, 0, At, B0); PG8_BAR; PG8_SCHED;
            PG8_LDB(B1, 0, 1); PG8_STAGE(PG8_SB(0, 0), b2, voffB);
            PG8_BAR; PG8_WAIT_L(0); PG8_MM(0, 1, At, B1); PG8_BAR;
            PG8_LDA(At, 0, 1); PG8_STAGE(PG8_SA(0, 0), a2, vX0);
            PG8_BAR; PG8_WAIT_L(0); PG8_MM(1, 0, At, B0); PG8_BAR; PG8_SCHED;
            PG8_STAGE(PG8_SB(0, 1), b2 + hstep, voffB);
            PG8_WAIT_V(6); PG8_BAR; PG8_MM(1, 1, At, B1); PG8_BAR;
            PG8_LDB(B0, 1, 0); PG8_SCHED; PG8_LDA(At, 1, 0); PG8_STAGE(PG8_SA(0, 1), a2, vX1);
            PG8_WAIT_L(8); PG8_BAR; PG8_WAIT_L(0); PG8_MM(0, 0, At, B0); PG8_BAR; PG8_SCHED;
            PG8_LDB(B1, 1, 1); PG8_STAGE(PG8_SB(1, 0), b3, voffB);
            PG8_BAR; PG8_WAIT_L(0); PG8_MM(0, 1, At, B1); PG8_BAR;
            PG8_LDA(At, 1, 1); PG8_STAGE(PG8_SA(1, 0), a3, vX0);
            PG8_BAR; PG8_WAIT_L(0); PG8_MM(1, 0, At, B0); PG8_BAR; PG8_SCHED;
            PG8_STAGE(PG8_SB(1, 1), b3 + hstep, voffB);
            PG8_WAIT_V(6); PG8_BAR; PG8_MM(1, 1, At, B1); PG8_BAR;
            }
        }
        if constexpr (ALIGN_EPI) { if (wr == 0) PG8_BAR; }
        if constexpr (FP8) asm volatile("s_nop 15\n\ts_nop 15" ::: "memory");
        if constexpr (!Epi::AFTER_DRAIN) { E(acc, cur, wr, wc, fr, fq); S.done(cur); }
        if (!has_next) break;
#pragma unroll
        for (int a = 0; a < 2; ++a)
#pragma unroll
            for (int b = 0; b < 2; ++b)
#pragma unroll
                for (int m = 0; m < 4; ++m)
#pragma unroll
                    for (int n = 0; n < 2; ++n) acc[a][b][m][n] = (f32x4){0.f, 0.f, 0.f, 0.f};
        cur = nxt; cA = nA; cB = nB; ++ui;
        if constexpr (GATHER) { _Pragma("unroll") for (int i = 0; i < 2; ++i) { vA0[i] = vN0[i]; vA1[i] = vN1[i]; } }
        if constexpr (ALIGN_EPI) { if (wr == 1) PG8_BAR; }
    }
    PG8_WAIT_V(0);
    if constexpr (!ALIGN_EPI) { if (wr == 0) PG8_BAR; }
    PG8_BAR;
    if constexpr (Epi::AFTER_DRAIN) { E.fused(acc, cur, wr, wc, fr, fq, lds, wid, lane); S.done(cur); }
#undef PG8_SA
#undef PG8_SB
#undef PG8_STAGE
#undef PG8_GLOAD
#undef PG8_LDA
#undef PG8_LDB
#undef PG8_MMA
#undef PG8_MMA8
#undef PG8_MFMA8
#undef PG8_MM
#undef PG8_CAT8
#undef PG8_WAIT_V
#undef PG8_WAIT_L
#undef PG8_BAR
#undef PG8_SCHED
}
}
namespace pg8 {
__device__ __forceinline__ float bf_lo(unsigned w) { return __builtin_bit_cast(float, w << 16); }
__device__ __forceinline__ float bf_hi(unsigned w) { return __builtin_bit_cast(float, w & 0xffff0000u); }
__device__ __forceinline__ unsigned pk4_fp8(float a, float b, float c, float d) { int r = 0; r = __builtin_amdgcn_cvt_pk_fp8_f32(a, b, r, false); r = __builtin_amdgcn_cvt_pk_fp8_f32(c, d, r, true); return (unsigned)r; }
__device__ __forceinline__ float sigmoid_f(float x) { return __builtin_amdgcn_rcpf(1.0f + __expf(-x)); }

template <bool ADD, bool OUT8 = false> struct EpiGate {
    static constexpr bool PERM = true, AFTER_DRAIN = false;
    const bf16_t* G; const bf16_t* Min; bf16_t* O; float ascale;
    __device__ __forceinline__ void operator()(const f32x4 (&acc)[2][2][4][2], const Unit& u, int wr, int wc, int fr, int fq) const {
        const int row0 = u.pm * BM + wr * 64 + fr, col0 = u.pn * BM + wc * 32 + 8 * fq;
#pragma unroll
        for (int ai = 0; ai < 2; ++ai)
#pragma unroll
            for (int m = 0; m < 4; ++m) { const size_t off = (size_t)(row0 + ai * HALF + m * 16) * 1024 + col0;
#pragma unroll
                for (int bj = 0; bj < 2; ++bj) {
                    const u32x4 g = *(const u32x4*)(G + off + bj * HALF);
                    f32x4 v0 = acc[ai][bj][m][0] * ascale, v1 = acc[ai][bj][m][1] * ascale;
                    v0[0] *= sigmoid_f(bf_lo(g.x)); v0[1] *= sigmoid_f(bf_hi(g.x)); v0[2] *= sigmoid_f(bf_lo(g.y)); v0[3] *= sigmoid_f(bf_hi(g.y));
                    v1[0] *= sigmoid_f(bf_lo(g.z)); v1[1] *= sigmoid_f(bf_hi(g.z)); v1[2] *= sigmoid_f(bf_lo(g.w)); v1[3] *= sigmoid_f(bf_hi(g.w));
                    if (ADD) { const u32x4 p = *(const u32x4*)(Min + off + bj * HALF);
                        v0[0] += bf_lo(p.x); v0[1] += bf_hi(p.x); v0[2] += bf_lo(p.y); v0[3] += bf_hi(p.y);
                        v1[0] += bf_lo(p.z); v1[1] += bf_hi(p.z); v1[2] += bf_lo(p.w); v1[3] += bf_hi(p.w); }
                    if constexpr (OUT8) { typedef unsigned u32x2_ __attribute__((ext_vector_type(2))); u32x2_ w; w.x = pk4_fp8(v0[0], v0[1], v0[2], v0[3]); w.y = pk4_fp8(v1[0], v1[1], v1[2], v1[3]);
                        __builtin_nontemporal_store(w, (u32x2_*)((unsigned char*)O + off + bj * HALF)); }
                    else { u32x4 w; w.x = cvt_pk_bf16(v0[0], v0[1]); w.y = cvt_pk_bf16(v0[2], v0[3]); w.z = cvt_pk_bf16(v1[0], v1[1]); w.w = cvt_pk_bf16(v1[2], v1[3]);
                        __builtin_nontemporal_store(w, (u32x4*)(O + off + bj * HALF)); } } }
    }
};

struct EpiResid {
    static constexpr bool PERM = false, AFTER_DRAIN = false;
    const float* X; const float* gate; float* out; int rows_per_batch; int gstride; float ascale;
    __device__ __forceinline__ void operator()(const f32x4 (&acc)[2][2][4][2], const Unit& u, int wr, int wc, int fr, int fq) const {
        const int col0 = u.pn * BM + wc * 32 + 4 * fq;
#pragma unroll
        for (int ai = 0; ai < 2; ++ai)
#pragma unroll
            for (int m = 0; m < 4; ++m) { const int row = u.pm * BM + ai * HALF + wr * 64 + m * 16 + fr; const size_t off = (size_t)row * 1024 + col0;
                const float* gp = gate + (size_t)(row / rows_per_batch) * gstride + col0;
#pragma unroll
                for (int bj = 0; bj < 2; ++bj)
#pragma unroll
                    for (int n = 0; n < 2; ++n) { const f32x4 xv = *(const f32x4*)(X + off + bj * HALF + n * 16); const f32x4 gv = *(const f32x4*)(gp + bj * HALF + n * 16);
                        *(f32x4*)(out + off + bj * HALF + n * 16) = xv + gv * (acc[ai][bj][m][n] * ascale); } }
    }
};

__device__ __forceinline__ float swiglu1(float g, float l) {
    g = fminf(g, 7.0f); l = fminf(fmaxf(l, -7.0f), 7.0f);
    return (l + 1.0f) * (g * __builtin_amdgcn_rcpf(1.0f + __expf(-1.702f * g)));
}
template <bool OUT8> struct EpiSwiglu {
    static constexpr bool PERM = true, AFTER_DRAIN = false;
    const float* b1; bf16_t* O; float ascale;
    __device__ __forceinline__ void operator()(const f32x4 (&acc)[2][2][4][2], const Unit& u, int wr, int wc, int fr, int fq) const {
        const int e = u.pn >> 3, pl = u.pn & 7, jc = wc * 32 + 8 * fq;
        const float* bg = b1 + (size_t)e * 2048 + 128 * pl + jc; const float* bl = bg + 1024;
        const f32x4 bg0 = *(const f32x4*)bg, bg1 = *(const f32x4*)(bg + 4), bl0 = *(const f32x4*)bl, bl1 = *(const f32x4*)(bl + 4);
        const int row0 = u.pm * BM + wr * 64 + fr;
#pragma unroll
        for (int ai = 0; ai < 2; ++ai)
#pragma unroll
            for (int m = 0; m < 4; ++m) {
                const f32x4 g0 = acc[ai][0][m][0] * ascale + bg0, g1 = acc[ai][0][m][1] * ascale + bg1, l0 = acc[ai][1][m][0] * ascale + bl0, l1 = acc[ai][1][m][1] * ascale + bl1;
                if constexpr (OUT8) { typedef unsigned u32x2_ __attribute__((ext_vector_type(2))); u32x2_ w;
                    w.x = pk4_fp8(swiglu1(g0[0], l0[0]), swiglu1(g0[1], l0[1]), swiglu1(g0[2], l0[2]), swiglu1(g0[3], l0[3])); w.y = pk4_fp8(swiglu1(g1[0], l1[0]), swiglu1(g1[1], l1[1]), swiglu1(g1[2], l1[2]), swiglu1(g1[3], l1[3]));
                    __builtin_nontemporal_store(w, (u32x2_*)((unsigned char*)O + (size_t)(row0 + ai * HALF + m * 16) * 1024 + 128 * pl + jc)); }
                else { u32x4 w; w.x = cvt_pk_bf16(swiglu1(g0[0], l0[0]), swiglu1(g0[1], l0[1])); w.y = cvt_pk_bf16(swiglu1(g0[2], l0[2]), swiglu1(g0[3], l0[3]));
                    w.z = cvt_pk_bf16(swiglu1(g1[0], l1[0]), swiglu1(g1[1], l1[1])); w.w = cvt_pk_bf16(swiglu1(g1[2], l1[2]), swiglu1(g1[3], l1[3]));
                    __builtin_nontemporal_store(w, (u32x4*)(O + (size_t)(row0 + ai * HALF + m * 16) * 1024 + 128 * pl + jc)); } }
    }
};

struct EpiOutS {
    static constexpr bool PERM = true, AFTER_DRAIN = false;
    bf16_t* O; const float* bias; float ascale;
    __device__ __forceinline__ void operator()(const f32x4 (&acc)[2][2][4][2], const Unit& u, int wr, int wc, int fr, int fq) const {
        const int row0 = u.pm * BM + wr * 64 + fr, col0 = (u.pn & 3) * BM + wc * 32 + 8 * fq, bcol0 = u.pn * BM + wc * 32 + 8 * fq;
        f32x4 bv[2][2];
#pragma unroll
        for (int bj = 0; bj < 2; ++bj)
#pragma unroll
            for (int n = 0; n < 2; ++n) bv[bj][n] = *(const f32x4*)(bias + bcol0 + bj * HALF + 4 * n);
#pragma unroll
        for (int ai = 0; ai < 2; ++ai)
#pragma unroll
            for (int m = 0; m < 4; ++m) { bf16_t* rowp = O + (size_t)(row0 + ai * HALF + m * 16) * 1024 + col0;
#pragma unroll
                for (int bj = 0; bj < 2; ++bj) { const f32x4 v0 = acc[ai][bj][m][0] * ascale + bv[bj][0], v1 = acc[ai][bj][m][1] * ascale + bv[bj][1];
                    u32x4 w; w.x = cvt_pk_bf16(v0[0], v0[1]); w.y = cvt_pk_bf16(v0[2], v0[3]); w.z = cvt_pk_bf16(v1[0], v1[1]); w.w = cvt_pk_bf16(v1[2], v1[3]);
                    __builtin_nontemporal_store(w, (u32x4*)(rowp + bj * HALF)); } }
    }
};

struct GroupedOrder {
    const PG8_LAS int* ts; int NT, G, c; const int* rowtok;
    __device__ __forceinline__ bool next(int i, Unit& u) const {
        const int total = __builtin_amdgcn_readfirstlane(ts[32]) * NT; const long L = (long)i * G + c; if (L >= total) return false;
        const int pm = (int)L / NT, pl = (int)L % NT; int e = 0;
#pragma unroll 1
        for (int j = 1; j < 32; ++j) e += (pm >= ts[j]) ? 1 : 0;
        u.pm = __builtin_amdgcn_readfirstlane(pm); u.pn = __builtin_amdgcn_readfirstlane(e * NT + pl); return true;
    }
    __device__ __forceinline__ void a_ready(const Unit&) const {}
    __device__ __forceinline__ void done(const Unit&) const {}
};
}
#define GAS __attribute__((address_space(1)))
#define LAS __attribute__((address_space(3)))
typedef unsigned short bf16;
typedef unsigned v4u __attribute__((ext_vector_type(4)));
typedef float f32x4 __attribute__((ext_vector_type(4)));
typedef short bf16x8 __attribute__((ext_vector_type(8)));
typedef GAS unsigned gu32;
typedef GAS unsigned long long gu64;
#define RLX_AGENT __ATOMIC_RELAXED, __HIP_MEMORY_SCOPE_AGENT
#define LDS_WAIT() asm volatile("s_waitcnt lgkmcnt(0)" ::: "memory")
#define VM_WAIT() asm volatile("s_waitcnt vmcnt(0)" ::: "memory")
__device__ __forceinline__ unsigned long long rt() { return __builtin_amdgcn_s_memrealtime(); }
__device__ __forceinline__ unsigned f2bf(float f) { unsigned u = __builtin_bit_cast(unsigned, f); return (u + 0x7fffu + ((u >> 16) & 1u)) >> 16; }
typedef float f32x2_pk __attribute__((ext_vector_type(2))); typedef __bf16 bf16x2_pk __attribute__((ext_vector_type(2)));
__device__ __forceinline__ unsigned pk2(float lo, float hi) { const f32x2_pk v = {lo, hi}; return __builtin_bit_cast(unsigned, __builtin_convertvector(v, bf16x2_pk)); }

#define XB_TMO      128
#define XB_XCNT(j)  (256  + 64 * (j))
#define XB_XSUB(j)  (1280 + 64 * (j))
#define XB_XGEN(j)  (2304 + 64 * (j))
#define XB_TOP      3328
#define XB_TOPGEN   3392
#define XCD_BAR_WORDS 3456
#define XB_SPIN_CAP (1u << 18)

__device__ __forceinline__ unsigned xb_ld(unsigned* p)              { return __hip_atomic_load(p, __ATOMIC_RELAXED, __HIP_MEMORY_SCOPE_AGENT); }
__device__ __forceinline__ unsigned xb_add(unsigned* p, unsigned v) { return __hip_atomic_fetch_add(p, v, __ATOMIC_RELAXED, __HIP_MEMORY_SCOPE_AGENT); }
__device__ __forceinline__ unsigned xb_xcc_id() { return (unsigned)__builtin_amdgcn_s_getreg((3 << 11) | 20) & 0xFu; }
#define XB_SPIN(cond, bar) do { unsigned _sp = 0; while (cond) { __builtin_amdgcn_s_sleep(1); \
    if ((++_sp & 255u) == 0u) { if (xb_ld(&(bar)[XB_TMO])) break; if (_sp > XB_SPIN_CAP) { atomicAdd(&(bar)[XB_TMO], 1u); break; } } } } while (0)

struct XcdBarrier {
    unsigned* bar; unsigned x;
    volatile LAS unsigned* st;
};

__device__ __forceinline__ XcdBarrier xcd_barrier_post(unsigned* bar, volatile LAS unsigned* st) {
    XcdBarrier b; b.bar = bar; b.x = xb_xcc_id(); b.st = st;
    if (threadIdx.x == 0) (void)xb_add(&bar[XB_XCNT(b.x)], 1u);
    return b;
}
__device__ __forceinline__ void xcd_barrier_complete(unsigned* bar, unsigned x, unsigned& nloc, unsigned& nx) {
    const unsigned G = gridDim.x * gridDim.y * gridDim.z;
    unsigned sum, cnt, mine, sp = 0u;
    for (;;) {
        sum = 0u; cnt = 0u; mine = 0u;
#pragma unroll
        for (unsigned j = 0; j < 16; ++j) { const unsigned c = xb_ld(&bar[XB_XCNT(j)]); sum += c; cnt += (c > 0u) ? 1u : 0u; mine = (j == x) ? c : mine; }
        if (sum == G) break;
        __builtin_amdgcn_s_sleep(1);
        if ((++sp & 255u) == 0u) { if (xb_ld(&bar[XB_TMO])) break; if (sp > XB_SPIN_CAP) { atomicAdd(&bar[XB_TMO], 1u); break; } }
    }
    nloc = mine > 0u ? mine : 1u; nx = cnt > 0u ? cnt : 1u;
}

__device__ __forceinline__ void xcd_barrier(const XcdBarrier& b) {
    asm volatile("s_waitcnt vmcnt(0)" ::: "memory");
    __syncthreads();
    if (threadIdx.x == 0) {
        unsigned* bar = b.bar;
        __builtin_amdgcn_s_waitcnt(0);
        unsigned nloc = b.st[0], nx = b.st[1];
        if (nloc == 0u) { xcd_barrier_complete(bar, b.x, nloc, nx); b.st[0] = nloc; b.st[1] = nx; }
        const unsigned old = xb_add(&bar[XB_XSUB(b.x)], 1u);
        const unsigned gen = old / nloc;
        if (old + 1u == (gen + 1u) * nloc) {
            __builtin_amdgcn_fence(__ATOMIC_RELEASE, "agent");
            asm volatile("s_waitcnt vmcnt(0)" ::: "memory");
            const unsigned og = xb_add(&bar[XB_TOP], 1u);
            const unsigned tg = og / nx;
            if (og + 1u == (tg + 1u) * nx) xb_add(&bar[XB_TOPGEN], 1u);
            else XB_SPIN(xb_ld(&bar[XB_TOPGEN]) == tg, bar);
            __builtin_amdgcn_fence(__ATOMIC_ACQUIRE, "agent");
            xb_add(&bar[XB_XGEN(b.x)], 1u);
            asm volatile("s_waitcnt vmcnt(0)" ::: "memory");
        } else {
            XB_SPIN(xb_ld(&bar[XB_XGEN(b.x)]) == gen, bar);
            __builtin_amdgcn_fence(__ATOMIC_ACQUIRE, "agent");
            asm volatile("s_waitcnt vmcnt(0)" ::: "memory");
        }
    }
    __syncthreads();
}

constexpr int NWAVES = 8;
constexpr int BATCH = 16, SEQ = 2048, D = 1024, T = BATCH * SEQ;
constexpr int NIN = 9224, NPROJ = 9216, NMOD = 6 * D;
constexpr int NE = 32, TOPK = 4;
constexpr int XS_ROWS = T * TOPK + NE * 256;
constexpr float EPS = 1e-6f;
constexpr float ATT_RTHR = -120.0f;
constexpr float W8SCALE = 64.0f;
constexpr float QSCALE = 0.125f * 1.4426950408889634f;

constexpr size_t MiB = 1u << 20;
constexpr size_t WS_CTL = 0, CTL_ZERO_BYTES = 1 * MiB;
constexpr size_t WS_MODP = 1 * MiB;
constexpr size_t WS_MOD = 3 * MiB;
constexpr size_t WS_IPRE = 4 * MiB, WS_LF = 4 * MiB + 512 * 1024;
constexpr size_t WS_TOKE = 5 * MiB, WS_TOKP = 5 * MiB + 512 * 1024, WS_TOKW = 6 * MiB, WS_TOKROW = 6 * MiB + 512 * 1024, WS_RSTD = 7 * MiB;
constexpr size_t WS_WIN = 8 * MiB, WS_WA = 26 * MiB, WS_WB = 28 * MiB, WS_WOUT = 30 * MiB, WS_W1 = 32 * MiB, WS_W2 = 160 * MiB;
constexpr size_t WS_H1 = 224 * MiB;
constexpr size_t WS_PROJ = 288 * MiB, SEG = 64 * MiB;
constexpr size_t WS_YB = 864 * MiB;
constexpr size_t WS_XS = 288 * MiB, WS_ACT = 560 * MiB;
constexpr size_t WS_ROW2TOK = 7 * MiB + 128 * 1024;
constexpr size_t WS_GT = 928 * MiB;
constexpr size_t WS_END = 932 * MiB;
static_assert(WS_XS + (size_t)XS_ROWS * 2048 <= WS_ACT && WS_ACT + (size_t)XS_ROWS * 2048 <= WS_YB, "ws map");
constexpr int CW_TMO = 0, CW_BAR = 4096, CW_ECNT = 8192;

constexpr int RING_BYTES = 131072, LDS_BYTES = 147456, LDSCTL_OFF = 146432;
constexpr int LC_BAR = 0, LC_TS = 16, LC_LCNT = 64, LC_GBASE = 96, LC_PS = 128, LC_CNT = 160;

__device__ __forceinline__ unsigned long long karg(int i) { return ((const __attribute__((address_space(4))) unsigned long long*)__builtin_amdgcn_kernarg_segment_ptr())[i]; }
struct Frame {
    LAS unsigned char* lds; volatile LAS unsigned* LC;
    gu32* ctl; unsigned char* ws; int tid, lane, wave, vcu, G;
    __device__ __forceinline__ const float* x() const { return (const float*)(const GAS float*)karg(0); }
    __device__ __forceinline__ const float* c() const { return (const float*)(const GAS float*)karg(1); }
    __device__ __forceinline__ const float* ada_w() const { return (const float*)(const GAS float*)karg(2); }
    __device__ __forceinline__ const float* ada_b() const { return (const float*)(const GAS float*)karg(3); }
    __device__ __forceinline__ const float* norm1_g() const { return (const float*)(const GAS float*)karg(4); }
    __device__ __forceinline__ const float* w_in() const { return (const float*)(const GAS float*)karg(5); }
    __device__ __forceinline__ const float* conv_w() const { return (const float*)(const GAS float*)karg(6); }
    __device__ __forceinline__ const float* conv_b() const { return (const float*)(const GAS float*)karg(7); }
    __device__ __forceinline__ const float* b_i() const { return (const float*)(const GAS float*)karg(8); }
    __device__ __forceinline__ const float* b_f() const { return (const float*)(const GAS float*)karg(9); }
    __device__ __forceinline__ const float* ml_norm_g() const { return (const float*)(const GAS float*)karg(10); }
    __device__ __forceinline__ const float* w_a() const { return (const float*)(const GAS float*)karg(11); }
    __device__ __forceinline__ const float* w_b() const { return (const float*)(const GAS float*)karg(12); }
    __device__ __forceinline__ const float* w_out() const { return (const float*)(const GAS float*)karg(13); }
    __device__ __forceinline__ const float* norm2_g() const { return (const float*)(const GAS float*)karg(14); }
    __device__ __forceinline__ const float* router_w() const { return (const float*)(const GAS float*)karg(15); }
    __device__ __forceinline__ const float* router_b() const { return (const float*)(const GAS float*)karg(16); }
    __device__ __forceinline__ const float* w1() const { return (const float*)(const GAS float*)karg(17); }
    __device__ __forceinline__ const float* b1() const { return (const float*)(const GAS float*)karg(18); }
    __device__ __forceinline__ const float* w2() const { return (const float*)(const GAS float*)karg(19); }
    __device__ __forceinline__ const float* b2() const { return (const float*)(const GAS float*)karg(20); }
    __device__ __forceinline__ const float* final_g() const { return (const float*)(const GAS float*)karg(21); }
    __device__ __forceinline__ float* out() const { return (float*)(GAS float*)karg(22); }
    __device__ __forceinline__ float* modp() const { return (float*)(ws + WS_MODP); }
    __device__ __forceinline__ float* mod() const { return (float*)(ws + WS_MOD); }
    __device__ __forceinline__ float* ipre() const { return (float*)(ws + WS_IPRE); }
    __device__ __forceinline__ float* lf() const { return (float*)(ws + WS_LF); }
    __device__ __forceinline__ float* tokw() const { return (float*)(ws + WS_TOKW); }
    __device__ __forceinline__ float* rstd2() const { return (float*)(ws + WS_RSTD); }
    __device__ __forceinline__ int* toke() const { return (int*)(ws + WS_TOKE); }
    __device__ __forceinline__ int* tokp() const { return (int*)(ws + WS_TOKP); }
    __device__ __forceinline__ int* tokrow() const { return (int*)(ws + WS_TOKROW); }
    __device__ __forceinline__ bf16* WIN_T() const { return (bf16*)(ws + WS_WIN); }
    __device__ __forceinline__ bf16* WA_T() const { return (bf16*)(ws + WS_WA); }
    __device__ __forceinline__ bf16* WB_T() const { return (bf16*)(ws + WS_WB); }
    __device__ __forceinline__ bf16* WOUT_T() const { return (bf16*)(ws + WS_WOUT); }
    __device__ __forceinline__ bf16* W1_T() const { return (bf16*)(ws + WS_W1); }
    __device__ __forceinline__ bf16* W2_T() const { return (bf16*)(ws + WS_W2); }
    __device__ __forceinline__ bf16* H1() const { return (bf16*)(ws + WS_H1); }
    __device__ __forceinline__ bf16* PROJ() const { return (bf16*)(ws + WS_PROJ); }
    __device__ __forceinline__ bf16* YA() const { return (bf16*)(ws + WS_H1); }
    __device__ __forceinline__ bf16* YB() const { return (bf16*)(ws + WS_YB); }
    __device__ __forceinline__ bf16* YB8() const { return (bf16*)(ws + WS_H1 + 32 * MiB); }
    __device__ __forceinline__ bf16* M1() const { return (bf16*)(ws + WS_PROJ); }
    __device__ __forceinline__ bf16* MERGED() const { return (bf16*)(ws + WS_PROJ + SEG); }
    __device__ __forceinline__ bf16* XS() const { return (bf16*)(ws + WS_XS); }
    __device__ __forceinline__ bf16* ACT() const { return (bf16*)(ws + WS_ACT); }
    __device__ __forceinline__ bf16* OUTR() const { return (bf16*)(ws + WS_XS); }
    __device__ __forceinline__ bf16* H2() const { return (bf16*)(ws + WS_XS); }
    __device__ __forceinline__ int* row2tok() const { return (int*)(ws + WS_ROW2TOK); }
    __device__ __forceinline__ float* gt() const { return (float*)(ws + WS_GT); }
};

__device__ __forceinline__ int opq(int v) { asm volatile("" : "+v"(v)); return v; }
__device__ __forceinline__ float wave_sum(float v) {
#pragma unroll
    for (int o = 1; o < 64; o <<= 1) v += __shfl_xor(v, o);
    return v;
}
__device__ __forceinline__ float bf2f(unsigned short b) { return __builtin_bit_cast(float, (unsigned)b << 16); }
__device__ __forceinline__ float bflo(unsigned w) { return __builtin_bit_cast(float, w << 16); }
__device__ __forceinline__ float bfhi(unsigned w) { return __builtin_bit_cast(float, w & 0xffff0000u); }
__device__ __forceinline__ float log_sigmoid_f(float x) { return fminf(x, 0.f) - log1pf(expf(-fabsf(x))); }

struct MapIn { __device__ __forceinline__ long operator()(int n) const { return n < 7168 ? (long)n : (n < 7176 ? -1L : (n < NIN ? (long)(n - 8) : -1L)); } };
struct MapId { long off; __device__ __forceinline__ long operator()(int n) const { return off + n; } };
struct MapW1 { int e; __device__ __forceinline__ long operator()(int n) const { return (long)e * 2048 + ((n & 1023) >> 7) * 256 + (n >> 10) * 128 + (n & 127); } };

template <class Map> __device__ __forceinline__ void transpose_item(const float* W, int K, int N, bf16* WT, LAS float* scr, int item, int lane, Map map, float scale8 = 0.f) {
    const int nblk = (N + 31) / 32, kb = item / nblk, nb = item % nblk, k0 = 64 * kb, n0 = 32 * nb;
    const int n4 = 4 * (lane & 7), kr = lane >> 3;
    const bool ok = (n0 + n4 + 3) < N;
    f32x4 v[8];
#pragma unroll
    for (int i = 0; i < 8; ++i) v[i] = ok ? *(const f32x4*)(W + (size_t)(k0 + 8 * i + kr) * N + n0 + n4) : (f32x4){0.f, 0.f, 0.f, 0.f};
#pragma unroll
    for (int i = 0; i < 8; ++i) { LAS float* d = scr + (8 * i + kr) * 33 + n4; d[0] = v[i].x; d[1] = v[i].y; d[2] = v[i].z; d[3] = v[i].w; }
    LDS_WAIT(); asm volatile("" ::: "memory");
    const int c = lane & 7;
#pragma unroll
    for (int j = 0; j < 4; ++j) { const int n = (lane >> 3) + 8 * j; const LAS float* s = scr + (8 * c) * 33 + n;
        const long dr = map(n0 + n);
        if (scale8 != 0.f) { typedef unsigned u32x2_ __attribute__((ext_vector_type(2))); u32x2_ o;
            o.x = pg8::pk4_fp8(s[0 * 33] * scale8, s[1 * 33] * scale8, s[2 * 33] * scale8, s[3 * 33] * scale8); o.y = pg8::pk4_fp8(s[4 * 33] * scale8, s[5 * 33] * scale8, s[6 * 33] * scale8, s[7 * 33] * scale8);
            if (dr >= 0) *(GAS u32x2_*)((unsigned char*)WT + (size_t)dr * K + k0 + 8 * c) = o; }
        else { v4u o; o.x = pk2(s[0 * 33], s[1 * 33]); o.y = pk2(s[2 * 33], s[3 * 33]); o.z = pk2(s[4 * 33], s[5 * 33]); o.w = pk2(s[6 * 33], s[7 * 33]);
            if (dr >= 0) *(GAS v4u*)(WT + (size_t)dr * K + k0 + 8 * c) = o; } }
    LDS_WAIT(); asm volatile("" ::: "memory");
}
__device__ __forceinline__ void mod_item(Frame& F, const LAS float* sil, int it) {
    const int j = it % 96, kq = it / 96, n = 64 * j + F.lane, k0 = 256 * kq;
    float acc[16];
#pragma unroll
    for (int b = 0; b < 16; ++b) acc[b] = 0.f;
    const float* w = F.ada_w() + (size_t)k0 * NMOD + n;
    const LAS f32x4* s = (const LAS f32x4*)sil + k0 * 4;
    for (int kk = 0; kk < 256; kk += 8) {
        float wv[8];
#pragma unroll
        for (int u = 0; u < 8; ++u) wv[u] = w[(size_t)(kk + u) * NMOD];
#pragma unroll
        for (int u = 0; u < 8; ++u) {
#pragma unroll
            for (int q = 0; q < 4; ++q) { const f32x4 sv = s[(kk + u) * 4 + q]; acc[4 * q + 0] += sv.x * wv[u]; acc[4 * q + 1] += sv.y * wv[u]; acc[4 * q + 2] += sv.z * wv[u]; acc[4 * q + 3] += sv.w * wv[u]; }
        }
    }
    float* o = F.modp() + (size_t)kq * 16 * NMOD + n;
#pragma unroll
    for (int b = 0; b < 16; ++b) o[(size_t)b * NMOD] = acc[b];
}
__device__ __forceinline__ void p0_prologue(Frame& F) {
    LAS float* sil = (LAS float*)F.lds;
    for (int idx = F.tid; idx < 16384; idx += 512) { const int b = idx >> 10, k = idx & 1023; const float v = F.c()[idx]; sil[k * 16 + b] = v / (1.0f + __expf(-v)); }
    __syncthreads();
    LAS float* scr = (LAS float*)(F.lds + 65536 + F.wave * 8704);
    const int gw = F.vcu * NWAVES + F.wave, NGW = F.G * NWAVES;
    constexpr int I_MOD = 384, I_IN = 16 * 289, I_SQ = 16 * 32, I_W1 = 32 * 16 * 64, I_W2 = 32 * 16 * 32;
    constexpr int NITEMS = I_MOD + I_IN + 3 * I_SQ + I_W1 + I_W2;
    for (int it = gw; it < NITEMS; it += NGW) {
        int r = it;
        if (r < I_MOD) { mod_item(F, sil, r); continue; } r -= I_MOD;
        if (r < I_IN) { transpose_item(F.w_in(), D, NIN, F.WIN_T(), scr, r, F.lane, MapIn{}, W8SCALE); continue; } r -= I_IN;
        if (r < I_SQ) { transpose_item(F.w_a(), D, D, F.WA_T(), scr, r, F.lane, MapId{0}, W8SCALE); continue; } r -= I_SQ;
        if (r < I_SQ) { transpose_item(F.w_b(), D, D, F.WB_T(), scr, r, F.lane, MapId{0}, W8SCALE); continue; } r -= I_SQ;
        if (r < I_SQ) { transpose_item(F.w_out(), D, D, F.WOUT_T(), scr, r, F.lane, MapId{0}, W8SCALE); continue; } r -= I_SQ;
        if (r < I_W1) { const int e = r >> 10; transpose_item(F.w1() + (size_t)e * D * 2048, D, 2048, F.W1_T(), scr, r & 1023, F.lane, MapW1{e}, W8SCALE); continue; } r -= I_W1;
        { const int e = r >> 9; transpose_item(F.w2() + (size_t)e * D * D, D, D, F.W2_T(), scr, r & 511, F.lane, MapId{(long)e * 1024}, W8SCALE); }
    }
}

__device__ __forceinline__ void p1_rows(Frame& F) {
    const int row0 = F.vcu * 128, b = row0 / SEQ, lane = opq(F.lane);
    LAS float* wif = (LAS float*)F.lds;
    for (int idx = F.tid; idx < 8192; idx += 512) wif[idx] = F.w_in()[(size_t)(idx >> 3) * NIN + 7168 + (idx & 7)];
    for (int idx = F.vcu * 512 + F.tid; idx < 16 * NMOD; idx += F.G * 512) { float s = F.ada_b()[idx % NMOD];
#pragma unroll
        for (int kq = 0; kq < 4; ++kq) s += F.modp()[(size_t)kq * 16 * NMOD + idx];
        F.mod()[idx] = s; }
    f32x4 Av[4], Bv[4];
#pragma unroll
    for (int j = 0; j < 4; ++j) { const int col = 4 * lane + 256 * j;
        f32x4 sh = *(const f32x4*)(F.ada_b() + col), sc = *(const f32x4*)(F.ada_b() + D + col);
#pragma unroll
        for (int kq = 0; kq < 4; ++kq) { sh += *(const f32x4*)(F.modp() + ((size_t)kq * 16 + b) * NMOD + col); sc += *(const f32x4*)(F.modp() + ((size_t)kq * 16 + b) * NMOD + D + col); }
        const f32x4 g = *(const f32x4*)(F.norm1_g() + col); Av[j] = g * (sc + 1.0f); Bv[j] = sh; }
    __syncthreads();
    f32x4 nx[4];
    { const GAS f32x4* xr = (const GAS f32x4*)(F.x() + (size_t)(row0 + 16 * F.wave) * D) + lane;
#pragma unroll
      for (int j = 0; j < 4; ++j) nx[j] = xr[64 * j]; }
    for (int r = 0; r < 16; ++r) {
        const int row = row0 + 16 * F.wave + r;
        f32x4 v[4]; float ss = 0.f;
#pragma unroll
        for (int j = 0; j < 4; ++j) { v[j] = nx[j]; ss += (v[j].x * v[j].x + v[j].y * v[j].y) + (v[j].z * v[j].z + v[j].w * v[j].w); }
        if (r < 15) { const GAS f32x4* xr = (const GAS f32x4*)(F.x() + (size_t)(row + 1) * D) + lane;
#pragma unroll
            for (int j = 0; j < 4; ++j) nx[j] = xr[64 * j]; }
        const float rstd = 1.0f / sqrtf(wave_sum(ss) * (1.0f / D) + EPS);
        GAS unsigned* o4 = (GAS unsigned*)((unsigned char*)F.H1() + (size_t)row * D) + lane;
        float p[8];
#pragma unroll
        for (int q = 0; q < 8; ++q) p[q] = 0.f;
#pragma unroll
        for (int j = 0; j < 4; ++j) { v[j] = v[j] * rstd * Av[j] + Bv[j];
            o4[64 * j] = pg8::pk4_fp8(v[j].x, v[j].y, v[j].z, v[j].w);
#pragma unroll
            for (int i = 0; i < 4; ++i) { const LAS f32x4* wp = (const LAS f32x4*)(wif + (4 * lane + 256 * j + i) * 8); const f32x4 w0 = wp[0], w1 = wp[1]; const float hv = v[j][i];
                p[0] += hv * w0.x; p[1] += hv * w0.y; p[2] += hv * w0.z; p[3] += hv * w0.w; p[4] += hv * w1.x; p[5] += hv * w1.y; p[6] += hv * w1.z; p[7] += hv * w1.w; } }
#pragma unroll
        for (int q = 0; q < 8; ++q) p[q] = wave_sum(p[q]);
        if (lane == 0) { const int t = row % SEQ;
#pragma unroll
            for (int hh = 0; hh < 4; ++hh) { F.ipre()[((size_t)b * 4 + hh) * SEQ + t] = p[hh] + F.b_i()[hh]; F.lf()[((size_t)b * 4 + hh) * SEQ + t] = log_sigmoid_f(p[4 + hh] + F.b_f()[hh]); } }
    }
}

__device__ __forceinline__ void attn_naive_item(Frame& F, int bh, int qblk) {
    const int b = bh >> 4, hd = bh & 15, t = qblk * 512 + F.tid;
    const bf16* Q = F.PROJ(); const bf16* K = F.PROJ() + SEG / 2; const bf16* V = F.PROJ() + SEG;
    const size_t rowb = (size_t)b * SEQ;
    float q[64], o[64];
    { const v4u* qp = (const v4u*)(Q + (rowb + t) * D + hd * 64);
#pragma unroll
      for (int i = 0; i < 8; ++i) { const v4u w = qp[i]; q[8 * i + 0] = bflo(w.x); q[8 * i + 1] = bfhi(w.x); q[8 * i + 2] = bflo(w.y); q[8 * i + 3] = bfhi(w.y); q[8 * i + 4] = bflo(w.z); q[8 * i + 5] = bfhi(w.z); q[8 * i + 6] = bflo(w.w); q[8 * i + 7] = bfhi(w.w); } }
#pragma unroll
    for (int i = 0; i < 64; ++i) o[i] = 0.f;
    float R = 0.f;
    LAS v4u* kt = (LAS v4u*)F.lds; LAS v4u* vt = (LAS v4u*)(F.lds + 8192);
    const int tmax_wave = qblk * 512 + F.wave * 64 + 63;
    bool wdone = false;
    LAS volatile int* dflag = (LAS volatile int*)(F.lds + 16384);
    if (F.tid < 8) dflag[F.tid] = 0;
    for (int tile = qblk * 8 + 7; tile >= 0; --tile) {
        __syncthreads();
        { int nd = 0;
#pragma unroll
          for (int w = 0; w < 8; ++w) nd += dflag[w];
          if (nd == 8) break; }
        { const int kr = F.tid >> 3, ch = F.tid & 7; const size_t g = (rowb + tile * 64 + kr) * D + hd * 64 + ch * 8;
          kt[F.tid] = *(const v4u*)(K + g); vt[F.tid] = *(const v4u*)(V + g); }
        __syncthreads();
        if (tile * 64 >= tmax_wave) continue;
        if (wdone) continue;
        for (int s = 63; s >= 0; --s) {
            const int key = tile * 64 + s;
            float z = 0.f;
#pragma unroll
            for (int i = 0; i < 8; ++i) { const v4u w = kt[s * 8 + i]; z += q[8 * i + 0] * bflo(w.x) + q[8 * i + 1] * bfhi(w.x) + q[8 * i + 2] * bflo(w.y) + q[8 * i + 3] * bfhi(w.y) + q[8 * i + 4] * bflo(w.z) + q[8 * i + 5] * bfhi(w.z) + q[8 * i + 6] * bflo(w.w) + q[8 * i + 7] * bfhi(w.w); }
            const float lb = fminf(z, 0.f) - __builtin_amdgcn_logf(1.0f + __builtin_amdgcn_exp2f(-fabsf(z)));
            const bool act = key < t;
            const float a = act ? __builtin_amdgcn_exp2f(lb + R) : 0.f;
            R += act ? (lb - z) : 0.f;
#pragma unroll
            for (int i = 0; i < 8; ++i) { const v4u w = vt[s * 8 + i]; o[8 * i + 0] += a * bflo(w.x); o[8 * i + 1] += a * bfhi(w.x); o[8 * i + 2] += a * bflo(w.y); o[8 * i + 3] += a * bfhi(w.y); o[8 * i + 4] += a * bflo(w.z); o[8 * i + 5] += a * bfhi(w.z); o[8 * i + 6] += a * bflo(w.w); o[8 * i + 7] += a * bfhi(w.w); }
        }
        if (__all(R < ATT_RTHR) && !wdone) { wdone = true; if (F.lane == 0) dflag[F.wave] = 1; }
    }
    __syncthreads();
    v4u* op = (v4u*)(F.YA() + (rowb + t) * D + hd * 64);
#pragma unroll
    for (int i = 0; i < 8; ++i) { v4u w; w.x = pk2(o[8 * i + 0], o[8 * i + 1]); w.y = pk2(o[8 * i + 2], o[8 * i + 3]); w.z = pk2(o[8 * i + 4], o[8 * i + 5]); w.w = pk2(o[8 * i + 6], o[8 * i + 7]); op[i] = w; }
}

__device__ __forceinline__ void mlstm_naive_item(Frame& F, int bh) {
    const int b = bh >> 2, hh = bh & 3, tid = opq(F.tid), e = tid & 255, half = tid >> 8;
    const bf16* MLQ = F.PROJ() + 3 * (SEG / 2); const bf16* MLK = F.PROJ() + 4 * (SEG / 2); const bf16* MLV = F.PROJ() + 5 * (SEG / 2); const bf16* MLO = F.PROJ() + 6 * (SEG / 2);
    LAS float* ql = (LAS float*)F.lds; LAS float* kl = ql + 8192; LAS float* vl = kl + 8192; LAS float* hl = vl + 8192;
    LAS float* part = hl + 8192;
    LAS float* red = part + 512;
    LAS float* il = red + 8; LAS float* fl = il + 32;
    const size_t rowb = (size_t)b * SEQ;
    float C[128];
#pragma unroll
    for (int i = 0; i < 128; ++i) C[i] = 0.f;
    float nreg = 0.f, m = 0.f;
    float cw[2][4], cb[2];
    { const int c = tid & 255;
#pragma unroll
      for (int z = 0; z < 2; ++z) { const int ch = z * 1024 + hh * 256 + c; cb[z] = F.conv_b()[ch];
#pragma unroll
          for (int tap = 0; tap < 4; ++tap) cw[z][tap] = F.conv_w()[tap * 2048 + ch]; } }
    for (int chunk = 0; chunk < SEQ / 32; ++chunk) {
        const int t0 = chunk * 32;
        __syncthreads();
        { const int c = tid & 255;
          for (int u = 0; u < 16; ++u) { const int tt = (tid >> 8) + 2 * u, t = t0 + tt; float yq = cb[0], yk = cb[1];
#pragma unroll
              for (int tap = 0; tap < 4; ++tap) { const int ts = t - 3 + tap; if (ts >= 0) { const size_t g = (rowb + ts) * D + hh * 256 + c; yq += cw[0][tap] * bf2f(MLQ[g]); yk += cw[1][tap] * bf2f(MLK[g]); } }
              ql[tt * 256 + c] = yq / (1.0f + __expf(-yq)); kl[tt * 256 + c] = (yk / (1.0f + __expf(-yk))) * 0.0625f;
              vl[tt * 256 + c] = bf2f(MLV[(rowb + t) * D + hh * 256 + c]); }
          if (tid < 32) { il[tid] = F.ipre()[((size_t)b * 4 + hh) * SEQ + t0 + tid]; fl[tid] = F.lf()[((size_t)b * 4 + hh) * SEQ + t0 + tid]; } }
        __syncthreads();
        for (int tt = 0; tt < 32; ++tt) {
            const float lfv = fl[tt], iv = il[tt];
            const float mn = fmaxf(lfv + m, iv), fp = __expf(lfv + m - mn), ip = __expf(iv - mn); m = mn;
            const float vv = vl[tt * 256 + e] * ip;
            const LAS f32x4* kq = (const LAS f32x4*)(kl + tt * 256 + 128 * half); const LAS f32x4* qq = (const LAS f32x4*)(ql + tt * 256 + 128 * half);
            float num = 0.f;
#pragma unroll
            for (int i = 0; i < 32; ++i) { const f32x4 kv = kq[i], qv = qq[i];
                C[4 * i + 0] = fp * C[4 * i + 0] + kv.x * vv; C[4 * i + 1] = fp * C[4 * i + 1] + kv.y * vv; C[4 * i + 2] = fp * C[4 * i + 2] + kv.z * vv; C[4 * i + 3] = fp * C[4 * i + 3] + kv.w * vv;
                num += (qv.x * C[4 * i + 0] + qv.y * C[4 * i + 1]) + (qv.z * C[4 * i + 2] + qv.w * C[4 * i + 3]); }
            const int buf = tt & 1;
            if (tid < 256) { nreg = fp * nreg + ip * kl[tt * 256 + tid]; const float pd = wave_sum(ql[tt * 256 + tid] * nreg); if (F.lane == 0) red[buf * 4 + F.wave] = pd; }
            else part[buf * 256 + e] = num;
            __syncthreads();
            if (tid < 256) { num += part[buf * 256 + e]; const float den = (red[buf * 4 + 0] + red[buf * 4 + 1]) + (red[buf * 4 + 2] + red[buf * 4 + 3]);
                hl[tt * 256 + e] = num / fmaxf(fabsf(den), __expf(-m)); }
        }
        __syncthreads();
        for (int r = 0; r < 4; ++r) { const int tt = 4 * F.wave + r; const size_t row = rowb + t0 + tt;
            const f32x4 hv = *(const LAS f32x4*)(hl + tt * 256 + 4 * F.lane);
            const float ss = wave_sum((hv.x * hv.x + hv.y * hv.y) + (hv.z * hv.z + hv.w * hv.w));
            const float rstd = 1.0f / sqrtf(ss * (1.0f / 256.0f) + EPS);
            const int col = hh * 256 + 4 * F.lane; const f32x4 g = *(const f32x4*)(F.ml_norm_g() + col);
            const unsigned long long ow = *(const unsigned long long*)(MLO + row * D + col);
            const float o0 = bflo((unsigned)ow), o1 = bfhi((unsigned)ow), o2 = bflo((unsigned)(ow >> 32)), o3 = bfhi((unsigned)(ow >> 32));
            const float y0 = hv.x * rstd * g.x / (1.0f + __expf(-o0)), y1 = hv.y * rstd * g.y / (1.0f + __expf(-o1)), y2 = hv.z * rstd * g.z / (1.0f + __expf(-o2)), y3 = hv.w * rstd * g.w / (1.0f + __expf(-o3));
            *(unsigned long long*)(F.YB() + row * D + col) = (unsigned long long)pk2(y0, y1) | ((unsigned long long)pk2(y2, y3) << 32); }
    }
}


namespace ml {
typedef short bf16x8 __attribute__((ext_vector_type(8)));
typedef short s16x4 __attribute__((ext_vector_type(4)));
typedef float f32x16 __attribute__((ext_vector_type(16)));
typedef LAS const char* lcp;
typedef LAS char* lp_t;
constexpr int L = 64;
constexpr int O_QI = 0, O_KI = 33792, O_CB = 67584, O_VI = 102400, O_VW = 111616, O_PI = 120832, O_F = 130048;
constexpr int F_NV = 0, F_QNP = 256, F_RSP = 768, F_AT = 896, F_US = 960, F_WIN = 1024, F_EDEN = 1088, F_WST = 1152, F_RDEN = 1216, F_CW = 1280, F_CBIAS = 3328;
__device__ __forceinline__ int crow(int r, int hi) { return (r & 3) + 8 * (r >> 2) + 4 * hi; }
template <int PITCH, int XM> __device__ __forceinline__ int ioff(int row, int ch) { return XM ? PITCH * row + 16 * (ch ^ (row & XM)) : PITCH * row + 16 * ch; }
template <int PITCH, int XM> __device__ __forceinline__ bf16x8 frag_row(lcp img, int row0, int s, int lane) {
    return *(LAS const bf16x8*)(img + ioff<PITCH, XM>(row0 + (lane & 31), 2 * s + (lane >> 5)));
}
template <int PITCH, int XM> __device__ __forceinline__ bf16x8 frag_tr(lcp img, int k0, int ks, int col0, int lane) {
    const int h = lane >> 5, blk = (lane >> 4) & 1, q = (lane & 15) >> 2, p = lane & 3;
    const int r0 = k0 + 16 * ks + 8 * h + q, ch = (col0 >> 3) + 2 * blk + (p >> 1);
    typedef short v4i16_t __attribute__((ext_vector_type(4)));
    const s16x4 a = __builtin_bit_cast(s16x4, __builtin_amdgcn_ds_read_tr16_b64_v4i16((LAS v4i16_t*)(img + ioff<PITCH, XM>(r0, ch) + 8 * (p & 1))));
    const s16x4 b = __builtin_bit_cast(s16x4, __builtin_amdgcn_ds_read_tr16_b64_v4i16((LAS v4i16_t*)(img + ioff<PITCH, XM>(r0 + 4, ch) + 8 * (p & 1))));
    return (bf16x8){a[0], a[1], a[2], a[3], b[0], b[1], b[2], b[3]};
}
__device__ __forceinline__ float half_sum(float v) {
    const auto rr = __builtin_amdgcn_permlane32_swap(__builtin_bit_cast(unsigned, v), __builtin_bit_cast(unsigned, v), false, false);
    return __builtin_bit_cast(float, rr[0]) + __builtin_bit_cast(float, rr[1]);
}
__device__ __forceinline__ float silu_f(float y) { return y * __builtin_amdgcn_rcpf(1.0f + __expf(-y)); }

__device__ __forceinline__ void mlstm_unit(Frame& F, int unit) {
    const int bh = unit >> 2, sl = unit & 3, b = bh >> 2, hh = bh & 3, tid = opq(F.tid), lane = opq(F.lane), wave = F.wave, hi = lane >> 5, l31 = lane & 31;
    const bf16* MLQ = (const bf16*)F.out(); const bf16* MLK = MLQ + (size_t)T * D; const bf16* MLV = F.PROJ() + 5 * (SEG / 2);
    lp_t base = (lp_t)F.lds;
    LAS float* Fa = (LAS float*)(base + O_F);
    const size_t rowb = (size_t)b * SEQ;
    const float LOG2E = 1.4426950408889634f;
    __syncthreads();
    for (int i = tid; i < 34816 / 16; i += 512) ((LAS v4u*)(base + O_CB))[i] = (v4u){0u, 0u, 0u, 0u};
    if (tid < 256) Fa[F_NV + tid] = 0.f;
    f32x16 C0, C1, C2;
#pragma unroll
    for (int r = 0; r < 16; ++r) { C0[r] = 0.f; C1[r] = 0.f; C2[r] = 0.f; }
    if (tid < 64) *(LAS v4u*)(base + O_VW + 144 * tid + 128) = (v4u){0u, 0u, 0u, 0u};
    const int cg = tid & 31, rb = tid >> 5;
    v4u rawq[2][4], rawk[2][4], rawv[2]; float g_bb[2], g_us[2], g_pm[2]; float m_prev = 0.f;
#define ML_PREFETCH(T0, P) do { const int t0_ = (T0); \
        _Pragma("unroll") for (int i = 0; i < 4; ++i) { const unsigned g_ = (unsigned)(((int)rowb + t0_ + 4 * rb + i) * D + hh * 256 + cg * 8); \
            rawq[P][i] = *(const v4u*)(MLQ + g_); rawk[P][i] = *(const v4u*)(MLK + g_); } \
        rawv[P] = *(const v4u*)(MLV + (unsigned)(((int)rowb + t0_ + (tid >> 3)) * D + hh * 256 + 64 * sl + (tid & 7) * 8)); \
        { const float* gt_ = F.gt() + (unsigned)(((bh * (SEQ / L) + t0_ / L) * 3) * 64 + lane); g_bb[P] = gt_[0]; g_us[P] = gt_[64]; g_pm[P] = gt_[128]; } } while (0)
    ML_PREFETCH(0, 0); ML_PREFETCH(L, 1);
    __syncthreads();
    for (int chunk2 = 0; chunk2 < SEQ / L; chunk2 += 2) {
#pragma unroll
      for (int par = 0; par < 2; ++par) {
        const int chunk = chunk2 + par, t0 = chunk * L;
        const int tid = opq(F.tid), lane = tid & 63, hi = lane >> 5, l31 = lane & 31, cg = tid & 31, rb = tid >> 5, lo = lane;
        const float u = g_us[par], mm = g_bb[par] + fmaxf(m_prev, g_pm[par]), winter = __builtin_amdgcn_exp2f(g_bb[par] + m_prev - mm), at = g_bb[par] - mm, eden = __builtin_amdgcn_exp2f(-mm);
        const float bb63 = __builtin_bit_cast(float, __builtin_amdgcn_readlane(__builtin_bit_cast(int, g_bb[par]), 63)), mnew = __builtin_bit_cast(float, __builtin_amdgcn_readlane(__builtin_bit_cast(int, mm), 63));
        const float decay = __builtin_amdgcn_exp2f(bb63 + m_prev - mnew), wstate = __builtin_amdgcn_exp2f(bb63 - mnew + u); m_prev = mnew;
        if (wave == 0) { Fa[F_AT + lane] = at; Fa[F_US + lane] = u; Fa[F_WIN + lane] = winter; Fa[F_EDEN + lane] = eden; Fa[F_WST + lane] = wstate; }
#pragma unroll
        for (int j = 0; j < 4; ++j) { *(LAS v4u*)(base + O_QI + ioff<528, 0>(4 * rb + j, cg)) = rawq[par][j]; *(LAS v4u*)(base + O_KI + ioff<528, 0>(4 * rb + j, cg)) = rawk[par][j]; }
        { const int s = tid >> 3, ch = tid & 7; const v4u w = rawv[par];
          *(LAS v4u*)(base + O_VI + ioff<144, 0>(s, ch)) = w;
          const float ws = __shfl(wstate, s);
          v4u o; o.x = pk2(bflo(w.x) * ws, bfhi(w.x) * ws); o.y = pk2(bflo(w.y) * ws, bfhi(w.y) * ws); o.z = pk2(bflo(w.z) * ws, bfhi(w.z) * ws); o.w = pk2(bflo(w.w) * ws, bfhi(w.w) * ws);
          *(LAS v4u*)(base + O_VW + ioff<144, 0>(s, ch)) = o;
          if (ch == 0) *(LAS unsigned short*)(base + O_VW + 144 * s + 128) = (unsigned short)pk2(ws, 0.f); }
        __syncthreads();
        if (chunk + 2 < SEQ / L) ML_PREFETCH(t0 + 2 * L, par);
        __builtin_amdgcn_sched_barrier(0);
        f32x16 acc;
#pragma unroll
        for (int r = 0; r < 16; ++r) acc[r] = 0.f;
        const int wq = wave & 3, ta = wq >> 1, tb = wq & 1;
        if (wave < 4) {
#pragma unroll
            for (int kh = 0; kh < 2; ++kh) { bf16x8 fa[8], fb[8];
#pragma unroll
                for (int ks = 0; ks < 8; ++ks) { fa[ks] = frag_row<528, 0>(base + O_KI, 32 * tb, 8 * kh + ks, lo); fb[ks] = frag_row<528, 0>(base + O_QI, 32 * ta, 8 * kh + ks, lo); }
                __builtin_amdgcn_sched_barrier(0);
#pragma unroll
                for (int ks = 0; ks < 8; ++ks) acc = __builtin_amdgcn_mfma_f32_32x32x16_bf16(fa[ks], fb[ks], acc, 0, 0, 0);
                __builtin_amdgcn_sched_barrier(0); }
            const float at_l = __shfl(at, 32 * ta + l31); const int t = 32 * ta + l31; float rsum = 0.f;
#pragma unroll
            for (int g = 0; g < 4; ++g) { const int s0 = 32 * tb + 8 * g + 4 * hi; const f32x4 us4 = *(LAS const f32x4*)(Fa + F_US + s0); float p[4];
#pragma unroll
                for (int i = 0; i < 4; ++i) { p[i] = (s0 + i <= t) ? acc[4 * g + i] * __builtin_amdgcn_exp2f(at_l + us4[i]) : 0.f; rsum += p[i]; }
                *(LAS unsigned long long*)(base + O_PI + ioff<144, 0>(t, s0 >> 3) + 2 * (s0 & 7)) = (unsigned long long)pk2(p[0], p[1]) | ((unsigned long long)pk2(p[2], p[3]) << 32); }
            rsum = half_sum(rsum);
            if (hi == 0) Fa[F_RSP + tb * 64 + t] = rsum;
        } else {
#pragma unroll
            for (int kh = 0; kh < 2; ++kh) { bf16x8 fa[8], fb[8];
#pragma unroll
                for (int ks = 0; ks < 8; ++ks) { fa[ks] = frag_row<528, 0>(base + O_QI, 32 * ta, 8 * kh + ks, lo); fb[ks] = frag_tr<136, 0>(base + O_CB, 0, 8 * kh + ks, 32 * tb, lo); }
                __builtin_amdgcn_sched_barrier(0);
#pragma unroll
                for (int ks = 0; ks < 8; ++ks) acc = __builtin_amdgcn_mfma_f32_32x32x16_bf16(fa[ks], fb[ks], acc, 0, 0, 0);
                __builtin_amdgcn_sched_barrier(0); }
        }
        { float s = 0.f;
#pragma unroll
          for (int c = 0; c < 4; ++c) { const v4u w = *(LAS const v4u*)(base + O_QI + ioff<528, 0>(lane, 4 * wave + c)); const f32x4 n0 = *(LAS const f32x4*)(Fa + F_NV + 32 * wave + 8 * c), n1 = *(LAS const f32x4*)(Fa + F_NV + 32 * wave + 8 * c + 4);
              s += bflo(w.x) * n0.x + bfhi(w.x) * n0.y + bflo(w.y) * n0.z + bfhi(w.y) * n0.w + bflo(w.z) * n1.x + bfhi(w.z) * n1.y + bflo(w.w) * n1.z + bfhi(w.w) * n1.w; }
          Fa[F_QNP + wave * 64 + lane] = s; }
        __syncthreads();
        if (wave >= 4) {
            { const int t = 32 * ta + l31;
              const float den = Fa[F_WIN + t] * (((Fa[F_QNP + t] + Fa[F_QNP + 64 + t]) + (Fa[F_QNP + 128 + t] + Fa[F_QNP + 192 + t])) + ((Fa[F_QNP + 256 + t] + Fa[F_QNP + 320 + t]) + (Fa[F_QNP + 384 + t] + Fa[F_QNP + 448 + t])))
                                + Fa[F_RSP + t] + Fa[F_RSP + 64 + t];
              if (hi == 0) Fa[F_CW + 32 * (wave - 4) + l31] = 1.0f / fmaxf(fabsf(den), Fa[F_EDEN + t]); }
#pragma unroll
            for (int g = 0; g < 4; ++g) { const f32x4 w4 = *(LAS const f32x4*)(Fa + F_WIN + 32 * ta + 8 * g + 4 * hi); acc[4 * g] *= w4.x; acc[4 * g + 1] *= w4.y; acc[4 * g + 2] *= w4.z; acc[4 * g + 3] *= w4.w; }
            { bf16x8 fa[4], fb[4];
#pragma unroll
              for (int ks = 0; ks < 4; ++ks) { fa[ks] = frag_row<144, 0>(base + O_PI, 32 * ta, ks, lo); fb[ks] = frag_tr<144, 0>(base + O_VI, 0, ks, 32 * tb, lo); }
              __builtin_amdgcn_sched_barrier(0);
#pragma unroll
              for (int ks = 0; ks < 4; ++ks) acc = __builtin_amdgcn_mfma_f32_32x32x16_bf16(fa[ks], fb[ks], acc, 0, 0, 0); }
            bf16* dst = F.YB() + (rowb + t0 + 32 * ta) * D + hh * 256 + 64 * sl + 32 * tb + l31;
#pragma unroll
            for (int g = 0; g < 4; ++g) { const f32x4 r4 = *(LAS const f32x4*)(Fa + F_CW + 32 * (wave - 4) + 8 * g + 4 * hi);
#pragma unroll
                for (int i = 0; i < 4; ++i) dst[(size_t)(8 * g + 4 * hi + i) * D] = (bf16)pk2(acc[4 * g + i] * r4[i], 0.f); }
        }
#pragma unroll
        for (int r = 0; r < 16; ++r) { C0[r] *= decay; C1[r] *= decay; C2[r] *= decay; }
        { bf16x8 bk[4], v0[4], v1[4], v2[4];
#pragma unroll
          for (int ks = 0; ks < 4; ++ks) { bk[ks] = frag_tr<528, 0>(base + O_KI, 0, ks, 32 * wave, lo); v0[ks] = frag_tr<144, 0>(base + O_VW, 0, ks, 0, lo); v1[ks] = frag_tr<144, 0>(base + O_VW, 0, ks, 32, lo); v2[ks] = frag_tr<144, 0>(base + O_VW, 0, ks, 64, lo); }
          __builtin_amdgcn_sched_barrier(0);
#pragma unroll
          for (int ks = 0; ks < 4; ++ks) { C0 = __builtin_amdgcn_mfma_f32_32x32x16_bf16(v0[ks], bk[ks], C0, 0, 0, 0); C1 = __builtin_amdgcn_mfma_f32_32x32x16_bf16(v1[ks], bk[ks], C1, 0, 0, 0); C2 = __builtin_amdgcn_mfma_f32_32x32x16_bf16(v2[ks], bk[ks], C2, 0, 0, 0); }
          __builtin_amdgcn_sched_barrier(0); }
        { const int d = 32 * wave + l31;
#pragma unroll
          for (int g = 0; g < 4; ++g) { const int e0 = 8 * g + 4 * hi;
              *(LAS unsigned long long*)(base + O_CB + ioff<136, 0>(d, e0 >> 3) + 2 * (e0 & 7)) = (unsigned long long)pk2(C0[4 * g], C0[4 * g + 1]) | ((unsigned long long)pk2(C0[4 * g + 2], C0[4 * g + 3]) << 32);
              *(LAS unsigned long long*)(base + O_CB + ioff<136, 0>(d, (32 + e0) >> 3) + 2 * (e0 & 7)) = (unsigned long long)pk2(C1[4 * g], C1[4 * g + 1]) | ((unsigned long long)pk2(C1[4 * g + 2], C1[4 * g + 3]) << 32); }
          if (hi == 0) Fa[F_NV + d] = C2[0];
        }
        __syncthreads();
      }
    }
#undef ML_PREFETCH
}
}


__device__ __forceinline__ void mlstm_gates(Frame& F, int job) {
    const int lane = opq(F.lane); const float LOG2E = 1.4426950408889634f;
    const float lf2 = F.lf()[(size_t)job * ml::L + lane] * LOG2E, ii2 = F.ipre()[(size_t)job * ml::L + lane] * LOG2E;
    float bb = lf2;
#pragma unroll
    for (int o = 1; o < 64; o <<= 1) { const float v = __shfl_up(bb, o); bb += (lane >= o) ? v : 0.f; }
    const float u = ii2 - bb; float pm = u;
#pragma unroll
    for (int o = 1; o < 64; o <<= 1) { const float v = __shfl_up(pm, o); pm = (lane >= o) ? fmaxf(pm, v) : pm; }
    float* gt = F.gt() + (size_t)job * 3 * 64 + lane;
    gt[0] = bb; gt[64] = u; gt[128] = pm;
}

__device__ __forceinline__ void mlstm_conv_rows(Frame& F) {
    const int tid = opq(F.tid), cg = tid & 255, z = cg >> 7, c0 = (cg & 127) * 8, r0 = F.vcu * 128 + 64 * (tid >> 8);
    const bf16* src = F.PROJ() + (size_t)(3 + z) * (SEG / 2) + c0; bf16* dst = (bf16*)F.out() + (size_t)z * T * D + c0;
    float w[4][8], bs[8];
#pragma unroll
    for (int tap = 0; tap < 4; ++tap) { const f32x4 a0 = *(const f32x4*)(F.conv_w() + tap * 2048 + cg * 8), a1 = *(const f32x4*)(F.conv_w() + tap * 2048 + cg * 8 + 4);
        w[tap][0] = a0.x; w[tap][1] = a0.y; w[tap][2] = a0.z; w[tap][3] = a0.w; w[tap][4] = a1.x; w[tap][5] = a1.y; w[tap][6] = a1.z; w[tap][7] = a1.w; }
    { const f32x4 a0 = *(const f32x4*)(F.conv_b() + cg * 8), a1 = *(const f32x4*)(F.conv_b() + cg * 8 + 4);
      bs[0] = a0.x; bs[1] = a0.y; bs[2] = a0.z; bs[3] = a0.w; bs[4] = a1.x; bs[5] = a1.y; bs[6] = a1.z; bs[7] = a1.w; }
    const float osc = z ? 0.0625f : 1.0f;
    const bool seq_start = (r0 % SEQ) == 0;
    v4u x0, x1, x2;
    { const v4u zero = {0u, 0u, 0u, 0u};
      x0 = seq_start ? zero : *(const v4u*)(src + (size_t)(r0 - 3 + (seq_start ? 3 : 0)) * D);
      x1 = seq_start ? zero : *(const v4u*)(src + (size_t)(r0 - 2 + (seq_start ? 2 : 0)) * D);
      x2 = seq_start ? zero : *(const v4u*)(src + (size_t)(r0 - 1 + (seq_start ? 1 : 0)) * D); }
    v4u nxs[8];
#pragma unroll
    for (int i = 0; i < 8; ++i) nxs[i] = *(const v4u*)(src + (size_t)(r0 + i) * D);
    for (int rr = 0; rr < 64; rr += 8) {
        v4u xs[8];
#pragma unroll
        for (int i = 0; i < 8; ++i) xs[i] = nxs[i];
        if (rr + 8 < 64) {
#pragma unroll
            for (int i = 0; i < 8; ++i) nxs[i] = *(const v4u*)(src + (size_t)(r0 + rr + 8 + i) * D); }
#pragma unroll
        for (int i = 0; i < 8; ++i) {
            const v4u x3 = xs[i]; float y[8];
#pragma unroll
            for (int c = 0; c < 8; ++c) y[c] = bs[c];
#define MK_TAP(tap, X) do { y[0] += w[tap][0] * bflo(X.x); y[1] += w[tap][1] * bfhi(X.x); y[2] += w[tap][2] * bflo(X.y); y[3] += w[tap][3] * bfhi(X.y); \
                           y[4] += w[tap][4] * bflo(X.z); y[5] += w[tap][5] * bfhi(X.z); y[6] += w[tap][6] * bflo(X.w); y[7] += w[tap][7] * bfhi(X.w); } while (0)
            MK_TAP(0, x0); MK_TAP(1, x1); MK_TAP(2, x2); MK_TAP(3, x3);
#undef MK_TAP
#pragma unroll
            for (int c = 0; c < 8; ++c) y[c] = ml::silu_f(y[c]) * osc;
            v4u o; o.x = pk2(y[0], y[1]); o.y = pk2(y[2], y[3]); o.z = pk2(y[4], y[5]); o.w = pk2(y[6], y[7]);
            *(v4u*)(dst + (size_t)(r0 + rr + i) * D) = o;
            x0 = x1; x1 = x2; x2 = x3;
        }
    }
}

__device__ __forceinline__ void mlstm_norm_rows(Frame& F) {
    const int row0 = F.vcu * 128, lane = opq(F.lane);
    const bf16* MLO = F.PROJ() + 6 * (SEG / 2);
    f32x4 G[4];
#pragma unroll
    for (int j = 0; j < 4; ++j) G[j] = *(const f32x4*)(F.ml_norm_g() + 256 * j + 4 * lane);
    unsigned long long nh[4], no[4];
#define NR_LOAD(ROW) do { const size_t row_ = (ROW); const GAS unsigned long long* hp_ = (const GAS unsigned long long*)(F.YB() + row_ * D) + lane; const GAS unsigned long long* op_ = (const GAS unsigned long long*)(MLO + row_ * D) + lane; \
        _Pragma("unroll") for (int j = 0; j < 4; ++j) { nh[j] = hp_[64 * j]; no[j] = op_[64 * j]; } } while (0)
    NR_LOAD((size_t)row0 + 16 * F.wave);
    for (int r = 0; r < 16; ++r) {
        const size_t row = (size_t)row0 + 16 * F.wave + r;
        GAS unsigned* hp = (GAS unsigned*)((unsigned char*)F.YB8() + row * D) + lane;
        unsigned long long ch[4], co[4];
#pragma unroll
        for (int j = 0; j < 4; ++j) { ch[j] = nh[j]; co[j] = no[j]; }
        if (r < 15) NR_LOAD(row + 1);
#pragma unroll
        for (int j = 0; j < 4; ++j) { const unsigned long long hw = ch[j], ow = co[j];
            const float h0 = bflo((unsigned)hw), h1 = bfhi((unsigned)hw), h2 = bflo((unsigned)(hw >> 32)), h3 = bfhi((unsigned)(hw >> 32));
            const float ss = wave_sum((h0 * h0 + h1 * h1) + (h2 * h2 + h3 * h3)); const float rstd = 1.0f / sqrtf(ss * (1.0f / 256.0f) + EPS);
            const float o0 = bflo((unsigned)ow), o1 = bfhi((unsigned)ow), o2 = bflo((unsigned)(ow >> 32)), o3 = bfhi((unsigned)(ow >> 32));
            const float y0 = h0 * rstd * G[j].x / (1.0f + __expf(-o0)), y1 = h1 * rstd * G[j].y / (1.0f + __expf(-o1)), y2 = h2 * rstd * G[j].z / (1.0f + __expf(-o2)), y3 = h3 * rstd * G[j].w / (1.0f + __expf(-o3));
            hp[64 * j] = pg8::pk4_fp8(y0, y1, y2, y3); }
    }
#undef NR_LOAD
}

namespace at {
using ml::bf16x8; using ml::s16x4; using ml::f32x16; using ml::ioff; using ml::frag_row; using ml::lcp; using ml::lp_t;
typedef _Float16 f16x8 __attribute__((ext_vector_type(8)));
typedef _Float16 f16x2 __attribute__((ext_vector_type(2)));
typedef float f32x2 __attribute__((ext_vector_type(2)));
constexpr int O_KI = 0, O_VI = 8192, O_FLAG = 16384;
template <int PITCH, int XM> __device__ __forceinline__ bf16x8 frag_trp(lcp img, int ks, int col0, int lane) {
    const int h = lane >> 5, blk = (lane >> 4) & 1, q = (lane & 15) >> 2, p = lane & 3;
    const int r0 = 16 * ks + 4 * h + q, ch = (col0 >> 3) + 2 * blk + (p >> 1);
    typedef short v4i16_t __attribute__((ext_vector_type(4)));
    const s16x4 a = __builtin_bit_cast(s16x4, __builtin_amdgcn_ds_read_tr16_b64_v4i16((LAS v4i16_t*)(img + ioff<PITCH, XM>(r0, ch) + 8 * (p & 1))));
    const s16x4 b = __builtin_bit_cast(s16x4, __builtin_amdgcn_ds_read_tr16_b64_v4i16((LAS v4i16_t*)(img + ioff<PITCH, XM>(r0 + 8, ch) + 8 * (p & 1))));
    return (bf16x8){a[0], a[1], a[2], a[3], b[0], b[1], b[2], b[3]};
}
__device__ __forceinline__ unsigned pkh(float a, float b) { const f32x2 v = {a, b}; return __builtin_bit_cast(unsigned, __builtin_convertvector(v, f16x2)); }
__device__ __forceinline__ f16x8 h8(unsigned a, unsigned b, unsigned c, unsigned d) { const v4u v = {a, b, c, d}; return __builtin_bit_cast(f16x8, v); }
__device__ __forceinline__ bf16x8 b8(unsigned a, unsigned b, unsigned c, unsigned d) { const v4u v = {a, b, c, d}; return __builtin_bit_cast(bf16x8, v); }

__device__ __forceinline__ void attn_unit(Frame& F, int bh, int qb) {
    const int b = bh >> 4, hd = bh & 15, tid = opq(F.tid), lane = opq(F.lane), wave = F.wave, hi = lane >> 5, l31 = lane & 31, pr = wave >> 1, tp = tid & 127;
    const bf16* Q = F.PROJ(); const bf16* K = F.PROJ() + SEG / 2; const bf16* V = F.PROJ() + SEG;
    lp_t base = (lp_t)F.lds + pr * 16384;
    LAS volatile int* dflag = (LAS volatile int*)((lp_t)F.lds + 65536);
    const size_t rowb = (size_t)b * SEQ; const int q0 = qb * 256, tw0 = q0 + 32 * wave, t = tw0 + l31, kt0 = qb * 4 + pr;
    bf16x8 qr[4];
#pragma unroll
    for (int ks = 0; ks < 4; ++ks) qr[ks] = *(const bf16x8*)(Q + (rowb + t) * D + hd * 64 + 16 * ks + 8 * hi);
    unsigned uw[2][4];
#pragma unroll
    for (int sp = 0; sp < 2; ++sp)
#pragma unroll
        for (int jj = 0; jj < 4; ++jj) { const int j0 = 2 * jj, j1 = 2 * jj + 1;
            const int k0 = 16 * sp + 8 * (j0 >> 2) + 4 * hi + (j0 & 3), k1 = 16 * sp + 8 * (j1 >> 2) + 4 * hi + (j1 & 3);
            uw[sp][jj] = (k0 > l31 ? 0x3C00u : 0u) | (k1 > l31 ? 0x3C000000u : 0u); }
    const f16x8 U0 = h8(uw[0][0], uw[0][1], uw[0][2], uw[0][3]), U1 = h8(uw[1][0], uw[1][1], uw[1][2], uw[1][3]), ONES = h8(0x3C003C00u, 0x3C003C00u, 0x3C003C00u, 0x3C003C00u);
    f32x16 O0, O1;
#pragma unroll
    for (int r = 0; r < 16; ++r) { O0[r] = 0.f; O1[r] = 0.f; }
    float R = 0.f; bool wdone = false;
    v4u kreg[4], vreg[4];
#define AT_LOAD(KT) do { _Pragma("unroll") for (int j = 0; j < 4; ++j) { const size_t g = (rowb + (KT) * 64 + (tp >> 3) + 16 * j) * D + hd * 64 + (tp & 7) * 8; kreg[j] = *(const v4u*)(K + g); vreg[j] = *(const v4u*)(V + g); } } while (0)
    AT_LOAD(kt0);
    __syncthreads();
    if (tid < 8) dflag[tid] = 0;
    for (int it = 0; it <= qb * 4 + 3; ++it) {
        const int kt = kt0 - it;
        __syncthreads();
        { int nd = 0;
#pragma unroll
          for (int w = 0; w < 8; ++w) nd += dflag[w];
          if (nd == 8) break; }
        if (kt >= 0) {
#pragma unroll
            for (int j = 0; j < 4; ++j) { *(LAS v4u*)(base + O_KI + ioff<128, 7>((tp >> 3) + 16 * j, tp & 7)) = kreg[j]; *(LAS v4u*)(base + O_VI + ioff<128, 7>((tp >> 3) + 16 * j, tp & 7)) = vreg[j]; } }
        __syncthreads();
        if (kt > 0) AT_LOAD(kt - 1);
        if (kt < 0) { if (!wdone) { wdone = true; if (lane == 0) dflag[wave] = 1; } continue; }
        if (wdone) continue;
        int lo = lane; asm volatile("" : "+v"(lo));
        f32x16 p0, p1;
#pragma unroll
        for (int r = 0; r < 16; ++r) { p0[r] = 0.f; p1[r] = 0.f; }
#pragma unroll
        for (int ks = 0; ks < 4; ++ks) { p0 = __builtin_amdgcn_mfma_f32_32x32x16_bf16(frag_row<128, 7>(base + O_KI, 0, ks, lo), qr[ks], p0, 0, 0, 0);
                                         p1 = __builtin_amdgcn_mfma_f32_32x32x16_bf16(frag_row<128, 7>(base + O_KI, 32, ks, lo), qr[ks], p1, 0, 0, 0); }
        const bool diag = (it == 0);
        const int trel = t - 64 * kt;
        float lk00 = 0.f;
        unsigned lkw0[8], lkw1[8];
#pragma unroll
        for (int r = 0; r < 16; ++r) {
            const int key0 = ml::crow(r, hi);
            { const float z = p0[r], lb = fminf(z, 0.f) - __builtin_amdgcn_logf(1.0f + __builtin_amdgcn_exp2f(-fabsf(z))); float lk = lb - z; if (diag && !(key0 < trel)) lk = 0.f; p0[r] = lb; if (r == 0) lk00 = lk;
              if (r & 1) lkw0[r >> 1] = pkh(__builtin_bit_cast(float, lkw0[r >> 1]), lk); else lkw0[r >> 1] = __builtin_bit_cast(unsigned, lk); }
            { const float z = p1[r], lb = fminf(z, 0.f) - __builtin_amdgcn_logf(1.0f + __builtin_amdgcn_exp2f(-fabsf(z))); float lk = lb - z; if (diag && !(key0 + 32 < trel)) lk = 0.f; p1[r] = lb;
              if (r & 1) lkw1[r >> 1] = pkh(__builtin_bit_cast(float, lkw1[r >> 1]), lk); else lkw1[r >> 1] = __builtin_bit_cast(unsigned, lk); }
        }
        f32x16 bt1, bt0;
#pragma unroll
        for (int r = 0; r < 16; ++r) { bt1[r] = R; bt0[r] = R; }
        const f16x8 L10 = h8(lkw1[0], lkw1[1], lkw1[2], lkw1[3]), L11 = h8(lkw1[4], lkw1[5], lkw1[6], lkw1[7]), L00 = h8(lkw0[0], lkw0[1], lkw0[2], lkw0[3]), L01 = h8(lkw0[4], lkw0[5], lkw0[6], lkw0[7]);
        bt1 = __builtin_amdgcn_mfma_f32_32x32x16_f16(U0, L10, bt1, 0, 0, 0); bt1 = __builtin_amdgcn_mfma_f32_32x32x16_f16(U1, L11, bt1, 0, 0, 0);
        bt0 = __builtin_amdgcn_mfma_f32_32x32x16_f16(ONES, L10, bt0, 0, 0, 0); bt0 = __builtin_amdgcn_mfma_f32_32x32x16_f16(ONES, L11, bt0, 0, 0, 0);
        bt0 = __builtin_amdgcn_mfma_f32_32x32x16_f16(U0, L00, bt0, 0, 0, 0); bt0 = __builtin_amdgcn_mfma_f32_32x32x16_f16(U1, L01, bt0, 0, 0, 0);
        { const float v = bt0[0] + lk00;
          const auto rr = __builtin_amdgcn_permlane32_swap(__builtin_bit_cast(unsigned, v), __builtin_bit_cast(unsigned, v), false, false);
          R = __builtin_bit_cast(float, rr[0]); }
        unsigned aw0[8], aw1[8];
#pragma unroll
        for (int r = 0; r < 16; r += 2) {
            const int key0 = ml::crow(r, hi);
            float a00 = __builtin_amdgcn_exp2f(p0[r] + bt0[r]), a01 = __builtin_amdgcn_exp2f(p0[r + 1] + bt0[r + 1]), a10 = __builtin_amdgcn_exp2f(p1[r] + bt1[r]), a11 = __builtin_amdgcn_exp2f(p1[r + 1] + bt1[r + 1]);
            if (diag) { if (!(key0 < trel)) a00 = 0.f; if (!(key0 + 1 < trel)) a01 = 0.f; if (!(key0 + 32 < trel)) a10 = 0.f; if (!(key0 + 33 < trel)) a11 = 0.f; }
            aw0[r >> 1] = pk2(a00, a01); aw1[r >> 1] = pk2(a10, a11);
        }
        const bf16x8 A00 = b8(aw0[0], aw0[1], aw0[2], aw0[3]), A01 = b8(aw0[4], aw0[5], aw0[6], aw0[7]), A10 = b8(aw1[0], aw1[1], aw1[2], aw1[3]), A11 = b8(aw1[4], aw1[5], aw1[6], aw1[7]);
        O0 = __builtin_amdgcn_mfma_f32_32x32x16_bf16(A00, frag_trp<128, 7>(base + O_VI, 0, 0, lo), O0, 0, 0, 0);  O1 = __builtin_amdgcn_mfma_f32_32x32x16_bf16(A00, frag_trp<128, 7>(base + O_VI, 0, 32, lo), O1, 0, 0, 0);
        O0 = __builtin_amdgcn_mfma_f32_32x32x16_bf16(A01, frag_trp<128, 7>(base + O_VI, 1, 0, lo), O0, 0, 0, 0);  O1 = __builtin_amdgcn_mfma_f32_32x32x16_bf16(A01, frag_trp<128, 7>(base + O_VI, 1, 32, lo), O1, 0, 0, 0);
        O0 = __builtin_amdgcn_mfma_f32_32x32x16_bf16(A10, frag_trp<128, 7>(base + O_VI, 2, 0, lo), O0, 0, 0, 0);  O1 = __builtin_amdgcn_mfma_f32_32x32x16_bf16(A10, frag_trp<128, 7>(base + O_VI, 2, 32, lo), O1, 0, 0, 0);
        O0 = __builtin_amdgcn_mfma_f32_32x32x16_bf16(A11, frag_trp<128, 7>(base + O_VI, 3, 0, lo), O0, 0, 0, 0);  O1 = __builtin_amdgcn_mfma_f32_32x32x16_bf16(A11, frag_trp<128, 7>(base + O_VI, 3, 32, lo), O1, 0, 0, 0);
        if (__all(R < ATT_RTHR)) { wdone = true; if (lane == 0) dflag[wave] = 1; }
    }
#undef AT_LOAD
    __syncthreads();
    unsigned char* dst = (unsigned char*)F.YA() + (rowb + tw0) * D + hd * 64 + l31;
#pragma unroll
    for (int r = 0; r < 16; ++r) { const int q = ml::crow(r, hi); dst[(size_t)q * D] = (unsigned char)pg8::pk4_fp8(O0[r], 0.f, 0.f, 0.f); dst[(size_t)q * D + 32] = (unsigned char)pg8::pk4_fp8(O1[r], 0.f, 0.f, 0.f); }
}
}

__device__ __forceinline__ void p5a_route(Frame& F) {
    const int row0 = F.vcu * 128, b = row0 / SEQ, lane = opq(F.lane), tid = opq(F.tid);
    LAS float* wr = (LAS float*)F.lds;
    LAS int* le = (LAS int*)(F.lds + 131584); LAS int* lp = le + 512;
    LAS int* lcnt = (LAS int*)(F.LC + LC_LCNT); LAS int* gbase = (LAS int*)(F.LC + LC_GBASE);
    for (int idx = tid; idx < 32768; idx += 512) wr[(idx & 31) * 1028 + (idx >> 5)] = F.router_w()[idx];
    if (tid < 32) lcnt[tid] = 0;
    f32x4 Av[4], Bv[4];
#pragma unroll
    for (int j = 0; j < 4; ++j) { const int col = 4 * lane + 256 * j; const float* mb = F.mod() + (size_t)b * NMOD;
        const f32x4 g = *(const f32x4*)(F.norm2_g() + col); Av[j] = g * (*(const f32x4*)(mb + 4 * D + col) + 1.0f); Bv[j] = *(const f32x4*)(mb + 3 * D + col); }
    float rb[32];
#pragma unroll
    for (int e = 0; e < 32; ++e) rb[e] = F.router_b()[e];
    __syncthreads();
    f32x4 nx[4];
    { const GAS f32x4* xr = (const GAS f32x4*)(F.out() + (size_t)(row0 + 16 * F.wave) * D) + lane;
#pragma unroll
      for (int j = 0; j < 4; ++j) nx[j] = xr[64 * j]; }
    for (int r = 0; r < 16; ++r) {
        const int rl = 16 * F.wave + r, row = row0 + rl;
        f32x4 v[4]; float ss = 0.f;
#pragma unroll
        for (int j = 0; j < 4; ++j) { v[j] = nx[j]; ss += (v[j].x * v[j].x + v[j].y * v[j].y) + (v[j].z * v[j].z + v[j].w * v[j].w); }
        if (r < 15) { const GAS f32x4* xr = (const GAS f32x4*)(F.out() + (size_t)(row + 1) * D) + lane;
#pragma unroll
            for (int j = 0; j < 4; ++j) nx[j] = xr[64 * j]; }
        const float rstd = 1.0f / sqrtf(wave_sum(ss) * (1.0f / D) + EPS);
        { GAS unsigned* o4 = (GAS unsigned*)((unsigned char*)F.H2() + (size_t)row * D) + lane;
#pragma unroll
          for (int j = 0; j < 4; ++j) { v[j] = v[j] * rstd * Av[j] + Bv[j]; o4[64 * j] = pg8::pk4_fp8(v[j].x, v[j].y, v[j].z, v[j].w); } }
        float p[32];
#pragma unroll
        for (int e = 0; e < 32; ++e) { float s = 0.f;
#pragma unroll
            for (int j = 0; j < 4; ++j) { const f32x4 w = *(const LAS f32x4*)(wr + e * 1028 + 4 * lane + 256 * j); s += (v[j].x * w.x + v[j].y * w.y) + (v[j].z * w.z + v[j].w * w.w); }
            p[e] = s; }
#pragma unroll
        for (int i = 0; i < 16; ++i) { const bool up = (lane & 32) != 0; const float send = up ? p[i] : p[i + 16], keep = up ? p[i + 16] : p[i]; p[i] = keep + __shfl_xor(send, 32); }
#pragma unroll
        for (int i = 0; i < 8; ++i) { const bool up = (lane & 16) != 0; const float send = up ? p[i] : p[i + 8], keep = up ? p[i + 8] : p[i]; p[i] = keep + __shfl_xor(send, 16); }
#pragma unroll
        for (int i = 0; i < 4; ++i) { const bool up = (lane & 8) != 0; const float send = up ? p[i] : p[i + 4], keep = up ? p[i + 4] : p[i]; p[i] = keep + __shfl_xor(send, 8); }
#pragma unroll
        for (int i = 0; i < 2; ++i) { const bool up = (lane & 4) != 0; const float send = up ? p[i] : p[i + 2], keep = up ? p[i + 2] : p[i]; p[i] = keep + __shfl_xor(send, 4); }
        { const bool up = (lane & 2) != 0; const float send = up ? p[0] : p[1], keep = up ? p[1] : p[0]; p[0] = keep + __shfl_xor(send, 2); }
        p[0] += __shfl_xor(p[0], 1);
        { LAS float* lg = (LAS float*)(F.lds + 135680) + F.wave * 32;
          if ((lane & 1) == 0) lg[lane >> 1] = p[0];
#pragma unroll
          for (int q = 0; q < 8; ++q) { const f32x4 t4 = *(const LAS f32x4*)(lg + 4 * q); p[4 * q] = t4.x + rb[4 * q]; p[4 * q + 1] = t4.y + rb[4 * q + 1]; p[4 * q + 2] = t4.z + rb[4 * q + 2]; p[4 * q + 3] = t4.w + rb[4 * q + 3]; } }
        int sel[4]; float sv[4]; unsigned used = 0u;
#pragma unroll
        for (int k = 0; k < 4; ++k) { float best = -3.0e38f; int bi = 0;
#pragma unroll
            for (int e = 0; e < 32; ++e) { const bool cnd = (((used >> e) & 1u) == 0u) && (p[e] > best); best = cnd ? p[e] : best; bi = cnd ? e : bi; }
            sel[k] = bi; sv[k] = best; used |= 1u << bi; }
        const float e1 = __expf(sv[1] - sv[0]), e2 = __expf(sv[2] - sv[0]), e3 = __expf(sv[3] - sv[0]), inv = 1.0f / (1.0f + e1 + e2 + e3);
        if (lane < 4) { const int ek = lane == 0 ? sel[0] : lane == 1 ? sel[1] : lane == 2 ? sel[2] : sel[3];
            const float wk = (lane == 0 ? 1.0f : lane == 1 ? e1 : lane == 2 ? e2 : e3) * inv;
            const int pos = __hip_atomic_fetch_add(lcnt + ek, 1, __ATOMIC_RELAXED, __HIP_MEMORY_SCOPE_WORKGROUP);
            le[rl * 4 + lane] = ek; lp[rl * 4 + lane] = pos; F.tokw()[(size_t)row * 4 + lane] = wk; }
        if (lane == 0) F.rstd2()[row] = rstd;
    }
    __syncthreads();
    if (tid < 32) gbase[tid] = (int)__hip_atomic_fetch_add(F.ctl + CW_ECNT + 64 * tid, (unsigned)lcnt[tid], __ATOMIC_RELAXED, __HIP_MEMORY_SCOPE_AGENT);
    __syncthreads();
    { const int ek = le[tid]; F.toke()[(size_t)row0 * 4 + tid] = ek; F.tokp()[(size_t)row0 * 4 + tid] = lp[tid] + gbase[ek]; }
}

__device__ __forceinline__ void p5b_tables(Frame& F) {
    const int row0 = F.vcu * 128, tid = opq(F.tid);
    LAS int* ts = (LAS int*)(F.LC + LC_TS); LAS int* ps = (LAS int*)(F.LC + LC_PS); LAS int* cn = (LAS int*)(F.LC + LC_CNT);
    if (tid < 32) cn[tid] = (int)__hip_atomic_load(F.ctl + CW_ECNT + 64 * tid, RLX_AGENT);
    __syncthreads();
    if (tid == 0) { int run = 0, trun = 0; for (int e = 0; e < 32; ++e) { ps[e] = run; ts[e] = trun; const int nt = (cn[e] + 255) >> 8; run += nt * 256; trun += nt; } ts[32] = trun; }
    __syncthreads();
    { const size_t idx = (size_t)row0 * 4 + tid; const int ek = F.toke()[idx], dst = ps[ek] + F.tokp()[idx]; F.tokrow()[idx] = dst; F.row2tok()[dst] = row0 + (tid >> 2); }
    if (F.vcu < 32) { const int e = F.vcu, start = ps[e] + cn[e], end = ps[e] + (((cn[e] + 255) >> 8) << 8); for (int r = start + tid; r < end; r += 512) F.row2tok()[r] = 0; }
}

__device__ __forceinline__ void p8_combine(Frame& F, bool poison) {
    const int row0 = F.vcu * 128, b = row0 / SEQ, lane = opq(F.lane);
    f32x4 G2[4], FG[4];
#pragma unroll
    for (int j = 0; j < 4; ++j) { const int col = 4 * lane + 256 * j; G2[j] = *(const f32x4*)(F.mod() + (size_t)b * NMOD + 5 * D + col); FG[j] = *(const f32x4*)(F.final_g() + col); }
    f32x4 nx[4]; unsigned long long ng[4][4]; float nw[4];
#define P8_LOAD(ROW) do { const size_t row_ = (ROW); const GAS f32x4* xr_ = (const GAS f32x4*)(F.out() + row_ * D) + lane; \
        _Pragma("unroll") for (int j = 0; j < 4; ++j) nx[j] = xr_[64 * j]; \
        _Pragma("unroll") for (int k = 0; k < 4; ++k) { const int src_ = F.tokrow()[row_ * 4 + k]; nw[k] = F.tokw()[row_ * 4 + k]; \
            const GAS unsigned long long* s8_ = (const GAS unsigned long long*)(F.OUTR() + (size_t)src_ * D) + lane; \
            _Pragma("unroll") for (int j = 0; j < 4; ++j) ng[k][j] = s8_[64 * j]; } } while (0)
    P8_LOAD((size_t)row0 + 16 * F.wave);
    for (int r = 0; r < 16; ++r) {
        const int row = row0 + 16 * F.wave + r;
        GAS f32x4* xr = (GAS f32x4*)(F.out() + (size_t)row * D) + lane;
        f32x4 y[4], xv[4];
#pragma unroll
        for (int j = 0; j < 4; ++j) { y[j] = (f32x4){0.f, 0.f, 0.f, 0.f}; xv[j] = nx[j]; }
#pragma unroll
        for (int k = 0; k < 4; ++k) { const float wk = nw[k];
#pragma unroll
            for (int j = 0; j < 4; ++j) { const unsigned long long w = ng[k][j]; y[j].x += wk * bflo((unsigned)w); y[j].y += wk * bfhi((unsigned)w); y[j].z += wk * bflo((unsigned)(w >> 32)); y[j].w += wk * bfhi((unsigned)(w >> 32)); } }
        if (r < 15) P8_LOAD((size_t)row + 1);
        f32x4 v[4]; float ss = 0.f;
#pragma unroll
        for (int j = 0; j < 4; ++j) { v[j] = xv[j] + G2[j] * y[j]; ss += (v[j].x * v[j].x + v[j].y * v[j].y) + (v[j].z * v[j].z + v[j].w * v[j].w); }
        const float rstd = 1.0f / sqrtf(wave_sum(ss) * (1.0f / D) + EPS);
        const float qn = __builtin_nanf("");
#pragma unroll
        for (int j = 0; j < 4; ++j) { f32x4 o = v[j] * rstd * FG[j]; if (poison) o = (f32x4){qn, qn, qn, qn}; xr[64 * j] = o; }
    }
#undef P8_LOAD
}

#ifndef MK_REP_G2
#define MK_REP_G2 1
#endif
#ifndef MK_REP_G4A
#define MK_REP_G4A 1
#endif
#ifndef MK_REP_G4B
#define MK_REP_G4B 1
#endif
#ifndef MK_REP_G4C
#define MK_REP_G4C 1
#endif
#ifndef MK_REP_G6
#define MK_REP_G6 1
#endif
#ifndef MK_REP_G7
#define MK_REP_G7 1
#endif
#ifndef MK_REP_P0
#define MK_REP_P0 1
#endif
#ifndef MK_REP_P3
#define MK_REP_P3 1
#endif
struct Args { const float* in[22]; float* out; unsigned char* ws; };
__global__ void __launch_bounds__(NWAVES * 64, 2) mk_fwd(Args args) {
    extern __shared__ __attribute__((aligned(16))) unsigned char lds[];
    Frame F;
    F.lds = (LAS unsigned char*)lds; F.LC = (volatile LAS unsigned*)(F.lds + LDSCTL_OFF);
    F.tid = threadIdx.x; F.lane = F.tid & 63; F.wave = __builtin_amdgcn_readfirstlane(F.tid >> 6);
    F.G = gridDim.x; { const int bx = blockIdx.x; F.vcu = (F.G % 8 == 0) ? (bx % 8) * (F.G / 8) + bx / 8 : bx; }
    F.ws = (unsigned char*)(GAS unsigned char*)karg(23);
    F.ctl = (gu32*)(F.ws + WS_CTL);
    for (int u = F.tid; u < (LDS_BYTES - LDSCTL_OFF) / 4; u += NWAVES * 64) ((LAS unsigned*)(F.lds + LDSCTL_OFF))[u] = 0u;
    __syncthreads();
    XcdBarrier bar = xcd_barrier_post((unsigned*)(F.ctl + CW_BAR), F.LC + LC_BAR);
#define GRID_BAR() xcd_barrier(bar)
    const int G = F.G, cid = (int)blockIdx.x;

    for (int rep_ = 0; rep_ < MK_REP_P0; ++rep_) p0_prologue(F);
    GRID_BAR();
    p1_rows(F);
    GRID_BAR();
    { pg8::Gemm g{F.H1(), F.WIN_T(), T, NPROJ, D / 2}; pg8::StaticOrder S; S.init(T, NPROJ, G, cid);
      pg8::EpiBf16<0> E{F.PROJ(), D, nullptr, D, SEG / 2, QSCALE, 1.0f / W8SCALE};
      for (int rep_ = 0; rep_ < MK_REP_G2; ++rep_) pg8::gemm_phase<pg8::EpiBf16<0>, pg8::StaticOrder, true, true, false, true>(F.lds, g, S, E); }
    GRID_BAR();
    for (int job = F.vcu * NWAVES + F.wave; job < BATCH * 4 * (SEQ / 64); job += G * NWAVES) mlstm_gates(F, job);
    mlstm_conv_rows(F);
    GRID_BAR();
#if defined(MK_NAIVE_MLSTM)
    for (int it = F.vcu; it < 1024; it += G) attn_naive_item(F, it & 255, it >> 8);
    __syncthreads();
    for (int it = F.vcu; it < 64; it += G) mlstm_naive_item(F, it);
#else
    for (int rep_ = 0; rep_ < MK_REP_P3; ++rep_) {
    for (int it = F.vcu; it < 256; it += G) ml::mlstm_unit(F, it);
    __syncthreads();
#if defined(MK_NAIVE_ATTN)
    for (int it = F.vcu; it < 1024; it += G) attn_naive_item(F, it & 255, it >> 8);
#else
    for (int it = F.vcu; it < 2048; it += G) at::attn_unit(F, it & 255, it >> 8);
#endif
    }
#endif
    GRID_BAR();
    { pg8::Gemm g{F.YA(), F.WA_T(), T, D, D / 2}; pg8::StaticOrder S; S.init(T, D, G, cid);
      pg8::EpiGate<false> E{F.PROJ() + 7 * (SEG / 2), nullptr, F.M1(), 1.0f / W8SCALE};
      for (int rep_ = 0; rep_ < MK_REP_G4A; ++rep_) pg8::gemm_phase<pg8::EpiGate<false>, pg8::StaticOrder, true, true, false, true>(F.lds, g, S, E); }
#if defined(MK_NAIVE_MLSTM)
    VM_WAIT(); __syncthreads();
#else
    __syncthreads();
    mlstm_norm_rows(F);
    GRID_BAR();
#endif
    { pg8::Gemm g{F.YB8(), F.WB_T(), T, D, D / 2}; pg8::StaticOrder S; S.init(T, D, G, cid);
      pg8::EpiGate<true, true> E{F.PROJ() + 8 * (SEG / 2), F.M1(), F.MERGED(), 1.0f / W8SCALE};
      for (int rep_ = 0; rep_ < MK_REP_G4B; ++rep_) pg8::gemm_phase<pg8::EpiGate<true, true>, pg8::StaticOrder, true, true, false, true>(F.lds, g, S, E); }
    GRID_BAR();
    { pg8::Gemm g{F.MERGED(), F.WOUT_T(), T, D, D / 2}; pg8::StaticOrder S; S.init(T, D, G, cid);
      pg8::EpiResid E{F.x(), F.mod() + 2 * D, F.out(), SEQ, NMOD, 1.0f / W8SCALE};
      for (int rep_ = 0; rep_ < MK_REP_G4C; ++rep_) pg8::gemm_phase<pg8::EpiResid, pg8::StaticOrder, true, true, false, true>(F.lds, g, S, E); }
    GRID_BAR();
    p5a_route(F);
    GRID_BAR();
    p5b_tables(F);
    GRID_BAR();
    { pg8::Gemm g{F.H2(), F.W1_T(), T, NE * 2048, D / 2}; pg8::GroupedOrder S{(const LAS int*)(F.LC + LC_TS), 8, G, cid, F.row2tok()};
      pg8::EpiSwiglu<true> E{F.b1(), F.ACT(), 1.0f / W8SCALE};
      for (int rep_ = 0; rep_ < MK_REP_G6; ++rep_) pg8::gemm_phase<pg8::EpiSwiglu<true>, pg8::GroupedOrder, true, true, true, true>(F.lds, g, S, E); }
    GRID_BAR();
    { pg8::Gemm g{F.ACT(), F.W2_T(), XS_ROWS, NE * 1024, D / 2}; pg8::GroupedOrder S{(const LAS int*)(F.LC + LC_TS), 4, G, cid, nullptr};
      pg8::EpiOutS E{F.OUTR(), F.b2(), 1.0f / W8SCALE};
      for (int rep_ = 0; rep_ < MK_REP_G7; ++rep_) pg8::gemm_phase<pg8::EpiOutS, pg8::GroupedOrder, true, true, false, true>(F.lds, g, S, E); }
    GRID_BAR();
    { const bool poison = __hip_atomic_load(F.ctl + CW_BAR + XB_TMO, RLX_AGENT) != 0u;
      p8_combine(F, poison); }
}

extern "C" void kernel_launch(void* const* d_in, const int* in_sizes, int n_in, void* d_out, int out_size, void* d_ws, size_t ws_size, hipStream_t stream) {
    static int grid = 0;
    if (grid == 0) {
        if (n_in != 22 || in_sizes[0] != T * D || out_size != T * D || ws_size < WS_END) { fprintf(stderr, "kernel_launch: unexpected shapes (n_in %d, in0 %d, out %d, ws %zu)\n", n_in, n_in > 0 ? in_sizes[0] : -1, out_size, ws_size); grid = -1; return; }
        int dev = 0, cus = 0, per_cu = 0;
        if (hipGetDevice(&dev) != hipSuccess || hipDeviceGetAttribute(&cus, hipDeviceAttributeMultiprocessorCount, dev) != hipSuccess) { grid = -1; return; }
        if (hipFuncSetAttribute((const void*)mk_fwd, hipFuncAttributeMaxDynamicSharedMemorySize, LDS_BYTES) != hipSuccess) { fprintf(stderr, "kernel_launch: hipFuncSetAttribute failed\n"); grid = -1; return; }
        if (hipOccupancyMaxActiveBlocksPerMultiprocessor(&per_cu, (const void*)mk_fwd, NWAVES * 64, LDS_BYTES) != hipSuccess || per_cu < 1) { fprintf(stderr, "kernel_launch: occupancy query says %d blocks per CU\n", per_cu); }
        (void)hipGetLastError();
        if (cus < 256) { fprintf(stderr, "kernel_launch: built for a 256-CU device, found %d CUs\n", cus); grid = -1; return; }
        grid = 256;
    }
    if (grid < 0) return;
    if (hipMemsetAsync((char*)d_ws + WS_CTL, 0, CTL_ZERO_BYTES, stream) != hipSuccess) return;
    Args a{};
    for (int i = 0; i < 22; ++i) a.in[i] = (const float*)d_in[i];
    a.out = (float*)d_out; a.ws = (unsigned char*)d_ws;
    hipLaunchKernelGGL(mk_fwd, dim3(grid), dim3(NWAVES * 64), LDS_BYTES, stream, a);
}
```

```cpp
#include <hip/hip_runtime.h>
#include <cstdio>
#include <cstdint>
namespace pg8 {
#define PG8_LAS __attribute__((address_space(3)))
typedef unsigned short bf16_t;
typedef short bf16x8 __attribute__((ext_vector_type(8)));
typedef float f32x4 __attribute__((ext_vector_type(4)));
typedef unsigned u32x4 __attribute__((ext_vector_type(4)));
typedef int i32x4_ __attribute__((ext_vector_type(4))); typedef int i32x8_ __attribute__((ext_vector_type(8)));
constexpr int BM = 256, BK = 64, HALF = 128, HTB = HALF * BK * 2  , STAGE_BYTES = 8 * HTB, NXCD = 8, WGM = 8;

__host__ __device__ __forceinline__ int lds_byte(int r, int c) { const int st = (r >> 4) * 2 + (c >> 5), rr = r & 15, cc = c & 31, ob = rr * 64 + cc * 2; return st * 1024 + (ob ^ (((ob >> 9) & 1) << 5)); }
__host__ __device__ __forceinline__ void stage_rc(int b, int& R, int& C) { const int st = b / 1024, sb = b % 1024, swz = sb ^ (((sb >> 9) & 1) << 5); R = (st >> 1) * 16 + swz / 64; C = (st & 1) * 32 + (swz % 64) / 2; }
__host__ __device__ __forceinline__ int perm32(int rho) { const int n = rho >> 4, i = rho & 15; return 8 * (i >> 2) + 4 * n + (i & 3); }

struct Unit { int pm, pn; };
struct Gemm { const bf16_t* A; const bf16_t* Bt; int M, N, K; };

struct StaticOrder {
    int nM, nN, nwg, G, c;
    __host__ __device__ void init(int M, int N, int G_, int c_) { nM = M / BM; nN = N / BM; nwg = nM * nN; G = G_; c = c_; }
    __host__ __device__ bool next(int i, Unit& u) const {
        const long L = (long)i * G + c; if (L >= nwg) return false;
        int wgid = (int)L; { const int q = nwg / NXCD, r = nwg % NXCD, xcd = wgid % NXCD, off = wgid / NXCD; wgid = (xcd < r ? xcd * (q + 1) : r * (q + 1) + (xcd - r) * q) + off; }
        const int nig = WGM * nN, gid = wgid / nig, fm = gid * WGM, gsz = (nM - fm) < WGM ? (nM - fm) : WGM;
        u.pm = fm + ((wgid % nig) % gsz); u.pn = (wgid % nig) / gsz; return true;
    }
    __device__ __forceinline__ void a_ready(const Unit&) const {}
    __device__ __forceinline__ void done(const Unit&) const {}
};

__device__ __forceinline__ unsigned cvt_pk_bf16(float lo, float hi) { unsigned r; asm volatile("v_cvt_pk_bf16_f32 %0, %1, %2" : "=v"(r) : "v"(lo), "v"(hi)); return r; }
typedef float f32x2 __attribute__((ext_vector_type(2)));
__device__ __forceinline__ f32x2 gelu_pk(f32x2 v) {
    const f32x2 av = __builtin_elementwise_abs(v), d = av * 0.2316418882f + 1.0f;
    f32x2 t; t.x = __builtin_amdgcn_rcpf(d.x); t.y = __builtin_amdgcn_rcpf(d.y);
    f32x2 q = t * 0.5307027145f + (-0.7265760135f); q = q * t + 0.7107068705f; q = q * t + (-0.142248368f); q = q * t + 0.127414796f; q = q * t;
    const f32x2 s = (v * v) * (-0.72134752044f);
    f32x2 e; e.x = __builtin_amdgcn_exp2f(s.x); e.y = __builtin_amdgcn_exp2f(s.y);
    const f32x2 m = v * (q * e), r = v - m;
    f32x2 o; o.x = v.x < 0.f ? m.x : r.x; o.y = v.y < 0.f ? m.y : r.y; return o;
}

__device__ __forceinline__ void xchg8(const u32x4& w0, const u32x4& w1, u32x4& d1, u32x4& d2) {
#pragma unroll
    for (int i = 0; i < 4; ++i) {
        d1[i] = (unsigned)__builtin_amdgcn_update_dpp((int)w0[i], (int)w1[i], 0x128, 0xf, 0xc, false);
        d2[i] = (unsigned)__builtin_amdgcn_update_dpp((int)w1[i], (int)w0[i], 0x128, 0xf, 0x3, false);
    }
}
template <int ACT  > struct EpiBf16 {
    static constexpr bool PERM = true, PERM2 = true, AFTER_DRAIN = false; static_assert(ACT == 0 || ACT == 1, "EpiBf16: ACT is 0 (none) or 1 (gelu_pk)");
    bf16_t* O; int ldc; const float* bias; int split_cols; size_t split_stride; float scale0; float ascale;
    __device__ __forceinline__ void operator()(const f32x4 (&acc)[2][2][4][2], const Unit& u, int wr, int wc, int fr, int fq) const {
        int colt = u.pn * BM; bf16_t* base = O;
        float sc = ascale; if (split_cols) { const int t = colt / split_cols; base += (size_t)t * split_stride; colt -= t * split_cols; if (t == 0) sc = scale0 * ascale; }
        const int bcol0 = u.pn * BM + wc * 64 + 16 * fq;
        f32x4 bv[2][2];
#pragma unroll
        for (int bj = 0; bj < 2; ++bj)
#pragma unroll
            for (int n = 0; n < 2; ++n) bv[bj][n] = bias ? *(const f32x4*)(bias + bcol0 + 8 * bj + 4 * n) : (f32x4){0.f, 0.f, 0.f, 0.f};
        bf16_t* lp = base + (size_t)(u.pm * BM + wr * 64 + (fr & 7)) * ldc + colt + wc * 64 + 16 * fq + 8 * (fr >> 3);
#pragma unroll
        for (int ai = 0; ai < 2; ++ai)
#pragma unroll
            for (int m = 0; m < 4; ++m) { u32x4 w[2];
#pragma unroll
                for (int bj = 0; bj < 2; ++bj) { f32x4 v0 = acc[ai][bj][m][0] + bv[bj][0], v1 = acc[ai][bj][m][1] + bv[bj][1];
                    if (ACT == 1) { f32x2 a = gelu_pk((f32x2){v0[0], v0[1]}), b = gelu_pk((f32x2){v0[2], v0[3]}), c = gelu_pk((f32x2){v1[0], v1[1]}), d = gelu_pk((f32x2){v1[2], v1[3]});
                        v0 = (f32x4){a.x, a.y, b.x, b.y}; v1 = (f32x4){c.x, c.y, d.x, d.y}; }
                    v0 = v0 * sc; v1 = v1 * sc; w[bj].x = cvt_pk_bf16(v0[0], v0[1]); w[bj].y = cvt_pk_bf16(v0[2], v0[3]); w[bj].z = cvt_pk_bf16(v1[0], v1[1]); w[bj].w = cvt_pk_bf16(v1[2], v1[3]); }
                u32x4 d1, d2; xchg8(w[0], w[1], d1, d2);
                bf16_t* rowp = lp + (size_t)(ai * HALF + m * 16) * ldc;
                __builtin_nontemporal_store(d1, (u32x4*)rowp); __builtin_nontemporal_store(d2, (u32x4*)(rowp + (size_t)8 * ldc)); }
    }
};
template <class Epi, class Sched, bool ALIGN_EPI = false, bool SP2 = false, bool GATHER = false, bool FP8 = false>
__device__ __forceinline__ void gemm_phase(PG8_LAS unsigned char* lds, const Gemm g, const Sched& S, const Epi& E) {
    int tid_ = threadIdx.x; asm volatile("" : "+v"(tid_));
    const int tid = tid_, wid = __builtin_amdgcn_readfirstlane(tid >> 6), lane = tid & 63, wr = wid >> 2, wc = wid & 3, fr = lane & 15, fq = lane >> 4;
    const int K = g.K, nt = K / BK;
    unsigned voffA[2], voffB[2], vA0[2], vA1[2], vN0[2], vN1[2]; int Rr_[2], Cc_[2];
#pragma unroll
    for (int i = 0; i < 2; ++i) { int R, C; stage_rc(tid * 16 + i * 8192, R, C); const int Rb = Epi::PERM2 ? (64 * (R >> 5) + 16 * ((R >> 2) & 3) + 4 * ((R >> 4) & 1) + (R & 3)) : (Epi::PERM ? ((R & ~31) + perm32(R & 31)) : R);
        voffA[i] = (unsigned)(R * K + C) * 2u; voffB[i] = (unsigned)(Rb * K + C) * 2u; Rr_[i] = R; Cc_[i] = C; }
    const size_t kstep = (size_t)(BK * 2);
    const size_t hstep = (size_t)HALF * K * 2;
    const size_t tstep = 2 * hstep;
    const size_t bhstep = Epi::PERM2 ? (size_t)8 * K * 2 : hstep;
#pragma unroll
    for (int i = 0; i < 2; ++i) { vA0[i] = voffA[i]; vA1[i] = voffA[i] + (unsigned)hstep; vN0[i] = vA0[i]; vN1[i] = vA1[i]; }
#define PG8_GLOAD(u, v0, v1) do { _Pragma("unroll") for (int _i = 0; _i < 2; ++_i) { const int _t0 = S.rowtok[(u).pm * BM + Rr_[_i]], _t1 = S.rowtok[(u).pm * BM + HALF + Rr_[_i]]; \
        (v0)[_i] = (unsigned)_t0 * (unsigned)(K * 2) + (unsigned)(Cc_[_i] * 2); (v1)[_i] = (unsigned)_t1 * (unsigned)(K * 2) + (unsigned)(Cc_[_i] * 2); } } while (0)
    const unsigned ldsw = (unsigned)wid * 1024u;
    const int aoff = lds_byte(wr * 64 + fr, fq * 8), boff = lds_byte(wc * 32 + fr, fq * 8);
#define PG8_SA(b, h) (((b) * 2 + (h)) * HTB)
#define PG8_SB(b, h) ((4 + (b) * 2 + (h)) * HTB)
#define PG8_STAGE(bufoff, gbase, voff) do { _Pragma("unroll") for (int _i = 0; _i < 2; ++_i) \
        __builtin_amdgcn_global_load_lds((const unsigned*)((const char*)(gbase) + (voff)[_i]), (PG8_LAS unsigned*)(lds + (bufoff) + ldsw + _i * 8192), 16, 0, 0); } while (0)
#define PG8_LDA(dst, b, h) do { _Pragma("unroll") for (int m = 0; m < 4; ++m) _Pragma("unroll") for (int k = 0; k < 2; ++k) dst[m][k] = *(const PG8_LAS bf16x8*)(lds + PG8_SA(b, h) + aoff + m * 2048 + k * 1024); } while (0)
#define PG8_LDB(dst, b, h) do { _Pragma("unroll") for (int n = 0; n < 2; ++n) _Pragma("unroll") for (int k = 0; k < 2; ++k) dst[n][k] = *(const PG8_LAS bf16x8*)(lds + PG8_SB(b, h) + boff + n * 2048 + k * 1024); } while (0)
#define PG8_MMA(ai, bj, At, Bt) do { __builtin_amdgcn_s_setprio(1); _Pragma("unroll") for (int m = 0; m < 4; ++m) _Pragma("unroll") for (int n = 0; n < 2; ++n) _Pragma("unroll") for (int k = 0; k < 2; ++k) \
        acc[ai][bj][m][n] = __builtin_amdgcn_mfma_f32_16x16x32_bf16(Bt[n][k], At[m][k], acc[ai][bj][m][n], 0, 0, 0); __builtin_amdgcn_s_setprio(0); } while (0)
#define PG8_CAT8(x0, x1) __builtin_shufflevector(__builtin_bit_cast(i32x4_, x0), __builtin_bit_cast(i32x4_, x1), 0, 1, 2, 3, 4, 5, 6, 7)
#define PG8_MFMA8(ACC, B8, A8) asm volatile("s_nop 1\n\tv_mfma_scale_f32_16x16x128_f8f6f4 %0, %1, %2, %0, %3, %3 op_sel_hi:[0,0,0]" : "+v"(ACC) : "v"(B8), "v"(A8), "v"(sc8_))
#define PG8_MMA8(ai, bj, At, Bt) do { i32x8_ a8_[4], b8_[2]; _Pragma("unroll") for (int m = 0; m < 4; ++m) a8_[m] = PG8_CAT8(At[m][0], At[m][1]); _Pragma("unroll") for (int n = 0; n < 2; ++n) b8_[n] = PG8_CAT8(Bt[n][0], Bt[n][1]); \
        __builtin_amdgcn_s_setprio(1); _Pragma("unroll") for (int m = 0; m < 4; ++m) _Pragma("unroll") for (int n = 0; n < 2; ++n) PG8_MFMA8(acc[ai][bj][m][n], b8_[n], a8_[m]); __builtin_amdgcn_s_setprio(0); } while (0)
#define PG8_MM(ai, bj, At, Bt) do { if constexpr (FP8) PG8_MMA8(ai, bj, At, Bt); else PG8_MMA(ai, bj, At, Bt); } while (0)
#define PG8_WAIT_V(n) asm volatile("s_waitcnt vmcnt(" #n ")" ::: "memory")
#define PG8_WAIT_L(n) asm volatile("s_waitcnt lgkmcnt(" #n ")" ::: "memory")
#define PG8_BAR __builtin_amdgcn_s_barrier()
#define PG8_SCHED __builtin_amdgcn_sched_barrier(0)
    const int sc8_ = 0x7F7F7F7F;
    Unit cur, nxt; int ui = 0;
    if (!S.next(0, cur)) return;
    f32x4 acc[2][2][4][2];
#pragma unroll
    for (int a = 0; a < 2; ++a)
#pragma unroll
        for (int b = 0; b < 2; ++b)
#pragma unroll
            for (int m = 0; m < 4; ++m)
#pragma unroll
                for (int n = 0; n < 2; ++n) acc[a][b][m][n] = (f32x4){0.f, 0.f, 0.f, 0.f};
    bf16x8 At[4][2], B0[2][2], B1[2][2];
    if constexpr (GATHER) PG8_GLOAD(cur, vA0, vA1);
    const char* cA = GATHER ? (const char*)g.A : (const char*)g.A + (size_t)cur.pm * tstep; const char* cB = (const char*)g.Bt + (size_t)cur.pn * tstep;
    S.a_ready(cur);
    if constexpr (SP2) {
        PG8_STAGE(PG8_SB(0, 0), cB, voffB); PG8_STAGE(PG8_SB(0, 1), cB + bhstep, voffB); PG8_STAGE(PG8_SA(0, 0), cA, vA0); PG8_STAGE(PG8_SA(0, 1), cA, vA1);
        if (wr == 1) PG8_BAR;
        PG8_WAIT_V(2); PG8_BAR;
        PG8_STAGE(PG8_SB(1, 0), cB + kstep, voffB); PG8_STAGE(PG8_SA(1, 0), cA + kstep, vA0); PG8_STAGE(PG8_SB(1, 1), cB + bhstep + kstep, voffB);
        PG8_WAIT_V(6); PG8_BAR;
    } else {
        PG8_STAGE(PG8_SB(0, 0), cB, voffB); PG8_STAGE(PG8_SA(0, 0), cA, vA0); PG8_STAGE(PG8_SB(0, 1), cB + bhstep, voffB); PG8_STAGE(PG8_SA(0, 1), cA, vA1);
        if (wr == 1) PG8_BAR;
        PG8_WAIT_V(4); PG8_BAR;
        PG8_STAGE(PG8_SB(1, 0), cB + kstep, voffB); PG8_STAGE(PG8_SA(1, 0), cA + kstep, vA0); PG8_STAGE(PG8_SB(1, 1), cB + bhstep + kstep, voffB);
        PG8_WAIT_V(6); PG8_BAR;
    }
    for (;;) {
        const bool has_next = S.next(ui + 1, nxt);
        if constexpr (GATHER) { if (has_next) PG8_GLOAD(nxt, vN0, vN1); else { _Pragma("unroll") for (int i = 0; i < 2; ++i) { vN0[i] = vA0[i]; vN1[i] = vA1[i]; } } }
        const char* nA = GATHER ? (const char*)g.A : (has_next ? (const char*)g.A + (size_t)nxt.pm * tstep : cA); const char* nB = has_next ? (const char*)g.Bt + (size_t)nxt.pn * tstep : cB;
        for (int t = 0; t < nt; t += 2) {
            const bool last = (t == nt - 2);
            const char* a1 = cA + (size_t)(t + 1) * kstep;
            const char* a2 = last ? nA : cA + (size_t)(t + 2) * kstep; const char* b2 = last ? nB : cB + (size_t)(t + 2) * kstep;
            const char* a3 = a2 + kstep; const char* b3 = b2 + kstep;
            unsigned vX0[2], vX1[2];
#pragma unroll
            for (int i = 0; i < 2; ++i) { vX0[i] = (GATHER && last) ? vN0[i] : vA0[i]; vX1[i] = (GATHER && last) ? vN1[i] : vA1[i]; }
            if (last && has_next) S.a_ready(nxt);
            if constexpr (SP2) {
            PG8_LDB(B0, 0, 0); PG8_LDB(B1, 0, 1); PG8_SCHED; PG8_LDA(At, 0, 0); PG8_STAGE(PG8_SA(1, 1), a1, vA1);
            PG8_WAIT_V(8); PG8_WAIT_L(0); PG8_BAR; PG8_MM(0, 0, At, B0); PG8_MM(0, 1, At, B1); PG8_BAR; PG8_SCHED;
            PG8_LDA(At, 0, 1); PG8_STAGE(PG8_SB(0, 0), b2, voffB); PG8_STAGE(PG8_SB(0, 1), b2 + bhstep, voffB); PG8_STAGE(PG8_SA(0, 0), a2, vX0);
            PG8_WAIT_V(8); PG8_WAIT_L(0); PG8_BAR; PG8_MM(1, 0, At, B0); PG8_MM(1, 1, At, B1); PG8_BAR; PG8_SCHED;
            PG8_LDB(B0, 1, 0); PG8_LDB(B1, 1, 1); PG8_SCHED; PG8_LDA(At, 1, 0); PG8_STAGE(PG8_SA(0, 1), a2, vX1);
            PG8_WAIT_V(8); PG8_WAIT_L(0); PG8_BAR; PG8_MM(0, 0, At, B0); PG8_MM(0, 1, At, B1); PG8_BAR; PG8_SCHED;
            PG8_LDA(At, 1, 1); PG8_STAGE(PG8_SB(1, 0), b3, voffB); PG8_STAGE(PG8_SB(1, 1), b3 + bhstep, voffB); PG8_STAGE(PG8_SA(1, 0), a3, vX0);
            PG8_WAIT_V(8); PG8_WAIT_L(0); PG8_BAR; PG8_MM(1, 0, At, B0); PG8_MM(1, 1, At, B1); PG8_BAR; PG8_SCHED;
            } else {
            PG8_LDB(B0, 0, 0); PG8_SCHED; PG8_LDA(At, 0, 0); PG8_STAGE(PG8_SA(1, 1), a1, vA1);
            PG8_WAIT_L(8); PG8_BAR; PG8_WAIT_L(0); PG8_MM(0, 0, At, B0); PG8_BAR; PG8_SCHED;
            PG8_LDB(B1, 0, 1); PG8_STAGE(PG8_SB(0, 0), b2, voffB);
            PG8_BAR; PG8_WAIT_L(0); PG8_MM(0, 1, At, B1); PG8_BAR;
            PG8_LDA(At, 0, 1); PG8_STAGE(PG8_SA(0, 0), a2, vX0);
            PG8_BAR; PG8_WAIT_L(0); PG8_MM(1, 0, At, B0); PG8_BAR; PG8_SCHED;
            PG8_STAGE(PG8_SB(0, 1), b2 + bhstep, voffB);
            PG8_WAIT_V(6); PG8_BAR; PG8_MM(1, 1, At, B1); PG8_BAR;
            PG8_LDB(B0, 1, 0); PG8_SCHED; PG8_LDA(At, 1, 0); PG8_STAGE(PG8_SA(0, 1), a2, vX1);
            PG8_WAIT_L(8); PG8_BAR; PG8_WAIT_L(0); PG8_MM(0, 0, At, B0); PG8_BAR; PG8_SCHED;
            PG8_LDB(B1, 1, 1); PG8_STAGE(PG8_SB(1, 0), b3, voffB);
            PG8_BAR; PG8_WAIT_L(0); PG8_MM(0, 1, At, B1); PG8_BAR;
            PG8_LDA(At, 1, 1); PG8_STAGE(PG8_SA(1, 0), a3, vX0);
            PG8_BAR; PG8_WAIT_L(0); PG8_MM(1, 0, At, B0); PG8_BAR; PG8_SCHED;
            PG8_STAGE(PG8_SB(1, 1), b3 + bhstep, voffB);
            PG8_WAIT_V(6); PG8_BAR; PG8_MM(1, 1, At, B1); PG8_BAR;
            }
        }
        if constexpr (ALIGN_EPI) { if (wr == 0) PG8_BAR; }
        if constexpr (FP8) asm volatile("s_nop 15\n\ts_nop 15" ::: "memory");
        if constexpr (!Epi::AFTER_DRAIN) { E(acc, cur, wr, wc, fr, fq); S.done(cur); }
        if (!has_next) break;
#pragma unroll
        for (int a = 0; a < 2; ++a)
#pragma unroll
            for (int b = 0; b < 2; ++b)
#pragma unroll
                for (int m = 0; m < 4; ++m)
#pragma unroll
                    for (int n = 0; n < 2; ++n) acc[a][b][m][n] = (f32x4){0.f, 0.f, 0.f, 0.f};
        cur = nxt; cA = nA; cB = nB; ++ui;
        if constexpr (GATHER) { _Pragma("unroll") for (int i = 0; i < 2; ++i) { vA0[i] = vN0[i]; vA1[i] = vN1[i]; } }
        if constexpr (ALIGN_EPI) { if (wr == 1) PG8_BAR; }
    }
    PG8_WAIT_V(0);
    if constexpr (!ALIGN_EPI) { if (wr == 0) PG8_BAR; }
    PG8_BAR;
    if constexpr (Epi::AFTER_DRAIN) { E.fused(acc, cur, wr, wc, fr, fq, lds, wid, lane); S.done(cur); }
#undef PG8_SA
#undef PG8_SB
#undef PG8_STAGE
#undef PG8_GLOAD
#undef PG8_LDA
#undef PG8_LDB
#undef PG8_MMA
#undef PG8_MMA8
#undef PG8_MFMA8
#undef PG8_MM
#undef PG8_CAT8
#undef PG8_WAIT_V
#undef PG8_WAIT_L
#undef PG8_BAR
#undef PG8_SCHED
}
}
namespace pg8 {
__device__ __forceinline__ float bf_lo(unsigned w) { return __builtin_bit_cast(float, w << 16); }
__device__ __forceinline__ float bf_hi(unsigned w) { return __builtin_bit_cast(float, w & 0xffff0000u); }
__device__ __forceinline__ unsigned pk4_fp8(float a, float b, float c, float d) { int r = 0; r = __builtin_amdgcn_cvt_pk_fp8_f32(a, b, r, false); r = __builtin_amdgcn_cvt_pk_fp8_f32(c, d, r, true); return (unsigned)r; }
__device__ __forceinline__ float sigmoid_f(float x) { return __builtin_amdgcn_rcpf(1.0f + __expf(-x)); }

template <bool ADD, bool OUT8 = false> struct EpiGate {
    static constexpr bool PERM = true, PERM2 = false, AFTER_DRAIN = false;
    const bf16_t* G; const bf16_t* Min; bf16_t* O; float ascale;
    __device__ __forceinline__ void operator()(const f32x4 (&acc)[2][2][4][2], const Unit& u, int wr, int wc, int fr, int fq) const {
        const int row0 = u.pm * BM + wr * 64 + fr, col0 = u.pn * BM + wc * 32 + 8 * fq;
#pragma unroll
        for (int ai = 0; ai < 2; ++ai)
#pragma unroll
            for (int m = 0; m < 4; ++m) { const size_t off = (size_t)(row0 + ai * HALF + m * 16) * 1024 + col0;
#pragma unroll
                for (int bj = 0; bj < 2; ++bj) {
                    const u32x4 g = *(const u32x4*)(G + off + bj * HALF);
                    f32x4 v0 = acc[ai][bj][m][0] * ascale, v1 = acc[ai][bj][m][1] * ascale;
                    v0[0] *= sigmoid_f(bf_lo(g.x)); v0[1] *= sigmoid_f(bf_hi(g.x)); v0[2] *= sigmoid_f(bf_lo(g.y)); v0[3] *= sigmoid_f(bf_hi(g.y));
                    v1[0] *= sigmoid_f(bf_lo(g.z)); v1[1] *= sigmoid_f(bf_hi(g.z)); v1[2] *= sigmoid_f(bf_lo(g.w)); v1[3] *= sigmoid_f(bf_hi(g.w));
                    if (ADD) { const u32x4 p = *(const u32x4*)(Min + off + bj * HALF);
                        v0[0] += bf_lo(p.x); v0[1] += bf_hi(p.x); v0[2] += bf_lo(p.y); v0[3] += bf_hi(p.y);
                        v1[0] += bf_lo(p.z); v1[1] += bf_hi(p.z); v1[2] += bf_lo(p.w); v1[3] += bf_hi(p.w); }
                    if constexpr (OUT8) { typedef unsigned u32x2_ __attribute__((ext_vector_type(2))); u32x2_ w; w.x = pk4_fp8(v0[0], v0[1], v0[2], v0[3]); w.y = pk4_fp8(v1[0], v1[1], v1[2], v1[3]);
                        __builtin_nontemporal_store(w, (u32x2_*)((unsigned char*)O + off + bj * HALF)); }
                    else { u32x4 w; w.x = cvt_pk_bf16(v0[0], v0[1]); w.y = cvt_pk_bf16(v0[2], v0[3]); w.z = cvt_pk_bf16(v1[0], v1[1]); w.w = cvt_pk_bf16(v1[2], v1[3]);
                        __builtin_nontemporal_store(w, (u32x4*)(O + off + bj * HALF)); } } }
    }
};

struct EpiResid {
    static constexpr bool PERM = false, PERM2 = false, AFTER_DRAIN = false;
    const float* X; const float* gate; float* out; int rows_per_batch; int gstride; float ascale;
    __device__ __forceinline__ void operator()(const f32x4 (&acc)[2][2][4][2], const Unit& u, int wr, int wc, int fr, int fq) const {
        const int col0 = u.pn * BM + wc * 32 + 4 * fq;
#pragma unroll
        for (int ai = 0; ai < 2; ++ai)
#pragma unroll
            for (int m = 0; m < 4; ++m) { const int row = u.pm * BM + ai * HALF + wr * 64 + m * 16 + fr; const size_t off = (size_t)row * 1024 + col0;
                const float* gp = gate + (size_t)(row / rows_per_batch) * gstride + col0;
#pragma unroll
                for (int bj = 0; bj < 2; ++bj)
#pragma unroll
                    for (int n = 0; n < 2; ++n) { const f32x4 xv = *(const f32x4*)(X + off + bj * HALF + n * 16); const f32x4 gv = *(const f32x4*)(gp + bj * HALF + n * 16);
                        *(f32x4*)(out + off + bj * HALF + n * 16) = xv + gv * (acc[ai][bj][m][n] * ascale); } }
    }
};

__device__ __forceinline__ float swiglu1(float g, float l) {
    g = fminf(g, 7.0f); l = fminf(fmaxf(l, -7.0f), 7.0f);
    return (l + 1.0f) * (g * __builtin_amdgcn_rcpf(1.0f + __expf(-1.702f * g)));
}
template <bool OUT8> struct EpiSwiglu {
    static constexpr bool PERM = true, PERM2 = false, AFTER_DRAIN = false;
    const float* b1; bf16_t* O; float ascale;
    __device__ __forceinline__ void operator()(const f32x4 (&acc)[2][2][4][2], const Unit& u, int wr, int wc, int fr, int fq) const {
        const int e = u.pn >> 3, pl = u.pn & 7, jc = wc * 32 + 8 * fq;
        const float* bg = b1 + (size_t)e * 2048 + 128 * pl + jc; const float* bl = bg + 1024;
        const f32x4 bg0 = *(const f32x4*)bg, bg1 = *(const f32x4*)(bg + 4), bl0 = *(const f32x4*)bl, bl1 = *(const f32x4*)(bl + 4);
        const int row0 = u.pm * BM + wr * 64 + fr;
#pragma unroll
        for (int ai = 0; ai < 2; ++ai)
#pragma unroll
            for (int m = 0; m < 4; ++m) {
                const f32x4 g0 = acc[ai][0][m][0] * ascale + bg0, g1 = acc[ai][0][m][1] * ascale + bg1, l0 = acc[ai][1][m][0] * ascale + bl0, l1 = acc[ai][1][m][1] * ascale + bl1;
                if constexpr (OUT8) { typedef unsigned u32x2_ __attribute__((ext_vector_type(2))); u32x2_ w;
                    w.x = pk4_fp8(swiglu1(g0[0], l0[0]), swiglu1(g0[1], l0[1]), swiglu1(g0[2], l0[2]), swiglu1(g0[3], l0[3])); w.y = pk4_fp8(swiglu1(g1[0], l1[0]), swiglu1(g1[1], l1[1]), swiglu1(g1[2], l1[2]), swiglu1(g1[3], l1[3]));
                    __builtin_nontemporal_store(w, (u32x2_*)((unsigned char*)O + (size_t)(row0 + ai * HALF + m * 16) * 1024 + 128 * pl + jc)); }
                else { u32x4 w; w.x = cvt_pk_bf16(swiglu1(g0[0], l0[0]), swiglu1(g0[1], l0[1])); w.y = cvt_pk_bf16(swiglu1(g0[2], l0[2]), swiglu1(g0[3], l0[3]));
                    w.z = cvt_pk_bf16(swiglu1(g1[0], l1[0]), swiglu1(g1[1], l1[1])); w.w = cvt_pk_bf16(swiglu1(g1[2], l1[2]), swiglu1(g1[3], l1[3]));
                    __builtin_nontemporal_store(w, (u32x4*)(O + (size_t)(row0 + ai * HALF + m * 16) * 1024 + 128 * pl + jc)); } }
    }
};

struct EpiOutS {
    static constexpr bool PERM = true, PERM2 = true, AFTER_DRAIN = false;
    bf16_t* O; const float* bias; float ascale;
    __device__ __forceinline__ void operator()(const f32x4 (&acc)[2][2][4][2], const Unit& u, int wr, int wc, int fr, int fq) const {
        const int bcol0 = u.pn * BM + wc * 64 + 16 * fq;
        f32x4 bv[2][2];
#pragma unroll
        for (int bj = 0; bj < 2; ++bj)
#pragma unroll
            for (int n = 0; n < 2; ++n) bv[bj][n] = *(const f32x4*)(bias + bcol0 + 8 * bj + 4 * n);
        bf16_t* lp = O + (size_t)(u.pm * BM + wr * 64 + (fr & 7)) * 1024 + (u.pn & 3) * BM + wc * 64 + 16 * fq + 8 * (fr >> 3);
#pragma unroll
        for (int ai = 0; ai < 2; ++ai)
#pragma unroll
            for (int m = 0; m < 4; ++m) { u32x4 w[2];
#pragma unroll
                for (int bj = 0; bj < 2; ++bj) { const f32x4 v0 = acc[ai][bj][m][0] * ascale + bv[bj][0], v1 = acc[ai][bj][m][1] * ascale + bv[bj][1];
                    w[bj].x = cvt_pk_bf16(v0[0], v0[1]); w[bj].y = cvt_pk_bf16(v0[2], v0[3]); w[bj].z = cvt_pk_bf16(v1[0], v1[1]); w[bj].w = cvt_pk_bf16(v1[2], v1[3]); }
                u32x4 d1, d2; xchg8(w[0], w[1], d1, d2);
                bf16_t* rowp = lp + (size_t)(ai * HALF + m * 16) * 1024;
                __builtin_nontemporal_store(d1, (u32x4*)rowp); __builtin_nontemporal_store(d2, (u32x4*)(rowp + 8 * 1024)); }
    }
};

struct GroupedOrder {
    const PG8_LAS int* ts; int NT, G, c; const int* rowtok;
    __device__ __forceinline__ bool next(int i, Unit& u) const {
        const int total = __builtin_amdgcn_readfirstlane(ts[32]) * NT; const long L = (long)i * G + c; if (L >= total) return false;
        const int pm = (int)L / NT, pl = (int)L % NT; int e = 0;
#pragma unroll 1
        for (int j = 1; j < 32; ++j) e += (pm >= ts[j]) ? 1 : 0;
        u.pm = __builtin_amdgcn_readfirstlane(pm); u.pn = __builtin_amdgcn_readfirstlane(e * NT + pl); return true;
    }
    __device__ __forceinline__ void a_ready(const Unit&) const {}
    __device__ __forceinline__ void done(const Unit&) const {}
};
}
#define GAS __attribute__((address_space(1)))
#define LAS __attribute__((address_space(3)))
typedef unsigned short bf16;
typedef unsigned v4u __attribute__((ext_vector_type(4)));
typedef float f32x4 __attribute__((ext_vector_type(4)));
typedef short bf16x8 __attribute__((ext_vector_type(8)));
typedef GAS unsigned gu32;
typedef GAS unsigned long long gu64;
#define RLX_AGENT __ATOMIC_RELAXED, __HIP_MEMORY_SCOPE_AGENT
#define LDS_WAIT() asm volatile("s_waitcnt lgkmcnt(0)" ::: "memory")
#define VM_WAIT() asm volatile("s_waitcnt vmcnt(0)" ::: "memory")
__device__ __forceinline__ unsigned long long rt() { return __builtin_amdgcn_s_memrealtime(); }
__device__ __forceinline__ unsigned f2bf(float f) { unsigned u = __builtin_bit_cast(unsigned, f); return (u + 0x7fffu + ((u >> 16) & 1u)) >> 16; }
typedef float f32x2_pk __attribute__((ext_vector_type(2))); typedef __bf16 bf16x2_pk __attribute__((ext_vector_type(2)));
__device__ __forceinline__ unsigned pk2(float lo, float hi) { const f32x2_pk v = {lo, hi}; return __builtin_bit_cast(unsigned, __builtin_convertvector(v, bf16x2_pk)); }

#define XB_TMO      128
#define XB_XCNT(j)  (256  + 64 * (j))
#define XB_XSUB(j)  (1280 + 64 * (j))
#define XB_XGEN(j)  (2304 + 64 * (j))
#define XB_TOP      3328
#define XB_TOPGEN   3392
#define XCD_BAR_WORDS 3456
#define XB_SPIN_CAP (1u << 18)

__device__ __forceinline__ unsigned xb_ld(unsigned* p)              { return __hip_atomic_load(p, __ATOMIC_RELAXED, __HIP_MEMORY_SCOPE_AGENT); }
__device__ __forceinline__ unsigned xb_add(unsigned* p, unsigned v) { return __hip_atomic_fetch_add(p, v, __ATOMIC_RELAXED, __HIP_MEMORY_SCOPE_AGENT); }
__device__ __forceinline__ unsigned xb_xcc_id() { return (unsigned)__builtin_amdgcn_s_getreg((3 << 11) | 20) & 0xFu; }
#define XB_SPIN(cond, bar) do { unsigned _sp = 0; while (cond) { __builtin_amdgcn_s_sleep(1); \
    if ((++_sp & 255u) == 0u) { if (xb_ld(&(bar)[XB_TMO])) break; if (_sp > XB_SPIN_CAP) { atomicAdd(&(bar)[XB_TMO], 1u); break; } } } } while (0)

struct XcdBarrier {
    unsigned* bar; unsigned x;
    volatile LAS unsigned* st;
};

__device__ __forceinline__ XcdBarrier xcd_barrier_post(unsigned* bar, volatile LAS unsigned* st) {
    XcdBarrier b; b.bar = bar; b.x = xb_xcc_id(); b.st = st;
    if (threadIdx.x == 0) (void)xb_add(&bar[XB_XCNT(b.x)], 1u);
    return b;
}
__device__ __forceinline__ void xcd_barrier_complete(unsigned* bar, unsigned x, unsigned& nloc, unsigned& nx) {
    const unsigned G = gridDim.x * gridDim.y * gridDim.z;
    unsigned sum, cnt, mine, sp = 0u;
    for (;;) {
        sum = 0u; cnt = 0u; mine = 0u;
#pragma unroll
        for (unsigned j = 0; j < 16; ++j) { const unsigned c = xb_ld(&bar[XB_XCNT(j)]); sum += c; cnt += (c > 0u) ? 1u : 0u; mine = (j == x) ? c : mine; }
        if (sum == G) break;
        __builtin_amdgcn_s_sleep(1);
        if ((++sp & 255u) == 0u) { if (xb_ld(&bar[XB_TMO])) break; if (sp > XB_SPIN_CAP) { atomicAdd(&bar[XB_TMO], 1u); break; } }
    }
    nloc = mine > 0u ? mine : 1u; nx = cnt > 0u ? cnt : 1u;
}

__device__ __forceinline__ void xcd_barrier(const XcdBarrier& b) {
    asm volatile("s_waitcnt vmcnt(0)" ::: "memory");
    __syncthreads();
    if (threadIdx.x == 0) {
        unsigned* bar = b.bar;
        __builtin_amdgcn_s_waitcnt(0);
        unsigned nloc = b.st[0], nx = b.st[1];
        if (nloc == 0u) { xcd_barrier_complete(bar, b.x, nloc, nx); b.st[0] = nloc; b.st[1] = nx; }
        const unsigned old = xb_add(&bar[XB_XSUB(b.x)], 1u);
        const unsigned gen = old / nloc;
        if (old + 1u == (gen + 1u) * nloc) {
            __builtin_amdgcn_fence(__ATOMIC_RELEASE, "agent");
            asm volatile("s_waitcnt vmcnt(0)" ::: "memory");
            const unsigned og = xb_add(&bar[XB_TOP], 1u);
            const unsigned tg = og / nx;
            if (og + 1u == (tg + 1u) * nx) xb_add(&bar[XB_TOPGEN], 1u);
            else XB_SPIN(xb_ld(&bar[XB_TOPGEN]) == tg, bar);
            __builtin_amdgcn_fence(__ATOMIC_ACQUIRE, "agent");
            xb_add(&bar[XB_XGEN(b.x)], 1u);
            asm volatile("s_waitcnt vmcnt(0)" ::: "memory");
        } else {
            XB_SPIN(xb_ld(&bar[XB_XGEN(b.x)]) == gen, bar);
            __builtin_amdgcn_fence(__ATOMIC_ACQUIRE, "agent");
            asm volatile("s_waitcnt vmcnt(0)" ::: "memory");
        }
    }
    __syncthreads();
}

constexpr int NWAVES = 8;
constexpr int BATCH = 16, SEQ = 2048, D = 1024, T = BATCH * SEQ;
constexpr int NIN = 9224, NPROJ = 9216, NMOD = 6 * D;
constexpr int NE = 32, TOPK = 4;
constexpr int XS_ROWS = T * TOPK + NE * 256;
constexpr float EPS = 1e-6f;
constexpr float ATT_RTHR = -120.0f;
constexpr float W8SCALE = 64.0f;
constexpr float QSCALE = 0.125f * 1.4426950408889634f;

constexpr size_t MiB = 1u << 20;
constexpr size_t WS_CTL = 0, CTL_ZERO_BYTES = 1 * MiB;
constexpr size_t WS_MODP = 1 * MiB;
constexpr size_t WS_MOD = 3 * MiB;
constexpr size_t WS_IPRE = 4 * MiB, WS_LF = 4 * MiB + 512 * 1024;
constexpr size_t WS_TOKE = 5 * MiB, WS_TOKP = 5 * MiB + 512 * 1024, WS_TOKW = 6 * MiB, WS_TOKROW = 6 * MiB + 512 * 1024, WS_RSTD = 7 * MiB;
constexpr size_t WS_WIN = 8 * MiB, WS_WA = 26 * MiB, WS_WB = 28 * MiB, WS_WOUT = 30 * MiB, WS_W1 = 32 * MiB, WS_W2 = 160 * MiB;
constexpr size_t WS_H1 = 224 * MiB;
constexpr size_t WS_PROJ = 288 * MiB, SEG = 64 * MiB;
constexpr size_t WS_YB = 864 * MiB;
constexpr size_t WS_XS = 288 * MiB, WS_ACT = 560 * MiB;
constexpr size_t WS_ROW2TOK = 7 * MiB + 128 * 1024;
constexpr size_t WS_GT = 928 * MiB;
constexpr size_t WS_END = 932 * MiB;
static_assert(WS_XS + (size_t)XS_ROWS * 2048 <= WS_ACT && WS_ACT + (size_t)XS_ROWS * 2048 <= WS_YB, "ws map");
constexpr int CW_TMO = 0, CW_BAR = 4096, CW_ECNT = 8192;

constexpr int RING_BYTES = 131072, LDS_BYTES = 147456, LDSCTL_OFF = 146432;
constexpr int LC_BAR = 0, LC_TS = 16, LC_LCNT = 64, LC_GBASE = 96, LC_PS = 128, LC_CNT = 160;

__device__ __forceinline__ unsigned long long karg(int i) { return ((const __attribute__((address_space(4))) unsigned long long*)__builtin_amdgcn_kernarg_segment_ptr())[i]; }
struct Frame {
    LAS unsigned char* lds; volatile LAS unsigned* LC;
    gu32* ctl; unsigned char* ws; int tid, lane, wave, vcu, G;
    __device__ __forceinline__ const float* x() const { return (const float*)(const GAS float*)karg(0); }
    __device__ __forceinline__ const float* c() const { return (const float*)(const GAS float*)karg(1); }
    __device__ __forceinline__ const float* ada_w() const { return (const float*)(const GAS float*)karg(2); }
    __device__ __forceinline__ const float* ada_b() const { return (const float*)(const GAS float*)karg(3); }
    __device__ __forceinline__ const float* norm1_g() const { return (const float*)(const GAS float*)karg(4); }
    __device__ __forceinline__ const float* w_in() const { return (const float*)(const GAS float*)karg(5); }
    __device__ __forceinline__ const float* conv_w() const { return (const float*)(const GAS float*)karg(6); }
    __device__ __forceinline__ const float* conv_b() const { return (const float*)(const GAS float*)karg(7); }
    __device__ __forceinline__ const float* b_i() const { return (const float*)(const GAS float*)karg(8); }
    __device__ __forceinline__ const float* b_f() const { return (const float*)(const GAS float*)karg(9); }
    __device__ __forceinline__ const float* ml_norm_g() const { return (const float*)(const GAS float*)karg(10); }
    __device__ __forceinline__ const float* w_a() const { return (const float*)(const GAS float*)karg(11); }
    __device__ __forceinline__ const float* w_b() const { return (const float*)(const GAS float*)karg(12); }
    __device__ __forceinline__ const float* w_out() const { return (const float*)(const GAS float*)karg(13); }
    __device__ __forceinline__ const float* norm2_g() const { return (const float*)(const GAS float*)karg(14); }
    __device__ __forceinline__ const float* router_w() const { return (const float*)(const GAS float*)karg(15); }
    __device__ __forceinline__ const float* router_b() const { return (const float*)(const GAS float*)karg(16); }
    __device__ __forceinline__ const float* w1() const { return (const float*)(const GAS float*)karg(17); }
    __device__ __forceinline__ const float* b1() const { return (const float*)(const GAS float*)karg(18); }
    __device__ __forceinline__ const float* w2() const { return (const float*)(const GAS float*)karg(19); }
    __device__ __forceinline__ const float* b2() const { return (const float*)(const GAS float*)karg(20); }
    __device__ __forceinline__ const float* final_g() const { return (const float*)(const GAS float*)karg(21); }
    __device__ __forceinline__ float* out() const { return (float*)(GAS float*)karg(22); }
    __device__ __forceinline__ float* modp() const { return (float*)(ws + WS_MODP); }
    __device__ __forceinline__ float* mod() const { return (float*)(ws + WS_MOD); }
    __device__ __forceinline__ float* ipre() const { return (float*)(ws + WS_IPRE); }
    __device__ __forceinline__ float* lf() const { return (float*)(ws + WS_LF); }
    __device__ __forceinline__ float* tokw() const { return (float*)(ws + WS_TOKW); }
    __device__ __forceinline__ float* rstd2() const { return (float*)(ws + WS_RSTD); }
    __device__ __forceinline__ int* toke() const { return (int*)(ws + WS_TOKE); }
    __device__ __forceinline__ int* tokp() const { return (int*)(ws + WS_TOKP); }
    __device__ __forceinline__ int* tokrow() const { return (int*)(ws + WS_TOKROW); }
    __device__ __forceinline__ bf16* WIN_T() const { return (bf16*)(ws + WS_WIN); }
    __device__ __forceinline__ bf16* WA_T() const { return (bf16*)(ws + WS_WA); }
    __device__ __forceinline__ bf16* WB_T() const { return (bf16*)(ws + WS_WB); }
    __device__ __forceinline__ bf16* WOUT_T() const { return (bf16*)(ws + WS_WOUT); }
    __device__ __forceinline__ bf16* W1_T() const { return (bf16*)(ws + WS_W1); }
    __device__ __forceinline__ bf16* W2_T() const { return (bf16*)(ws + WS_W2); }
    __device__ __forceinline__ bf16* H1() const { return (bf16*)(ws + WS_H1); }
    __device__ __forceinline__ bf16* PROJ() const { return (bf16*)(ws + WS_PROJ); }
    __device__ __forceinline__ bf16* YA() const { return (bf16*)(ws + WS_H1); }
    __device__ __forceinline__ bf16* YB() const { return (bf16*)(ws + WS_YB); }
    __device__ __forceinline__ bf16* YB8() const { return (bf16*)(ws + WS_H1 + 32 * MiB); }
    __device__ __forceinline__ bf16* M1() const { return (bf16*)(ws + WS_PROJ); }
    __device__ __forceinline__ bf16* MERGED() const { return (bf16*)(ws + WS_PROJ + SEG); }
    __device__ __forceinline__ bf16* XS() const { return (bf16*)(ws + WS_XS); }
    __device__ __forceinline__ bf16* ACT() const { return (bf16*)(ws + WS_ACT); }
    __device__ __forceinline__ bf16* OUTR() const { return (bf16*)(ws + WS_XS); }
    __device__ __forceinline__ bf16* H2() const { return (bf16*)(ws + WS_XS); }
    __device__ __forceinline__ int* row2tok() const { return (int*)(ws + WS_ROW2TOK); }
    __device__ __forceinline__ float* gt() const { return (float*)(ws + WS_GT); }
};

__device__ __forceinline__ int opq(int v) { asm volatile("" : "+v"(v)); return v; }
__device__ __forceinline__ float wave_sum(float v) {
#pragma unroll
    for (int o = 1; o < 64; o <<= 1) v += __shfl_xor(v, o);
    return v;
}
__device__ __forceinline__ float bf2f(unsigned short b) { return __builtin_bit_cast(float, (unsigned)b << 16); }
__device__ __forceinline__ float bflo(unsigned w) { return __builtin_bit_cast(float, w << 16); }
__device__ __forceinline__ float bfhi(unsigned w) { return __builtin_bit_cast(float, w & 0xffff0000u); }
__device__ __forceinline__ float log_sigmoid_f(float x) { return fminf(x, 0.f) - log1pf(expf(-fabsf(x))); }

struct MapIn { __device__ __forceinline__ long operator()(int n) const { return n < 7168 ? (long)n : (n < 7176 ? -1L : (n < NIN ? (long)(n - 8) : -1L)); } };
struct MapId { long off; __device__ __forceinline__ long operator()(int n) const { return off + n; } };
struct MapW1 { int e; __device__ __forceinline__ long operator()(int n) const { return (long)e * 2048 + ((n & 1023) >> 7) * 256 + (n >> 10) * 128 + (n & 127); } };

template <class Map> __device__ __forceinline__ void transpose_item(const float* W, int K, int N, bf16* WT, LAS float* scr, int item, int lane, Map map, float scale8 = 0.f) {
    const int nblk = (N + 31) / 32, kb = item / nblk, nb = item % nblk, k0 = 64 * kb, n0 = 32 * nb;
    const int n4 = 4 * (lane & 7), kr = lane >> 3;
    const bool ok = (n0 + n4 + 3) < N;
    f32x4 v[8];
#pragma unroll
    for (int i = 0; i < 8; ++i) v[i] = ok ? *(const f32x4*)(W + (size_t)(k0 + 8 * i + kr) * N + n0 + n4) : (f32x4){0.f, 0.f, 0.f, 0.f};
#pragma unroll
    for (int i = 0; i < 8; ++i) { LAS float* d = scr + (8 * i + kr) * 33 + n4; d[0] = v[i].x; d[1] = v[i].y; d[2] = v[i].z; d[3] = v[i].w; }
    LDS_WAIT(); asm volatile("" ::: "memory");
    const int c = lane & 7;
#pragma unroll
    for (int j = 0; j < 4; ++j) { const int n = (lane >> 3) + 8 * j; const LAS float* s = scr + (8 * c) * 33 + n;
        const long dr = map(n0 + n);
        if (scale8 != 0.f) { typedef unsigned u32x2_ __attribute__((ext_vector_type(2))); u32x2_ o;
            o.x = pg8::pk4_fp8(s[0 * 33] * scale8, s[1 * 33] * scale8, s[2 * 33] * scale8, s[3 * 33] * scale8); o.y = pg8::pk4_fp8(s[4 * 33] * scale8, s[5 * 33] * scale8, s[6 * 33] * scale8, s[7 * 33] * scale8);
            if (dr >= 0) *(GAS u32x2_*)((unsigned char*)WT + (size_t)dr * K + k0 + 8 * c) = o; }
        else { v4u o; o.x = pk2(s[0 * 33], s[1 * 33]); o.y = pk2(s[2 * 33], s[3 * 33]); o.z = pk2(s[4 * 33], s[5 * 33]); o.w = pk2(s[6 * 33], s[7 * 33]);
            if (dr >= 0) *(GAS v4u*)(WT + (size_t)dr * K + k0 + 8 * c) = o; } }
    LDS_WAIT(); asm volatile("" ::: "memory");
}
__device__ __forceinline__ void mod_item(Frame& F, const LAS float* sil, int it) {
    const int j = it % 96, kq = it / 96, n = 64 * j + F.lane, k0 = 256 * kq;
    float acc[16];
#pragma unroll
    for (int b = 0; b < 16; ++b) acc[b] = 0.f;
    const float* w = F.ada_w() + (size_t)k0 * NMOD + n;
    const LAS f32x4* s = (const LAS f32x4*)sil + k0 * 4;
    for (int kk = 0; kk < 256; kk += 8) {
        float wv[8];
#pragma unroll
        for (int u = 0; u < 8; ++u) wv[u] = w[(size_t)(kk + u) * NMOD];
#pragma unroll
        for (int u = 0; u < 8; ++u) {
#pragma unroll
            for (int q = 0; q < 4; ++q) { const f32x4 sv = s[(kk + u) * 4 + q]; acc[4 * q + 0] += sv.x * wv[u]; acc[4 * q + 1] += sv.y * wv[u]; acc[4 * q + 2] += sv.z * wv[u]; acc[4 * q + 3] += sv.w * wv[u]; }
        }
    }
    float* o = F.modp() + (size_t)kq * 16 * NMOD + n;
#pragma unroll
    for (int b = 0; b < 16; ++b) o[(size_t)b * NMOD] = acc[b];
}
__device__ __forceinline__ void p0_prologue(Frame& F) {
    LAS float* sil = (LAS float*)F.lds;
    for (int idx = F.tid; idx < 16384; idx += 512) { const int b = idx >> 10, k = idx & 1023; const float v = F.c()[idx]; sil[k * 16 + b] = v / (1.0f + __expf(-v)); }
    __syncthreads();
    LAS float* scr = (LAS float*)(F.lds + 65536 + F.wave * 8704);
    const int gw = F.vcu * NWAVES + F.wave, NGW = F.G * NWAVES;
    constexpr int I_MOD = 384, I_IN = 16 * 289, I_SQ = 16 * 32, I_W1 = 32 * 16 * 64, I_W2 = 32 * 16 * 32;
    constexpr int NITEMS = I_MOD + I_IN + 3 * I_SQ + I_W1 + I_W2;
    for (int it = gw; it < NITEMS; it += NGW) {
        int r = it;
        if (r < I_MOD) { mod_item(F, sil, r); continue; } r -= I_MOD;
        if (r < I_IN) { transpose_item(F.w_in(), D, NIN, F.WIN_T(), scr, r, F.lane, MapIn{}, W8SCALE); continue; } r -= I_IN;
        if (r < I_SQ) { transpose_item(F.w_a(), D, D, F.WA_T(), scr, r, F.lane, MapId{0}, W8SCALE); continue; } r -= I_SQ;
        if (r < I_SQ) { transpose_item(F.w_b(), D, D, F.WB_T(), scr, r, F.lane, MapId{0}, W8SCALE); continue; } r -= I_SQ;
        if (r < I_SQ) { transpose_item(F.w_out(), D, D, F.WOUT_T(), scr, r, F.lane, MapId{0}, W8SCALE); continue; } r -= I_SQ;
        if (r < I_W1) { const int e = r >> 10; transpose_item(F.w1() + (size_t)e * D * 2048, D, 2048, F.W1_T(), scr, r & 1023, F.lane, MapW1{e}, W8SCALE); continue; } r -= I_W1;
        { const int e = r >> 9; transpose_item(F.w2() + (size_t)e * D * D, D, D, F.W2_T(), scr, r & 511, F.lane, MapId{(long)e * 1024}, W8SCALE); }
    }
}

__device__ __forceinline__ void p1_rows(Frame& F) {
    const int row0 = F.vcu * 128, b = row0 / SEQ, lane = opq(F.lane);
    LAS float* wif = (LAS float*)F.lds;
    for (int idx = F.tid; idx < 8192; idx += 512) wif[idx] = F.w_in()[(size_t)(idx >> 3) * NIN + 7168 + (idx & 7)];
    for (int idx = F.vcu * 512 + F.tid; idx < 16 * NMOD; idx += F.G * 512) { float s = F.ada_b()[idx % NMOD];
#pragma unroll
        for (int kq = 0; kq < 4; ++kq) s += F.modp()[(size_t)kq * 16 * NMOD + idx];
        F.mod()[idx] = s; }
    f32x4 Av[4], Bv[4];
#pragma unroll
    for (int j = 0; j < 4; ++j) { const int col = 4 * lane + 256 * j;
        f32x4 sh = *(const f32x4*)(F.ada_b() + col), sc = *(const f32x4*)(F.ada_b() + D + col);
#pragma unroll
        for (int kq = 0; kq < 4; ++kq) { sh += *(const f32x4*)(F.modp() + ((size_t)kq * 16 + b) * NMOD + col); sc += *(const f32x4*)(F.modp() + ((size_t)kq * 16 + b) * NMOD + D + col); }
        const f32x4 g = *(const f32x4*)(F.norm1_g() + col); Av[j] = g * (sc + 1.0f); Bv[j] = sh; }
    __syncthreads();
    f32x4 nx[4];
    { const GAS f32x4* xr = (const GAS f32x4*)(F.x() + (size_t)(row0 + 16 * F.wave) * D) + lane;
#pragma unroll
      for (int j = 0; j < 4; ++j) nx[j] = xr[64 * j]; }
    for (int r = 0; r < 16; ++r) {
        const int row = row0 + 16 * F.wave + r;
        f32x4 v[4]; float ss = 0.f;
#pragma unroll
        for (int j = 0; j < 4; ++j) { v[j] = nx[j]; ss += (v[j].x * v[j].x + v[j].y * v[j].y) + (v[j].z * v[j].z + v[j].w * v[j].w); }
        if (r < 15) { const GAS f32x4* xr = (const GAS f32x4*)(F.x() + (size_t)(row + 1) * D) + lane;
#pragma unroll
            for (int j = 0; j < 4; ++j) nx[j] = xr[64 * j]; }
        const float rstd = 1.0f / sqrtf(wave_sum(ss) * (1.0f / D) + EPS);
        GAS unsigned* o4 = (GAS unsigned*)((unsigned char*)F.H1() + (size_t)row * D) + lane;
        float p[8];
#pragma unroll
        for (int q = 0; q < 8; ++q) p[q] = 0.f;
#pragma unroll
        for (int j = 0; j < 4; ++j) { v[j] = v[j] * rstd * Av[j] + Bv[j];
            o4[64 * j] = pg8::pk4_fp8(v[j].x, v[j].y, v[j].z, v[j].w);
#pragma unroll
            for (int i = 0; i < 4; ++i) { const LAS f32x4* wp = (const LAS f32x4*)(wif + (4 * lane + 256 * j + i) * 8); const f32x4 w0 = wp[0], w1 = wp[1]; const float hv = v[j][i];
                p[0] += hv * w0.x; p[1] += hv * w0.y; p[2] += hv * w0.z; p[3] += hv * w0.w; p[4] += hv * w1.x; p[5] += hv * w1.y; p[6] += hv * w1.z; p[7] += hv * w1.w; } }
#pragma unroll
        for (int q = 0; q < 8; ++q) p[q] = wave_sum(p[q]);
        if (lane == 0) { const int t = row % SEQ;
#pragma unroll
            for (int hh = 0; hh < 4; ++hh) { F.ipre()[((size_t)b * 4 + hh) * SEQ + t] = p[hh] + F.b_i()[hh]; F.lf()[((size_t)b * 4 + hh) * SEQ + t] = log_sigmoid_f(p[4 + hh] + F.b_f()[hh]); } }
    }
}

__device__ __forceinline__ void attn_naive_item(Frame& F, int bh, int qblk) {
    const int b = bh >> 4, hd = bh & 15, t = qblk * 512 + F.tid;
    const bf16* Q = F.PROJ(); const bf16* K = F.PROJ() + SEG / 2; const bf16* V = F.PROJ() + SEG;
    const size_t rowb = (size_t)b * SEQ;
    float q[64], o[64];
    { const v4u* qp = (const v4u*)(Q + (rowb + t) * D + hd * 64);
#pragma unroll
      for (int i = 0; i < 8; ++i) { const v4u w = qp[i]; q[8 * i + 0] = bflo(w.x); q[8 * i + 1] = bfhi(w.x); q[8 * i + 2] = bflo(w.y); q[8 * i + 3] = bfhi(w.y); q[8 * i + 4] = bflo(w.z); q[8 * i + 5] = bfhi(w.z); q[8 * i + 6] = bflo(w.w); q[8 * i + 7] = bfhi(w.w); } }
#pragma unroll
    for (int i = 0; i < 64; ++i) o[i] = 0.f;
    float R = 0.f;
    LAS v4u* kt = (LAS v4u*)F.lds; LAS v4u* vt = (LAS v4u*)(F.lds + 8192);
    const int tmax_wave = qblk * 512 + F.wave * 64 + 63;
    bool wdone = false;
    LAS volatile int* dflag = (LAS volatile int*)(F.lds + 16384);
    if (F.tid < 8) dflag[F.tid] = 0;
    for (int tile = qblk * 8 + 7; tile >= 0; --tile) {
        __syncthreads();
        { int nd = 0;
#pragma unroll
          for (int w = 0; w < 8; ++w) nd += dflag[w];
          if (nd == 8) break; }
        { const int kr = F.tid >> 3, ch = F.tid & 7; const size_t g = (rowb + tile * 64 + kr) * D + hd * 64 + ch * 8;
          kt[F.tid] = *(const v4u*)(K + g); vt[F.tid] = *(const v4u*)(V + g); }
        __syncthreads();
        if (tile * 64 >= tmax_wave) continue;
        if (wdone) continue;
        for (int s = 63; s >= 0; --s) {
            const int key = tile * 64 + s;
            float z = 0.f;
#pragma unroll
            for (int i = 0; i < 8; ++i) { const v4u w = kt[s * 8 + i]; z += q[8 * i + 0] * bflo(w.x) + q[8 * i + 1] * bfhi(w.x) + q[8 * i + 2] * bflo(w.y) + q[8 * i + 3] * bfhi(w.y) + q[8 * i + 4] * bflo(w.z) + q[8 * i + 5] * bfhi(w.z) + q[8 * i + 6] * bflo(w.w) + q[8 * i + 7] * bfhi(w.w); }
            const float lb = fminf(z, 0.f) - __builtin_amdgcn_logf(1.0f + __builtin_amdgcn_exp2f(-fabsf(z)));
            const bool act = key < t;
            const float a = act ? __builtin_amdgcn_exp2f(lb + R) : 0.f;
            R += act ? (lb - z) : 0.f;
#pragma unroll
            for (int i = 0; i < 8; ++i) { const v4u w = vt[s * 8 + i]; o[8 * i + 0] += a * bflo(w.x); o[8 * i + 1] += a * bfhi(w.x); o[8 * i + 2] += a * bflo(w.y); o[8 * i + 3] += a * bfhi(w.y); o[8 * i + 4] += a * bflo(w.z); o[8 * i + 5] += a * bfhi(w.z); o[8 * i + 6] += a * bflo(w.w); o[8 * i + 7] += a * bfhi(w.w); }
        }
        if (__all(R < ATT_RTHR) && !wdone) { wdone = true; if (F.lane == 0) dflag[F.wave] = 1; }
    }
    __syncthreads();
    v4u* op = (v4u*)(F.YA() + (rowb + t) * D + hd * 64);
#pragma unroll
    for (int i = 0; i < 8; ++i) { v4u w; w.x = pk2(o[8 * i + 0], o[8 * i + 1]); w.y = pk2(o[8 * i + 2], o[8 * i + 3]); w.z = pk2(o[8 * i + 4], o[8 * i + 5]); w.w = pk2(o[8 * i + 6], o[8 * i + 7]); op[i] = w; }
}

__device__ __forceinline__ void mlstm_naive_item(Frame& F, int bh) {
    const int b = bh >> 2, hh = bh & 3, tid = opq(F.tid), e = tid & 255, half = tid >> 8;
    const bf16* MLQ = F.PROJ() + 3 * (SEG / 2); const bf16* MLK = F.PROJ() + 4 * (SEG / 2); const bf16* MLV = F.PROJ() + 5 * (SEG / 2); const bf16* MLO = F.PROJ() + 6 * (SEG / 2);
    LAS float* ql = (LAS float*)F.lds; LAS float* kl = ql + 8192; LAS float* vl = kl + 8192; LAS float* hl = vl + 8192;
    LAS float* part = hl + 8192;
    LAS float* red = part + 512;
    LAS float* il = red + 8; LAS float* fl = il + 32;
    const size_t rowb = (size_t)b * SEQ;
    float C[128];
#pragma unroll
    for (int i = 0; i < 128; ++i) C[i] = 0.f;
    float nreg = 0.f, m = 0.f;
    float cw[2][4], cb[2];
    { const int c = tid & 255;
#pragma unroll
      for (int z = 0; z < 2; ++z) { const int ch = z * 1024 + hh * 256 + c; cb[z] = F.conv_b()[ch];
#pragma unroll
          for (int tap = 0; tap < 4; ++tap) cw[z][tap] = F.conv_w()[tap * 2048 + ch]; } }
    for (int chunk = 0; chunk < SEQ / 32; ++chunk) {
        const int t0 = chunk * 32;
        __syncthreads();
        { const int c = tid & 255;
          for (int u = 0; u < 16; ++u) { const int tt = (tid >> 8) + 2 * u, t = t0 + tt; float yq = cb[0], yk = cb[1];
#pragma unroll
              for (int tap = 0; tap < 4; ++tap) { const int ts = t - 3 + tap; if (ts >= 0) { const size_t g = (rowb + ts) * D + hh * 256 + c; yq += cw[0][tap] * bf2f(MLQ[g]); yk += cw[1][tap] * bf2f(MLK[g]); } }
              ql[tt * 256 + c] = yq / (1.0f + __expf(-yq)); kl[tt * 256 + c] = (yk / (1.0f + __expf(-yk))) * 0.0625f;
              vl[tt * 256 + c] = bf2f(MLV[(rowb + t) * D + hh * 256 + c]); }
          if (tid < 32) { il[tid] = F.ipre()[((size_t)b * 4 + hh) * SEQ + t0 + tid]; fl[tid] = F.lf()[((size_t)b * 4 + hh) * SEQ + t0 + tid]; } }
        __syncthreads();
        for (int tt = 0; tt < 32; ++tt) {
            const float lfv = fl[tt], iv = il[tt];
            const float mn = fmaxf(lfv + m, iv), fp = __expf(lfv + m - mn), ip = __expf(iv - mn); m = mn;
            const float vv = vl[tt * 256 + e] * ip;
            const LAS f32x4* kq = (const LAS f32x4*)(kl + tt * 256 + 128 * half); const LAS f32x4* qq = (const LAS f32x4*)(ql + tt * 256 + 128 * half);
            float num = 0.f;
#pragma unroll
            for (int i = 0; i < 32; ++i) { const f32x4 kv = kq[i], qv = qq[i];
                C[4 * i + 0] = fp * C[4 * i + 0] + kv.x * vv; C[4 * i + 1] = fp * C[4 * i + 1] + kv.y * vv; C[4 * i + 2] = fp * C[4 * i + 2] + kv.z * vv; C[4 * i + 3] = fp * C[4 * i + 3] + kv.w * vv;
                num += (qv.x * C[4 * i + 0] + qv.y * C[4 * i + 1]) + (qv.z * C[4 * i + 2] + qv.w * C[4 * i + 3]); }
            const int buf = tt & 1;
            if (tid < 256) { nreg = fp * nreg + ip * kl[tt * 256 + tid]; const float pd = wave_sum(ql[tt * 256 + tid] * nreg); if (F.lane == 0) red[buf * 4 + F.wave] = pd; }
            else part[buf * 256 + e] = num;
            __syncthreads();
            if (tid < 256) { num += part[buf * 256 + e]; const float den = (red[buf * 4 + 0] + red[buf * 4 + 1]) + (red[buf * 4 + 2] + red[buf * 4 + 3]);
                hl[tt * 256 + e] = num / fmaxf(fabsf(den), __expf(-m)); }
        }
        __syncthreads();
        for (int r = 0; r < 4; ++r) { const int tt = 4 * F.wave + r; const size_t row = rowb + t0 + tt;
            const f32x4 hv = *(const LAS f32x4*)(hl + tt * 256 + 4 * F.lane);
            const float ss = wave_sum((hv.x * hv.x + hv.y * hv.y) + (hv.z * hv.z + hv.w * hv.w));
            const float rstd = 1.0f / sqrtf(ss * (1.0f / 256.0f) + EPS);
            const int col = hh * 256 + 4 * F.lane; const f32x4 g = *(const f32x4*)(F.ml_norm_g() + col);
            const unsigned long long ow = *(const unsigned long long*)(MLO + row * D + col);
            const float o0 = bflo((unsigned)ow), o1 = bfhi((unsigned)ow), o2 = bflo((unsigned)(ow >> 32)), o3 = bfhi((unsigned)(ow >> 32));
            const float y0 = hv.x * rstd * g.x / (1.0f + __expf(-o0)), y1 = hv.y * rstd * g.y / (1.0f + __expf(-o1)), y2 = hv.z * rstd * g.z / (1.0f + __expf(-o2)), y3 = hv.w * rstd * g.w / (1.0f + __expf(-o3));
            *(unsigned long long*)(F.YB() + row * D + col) = (unsigned long long)pk2(y0, y1) | ((unsigned long long)pk2(y2, y3) << 32); }
    }
}


namespace ml {
typedef short bf16x8 __attribute__((ext_vector_type(8)));
typedef short s16x4 __attribute__((ext_vector_type(4)));
typedef float f32x16 __attribute__((ext_vector_type(16)));
typedef LAS const char* lcp;
typedef LAS char* lp_t;
constexpr int L = 64;
constexpr int O_QI = 0, O_KI = 33792, O_CB = 67584, O_VI = 102400, O_VW = 111616, O_PI = 120832, O_F = 130048;
constexpr int F_NV = 0, F_QNP = 256, F_RSP = 768, F_AT = 896, F_US = 960, F_WIN = 1024, F_EDEN = 1088, F_WST = 1152, F_RDEN = 1216, F_CW = 1280, F_CBIAS = 3328;
__device__ __forceinline__ int crow(int r, int hi) { return (r & 3) + 8 * (r >> 2) + 4 * hi; }
template <int PITCH, int XM> __device__ __forceinline__ int ioff(int row, int ch) { return XM ? PITCH * row + 16 * (ch ^ (row & XM)) : PITCH * row + 16 * ch; }
template <int PITCH, int XM> __device__ __forceinline__ bf16x8 frag_row(lcp img, int row0, int s, int lane) {
    return *(LAS const bf16x8*)(img + ioff<PITCH, XM>(row0 + (lane & 31), 2 * s + (lane >> 5)));
}
template <int PITCH, int XM> __device__ __forceinline__ bf16x8 frag_tr(lcp img, int k0, int ks, int col0, int lane) {
    const int h = lane >> 5, blk = (lane >> 4) & 1, q = (lane & 15) >> 2, p = lane & 3;
    const int r0 = k0 + 16 * ks + 8 * h + q, ch = (col0 >> 3) + 2 * blk + (p >> 1);
    typedef short v4i16_t __attribute__((ext_vector_type(4)));
    const s16x4 a = __builtin_bit_cast(s16x4, __builtin_amdgcn_ds_read_tr16_b64_v4i16((LAS v4i16_t*)(img + ioff<PITCH, XM>(r0, ch) + 8 * (p & 1))));
    const s16x4 b = __builtin_bit_cast(s16x4, __builtin_amdgcn_ds_read_tr16_b64_v4i16((LAS v4i16_t*)(img + ioff<PITCH, XM>(r0 + 4, ch) + 8 * (p & 1))));
    return (bf16x8){a[0], a[1], a[2], a[3], b[0], b[1], b[2], b[3]};
}
__device__ __forceinline__ float half_sum(float v) {
    const auto rr = __builtin_amdgcn_permlane32_swap(__builtin_bit_cast(unsigned, v), __builtin_bit_cast(unsigned, v), false, false);
    return __builtin_bit_cast(float, rr[0]) + __builtin_bit_cast(float, rr[1]);
}
__device__ __forceinline__ float silu_f(float y) { return y * __builtin_amdgcn_rcpf(1.0f + __expf(-y)); }

__device__ __forceinline__ void mlstm_unit(Frame& F, int unit) {
    const int bh = unit >> 2, sl = unit & 3, b = bh >> 2, hh = bh & 3, tid = opq(F.tid), lane = opq(F.lane), wave = F.wave, hi = lane >> 5, l31 = lane & 31;
    const bf16* MLQ = (const bf16*)F.out(); const bf16* MLK = MLQ + (size_t)T * D; const bf16* MLV = F.PROJ() + 5 * (SEG / 2);
    lp_t base = (lp_t)F.lds;
    LAS float* Fa = (LAS float*)(base + O_F);
    const size_t rowb = (size_t)b * SEQ;
    const float LOG2E = 1.4426950408889634f;
    __syncthreads();
    for (int i = tid; i < 34816 / 16; i += 512) ((LAS v4u*)(base + O_CB))[i] = (v4u){0u, 0u, 0u, 0u};
    if (tid < 256) Fa[F_NV + tid] = 0.f;
    f32x16 C0, C1, C2;
#pragma unroll
    for (int r = 0; r < 16; ++r) { C0[r] = 0.f; C1[r] = 0.f; C2[r] = 0.f; }
    if (tid < 64) *(LAS v4u*)(base + O_VW + 144 * tid + 128) = (v4u){0u, 0u, 0u, 0u};
    const int cg = tid & 31, rb = tid >> 5;
    v4u rawq[2][4], rawk[2][4], rawv[2]; float g_bb[2], g_us[2], g_pm[2]; float m_prev = 0.f;
#define ML_PREFETCH(T0, P) do { const int t0_ = (T0); \
        _Pragma("unroll") for (int i = 0; i < 4; ++i) { const unsigned g_ = (unsigned)(((int)rowb + t0_ + 4 * rb + i) * D + hh * 256 + cg * 8); \
            rawq[P][i] = *(const v4u*)(MLQ + g_); rawk[P][i] = *(const v4u*)(MLK + g_); } \
        rawv[P] = *(const v4u*)(MLV + (unsigned)(((int)rowb + t0_ + (tid >> 3)) * D + hh * 256 + 64 * sl + (tid & 7) * 8)); \
        { const float* gt_ = F.gt() + (unsigned)(((bh * (SEQ / L) + t0_ / L) * 3) * 64 + lane); g_bb[P] = gt_[0]; g_us[P] = gt_[64]; g_pm[P] = gt_[128]; } } while (0)
    ML_PREFETCH(0, 0); ML_PREFETCH(L, 1);
    __syncthreads();
    for (int chunk2 = 0; chunk2 < SEQ / L; chunk2 += 2) {
#pragma unroll
      for (int par = 0; par < 2; ++par) {
        const int chunk = chunk2 + par, t0 = chunk * L;
        const int tid = opq(F.tid), lane = tid & 63, hi = lane >> 5, l31 = lane & 31, cg = tid & 31, rb = tid >> 5, lo = lane;
        const float u = g_us[par], mm = g_bb[par] + fmaxf(m_prev, g_pm[par]), winter = __builtin_amdgcn_exp2f(g_bb[par] + m_prev - mm), at = g_bb[par] - mm, eden = __builtin_amdgcn_exp2f(-mm);
        const float bb63 = __builtin_bit_cast(float, __builtin_amdgcn_readlane(__builtin_bit_cast(int, g_bb[par]), 63)), mnew = __builtin_bit_cast(float, __builtin_amdgcn_readlane(__builtin_bit_cast(int, mm), 63));
        const float decay = __builtin_amdgcn_exp2f(bb63 + m_prev - mnew), wstate = __builtin_amdgcn_exp2f(bb63 - mnew + u); m_prev = mnew;
        if (wave == 0) { Fa[F_AT + lane] = at; Fa[F_US + lane] = u; Fa[F_WIN + lane] = winter; Fa[F_EDEN + lane] = eden; Fa[F_WST + lane] = wstate; }
#pragma unroll
        for (int j = 0; j < 4; ++j) { *(LAS v4u*)(base + O_QI + ioff<528, 0>(4 * rb + j, cg)) = rawq[par][j]; *(LAS v4u*)(base + O_KI + ioff<528, 0>(4 * rb + j, cg)) = rawk[par][j]; }
        { const int s = tid >> 3, ch = tid & 7; const v4u w = rawv[par];
          *(LAS v4u*)(base + O_VI + ioff<144, 0>(s, ch)) = w;
          const float ws = __shfl(wstate, s);
          v4u o; o.x = pk2(bflo(w.x) * ws, bfhi(w.x) * ws); o.y = pk2(bflo(w.y) * ws, bfhi(w.y) * ws); o.z = pk2(bflo(w.z) * ws, bfhi(w.z) * ws); o.w = pk2(bflo(w.w) * ws, bfhi(w.w) * ws);
          *(LAS v4u*)(base + O_VW + ioff<144, 0>(s, ch)) = o;
          if (ch == 0) *(LAS unsigned short*)(base + O_VW + 144 * s + 128) = (unsigned short)pk2(ws, 0.f); }
        __syncthreads();
        if (chunk + 2 < SEQ / L) ML_PREFETCH(t0 + 2 * L, par);
        __builtin_amdgcn_sched_barrier(0);
        f32x16 acc;
#pragma unroll
        for (int r = 0; r < 16; ++r) acc[r] = 0.f;
        const int wq = wave & 3, ta = wq >> 1, tb = wq & 1;
        if (wave < 4) {
#pragma unroll
            for (int kh = 0; kh < 2; ++kh) { bf16x8 fa[8], fb[8];
#pragma unroll
                for (int ks = 0; ks < 8; ++ks) { fa[ks] = frag_row<528, 0>(base + O_KI, 32 * tb, 8 * kh + ks, lo); fb[ks] = frag_row<528, 0>(base + O_QI, 32 * ta, 8 * kh + ks, lo); }
                __builtin_amdgcn_sched_barrier(0);
#pragma unroll
                for (int ks = 0; ks < 8; ++ks) acc = __builtin_amdgcn_mfma_f32_32x32x16_bf16(fa[ks], fb[ks], acc, 0, 0, 0);
                __builtin_amdgcn_sched_barrier(0); }
            const float at_l = __shfl(at, 32 * ta + l31); const int t = 32 * ta + l31; float rsum = 0.f;
#pragma unroll
            for (int g = 0; g < 4; ++g) { const int s0 = 32 * tb + 8 * g + 4 * hi; const f32x4 us4 = *(LAS const f32x4*)(Fa + F_US + s0); float p[4];
#pragma unroll
                for (int i = 0; i < 4; ++i) { p[i] = (s0 + i <= t) ? acc[4 * g + i] * __builtin_amdgcn_exp2f(at_l + us4[i]) : 0.f; rsum += p[i]; }
                *(LAS unsigned long long*)(base + O_PI + ioff<144, 0>(t, s0 >> 3) + 2 * (s0 & 7)) = (unsigned long long)pk2(p[0], p[1]) | ((unsigned long long)pk2(p[2], p[3]) << 32); }
            rsum = half_sum(rsum);
            if (hi == 0) Fa[F_RSP + tb * 64 + t] = rsum;
        } else {
#pragma unroll
            for (int kh = 0; kh < 2; ++kh) { bf16x8 fa[8], fb[8];
#pragma unroll
                for (int ks = 0; ks < 8; ++ks) { fa[ks] = frag_row<528, 0>(base + O_QI, 32 * ta, 8 * kh + ks, lo); fb[ks] = frag_tr<136, 0>(base + O_CB, 0, 8 * kh + ks, 32 * tb, lo); }
                __builtin_amdgcn_sched_barrier(0);
#pragma unroll
                for (int ks = 0; ks < 8; ++ks) acc = __builtin_amdgcn_mfma_f32_32x32x16_bf16(fa[ks], fb[ks], acc, 0, 0, 0);
                __builtin_amdgcn_sched_barrier(0); }
        }
        { float s = 0.f;
#pragma unroll
          for (int c = 0; c < 4; ++c) { const v4u w = *(LAS const v4u*)(base + O_QI + ioff<528, 0>(lane, 4 * wave + c)); const f32x4 n0 = *(LAS const f32x4*)(Fa + F_NV + 32 * wave + 8 * c), n1 = *(LAS const f32x4*)(Fa + F_NV + 32 * wave + 8 * c + 4);
              s += bflo(w.x) * n0.x + bfhi(w.x) * n0.y + bflo(w.y) * n0.z + bfhi(w.y) * n0.w + bflo(w.z) * n1.x + bfhi(w.z) * n1.y + bflo(w.w) * n1.z + bfhi(w.w) * n1.w; }
          Fa[F_QNP + wave * 64 + lane] = s; }
        __syncthreads();
        if (wave >= 4) {
            { const int t = 32 * ta + l31;
              const float den = Fa[F_WIN + t] * (((Fa[F_QNP + t] + Fa[F_QNP + 64 + t]) + (Fa[F_QNP + 128 + t] + Fa[F_QNP + 192 + t])) + ((Fa[F_QNP + 256 + t] + Fa[F_QNP + 320 + t]) + (Fa[F_QNP + 384 + t] + Fa[F_QNP + 448 + t])))
                                + Fa[F_RSP + t] + Fa[F_RSP + 64 + t];
              if (hi == 0) Fa[F_CW + 32 * (wave - 4) + l31] = 1.0f / fmaxf(fabsf(den), Fa[F_EDEN + t]); }
#pragma unroll
            for (int g = 0; g < 4; ++g) { const f32x4 w4 = *(LAS const f32x4*)(Fa + F_WIN + 32 * ta + 8 * g + 4 * hi); acc[4 * g] *= w4.x; acc[4 * g + 1] *= w4.y; acc[4 * g + 2] *= w4.z; acc[4 * g + 3] *= w4.w; }
            { bf16x8 fa[4], fb[4];
#pragma unroll
              for (int ks = 0; ks < 4; ++ks) { fa[ks] = frag_row<144, 0>(base + O_PI, 32 * ta, ks, lo); fb[ks] = frag_tr<144, 0>(base + O_VI, 0, ks, 32 * tb, lo); }
              __builtin_amdgcn_sched_barrier(0);
#pragma unroll
              for (int ks = 0; ks < 4; ++ks) acc = __builtin_amdgcn_mfma_f32_32x32x16_bf16(fa[ks], fb[ks], acc, 0, 0, 0); }
            bf16* dst = F.YB() + (rowb + t0 + 32 * ta) * D + hh * 256 + 64 * sl + 32 * tb + l31;
#pragma unroll
            for (int g = 0; g < 4; ++g) { const f32x4 r4 = *(LAS const f32x4*)(Fa + F_CW + 32 * (wave - 4) + 8 * g + 4 * hi);
#pragma unroll
                for (int i = 0; i < 4; ++i) dst[(size_t)(8 * g + 4 * hi + i) * D] = (bf16)pk2(acc[4 * g + i] * r4[i], 0.f); }
        }
#pragma unroll
        for (int r = 0; r < 16; ++r) { C0[r] *= decay; C1[r] *= decay; C2[r] *= decay; }
        { bf16x8 bk[4], v0[4], v1[4], v2[4];
#pragma unroll
          for (int ks = 0; ks < 4; ++ks) { bk[ks] = frag_tr<528, 0>(base + O_KI, 0, ks, 32 * wave, lo); v0[ks] = frag_tr<144, 0>(base + O_VW, 0, ks, 0, lo); v1[ks] = frag_tr<144, 0>(base + O_VW, 0, ks, 32, lo); v2[ks] = frag_tr<144, 0>(base + O_VW, 0, ks, 64, lo); }
          __builtin_amdgcn_sched_barrier(0);
#pragma unroll
          for (int ks = 0; ks < 4; ++ks) { C0 = __builtin_amdgcn_mfma_f32_32x32x16_bf16(v0[ks], bk[ks], C0, 0, 0, 0); C1 = __builtin_amdgcn_mfma_f32_32x32x16_bf16(v1[ks], bk[ks], C1, 0, 0, 0); C2 = __builtin_amdgcn_mfma_f32_32x32x16_bf16(v2[ks], bk[ks], C2, 0, 0, 0); }
          __builtin_amdgcn_sched_barrier(0); }
        { const int d = 32 * wave + l31;
#pragma unroll
          for (int g = 0; g < 4; ++g) { const int e0 = 8 * g + 4 * hi;
              *(LAS unsigned long long*)(base + O_CB + ioff<136, 0>(d, e0 >> 3) + 2 * (e0 & 7)) = (unsigned long long)pk2(C0[4 * g], C0[4 * g + 1]) | ((unsigned long long)pk2(C0[4 * g + 2], C0[4 * g + 3]) << 32);
              *(LAS unsigned long long*)(base + O_CB + ioff<136, 0>(d, (32 + e0) >> 3) + 2 * (e0 & 7)) = (unsigned long long)pk2(C1[4 * g], C1[4 * g + 1]) | ((unsigned long long)pk2(C1[4 * g + 2], C1[4 * g + 3]) << 32); }
          if (hi == 0) Fa[F_NV + d] = C2[0];
        }
        __syncthreads();
      }
    }
#undef ML_PREFETCH
}
}


__device__ __forceinline__ void mlstm_gates(Frame& F, int job) {
    const int lane = opq(F.lane); const float LOG2E = 1.4426950408889634f;
    const float lf2 = F.lf()[(size_t)job * ml::L + lane] * LOG2E, ii2 = F.ipre()[(size_t)job * ml::L + lane] * LOG2E;
    float bb = lf2;
#pragma unroll
    for (int o = 1; o < 64; o <<= 1) { const float v = __shfl_up(bb, o); bb += (lane >= o) ? v : 0.f; }
    const float u = ii2 - bb; float pm = u;
#pragma unroll
    for (int o = 1; o < 64; o <<= 1) { const float v = __shfl_up(pm, o); pm = (lane >= o) ? fmaxf(pm, v) : pm; }
    float* gt = F.gt() + (size_t)job * 3 * 64 + lane;
    gt[0] = bb; gt[64] = u; gt[128] = pm;
}

__device__ __forceinline__ void mlstm_conv_rows(Frame& F) {
    const int tid = opq(F.tid), cg = tid & 255, z = cg >> 7, c0 = (cg & 127) * 8, r0 = F.vcu * 128 + 64 * (tid >> 8);
    const bf16* src = F.PROJ() + (size_t)(3 + z) * (SEG / 2) + c0; bf16* dst = (bf16*)F.out() + (size_t)z * T * D + c0;
    float w[4][8], bs[8];
#pragma unroll
    for (int tap = 0; tap < 4; ++tap) { const f32x4 a0 = *(const f32x4*)(F.conv_w() + tap * 2048 + cg * 8), a1 = *(const f32x4*)(F.conv_w() + tap * 2048 + cg * 8 + 4);
        w[tap][0] = a0.x; w[tap][1] = a0.y; w[tap][2] = a0.z; w[tap][3] = a0.w; w[tap][4] = a1.x; w[tap][5] = a1.y; w[tap][6] = a1.z; w[tap][7] = a1.w; }
    { const f32x4 a0 = *(const f32x4*)(F.conv_b() + cg * 8), a1 = *(const f32x4*)(F.conv_b() + cg * 8 + 4);
      bs[0] = a0.x; bs[1] = a0.y; bs[2] = a0.z; bs[3] = a0.w; bs[4] = a1.x; bs[5] = a1.y; bs[6] = a1.z; bs[7] = a1.w; }
    const float osc = z ? 0.0625f : 1.0f;
    const bool seq_start = (r0 % SEQ) == 0;
    v4u x0, x1, x2;
    { const v4u zero = {0u, 0u, 0u, 0u};
      x0 = seq_start ? zero : *(const v4u*)(src + (size_t)(r0 - 3 + (seq_start ? 3 : 0)) * D);
      x1 = seq_start ? zero : *(const v4u*)(src + (size_t)(r0 - 2 + (seq_start ? 2 : 0)) * D);
      x2 = seq_start ? zero : *(const v4u*)(src + (size_t)(r0 - 1 + (seq_start ? 1 : 0)) * D); }
    v4u nxs[8];
#pragma unroll
    for (int i = 0; i < 8; ++i) nxs[i] = *(const v4u*)(src + (size_t)(r0 + i) * D);
    for (int rr = 0; rr < 64; rr += 8) {
        v4u xs[8];
#pragma unroll
        for (int i = 0; i < 8; ++i) xs[i] = nxs[i];
        if (rr + 8 < 64) {
#pragma unroll
            for (int i = 0; i < 8; ++i) nxs[i] = *(const v4u*)(src + (size_t)(r0 + rr + 8 + i) * D); }
#pragma unroll
        for (int i = 0; i < 8; ++i) {
            const v4u x3 = xs[i]; float y[8];
#pragma unroll
            for (int c = 0; c < 8; ++c) y[c] = bs[c];
#define MK_TAP(tap, X) do { y[0] += w[tap][0] * bflo(X.x); y[1] += w[tap][1] * bfhi(X.x); y[2] += w[tap][2] * bflo(X.y); y[3] += w[tap][3] * bfhi(X.y); \
                           y[4] += w[tap][4] * bflo(X.z); y[5] += w[tap][5] * bfhi(X.z); y[6] += w[tap][6] * bflo(X.w); y[7] += w[tap][7] * bfhi(X.w); } while (0)
            MK_TAP(0, x0); MK_TAP(1, x1); MK_TAP(2, x2); MK_TAP(3, x3);
#undef MK_TAP
#pragma unroll
            for (int c = 0; c < 8; ++c) y[c] = ml::silu_f(y[c]) * osc;
            v4u o; o.x = pk2(y[0], y[1]); o.y = pk2(y[2], y[3]); o.z = pk2(y[4], y[5]); o.w = pk2(y[6], y[7]);
            *(v4u*)(dst + (size_t)(r0 + rr + i) * D) = o;
            x0 = x1; x1 = x2; x2 = x3;
        }
    }
}

__device__ __forceinline__ void mlstm_norm_rows(Frame& F) {
    const int row0 = F.vcu * 128, lane = opq(F.lane);
    const bf16* MLO = F.PROJ() + 6 * (SEG / 2);
    f32x4 G[4];
#pragma unroll
    for (int j = 0; j < 4; ++j) G[j] = *(const f32x4*)(F.ml_norm_g() + 256 * j + 4 * lane);
    unsigned long long nh[4], no[4];
#define NR_LOAD(ROW) do { const size_t row_ = (ROW); const GAS unsigned long long* hp_ = (const GAS unsigned long long*)(F.YB() + row_ * D) + lane; const GAS unsigned long long* op_ = (const GAS unsigned long long*)(MLO + row_ * D) + lane; \
        _Pragma("unroll") for (int j = 0; j < 4; ++j) { nh[j] = hp_[64 * j]; no[j] = op_[64 * j]; } } while (0)
    NR_LOAD((size_t)row0 + 16 * F.wave);
    for (int r = 0; r < 16; ++r) {
        const size_t row = (size_t)row0 + 16 * F.wave + r;
        GAS unsigned* hp = (GAS unsigned*)((unsigned char*)F.YB8() + row * D) + lane;
        unsigned long long ch[4], co[4];
#pragma unroll
        for (int j = 0; j < 4; ++j) { ch[j] = nh[j]; co[j] = no[j]; }
        if (r < 15) NR_LOAD(row + 1);
#pragma unroll
        for (int j = 0; j < 4; ++j) { const unsigned long long hw = ch[j], ow = co[j];
            const float h0 = bflo((unsigned)hw), h1 = bfhi((unsigned)hw), h2 = bflo((unsigned)(hw >> 32)), h3 = bfhi((unsigned)(hw >> 32));
            const float ss = wave_sum((h0 * h0 + h1 * h1) + (h2 * h2 + h3 * h3)); const float rstd = 1.0f / sqrtf(ss * (1.0f / 256.0f) + EPS);
            const float o0 = bflo((unsigned)ow), o1 = bfhi((unsigned)ow), o2 = bflo((unsigned)(ow >> 32)), o3 = bfhi((unsigned)(ow >> 32));
            const float y0 = h0 * rstd * G[j].x / (1.0f + __expf(-o0)), y1 = h1 * rstd * G[j].y / (1.0f + __expf(-o1)), y2 = h2 * rstd * G[j].z / (1.0f + __expf(-o2)), y3 = h3 * rstd * G[j].w / (1.0f + __expf(-o3));
            hp[64 * j] = pg8::pk4_fp8(y0, y1, y2, y3); }
    }
#undef NR_LOAD
}

namespace at {
using ml::bf16x8; using ml::s16x4; using ml::f32x16; using ml::ioff; using ml::frag_row; using ml::lcp; using ml::lp_t;
typedef _Float16 f16x8 __attribute__((ext_vector_type(8)));
typedef _Float16 f16x2 __attribute__((ext_vector_type(2)));
typedef float f32x2 __attribute__((ext_vector_type(2)));
constexpr int O_KI = 0, O_VI = 8192, O_FLAG = 16384;
template <int PITCH, int XM> __device__ __forceinline__ bf16x8 frag_trp(lcp img, int ks, int col0, int lane) {
    const int h = lane >> 5, blk = (lane >> 4) & 1, q = (lane & 15) >> 2, p = lane & 3;
    const int r0 = 16 * ks + 4 * h + q, ch = (col0 >> 3) + 2 * blk + (p >> 1);
    typedef short v4i16_t __attribute__((ext_vector_type(4)));
    const s16x4 a = __builtin_bit_cast(s16x4, __builtin_amdgcn_ds_read_tr16_b64_v4i16((LAS v4i16_t*)(img + ioff<PITCH, XM>(r0, ch) + 8 * (p & 1))));
    const s16x4 b = __builtin_bit_cast(s16x4, __builtin_amdgcn_ds_read_tr16_b64_v4i16((LAS v4i16_t*)(img + ioff<PITCH, XM>(r0 + 8, ch) + 8 * (p & 1))));
    return (bf16x8){a[0], a[1], a[2], a[3], b[0], b[1], b[2], b[3]};
}
__device__ __forceinline__ unsigned pkh(float a, float b) { const f32x2 v = {a, b}; return __builtin_bit_cast(unsigned, __builtin_convertvector(v, f16x2)); }
__device__ __forceinline__ f16x8 h8(unsigned a, unsigned b, unsigned c, unsigned d) { const v4u v = {a, b, c, d}; return __builtin_bit_cast(f16x8, v); }
__device__ __forceinline__ bf16x8 b8(unsigned a, unsigned b, unsigned c, unsigned d) { const v4u v = {a, b, c, d}; return __builtin_bit_cast(bf16x8, v); }

__device__ __forceinline__ void attn_unit(Frame& F, int bh, int qb) {
    const int b = bh >> 4, hd = bh & 15, tid = opq(F.tid), lane = opq(F.lane), wave = F.wave, hi = lane >> 5, l31 = lane & 31, pr = wave >> 1, tp = tid & 127;
    const bf16* Q = F.PROJ(); const bf16* K = F.PROJ() + SEG / 2; const bf16* V = F.PROJ() + SEG;
    lp_t base = (lp_t)F.lds + pr * 16384;
    LAS volatile int* dflag = (LAS volatile int*)((lp_t)F.lds + 65536);
    const size_t rowb = (size_t)b * SEQ; const int q0 = qb * 256, tw0 = q0 + 32 * wave, t = tw0 + l31, kt0 = qb * 4 + pr;
    bf16x8 qr[4];
#pragma unroll
    for (int ks = 0; ks < 4; ++ks) qr[ks] = *(const bf16x8*)(Q + (rowb + t) * D + hd * 64 + 16 * ks + 8 * hi);
    unsigned uw[2][4];
#pragma unroll
    for (int sp = 0; sp < 2; ++sp)
#pragma unroll
        for (int jj = 0; jj < 4; ++jj) { const int j0 = 2 * jj, j1 = 2 * jj + 1;
            const int k0 = 16 * sp + 8 * (j0 >> 2) + 4 * hi + (j0 & 3), k1 = 16 * sp + 8 * (j1 >> 2) + 4 * hi + (j1 & 3);
            uw[sp][jj] = (k0 > l31 ? 0x3C00u : 0u) | (k1 > l31 ? 0x3C000000u : 0u); }
    const f16x8 U0 = h8(uw[0][0], uw[0][1], uw[0][2], uw[0][3]), U1 = h8(uw[1][0], uw[1][1], uw[1][2], uw[1][3]), ONES = h8(0x3C003C00u, 0x3C003C00u, 0x3C003C00u, 0x3C003C00u);
    f32x16 O0, O1;
#pragma unroll
    for (int r = 0; r < 16; ++r) { O0[r] = 0.f; O1[r] = 0.f; }
    float R = 0.f; bool wdone = false;
    v4u kreg[4], vreg[4];
#define AT_LOAD(KT) do { _Pragma("unroll") for (int j = 0; j < 4; ++j) { const size_t g = (rowb + (KT) * 64 + (tp >> 3) + 16 * j) * D + hd * 64 + (tp & 7) * 8; kreg[j] = *(const v4u*)(K + g); vreg[j] = *(const v4u*)(V + g); } } while (0)
    AT_LOAD(kt0);
    __syncthreads();
    if (tid < 8) dflag[tid] = 0;
    for (int it = 0; it <= qb * 4 + 3; ++it) {
        const int kt = kt0 - it;
        __syncthreads();
        { int nd = 0;
#pragma unroll
          for (int w = 0; w < 8; ++w) nd += dflag[w];
          if (nd == 8) break; }
        if (kt >= 0) {
#pragma unroll
            for (int j = 0; j < 4; ++j) { *(LAS v4u*)(base + O_KI + ioff<128, 7>((tp >> 3) + 16 * j, tp & 7)) = kreg[j]; *(LAS v4u*)(base + O_VI + ioff<128, 7>((tp >> 3) + 16 * j, tp & 7)) = vreg[j]; } }
        __syncthreads();
        if (kt > 0) AT_LOAD(kt - 1);
        if (kt < 0) { if (!wdone) { wdone = true; if (lane == 0) dflag[wave] = 1; } continue; }
        if (wdone) continue;
        int lo = lane; asm volatile("" : "+v"(lo));
        f32x16 p0, p1;
#pragma unroll
        for (int r = 0; r < 16; ++r) { p0[r] = 0.f; p1[r] = 0.f; }
#pragma unroll
        for (int ks = 0; ks < 4; ++ks) { p0 = __builtin_amdgcn_mfma_f32_32x32x16_bf16(frag_row<128, 7>(base + O_KI, 0, ks, lo), qr[ks], p0, 0, 0, 0);
                                         p1 = __builtin_amdgcn_mfma_f32_32x32x16_bf16(frag_row<128, 7>(base + O_KI, 32, ks, lo), qr[ks], p1, 0, 0, 0); }
        const bool diag = (it == 0);
        const int trel = t - 64 * kt;
        float lk00 = 0.f;
        unsigned lkw0[8], lkw1[8];
#pragma unroll
        for (int r = 0; r < 16; ++r) {
            const int key0 = ml::crow(r, hi);
            { const float z = p0[r], lb = fminf(z, 0.f) - __builtin_amdgcn_logf(1.0f + __builtin_amdgcn_exp2f(-fabsf(z))); float lk = lb - z; if (diag && !(key0 < trel)) lk = 0.f; p0[r] = lb; if (r == 0) lk00 = lk;
              if (r & 1) lkw0[r >> 1] = pkh(__builtin_bit_cast(float, lkw0[r >> 1]), lk); else lkw0[r >> 1] = __builtin_bit_cast(unsigned, lk); }
            { const float z = p1[r], lb = fminf(z, 0.f) - __builtin_amdgcn_logf(1.0f + __builtin_amdgcn_exp2f(-fabsf(z))); float lk = lb - z; if (diag && !(key0 + 32 < trel)) lk = 0.f; p1[r] = lb;
              if (r & 1) lkw1[r >> 1] = pkh(__builtin_bit_cast(float, lkw1[r >> 1]), lk); else lkw1[r >> 1] = __builtin_bit_cast(unsigned, lk); }
        }
        f32x16 bt1, bt0;
#pragma unroll
        for (int r = 0; r < 16; ++r) { bt1[r] = R; bt0[r] = R; }
        const f16x8 L10 = h8(lkw1[0], lkw1[1], lkw1[2], lkw1[3]), L11 = h8(lkw1[4], lkw1[5], lkw1[6], lkw1[7]), L00 = h8(lkw0[0], lkw0[1], lkw0[2], lkw0[3]), L01 = h8(lkw0[4], lkw0[5], lkw0[6], lkw0[7]);
        bt1 = __builtin_amdgcn_mfma_f32_32x32x16_f16(U0, L10, bt1, 0, 0, 0); bt1 = __builtin_amdgcn_mfma_f32_32x32x16_f16(U1, L11, bt1, 0, 0, 0);
        bt0 = __builtin_amdgcn_mfma_f32_32x32x16_f16(ONES, L10, bt0, 0, 0, 0); bt0 = __builtin_amdgcn_mfma_f32_32x32x16_f16(ONES, L11, bt0, 0, 0, 0);
        bt0 = __builtin_amdgcn_mfma_f32_32x32x16_f16(U0, L00, bt0, 0, 0, 0); bt0 = __builtin_amdgcn_mfma_f32_32x32x16_f16(U1, L01, bt0, 0, 0, 0);
        { const float v = bt0[0] + lk00;
          const auto rr = __builtin_amdgcn_permlane32_swap(__builtin_bit_cast(unsigned, v), __builtin_bit_cast(unsigned, v), false, false);
          R = __builtin_bit_cast(float, rr[0]); }
        unsigned aw0[8], aw1[8];
#pragma unroll
        for (int r = 0; r < 16; r += 2) {
            const int key0 = ml::crow(r, hi);
            float a00 = __builtin_amdgcn_exp2f(p0[r] + bt0[r]), a01 = __builtin_amdgcn_exp2f(p0[r + 1] + bt0[r + 1]), a10 = __builtin_amdgcn_exp2f(p1[r] + bt1[r]), a11 = __builtin_amdgcn_exp2f(p1[r + 1] + bt1[r + 1]);
            if (diag) { if (!(key0 < trel)) a00 = 0.f; if (!(key0 + 1 < trel)) a01 = 0.f; if (!(key0 + 32 < trel)) a10 = 0.f; if (!(key0 + 33 < trel)) a11 = 0.f; }
            aw0[r >> 1] = pk2(a00, a01); aw1[r >> 1] = pk2(a10, a11);
        }
        const bf16x8 A00 = b8(aw0[0], aw0[1], aw0[2], aw0[3]), A01 = b8(aw0[4], aw0[5], aw0[6], aw0[7]), A10 = b8(aw1[0], aw1[1], aw1[2], aw1[3]), A11 = b8(aw1[4], aw1[5], aw1[6], aw1[7]);
        O0 = __builtin_amdgcn_mfma_f32_32x32x16_bf16(A00, frag_trp<128, 7>(base + O_VI, 0, 0, lo), O0, 0, 0, 0);  O1 = __builtin_amdgcn_mfma_f32_32x32x16_bf16(A00, frag_trp<128, 7>(base + O_VI, 0, 32, lo), O1, 0, 0, 0);
        O0 = __builtin_amdgcn_mfma_f32_32x32x16_bf16(A01, frag_trp<128, 7>(base + O_VI, 1, 0, lo), O0, 0, 0, 0);  O1 = __builtin_amdgcn_mfma_f32_32x32x16_bf16(A01, frag_trp<128, 7>(base + O_VI, 1, 32, lo), O1, 0, 0, 0);
        O0 = __builtin_amdgcn_mfma_f32_32x32x16_bf16(A10, frag_trp<128, 7>(base + O_VI, 2, 0, lo), O0, 0, 0, 0);  O1 = __builtin_amdgcn_mfma_f32_32x32x16_bf16(A10, frag_trp<128, 7>(base + O_VI, 2, 32, lo), O1, 0, 0, 0);
        O0 = __builtin_amdgcn_mfma_f32_32x32x16_bf16(A11, frag_trp<128, 7>(base + O_VI, 3, 0, lo), O0, 0, 0, 0);  O1 = __builtin_amdgcn_mfma_f32_32x32x16_bf16(A11, frag_trp<128, 7>(base + O_VI, 3, 32, lo), O1, 0, 0, 0);
        if (__all(R < ATT_RTHR)) { wdone = true; if (lane == 0) dflag[wave] = 1; }
    }
#undef AT_LOAD
    __syncthreads();
    unsigned char* dst = (unsigned char*)F.YA() + (rowb + tw0) * D + hd * 64 + l31;
#pragma unroll
    for (int r = 0; r < 16; ++r) { const int q = ml::crow(r, hi); dst[(size_t)q * D] = (unsigned char)pg8::pk4_fp8(O0[r], 0.f, 0.f, 0.f); dst[(size_t)q * D + 32] = (unsigned char)pg8::pk4_fp8(O1[r], 0.f, 0.f, 0.f); }
}
}

__device__ __forceinline__ void p5a_route(Frame& F) {
    const int row0 = F.vcu * 128, b = row0 / SEQ, lane = opq(F.lane), tid = opq(F.tid);
    LAS float* wr = (LAS float*)F.lds;
    LAS int* le = (LAS int*)(F.lds + 131584); LAS int* lp = le + 512;
    LAS int* lcnt = (LAS int*)(F.LC + LC_LCNT); LAS int* gbase = (LAS int*)(F.LC + LC_GBASE);
    for (int idx = tid; idx < 32768; idx += 512) wr[(idx & 31) * 1028 + (idx >> 5)] = F.router_w()[idx];
    if (tid < 32) lcnt[tid] = 0;
    f32x4 Av[4], Bv[4];
#pragma unroll
    for (int j = 0; j < 4; ++j) { const int col = 4 * lane + 256 * j; const float* mb = F.mod() + (size_t)b * NMOD;
        const f32x4 g = *(const f32x4*)(F.norm2_g() + col); Av[j] = g * (*(const f32x4*)(mb + 4 * D + col) + 1.0f); Bv[j] = *(const f32x4*)(mb + 3 * D + col); }
    float rb[32];
#pragma unroll
    for (int e = 0; e < 32; ++e) rb[e] = F.router_b()[e];
    __syncthreads();
    f32x4 nx[4];
    { const GAS f32x4* xr = (const GAS f32x4*)(F.out() + (size_t)(row0 + 16 * F.wave) * D) + lane;
#pragma unroll
      for (int j = 0; j < 4; ++j) nx[j] = xr[64 * j]; }
    for (int r = 0; r < 16; ++r) {
        const int rl = 16 * F.wave + r, row = row0 + rl;
        f32x4 v[4]; float ss = 0.f;
#pragma unroll
        for (int j = 0; j < 4; ++j) { v[j] = nx[j]; ss += (v[j].x * v[j].x + v[j].y * v[j].y) + (v[j].z * v[j].z + v[j].w * v[j].w); }
        if (r < 15) { const GAS f32x4* xr = (const GAS f32x4*)(F.out() + (size_t)(row + 1) * D) + lane;
#pragma unroll
            for (int j = 0; j < 4; ++j) nx[j] = xr[64 * j]; }
        const float rstd = 1.0f / sqrtf(wave_sum(ss) * (1.0f / D) + EPS);
        { GAS unsigned* o4 = (GAS unsigned*)((unsigned char*)F.H2() + (size_t)row * D) + lane;
#pragma unroll
          for (int j = 0; j < 4; ++j) { v[j] = v[j] * rstd * Av[j] + Bv[j]; o4[64 * j] = pg8::pk4_fp8(v[j].x, v[j].y, v[j].z, v[j].w); } }
        float p[32];
#pragma unroll
        for (int e = 0; e < 32; ++e) { float s = 0.f;
#pragma unroll
            for (int j = 0; j < 4; ++j) { const f32x4 w = *(const LAS f32x4*)(wr + e * 1028 + 4 * lane + 256 * j); s += (v[j].x * w.x + v[j].y * w.y) + (v[j].z * w.z + v[j].w * w.w); }
            p[e] = s; }
#pragma unroll
        for (int i = 0; i < 16; ++i) { const bool up = (lane & 32) != 0; const float send = up ? p[i] : p[i + 16], keep = up ? p[i + 16] : p[i]; p[i] = keep + __shfl_xor(send, 32); }
#pragma unroll
        for (int i = 0; i < 8; ++i) { const bool up = (lane & 16) != 0; const float send = up ? p[i] : p[i + 8], keep = up ? p[i + 8] : p[i]; p[i] = keep + __shfl_xor(send, 16); }
#pragma unroll
        for (int i = 0; i < 4; ++i) { const bool up = (lane & 8) != 0; const float send = up ? p[i] : p[i + 4], keep = up ? p[i + 4] : p[i]; p[i] = keep + __shfl_xor(send, 8); }
#pragma unroll
        for (int i = 0; i < 2; ++i) { const bool up = (lane & 4) != 0; const float send = up ? p[i] : p[i + 2], keep = up ? p[i + 2] : p[i]; p[i] = keep + __shfl_xor(send, 4); }
        { const bool up = (lane & 2) != 0; const float send = up ? p[0] : p[1], keep = up ? p[1] : p[0]; p[0] = keep + __shfl_xor(send, 2); }
        p[0] += __shfl_xor(p[0], 1);
        { LAS float* lg = (LAS float*)(F.lds + 135680) + F.wave * 32;
          if ((lane & 1) == 0) lg[lane >> 1] = p[0];
#pragma unroll
          for (int q = 0; q < 8; ++q) { const f32x4 t4 = *(const LAS f32x4*)(lg + 4 * q); p[4 * q] = t4.x + rb[4 * q]; p[4 * q + 1] = t4.y + rb[4 * q + 1]; p[4 * q + 2] = t4.z + rb[4 * q + 2]; p[4 * q + 3] = t4.w + rb[4 * q + 3]; } }
        int sel[4]; float sv[4]; unsigned used = 0u;
#pragma unroll
        for (int k = 0; k < 4; ++k) { float best = -3.0e38f; int bi = 0;
#pragma unroll
            for (int e = 0; e < 32; ++e) { const bool cnd = (((used >> e) & 1u) == 0u) && (p[e] > best); best = cnd ? p[e] : best; bi = cnd ? e : bi; }
            sel[k] = bi; sv[k] = best; used |= 1u << bi; }
        const float e1 = __expf(sv[1] - sv[0]), e2 = __expf(sv[2] - sv[0]), e3 = __expf(sv[3] - sv[0]), inv = 1.0f / (1.0f + e1 + e2 + e3);
        if (lane < 4) { const int ek = lane == 0 ? sel[0] : lane == 1 ? sel[1] : lane == 2 ? sel[2] : sel[3];
            const float wk = (lane == 0 ? 1.0f : lane == 1 ? e1 : lane == 2 ? e2 : e3) * inv;
            const int pos = __hip_atomic_fetch_add(lcnt + ek, 1, __ATOMIC_RELAXED, __HIP_MEMORY_SCOPE_WORKGROUP);
            le[rl * 4 + lane] = ek; lp[rl * 4 + lane] = pos; F.tokw()[(size_t)row * 4 + lane] = wk; }
        if (lane == 0) F.rstd2()[row] = rstd;
    }
    __syncthreads();
    if (tid < 32) gbase[tid] = (int)__hip_atomic_fetch_add(F.ctl + CW_ECNT + 64 * tid, (unsigned)lcnt[tid], __ATOMIC_RELAXED, __HIP_MEMORY_SCOPE_AGENT);
    __syncthreads();
    { const int ek = le[tid]; F.toke()[(size_t)row0 * 4 + tid] = ek; F.tokp()[(size_t)row0 * 4 + tid] = lp[tid] + gbase[ek]; }
}

__device__ __forceinline__ void p5b_tables(Frame& F) {
    const int row0 = F.vcu * 128, tid = opq(F.tid);
    LAS int* ts = (LAS int*)(F.LC + LC_TS); LAS int* ps = (LAS int*)(F.LC + LC_PS); LAS int* cn = (LAS int*)(F.LC + LC_CNT);
    if (tid < 32) cn[tid] = (int)__hip_atomic_load(F.ctl + CW_ECNT + 64 * tid, RLX_AGENT);
    __syncthreads();
    if (tid == 0) { int run = 0, trun = 0; for (int e = 0; e < 32; ++e) { ps[e] = run; ts[e] = trun; const int nt = (cn[e] + 255) >> 8; run += nt * 256; trun += nt; } ts[32] = trun; }
    __syncthreads();
    { const size_t idx = (size_t)row0 * 4 + tid; const int ek = F.toke()[idx], dst = ps[ek] + F.tokp()[idx]; F.tokrow()[idx] = dst; F.row2tok()[dst] = row0 + (tid >> 2); }
    if (F.vcu < 32) { const int e = F.vcu, start = ps[e] + cn[e], end = ps[e] + (((cn[e] + 255) >> 8) << 8); for (int r = start + tid; r < end; r += 512) F.row2tok()[r] = 0; }
}

__device__ __forceinline__ void p8_combine(Frame& F, bool poison) {
    const int row0 = F.vcu * 128, b = row0 / SEQ, lane = opq(F.lane);
    f32x4 G2[4], FG[4];
#pragma unroll
    for (int j = 0; j < 4; ++j) { const int col = 4 * lane + 256 * j; G2[j] = *(const f32x4*)(F.mod() + (size_t)b * NMOD + 5 * D + col); FG[j] = *(const f32x4*)(F.final_g() + col); }
    f32x4 nx[4]; unsigned long long ng[4][4]; float nw[4];
#define P8_LOAD(ROW) do { const size_t row_ = (ROW); const GAS f32x4* xr_ = (const GAS f32x4*)(F.out() + row_ * D) + lane; \
        _Pragma("unroll") for (int j = 0; j < 4; ++j) nx[j] = xr_[64 * j]; \
        _Pragma("unroll") for (int k = 0; k < 4; ++k) { const int src_ = F.tokrow()[row_ * 4 + k]; nw[k] = F.tokw()[row_ * 4 + k]; \
            const GAS unsigned long long* s8_ = (const GAS unsigned long long*)(F.OUTR() + (size_t)src_ * D) + lane; \
            _Pragma("unroll") for (int j = 0; j < 4; ++j) ng[k][j] = s8_[64 * j]; } } while (0)
    P8_LOAD((size_t)row0 + 16 * F.wave);
    for (int r = 0; r < 16; ++r) {
        const int row = row0 + 16 * F.wave + r;
        GAS f32x4* xr = (GAS f32x4*)(F.out() + (size_t)row * D) + lane;
        f32x4 y[4], xv[4];
#pragma unroll
        for (int j = 0; j < 4; ++j) { y[j] = (f32x4){0.f, 0.f, 0.f, 0.f}; xv[j] = nx[j]; }
#pragma unroll
        for (int k = 0; k < 4; ++k) { const float wk = nw[k];
#pragma unroll
            for (int j = 0; j < 4; ++j) { const unsigned long long w = ng[k][j]; y[j].x += wk * bflo((unsigned)w); y[j].y += wk * bfhi((unsigned)w); y[j].z += wk * bflo((unsigned)(w >> 32)); y[j].w += wk * bfhi((unsigned)(w >> 32)); } }
        if (r < 15) P8_LOAD((size_t)row + 1);
        f32x4 v[4]; float ss = 0.f;
#pragma unroll
        for (int j = 0; j < 4; ++j) { v[j] = xv[j] + G2[j] * y[j]; ss += (v[j].x * v[j].x + v[j].y * v[j].y) + (v[j].z * v[j].z + v[j].w * v[j].w); }
        const float rstd = 1.0f / sqrtf(wave_sum(ss) * (1.0f / D) + EPS);
        const float qn = __builtin_nanf("");
#pragma unroll
        for (int j = 0; j < 4; ++j) { f32x4 o = v[j] * rstd * FG[j]; if (poison) o = (f32x4){qn, qn, qn, qn}; xr[64 * j] = o; }
    }
#undef P8_LOAD
}

#ifndef MK_REP_G2
#define MK_REP_G2 1
#endif
#ifndef MK_REP_G4A
#define MK_REP_G4A 1
#endif
#ifndef MK_REP_G4B
#define MK_REP_G4B 1
#endif
#ifndef MK_REP_G4C
#define MK_REP_G4C 1
#endif
#ifndef MK_REP_G6
#define MK_REP_G6 1
#endif
#ifndef MK_REP_G7
#define MK_REP_G7 1
#endif
#ifndef MK_REP_P0
#define MK_REP_P0 1
#endif
#ifndef MK_REP_P3
#define MK_REP_P3 1
#endif
struct Args { const float* in[22]; float* out; unsigned char* ws; };
__global__ void __launch_bounds__(NWAVES * 64, 2) mk_fwd(Args args) {
    extern __shared__ __attribute__((aligned(16))) unsigned char lds[];
    Frame F;
    F.lds = (LAS unsigned char*)lds; F.LC = (volatile LAS unsigned*)(F.lds + LDSCTL_OFF);
    F.tid = threadIdx.x; F.lane = F.tid & 63; F.wave = __builtin_amdgcn_readfirstlane(F.tid >> 6);
    F.G = gridDim.x; { const int bx = blockIdx.x; F.vcu = (F.G % 8 == 0) ? (bx % 8) * (F.G / 8) + bx / 8 : bx; }
    F.ws = (unsigned char*)(GAS unsigned char*)karg(23);
    F.ctl = (gu32*)(F.ws + WS_CTL);
    for (int u = F.tid; u < (LDS_BYTES - LDSCTL_OFF) / 4; u += NWAVES * 64) ((LAS unsigned*)(F.lds + LDSCTL_OFF))[u] = 0u;
    __syncthreads();
    XcdBarrier bar = xcd_barrier_post((unsigned*)(F.ctl + CW_BAR), F.LC + LC_BAR);
#define GRID_BAR() xcd_barrier(bar)
    const int G = F.G, cid = (int)blockIdx.x;

    for (int rep_ = 0; rep_ < MK_REP_P0; ++rep_) p0_prologue(F);
    GRID_BAR();
    p1_rows(F);
    GRID_BAR();
    { pg8::Gemm g{F.H1(), F.WIN_T(), T, NPROJ, D / 2}; pg8::StaticOrder S; S.init(T, NPROJ, G, cid);
      pg8::EpiBf16<0> E{F.PROJ(), D, nullptr, D, SEG / 2, QSCALE, 1.0f / W8SCALE};
      for (int rep_ = 0; rep_ < MK_REP_G2; ++rep_) pg8::gemm_phase<pg8::EpiBf16<0>, pg8::StaticOrder, true, true, false, true>(F.lds, g, S, E); }
    GRID_BAR();
    for (int job = F.vcu * NWAVES + F.wave; job < BATCH * 4 * (SEQ / 64); job += G * NWAVES) mlstm_gates(F, job);
    mlstm_conv_rows(F);
    GRID_BAR();
#if defined(MK_NAIVE_MLSTM)
    for (int it = F.vcu; it < 1024; it += G) attn_naive_item(F, it & 255, it >> 8);
    __syncthreads();
    for (int it = F.vcu; it < 64; it += G) mlstm_naive_item(F, it);
#else
    for (int rep_ = 0; rep_ < MK_REP_P3; ++rep_) {
    for (int it = F.vcu; it < 256; it += G) ml::mlstm_unit(F, it);
    __syncthreads();
#if defined(MK_NAIVE_ATTN)
    for (int it = F.vcu; it < 1024; it += G) attn_naive_item(F, it & 255, it >> 8);
#else
    for (int it = F.vcu; it < 2048; it += G) at::attn_unit(F, it & 255, it >> 8);
#endif
    }
#endif
    GRID_BAR();
    { pg8::Gemm g{F.YA(), F.WA_T(), T, D, D / 2}; pg8::StaticOrder S; S.init(T, D, G, cid);
      pg8::EpiGate<false> E{F.PROJ() + 7 * (SEG / 2), nullptr, F.M1(), 1.0f / W8SCALE};
      for (int rep_ = 0; rep_ < MK_REP_G4A; ++rep_) pg8::gemm_phase<pg8::EpiGate<false>, pg8::StaticOrder, true, true, false, true>(F.lds, g, S, E); }
#if defined(MK_NAIVE_MLSTM)
    VM_WAIT(); __syncthreads();
#else
    __syncthreads();
    mlstm_norm_rows(F);
    GRID_BAR();
#endif
    { pg8::Gemm g{F.YB8(), F.WB_T(), T, D, D / 2}; pg8::StaticOrder S; S.init(T, D, G, cid);
      pg8::EpiGate<true, true> E{F.PROJ() + 8 * (SEG / 2), F.M1(), F.MERGED(), 1.0f / W8SCALE};
      for (int rep_ = 0; rep_ < MK_REP_G4B; ++rep_) pg8::gemm_phase<pg8::EpiGate<true, true>, pg8::StaticOrder, true, true, false, true>(F.lds, g, S, E); }
    GRID_BAR();
    { pg8::Gemm g{F.MERGED(), F.WOUT_T(), T, D, D / 2}; pg8::StaticOrder S; S.init(T, D, G, cid);
      pg8::EpiResid E{F.x(), F.mod() + 2 * D, F.out(), SEQ, NMOD, 1.0f / W8SCALE};
      for (int rep_ = 0; rep_ < MK_REP_G4C; ++rep_) pg8::gemm_phase<pg8::EpiResid, pg8::StaticOrder, true, true, false, true>(F.lds, g, S, E); }
    GRID_BAR();
    p5a_route(F);
    GRID_BAR();
    p5b_tables(F);
    GRID_BAR();
    { pg8::Gemm g{F.H2(), F.W1_T(), T, NE * 2048, D / 2}; pg8::GroupedOrder S{(const LAS int*)(F.LC + LC_TS), 8, G, cid, F.row2tok()};
      pg8::EpiSwiglu<true> E{F.b1(), F.ACT(), 1.0f / W8SCALE};
      for (int rep_ = 0; rep_ < MK_REP_G6; ++rep_) pg8::gemm_phase<pg8::EpiSwiglu<true>, pg8::GroupedOrder, true, true, true, true>(F.lds, g, S, E); }
    GRID_BAR();
    { pg8::Gemm g{F.ACT(), F.W2_T(), XS_ROWS, NE * 1024, D / 2}; pg8::GroupedOrder S{(const LAS int*)(F.LC + LC_TS), 4, G, cid, nullptr};
      pg8::EpiOutS E{F.OUTR(), F.b2(), 1.0f / W8SCALE};
      for (int rep_ = 0; rep_ < MK_REP_G7; ++rep_) pg8::gemm_phase<pg8::EpiOutS, pg8::GroupedOrder, true, true, false, true>(F.lds, g, S, E); }
    GRID_BAR();
    { const bool poison = __hip_atomic_load(F.ctl + CW_BAR + XB_TMO, RLX_AGENT) != 0u;
      p8_combine(F, poison); }
}

extern "C" void kernel_launch(void* const* d_in, const int* in_sizes, int n_in, void* d_out, int out_size, void* d_ws, size_t ws_size, hipStream_t stream) {
    static int grid = 0;
    if (grid == 0) {
        if (n_in != 22 || in_sizes[0] != T * D || out_size != T * D || ws_size < WS_END) { fprintf(stderr, "kernel_launch: unexpected shapes (n_in %d, in0 %d, out %d, ws %zu)\n", n_in, n_in > 0 ? in_sizes[0] : -1, out_size, ws_size); grid = -1; return; }
        int dev = 0, cus = 0, per_cu = 0;
        if (hipGetDevice(&dev) != hipSuccess || hipDeviceGetAttribute(&cus, hipDeviceAttributeMultiprocessorCount, dev) != hipSuccess) { grid = -1; return; }
        if (hipFuncSetAttribute((const void*)mk_fwd, hipFuncAttributeMaxDynamicSharedMemorySize, LDS_BYTES) != hipSuccess) { fprintf(stderr, "kernel_launch: hipFuncSetAttribute failed\n"); grid = -1; return; }
        if (hipOccupancyMaxActiveBlocksPerMultiprocessor(&per_cu, (const void*)mk_fwd, NWAVES * 64, LDS_BYTES) != hipSuccess || per_cu < 1) { fprintf(stderr, "kernel_launch: occupancy query says %d blocks per CU\n", per_cu); }
        (void)hipGetLastError();
        if (cus < 256) { fprintf(stderr, "kernel_launch: built for a 256-CU device, found %d CUs\n", cus); grid = -1; return; }
        grid = 256;
    }
    if (grid < 0) return;
    if (hipMemsetAsync((char*)d_ws + WS_CTL, 0, CTL_ZERO_BYTES, stream) != hipSuccess) return;
    Args a{};
    for (int i = 0; i < 22; ++i) a.in[i] = (const float*)d_in[i];
    a.out = (float*)d_out; a.ws = (unsigned char*)d_ws;
    hipLaunchKernelGGL(mk_fwd, dim3(grid), dim3(NWAVES * 64), LDS_BYTES, stream, a);
}
```

```cpp
#include <hip/hip_runtime.h>
#include <cstdio>
#include <cstdint>
namespace pg8 {
#define PG8_LAS __attribute__((address_space(3)))
typedef unsigned short bf16_t;
typedef short bf16x8 __attribute__((ext_vector_type(8)));
typedef float f32x4 __attribute__((ext_vector_type(4)));
typedef unsigned u32x4 __attribute__((ext_vector_type(4)));
typedef int i32x4_ __attribute__((ext_vector_type(4))); typedef int i32x8_ __attribute__((ext_vector_type(8)));
constexpr int BM = 256, BK = 64, HALF = 128, HTB = HALF * BK * 2  , STAGE_BYTES = 8 * HTB, NXCD = 8, WGM = 8;

__host__ __device__ __forceinline__ int lds_byte(int r, int c) { const int st = (r >> 4) * 2 + (c >> 5), rr = r & 15, cc = c & 31, ob = rr * 64 + cc * 2; return st * 1024 + (ob ^ (((ob >> 9) & 1) << 5)); }
__host__ __device__ __forceinline__ void stage_rc(int b, int& R, int& C) { const int st = b / 1024, sb = b % 1024, swz = sb ^ (((sb >> 9) & 1) << 5); R = (st >> 1) * 16 + swz / 64; C = (st & 1) * 32 + (swz % 64) / 2; }
__host__ __device__ __forceinline__ int perm32(int rho) { const int n = rho >> 4, i = rho & 15; return 8 * (i >> 2) + 4 * n + (i & 3); }

struct Unit { int pm, pn; };
struct Gemm { const bf16_t* A; const bf16_t* Bt; int M, N, K; };

struct StaticOrder {
    int nM, nN, nwg, G, c;
    __host__ __device__ void init(int M, int N, int G_, int c_) { nM = M / BM; nN = N / BM; nwg = nM * nN; G = G_; c = c_; }
    __host__ __device__ bool next(int i, Unit& u) const {
        const long L = (long)i * G + c; if (L >= nwg) return false;
        int wgid = (int)L; { const int q = nwg / NXCD, r = nwg % NXCD, xcd = wgid % NXCD, off = wgid / NXCD; wgid = (xcd < r ? xcd * (q + 1) : r * (q + 1) + (xcd - r) * q) + off; }
        const int nig = WGM * nN, gid = wgid / nig, fm = gid * WGM, gsz = (nM - fm) < WGM ? (nM - fm) : WGM;
        u.pm = fm + ((wgid % nig) % gsz); u.pn = (wgid % nig) / gsz; return true;
    }
    __device__ __forceinline__ void a_ready(const Unit&) const {}
    __device__ __forceinline__ void done(const Unit&) const {}
};

__device__ __forceinline__ unsigned cvt_pk_bf16(float lo, float hi) { unsigned r; asm volatile("v_cvt_pk_bf16_f32 %0, %1, %2" : "=v"(r) : "v"(lo), "v"(hi)); return r; }
typedef float f32x2 __attribute__((ext_vector_type(2)));
__device__ __forceinline__ f32x2 gelu_pk(f32x2 v) {
    const f32x2 av = __builtin_elementwise_abs(v), d = av * 0.2316418882f + 1.0f;
    f32x2 t; t.x = __builtin_amdgcn_rcpf(d.x); t.y = __builtin_amdgcn_rcpf(d.y);
    f32x2 q = t * 0.5307027145f + (-0.7265760135f); q = q * t + 0.7107068705f; q = q * t + (-0.142248368f); q = q * t + 0.127414796f; q = q * t;
    const f32x2 s = (v * v) * (-0.72134752044f);
    f32x2 e; e.x = __builtin_amdgcn_exp2f(s.x); e.y = __builtin_amdgcn_exp2f(s.y);
    const f32x2 m = v * (q * e), r = v - m;
    f32x2 o; o.x = v.x < 0.f ? m.x : r.x; o.y = v.y < 0.f ? m.y : r.y; return o;
}

__device__ __forceinline__ void xchg8(const u32x4& w0, const u32x4& w1, u32x4& d1, u32x4& d2) {
#pragma unroll
    for (int i = 0; i < 4; ++i) {
        d1[i] = (unsigned)__builtin_amdgcn_update_dpp((int)w0[i], (int)w1[i], 0x128, 0xf, 0xc, false);
        d2[i] = (unsigned)__builtin_amdgcn_update_dpp((int)w1[i], (int)w0[i], 0x128, 0xf, 0x3, false);
    }
}
template <int ACT  > struct EpiBf16 {
    static constexpr bool PERM = true, PERM2 = true, AFTER_DRAIN = false; static_assert(ACT == 0 || ACT == 1, "EpiBf16: ACT is 0 (none) or 1 (gelu_pk)");
    bf16_t* O; int ldc; const float* bias; int split_cols; size_t split_stride; float scale0; float ascale;
    __device__ __forceinline__ void operator()(const f32x4 (&acc)[2][2][4][2], const Unit& u, int wr, int wc, int fr, int fq) const {
        int colt = u.pn * BM; bf16_t* base = O;
        float sc = ascale; if (split_cols) { const int t = colt / split_cols; base += (size_t)t * split_stride; colt -= t * split_cols; if (t == 0) sc = scale0 * ascale; }
        const int bcol0 = u.pn * BM + wc * 64 + 16 * fq;
        f32x4 bv[2][2];
#pragma unroll
        for (int bj = 0; bj < 2; ++bj)
#pragma unroll
            for (int n = 0; n < 2; ++n) bv[bj][n] = bias ? *(const f32x4*)(bias + bcol0 + 8 * bj + 4 * n) : (f32x4){0.f, 0.f, 0.f, 0.f};
        bf16_t* lp = base + (size_t)(u.pm * BM + wr * 64 + (fr & 7)) * ldc + colt + wc * 64 + 16 * fq + 8 * (fr >> 3);
#pragma unroll
        for (int ai = 0; ai < 2; ++ai)
#pragma unroll
            for (int m = 0; m < 4; ++m) { u32x4 w[2];
#pragma unroll
                for (int bj = 0; bj < 2; ++bj) { f32x4 v0 = acc[ai][bj][m][0] + bv[bj][0], v1 = acc[ai][bj][m][1] + bv[bj][1];
                    if (ACT == 1) { f32x2 a = gelu_pk((f32x2){v0[0], v0[1]}), b = gelu_pk((f32x2){v0[2], v0[3]}), c = gelu_pk((f32x2){v1[0], v1[1]}), d = gelu_pk((f32x2){v1[2], v1[3]});
                        v0 = (f32x4){a.x, a.y, b.x, b.y}; v1 = (f32x4){c.x, c.y, d.x, d.y}; }
                    v0 = v0 * sc; v1 = v1 * sc; w[bj].x = cvt_pk_bf16(v0[0], v0[1]); w[bj].y = cvt_pk_bf16(v0[2], v0[3]); w[bj].z = cvt_pk_bf16(v1[0], v1[1]); w[bj].w = cvt_pk_bf16(v1[2], v1[3]); }
                u32x4 d1, d2; xchg8(w[0], w[1], d1, d2);
                bf16_t* rowp = lp + (size_t)(ai * HALF + m * 16) * ldc;
                __builtin_nontemporal_store(d1, (u32x4*)rowp); __builtin_nontemporal_store(d2, (u32x4*)(rowp + (size_t)8 * ldc)); }
    }
};
template <class Epi, class Sched, bool ALIGN_EPI = false, bool SP2 = false, bool GATHER = false, bool FP8 = false>
__device__ __forceinline__ void gemm_phase(PG8_LAS unsigned char* lds, const Gemm g, const Sched& S, const Epi& E) {
    int tid_ = threadIdx.x; asm volatile("" : "+v"(tid_));
    const int tid = tid_, wid = __builtin_amdgcn_readfirstlane(tid >> 6), lane = tid & 63, wr = wid >> 2, wc = wid & 3, fr = lane & 15, fq = lane >> 4;
    const int K = g.K, nt = K / BK;
    unsigned voffA[2], voffB[2], vA0[2], vA1[2], vN0[2], vN1[2]; int Rr_[2], Cc_[2];
#pragma unroll
    for (int i = 0; i < 2; ++i) { int R, C; stage_rc(tid * 16 + i * 8192, R, C); const int Rb = Epi::PERM2 ? (64 * (R >> 5) + 16 * ((R >> 2) & 3) + 4 * ((R >> 4) & 1) + (R & 3)) : (Epi::PERM ? ((R & ~31) + perm32(R & 31)) : R);
        voffA[i] = (unsigned)(R * K + C) * 2u; voffB[i] = (unsigned)(Rb * K + C) * 2u; Rr_[i] = R; Cc_[i] = C; }
    const size_t kstep = (size_t)(BK * 2);
    const size_t hstep = (size_t)HALF * K * 2;
    const size_t tstep = 2 * hstep;
    const size_t bhstep = Epi::PERM2 ? (size_t)8 * K * 2 : hstep;
#pragma unroll
    for (int i = 0; i < 2; ++i) { vA0[i] = voffA[i]; vA1[i] = voffA[i] + (unsigned)hstep; vN0[i] = vA0[i]; vN1[i] = vA1[i]; }
#define PG8_GLOAD(u, v0, v1) do { _Pragma("unroll") for (int _i = 0; _i < 2; ++_i) { const int _t0 = S.rowtok[(u).pm * BM + Rr_[_i]], _t1 = S.rowtok[(u).pm * BM + HALF + Rr_[_i]]; \
        (v0)[_i] = (unsigned)_t0 * (unsigned)(K * 2) + (unsigned)(Cc_[_i] * 2); (v1)[_i] = (unsigned)_t1 * (unsigned)(K * 2) + (unsigned)(Cc_[_i] * 2); } } while (0)
    const unsigned ldsw = (unsigned)wid * 1024u;
    const int aoff = lds_byte(wr * 64 + fr, fq * 8), boff = lds_byte(wc * 32 + fr, fq * 8);
#define PG8_SA(b, h) (((b) * 2 + (h)) * HTB)
#define PG8_SB(b, h) ((4 + (b) * 2 + (h)) * HTB)
#define PG8_STAGE(bufoff, gbase, voff) do { _Pragma("unroll") for (int _i = 0; _i < 2; ++_i) \
        __builtin_amdgcn_global_load_lds((const unsigned*)((const char*)(gbase) + (voff)[_i]), (PG8_LAS unsigned*)(lds + (bufoff) + ldsw + _i * 8192), 16, 0, 0); } while (0)
#define PG8_LDA(dst, b, h) do { _Pragma("unroll") for (int m = 0; m < 4; ++m) _Pragma("unroll") for (int k = 0; k < 2; ++k) dst[m][k] = *(const PG8_LAS bf16x8*)(lds + PG8_SA(b, h) + aoff + m * 2048 + k * 1024); } while (0)
#define PG8_LDB(dst, b, h) do { _Pragma("unroll") for (int n = 0; n < 2; ++n) _Pragma("unroll") for (int k = 0; k < 2; ++k) dst[n][k] = *(const PG8_LAS bf16x8*)(lds + PG8_SB(b, h) + boff + n * 2048 + k * 1024); } while (0)
#define PG8_MMA(ai, bj, At, Bt) do { __builtin_amdgcn_s_setprio(1); _Pragma("unroll") for (int m = 0; m < 4; ++m) _Pragma("unroll") for (int n = 0; n < 2; ++n) _Pragma("unroll") for (int k = 0; k < 2; ++k) \
        acc[ai][bj][m][n] = __builtin_amdgcn_mfma_f32_16x16x32_bf16(Bt[n][k], At[m][k], acc[ai][bj][m][n], 0, 0, 0); __builtin_amdgcn_s_setprio(0); } while (0)
#define PG8_CAT8(x0, x1) __builtin_shufflevector(__builtin_bit_cast(i32x4_, x0), __builtin_bit_cast(i32x4_, x1), 0, 1, 2, 3, 4, 5, 6, 7)
#define PG8_MFMA8(ACC, B8, A8) asm volatile("s_nop 1\n\tv_mfma_scale_f32_16x16x128_f8f6f4 %0, %1, %2, %0, %3, %3 op_sel_hi:[0,0,0]" : "+v"(ACC) : "v"(B8), "v"(A8), "v"(sc8_))
#define PG8_MMA8(ai, bj, At, Bt) do { i32x8_ a8_[4], b8_[2]; _Pragma("unroll") for (int m = 0; m < 4; ++m) a8_[m] = PG8_CAT8(At[m][0], At[m][1]); _Pragma("unroll") for (int n = 0; n < 2; ++n) b8_[n] = PG8_CAT8(Bt[n][0], Bt[n][1]); \
        __builtin_amdgcn_s_setprio(1); _Pragma("unroll") for (int m = 0; m < 4; ++m) _Pragma("unroll") for (int n = 0; n < 2; ++n) PG8_MFMA8(acc[ai][bj][m][n], b8_[n], a8_[m]); __builtin_amdgcn_s_setprio(0); } while (0)
#define PG8_MM(ai, bj, At, Bt) do { if constexpr (FP8) PG8_MMA8(ai, bj, At, Bt); else PG8_MMA(ai, bj, At, Bt); } while (0)
#define PG8_WAIT_V(n) asm volatile("s_waitcnt vmcnt(" #n ")" ::: "memory")
#define PG8_WAIT_L(n) asm volatile("s_waitcnt lgkmcnt(" #n ")" ::: "memory")
#define PG8_BAR __builtin_amdgcn_s_barrier()
#define PG8_SCHED __builtin_amdgcn_sched_barrier(0)
    const int sc8_ = 0x7F7F7F7F;
    Unit cur, nxt; int ui = 0;
    if (!S.next(0, cur)) return;
    f32x4 acc[2][2][4][2];
#pragma unroll
    for (int a = 0; a < 2; ++a)
#pragma unroll
        for (int b = 0; b < 2; ++b)
#pragma unroll
            for (int m = 0; m < 4; ++m)
#pragma unroll
                for (int n = 0; n < 2; ++n) acc[a][b][m][n] = (f32x4){0.f, 0.f, 0.f, 0.f};
    bf16x8 At[4][2], B0[2][2], B1[2][2];
    if constexpr (GATHER) PG8_GLOAD(cur, vA0, vA1);
    const char* cA = GATHER ? (const char*)g.A : (const char*)g.A + (size_t)cur.pm * tstep; const char* cB = (const char*)g.Bt + (size_t)cur.pn * tstep;
    S.a_ready(cur);
    if constexpr (SP2) {
        PG8_STAGE(PG8_SB(0, 0), cB, voffB); PG8_STAGE(PG8_SB(0, 1), cB + bhstep, voffB); PG8_STAGE(PG8_SA(0, 0), cA, vA0); PG8_STAGE(PG8_SA(0, 1), cA, vA1);
        if (wr == 1) PG8_BAR;
        PG8_WAIT_V(2); PG8_BAR;
        PG8_STAGE(PG8_SB(1, 0), cB + kstep, voffB); PG8_STAGE(PG8_SA(1, 0), cA + kstep, vA0); PG8_STAGE(PG8_SB(1, 1), cB + bhstep + kstep, voffB);
        PG8_WAIT_V(6); PG8_BAR;
    } else {
        PG8_STAGE(PG8_SB(0, 0), cB, voffB); PG8_STAGE(PG8_SA(0, 0), cA, vA0); PG8_STAGE(PG8_SB(0, 1), cB + bhstep, voffB); PG8_STAGE(PG8_SA(0, 1), cA, vA1);
        if (wr == 1) PG8_BAR;
        PG8_WAIT_V(4); PG8_BAR;
        PG8_STAGE(PG8_SB(1, 0), cB + kstep, voffB); PG8_STAGE(PG8_SA(1, 0), cA + kstep, vA0); PG8_STAGE(PG8_SB(1, 1), cB + bhstep + kstep, voffB);
        PG8_WAIT_V(6); PG8_BAR;
    }
    for (;;) {
        const bool has_next = S.next(ui + 1, nxt);
        if constexpr (GATHER) { if (has_next) PG8_GLOAD(nxt, vN0, vN1); else { _Pragma("unroll") for (int i = 0; i < 2; ++i) { vN0[i] = vA0[i]; vN1[i] = vA1[i]; } } }
        const char* nA = GATHER ? (const char*)g.A : (has_next ? (const char*)g.A + (size_t)nxt.pm * tstep : cA); const char* nB = has_next ? (const char*)g.Bt + (size_t)nxt.pn * tstep : cB;
        for (int t = 0; t < nt; t += 2) {
            const bool last = (t == nt - 2);
            const char* a1 = cA + (size_t)(t + 1) * kstep;
            const char* a2 = last ? nA : cA + (size_t)(t + 2) * kstep; const char* b2 = last ? nB : cB + (size_t)(t + 2) * kstep;
            const char* a3 = a2 + kstep; const char* b3 = b2 + kstep;
            unsigned vX0[2], vX1[2];
#pragma unroll
            for (int i = 0; i < 2; ++i) { vX0[i] = (GATHER && last) ? vN0[i] : vA0[i]; vX1[i] = (GATHER && last) ? vN1[i] : vA1[i]; }
            if (last && has_next) S.a_ready(nxt);
            if constexpr (SP2) {
            PG8_LDB(B0, 0, 0); PG8_LDB(B1, 0, 1); PG8_SCHED; PG8_LDA(At, 0, 0); PG8_STAGE(PG8_SA(1, 1), a1, vA1);
            PG8_WAIT_V(8); PG8_WAIT_L(0); PG8_BAR; PG8_MM(0, 0, At, B0); PG8_MM(0, 1, At, B1); PG8_BAR; PG8_SCHED;
            PG8_LDA(At, 0, 1); PG8_STAGE(PG8_SB(0, 0), b2, voffB); PG8_STAGE(PG8_SB(0, 1), b2 + bhstep, voffB); PG8_STAGE(PG8_SA(0, 0), a2, vX0);
            PG8_WAIT_V(8); PG8_WAIT_L(0); PG8_BAR; PG8_MM(1, 0, At, B0); PG8_MM(1, 1, At, B1); PG8_BAR; PG8_SCHED;
            PG8_LDB(B0, 1, 0); PG8_LDB(B1, 1, 1); PG8_SCHED; PG8_LDA(At, 1, 0); PG8_STAGE(PG8_SA(0, 1), a2, vX1);
            PG8_WAIT_V(8); PG8_WAIT_L(0); PG8_BAR; PG8_MM(0, 0, At, B0); PG8_MM(0, 1, At, B1); PG8_BAR; PG8_SCHED;
            PG8_LDA(At, 1, 1); PG8_STAGE(PG8_SB(1, 0), b3, voffB); PG8_STAGE(PG8_SB(1, 1), b3 + bhstep, voffB); PG8_STAGE(PG8_SA(1, 0), a3, vX0);
            PG8_WAIT_V(8); PG8_WAIT_L(0); PG8_BAR; PG8_MM(1, 0, At, B0); PG8_MM(1, 1, At, B1); PG8_BAR; PG8_SCHED;
            } else {
            PG8_LDB(B0, 0, 0); PG8_SCHED; PG8_LDA(At, 0, 0); PG8_STAGE(PG8_SA(1, 1), a1, vA1);
            PG8_WAIT_L(8); PG8_BAR; PG8_WAIT_L(0); PG8_MM(0, 0, At, B0); PG8_BAR; PG8_SCHED;
            PG8_LDB(B1, 0, 1); PG8_STAGE(PG8_SB(0, 0), b2, voffB);
            PG8_BAR; PG8_WAIT_L(0); PG8_MM(0, 1, At, B1); PG8_BAR;
            PG8_LDA(At, 0, 1); PG8_STAGE(PG8_SA(0, 0), a2, vX0);
            PG8_BAR; PG8_WAIT_L(0); PG8_MM(1, 0, At, B0); PG8_BAR; PG8_SCHED;
            PG8_STAGE(PG8_SB(0, 1), b2 + bhstep, voffB);
            PG8_WAIT_V(6); PG8_BAR; PG8_MM(1, 1, At, B1); PG8_BAR;
            PG8_LDB(B0, 1, 0); PG8_SCHED; PG8_LDA(At, 1, 0); PG8_STAGE(PG8_SA(0, 1), a2, vX1);
            PG8_WAIT_L(8); PG8_BAR; PG8_WAIT_L(0); PG8_MM(0, 0, At, B0); PG8_BAR; PG8_SCHED;
            PG8_LDB(B1, 1, 1); PG8_STAGE(PG8_SB(1, 0), b3, voffB);
            PG8_BAR; PG8_WAIT_L(0); PG8_MM(0, 1, At, B1); PG8_BAR;
            PG8_LDA(At, 1, 1); PG8_STAGE(PG8_SA(1, 0), a3, vX0);
            PG8_BAR; PG8_WAIT_L(0); PG8_MM(1, 0, At, B0); PG8_BAR; PG8_SCHED;
            PG8_STAGE(PG8_SB(1, 1), b3 + bhstep, voffB);
            PG8_WAIT_V(6); PG8_BAR; PG8_MM(1, 1, At, B1); PG8_BAR;
            }
        }
        if constexpr (ALIGN_EPI) { if (wr == 0) PG8_BAR; }
        if constexpr (FP8) asm volatile("s_nop 15\n\ts_nop 15" ::: "memory");
        if constexpr (!Epi::AFTER_DRAIN) { E(acc, cur, wr, wc, fr, fq); S.done(cur); }
        if (!has_next) break;
#pragma unroll
        for (int a = 0; a < 2; ++a)
#pragma unroll
            for (int b = 0; b < 2; ++b)
#pragma unroll
                for (int m = 0; m < 4; ++m)
#pragma unroll
                    for (int n = 0; n < 2; ++n) acc[a][b][m][n] = (f32x4){0.f, 0.f, 0.f, 0.f};
        cur = nxt; cA = nA; cB = nB; ++ui;
        if constexpr (GATHER) { _Pragma("unroll") for (int i = 0; i < 2; ++i) { vA0[i] = vN0[i]; vA1[i] = vN1[i]; } }
        if constexpr (ALIGN_EPI) { if (wr == 1) PG8_BAR; }
    }
    PG8_WAIT_V(0);
    if constexpr (!ALIGN_EPI) { if (wr == 0) PG8_BAR; }
    PG8_BAR;
    if constexpr (Epi::AFTER_DRAIN) { E.fused(acc, cur, wr, wc, fr, fq, lds, wid, lane); S.done(cur); }
#undef PG8_SA
#undef PG8_SB
#undef PG8_STAGE
#undef PG8_GLOAD
#undef PG8_LDA
#undef PG8_LDB
#undef PG8_MMA
#undef PG8_MMA8
#undef PG8_MFMA8
#undef PG8_MM
#undef PG8_CAT8
#undef PG8_WAIT_V
#undef PG8_WAIT_L
#undef PG8_BAR
#undef PG8_SCHED
}
}
namespace pg8 {
__device__ __forceinline__ float bf_lo(unsigned w) { return __builtin_bit_cast(float, w << 16); }
__device__ __forceinline__ float bf_hi(unsigned w) { return __builtin_bit_cast(float, w & 0xffff0000u); }
__device__ __forceinline__ unsigned pk4_fp8(float a, float b, float c, float d) { int r = 0; r = __builtin_amdgcn_cvt_pk_fp8_f32(a, b, r, false); r = __builtin_amdgcn_cvt_pk_fp8_f32(c, d, r, true); return (unsigned)r; }
__device__ __forceinline__ float sigmoid_f(float x) { return __builtin_amdgcn_rcpf(1.0f + __expf(-x)); }

template <bool ADD, bool OUT8 = false> struct EpiGate {
    static constexpr bool PERM = true, PERM2 = true, AFTER_DRAIN = false;
    const bf16_t* G; const bf16_t* Min; bf16_t* O; float ascale;
    __device__ __forceinline__ void operator()(const f32x4 (&acc)[2][2][4][2], const Unit& u, int wr, int wc, int fr, int fq) const {
        const int row0 = u.pm * BM + wr * 64 + fr, col0 = u.pn * BM + wc * 64 + 16 * fq;
        bf16_t* lp = O + (size_t)(u.pm * BM + wr * 64 + (fr & 7)) * 1024 + col0 + 8 * (fr >> 3);
#pragma unroll
        for (int ai = 0; ai < 2; ++ai)
#pragma unroll
            for (int m = 0; m < 4; ++m) { const size_t off = (size_t)(row0 + ai * HALF + m * 16) * 1024 + col0; u32x4 w[2]; unsigned w8[4];
#pragma unroll
                for (int bj = 0; bj < 2; ++bj) {
                    const u32x4 g = *(const u32x4*)(G + off + 8 * bj);
                    f32x4 v0 = acc[ai][bj][m][0] * ascale, v1 = acc[ai][bj][m][1] * ascale;
                    v0[0] *= sigmoid_f(bf_lo(g.x)); v0[1] *= sigmoid_f(bf_hi(g.x)); v0[2] *= sigmoid_f(bf_lo(g.y)); v0[3] *= sigmoid_f(bf_hi(g.y));
                    v1[0] *= sigmoid_f(bf_lo(g.z)); v1[1] *= sigmoid_f(bf_hi(g.z)); v1[2] *= sigmoid_f(bf_lo(g.w)); v1[3] *= sigmoid_f(bf_hi(g.w));
                    if (ADD) { const u32x4 p = *(const u32x4*)(Min + off + 8 * bj);
                        v0[0] += bf_lo(p.x); v0[1] += bf_hi(p.x); v0[2] += bf_lo(p.y); v0[3] += bf_hi(p.y);
                        v1[0] += bf_lo(p.z); v1[1] += bf_hi(p.z); v1[2] += bf_lo(p.w); v1[3] += bf_hi(p.w); }
                    if constexpr (OUT8) { w8[2 * bj] = pk4_fp8(v0[0], v0[1], v0[2], v0[3]); w8[2 * bj + 1] = pk4_fp8(v1[0], v1[1], v1[2], v1[3]); }
                    else { w[bj].x = cvt_pk_bf16(v0[0], v0[1]); w[bj].y = cvt_pk_bf16(v0[2], v0[3]); w[bj].z = cvt_pk_bf16(v1[0], v1[1]); w[bj].w = cvt_pk_bf16(v1[2], v1[3]); } }
                if constexpr (OUT8) { const u32x4 o = {w8[0], w8[1], w8[2], w8[3]}; __builtin_nontemporal_store(o, (u32x4*)((unsigned char*)O + off)); }
                else { u32x4 d1, d2; xchg8(w[0], w[1], d1, d2); bf16_t* rowp = lp + (size_t)(ai * HALF + m * 16) * 1024;
                    __builtin_nontemporal_store(d1, (u32x4*)rowp); __builtin_nontemporal_store(d2, (u32x4*)(rowp + 8 * 1024)); } }
    }
};

struct EpiResid {
    static constexpr bool PERM = false, PERM2 = false, AFTER_DRAIN = false;
    const float* X; const float* gate; float* out; int rows_per_batch; int gstride; float ascale;
    __device__ __forceinline__ void operator()(const f32x4 (&acc)[2][2][4][2], const Unit& u, int wr, int wc, int fr, int fq) const {
        const int col0 = u.pn * BM + wc * 32 + 4 * fq;
#pragma unroll
        for (int ai = 0; ai < 2; ++ai)
#pragma unroll
            for (int m = 0; m < 4; ++m) { const int row = u.pm * BM + ai * HALF + wr * 64 + m * 16 + fr; const size_t off = (size_t)row * 1024 + col0;
                const float* gp = gate + (size_t)(row / rows_per_batch) * gstride + col0;
#pragma unroll
                for (int bj = 0; bj < 2; ++bj)
#pragma unroll
                    for (int n = 0; n < 2; ++n) { const f32x4 xv = *(const f32x4*)(X + off + bj * HALF + n * 16); const f32x4 gv = *(const f32x4*)(gp + bj * HALF + n * 16);
                        *(f32x4*)(out + off + bj * HALF + n * 16) = xv + gv * (acc[ai][bj][m][n] * ascale); } }
    }
};

__device__ __forceinline__ float swiglu1(float g, float l) {
    g = fminf(g, 7.0f); l = fminf(fmaxf(l, -7.0f), 7.0f);
    return (l + 1.0f) * (g * __builtin_amdgcn_rcpf(1.0f + __expf(-1.702f * g)));
}
template <bool OUT8> struct EpiSwiglu {
    static constexpr bool PERM = true, PERM2 = false, AFTER_DRAIN = false;
    const float* b1; bf16_t* O; float ascale;
    __device__ __forceinline__ void operator()(const f32x4 (&acc)[2][2][4][2], const Unit& u, int wr, int wc, int fr, int fq) const {
        const int e = u.pn >> 3, pl = u.pn & 7, jc = wc * 32 + 8 * fq;
        const float* bg = b1 + (size_t)e * 2048 + 128 * pl + jc; const float* bl = bg + 1024;
        const f32x4 bg0 = *(const f32x4*)bg, bg1 = *(const f32x4*)(bg + 4), bl0 = *(const f32x4*)bl, bl1 = *(const f32x4*)(bl + 4);
        const int row0 = u.pm * BM + wr * 64 + fr;
#pragma unroll
        for (int ai = 0; ai < 2; ++ai)
#pragma unroll
            for (int m = 0; m < 4; ++m) {
                const f32x4 g0 = acc[ai][0][m][0] * ascale + bg0, g1 = acc[ai][0][m][1] * ascale + bg1, l0 = acc[ai][1][m][0] * ascale + bl0, l1 = acc[ai][1][m][1] * ascale + bl1;
                if constexpr (OUT8) { typedef unsigned u32x2_ __attribute__((ext_vector_type(2))); u32x2_ w;
                    w.x = pk4_fp8(swiglu1(g0[0], l0[0]), swiglu1(g0[1], l0[1]), swiglu1(g0[2], l0[2]), swiglu1(g0[3], l0[3])); w.y = pk4_fp8(swiglu1(g1[0], l1[0]), swiglu1(g1[1], l1[1]), swiglu1(g1[2], l1[2]), swiglu1(g1[3], l1[3]));
                    __builtin_nontemporal_store(w, (u32x2_*)((unsigned char*)O + (size_t)(row0 + ai * HALF + m * 16) * 1024 + 128 * pl + jc)); }
                else { u32x4 w; w.x = cvt_pk_bf16(swiglu1(g0[0], l0[0]), swiglu1(g0[1], l0[1])); w.y = cvt_pk_bf16(swiglu1(g0[2], l0[2]), swiglu1(g0[3], l0[3]));
                    w.z = cvt_pk_bf16(swiglu1(g1[0], l1[0]), swiglu1(g1[1], l1[1])); w.w = cvt_pk_bf16(swiglu1(g1[2], l1[2]), swiglu1(g1[3], l1[3]));
                    __builtin_nontemporal_store(w, (u32x4*)(O + (size_t)(row0 + ai * HALF + m * 16) * 1024 + 128 * pl + jc)); } }
    }
};

struct EpiOutS {
    static constexpr bool PERM = true, PERM2 = true, AFTER_DRAIN = false;
    bf16_t* O; const float* bias; float ascale;
    __device__ __forceinline__ void operator()(const f32x4 (&acc)[2][2][4][2], const Unit& u, int wr, int wc, int fr, int fq) const {
        const int bcol0 = u.pn * BM + wc * 64 + 16 * fq;
        f32x4 bv[2][2];
#pragma unroll
        for (int bj = 0; bj < 2; ++bj)
#pragma unroll
            for (int n = 0; n < 2; ++n) bv[bj][n] = *(const f32x4*)(bias + bcol0 + 8 * bj + 4 * n);
        bf16_t* lp = O + (size_t)(u.pm * BM + wr * 64 + (fr & 7)) * 1024 + (u.pn & 3) * BM + wc * 64 + 16 * fq + 8 * (fr >> 3);
#pragma unroll
        for (int ai = 0; ai < 2; ++ai)
#pragma unroll
            for (int m = 0; m < 4; ++m) { u32x4 w[2];
#pragma unroll
                for (int bj = 0; bj < 2; ++bj) { const f32x4 v0 = acc[ai][bj][m][0] * ascale + bv[bj][0], v1 = acc[ai][bj][m][1] * ascale + bv[bj][1];
                    w[bj].x = cvt_pk_bf16(v0[0], v0[1]); w[bj].y = cvt_pk_bf16(v0[2], v0[3]); w[bj].z = cvt_pk_bf16(v1[0], v1[1]); w[bj].w = cvt_pk_bf16(v1[2], v1[3]); }
                u32x4 d1, d2; xchg8(w[0], w[1], d1, d2);
                bf16_t* rowp = lp + (size_t)(ai * HALF + m * 16) * 1024;
                __builtin_nontemporal_store(d1, (u32x4*)rowp); __builtin_nontemporal_store(d2, (u32x4*)(rowp + 8 * 1024)); }
    }
};

struct GroupedOrder {
    const PG8_LAS int* ts; int NT, G, c; const int* rowtok;
    __device__ __forceinline__ bool next(int i, Unit& u) const {
        const int total = __builtin_amdgcn_readfirstlane(ts[32]) * NT; const long L = (long)i * G + c; if (L >= total) return false;
        const int pm = (int)L / NT, pl = (int)L % NT; int e = 0;
#pragma unroll 1
        for (int j = 1; j < 32; ++j) e += (pm >= ts[j]) ? 1 : 0;
        u.pm = __builtin_amdgcn_readfirstlane(pm); u.pn = __builtin_amdgcn_readfirstlane(e * NT + pl); return true;
    }
    __device__ __forceinline__ void a_ready(const Unit&) const {}
    __device__ __forceinline__ void done(const Unit&) const {}
};
}
#define GAS __attribute__((address_space(1)))
#define LAS __attribute__((address_space(3)))
typedef unsigned short bf16;
typedef unsigned v4u __attribute__((ext_vector_type(4)));
typedef float f32x4 __attribute__((ext_vector_type(4)));
typedef short bf16x8 __attribute__((ext_vector_type(8)));
typedef GAS unsigned gu32;
typedef GAS unsigned long long gu64;
#define RLX_AGENT __ATOMIC_RELAXED, __HIP_MEMORY_SCOPE_AGENT
#define LDS_WAIT() asm volatile("s_waitcnt lgkmcnt(0)" ::: "memory")
#define VM_WAIT() asm volatile("s_waitcnt vmcnt(0)" ::: "memory")
__device__ __forceinline__ unsigned long long rt() { return __builtin_amdgcn_s_memrealtime(); }
__device__ __forceinline__ unsigned f2bf(float f) { unsigned u = __builtin_bit_cast(unsigned, f); return (u + 0x7fffu + ((u >> 16) & 1u)) >> 16; }
typedef float f32x2_pk __attribute__((ext_vector_type(2))); typedef __bf16 bf16x2_pk __attribute__((ext_vector_type(2)));
__device__ __forceinline__ unsigned pk2(float lo, float hi) { const f32x2_pk v = {lo, hi}; return __builtin_bit_cast(unsigned, __builtin_convertvector(v, bf16x2_pk)); }

#define XB_TMO      128
#define XB_XCNT(j)  (256  + 64 * (j))
#define XB_XSUB(j)  (1280 + 64 * (j))
#define XB_XGEN(j)  (2304 + 64 * (j))
#define XB_TOP      3328
#define XB_TOPGEN   3392
#define XCD_BAR_WORDS 3456
#define XB_SPIN_CAP (1u << 18)

__device__ __forceinline__ unsigned xb_ld(unsigned* p)              { return __hip_atomic_load(p, __ATOMIC_RELAXED, __HIP_MEMORY_SCOPE_AGENT); }
__device__ __forceinline__ unsigned xb_add(unsigned* p, unsigned v) { return __hip_atomic_fetch_add(p, v, __ATOMIC_RELAXED, __HIP_MEMORY_SCOPE_AGENT); }
__device__ __forceinline__ unsigned xb_xcc_id() { return (unsigned)__builtin_amdgcn_s_getreg((3 << 11) | 20) & 0xFu; }
#define XB_SPIN(cond, bar) do { unsigned _sp = 0; while (cond) { __builtin_amdgcn_s_sleep(1); \
    if ((++_sp & 255u) == 0u) { if (xb_ld(&(bar)[XB_TMO])) break; if (_sp > XB_SPIN_CAP) { atomicAdd(&(bar)[XB_TMO], 1u); break; } } } } while (0)

struct XcdBarrier {
    unsigned* bar; unsigned x;
    volatile LAS unsigned* st;
};

__device__ __forceinline__ XcdBarrier xcd_barrier_post(unsigned* bar, volatile LAS unsigned* st) {
    XcdBarrier b; b.bar = bar; b.x = xb_xcc_id(); b.st = st;
    if (threadIdx.x == 0) (void)xb_add(&bar[XB_XCNT(b.x)], 1u);
    return b;
}
__device__ __forceinline__ void xcd_barrier_complete(unsigned* bar, unsigned x, unsigned& nloc, unsigned& nx) {
    const unsigned G = gridDim.x * gridDim.y * gridDim.z;
    unsigned sum, cnt, mine, sp = 0u;
    for (;;) {
        sum = 0u; cnt = 0u; mine = 0u;
#pragma unroll
        for (unsigned j = 0; j < 16; ++j) { const unsigned c = xb_ld(&bar[XB_XCNT(j)]); sum += c; cnt += (c > 0u) ? 1u : 0u; mine = (j == x) ? c : mine; }
        if (sum == G) break;
        __builtin_amdgcn_s_sleep(1);
        if ((++sp & 255u) == 0u) { if (xb_ld(&bar[XB_TMO])) break; if (sp > XB_SPIN_CAP) { atomicAdd(&bar[XB_TMO], 1u); break; } }
    }
    nloc = mine > 0u ? mine : 1u; nx = cnt > 0u ? cnt : 1u;
}

__device__ __forceinline__ void xcd_barrier(const XcdBarrier& b) {
    asm volatile("s_waitcnt vmcnt(0)" ::: "memory");
    __syncthreads();
    if (threadIdx.x == 0) {
        unsigned* bar = b.bar;
        __builtin_amdgcn_s_waitcnt(0);
        unsigned nloc = b.st[0], nx = b.st[1];
        if (nloc == 0u) { xcd_barrier_complete(bar, b.x, nloc, nx); b.st[0] = nloc; b.st[1] = nx; }
        const unsigned old = xb_add(&bar[XB_XSUB(b.x)], 1u);
        const unsigned gen = old / nloc;
        if (old + 1u == (gen + 1u) * nloc) {
            __builtin_amdgcn_fence(__ATOMIC_RELEASE, "agent");
            asm volatile("s_waitcnt vmcnt(0)" ::: "memory");
            const unsigned og = xb_add(&bar[XB_TOP], 1u);
            const unsigned tg = og / nx;
            if (og + 1u == (tg + 1u) * nx) xb_add(&bar[XB_TOPGEN], 1u);
            else XB_SPIN(xb_ld(&bar[XB_TOPGEN]) == tg, bar);
            __builtin_amdgcn_fence(__ATOMIC_ACQUIRE, "agent");
            xb_add(&bar[XB_XGEN(b.x)], 1u);
            asm volatile("s_waitcnt vmcnt(0)" ::: "memory");
        } else {
            XB_SPIN(xb_ld(&bar[XB_XGEN(b.x)]) == gen, bar);
            __builtin_amdgcn_fence(__ATOMIC_ACQUIRE, "agent");
            asm volatile("s_waitcnt vmcnt(0)" ::: "memory");
        }
    }
    __syncthreads();
}

constexpr int NWAVES = 8;
constexpr int BATCH = 16, SEQ = 2048, D = 1024, T = BATCH * SEQ;
constexpr int NIN = 9224, NPROJ = 9216, NMOD = 6 * D;
constexpr int NE = 32, TOPK = 4;
constexpr int XS_ROWS = T * TOPK + NE * 256;
constexpr float EPS = 1e-6f;
constexpr float ATT_RTHR = -120.0f;
constexpr float W8SCALE = 64.0f;
constexpr float QSCALE = 0.125f * 1.4426950408889634f;

constexpr size_t MiB = 1u << 20;
constexpr size_t WS_CTL = 0, CTL_ZERO_BYTES = 1 * MiB;
constexpr size_t WS_MODP = 1 * MiB;
constexpr size_t WS_MOD = 3 * MiB;
constexpr size_t WS_IPRE = 4 * MiB, WS_LF = 4 * MiB + 512 * 1024;
constexpr size_t WS_TOKE = 5 * MiB, WS_TOKP = 5 * MiB + 512 * 1024, WS_TOKW = 6 * MiB, WS_TOKROW = 6 * MiB + 512 * 1024, WS_RSTD = 7 * MiB;
constexpr size_t WS_WIN = 8 * MiB, WS_WA = 26 * MiB, WS_WB = 28 * MiB, WS_WOUT = 30 * MiB, WS_W1 = 32 * MiB, WS_W2 = 160 * MiB;
constexpr size_t WS_H1 = 224 * MiB;
constexpr size_t WS_PROJ = 288 * MiB, SEG = 64 * MiB;
constexpr size_t WS_YB = 864 * MiB;
constexpr size_t WS_XS = 288 * MiB, WS_ACT = 560 * MiB;
constexpr size_t WS_ROW2TOK = 7 * MiB + 128 * 1024;
constexpr size_t WS_GT = 928 * MiB;
constexpr size_t WS_END = 932 * MiB;
static_assert(WS_XS + (size_t)XS_ROWS * 2048 <= WS_ACT && WS_ACT + (size_t)XS_ROWS * 2048 <= WS_YB, "ws map");
constexpr int CW_TMO = 0, CW_BAR = 4096, CW_ECNT = 8192;

constexpr int RING_BYTES = 131072, LDS_BYTES = 147456, LDSCTL_OFF = 146432;
constexpr int LC_BAR = 0, LC_TS = 16, LC_LCNT = 64, LC_GBASE = 96, LC_PS = 128, LC_CNT = 160;

__device__ __forceinline__ unsigned long long karg(int i) { return ((const __attribute__((address_space(4))) unsigned long long*)__builtin_amdgcn_kernarg_segment_ptr())[i]; }
struct Frame {
    LAS unsigned char* lds; volatile LAS unsigned* LC;
    gu32* ctl; unsigned char* ws; int tid, lane, wave, vcu, G;
    __device__ __forceinline__ const float* x() const { return (const float*)(const GAS float*)karg(0); }
    __device__ __forceinline__ const float* c() const { return (const float*)(const GAS float*)karg(1); }
    __device__ __forceinline__ const float* ada_w() const { return (const float*)(const GAS float*)karg(2); }
    __device__ __forceinline__ const float* ada_b() const { return (const float*)(const GAS float*)karg(3); }
    __device__ __forceinline__ const float* norm1_g() const { return (const float*)(const GAS float*)karg(4); }
    __device__ __forceinline__ const float* w_in() const { return (const float*)(const GAS float*)karg(5); }
    __device__ __forceinline__ const float* conv_w() const { return (const float*)(const GAS float*)karg(6); }
    __device__ __forceinline__ const float* conv_b() const { return (const float*)(const GAS float*)karg(7); }
    __device__ __forceinline__ const float* b_i() const { return (const float*)(const GAS float*)karg(8); }
    __device__ __forceinline__ const float* b_f() const { return (const float*)(const GAS float*)karg(9); }
    __device__ __forceinline__ const float* ml_norm_g() const { return (const float*)(const GAS float*)karg(10); }
    __device__ __forceinline__ const float* w_a() const { return (const float*)(const GAS float*)karg(11); }
    __device__ __forceinline__ const float* w_b() const { return (const float*)(const GAS float*)karg(12); }
    __device__ __forceinline__ const float* w_out() const { return (const float*)(const GAS float*)karg(13); }
    __device__ __forceinline__ const float* norm2_g() const { return (const float*)(const GAS float*)karg(14); }
    __device__ __forceinline__ const float* router_w() const { return (const float*)(const GAS float*)karg(15); }
    __device__ __forceinline__ const float* router_b() const { return (const float*)(const GAS float*)karg(16); }
    __device__ __forceinline__ const float* w1() const { return (const float*)(const GAS float*)karg(17); }
    __device__ __forceinline__ const float* b1() const { return (const float*)(const GAS float*)karg(18); }
    __device__ __forceinline__ const float* w2() const { return (const float*)(const GAS float*)karg(19); }
    __device__ __forceinline__ const float* b2() const { return (const float*)(const GAS float*)karg(20); }
    __device__ __forceinline__ const float* final_g() const { return (const float*)(const GAS float*)karg(21); }
    __device__ __forceinline__ float* out() const { return (float*)(GAS float*)karg(22); }
    __device__ __forceinline__ float* modp() const { return (float*)(ws + WS_MODP); }
    __device__ __forceinline__ float* mod() const { return (float*)(ws + WS_MOD); }
    __device__ __forceinline__ float* ipre() const { return (float*)(ws + WS_IPRE); }
    __device__ __forceinline__ float* lf() const { return (float*)(ws + WS_LF); }
    __device__ __forceinline__ float* tokw() const { return (float*)(ws + WS_TOKW); }
    __device__ __forceinline__ float* rstd2() const { return (float*)(ws + WS_RSTD); }
    __device__ __forceinline__ int* toke() const { return (int*)(ws + WS_TOKE); }
    __device__ __forceinline__ int* tokp() const { return (int*)(ws + WS_TOKP); }
    __device__ __forceinline__ int* tokrow() const { return (int*)(ws + WS_TOKROW); }
    __device__ __forceinline__ bf16* WIN_T() const { return (bf16*)(ws + WS_WIN); }
    __device__ __forceinline__ bf16* WA_T() const { return (bf16*)(ws + WS_WA); }
    __device__ __forceinline__ bf16* WB_T() const { return (bf16*)(ws + WS_WB); }
    __device__ __forceinline__ bf16* WOUT_T() const { return (bf16*)(ws + WS_WOUT); }
    __device__ __forceinline__ bf16* W1_T() const { return (bf16*)(ws + WS_W1); }
    __device__ __forceinline__ bf16* W2_T() const { return (bf16*)(ws + WS_W2); }
    __device__ __forceinline__ bf16* H1() const { return (bf16*)(ws + WS_H1); }
    __device__ __forceinline__ bf16* PROJ() const { return (bf16*)(ws + WS_PROJ); }
    __device__ __forceinline__ bf16* YA() const { return (bf16*)(ws + WS_H1); }
    __device__ __forceinline__ bf16* YB() const { return (bf16*)(ws + WS_YB); }
    __device__ __forceinline__ bf16* YB8() const { return (bf16*)(ws + WS_H1 + 32 * MiB); }
    __device__ __forceinline__ bf16* M1() const { return (bf16*)(ws + WS_PROJ); }
    __device__ __forceinline__ bf16* MERGED() const { return (bf16*)(ws + WS_PROJ + SEG); }
    __device__ __forceinline__ bf16* XS() const { return (bf16*)(ws + WS_XS); }
    __device__ __forceinline__ bf16* ACT() const { return (bf16*)(ws + WS_ACT); }
    __device__ __forceinline__ bf16* OUTR() const { return (bf16*)(ws + WS_XS); }
    __device__ __forceinline__ bf16* H2() const { return (bf16*)(ws + WS_XS); }
    __device__ __forceinline__ int* row2tok() const { return (int*)(ws + WS_ROW2TOK); }
    __device__ __forceinline__ float* gt() const { return (float*)(ws + WS_GT); }
};

__device__ __forceinline__ int opq(int v) { asm volatile("" : "+v"(v)); return v; }
__device__ __forceinline__ float wave_sum(float v) {
#pragma unroll
    for (int o = 1; o < 64; o <<= 1) v += __shfl_xor(v, o);
    return v;
}
__device__ __forceinline__ float bf2f(unsigned short b) { return __builtin_bit_cast(float, (unsigned)b << 16); }
__device__ __forceinline__ float bflo(unsigned w) { return __builtin_bit_cast(float, w << 16); }
__device__ __forceinline__ float bfhi(unsigned w) { return __builtin_bit_cast(float, w & 0xffff0000u); }
__device__ __forceinline__ float log_sigmoid_f(float x) { return fminf(x, 0.f) - log1pf(expf(-fabsf(x))); }

struct MapIn { __device__ __forceinline__ long operator()(int n) const { return n < 7168 ? (long)n : (n < 7176 ? -1L : (n < NIN ? (long)(n - 8) : -1L)); } };
struct MapId { long off; __device__ __forceinline__ long operator()(int n) const { return off + n; } };
struct MapW1 { int e; __device__ __forceinline__ long operator()(int n) const { return (long)e * 2048 + ((n & 1023) >> 7) * 256 + (n >> 10) * 128 + (n & 127); } };

template <class Map> __device__ __forceinline__ void transpose_item(const float* W, int K, int N, bf16* WT, LAS float* scr, int item, int lane, Map map, float scale8) {
    const int nblk = (N + 31) / 32, kb = item / nblk, nb = item % nblk, k0 = 128 * kb, n0 = 32 * nb;
    const int n4 = 4 * (lane & 7), kr = lane >> 3;
    const bool ok = (n0 + n4 + 3) < N;
    f32x4 v[16];
#pragma unroll
    for (int i = 0; i < 16; ++i) v[i] = ok ? *(const f32x4*)(W + (size_t)(k0 + 8 * i + kr) * N + n0 + n4) : (f32x4){0.f, 0.f, 0.f, 0.f};
#pragma unroll
    for (int i = 0; i < 16; ++i) { LAS float* d = scr + (8 * i + kr) * 33 + n4; d[0] = v[i].x; d[1] = v[i].y; d[2] = v[i].z; d[3] = v[i].w; }
    LDS_WAIT(); asm volatile("" ::: "memory");
    const int c = lane & 7;
#pragma unroll
    for (int j = 0; j < 4; ++j) { const int n = (lane >> 3) + 8 * j; const LAS float* s = scr + (16 * c) * 33 + n;
        const long dr = map(n0 + n); v4u o;
        o.x = pg8::pk4_fp8(s[0 * 33] * scale8, s[1 * 33] * scale8, s[2 * 33] * scale8, s[3 * 33] * scale8);     o.y = pg8::pk4_fp8(s[4 * 33] * scale8, s[5 * 33] * scale8, s[6 * 33] * scale8, s[7 * 33] * scale8);
        o.z = pg8::pk4_fp8(s[8 * 33] * scale8, s[9 * 33] * scale8, s[10 * 33] * scale8, s[11 * 33] * scale8);   o.w = pg8::pk4_fp8(s[12 * 33] * scale8, s[13 * 33] * scale8, s[14 * 33] * scale8, s[15 * 33] * scale8);
        if (dr >= 0) *(GAS v4u*)((unsigned char*)WT + (size_t)dr * K + k0 + 16 * c) = o; }
    LDS_WAIT(); asm volatile("" ::: "memory");
}
__device__ __forceinline__ void mod_item(Frame& F, const LAS float* sil, int it) {
    const int j = it % 96, kq = it / 96, n = 64 * j + F.lane, k0 = 256 * kq;
    float acc[16];
#pragma unroll
    for (int b = 0; b < 16; ++b) acc[b] = 0.f;
    const float* w = F.ada_w() + (size_t)k0 * NMOD + n;
    const LAS f32x4* s = (const LAS f32x4*)sil + k0 * 4;
    for (int kk = 0; kk < 256; kk += 8) {
        float wv[8];
#pragma unroll
        for (int u = 0; u < 8; ++u) wv[u] = w[(size_t)(kk + u) * NMOD];
#pragma unroll
        for (int u = 0; u < 8; ++u) {
#pragma unroll
            for (int q = 0; q < 4; ++q) { const f32x4 sv = s[(kk + u) * 4 + q]; acc[4 * q + 0] += sv.x * wv[u]; acc[4 * q + 1] += sv.y * wv[u]; acc[4 * q + 2] += sv.z * wv[u]; acc[4 * q + 3] += sv.w * wv[u]; }
        }
    }
    float* o = F.modp() + (size_t)kq * 16 * NMOD + n;
#pragma unroll
    for (int b = 0; b < 16; ++b) o[(size_t)b * NMOD] = acc[b];
}
__device__ __forceinline__ void p0_prologue(Frame& F) {
    LAS float* sil = (LAS float*)F.lds;
    for (int idx = F.tid; idx < 16384; idx += 512) { const int b = idx >> 10, k = idx & 1023; const float v = F.c()[idx]; sil[k * 16 + b] = v / (1.0f + __expf(-v)); }
    __syncthreads();
    const int gw = F.vcu * NWAVES + F.wave, NGW = F.G * NWAVES;
    constexpr int I_MOD = 384, I_IN = 8 * 289, I_SQ = 8 * 32, I_W1 = 32 * 8 * 64, I_W2 = 32 * 8 * 32;
    constexpr int NITEMS = I_IN + 3 * I_SQ + I_W1 + I_W2;
    if (gw < I_MOD) mod_item(F, sil, gw);
    __syncthreads();
    LAS float* scr = (LAS float*)(F.lds + F.wave * 16896);
    const int ow = (gw + NGW - I_MOD) % NGW;
    for (int it = ow; it < NITEMS; it += NGW) {
        int r = it;
        if (r < I_IN) { transpose_item(F.w_in(), D, NIN, F.WIN_T(), scr, r, F.lane, MapIn{}, W8SCALE); continue; } r -= I_IN;
        if (r < I_SQ) { transpose_item(F.w_a(), D, D, F.WA_T(), scr, r, F.lane, MapId{0}, W8SCALE); continue; } r -= I_SQ;
        if (r < I_SQ) { transpose_item(F.w_b(), D, D, F.WB_T(), scr, r, F.lane, MapId{0}, W8SCALE); continue; } r -= I_SQ;
        if (r < I_SQ) { transpose_item(F.w_out(), D, D, F.WOUT_T(), scr, r, F.lane, MapId{0}, W8SCALE); continue; } r -= I_SQ;
        if (r < I_W1) { const int e = r >> 9; transpose_item(F.w1() + (size_t)e * D * 2048, D, 2048, F.W1_T(), scr, r & 511, F.lane, MapW1{e}, W8SCALE); continue; } r -= I_W1;
        { const int e = r >> 8; transpose_item(F.w2() + (size_t)e * D * D, D, D, F.W2_T(), scr, r & 255, F.lane, MapId{(long)e * 1024}, W8SCALE); }
    }
}

__device__ __forceinline__ void p1_rows(Frame& F) {
    const int row0 = F.vcu * 128, b = row0 / SEQ, lane = opq(F.lane);
    LAS float* wif = (LAS float*)F.lds;
    for (int idx = F.tid; idx < 8192; idx += 512) wif[idx] = F.w_in()[(size_t)(idx >> 3) * NIN + 7168 + (idx & 7)];
    for (int idx = F.vcu * 512 + F.tid; idx < 16 * NMOD; idx += F.G * 512) { float s = F.ada_b()[idx % NMOD];
#pragma unroll
        for (int kq = 0; kq < 4; ++kq) s += F.modp()[(size_t)kq * 16 * NMOD + idx];
        F.mod()[idx] = s; }
    f32x4 Av[4], Bv[4];
#pragma unroll
    for (int j = 0; j < 4; ++j) { const int col = 4 * lane + 256 * j;
        f32x4 sh = *(const f32x4*)(F.ada_b() + col), sc = *(const f32x4*)(F.ada_b() + D + col);
#pragma unroll
        for (int kq = 0; kq < 4; ++kq) { sh += *(const f32x4*)(F.modp() + ((size_t)kq * 16 + b) * NMOD + col); sc += *(const f32x4*)(F.modp() + ((size_t)kq * 16 + b) * NMOD + D + col); }
        const f32x4 g = *(const f32x4*)(F.norm1_g() + col); Av[j] = g * (sc + 1.0f); Bv[j] = sh; }
    __syncthreads();
    f32x4 nx[4];
    { const GAS f32x4* xr = (const GAS f32x4*)(F.x() + (size_t)(row0 + 16 * F.wave) * D) + lane;
#pragma unroll
      for (int j = 0; j < 4; ++j) nx[j] = xr[64 * j]; }
    for (int r = 0; r < 16; ++r) {
        const int row = row0 + 16 * F.wave + r;
        f32x4 v[4]; float ss = 0.f;
#pragma unroll
        for (int j = 0; j < 4; ++j) { v[j] = nx[j]; ss += (v[j].x * v[j].x + v[j].y * v[j].y) + (v[j].z * v[j].z + v[j].w * v[j].w); }
        if (r < 15) { const GAS f32x4* xr = (const GAS f32x4*)(F.x() + (size_t)(row + 1) * D) + lane;
#pragma unroll
            for (int j = 0; j < 4; ++j) nx[j] = xr[64 * j]; }
        const float rstd = 1.0f / sqrtf(wave_sum(ss) * (1.0f / D) + EPS);
        GAS unsigned* o4 = (GAS unsigned*)((unsigned char*)F.H1() + (size_t)row * D) + lane;
        float p[8];
#pragma unroll
        for (int q = 0; q < 8; ++q) p[q] = 0.f;
#pragma unroll
        for (int j = 0; j < 4; ++j) { v[j] = v[j] * rstd * Av[j] + Bv[j];
            o4[64 * j] = pg8::pk4_fp8(v[j].x, v[j].y, v[j].z, v[j].w);
#pragma unroll
            for (int i = 0; i < 4; ++i) { const LAS f32x4* wp = (const LAS f32x4*)(wif + (4 * lane + 256 * j + i) * 8); const f32x4 w0 = wp[0], w1 = wp[1]; const float hv = v[j][i];
                p[0] += hv * w0.x; p[1] += hv * w0.y; p[2] += hv * w0.z; p[3] += hv * w0.w; p[4] += hv * w1.x; p[5] += hv * w1.y; p[6] += hv * w1.z; p[7] += hv * w1.w; } }
#pragma unroll
        for (int q = 0; q < 8; ++q) p[q] = wave_sum(p[q]);
        if (lane == 0) { const int t = row % SEQ;
#pragma unroll
            for (int hh = 0; hh < 4; ++hh) { F.ipre()[((size_t)b * 4 + hh) * SEQ + t] = p[hh] + F.b_i()[hh]; F.lf()[((size_t)b * 4 + hh) * SEQ + t] = log_sigmoid_f(p[4 + hh] + F.b_f()[hh]); } }
    }
}

__device__ __forceinline__ void attn_naive_item(Frame& F, int bh, int qblk) {
    const int b = bh >> 4, hd = bh & 15, t = qblk * 512 + F.tid;
    const bf16* Q = F.PROJ(); const bf16* K = F.PROJ() + SEG / 2; const bf16* V = F.PROJ() + SEG;
    const size_t rowb = (size_t)b * SEQ;
    float q[64], o[64];
    { const v4u* qp = (const v4u*)(Q + (rowb + t) * D + hd * 64);
#pragma unroll
      for (int i = 0; i < 8; ++i) { const v4u w = qp[i]; q[8 * i + 0] = bflo(w.x); q[8 * i + 1] = bfhi(w.x); q[8 * i + 2] = bflo(w.y); q[8 * i + 3] = bfhi(w.y); q[8 * i + 4] = bflo(w.z); q[8 * i + 5] = bfhi(w.z); q[8 * i + 6] = bflo(w.w); q[8 * i + 7] = bfhi(w.w); } }
#pragma unroll
    for (int i = 0; i < 64; ++i) o[i] = 0.f;
    float R = 0.f;
    LAS v4u* kt = (LAS v4u*)F.lds; LAS v4u* vt = (LAS v4u*)(F.lds + 8192);
    const int tmax_wave = qblk * 512 + F.wave * 64 + 63;
    bool wdone = false;
    LAS volatile int* dflag = (LAS volatile int*)(F.lds + 16384);
    if (F.tid < 8) dflag[F.tid] = 0;
    for (int tile = qblk * 8 + 7; tile >= 0; --tile) {
        __syncthreads();
        { int nd = 0;
#pragma unroll
          for (int w = 0; w < 8; ++w) nd += dflag[w];
          if (nd == 8) break; }
        { const int kr = F.tid >> 3, ch = F.tid & 7; const size_t g = (rowb + tile * 64 + kr) * D + hd * 64 + ch * 8;
          kt[F.tid] = *(const v4u*)(K + g); vt[F.tid] = *(const v4u*)(V + g); }
        __syncthreads();
        if (tile * 64 >= tmax_wave) continue;
        if (wdone) continue;
        for (int s = 63; s >= 0; --s) {
            const int key = tile * 64 + s;
            float z = 0.f;
#pragma unroll
            for (int i = 0; i < 8; ++i) { const v4u w = kt[s * 8 + i]; z += q[8 * i + 0] * bflo(w.x) + q[8 * i + 1] * bfhi(w.x) + q[8 * i + 2] * bflo(w.y) + q[8 * i + 3] * bfhi(w.y) + q[8 * i + 4] * bflo(w.z) + q[8 * i + 5] * bfhi(w.z) + q[8 * i + 6] * bflo(w.w) + q[8 * i + 7] * bfhi(w.w); }
            const float lb = fminf(z, 0.f) - __builtin_amdgcn_logf(1.0f + __builtin_amdgcn_exp2f(-fabsf(z)));
            const bool act = key < t;
            const float a = act ? __builtin_amdgcn_exp2f(lb + R) : 0.f;
            R += act ? (lb - z) : 0.f;
#pragma unroll
            for (int i = 0; i < 8; ++i) { const v4u w = vt[s * 8 + i]; o[8 * i + 0] += a * bflo(w.x); o[8 * i + 1] += a * bfhi(w.x); o[8 * i + 2] += a * bflo(w.y); o[8 * i + 3] += a * bfhi(w.y); o[8 * i + 4] += a * bflo(w.z); o[8 * i + 5] += a * bfhi(w.z); o[8 * i + 6] += a * bflo(w.w); o[8 * i + 7] += a * bfhi(w.w); }
        }
        if (__all(R < ATT_RTHR) && !wdone) { wdone = true; if (F.lane == 0) dflag[F.wave] = 1; }
    }
    __syncthreads();
    v4u* op = (v4u*)(F.YA() + (rowb + t) * D + hd * 64);
#pragma unroll
    for (int i = 0; i < 8; ++i) { v4u w; w.x = pk2(o[8 * i + 0], o[8 * i + 1]); w.y = pk2(o[8 * i + 2], o[8 * i + 3]); w.z = pk2(o[8 * i + 4], o[8 * i + 5]); w.w = pk2(o[8 * i + 6], o[8 * i + 7]); op[i] = w; }
}

__device__ __forceinline__ void mlstm_naive_item(Frame& F, int bh) {
    const int b = bh >> 2, hh = bh & 3, tid = opq(F.tid), e = tid & 255, half = tid >> 8;
    const bf16* MLQ = F.PROJ() + 3 * (SEG / 2); const bf16* MLK = F.PROJ() + 4 * (SEG / 2); const bf16* MLV = F.PROJ() + 5 * (SEG / 2); const bf16* MLO = F.PROJ() + 6 * (SEG / 2);
    LAS float* ql = (LAS float*)F.lds; LAS float* kl = ql + 8192; LAS float* vl = kl + 8192; LAS float* hl = vl + 8192;
    LAS float* part = hl + 8192;
    LAS float* red = part + 512;
    LAS float* il = red + 8; LAS float* fl = il + 32;
    const size_t rowb = (size_t)b * SEQ;
    float C[128];
#pragma unroll
    for (int i = 0; i < 128; ++i) C[i] = 0.f;
    float nreg = 0.f, m = 0.f;
    float cw[2][4], cb[2];
    { const int c = tid & 255;
#pragma unroll
      for (int z = 0; z < 2; ++z) { const int ch = z * 1024 + hh * 256 + c; cb[z] = F.conv_b()[ch];
#pragma unroll
          for (int tap = 0; tap < 4; ++tap) cw[z][tap] = F.conv_w()[tap * 2048 + ch]; } }
    for (int chunk = 0; chunk < SEQ / 32; ++chunk) {
        const int t0 = chunk * 32;
        __syncthreads();
        { const int c = tid & 255;
          for (int u = 0; u < 16; ++u) { const int tt = (tid >> 8) + 2 * u, t = t0 + tt; float yq = cb[0], yk = cb[1];
#pragma unroll
              for (int tap = 0; tap < 4; ++tap) { const int ts = t - 3 + tap; if (ts >= 0) { const size_t g = (rowb + ts) * D + hh * 256 + c; yq += cw[0][tap] * bf2f(MLQ[g]); yk += cw[1][tap] * bf2f(MLK[g]); } }
              ql[tt * 256 + c] = yq / (1.0f + __expf(-yq)); kl[tt * 256 + c] = (yk / (1.0f + __expf(-yk))) * 0.0625f;
              vl[tt * 256 + c] = bf2f(MLV[(rowb + t) * D + hh * 256 + c]); }
          if (tid < 32) { il[tid] = F.ipre()[((size_t)b * 4 + hh) * SEQ + t0 + tid]; fl[tid] = F.lf()[((size_t)b * 4 + hh) * SEQ + t0 + tid]; } }
        __syncthreads();
        for (int tt = 0; tt < 32; ++tt) {
            const float lfv = fl[tt], iv = il[tt];
            const float mn = fmaxf(lfv + m, iv), fp = __expf(lfv + m - mn), ip = __expf(iv - mn); m = mn;
            const float vv = vl[tt * 256 + e] * ip;
            const LAS f32x4* kq = (const LAS f32x4*)(kl + tt * 256 + 128 * half); const LAS f32x4* qq = (const LAS f32x4*)(ql + tt * 256 + 128 * half);
            float num = 0.f;
#pragma unroll
            for (int i = 0; i < 32; ++i) { const f32x4 kv = kq[i], qv = qq[i];
                C[4 * i + 0] = fp * C[4 * i + 0] + kv.x * vv; C[4 * i + 1] = fp * C[4 * i + 1] + kv.y * vv; C[4 * i + 2] = fp * C[4 * i + 2] + kv.z * vv; C[4 * i + 3] = fp * C[4 * i + 3] + kv.w * vv;
                num += (qv.x * C[4 * i + 0] + qv.y * C[4 * i + 1]) + (qv.z * C[4 * i + 2] + qv.w * C[4 * i + 3]); }
            const int buf = tt & 1;
            if (tid < 256) { nreg = fp * nreg + ip * kl[tt * 256 + tid]; const float pd = wave_sum(ql[tt * 256 + tid] * nreg); if (F.lane == 0) red[buf * 4 + F.wave] = pd; }
            else part[buf * 256 + e] = num;
            __syncthreads();
            if (tid < 256) { num += part[buf * 256 + e]; const float den = (red[buf * 4 + 0] + red[buf * 4 + 1]) + (red[buf * 4 + 2] + red[buf * 4 + 3]);
                hl[tt * 256 + e] = num / fmaxf(fabsf(den), __expf(-m)); }
        }
        __syncthreads();
        for (int r = 0; r < 4; ++r) { const int tt = 4 * F.wave + r; const size_t row = rowb + t0 + tt;
            const f32x4 hv = *(const LAS f32x4*)(hl + tt * 256 + 4 * F.lane);
            const float ss = wave_sum((hv.x * hv.x + hv.y * hv.y) + (hv.z * hv.z + hv.w * hv.w));
            const float rstd = 1.0f / sqrtf(ss * (1.0f / 256.0f) + EPS);
            const int col = hh * 256 + 4 * F.lane; const f32x4 g = *(const f32x4*)(F.ml_norm_g() + col);
            const unsigned long long ow = *(const unsigned long long*)(MLO + row * D + col);
            const float o0 = bflo((unsigned)ow), o1 = bfhi((unsigned)ow), o2 = bflo((unsigned)(ow >> 32)), o3 = bfhi((unsigned)(ow >> 32));
            const float y0 = hv.x * rstd * g.x / (1.0f + __expf(-o0)), y1 = hv.y * rstd * g.y / (1.0f + __expf(-o1)), y2 = hv.z * rstd * g.z / (1.0f + __expf(-o2)), y3 = hv.w * rstd * g.w / (1.0f + __expf(-o3));
            *(unsigned long long*)(F.YB() + row * D + col) = (unsigned long long)pk2(y0, y1) | ((unsigned long long)pk2(y2, y3) << 32); }
    }
}


namespace ml {
typedef short bf16x8 __attribute__((ext_vector_type(8)));
typedef short s16x4 __attribute__((ext_vector_type(4)));
typedef float f32x16 __attribute__((ext_vector_type(16)));
typedef LAS const char* lcp;
typedef LAS char* lp_t;
constexpr int L = 64;
constexpr int O_QI = 0, O_KI = 33792, O_CB = 67584, O_VI = 102400, O_VW = 111616, O_PI = 120832, O_F = 130048;
constexpr int F_NV = 0, F_QNP = 256, F_RSP = 768, F_AT = 896, F_US = 960, F_WIN = 1024, F_EDEN = 1088, F_WST = 1152, F_RDEN = 1216, F_CW = 1280, F_CBIAS = 3328;
__device__ __forceinline__ int crow(int r, int hi) { return (r & 3) + 8 * (r >> 2) + 4 * hi; }
template <int PITCH, int XM> __device__ __forceinline__ int ioff(int row, int ch) { return XM ? PITCH * row + 16 * (ch ^ (row & XM)) : PITCH * row + 16 * ch; }
template <int PITCH, int XM> __device__ __forceinline__ bf16x8 frag_row(lcp img, int row0, int s, int lane) {
    return *(LAS const bf16x8*)(img + ioff<PITCH, XM>(row0 + (lane & 31), 2 * s + (lane >> 5)));
}
template <int PITCH, int XM> __device__ __forceinline__ bf16x8 frag_tr(lcp img, int k0, int ks, int col0, int lane) {
    const int h = lane >> 5, blk = (lane >> 4) & 1, q = (lane & 15) >> 2, p = lane & 3;
    const int r0 = k0 + 16 * ks + 8 * h + q, ch = (col0 >> 3) + 2 * blk + (p >> 1);
    typedef short v4i16_t __attribute__((ext_vector_type(4)));
    const s16x4 a = __builtin_bit_cast(s16x4, __builtin_amdgcn_ds_read_tr16_b64_v4i16((LAS v4i16_t*)(img + ioff<PITCH, XM>(r0, ch) + 8 * (p & 1))));
    const s16x4 b = __builtin_bit_cast(s16x4, __builtin_amdgcn_ds_read_tr16_b64_v4i16((LAS v4i16_t*)(img + ioff<PITCH, XM>(r0 + 4, ch) + 8 * (p & 1))));
    return (bf16x8){a[0], a[1], a[2], a[3], b[0], b[1], b[2], b[3]};
}
__device__ __forceinline__ float half_sum(float v) {
    const auto rr = __builtin_amdgcn_permlane32_swap(__builtin_bit_cast(unsigned, v), __builtin_bit_cast(unsigned, v), false, false);
    return __builtin_bit_cast(float, rr[0]) + __builtin_bit_cast(float, rr[1]);
}
__device__ __forceinline__ float silu_f(float y) { return y * __builtin_amdgcn_rcpf(1.0f + __expf(-y)); }

__device__ __forceinline__ void mlstm_unit(Frame& F, int unit) {
    const int bh = unit >> 2, sl = unit & 3, b = bh >> 2, hh = bh & 3, tid = opq(F.tid), lane = opq(F.lane), wave = F.wave, hi = lane >> 5, l31 = lane & 31;
    const bf16* MLQ = (const bf16*)F.out(); const bf16* MLK = MLQ + (size_t)T * D; const bf16* MLV = F.PROJ() + 5 * (SEG / 2);
    lp_t base = (lp_t)F.lds;
    LAS float* Fa = (LAS float*)(base + O_F);
    const size_t rowb = (size_t)b * SEQ;
    const float LOG2E = 1.4426950408889634f;
    __syncthreads();
    for (int i = tid; i < 34816 / 16; i += 512) ((LAS v4u*)(base + O_CB))[i] = (v4u){0u, 0u, 0u, 0u};
    if (tid < 256) Fa[F_NV + tid] = 0.f;
    f32x16 C0, C1, C2;
#pragma unroll
    for (int r = 0; r < 16; ++r) { C0[r] = 0.f; C1[r] = 0.f; C2[r] = 0.f; }
    if (tid < 64) *(LAS v4u*)(base + O_VW + 144 * tid + 128) = (v4u){0u, 0u, 0u, 0u};
    const int cg = tid & 31, rb = tid >> 5;
    v4u rawq[2][4], rawk[2][4], rawv[2]; float g_bb[2], g_us[2], g_pm[2]; float m_prev = 0.f;
#define ML_PREFETCH(T0, P) do { const int t0_ = (T0); \
        _Pragma("unroll") for (int i = 0; i < 4; ++i) { const unsigned g_ = (unsigned)(((int)rowb + t0_ + 4 * rb + i) * D + hh * 256 + cg * 8); \
            rawq[P][i] = *(const v4u*)(MLQ + g_); rawk[P][i] = *(const v4u*)(MLK + g_); } \
        rawv[P] = *(const v4u*)(MLV + (unsigned)(((int)rowb + t0_ + (tid >> 3)) * D + hh * 256 + 64 * sl + (tid & 7) * 8)); \
        { const float* gt_ = F.gt() + (unsigned)(((bh * (SEQ / L) + t0_ / L) * 3) * 64 + lane); g_bb[P] = gt_[0]; g_us[P] = gt_[64]; g_pm[P] = gt_[128]; } } while (0)
    ML_PREFETCH(0, 0); ML_PREFETCH(L, 1);
    __syncthreads();
    for (int chunk2 = 0; chunk2 < SEQ / L; chunk2 += 2) {
#pragma unroll
      for (int par = 0; par < 2; ++par) {
        const int chunk = chunk2 + par, t0 = chunk * L;
        const int tid = opq(F.tid), lane = tid & 63, hi = lane >> 5, l31 = lane & 31, cg = tid & 31, rb = tid >> 5, lo = lane;
        const float u = g_us[par], mm = g_bb[par] + fmaxf(m_prev, g_pm[par]), winter = __builtin_amdgcn_exp2f(g_bb[par] + m_prev - mm), at = g_bb[par] - mm, eden = __builtin_amdgcn_exp2f(-mm);
        const float bb63 = __builtin_bit_cast(float, __builtin_amdgcn_readlane(__builtin_bit_cast(int, g_bb[par]), 63)), mnew = __builtin_bit_cast(float, __builtin_amdgcn_readlane(__builtin_bit_cast(int, mm), 63));
        const float decay = __builtin_amdgcn_exp2f(bb63 + m_prev - mnew), wstate = __builtin_amdgcn_exp2f(bb63 - mnew + u); m_prev = mnew;
        if (wave == 0) { Fa[F_AT + lane] = at; Fa[F_US + lane] = u; Fa[F_WIN + lane] = winter; Fa[F_EDEN + lane] = eden; Fa[F_WST + lane] = wstate; }
#pragma unroll
        for (int j = 0; j < 4; ++j) { *(LAS v4u*)(base + O_QI + ioff<528, 0>(4 * rb + j, cg)) = rawq[par][j]; *(LAS v4u*)(base + O_KI + ioff<528, 0>(4 * rb + j, cg)) = rawk[par][j]; }
        { const int s = tid >> 3, ch = tid & 7; const v4u w = rawv[par];
          *(LAS v4u*)(base + O_VI + ioff<144, 0>(s, ch)) = w;
          const float ws = __shfl(wstate, s);
          v4u o; o.x = pk2(bflo(w.x) * ws, bfhi(w.x) * ws); o.y = pk2(bflo(w.y) * ws, bfhi(w.y) * ws); o.z = pk2(bflo(w.z) * ws, bfhi(w.z) * ws); o.w = pk2(bflo(w.w) * ws, bfhi(w.w) * ws);
          *(LAS v4u*)(base + O_VW + ioff<144, 0>(s, ch)) = o;
          if (ch == 0) *(LAS unsigned short*)(base + O_VW + 144 * s + 128) = (unsigned short)pk2(ws, 0.f); }
        __syncthreads();
        if (chunk + 2 < SEQ / L) ML_PREFETCH(t0 + 2 * L, par);
        __builtin_amdgcn_sched_barrier(0);
        f32x16 acc;
#pragma unroll
        for (int r = 0; r < 16; ++r) acc[r] = 0.f;
        const int wq = wave & 3, ta = wq >> 1, tb = wq & 1;
        if (wave < 4) {
#pragma unroll
            for (int kh = 0; kh < 2; ++kh) { bf16x8 fa[8], fb[8];
#pragma unroll
                for (int ks = 0; ks < 8; ++ks) { fa[ks] = frag_row<528, 0>(base + O_KI, 32 * tb, 8 * kh + ks, lo); fb[ks] = frag_row<528, 0>(base + O_QI, 32 * ta, 8 * kh + ks, lo); }
                __builtin_amdgcn_sched_barrier(0);
#pragma unroll
                for (int ks = 0; ks < 8; ++ks) acc = __builtin_amdgcn_mfma_f32_32x32x16_bf16(fa[ks], fb[ks], acc, 0, 0, 0);
                __builtin_amdgcn_sched_barrier(0); }
            const float at_l = __shfl(at, 32 * ta + l31); const int t = 32 * ta + l31; float rsum = 0.f;
#pragma unroll
            for (int g = 0; g < 4; ++g) { const int s0 = 32 * tb + 8 * g + 4 * hi; const f32x4 us4 = *(LAS const f32x4*)(Fa + F_US + s0); float p[4];
#pragma unroll
                for (int i = 0; i < 4; ++i) { p[i] = (s0 + i <= t) ? acc[4 * g + i] * __builtin_amdgcn_exp2f(at_l + us4[i]) : 0.f; rsum += p[i]; }
                *(LAS unsigned long long*)(base + O_PI + ioff<144, 0>(t, s0 >> 3) + 2 * (s0 & 7)) = (unsigned long long)pk2(p[0], p[1]) | ((unsigned long long)pk2(p[2], p[3]) << 32); }
            rsum = half_sum(rsum);
            if (hi == 0) Fa[F_RSP + tb * 64 + t] = rsum;
        } else {
#pragma unroll
            for (int kh = 0; kh < 2; ++kh) { bf16x8 fa[8], fb[8];
#pragma unroll
                for (int ks = 0; ks < 8; ++ks) { fa[ks] = frag_row<528, 0>(base + O_QI, 32 * ta, 8 * kh + ks, lo); fb[ks] = frag_tr<136, 0>(base + O_CB, 0, 8 * kh + ks, 32 * tb, lo); }
                __builtin_amdgcn_sched_barrier(0);
#pragma unroll
                for (int ks = 0; ks < 8; ++ks) acc = __builtin_amdgcn_mfma_f32_32x32x16_bf16(fa[ks], fb[ks], acc, 0, 0, 0);
                __builtin_amdgcn_sched_barrier(0); }
        }
        { float s = 0.f;
#pragma unroll
          for (int c = 0; c < 4; ++c) { const v4u w = *(LAS const v4u*)(base + O_QI + ioff<528, 0>(lane, 4 * wave + c)); const f32x4 n0 = *(LAS const f32x4*)(Fa + F_NV + 32 * wave + 8 * c), n1 = *(LAS const f32x4*)(Fa + F_NV + 32 * wave + 8 * c + 4);
              s += bflo(w.x) * n0.x + bfhi(w.x) * n0.y + bflo(w.y) * n0.z + bfhi(w.y) * n0.w + bflo(w.z) * n1.x + bfhi(w.z) * n1.y + bflo(w.w) * n1.z + bfhi(w.w) * n1.w; }
          Fa[F_QNP + wave * 64 + lane] = s; }
        __syncthreads();
        if (wave >= 4) {
            { const int t = 32 * ta + l31;
              const float den = Fa[F_WIN + t] * (((Fa[F_QNP + t] + Fa[F_QNP + 64 + t]) + (Fa[F_QNP + 128 + t] + Fa[F_QNP + 192 + t])) + ((Fa[F_QNP + 256 + t] + Fa[F_QNP + 320 + t]) + (Fa[F_QNP + 384 + t] + Fa[F_QNP + 448 + t])))
                                + Fa[F_RSP + t] + Fa[F_RSP + 64 + t];
              if (hi == 0) Fa[F_CW + 32 * (wave - 4) + l31] = 1.0f / fmaxf(fabsf(den), Fa[F_EDEN + t]); }
#pragma unroll
            for (int g = 0; g < 4; ++g) { const f32x4 w4 = *(LAS const f32x4*)(Fa + F_WIN + 32 * ta + 8 * g + 4 * hi); acc[4 * g] *= w4.x; acc[4 * g + 1] *= w4.y; acc[4 * g + 2] *= w4.z; acc[4 * g + 3] *= w4.w; }
            { bf16x8 fa[4], fb[4];
#pragma unroll
              for (int ks = 0; ks < 4; ++ks) { fa[ks] = frag_row<144, 0>(base + O_PI, 32 * ta, ks, lo); fb[ks] = frag_tr<144, 0>(base + O_VI, 0, ks, 32 * tb, lo); }
              __builtin_amdgcn_sched_barrier(0);
#pragma unroll
              for (int ks = 0; ks < 4; ++ks) acc = __builtin_amdgcn_mfma_f32_32x32x16_bf16(fa[ks], fb[ks], acc, 0, 0, 0); }
            bf16* dst = F.YB() + (rowb + t0 + 32 * ta) * D + hh * 256 + 64 * sl + 32 * tb + l31;
#pragma unroll
            for (int g = 0; g < 4; ++g) { const f32x4 r4 = *(LAS const f32x4*)(Fa + F_CW + 32 * (wave - 4) + 8 * g + 4 * hi);
#pragma unroll
                for (int i = 0; i < 4; ++i) dst[(size_t)(8 * g + 4 * hi + i) * D] = (bf16)pk2(acc[4 * g + i] * r4[i], 0.f); }
        }
#pragma unroll
        for (int r = 0; r < 16; ++r) { C0[r] *= decay; C1[r] *= decay; C2[r] *= decay; }
        { bf16x8 bk[4], v0[4], v1[4], v2[4];
#pragma unroll
          for (int ks = 0; ks < 4; ++ks) { bk[ks] = frag_tr<528, 0>(base + O_KI, 0, ks, 32 * wave, lo); v0[ks] = frag_tr<144, 0>(base + O_VW, 0, ks, 0, lo); v1[ks] = frag_tr<144, 0>(base + O_VW, 0, ks, 32, lo); v2[ks] = frag_tr<144, 0>(base + O_VW, 0, ks, 64, lo); }
          __builtin_amdgcn_sched_barrier(0);
#pragma unroll
          for (int ks = 0; ks < 4; ++ks) { C0 = __builtin_amdgcn_mfma_f32_32x32x16_bf16(v0[ks], bk[ks], C0, 0, 0, 0); C1 = __builtin_amdgcn_mfma_f32_32x32x16_bf16(v1[ks], bk[ks], C1, 0, 0, 0); C2 = __builtin_amdgcn_mfma_f32_32x32x16_bf16(v2[ks], bk[ks], C2, 0, 0, 0); }
          __builtin_amdgcn_sched_barrier(0); }
        { const int d = 32 * wave + l31;
#pragma unroll
          for (int g = 0; g < 4; ++g) { const int e0 = 8 * g + 4 * hi;
              *(LAS unsigned long long*)(base + O_CB + ioff<136, 0>(d, e0 >> 3) + 2 * (e0 & 7)) = (unsigned long long)pk2(C0[4 * g], C0[4 * g + 1]) | ((unsigned long long)pk2(C0[4 * g + 2], C0[4 * g + 3]) << 32);
              *(LAS unsigned long long*)(base + O_CB + ioff<136, 0>(d, (32 + e0) >> 3) + 2 * (e0 & 7)) = (unsigned long long)pk2(C1[4 * g], C1[4 * g + 1]) | ((unsigned long long)pk2(C1[4 * g + 2], C1[4 * g + 3]) << 32); }
          if (hi == 0) Fa[F_NV + d] = C2[0];
        }
        __syncthreads();
      }
    }
#undef ML_PREFETCH
}
}


__device__ __forceinline__ void mlstm_gates(Frame& F, int job) {
    const int lane = opq(F.lane); const float LOG2E = 1.4426950408889634f;
    const float lf2 = F.lf()[(size_t)job * ml::L + lane] * LOG2E, ii2 = F.ipre()[(size_t)job * ml::L + lane] * LOG2E;
    float bb = lf2;
#pragma unroll
    for (int o = 1; o < 64; o <<= 1) { const float v = __shfl_up(bb, o); bb += (lane >= o) ? v : 0.f; }
    const float u = ii2 - bb; float pm = u;
#pragma unroll
    for (int o = 1; o < 64; o <<= 1) { const float v = __shfl_up(pm, o); pm = (lane >= o) ? fmaxf(pm, v) : pm; }
    float* gt = F.gt() + (size_t)job * 3 * 64 + lane;
    gt[0] = bb; gt[64] = u; gt[128] = pm;
}

__device__ __forceinline__ void mlstm_conv_rows(Frame& F) {
    const int tid = opq(F.tid), cg = tid & 255, z = cg >> 7, c0 = (cg & 127) * 8, r0 = F.vcu * 128 + 64 * (tid >> 8);
    const bf16* src = F.PROJ() + (size_t)(3 + z) * (SEG / 2) + c0; bf16* dst = (bf16*)F.out() + (size_t)z * T * D + c0;
    float w[4][8], bs[8];
#pragma unroll
    for (int tap = 0; tap < 4; ++tap) { const f32x4 a0 = *(const f32x4*)(F.conv_w() + tap * 2048 + cg * 8), a1 = *(const f32x4*)(F.conv_w() + tap * 2048 + cg * 8 + 4);
        w[tap][0] = a0.x; w[tap][1] = a0.y; w[tap][2] = a0.z; w[tap][3] = a0.w; w[tap][4] = a1.x; w[tap][5] = a1.y; w[tap][6] = a1.z; w[tap][7] = a1.w; }
    { const f32x4 a0 = *(const f32x4*)(F.conv_b() + cg * 8), a1 = *(const f32x4*)(F.conv_b() + cg * 8 + 4);
      bs[0] = a0.x; bs[1] = a0.y; bs[2] = a0.z; bs[3] = a0.w; bs[4] = a1.x; bs[5] = a1.y; bs[6] = a1.z; bs[7] = a1.w; }
    const float osc = z ? 0.0625f : 1.0f;
    const bool seq_start = (r0 % SEQ) == 0;
    v4u x0, x1, x2;
    { const v4u zero = {0u, 0u, 0u, 0u};
      x0 = seq_start ? zero : *(const v4u*)(src + (size_t)(r0 - 3 + (seq_start ? 3 : 0)) * D);
      x1 = seq_start ? zero : *(const v4u*)(src + (size_t)(r0 - 2 + (seq_start ? 2 : 0)) * D);
      x2 = seq_start ? zero : *(const v4u*)(src + (size_t)(r0 - 1 + (seq_start ? 1 : 0)) * D); }
    v4u nxs[8];
#pragma unroll
    for (int i = 0; i < 8; ++i) nxs[i] = *(const v4u*)(src + (size_t)(r0 + i) * D);
    for (int rr = 0; rr < 64; rr += 8) {
        v4u xs[8];
#pragma unroll
        for (int i = 0; i < 8; ++i) xs[i] = nxs[i];
        if (rr + 8 < 64) {
#pragma unroll
            for (int i = 0; i < 8; ++i) nxs[i] = *(const v4u*)(src + (size_t)(r0 + rr + 8 + i) * D); }
#pragma unroll
        for (int i = 0; i < 8; ++i) {
            const v4u x3 = xs[i]; float y[8];
#pragma unroll
            for (int c = 0; c < 8; ++c) y[c] = bs[c];
#define MK_TAP(tap, X) do { y[0] += w[tap][0] * bflo(X.x); y[1] += w[tap][1] * bfhi(X.x); y[2] += w[tap][2] * bflo(X.y); y[3] += w[tap][3] * bfhi(X.y); \
                           y[4] += w[tap][4] * bflo(X.z); y[5] += w[tap][5] * bfhi(X.z); y[6] += w[tap][6] * bflo(X.w); y[7] += w[tap][7] * bfhi(X.w); } while (0)
            MK_TAP(0, x0); MK_TAP(1, x1); MK_TAP(2, x2); MK_TAP(3, x3);
#undef MK_TAP
#pragma unroll
            for (int c = 0; c < 8; ++c) y[c] = ml::silu_f(y[c]) * osc;
            v4u o; o.x = pk2(y[0], y[1]); o.y = pk2(y[2], y[3]); o.z = pk2(y[4], y[5]); o.w = pk2(y[6], y[7]);
            *(v4u*)(dst + (size_t)(r0 + rr + i) * D) = o;
            x0 = x1; x1 = x2; x2 = x3;
        }
    }
}

__device__ __forceinline__ void mlstm_norm_rows(Frame& F) {
    const int row0 = F.vcu * 128, lane = opq(F.lane);
    const bf16* MLO = F.PROJ() + 6 * (SEG / 2);
    f32x4 G[4];
#pragma unroll
    for (int j = 0; j < 4; ++j) G[j] = *(const f32x4*)(F.ml_norm_g() + 256 * j + 4 * lane);
    unsigned long long nh[4], no[4];
#define NR_LOAD(ROW) do { const size_t row_ = (ROW); const GAS unsigned long long* hp_ = (const GAS unsigned long long*)(F.YB() + row_ * D) + lane; const GAS unsigned long long* op_ = (const GAS unsigned long long*)(MLO + row_ * D) + lane; \
        _Pragma("unroll") for (int j = 0; j < 4; ++j) { nh[j] = hp_[64 * j]; no[j] = op_[64 * j]; } } while (0)
    NR_LOAD((size_t)row0 + 16 * F.wave);
    for (int r = 0; r < 16; ++r) {
        const size_t row = (size_t)row0 + 16 * F.wave + r;
        GAS unsigned* hp = (GAS unsigned*)((unsigned char*)F.YB8() + row * D) + lane;
        unsigned long long ch[4], co[4];
#pragma unroll
        for (int j = 0; j < 4; ++j) { ch[j] = nh[j]; co[j] = no[j]; }
        if (r < 15) NR_LOAD(row + 1);
#pragma unroll
        for (int j = 0; j < 4; ++j) { const unsigned long long hw = ch[j], ow = co[j];
            const float h0 = bflo((unsigned)hw), h1 = bfhi((unsigned)hw), h2 = bflo((unsigned)(hw >> 32)), h3 = bfhi((unsigned)(hw >> 32));
            const float ss = wave_sum((h0 * h0 + h1 * h1) + (h2 * h2 + h3 * h3)); const float rstd = 1.0f / sqrtf(ss * (1.0f / 256.0f) + EPS);
            const float o0 = bflo((unsigned)ow), o1 = bfhi((unsigned)ow), o2 = bflo((unsigned)(ow >> 32)), o3 = bfhi((unsigned)(ow >> 32));
            const float y0 = h0 * rstd * G[j].x / (1.0f + __expf(-o0)), y1 = h1 * rstd * G[j].y / (1.0f + __expf(-o1)), y2 = h2 * rstd * G[j].z / (1.0f + __expf(-o2)), y3 = h3 * rstd * G[j].w / (1.0f + __expf(-o3));
            hp[64 * j] = pg8::pk4_fp8(y0, y1, y2, y3); }
    }
#undef NR_LOAD
}

namespace at {
using ml::bf16x8; using ml::s16x4; using ml::f32x16; using ml::ioff; using ml::frag_row; using ml::lcp; using ml::lp_t;
typedef _Float16 f16x8 __attribute__((ext_vector_type(8)));
typedef _Float16 f16x2 __attribute__((ext_vector_type(2)));
typedef float f32x2 __attribute__((ext_vector_type(2)));
constexpr int O_KI = 0, O_VI = 8192, O_FLAG = 16384;
template <int PITCH, int XM> __device__ __forceinline__ bf16x8 frag_trp(lcp img, int ks, int col0, int lane) {
    const int h = lane >> 5, blk = (lane >> 4) & 1, q = (lane & 15) >> 2, p = lane & 3;
    const int r0 = 16 * ks + 4 * h + q, ch = (col0 >> 3) + 2 * blk + (p >> 1);
    typedef short v4i16_t __attribute__((ext_vector_type(4)));
    const s16x4 a = __builtin_bit_cast(s16x4, __builtin_amdgcn_ds_read_tr16_b64_v4i16((LAS v4i16_t*)(img + ioff<PITCH, XM>(r0, ch) + 8 * (p & 1))));
    const s16x4 b = __builtin_bit_cast(s16x4, __builtin_amdgcn_ds_read_tr16_b64_v4i16((LAS v4i16_t*)(img + ioff<PITCH, XM>(r0 + 8, ch) + 8 * (p & 1))));
    return (bf16x8){a[0], a[1], a[2], a[3], b[0], b[1], b[2], b[3]};
}
__device__ __forceinline__ unsigned pkh(float a, float b) { const f32x2 v = {a, b}; return __builtin_bit_cast(unsigned, __builtin_convertvector(v, f16x2)); }
__device__ __forceinline__ f16x8 h8(unsigned a, unsigned b, unsigned c, unsigned d) { const v4u v = {a, b, c, d}; return __builtin_bit_cast(f16x8, v); }
__device__ __forceinline__ bf16x8 b8(unsigned a, unsigned b, unsigned c, unsigned d) { const v4u v = {a, b, c, d}; return __builtin_bit_cast(bf16x8, v); }

__device__ __forceinline__ void attn_unit(Frame& F, int bh, int qb) {
    const int b = bh >> 4, hd = bh & 15, tid = opq(F.tid), lane = opq(F.lane), wave = F.wave, hi = lane >> 5, l31 = lane & 31, pr = wave >> 1, tp = tid & 127;
    const bf16* Q = F.PROJ(); const bf16* K = F.PROJ() + SEG / 2; const bf16* V = F.PROJ() + SEG;
    lp_t base = (lp_t)F.lds + pr * 16384;
    LAS volatile int* dflag = (LAS volatile int*)((lp_t)F.lds + 65536);
    const size_t rowb = (size_t)b * SEQ; const int q0 = qb * 256, tw0 = q0 + 32 * wave, t = tw0 + l31, kt0 = qb * 4 + pr;
    bf16x8 qr[4];
#pragma unroll
    for (int ks = 0; ks < 4; ++ks) qr[ks] = *(const bf16x8*)(Q + (rowb + t) * D + hd * 64 + 16 * ks + 8 * hi);
    unsigned uw[2][4];
#pragma unroll
    for (int sp = 0; sp < 2; ++sp)
#pragma unroll
        for (int jj = 0; jj < 4; ++jj) { const int j0 = 2 * jj, j1 = 2 * jj + 1;
            const int k0 = 16 * sp + 8 * (j0 >> 2) + 4 * hi + (j0 & 3), k1 = 16 * sp + 8 * (j1 >> 2) + 4 * hi + (j1 & 3);
            uw[sp][jj] = (k0 > l31 ? 0x3C00u : 0u) | (k1 > l31 ? 0x3C000000u : 0u); }
    const f16x8 U0 = h8(uw[0][0], uw[0][1], uw[0][2], uw[0][3]), U1 = h8(uw[1][0], uw[1][1], uw[1][2], uw[1][3]), ONES = h8(0x3C003C00u, 0x3C003C00u, 0x3C003C00u, 0x3C003C00u);
    f32x16 O0, O1;
#pragma unroll
    for (int r = 0; r < 16; ++r) { O0[r] = 0.f; O1[r] = 0.f; }
    float R = 0.f; bool wdone = false;
    v4u kreg[4], vreg[4];
#define AT_LOAD(KT) do { _Pragma("unroll") for (int j = 0; j < 4; ++j) { const size_t g = (rowb + (KT) * 64 + (tp >> 3) + 16 * j) * D + hd * 64 + (tp & 7) * 8; kreg[j] = *(const v4u*)(K + g); vreg[j] = *(const v4u*)(V + g); } } while (0)
    AT_LOAD(kt0);
    __syncthreads();
    if (tid < 8) dflag[tid] = 0;
    for (int it = 0; it <= qb * 4 + 3; ++it) {
        const int kt = kt0 - it;
        __syncthreads();
        { int nd = 0;
#pragma unroll
          for (int w = 0; w < 8; ++w) nd += dflag[w];
          if (nd == 8) break; }
        if (kt >= 0) {
#pragma unroll
            for (int j = 0; j < 4; ++j) { *(LAS v4u*)(base + O_KI + ioff<128, 7>((tp >> 3) + 16 * j, tp & 7)) = kreg[j]; *(LAS v4u*)(base + O_VI + ioff<128, 7>((tp >> 3) + 16 * j, tp & 7)) = vreg[j]; } }
        __syncthreads();
        if (kt > 0) AT_LOAD(kt - 1);
        if (kt < 0) { if (!wdone) { wdone = true; if (lane == 0) dflag[wave] = 1; } continue; }
        if (wdone) continue;
        int lo = lane; asm volatile("" : "+v"(lo));
        f32x16 p0, p1;
#pragma unroll
        for (int r = 0; r < 16; ++r) { p0[r] = 0.f; p1[r] = 0.f; }
#pragma unroll
        for (int ks = 0; ks < 4; ++ks) { p0 = __builtin_amdgcn_mfma_f32_32x32x16_bf16(frag_row<128, 7>(base + O_KI, 0, ks, lo), qr[ks], p0, 0, 0, 0);
                                         p1 = __builtin_amdgcn_mfma_f32_32x32x16_bf16(frag_row<128, 7>(base + O_KI, 32, ks, lo), qr[ks], p1, 0, 0, 0); }
        const bool diag = (it == 0);
        const int trel = t - 64 * kt;
        float lk00 = 0.f;
        unsigned lkw0[8], lkw1[8];
#pragma unroll
        for (int r = 0; r < 16; ++r) {
            const int key0 = ml::crow(r, hi);
            { const float z = p0[r], lb = fminf(z, 0.f) - __builtin_amdgcn_logf(1.0f + __builtin_amdgcn_exp2f(-fabsf(z))); float lk = lb - z; if (diag && !(key0 < trel)) lk = 0.f; p0[r] = lb; if (r == 0) lk00 = lk;
              if (r & 1) lkw0[r >> 1] = pkh(__builtin_bit_cast(float, lkw0[r >> 1]), lk); else lkw0[r >> 1] = __builtin_bit_cast(unsigned, lk); }
            { const float z = p1[r], lb = fminf(z, 0.f) - __builtin_amdgcn_logf(1.0f + __builtin_amdgcn_exp2f(-fabsf(z))); float lk = lb - z; if (diag && !(key0 + 32 < trel)) lk = 0.f; p1[r] = lb;
              if (r & 1) lkw1[r >> 1] = pkh(__builtin_bit_cast(float, lkw1[r >> 1]), lk); else lkw1[r >> 1] = __builtin_bit_cast(unsigned, lk); }
        }
        f32x16 bt1, bt0;
#pragma unroll
        for (int r = 0; r < 16; ++r) { bt1[r] = R; bt0[r] = R; }
        const f16x8 L10 = h8(lkw1[0], lkw1[1], lkw1[2], lkw1[3]), L11 = h8(lkw1[4], lkw1[5], lkw1[6], lkw1[7]), L00 = h8(lkw0[0], lkw0[1], lkw0[2], lkw0[3]), L01 = h8(lkw0[4], lkw0[5], lkw0[6], lkw0[7]);
        bt1 = __builtin_amdgcn_mfma_f32_32x32x16_f16(U0, L10, bt1, 0, 0, 0); bt1 = __builtin_amdgcn_mfma_f32_32x32x16_f16(U1, L11, bt1, 0, 0, 0);
        bt0 = __builtin_amdgcn_mfma_f32_32x32x16_f16(ONES, L10, bt0, 0, 0, 0); bt0 = __builtin_amdgcn_mfma_f32_32x32x16_f16(ONES, L11, bt0, 0, 0, 0);
        bt0 = __builtin_amdgcn_mfma_f32_32x32x16_f16(U0, L00, bt0, 0, 0, 0); bt0 = __builtin_amdgcn_mfma_f32_32x32x16_f16(U1, L01, bt0, 0, 0, 0);
        { const float v = bt0[0] + lk00;
          const auto rr = __builtin_amdgcn_permlane32_swap(__builtin_bit_cast(unsigned, v), __builtin_bit_cast(unsigned, v), false, false);
          R = __builtin_bit_cast(float, rr[0]); }
        unsigned aw0[8], aw1[8];
#pragma unroll
        for (int r = 0; r < 16; r += 2) {
            const int key0 = ml::crow(r, hi);
            float a00 = __builtin_amdgcn_exp2f(p0[r] + bt0[r]), a01 = __builtin_amdgcn_exp2f(p0[r + 1] + bt0[r + 1]), a10 = __builtin_amdgcn_exp2f(p1[r] + bt1[r]), a11 = __builtin_amdgcn_exp2f(p1[r + 1] + bt1[r + 1]);
            if (diag) { if (!(key0 < trel)) a00 = 0.f; if (!(key0 + 1 < trel)) a01 = 0.f; if (!(key0 + 32 < trel)) a10 = 0.f; if (!(key0 + 33 < trel)) a11 = 0.f; }
            aw0[r >> 1] = pk2(a00, a01); aw1[r >> 1] = pk2(a10, a11);
        }
        const bf16x8 A00 = b8(aw0[0], aw0[1], aw0[2], aw0[3]), A01 = b8(aw0[4], aw0[5], aw0[6], aw0[7]), A10 = b8(aw1[0], aw1[1], aw1[2], aw1[3]), A11 = b8(aw1[4], aw1[5], aw1[6], aw1[7]);
        O0 = __builtin_amdgcn_mfma_f32_32x32x16_bf16(A00, frag_trp<128, 7>(base + O_VI, 0, 0, lo), O0, 0, 0, 0);  O1 = __builtin_amdgcn_mfma_f32_32x32x16_bf16(A00, frag_trp<128, 7>(base + O_VI, 0, 32, lo), O1, 0, 0, 0);
        O0 = __builtin_amdgcn_mfma_f32_32x32x16_bf16(A01, frag_trp<128, 7>(base + O_VI, 1, 0, lo), O0, 0, 0, 0);  O1 = __builtin_amdgcn_mfma_f32_32x32x16_bf16(A01, frag_trp<128, 7>(base + O_VI, 1, 32, lo), O1, 0, 0, 0);
        O0 = __builtin_amdgcn_mfma_f32_32x32x16_bf16(A10, frag_trp<128, 7>(base + O_VI, 2, 0, lo), O0, 0, 0, 0);  O1 = __builtin_amdgcn_mfma_f32_32x32x16_bf16(A10, frag_trp<128, 7>(base + O_VI, 2, 32, lo), O1, 0, 0, 0);
        O0 = __builtin_amdgcn_mfma_f32_32x32x16_bf16(A11, frag_trp<128, 7>(base + O_VI, 3, 0, lo), O0, 0, 0, 0);  O1 = __builtin_amdgcn_mfma_f32_32x32x16_bf16(A11, frag_trp<128, 7>(base + O_VI, 3, 32, lo), O1, 0, 0, 0);
        if (__all(R < ATT_RTHR)) { wdone = true; if (lane == 0) dflag[wave] = 1; }
    }
#undef AT_LOAD
    __syncthreads();
    unsigned char* dst = (unsigned char*)F.YA() + (rowb + tw0) * D + hd * 64 + l31;
#pragma unroll
    for (int r = 0; r < 16; ++r) { const int q = ml::crow(r, hi); dst[(size_t)q * D] = (unsigned char)pg8::pk4_fp8(O0[r], 0.f, 0.f, 0.f); dst[(size_t)q * D + 32] = (unsigned char)pg8::pk4_fp8(O1[r], 0.f, 0.f, 0.f); }
}
}

__device__ __forceinline__ void p5a_route(Frame& F) {
    const int row0 = F.vcu * 128, b = row0 / SEQ, lane = opq(F.lane), tid = opq(F.tid);
    LAS float* wr = (LAS float*)F.lds;
    LAS int* le = (LAS int*)(F.lds + 131584); LAS int* lp = le + 512;
    LAS int* lcnt = (LAS int*)(F.LC + LC_LCNT); LAS int* gbase = (LAS int*)(F.LC + LC_GBASE);
    for (int idx = tid; idx < 32768; idx += 512) wr[(idx & 31) * 1028 + (idx >> 5)] = F.router_w()[idx];
    if (tid < 32) lcnt[tid] = 0;
    f32x4 Av[4], Bv[4];
#pragma unroll
    for (int j = 0; j < 4; ++j) { const int col = 4 * lane + 256 * j; const float* mb = F.mod() + (size_t)b * NMOD;
        const f32x4 g = *(const f32x4*)(F.norm2_g() + col); Av[j] = g * (*(const f32x4*)(mb + 4 * D + col) + 1.0f); Bv[j] = *(const f32x4*)(mb + 3 * D + col); }
    float rb[32];
#pragma unroll
    for (int e = 0; e < 32; ++e) rb[e] = F.router_b()[e];
    __syncthreads();
    f32x4 nx[4];
    { const GAS f32x4* xr = (const GAS f32x4*)(F.out() + (size_t)(row0 + 16 * F.wave) * D) + lane;
#pragma unroll
      for (int j = 0; j < 4; ++j) nx[j] = xr[64 * j]; }
    for (int r = 0; r < 16; ++r) {
        const int rl = 16 * F.wave + r, row = row0 + rl;
        f32x4 v[4]; float ss = 0.f;
#pragma unroll
        for (int j = 0; j < 4; ++j) { v[j] = nx[j]; ss += (v[j].x * v[j].x + v[j].y * v[j].y) + (v[j].z * v[j].z + v[j].w * v[j].w); }
        if (r < 15) { const GAS f32x4* xr = (const GAS f32x4*)(F.out() + (size_t)(row + 1) * D) + lane;
#pragma unroll
            for (int j = 0; j < 4; ++j) nx[j] = xr[64 * j]; }
        const float rstd = 1.0f / sqrtf(wave_sum(ss) * (1.0f / D) + EPS);
        { GAS unsigned* o4 = (GAS unsigned*)((unsigned char*)F.H2() + (size_t)row * D) + lane;
#pragma unroll
          for (int j = 0; j < 4; ++j) { v[j] = v[j] * rstd * Av[j] + Bv[j]; o4[64 * j] = pg8::pk4_fp8(v[j].x, v[j].y, v[j].z, v[j].w); } }
        float p[32];
#pragma unroll
        for (int e = 0; e < 32; ++e) { float s = 0.f;
#pragma unroll
            for (int j = 0; j < 4; ++j) { const f32x4 w = *(const LAS f32x4*)(wr + e * 1028 + 4 * lane + 256 * j); s += (v[j].x * w.x + v[j].y * w.y) + (v[j].z * w.z + v[j].w * w.w); }
            p[e] = s; }
#pragma unroll
        for (int i = 0; i < 16; ++i) { const bool up = (lane & 32) != 0; const float send = up ? p[i] : p[i + 16], keep = up ? p[i + 16] : p[i]; p[i] = keep + __shfl_xor(send, 32); }
#pragma unroll
        for (int i = 0; i < 8; ++i) { const bool up = (lane & 16) != 0; const float send = up ? p[i] : p[i + 8], keep = up ? p[i + 8] : p[i]; p[i] = keep + __shfl_xor(send, 16); }
#pragma unroll
        for (int i = 0; i < 4; ++i) { const bool up = (lane & 8) != 0; const float send = up ? p[i] : p[i + 4], keep = up ? p[i + 4] : p[i]; p[i] = keep + __shfl_xor(send, 8); }
#pragma unroll
        for (int i = 0; i < 2; ++i) { const bool up = (lane & 4) != 0; const float send = up ? p[i] : p[i + 2], keep = up ? p[i + 2] : p[i]; p[i] = keep + __shfl_xor(send, 4); }
        { const bool up = (lane & 2) != 0; const float send = up ? p[0] : p[1], keep = up ? p[1] : p[0]; p[0] = keep + __shfl_xor(send, 2); }
        p[0] += __shfl_xor(p[0], 1);
        { LAS float* lg = (LAS float*)(F.lds + 135680) + F.wave * 32;
          if ((lane & 1) == 0) lg[lane >> 1] = p[0];
#pragma unroll
          for (int q = 0; q < 8; ++q) { const f32x4 t4 = *(const LAS f32x4*)(lg + 4 * q); p[4 * q] = t4.x + rb[4 * q]; p[4 * q + 1] = t4.y + rb[4 * q + 1]; p[4 * q + 2] = t4.z + rb[4 * q + 2]; p[4 * q + 3] = t4.w + rb[4 * q + 3]; } }
        int sel[4]; float sv[4]; unsigned used = 0u;
#pragma unroll
        for (int k = 0; k < 4; ++k) { float best = -3.0e38f; int bi = 0;
#pragma unroll
            for (int e = 0; e < 32; ++e) { const bool cnd = (((used >> e) & 1u) == 0u) && (p[e] > best); best = cnd ? p[e] : best; bi = cnd ? e : bi; }
            sel[k] = bi; sv[k] = best; used |= 1u << bi; }
        const float e1 = __expf(sv[1] - sv[0]), e2 = __expf(sv[2] - sv[0]), e3 = __expf(sv[3] - sv[0]), inv = 1.0f / (1.0f + e1 + e2 + e3);
        if (lane < 4) { const int ek = lane == 0 ? sel[0] : lane == 1 ? sel[1] : lane == 2 ? sel[2] : sel[3];
            const float wk = (lane == 0 ? 1.0f : lane == 1 ? e1 : lane == 2 ? e2 : e3) * inv;
            const int pos = __hip_atomic_fetch_add(lcnt + ek, 1, __ATOMIC_RELAXED, __HIP_MEMORY_SCOPE_WORKGROUP);
            le[rl * 4 + lane] = ek; lp[rl * 4 + lane] = pos; F.tokw()[(size_t)row * 4 + lane] = wk; }
        if (lane == 0) F.rstd2()[row] = rstd;
    }
    __syncthreads();
    if (tid < 32) gbase[tid] = (int)__hip_atomic_fetch_add(F.ctl + CW_ECNT + 64 * tid, (unsigned)lcnt[tid], __ATOMIC_RELAXED, __HIP_MEMORY_SCOPE_AGENT);
    __syncthreads();
    { const int ek = le[tid]; F.toke()[(size_t)row0 * 4 + tid] = ek; F.tokp()[(size_t)row0 * 4 + tid] = lp[tid] + gbase[ek]; }
}

__device__ __forceinline__ void p5b_tables(Frame& F) {
    const int row0 = F.vcu * 128, tid = opq(F.tid);
    LAS int* ts = (LAS int*)(F.LC + LC_TS); LAS int* ps = (LAS int*)(F.LC + LC_PS); LAS int* cn = (LAS int*)(F.LC + LC_CNT);
    if (tid < 32) cn[tid] = (int)__hip_atomic_load(F.ctl + CW_ECNT + 64 * tid, RLX_AGENT);
    __syncthreads();
    if (tid == 0) { int run = 0, trun = 0; for (int e = 0; e < 32; ++e) { ps[e] = run; ts[e] = trun; const int nt = (cn[e] + 255) >> 8; run += nt * 256; trun += nt; } ts[32] = trun; }
    __syncthreads();
    { const size_t idx = (size_t)row0 * 4 + tid; const int ek = F.toke()[idx], dst = ps[ek] + F.tokp()[idx]; F.tokrow()[idx] = dst; F.row2tok()[dst] = row0 + (tid >> 2); }
    if (F.vcu < 32) { const int e = F.vcu, start = ps[e] + cn[e], end = ps[e] + (((cn[e] + 255) >> 8) << 8); for (int r = start + tid; r < end; r += 512) F.row2tok()[r] = 0; }
}

__device__ __forceinline__ void p8_combine(Frame& F, bool poison) {
    const int row0 = F.vcu * 128, b = row0 / SEQ, lane = opq(F.lane);
    f32x4 G2[4], FG[4];
#pragma unroll
    for (int j = 0; j < 4; ++j) { const int col = 4 * lane + 256 * j; G2[j] = *(const f32x4*)(F.mod() + (size_t)b * NMOD + 5 * D + col); FG[j] = *(const f32x4*)(F.final_g() + col); }
    f32x4 nx[4]; unsigned long long ng[4][4]; float nw[4];
#define P8_LOAD(ROW) do { const size_t row_ = (ROW); const GAS f32x4* xr_ = (const GAS f32x4*)(F.out() + row_ * D) + lane; \
        _Pragma("unroll") for (int j = 0; j < 4; ++j) nx[j] = xr_[64 * j]; \
        _Pragma("unroll") for (int k = 0; k < 4; ++k) { const int src_ = F.tokrow()[row_ * 4 + k]; nw[k] = F.tokw()[row_ * 4 + k]; \
            const GAS unsigned long long* s8_ = (const GAS unsigned long long*)(F.OUTR() + (size_t)src_ * D) + lane; \
            _Pragma("unroll") for (int j = 0; j < 4; ++j) ng[k][j] = s8_[64 * j]; } } while (0)
    P8_LOAD((size_t)row0 + 16 * F.wave);
    for (int r = 0; r < 16; ++r) {
        const int row = row0 + 16 * F.wave + r;
        GAS f32x4* xr = (GAS f32x4*)(F.out() + (size_t)row * D) + lane;
        f32x4 y[4], xv[4];
#pragma unroll
        for (int j = 0; j < 4; ++j) { y[j] = (f32x4){0.f, 0.f, 0.f, 0.f}; xv[j] = nx[j]; }
#pragma unroll
        for (int k = 0; k < 4; ++k) { const float wk = nw[k];
#pragma unroll
            for (int j = 0; j < 4; ++j) { const unsigned long long w = ng[k][j]; y[j].x += wk * bflo((unsigned)w); y[j].y += wk * bfhi((unsigned)w); y[j].z += wk * bflo((unsigned)(w >> 32)); y[j].w += wk * bfhi((unsigned)(w >> 32)); } }
        if (r < 15) P8_LOAD((size_t)row + 1);
        f32x4 v[4]; float ss = 0.f;
#pragma unroll
        for (int j = 0; j < 4; ++j) { v[j] = xv[j] + G2[j] * y[j]; ss += (v[j].x * v[j].x + v[j].y * v[j].y) + (v[j].z * v[j].z + v[j].w * v[j].w); }
        const float rstd = 1.0f / sqrtf(wave_sum(ss) * (1.0f / D) + EPS);
        const float qn = __builtin_nanf("");
#pragma unroll
        for (int j = 0; j < 4; ++j) { f32x4 o = v[j] * rstd * FG[j]; if (poison) o = (f32x4){qn, qn, qn, qn}; xr[64 * j] = o; }
    }
#undef P8_LOAD
}

#ifndef MK_REP_G2
#define MK_REP_G2 1
#endif
#ifndef MK_REP_G4A
#define MK_REP_G4A 1
#endif
#ifndef MK_REP_G4B
#define MK_REP_G4B 1
#endif
#ifndef MK_REP_G4C
#define MK_REP_G4C 1
#endif
#ifndef MK_REP_G6
#define MK_REP_G6 1
#endif
#ifndef MK_REP_G7
#define MK_REP_G7 1
#endif
#ifndef MK_REP_P0
#define MK_REP_P0 1
#endif
#ifndef MK_REP_P3
#define MK_REP_P3 1
#endif
struct Args { const float* in[22]; float* out; unsigned char* ws; };
__global__ void __launch_bounds__(NWAVES * 64, 2) mk_fwd(Args args) {
    extern __shared__ __attribute__((aligned(16))) unsigned char lds[];
    Frame F;
    F.lds = (LAS unsigned char*)lds; F.LC = (volatile LAS unsigned*)(F.lds + LDSCTL_OFF);
    F.tid = threadIdx.x; F.lane = F.tid & 63; F.wave = __builtin_amdgcn_readfirstlane(F.tid >> 6);
    F.G = gridDim.x; { const int bx = blockIdx.x; F.vcu = (F.G % 8 == 0) ? (bx % 8) * (F.G / 8) + bx / 8 : bx; }
    F.ws = (unsigned char*)(GAS unsigned char*)karg(23);
    F.ctl = (gu32*)(F.ws + WS_CTL);
    for (int u = F.tid; u < (LDS_BYTES - LDSCTL_OFF) / 4; u += NWAVES * 64) ((LAS unsigned*)(F.lds + LDSCTL_OFF))[u] = 0u;
    __syncthreads();
    XcdBarrier bar = xcd_barrier_post((unsigned*)(F.ctl + CW_BAR), F.LC + LC_BAR);
#define GRID_BAR() xcd_barrier(bar)
    const int G = F.G, cid = (int)blockIdx.x;

    for (int rep_ = 0; rep_ < MK_REP_P0; ++rep_) p0_prologue(F);
    GRID_BAR();
    p1_rows(F);
    GRID_BAR();
    { pg8::Gemm g{F.H1(), F.WIN_T(), T, NPROJ, D / 2}; pg8::StaticOrder S; S.init(T, NPROJ, G, cid);
      pg8::EpiBf16<0> E{F.PROJ(), D, nullptr, D, SEG / 2, QSCALE, 1.0f / W8SCALE};
      for (int rep_ = 0; rep_ < MK_REP_G2; ++rep_) pg8::gemm_phase<pg8::EpiBf16<0>, pg8::StaticOrder, true, true, false, true>(F.lds, g, S, E); }
    GRID_BAR();
    for (int job = F.vcu * NWAVES + F.wave; job < BATCH * 4 * (SEQ / 64); job += G * NWAVES) mlstm_gates(F, job);
    mlstm_conv_rows(F);
    GRID_BAR();
#if defined(MK_NAIVE_MLSTM)
    for (int it = F.vcu; it < 1024; it += G) attn_naive_item(F, it & 255, it >> 8);
    __syncthreads();
    for (int it = F.vcu; it < 64; it += G) mlstm_naive_item(F, it);
#else
    for (int rep_ = 0; rep_ < MK_REP_P3; ++rep_) {
    for (int it = F.vcu; it < 256; it += G) ml::mlstm_unit(F, it);
    __syncthreads();
#if defined(MK_NAIVE_ATTN)
    for (int it = F.vcu; it < 1024; it += G) attn_naive_item(F, it & 255, it >> 8);
#else
    for (int it = F.vcu; it < 2048; it += G) at::attn_unit(F, it & 255, it >> 8);
#endif
    }
#endif
    GRID_BAR();
    { pg8::Gemm g{F.YA(), F.WA_T(), T, D, D / 2}; pg8::StaticOrder S; S.init(T, D, G, cid);
      pg8::EpiGate<false> E{F.PROJ() + 7 * (SEG / 2), nullptr, F.M1(), 1.0f / W8SCALE};
      for (int rep_ = 0; rep_ < MK_REP_G4A; ++rep_) pg8::gemm_phase<pg8::EpiGate<false>, pg8::StaticOrder, true, true, false, true>(F.lds, g, S, E); }
#if defined(MK_NAIVE_MLSTM)
    VM_WAIT(); __syncthreads();
#else
    __syncthreads();
    mlstm_norm_rows(F);
    GRID_BAR();
#endif
    { pg8::Gemm g{F.YB8(), F.WB_T(), T, D, D / 2}; pg8::StaticOrder S; S.init(T, D, G, cid);
      pg8::EpiGate<true, true> E{F.PROJ() + 8 * (SEG / 2), F.M1(), F.MERGED(), 1.0f / W8SCALE};
      for (int rep_ = 0; rep_ < MK_REP_G4B; ++rep_) pg8::gemm_phase<pg8::EpiGate<true, true>, pg8::StaticOrder, true, true, false, true>(F.lds, g, S, E); }
    GRID_BAR();
    { pg8::Gemm g{F.MERGED(), F.WOUT_T(), T, D, D / 2}; pg8::StaticOrder S; S.init(T, D, G, cid);
      pg8::EpiResid E{F.x(), F.mod() + 2 * D, F.out(), SEQ, NMOD, 1.0f / W8SCALE};
      for (int rep_ = 0; rep_ < MK_REP_G4C; ++rep_) pg8::gemm_phase<pg8::EpiResid, pg8::StaticOrder, true, true, false, true>(F.lds, g, S, E); }
    GRID_BAR();
    p5a_route(F);
    GRID_BAR();
    p5b_tables(F);
    GRID_BAR();
    { pg8::Gemm g{F.H2(), F.W1_T(), T, NE * 2048, D / 2}; pg8::GroupedOrder S{(const LAS int*)(F.LC + LC_TS), 8, G, cid, F.row2tok()};
      pg8::EpiSwiglu<true> E{F.b1(), F.ACT(), 1.0f / W8SCALE};
      for (int rep_ = 0; rep_ < MK_REP_G6; ++rep_) pg8::gemm_phase<pg8::EpiSwiglu<true>, pg8::GroupedOrder, true, true, true, true>(F.lds, g, S, E); }
    GRID_BAR();
    { pg8::Gemm g{F.ACT(), F.W2_T(), XS_ROWS, NE * 1024, D / 2}; pg8::GroupedOrder S{(const LAS int*)(F.LC + LC_TS), 4, G, cid, nullptr};
      pg8::EpiOutS E{F.OUTR(), F.b2(), 1.0f / W8SCALE};
      for (int rep_ = 0; rep_ < MK_REP_G7; ++rep_) pg8::gemm_phase<pg8::EpiOutS, pg8::GroupedOrder, true, true, false, true>(F.lds, g, S, E); }
    GRID_BAR();
    { const bool poison = __hip_atomic_load(F.ctl + CW_BAR + XB_TMO, RLX_AGENT) != 0u;
      p8_combine(F, poison); }
}

extern "C" void kernel_launch(void* const* d_in, const int* in_sizes, int n_in, void* d_out, int out_size, void* d_ws, size_t ws_size, hipStream_t stream) {
    static int grid = 0;
    if (grid == 0) {
        if (n_in != 22 || in_sizes[0] != T * D || out_size != T * D || ws_size < WS_END) { fprintf(stderr, "kernel_launch: unexpected shapes (n_in %d, in0 %d, out %d, ws %zu)\n", n_in, n_in > 0 ? in_sizes[0] : -1, out_size, ws_size); grid = -1; return; }
        int dev = 0, cus = 0, per_cu = 0;
        if (hipGetDevice(&dev) != hipSuccess || hipDeviceGetAttribute(&cus, hipDeviceAttributeMultiprocessorCount, dev) != hipSuccess) { grid = -1; return; }
        if (hipFuncSetAttribute((const void*)mk_fwd, hipFuncAttributeMaxDynamicSharedMemorySize, LDS_BYTES) != hipSuccess) { fprintf(stderr, "kernel_launch: hipFuncSetAttribute failed\n"); grid = -1; return; }
        if (hipOccupancyMaxActiveBlocksPerMultiprocessor(&per_cu, (const void*)mk_fwd, NWAVES * 64, LDS_BYTES) != hipSuccess || per_cu < 1) { fprintf(stderr, "kernel_launch: occupancy query says %d blocks per CU\n", per_cu); }
        (void)hipGetLastError();
        if (cus < 256) { fprintf(stderr, "kernel_launch: built for a 256-CU device, found %d CUs\n", cus); grid = -1; return; }
        grid = 256;
    }
    if (grid < 0) return;
    if (hipMemsetAsync((char*)d_ws + WS_CTL, 0, CTL_ZERO_BYTES, stream) != hipSuccess) return;
    Args a{};
    for (int i = 0; i < 22; ++i) a.in[i] = (const float*)d_in[i];
    a.out = (float*)d_out; a.ws = (unsigned char*)d_ws;
    hipLaunchKernelGGL(mk_fwd, dim3(grid), dim3(NWAVES * 64), LDS_BYTES, stream, a);
}
```

```cpp
#include <hip/hip_runtime.h>
#include <cstdio>
#include <cstdint>
namespace pg8 {
#define PG8_LAS __attribute__((address_space(3)))
typedef unsigned short bf16_t;
typedef short bf16x8 __attribute__((ext_vector_type(8)));
typedef float f32x4 __attribute__((ext_vector_type(4)));
typedef unsigned u32x4 __attribute__((ext_vector_type(4)));
typedef int i32x4_ __attribute__((ext_vector_type(4))); typedef int i32x8_ __attribute__((ext_vector_type(8)));
constexpr int BM = 256, BK = 64, HALF = 128, HTB = HALF * BK * 2  , STAGE_BYTES = 8 * HTB, NXCD = 8, WGM = 8;

__host__ __device__ __forceinline__ int lds_byte(int r, int c) { const int st = (r >> 4) * 2 + (c >> 5), rr = r & 15, cc = c & 31, ob = rr * 64 + cc * 2; return st * 1024 + (ob ^ (((ob >> 9) & 1) << 5)); }
__host__ __device__ __forceinline__ void stage_rc(int b, int& R, int& C) { const int st = b / 1024, sb = b % 1024, swz = sb ^ (((sb >> 9) & 1) << 5); R = (st >> 1) * 16 + swz / 64; C = (st & 1) * 32 + (swz % 64) / 2; }
__host__ __device__ __forceinline__ int perm32(int rho) { const int n = rho >> 4, i = rho & 15; return 8 * (i >> 2) + 4 * n + (i & 3); }

struct Unit { int pm, pn; };
struct Gemm { const bf16_t* A; const bf16_t* Bt; int M, N, K; };

struct StaticOrder {
    int nM, nN, nwg, G, c;
    __host__ __device__ void init(int M, int N, int G_, int c_) { nM = M / BM; nN = N / BM; nwg = nM * nN; G = G_; c = c_; }
    __host__ __device__ bool next(int i, Unit& u) const {
        const long L = (long)i * G + c; if (L >= nwg) return false;
        int wgid = (int)L; { const int q = nwg / NXCD, r = nwg % NXCD, xcd = wgid % NXCD, off = wgid / NXCD; wgid = (xcd < r ? xcd * (q + 1) : r * (q + 1) + (xcd - r) * q) + off; }
        const int nig = WGM * nN, gid = wgid / nig, fm = gid * WGM, gsz = (nM - fm) < WGM ? (nM - fm) : WGM;
        u.pm = fm + ((wgid % nig) % gsz); u.pn = (wgid % nig) / gsz; return true;
    }
    __device__ __forceinline__ void a_ready(const Unit&) const {}
    __device__ __forceinline__ void done(const Unit&) const {}
};

__device__ __forceinline__ unsigned cvt_pk_bf16(float lo, float hi) { unsigned r; asm volatile("v_cvt_pk_bf16_f32 %0, %1, %2" : "=v"(r) : "v"(lo), "v"(hi)); return r; }
typedef float f32x2 __attribute__((ext_vector_type(2)));
__device__ __forceinline__ f32x2 gelu_pk(f32x2 v) {
    const f32x2 av = __builtin_elementwise_abs(v), d = av * 0.2316418882f + 1.0f;
    f32x2 t; t.x = __builtin_amdgcn_rcpf(d.x); t.y = __builtin_amdgcn_rcpf(d.y);
    f32x2 q = t * 0.5307027145f + (-0.7265760135f); q = q * t + 0.7107068705f; q = q * t + (-0.142248368f); q = q * t + 0.127414796f; q = q * t;
    const f32x2 s = (v * v) * (-0.72134752044f);
    f32x2 e; e.x = __builtin_amdgcn_exp2f(s.x); e.y = __builtin_amdgcn_exp2f(s.y);
    const f32x2 m = v * (q * e), r = v - m;
    f32x2 o; o.x = v.x < 0.f ? m.x : r.x; o.y = v.y < 0.f ? m.y : r.y; return o;
}

__device__ __forceinline__ void xchg8(const u32x4& w0, const u32x4& w1, u32x4& d1, u32x4& d2) {
#pragma unroll
    for (int i = 0; i < 4; ++i) {
        d1[i] = (unsigned)__builtin_amdgcn_update_dpp((int)w0[i], (int)w1[i], 0x128, 0xf, 0xc, false);
        d2[i] = (unsigned)__builtin_amdgcn_update_dpp((int)w1[i], (int)w0[i], 0x128, 0xf, 0x3, false);
    }
}
template <int ACT  > struct EpiBf16 {
    static constexpr bool PERM = true, PERM2 = true, AFTER_DRAIN = false; static_assert(ACT == 0 || ACT == 1, "EpiBf16: ACT is 0 (none) or 1 (gelu_pk)");
    bf16_t* O; int ldc; const float* bias; int split_cols; size_t split_stride; float scale0; float ascale;
    __device__ __forceinline__ void operator()(const f32x4 (&acc)[2][2][4][2], const Unit& u, int wr, int wc, int fr, int fq) const {
        int colt = u.pn * BM; bf16_t* base = O;
        float sc = ascale; if (split_cols) { const int t = colt / split_cols; base += (size_t)t * split_stride; colt -= t * split_cols; if (t == 0) sc = scale0 * ascale; }
        const int bcol0 = u.pn * BM + wc * 64 + 16 * fq;
        f32x4 bv[2][2];
#pragma unroll
        for (int bj = 0; bj < 2; ++bj)
#pragma unroll
            for (int n = 0; n < 2; ++n) bv[bj][n] = bias ? *(const f32x4*)(bias + bcol0 + 8 * bj + 4 * n) : (f32x4){0.f, 0.f, 0.f, 0.f};
        bf16_t* lp = base + (size_t)(u.pm * BM + wr * 64 + (fr & 7)) * ldc + colt + wc * 64 + 16 * fq + 8 * (fr >> 3);
#pragma unroll
        for (int ai = 0; ai < 2; ++ai)
#pragma unroll
            for (int m = 0; m < 4; ++m) { u32x4 w[2];
#pragma unroll
                for (int bj = 0; bj < 2; ++bj) { f32x4 v0 = acc[ai][bj][m][0] + bv[bj][0], v1 = acc[ai][bj][m][1] + bv[bj][1];
                    if (ACT == 1) { f32x2 a = gelu_pk((f32x2){v0[0], v0[1]}), b = gelu_pk((f32x2){v0[2], v0[3]}), c = gelu_pk((f32x2){v1[0], v1[1]}), d = gelu_pk((f32x2){v1[2], v1[3]});
                        v0 = (f32x4){a.x, a.y, b.x, b.y}; v1 = (f32x4){c.x, c.y, d.x, d.y}; }
                    v0 = v0 * sc; v1 = v1 * sc; w[bj].x = cvt_pk_bf16(v0[0], v0[1]); w[bj].y = cvt_pk_bf16(v0[2], v0[3]); w[bj].z = cvt_pk_bf16(v1[0], v1[1]); w[bj].w = cvt_pk_bf16(v1[2], v1[3]); }
                u32x4 d1, d2; xchg8(w[0], w[1], d1, d2);
                bf16_t* rowp = lp + (size_t)(ai * HALF + m * 16) * ldc;
                __builtin_nontemporal_store(d1, (u32x4*)rowp); __builtin_nontemporal_store(d2, (u32x4*)(rowp + (size_t)8 * ldc)); }
    }
};
template <class Epi, class Sched, bool ALIGN_EPI = false, bool SP2 = false, bool GATHER = false, bool FP8 = false>
__device__ __forceinline__ void gemm_phase(PG8_LAS unsigned char* lds, const Gemm g, const Sched& S, const Epi& E) {
    int tid_ = threadIdx.x; asm volatile("" : "+v"(tid_));
    const int tid = tid_, wid = __builtin_amdgcn_readfirstlane(tid >> 6), lane = tid & 63, wr = wid >> 2, wc = wid & 3, fr = lane & 15, fq = lane >> 4;
    const int K = g.K, nt = K / BK;
    unsigned voffA[2], voffB[2], vA0[2], vA1[2], vN0[2], vN1[2]; int Rr_[2], Cc_[2];
#pragma unroll
    for (int i = 0; i < 2; ++i) { int R, C; stage_rc(tid * 16 + i * 8192, R, C); const int Rb = Epi::PERM2 ? (64 * (R >> 5) + 16 * ((R >> 2) & 3) + 4 * ((R >> 4) & 1) + (R & 3)) : (Epi::PERM ? ((R & ~31) + perm32(R & 31)) : R);
        voffA[i] = (unsigned)(R * K + C) * 2u; voffB[i] = (unsigned)(Rb * K + C) * 2u; Rr_[i] = R; Cc_[i] = C; }
    const size_t kstep = (size_t)(BK * 2);
    const size_t hstep = (size_t)HALF * K * 2;
    const size_t tstep = 2 * hstep;
    const size_t bhstep = Epi::PERM2 ? (size_t)8 * K * 2 : hstep;
#pragma unroll
    for (int i = 0; i < 2; ++i) { vA0[i] = voffA[i]; vA1[i] = voffA[i] + (unsigned)hstep; vN0[i] = vA0[i]; vN1[i] = vA1[i]; }
#define PG8_GLOAD(u, v0, v1) do { _Pragma("unroll") for (int _i = 0; _i < 2; ++_i) { const int _t0 = S.rowtok[(u).pm * BM + Rr_[_i]], _t1 = S.rowtok[(u).pm * BM + HALF + Rr_[_i]]; \
        (v0)[_i] = (unsigned)_t0 * (unsigned)(K * 2) + (unsigned)(Cc_[_i] * 2); (v1)[_i] = (unsigned)_t1 * (unsigned)(K * 2) + (unsigned)(Cc_[_i] * 2); } } while (0)
    const unsigned ldsw = (unsigned)wid * 1024u;
    const int aoff = lds_byte(wr * 64 + fr, fq * 8), boff = lds_byte(wc * 32 + fr, fq * 8);
#define PG8_SA(b, h) (((b) * 2 + (h)) * HTB)
#define PG8_SB(b, h) ((4 + (b) * 2 + (h)) * HTB)
#define PG8_STAGE(bufoff, gbase, voff) do { _Pragma("unroll") for (int _i = 0; _i < 2; ++_i) \
        __builtin_amdgcn_global_load_lds((const unsigned*)((const char*)(gbase) + (voff)[_i]), (PG8_LAS unsigned*)(lds + (bufoff) + ldsw + _i * 8192), 16, 0, 0); } while (0)
#define PG8_LDA(dst, b, h) do { _Pragma("unroll") for (int m = 0; m < 4; ++m) _Pragma("unroll") for (int k = 0; k < 2; ++k) dst[m][k] = *(const PG8_LAS bf16x8*)(lds + PG8_SA(b, h) + aoff + m * 2048 + k * 1024); } while (0)
#define PG8_LDB(dst, b, h) do { _Pragma("unroll") for (int n = 0; n < 2; ++n) _Pragma("unroll") for (int k = 0; k < 2; ++k) dst[n][k] = *(const PG8_LAS bf16x8*)(lds + PG8_SB(b, h) + boff + n * 2048 + k * 1024); } while (0)
#define PG8_MMA(ai, bj, At, Bt) do { __builtin_amdgcn_s_setprio(1); _Pragma("unroll") for (int m = 0; m < 4; ++m) _Pragma("unroll") for (int n = 0; n < 2; ++n) _Pragma("unroll") for (int k = 0; k < 2; ++k) \
        acc[ai][bj][m][n] = __builtin_amdgcn_mfma_f32_16x16x32_bf16(Bt[n][k], At[m][k], acc[ai][bj][m][n], 0, 0, 0); __builtin_amdgcn_s_setprio(0); } while (0)
#define PG8_CAT8(x0, x1) __builtin_shufflevector(__builtin_bit_cast(i32x4_, x0), __builtin_bit_cast(i32x4_, x1), 0, 1, 2, 3, 4, 5, 6, 7)
#define PG8_MFMA8(ACC, B8, A8) asm volatile("s_nop 1\n\tv_mfma_scale_f32_16x16x128_f8f6f4 %0, %1, %2, %0, %3, %3 op_sel_hi:[0,0,0]" : "+v"(ACC) : "v"(B8), "v"(A8), "v"(sc8_))
#define PG8_MMA8(ai, bj, At, Bt) do { i32x8_ a8_[4], b8_[2]; _Pragma("unroll") for (int m = 0; m < 4; ++m) a8_[m] = PG8_CAT8(At[m][0], At[m][1]); _Pragma("unroll") for (int n = 0; n < 2; ++n) b8_[n] = PG8_CAT8(Bt[n][0], Bt[n][1]); \
        __builtin_amdgcn_s_setprio(1); _Pragma("unroll") for (int m = 0; m < 4; ++m) _Pragma("unroll") for (int n = 0; n < 2; ++n) PG8_MFMA8(acc[ai][bj][m][n], b8_[n], a8_[m]); __builtin_amdgcn_s_setprio(0); } while (0)
#define PG8_MM(ai, bj, At, Bt) do { if constexpr (FP8) PG8_MMA8(ai, bj, At, Bt); else PG8_MMA(ai, bj, At, Bt); } while (0)
#define PG8_WAIT_V(n) asm volatile("s_waitcnt vmcnt(" #n ")" ::: "memory")
#define PG8_WAIT_L(n) asm volatile("s_waitcnt lgkmcnt(" #n ")" ::: "memory")
#define PG8_BAR __builtin_amdgcn_s_barrier()
#define PG8_SCHED __builtin_amdgcn_sched_barrier(0)
    const int sc8_ = 0x7F7F7F7F;
    Unit cur, nxt; int ui = 0;
    if (!S.next(0, cur)) return;
    f32x4 acc[2][2][4][2];
#pragma unroll
    for (int a = 0; a < 2; ++a)
#pragma unroll
        for (int b = 0; b < 2; ++b)
#pragma unroll
            for (int m = 0; m < 4; ++m)
#pragma unroll
                for (int n = 0; n < 2; ++n) acc[a][b][m][n] = (f32x4){0.f, 0.f, 0.f, 0.f};
    bf16x8 At[4][2], B0[2][2], B1[2][2];
    if constexpr (GATHER) PG8_GLOAD(cur, vA0, vA1);
    const char* cA = GATHER ? (const char*)g.A : (const char*)g.A + (size_t)cur.pm * tstep; const char* cB = (const char*)g.Bt + (size_t)cur.pn * tstep;
    S.a_ready(cur);
    if constexpr (SP2) {
        PG8_STAGE(PG8_SB(0, 0), cB, voffB); PG8_STAGE(PG8_SB(0, 1), cB + bhstep, voffB); PG8_STAGE(PG8_SA(0, 0), cA, vA0); PG8_STAGE(PG8_SA(0, 1), cA, vA1);
        if (wr == 1) PG8_BAR;
        PG8_WAIT_V(2); PG8_BAR;
        PG8_STAGE(PG8_SB(1, 0), cB + kstep, voffB); PG8_STAGE(PG8_SA(1, 0), cA + kstep, vA0); PG8_STAGE(PG8_SB(1, 1), cB + bhstep + kstep, voffB);
        PG8_WAIT_V(6); PG8_BAR;
    } else {
        PG8_STAGE(PG8_SB(0, 0), cB, voffB); PG8_STAGE(PG8_SA(0, 0), cA, vA0); PG8_STAGE(PG8_SB(0, 1), cB + bhstep, voffB); PG8_STAGE(PG8_SA(0, 1), cA, vA1);
        if (wr == 1) PG8_BAR;
        PG8_WAIT_V(4); PG8_BAR;
        PG8_STAGE(PG8_SB(1, 0), cB + kstep, voffB); PG8_STAGE(PG8_SA(1, 0), cA + kstep, vA0); PG8_STAGE(PG8_SB(1, 1), cB + bhstep + kstep, voffB);
        PG8_WAIT_V(6); PG8_BAR;
    }
    for (;;) {
        const bool has_next = S.next(ui + 1, nxt);
        if constexpr (GATHER) { if (has_next) PG8_GLOAD(nxt, vN0, vN1); else { _Pragma("unroll") for (int i = 0; i < 2; ++i) { vN0[i] = vA0[i]; vN1[i] = vA1[i]; } } }
        const char* nA = GATHER ? (const char*)g.A : (has_next ? (const char*)g.A + (size_t)nxt.pm * tstep : cA); const char* nB = has_next ? (const char*)g.Bt + (size_t)nxt.pn * tstep : cB;
        for (int t = 0; t < nt; t += 2) {
            const bool last = (t == nt - 2);
            const char* a1 = cA + (size_t)(t + 1) * kstep;
            const char* a2 = last ? nA : cA + (size_t)(t + 2) * kstep; const char* b2 = last ? nB : cB + (size_t)(t + 2) * kstep;
            const char* a3 = a2 + kstep; const char* b3 = b2 + kstep;
            unsigned vX0[2], vX1[2];
#pragma unroll
            for (int i = 0; i < 2; ++i) { vX0[i] = (GATHER && last) ? vN0[i] : vA0[i]; vX1[i] = (GATHER && last) ? vN1[i] : vA1[i]; }
            if (last && has_next) S.a_ready(nxt);
            if constexpr (SP2) {
            PG8_LDB(B0, 0, 0); PG8_LDB(B1, 0, 1); PG8_SCHED; PG8_LDA(At, 0, 0); PG8_STAGE(PG8_SA(1, 1), a1, vA1);
            PG8_WAIT_V(8); PG8_WAIT_L(0); PG8_BAR; PG8_MM(0, 0, At, B0); PG8_MM(0, 1, At, B1); PG8_BAR; PG8_SCHED;
            PG8_LDA(At, 0, 1); PG8_STAGE(PG8_SB(0, 0), b2, voffB); PG8_STAGE(PG8_SB(0, 1), b2 + bhstep, voffB); PG8_STAGE(PG8_SA(0, 0), a2, vX0);
            PG8_WAIT_V(8); PG8_WAIT_L(0); PG8_BAR; PG8_MM(1, 0, At, B0); PG8_MM(1, 1, At, B1); PG8_BAR; PG8_SCHED;
            PG8_LDB(B0, 1, 0); PG8_LDB(B1, 1, 1); PG8_SCHED; PG8_LDA(At, 1, 0); PG8_STAGE(PG8_SA(0, 1), a2, vX1);
            PG8_WAIT_V(8); PG8_WAIT_L(0); PG8_BAR; PG8_MM(0, 0, At, B0); PG8_MM(0, 1, At, B1); PG8_BAR; PG8_SCHED;
            PG8_LDA(At, 1, 1); PG8_STAGE(PG8_SB(1, 0), b3, voffB); PG8_STAGE(PG8_SB(1, 1), b3 + bhstep, voffB); PG8_STAGE(PG8_SA(1, 0), a3, vX0);
            PG8_WAIT_V(8); PG8_WAIT_L(0); PG8_BAR; PG8_MM(1, 0, At, B0); PG8_MM(1, 1, At, B1); PG8_BAR; PG8_SCHED;
            } else {
            PG8_LDB(B0, 0, 0); PG8_SCHED; PG8_LDA(At, 0, 0); PG8_STAGE(PG8_SA(1, 1), a1, vA1);
            PG8_WAIT_L(8); PG8_BAR; PG8_WAIT_L(0); PG8_MM(0, 0, At, B0); PG8_BAR; PG8_SCHED;
            PG8_LDB(B1, 0, 1); PG8_STAGE(PG8_SB(0, 0), b2, voffB);
            PG8_BAR; PG8_WAIT_L(0); PG8_MM(0, 1, At, B1); PG8_BAR;
            PG8_LDA(At, 0, 1); PG8_STAGE(PG8_SA(0, 0), a2, vX0);
            PG8_BAR; PG8_WAIT_L(0); PG8_MM(1, 0, At, B0); PG8_BAR; PG8_SCHED;
            PG8_STAGE(PG8_SB(0, 1), b2 + bhstep, voffB);
            PG8_WAIT_V(6); PG8_BAR; PG8_MM(1, 1, At, B1); PG8_BAR;
            PG8_LDB(B0, 1, 0); PG8_SCHED; PG8_LDA(At, 1, 0); PG8_STAGE(PG8_SA(0, 1), a2, vX1);
            PG8_WAIT_L(8); PG8_BAR; PG8_WAIT_L(0); PG8_MM(0, 0, At, B0); PG8_BAR; PG8_SCHED;
            PG8_LDB(B1, 1, 1); PG8_STAGE(PG8_SB(1, 0), b3, voffB);
            PG8_BAR; PG8_WAIT_L(0); PG8_MM(0, 1, At, B1); PG8_BAR;
            PG8_LDA(At, 1, 1); PG8_STAGE(PG8_SA(1, 0), a3, vX0);
            PG8_BAR; PG8_WAIT_L(0); PG8_MM(1, 0, At, B0); PG8_BAR; PG8_SCHED;
            PG8_STAGE(PG8_SB(1, 1), b3 + bhstep, voffB);
            PG8_WAIT_V(6); PG8_BAR; PG8_MM(1, 1, At, B1); PG8_BAR;
            }
        }
        if constexpr (ALIGN_EPI) { if (wr == 0) PG8_BAR; }
        if constexpr (FP8) asm volatile("s_nop 15\n\ts_nop 15" ::: "memory");
        if constexpr (!Epi::AFTER_DRAIN) { E(acc, cur, wr, wc, fr, fq); S.done(cur); }
        if (!has_next) break;
#pragma unroll
        for (int a = 0; a < 2; ++a)
#pragma unroll
            for (int b = 0; b < 2; ++b)
#pragma unroll
                for (int m = 0; m < 4; ++m)
#pragma unroll
                    for (int n = 0; n < 2; ++n) acc[a][b][m][n] = (f32x4){0.f, 0.f, 0.f, 0.f};
        cur = nxt; cA = nA; cB = nB; ++ui;
        if constexpr (GATHER) { _Pragma("unroll") for (int i = 0; i < 2; ++i) { vA0[i] = vN0[i]; vA1[i] = vN1[i]; } }
        if constexpr (ALIGN_EPI) { if (wr == 1) PG8_BAR; }
    }
    PG8_WAIT_V(0);
    if constexpr (!ALIGN_EPI) { if (wr == 0) PG8_BAR; }
    PG8_BAR;
    if constexpr (Epi::AFTER_DRAIN) { E.fused(acc, cur, wr, wc, fr, fq, lds, wid, lane); S.done(cur); }
#undef PG8_SA
#undef PG8_SB
#undef PG8_STAGE
#undef PG8_GLOAD
#undef PG8_LDA
#undef PG8_LDB
#undef PG8_MMA
#undef PG8_MMA8
#undef PG8_MFMA8
#undef PG8_MM
#undef PG8_CAT8
#undef PG8_WAIT_V
#undef PG8_WAIT_L
#undef PG8_BAR
#undef PG8_SCHED
}
}
namespace pg8 {
__device__ __forceinline__ float bf_lo(unsigned w) { return __builtin_bit_cast(float, w << 16); }
__device__ __forceinline__ float bf_hi(unsigned w) { return __builtin_bit_cast(float, w & 0xffff0000u); }
__device__ __forceinline__ unsigned pk4_fp8(float a, float b, float c, float d) { int r = 0; r = __builtin_amdgcn_cvt_pk_fp8_f32(a, b, r, false); r = __builtin_amdgcn_cvt_pk_fp8_f32(c, d, r, true); return (unsigned)r; }
__device__ __forceinline__ float sigmoid_f(float x) { return __builtin_amdgcn_rcpf(1.0f + __expf(-x)); }

template <bool ADD, bool OUT8 = false> struct EpiGate {
    static constexpr bool PERM = true, PERM2 = true, AFTER_DRAIN = false;
    const bf16_t* G; const bf16_t* Min; bf16_t* O; float ascale;
    __device__ __forceinline__ void operator()(const f32x4 (&acc)[2][2][4][2], const Unit& u, int wr, int wc, int fr, int fq) const {
        const int row0 = u.pm * BM + wr * 64 + fr, col0 = u.pn * BM + wc * 64 + 16 * fq;
        bf16_t* lp = O + (size_t)(u.pm * BM + wr * 64 + (fr & 7)) * 1024 + col0 + 8 * (fr >> 3);
#pragma unroll
        for (int ai = 0; ai < 2; ++ai)
#pragma unroll
            for (int m = 0; m < 4; ++m) { const size_t off = (size_t)(row0 + ai * HALF + m * 16) * 1024 + col0; u32x4 w[2]; unsigned w8[4];
#pragma unroll
                for (int bj = 0; bj < 2; ++bj) {
                    const u32x4 g = *(const u32x4*)(G + off + 8 * bj);
                    f32x4 v0 = acc[ai][bj][m][0] * ascale, v1 = acc[ai][bj][m][1] * ascale;
                    v0[0] *= sigmoid_f(bf_lo(g.x)); v0[1] *= sigmoid_f(bf_hi(g.x)); v0[2] *= sigmoid_f(bf_lo(g.y)); v0[3] *= sigmoid_f(bf_hi(g.y));
                    v1[0] *= sigmoid_f(bf_lo(g.z)); v1[1] *= sigmoid_f(bf_hi(g.z)); v1[2] *= sigmoid_f(bf_lo(g.w)); v1[3] *= sigmoid_f(bf_hi(g.w));
                    if (ADD) { const u32x4 p = *(const u32x4*)(Min + off + 8 * bj);
                        v0[0] += bf_lo(p.x); v0[1] += bf_hi(p.x); v0[2] += bf_lo(p.y); v0[3] += bf_hi(p.y);
                        v1[0] += bf_lo(p.z); v1[1] += bf_hi(p.z); v1[2] += bf_lo(p.w); v1[3] += bf_hi(p.w); }
                    if constexpr (OUT8) { w8[2 * bj] = pk4_fp8(v0[0], v0[1], v0[2], v0[3]); w8[2 * bj + 1] = pk4_fp8(v1[0], v1[1], v1[2], v1[3]); }
                    else { w[bj].x = cvt_pk_bf16(v0[0], v0[1]); w[bj].y = cvt_pk_bf16(v0[2], v0[3]); w[bj].z = cvt_pk_bf16(v1[0], v1[1]); w[bj].w = cvt_pk_bf16(v1[2], v1[3]); } }
                if constexpr (OUT8) { const u32x4 o = {w8[0], w8[1], w8[2], w8[3]}; __builtin_nontemporal_store(o, (u32x4*)((unsigned char*)O + off)); }
                else { u32x4 d1, d2; xchg8(w[0], w[1], d1, d2); bf16_t* rowp = lp + (size_t)(ai * HALF + m * 16) * 1024;
                    __builtin_nontemporal_store(d1, (u32x4*)rowp); __builtin_nontemporal_store(d2, (u32x4*)(rowp + 8 * 1024)); } }
    }
};

struct EpiResid {
    static constexpr bool PERM = false, PERM2 = false, AFTER_DRAIN = false;
    const float* X; const float* gate; float* out; int rows_per_batch; int gstride; float ascale;
    __device__ __forceinline__ void operator()(const f32x4 (&acc)[2][2][4][2], const Unit& u, int wr, int wc, int fr, int fq) const {
        const int col0 = u.pn * BM + wc * 32 + 4 * fq;
#pragma unroll
        for (int ai = 0; ai < 2; ++ai)
#pragma unroll
            for (int m = 0; m < 4; ++m) { const int row = u.pm * BM + ai * HALF + wr * 64 + m * 16 + fr; const size_t off = (size_t)row * 1024 + col0;
                const float* gp = gate + (size_t)(row / rows_per_batch) * gstride + col0;
#pragma unroll
                for (int bj = 0; bj < 2; ++bj)
#pragma unroll
                    for (int n = 0; n < 2; ++n) { const f32x4 xv = *(const f32x4*)(X + off + bj * HALF + n * 16); const f32x4 gv = *(const f32x4*)(gp + bj * HALF + n * 16);
                        *(f32x4*)(out + off + bj * HALF + n * 16) = xv + gv * (acc[ai][bj][m][n] * ascale); } }
    }
};

__device__ __forceinline__ float swiglu1(float g, float l) {
    g = fminf(g, 7.0f); l = fminf(fmaxf(l, -7.0f), 7.0f);
    return (l + 1.0f) * (g * __builtin_amdgcn_rcpf(1.0f + __expf(-1.702f * g)));
}
template <bool OUT8> struct EpiSwiglu {
    static constexpr bool PERM = true, PERM2 = false, AFTER_DRAIN = false;
    const float* b1; bf16_t* O; float ascale;
    __device__ __forceinline__ void operator()(const f32x4 (&acc)[2][2][4][2], const Unit& u, int wr, int wc, int fr, int fq) const {
        const int e = u.pn >> 3, pl = u.pn & 7, jc = wc * 32 + 8 * fq;
        const float* bg = b1 + (size_t)e * 2048 + 128 * pl + jc; const float* bl = bg + 1024;
        const f32x4 bg0 = *(const f32x4*)bg, bg1 = *(const f32x4*)(bg + 4), bl0 = *(const f32x4*)bl, bl1 = *(const f32x4*)(bl + 4);
        const int row0 = u.pm * BM + wr * 64 + fr;
#pragma unroll
        for (int ai = 0; ai < 2; ++ai)
#pragma unroll
            for (int m = 0; m < 4; ++m) {
                const f32x4 g0 = acc[ai][0][m][0] * ascale + bg0, g1 = acc[ai][0][m][1] * ascale + bg1, l0 = acc[ai][1][m][0] * ascale + bl0, l1 = acc[ai][1][m][1] * ascale + bl1;
                if constexpr (OUT8) { typedef unsigned u32x2_ __attribute__((ext_vector_type(2))); u32x2_ w;
                    w.x = pk4_fp8(swiglu1(g0[0], l0[0]), swiglu1(g0[1], l0[1]), swiglu1(g0[2], l0[2]), swiglu1(g0[3], l0[3])); w.y = pk4_fp8(swiglu1(g1[0], l1[0]), swiglu1(g1[1], l1[1]), swiglu1(g1[2], l1[2]), swiglu1(g1[3], l1[3]));
                    __builtin_nontemporal_store(w, (u32x2_*)((unsigned char*)O + (size_t)(row0 + ai * HALF + m * 16) * 1024 + 128 * pl + jc)); }
                else { u32x4 w; w.x = cvt_pk_bf16(swiglu1(g0[0], l0[0]), swiglu1(g0[1], l0[1])); w.y = cvt_pk_bf16(swiglu1(g0[2], l0[2]), swiglu1(g0[3], l0[3]));
                    w.z = cvt_pk_bf16(swiglu1(g1[0], l1[0]), swiglu1(g1[1], l1[1])); w.w = cvt_pk_bf16(swiglu1(g1[2], l1[2]), swiglu1(g1[3], l1[3]));
                    __builtin_nontemporal_store(w, (u32x4*)(O + (size_t)(row0 + ai * HALF + m * 16) * 1024 + 128 * pl + jc)); } }
    }
};

struct EpiOutS {
    static constexpr bool PERM = true, PERM2 = true, AFTER_DRAIN = false;
    bf16_t* O; const float* bias; float ascale;
    __device__ __forceinline__ void operator()(const f32x4 (&acc)[2][2][4][2], const Unit& u, int wr, int wc, int fr, int fq) const {
        const int bcol0 = u.pn * BM + wc * 64 + 16 * fq;
        f32x4 bv[2][2];
#pragma unroll
        for (int bj = 0; bj < 2; ++bj)
#pragma unroll
            for (int n = 0; n < 2; ++n) bv[bj][n] = *(const f32x4*)(bias + bcol0 + 8 * bj + 4 * n);
        bf16_t* lp = O + (size_t)(u.pm * BM + wr * 64 + (fr & 7)) * 1024 + (u.pn & 3) * BM + wc * 64 + 16 * fq + 8 * (fr >> 3);
#pragma unroll
        for (int ai = 0; ai < 2; ++ai)
#pragma unroll
            for (int m = 0; m < 4; ++m) { u32x4 w[2];
#pragma unroll
                for (int bj = 0; bj < 2; ++bj) { const f32x4 v0 = acc[ai][bj][m][0] * ascale + bv[bj][0], v1 = acc[ai][bj][m][1] * ascale + bv[bj][1];
                    w[bj].x = cvt_pk_bf16(v0[0], v0[1]); w[bj].y = cvt_pk_bf16(v0[2], v0[3]); w[bj].z = cvt_pk_bf16(v1[0], v1[1]); w[bj].w = cvt_pk_bf16(v1[2], v1[3]); }
                u32x4 d1, d2; xchg8(w[0], w[1], d1, d2);
                bf16_t* rowp = lp + (size_t)(ai * HALF + m * 16) * 1024;
                __builtin_nontemporal_store(d1, (u32x4*)rowp); __builtin_nontemporal_store(d2, (u32x4*)(rowp + 8 * 1024)); }
    }
};

struct GroupedOrder {
    const PG8_LAS int* ts; int NT, G, c; const int* rowtok;
    __device__ __forceinline__ bool next(int i, Unit& u) const {
        const int total = __builtin_amdgcn_readfirstlane(ts[32]) * NT; const long L = (long)i * G + c; if (L >= total) return false;
        const int pm = (int)L / NT, pl = (int)L % NT; int e = 0;
#pragma unroll 1
        for (int j = 1; j < 32; ++j) e += (pm >= ts[j]) ? 1 : 0;
        u.pm = __builtin_amdgcn_readfirstlane(pm); u.pn = __builtin_amdgcn_readfirstlane(e * NT + pl); return true;
    }
    __device__ __forceinline__ void a_ready(const Unit&) const {}
    __device__ __forceinline__ void done(const Unit&) const {}
};
}
#define GAS __attribute__((address_space(1)))
#define LAS __attribute__((address_space(3)))
typedef unsigned short bf16;
typedef unsigned v4u __attribute__((ext_vector_type(4)));
typedef float f32x4 __attribute__((ext_vector_type(4)));
typedef short bf16x8 __attribute__((ext_vector_type(8)));
typedef GAS unsigned gu32;
typedef GAS unsigned long long gu64;
#define RLX_AGENT __ATOMIC_RELAXED, __HIP_MEMORY_SCOPE_AGENT
#define LDS_WAIT() asm volatile("s_waitcnt lgkmcnt(0)" ::: "memory")
#define VM_WAIT() asm volatile("s_waitcnt vmcnt(0)" ::: "memory")
__device__ __forceinline__ unsigned long long rt() { return __builtin_amdgcn_s_memrealtime(); }
__device__ __forceinline__ unsigned f2bf(float f) { unsigned u = __builtin_bit_cast(unsigned, f); return (u + 0x7fffu + ((u >> 16) & 1u)) >> 16; }
typedef float f32x2_pk __attribute__((ext_vector_type(2))); typedef __bf16 bf16x2_pk __attribute__((ext_vector_type(2)));
__device__ __forceinline__ unsigned pk2(float lo, float hi) { const f32x2_pk v = {lo, hi}; return __builtin_bit_cast(unsigned, __builtin_convertvector(v, bf16x2_pk)); }

#define XB_TMO      128
#define XB_XCNT(j)  (256  + 64 * (j))
#define XB_XSUB(j)  (1280 + 64 * (j))
#define XB_XGEN(j)  (2304 + 64 * (j))
#define XB_TOP      3328
#define XB_TOPGEN   3392
#define XCD_BAR_WORDS 3456
#define XB_SPIN_CAP (1u << 18)

__device__ __forceinline__ unsigned xb_ld(unsigned* p)              { return __hip_atomic_load(p, __ATOMIC_RELAXED, __HIP_MEMORY_SCOPE_AGENT); }
__device__ __forceinline__ unsigned xb_add(unsigned* p, unsigned v) { return __hip_atomic_fetch_add(p, v, __ATOMIC_RELAXED, __HIP_MEMORY_SCOPE_AGENT); }
__device__ __forceinline__ unsigned xb_xcc_id() { return (unsigned)__builtin_amdgcn_s_getreg((3 << 11) | 20) & 0xFu; }
#define XB_SPIN(cond, bar) do { unsigned _sp = 0; while (cond) { __builtin_amdgcn_s_sleep(1); \
    if ((++_sp & 255u) == 0u) { if (xb_ld(&(bar)[XB_TMO])) break; if (_sp > XB_SPIN_CAP) { atomicAdd(&(bar)[XB_TMO], 1u); break; } } } } while (0)

struct XcdBarrier {
    unsigned* bar; unsigned x;
    volatile LAS unsigned* st;
};

__device__ __forceinline__ XcdBarrier xcd_barrier_post(unsigned* bar, volatile LAS unsigned* st) {
    XcdBarrier b; b.bar = bar; b.x = xb_xcc_id(); b.st = st;
    if (threadIdx.x == 0) (void)xb_add(&bar[XB_XCNT(b.x)], 1u);
    return b;
}
__device__ __forceinline__ void xcd_barrier_complete(unsigned* bar, unsigned x, unsigned& nloc, unsigned& nx) {
    const unsigned G = gridDim.x * gridDim.y * gridDim.z;
    unsigned sum, cnt, mine, sp = 0u;
    for (;;) {
        sum = 0u; cnt = 0u; mine = 0u;
#pragma unroll
        for (unsigned j = 0; j < 16; ++j) { const unsigned c = xb_ld(&bar[XB_XCNT(j)]); sum += c; cnt += (c > 0u) ? 1u : 0u; mine = (j == x) ? c : mine; }
        if (sum == G) break;
        __builtin_amdgcn_s_sleep(1);
        if ((++sp & 255u) == 0u) { if (xb_ld(&bar[XB_TMO])) break; if (sp > XB_SPIN_CAP) { atomicAdd(&bar[XB_TMO], 1u); break; } }
    }
    nloc = mine > 0u ? mine : 1u; nx = cnt > 0u ? cnt : 1u;
}

__device__ __forceinline__ void xcd_barrier(const XcdBarrier& b) {
    asm volatile("s_waitcnt vmcnt(0)" ::: "memory");
    __syncthreads();
    if (threadIdx.x == 0) {
        unsigned* bar = b.bar;
        __builtin_amdgcn_s_waitcnt(0);
        unsigned nloc = b.st[0], nx = b.st[1];
        if (nloc == 0u) { xcd_barrier_complete(bar, b.x, nloc, nx); b.st[0] = nloc; b.st[1] = nx; }
        const unsigned old = xb_add(&bar[XB_XSUB(b.x)], 1u);
        const unsigned gen = old / nloc;
        if (old + 1u == (gen + 1u) * nloc) {
            __builtin_amdgcn_fence(__ATOMIC_RELEASE, "agent");
            asm volatile("s_waitcnt vmcnt(0)" ::: "memory");
            const unsigned og = xb_add(&bar[XB_TOP], 1u);
            const unsigned tg = og / nx;
            if (og + 1u == (tg + 1u) * nx) xb_add(&bar[XB_TOPGEN], 1u);
            else XB_SPIN(xb_ld(&bar[XB_TOPGEN]) == tg, bar);
            __builtin_amdgcn_fence(__ATOMIC_ACQUIRE, "agent");
            xb_add(&bar[XB_XGEN(b.x)], 1u);
            asm volatile("s_waitcnt vmcnt(0)" ::: "memory");
        } else {
            XB_SPIN(xb_ld(&bar[XB_XGEN(b.x)]) == gen, bar);
            __builtin_amdgcn_fence(__ATOMIC_ACQUIRE, "agent");
            asm volatile("s_waitcnt vmcnt(0)" ::: "memory");
        }
    }
    __syncthreads();
}

constexpr int NWAVES = 8;
constexpr int BATCH = 16, SEQ = 2048, D = 1024, T = BATCH * SEQ;
constexpr int NIN = 9224, NPROJ = 9216, NMOD = 6 * D;
constexpr int NE = 32, TOPK = 4;
constexpr int XS_ROWS = T * TOPK + NE * 256;
constexpr float EPS = 1e-6f;
constexpr float ATT_RTHR = -120.0f;
constexpr float W8SCALE = 64.0f;
constexpr float QSCALE = 0.125f * 1.4426950408889634f;

constexpr size_t MiB = 1u << 20;
constexpr size_t WS_CTL = 0, CTL_ZERO_BYTES = 1 * MiB;
constexpr size_t WS_MODP = 1 * MiB;
constexpr size_t WS_MOD = 3 * MiB;
constexpr size_t WS_IPRE = 4 * MiB, WS_LF = 4 * MiB + 512 * 1024;
constexpr size_t WS_TOKE = 5 * MiB, WS_TOKP = 5 * MiB + 512 * 1024, WS_TOKW = 6 * MiB, WS_TOKROW = 6 * MiB + 512 * 1024, WS_RSTD = 7 * MiB;
constexpr size_t WS_WIN = 8 * MiB, WS_WA = 26 * MiB, WS_WB = 28 * MiB, WS_WOUT = 30 * MiB, WS_W1 = 32 * MiB, WS_W2 = 160 * MiB;
constexpr size_t WS_H1 = 224 * MiB;
constexpr size_t WS_PROJ = 288 * MiB, SEG = 64 * MiB;
constexpr size_t WS_YB = 864 * MiB;
constexpr size_t WS_XS = 288 * MiB, WS_ACT = 560 * MiB;
constexpr size_t WS_ROW2TOK = 7 * MiB + 128 * 1024;
constexpr size_t WS_GT = 928 * MiB;
constexpr size_t WS_END = 932 * MiB;
static_assert(WS_XS + (size_t)XS_ROWS * 2048 <= WS_ACT && WS_ACT + (size_t)XS_ROWS * 2048 <= WS_YB, "ws map");
constexpr int CW_TMO = 0, CW_BAR = 4096, CW_ECNT = 8192;

constexpr int RING_BYTES = 131072, LDS_BYTES = 147456, LDSCTL_OFF = 146432;
constexpr int LC_BAR = 0, LC_TS = 16, LC_LCNT = 64, LC_GBASE = 96, LC_PS = 128, LC_CNT = 160;

__device__ __forceinline__ unsigned long long karg(int i) { return ((const __attribute__((address_space(4))) unsigned long long*)__builtin_amdgcn_kernarg_segment_ptr())[i]; }
struct Frame {
    LAS unsigned char* lds; volatile LAS unsigned* LC;
    gu32* ctl; unsigned char* ws; int tid, lane, wave, vcu, G;
    __device__ __forceinline__ const float* x() const { return (const float*)(const GAS float*)karg(0); }
    __device__ __forceinline__ const float* c() const { return (const float*)(const GAS float*)karg(1); }
    __device__ __forceinline__ const float* ada_w() const { return (const float*)(const GAS float*)karg(2); }
    __device__ __forceinline__ const float* ada_b() const { return (const float*)(const GAS float*)karg(3); }
    __device__ __forceinline__ const float* norm1_g() const { return (const float*)(const GAS float*)karg(4); }
    __device__ __forceinline__ const float* w_in() const { return (const float*)(const GAS float*)karg(5); }
    __device__ __forceinline__ const float* conv_w() const { return (const float*)(const GAS float*)karg(6); }
    __device__ __forceinline__ const float* conv_b() const { return (const float*)(const GAS float*)karg(7); }
    __device__ __forceinline__ const float* b_i() const { return (const float*)(const GAS float*)karg(8); }
    __device__ __forceinline__ const float* b_f() const { return (const float*)(const GAS float*)karg(9); }
    __device__ __forceinline__ const float* ml_norm_g() const { return (const float*)(const GAS float*)karg(10); }
    __device__ __forceinline__ const float* w_a() const { return (const float*)(const GAS float*)karg(11); }
    __device__ __forceinline__ const float* w_b() const { return (const float*)(const GAS float*)karg(12); }
    __device__ __forceinline__ const float* w_out() const { return (const float*)(const GAS float*)karg(13); }
    __device__ __forceinline__ const float* norm2_g() const { return (const float*)(const GAS float*)karg(14); }
    __device__ __forceinline__ const float* router_w() const { return (const float*)(const GAS float*)karg(15); }
    __device__ __forceinline__ const float* router_b() const { return (const float*)(const GAS float*)karg(16); }
    __device__ __forceinline__ const float* w1() const { return (const float*)(const GAS float*)karg(17); }
    __device__ __forceinline__ const float* b1() const { return (const float*)(const GAS float*)karg(18); }
    __device__ __forceinline__ const float* w2() const { return (const float*)(const GAS float*)karg(19); }
    __device__ __forceinline__ const float* b2() const { return (const float*)(const GAS float*)karg(20); }
    __device__ __forceinline__ const float* final_g() const { return (const float*)(const GAS float*)karg(21); }
    __device__ __forceinline__ float* out() const { return (float*)(GAS float*)karg(22); }
    __device__ __forceinline__ float* modp() const { return (float*)(ws + WS_MODP); }
    __device__ __forceinline__ float* mod() const { return (float*)(ws + WS_MOD); }
    __device__ __forceinline__ float* ipre() const { return (float*)(ws + WS_IPRE); }
    __device__ __forceinline__ float* lf() const { return (float*)(ws + WS_LF); }
    __device__ __forceinline__ float* tokw() const { return (float*)(ws + WS_TOKW); }
    __device__ __forceinline__ float* rstd2() const { return (float*)(ws + WS_RSTD); }
    __device__ __forceinline__ int* toke() const { return (int*)(ws + WS_TOKE); }
    __device__ __forceinline__ int* tokp() const { return (int*)(ws + WS_TOKP); }
    __device__ __forceinline__ int* tokrow() const { return (int*)(ws + WS_TOKROW); }
    __device__ __forceinline__ bf16* WIN_T() const { return (bf16*)(ws + WS_WIN); }
    __device__ __forceinline__ bf16* WA_T() const { return (bf16*)(ws + WS_WA); }
    __device__ __forceinline__ bf16* WB_T() const { return (bf16*)(ws + WS_WB); }
    __device__ __forceinline__ bf16* WOUT_T() const { return (bf16*)(ws + WS_WOUT); }
    __device__ __forceinline__ bf16* W1_T() const { return (bf16*)(ws + WS_W1); }
    __device__ __forceinline__ bf16* W2_T() const { return (bf16*)(ws + WS_W2); }
    __device__ __forceinline__ bf16* H1() const { return (bf16*)(ws + WS_H1); }
    __device__ __forceinline__ bf16* PROJ() const { return (bf16*)(ws + WS_PROJ); }
    __device__ __forceinline__ bf16* YA() const { return (bf16*)(ws + WS_H1); }
    __device__ __forceinline__ bf16* YB() const { return (bf16*)(ws + WS_YB); }
    __device__ __forceinline__ bf16* YB8() const { return (bf16*)(ws + WS_H1 + 32 * MiB); }
    __device__ __forceinline__ bf16* M1() const { return (bf16*)(ws + WS_PROJ); }
    __device__ __forceinline__ bf16* MERGED() const { return (bf16*)(ws + WS_PROJ + SEG); }
    __device__ __forceinline__ bf16* XS() const { return (bf16*)(ws + WS_XS); }
    __device__ __forceinline__ bf16* ACT() const { return (bf16*)(ws + WS_ACT); }
    __device__ __forceinline__ bf16* OUTR() const { return (bf16*)(ws + WS_XS); }
    __device__ __forceinline__ bf16* H2() const { return (bf16*)(ws + WS_XS); }
    __device__ __forceinline__ int* row2tok() const { return (int*)(ws + WS_ROW2TOK); }
    __device__ __forceinline__ float* gt() const { return (float*)(ws + WS_GT); }
};

__device__ __forceinline__ int opq(int v) { asm volatile("" : "+v"(v)); return v; }
__device__ __forceinline__ float wave_sum(float v) {
#pragma unroll
    for (int o = 1; o < 64; o <<= 1) v += __shfl_xor(v, o);
    return v;
}
__device__ __forceinline__ float bf2f(unsigned short b) { return __builtin_bit_cast(float, (unsigned)b << 16); }
__device__ __forceinline__ float bflo(unsigned w) { return __builtin_bit_cast(float, w << 16); }
__device__ __forceinline__ float bfhi(unsigned w) { return __builtin_bit_cast(float, w & 0xffff0000u); }
__device__ __forceinline__ float log_sigmoid_f(float x) { return fminf(x, 0.f) - log1pf(expf(-fabsf(x))); }

struct MapIn { __device__ __forceinline__ long operator()(int n) const { return n < 7168 ? (long)n : (n < 7176 ? -1L : (n < NIN ? (long)(n - 8) : -1L)); } };
struct MapId { long off; __device__ __forceinline__ long operator()(int n) const { return off + n; } };
struct MapW1 { int e; __device__ __forceinline__ long operator()(int n) const { return (long)e * 2048 + ((n & 1023) >> 7) * 256 + (n >> 10) * 128 + (n & 127); } };

template <class Map> __device__ __forceinline__ void transpose_item(const float* W, int K, int N, bf16* WT, LAS float* scr, int item, int lane, Map map, float scale8) {
    const int nblk = (N + 31) / 32, kb = item / nblk, nb = item % nblk, k0 = 128 * kb, n0 = 32 * nb;
    const int n4 = 4 * (lane & 7), kr = lane >> 3;
    const bool ok = (n0 + n4 + 3) < N;
    f32x4 v[16];
#pragma unroll
    for (int i = 0; i < 16; ++i) v[i] = ok ? *(const f32x4*)(W + (size_t)(k0 + 8 * i + kr) * N + n0 + n4) : (f32x4){0.f, 0.f, 0.f, 0.f};
#pragma unroll
    for (int i = 0; i < 16; ++i) { LAS float* d = scr + (8 * i + kr) * 33 + n4; d[0] = v[i].x; d[1] = v[i].y; d[2] = v[i].z; d[3] = v[i].w; }
    LDS_WAIT(); asm volatile("" ::: "memory");
    const int c = lane & 7;
#pragma unroll
    for (int j = 0; j < 4; ++j) { const int n = (lane >> 3) + 8 * j; const LAS float* s = scr + (16 * c) * 33 + n;
        const long dr = map(n0 + n); v4u o;
        o.x = pg8::pk4_fp8(s[0 * 33] * scale8, s[1 * 33] * scale8, s[2 * 33] * scale8, s[3 * 33] * scale8);     o.y = pg8::pk4_fp8(s[4 * 33] * scale8, s[5 * 33] * scale8, s[6 * 33] * scale8, s[7 * 33] * scale8);
        o.z = pg8::pk4_fp8(s[8 * 33] * scale8, s[9 * 33] * scale8, s[10 * 33] * scale8, s[11 * 33] * scale8);   o.w = pg8::pk4_fp8(s[12 * 33] * scale8, s[13 * 33] * scale8, s[14 * 33] * scale8, s[15 * 33] * scale8);
        if (dr >= 0) *(GAS v4u*)((unsigned char*)WT + (size_t)dr * K + k0 + 16 * c) = o; }
    LDS_WAIT(); asm volatile("" ::: "memory");
}
__device__ __forceinline__ void mod_item(Frame& F, const LAS float* sil, int it) {
    const int j = it % 96, kq = it / 96, n = 64 * j + F.lane, k0 = 256 * kq;
    float acc[16];
#pragma unroll
    for (int b = 0; b < 16; ++b) acc[b] = 0.f;
    const float* w = F.ada_w() + (size_t)k0 * NMOD + n;
    const LAS f32x4* s = (const LAS f32x4*)sil + k0 * 4;
    for (int kk = 0; kk < 256; kk += 8) {
        float wv[8];
#pragma unroll
        for (int u = 0; u < 8; ++u) wv[u] = w[(size_t)(kk + u) * NMOD];
#pragma unroll
        for (int u = 0; u < 8; ++u) {
#pragma unroll
            for (int q = 0; q < 4; ++q) { const f32x4 sv = s[(kk + u) * 4 + q]; acc[4 * q + 0] += sv.x * wv[u]; acc[4 * q + 1] += sv.y * wv[u]; acc[4 * q + 2] += sv.z * wv[u]; acc[4 * q + 3] += sv.w * wv[u]; }
        }
    }
    float* o = F.modp() + (size_t)kq * 16 * NMOD + n;
#pragma unroll
    for (int b = 0; b < 16; ++b) o[(size_t)b * NMOD] = acc[b];
}
__device__ __forceinline__ void p0_prologue(Frame& F) {
    LAS float* sil = (LAS float*)F.lds;
    for (int idx = F.tid; idx < 16384; idx += 512) { const int b = idx >> 10, k = idx & 1023; const float v = F.c()[idx]; sil[k * 16 + b] = v / (1.0f + __expf(-v)); }
    __syncthreads();
    const int gw = F.vcu * NWAVES + F.wave, NGW = F.G * NWAVES;
    constexpr int I_MOD = 384, I_IN = 8 * 289, I_SQ = 8 * 32, I_W1 = 32 * 8 * 64, I_W2 = 32 * 8 * 32;
    constexpr int NITEMS = I_IN + 3 * I_SQ + I_W1 + I_W2;
    if (gw < I_MOD) mod_item(F, sil, gw);
    __syncthreads();
    LAS float* scr = (LAS float*)(F.lds + F.wave * 16896);
    const int ow = (gw + NGW - I_MOD) % NGW;
    for (int it = ow; it < NITEMS; it += NGW) {
        int r = it;
        if (r < I_IN) { transpose_item(F.w_in(), D, NIN, F.WIN_T(), scr, r, F.lane, MapIn{}, W8SCALE); continue; } r -= I_IN;
        if (r < I_SQ) { transpose_item(F.w_a(), D, D, F.WA_T(), scr, r, F.lane, MapId{0}, W8SCALE); continue; } r -= I_SQ;
        if (r < I_SQ) { transpose_item(F.w_b(), D, D, F.WB_T(), scr, r, F.lane, MapId{0}, W8SCALE); continue; } r -= I_SQ;
        if (r < I_SQ) { transpose_item(F.w_out(), D, D, F.WOUT_T(), scr, r, F.lane, MapId{0}, W8SCALE); continue; } r -= I_SQ;
        if (r < I_W1) { const int e = r >> 9; transpose_item(F.w1() + (size_t)e * D * 2048, D, 2048, F.W1_T(), scr, r & 511, F.lane, MapW1{e}, W8SCALE); continue; } r -= I_W1;
        { const int e = r >> 8; transpose_item(F.w2() + (size_t)e * D * D, D, D, F.W2_T(), scr, r & 255, F.lane, MapId{(long)e * 1024}, W8SCALE); }
    }
}

__device__ __forceinline__ void p1_rows(Frame& F) {
    const int row0 = F.vcu * 128, b = row0 / SEQ, lane = opq(F.lane);
    LAS float* wif = (LAS float*)F.lds;
    for (int idx = F.tid; idx < 8192; idx += 512) wif[idx] = F.w_in()[(size_t)(idx >> 3) * NIN + 7168 + (idx & 7)];
    for (int idx = F.vcu * 512 + F.tid; idx < 16 * NMOD; idx += F.G * 512) { float s = F.ada_b()[idx % NMOD];
#pragma unroll
        for (int kq = 0; kq < 4; ++kq) s += F.modp()[(size_t)kq * 16 * NMOD + idx];
        F.mod()[idx] = s; }
    f32x4 Av[4], Bv[4];
#pragma unroll
    for (int j = 0; j < 4; ++j) { const int col = 4 * lane + 256 * j;
        f32x4 sh = *(const f32x4*)(F.ada_b() + col), sc = *(const f32x4*)(F.ada_b() + D + col);
#pragma unroll
        for (int kq = 0; kq < 4; ++kq) { sh += *(const f32x4*)(F.modp() + ((size_t)kq * 16 + b) * NMOD + col); sc += *(const f32x4*)(F.modp() + ((size_t)kq * 16 + b) * NMOD + D + col); }
        const f32x4 g = *(const f32x4*)(F.norm1_g() + col); Av[j] = g * (sc + 1.0f); Bv[j] = sh; }
    __syncthreads();
    f32x4 nx[4];
    { const GAS f32x4* xr = (const GAS f32x4*)(F.x() + (size_t)(row0 + 16 * F.wave) * D) + lane;
#pragma unroll
      for (int j = 0; j < 4; ++j) nx[j] = xr[64 * j]; }
    for (int r = 0; r < 16; ++r) {
        const int row = row0 + 16 * F.wave + r;
        f32x4 v[4]; float ss = 0.f;
#pragma unroll
        for (int j = 0; j < 4; ++j) { v[j] = nx[j]; ss += (v[j].x * v[j].x + v[j].y * v[j].y) + (v[j].z * v[j].z + v[j].w * v[j].w); }
        if (r < 15) { const GAS f32x4* xr = (const GAS f32x4*)(F.x() + (size_t)(row + 1) * D) + lane;
#pragma unroll
            for (int j = 0; j < 4; ++j) nx[j] = xr[64 * j]; }
        const float rstd = 1.0f / sqrtf(wave_sum(ss) * (1.0f / D) + EPS);
        GAS unsigned* o4 = (GAS unsigned*)((unsigned char*)F.H1() + (size_t)row * D) + lane;
        float p[8];
#pragma unroll
        for (int q = 0; q < 8; ++q) p[q] = 0.f;
#pragma unroll
        for (int j = 0; j < 4; ++j) { v[j] = v[j] * rstd * Av[j] + Bv[j];
            o4[64 * j] = pg8::pk4_fp8(v[j].x, v[j].y, v[j].z, v[j].w);
#pragma unroll
            for (int i = 0; i < 4; ++i) { const LAS f32x4* wp = (const LAS f32x4*)(wif + (4 * lane + 256 * j + i) * 8); const f32x4 w0 = wp[0], w1 = wp[1]; const float hv = v[j][i];
                p[0] += hv * w0.x; p[1] += hv * w0.y; p[2] += hv * w0.z; p[3] += hv * w0.w; p[4] += hv * w1.x; p[5] += hv * w1.y; p[6] += hv * w1.z; p[7] += hv * w1.w; } }
#pragma unroll
        for (int q = 0; q < 8; ++q) p[q] = wave_sum(p[q]);
        if (lane == 0) { const int t = row % SEQ;
#pragma unroll
            for (int hh = 0; hh < 4; ++hh) { F.ipre()[((size_t)b * 4 + hh) * SEQ + t] = p[hh] + F.b_i()[hh]; F.lf()[((size_t)b * 4 + hh) * SEQ + t] = log_sigmoid_f(p[4 + hh] + F.b_f()[hh]); } }
    }
}

__device__ __forceinline__ void attn_naive_item(Frame& F, int bh, int qblk) {
    const int b = bh >> 4, hd = bh & 15, t = qblk * 512 + F.tid;
    const bf16* Q = F.PROJ(); const bf16* K = F.PROJ() + SEG / 2; const bf16* V = F.PROJ() + SEG;
    const size_t rowb = (size_t)b * SEQ;
    float q[64], o[64];
    { const v4u* qp = (const v4u*)(Q + (rowb + t) * D + hd * 64);
#pragma unroll
      for (int i = 0; i < 8; ++i) { const v4u w = qp[i]; q[8 * i + 0] = bflo(w.x); q[8 * i + 1] = bfhi(w.x); q[8 * i + 2] = bflo(w.y); q[8 * i + 3] = bfhi(w.y); q[8 * i + 4] = bflo(w.z); q[8 * i + 5] = bfhi(w.z); q[8 * i + 6] = bflo(w.w); q[8 * i + 7] = bfhi(w.w); } }
#pragma unroll
    for (int i = 0; i < 64; ++i) o[i] = 0.f;
    float R = 0.f;
    LAS v4u* kt = (LAS v4u*)F.lds; LAS v4u* vt = (LAS v4u*)(F.lds + 8192);
    const int tmax_wave = qblk * 512 + F.wave * 64 + 63;
    bool wdone = false;
    LAS volatile int* dflag = (LAS volatile int*)(F.lds + 16384);
    if (F.tid < 8) dflag[F.tid] = 0;
    for (int tile = qblk * 8 + 7; tile >= 0; --tile) {
        __syncthreads();
        { int nd = 0;
#pragma unroll
          for (int w = 0; w < 8; ++w) nd += dflag[w];
          if (nd == 8) break; }
        { const int kr = F.tid >> 3, ch = F.tid & 7; const size_t g = (rowb + tile * 64 + kr) * D + hd * 64 + ch * 8;
          kt[F.tid] = *(const v4u*)(K + g); vt[F.tid] = *(const v4u*)(V + g); }
        __syncthreads();
        if (tile * 64 >= tmax_wave) continue;
        if (wdone) continue;
        for (int s = 63; s >= 0; --s) {
            const int key = tile * 64 + s;
            float z = 0.f;
#pragma unroll
            for (int i = 0; i < 8; ++i) { const v4u w = kt[s * 8 + i]; z += q[8 * i + 0] * bflo(w.x) + q[8 * i + 1] * bfhi(w.x) + q[8 * i + 2] * bflo(w.y) + q[8 * i + 3] * bfhi(w.y) + q[8 * i + 4] * bflo(w.z) + q[8 * i + 5] * bfhi(w.z) + q[8 * i + 6] * bflo(w.w) + q[8 * i + 7] * bfhi(w.w); }
            const float lb = fminf(z, 0.f) - __builtin_amdgcn_logf(1.0f + __builtin_amdgcn_exp2f(-fabsf(z)));
            const bool act = key < t;
            const float a = act ? __builtin_amdgcn_exp2f(lb + R) : 0.f;
            R += act ? (lb - z) : 0.f;
#pragma unroll
            for (int i = 0; i < 8; ++i) { const v4u w = vt[s * 8 + i]; o[8 * i + 0] += a * bflo(w.x); o[8 * i + 1] += a * bfhi(w.x); o[8 * i + 2] += a * bflo(w.y); o[8 * i + 3] += a * bfhi(w.y); o[8 * i + 4] += a * bflo(w.z); o[8 * i + 5] += a * bfhi(w.z); o[8 * i + 6] += a * bflo(w.w); o[8 * i + 7] += a * bfhi(w.w); }
        }
        if (__all(R < ATT_RTHR) && !wdone) { wdone = true; if (F.lane == 0) dflag[F.wave] = 1; }
    }
    __syncthreads();
    v4u* op = (v4u*)(F.YA() + (rowb + t) * D + hd * 64);
#pragma unroll
    for (int i = 0; i < 8; ++i) { v4u w; w.x = pk2(o[8 * i + 0], o[8 * i + 1]); w.y = pk2(o[8 * i + 2], o[8 * i + 3]); w.z = pk2(o[8 * i + 4], o[8 * i + 5]); w.w = pk2(o[8 * i + 6], o[8 * i + 7]); op[i] = w; }
}

__device__ __forceinline__ void mlstm_naive_item(Frame& F, int bh) {
    const int b = bh >> 2, hh = bh & 3, tid = opq(F.tid), e = tid & 255, half = tid >> 8;
    const bf16* MLQ = F.PROJ() + 3 * (SEG / 2); const bf16* MLK = F.PROJ() + 4 * (SEG / 2); const bf16* MLV = F.PROJ() + 5 * (SEG / 2); const bf16* MLO = F.PROJ() + 6 * (SEG / 2);
    LAS float* ql = (LAS float*)F.lds; LAS float* kl = ql + 8192; LAS float* vl = kl + 8192; LAS float* hl = vl + 8192;
    LAS float* part = hl + 8192;
    LAS float* red = part + 512;
    LAS float* il = red + 8; LAS float* fl = il + 32;
    const size_t rowb = (size_t)b * SEQ;
    float C[128];
#pragma unroll
    for (int i = 0; i < 128; ++i) C[i] = 0.f;
    float nreg = 0.f, m = 0.f;
    float cw[2][4], cb[2];
    { const int c = tid & 255;
#pragma unroll
      for (int z = 0; z < 2; ++z) { const int ch = z * 1024 + hh * 256 + c; cb[z] = F.conv_b()[ch];
#pragma unroll
          for (int tap = 0; tap < 4; ++tap) cw[z][tap] = F.conv_w()[tap * 2048 + ch]; } }
    for (int chunk = 0; chunk < SEQ / 32; ++chunk) {
        const int t0 = chunk * 32;
        __syncthreads();
        { const int c = tid & 255;
          for (int u = 0; u < 16; ++u) { const int tt = (tid >> 8) + 2 * u, t = t0 + tt; float yq = cb[0], yk = cb[1];
#pragma unroll
              for (int tap = 0; tap < 4; ++tap) { const int ts = t - 3 + tap; if (ts >= 0) { const size_t g = (rowb + ts) * D + hh * 256 + c; yq += cw[0][tap] * bf2f(MLQ[g]); yk += cw[1][tap] * bf2f(MLK[g]); } }
              ql[tt * 256 + c] = yq / (1.0f + __expf(-yq)); kl[tt * 256 + c] = (yk / (1.0f + __expf(-yk))) * 0.0625f;
              vl[tt * 256 + c] = bf2f(MLV[(rowb + t) * D + hh * 256 + c]); }
          if (tid < 32) { il[tid] = F.ipre()[((size_t)b * 4 + hh) * SEQ + t0 + tid]; fl[tid] = F.lf()[((size_t)b * 4 + hh) * SEQ + t0 + tid]; } }
        __syncthreads();
        for (int tt = 0; tt < 32; ++tt) {
            const float lfv = fl[tt], iv = il[tt];
            const float mn = fmaxf(lfv + m, iv), fp = __expf(lfv + m - mn), ip = __expf(iv - mn); m = mn;
            const float vv = vl[tt * 256 + e] * ip;
            const LAS f32x4* kq = (const LAS f32x4*)(kl + tt * 256 + 128 * half); const LAS f32x4* qq = (const LAS f32x4*)(ql + tt * 256 + 128 * half);
            float num = 0.f;
#pragma unroll
            for (int i = 0; i < 32; ++i) { const f32x4 kv = kq[i], qv = qq[i];
                C[4 * i + 0] = fp * C[4 * i + 0] + kv.x * vv; C[4 * i + 1] = fp * C[4 * i + 1] + kv.y * vv; C[4 * i + 2] = fp * C[4 * i + 2] + kv.z * vv; C[4 * i + 3] = fp * C[4 * i + 3] + kv.w * vv;
                num += (qv.x * C[4 * i + 0] + qv.y * C[4 * i + 1]) + (qv.z * C[4 * i + 2] + qv.w * C[4 * i + 3]); }
            const int buf = tt & 1;
            if (tid < 256) { nreg = fp * nreg + ip * kl[tt * 256 + tid]; const float pd = wave_sum(ql[tt * 256 + tid] * nreg); if (F.lane == 0) red[buf * 4 + F.wave] = pd; }
            else part[buf * 256 + e] = num;
            __syncthreads();
            if (tid < 256) { num += part[buf * 256 + e]; const float den = (red[buf * 4 + 0] + red[buf * 4 + 1]) + (red[buf * 4 + 2] + red[buf * 4 + 3]);
                hl[tt * 256 + e] = num / fmaxf(fabsf(den), __expf(-m)); }
        }
        __syncthreads();
        for (int r = 0; r < 4; ++r) { const int tt = 4 * F.wave + r; const size_t row = rowb + t0 + tt;
            const f32x4 hv = *(const LAS f32x4*)(hl + tt * 256 + 4 * F.lane);
            const float ss = wave_sum((hv.x * hv.x + hv.y * hv.y) + (hv.z * hv.z + hv.w * hv.w));
            const float rstd = 1.0f / sqrtf(ss * (1.0f / 256.0f) + EPS);
            const int col = hh * 256 + 4 * F.lane; const f32x4 g = *(const f32x4*)(F.ml_norm_g() + col);
            const unsigned long long ow = *(const unsigned long long*)(MLO + row * D + col);
            const float o0 = bflo((unsigned)ow), o1 = bfhi((unsigned)ow), o2 = bflo((unsigned)(ow >> 32)), o3 = bfhi((unsigned)(ow >> 32));
            const float y0 = hv.x * rstd * g.x / (1.0f + __expf(-o0)), y1 = hv.y * rstd * g.y / (1.0f + __expf(-o1)), y2 = hv.z * rstd * g.z / (1.0f + __expf(-o2)), y3 = hv.w * rstd * g.w / (1.0f + __expf(-o3));
            *(unsigned long long*)(F.YB() + row * D + col) = (unsigned long long)pk2(y0, y1) | ((unsigned long long)pk2(y2, y3) << 32); }
    }
}


namespace ml {
typedef short bf16x8 __attribute__((ext_vector_type(8)));
typedef short s16x4 __attribute__((ext_vector_type(4)));
typedef float f32x16 __attribute__((ext_vector_type(16)));
typedef LAS const char* lcp;
typedef LAS char* lp_t;
constexpr int L = 64;
constexpr int O_QI = 0, O_KI = 33792, O_CB = 67584, O_VI = 102400, O_VW = 111616, O_PI = 120832, O_F = 130048;
constexpr int F_NV = 0, F_QNP = 256, F_RSP = 768, F_AT = 896, F_US = 960, F_WIN = 1024, F_EDEN = 1088, F_WST = 1152, F_RDEN = 1216, F_CW = 1280, F_CBIAS = 3328;
__device__ __forceinline__ int crow(int r, int hi) { return (r & 3) + 8 * (r >> 2) + 4 * hi; }
template <int PITCH, int XM> __device__ __forceinline__ int ioff(int row, int ch) { return XM ? PITCH * row + 16 * (ch ^ (row & XM)) : PITCH * row + 16 * ch; }
template <int PITCH, int XM> __device__ __forceinline__ bf16x8 frag_row(lcp img, int row0, int s, int lane) {
    return *(LAS const bf16x8*)(img + ioff<PITCH, XM>(row0 + (lane & 31), 2 * s + (lane >> 5)));
}
template <int PITCH, int XM> __device__ __forceinline__ bf16x8 frag_tr(lcp img, int k0, int ks, int col0, int lane) {
    const int h = lane >> 5, blk = (lane >> 4) & 1, q = (lane & 15) >> 2, p = lane & 3;
    const int r0 = k0 + 16 * ks + 8 * h + q, ch = (col0 >> 3) + 2 * blk + (p >> 1);
    typedef short v4i16_t __attribute__((ext_vector_type(4)));
    const s16x4 a = __builtin_bit_cast(s16x4, __builtin_amdgcn_ds_read_tr16_b64_v4i16((LAS v4i16_t*)(img + ioff<PITCH, XM>(r0, ch) + 8 * (p & 1))));
    const s16x4 b = __builtin_bit_cast(s16x4, __builtin_amdgcn_ds_read_tr16_b64_v4i16((LAS v4i16_t*)(img + ioff<PITCH, XM>(r0 + 4, ch) + 8 * (p & 1))));
    return (bf16x8){a[0], a[1], a[2], a[3], b[0], b[1], b[2], b[3]};
}
__device__ __forceinline__ float half_sum(float v) {
    const auto rr = __builtin_amdgcn_permlane32_swap(__builtin_bit_cast(unsigned, v), __builtin_bit_cast(unsigned, v), false, false);
    return __builtin_bit_cast(float, rr[0]) + __builtin_bit_cast(float, rr[1]);
}
__device__ __forceinline__ float silu_f(float y) { return y * __builtin_amdgcn_rcpf(1.0f + __expf(-y)); }

__device__ __forceinline__ void mlstm_unit(Frame& F, int unit) {
    const int bh = unit >> 2, sl = unit & 3, b = bh >> 2, hh = bh & 3, tid = opq(F.tid), lane = opq(F.lane), wave = F.wave, hi = lane >> 5, l31 = lane & 31;
    const bf16* MLQ = (const bf16*)F.out(); const bf16* MLK = MLQ + (size_t)T * D; const bf16* MLV = F.PROJ() + 5 * (SEG / 2);
    lp_t base = (lp_t)F.lds;
    LAS float* Fa = (LAS float*)(base + O_F);
    const size_t rowb = (size_t)b * SEQ;
    const float LOG2E = 1.4426950408889634f;
    __syncthreads();
    for (int i = tid; i < 34816 / 16; i += 512) ((LAS v4u*)(base + O_CB))[i] = (v4u){0u, 0u, 0u, 0u};
    if (tid < 256) Fa[F_NV + tid] = 0.f;
    f32x16 C0, C1, C2;
#pragma unroll
    for (int r = 0; r < 16; ++r) { C0[r] = 0.f; C1[r] = 0.f; C2[r] = 0.f; }
    if (tid < 64) *(LAS v4u*)(base + O_VW + 144 * tid + 128) = (v4u){0u, 0u, 0u, 0u};
    const int cg = tid & 31, rb = tid >> 5;
    v4u rawq[2][4], rawk[2][4], rawv[2]; float g_bb[2], g_us[2], g_pm[2]; float m_prev = 0.f;
#define ML_PREFETCH(T0, P) do { const int t0_ = (T0); \
        _Pragma("unroll") for (int i = 0; i < 4; ++i) { const unsigned g_ = (unsigned)(((int)rowb + t0_ + 4 * rb + i) * D + hh * 256 + cg * 8); \
            rawq[P][i] = *(const v4u*)(MLQ + g_); rawk[P][i] = *(const v4u*)(MLK + g_); } \
        rawv[P] = *(const v4u*)(MLV + (unsigned)(((int)rowb + t0_ + (tid >> 3)) * D + hh * 256 + 64 * sl + (tid & 7) * 8)); \
        { const float* gt_ = F.gt() + (unsigned)(((bh * (SEQ / L) + t0_ / L) * 3) * 64 + lane); g_bb[P] = gt_[0]; g_us[P] = gt_[64]; g_pm[P] = gt_[128]; } } while (0)
    ML_PREFETCH(0, 0); ML_PREFETCH(L, 1);
    __syncthreads();
    for (int chunk2 = 0; chunk2 < SEQ / L; chunk2 += 2) {
#pragma unroll
      for (int par = 0; par < 2; ++par) {
        const int chunk = chunk2 + par, t0 = chunk * L;
        const int tid = opq(F.tid), lane = tid & 63, hi = lane >> 5, l31 = lane & 31, cg = tid & 31, rb = tid >> 5, lo = lane;
        const float u = g_us[par], mm = g_bb[par] + fmaxf(m_prev, g_pm[par]), winter = __builtin_amdgcn_exp2f(g_bb[par] + m_prev - mm), at = g_bb[par] - mm, eden = __builtin_amdgcn_exp2f(-mm);
        const float bb63 = __builtin_bit_cast(float, __builtin_amdgcn_readlane(__builtin_bit_cast(int, g_bb[par]), 63)), mnew = __builtin_bit_cast(float, __builtin_amdgcn_readlane(__builtin_bit_cast(int, mm), 63));
        const float decay = __builtin_amdgcn_exp2f(bb63 + m_prev - mnew), wstate = __builtin_amdgcn_exp2f(bb63 - mnew + u); m_prev = mnew;
        if (wave == 0) { Fa[F_AT + lane] = at; Fa[F_US + lane] = u; Fa[F_WIN + lane] = winter; Fa[F_EDEN + lane] = eden; Fa[F_WST + lane] = wstate; }
#pragma unroll
        for (int j = 0; j < 4; ++j) { *(LAS v4u*)(base + O_QI + ioff<528, 0>(4 * rb + j, cg)) = rawq[par][j]; *(LAS v4u*)(base + O_KI + ioff<528, 0>(4 * rb + j, cg)) = rawk[par][j]; }
        { const int s = tid >> 3, ch = tid & 7; const v4u w = rawv[par];
          *(LAS v4u*)(base + O_VI + ioff<144, 0>(s, ch)) = w;
          const float ws = __shfl(wstate, s);
          v4u o; o.x = pk2(bflo(w.x) * ws, bfhi(w.x) * ws); o.y = pk2(bflo(w.y) * ws, bfhi(w.y) * ws); o.z = pk2(bflo(w.z) * ws, bfhi(w.z) * ws); o.w = pk2(bflo(w.w) * ws, bfhi(w.w) * ws);
          *(LAS v4u*)(base + O_VW + ioff<144, 0>(s, ch)) = o;
          if (ch == 0) *(LAS unsigned short*)(base + O_VW + 144 * s + 128) = (unsigned short)pk2(ws, 0.f); }
        __syncthreads();
        if (chunk + 2 < SEQ / L) ML_PREFETCH(t0 + 2 * L, par);
        __builtin_amdgcn_sched_barrier(0);
        f32x16 acc;
#pragma unroll
        for (int r = 0; r < 16; ++r) acc[r] = 0.f;
        const int wq = wave & 3, ta = wq >> 1, tb = wq & 1;
        if (wave < 4) {
#pragma unroll
            for (int kh = 0; kh < 2; ++kh) { bf16x8 fa[8], fb[8];
#pragma unroll
                for (int ks = 0; ks < 8; ++ks) { fa[ks] = frag_row<528, 0>(base + O_KI, 32 * tb, 8 * kh + ks, lo); fb[ks] = frag_row<528, 0>(base + O_QI, 32 * ta, 8 * kh + ks, lo); }
                __builtin_amdgcn_sched_barrier(0);
#pragma unroll
                for (int ks = 0; ks < 8; ++ks) acc = __builtin_amdgcn_mfma_f32_32x32x16_bf16(fa[ks], fb[ks], acc, 0, 0, 0);
                __builtin_amdgcn_sched_barrier(0); }
            const float at_l = __shfl(at, 32 * ta + l31); const int t = 32 * ta + l31; float rsum = 0.f;
#pragma unroll
            for (int g = 0; g < 4; ++g) { const int s0 = 32 * tb + 8 * g + 4 * hi; const f32x4 us4 = *(LAS const f32x4*)(Fa + F_US + s0); float p[4];
#pragma unroll
                for (int i = 0; i < 4; ++i) { p[i] = (s0 + i <= t) ? acc[4 * g + i] * __builtin_amdgcn_exp2f(at_l + us4[i]) : 0.f; rsum += p[i]; }
                *(LAS unsigned long long*)(base + O_PI + ioff<144, 0>(t, s0 >> 3) + 2 * (s0 & 7)) = (unsigned long long)pk2(p[0], p[1]) | ((unsigned long long)pk2(p[2], p[3]) << 32); }
            rsum = half_sum(rsum);
            if (hi == 0) Fa[F_RSP + tb * 64 + t] = rsum;
        } else {
#pragma unroll
            for (int kh = 0; kh < 2; ++kh) { bf16x8 fa[8], fb[8];
#pragma unroll
                for (int ks = 0; ks < 8; ++ks) { fa[ks] = frag_row<528, 0>(base + O_QI, 32 * ta, 8 * kh + ks, lo); fb[ks] = frag_tr<136, 0>(base + O_CB, 0, 8 * kh + ks, 32 * tb, lo); }
                __builtin_amdgcn_sched_barrier(0);
#pragma unroll
                for (int ks = 0; ks < 8; ++ks) acc = __builtin_amdgcn_mfma_f32_32x32x16_bf16(fa[ks], fb[ks], acc, 0, 0, 0);
                __builtin_amdgcn_sched_barrier(0); }
        }
        { float s = 0.f;
#pragma unroll
          for (int c = 0; c < 4; ++c) { const v4u w = *(LAS const v4u*)(base + O_QI + ioff<528, 0>(lane, 4 * wave + c)); const f32x4 n0 = *(LAS const f32x4*)(Fa + F_NV + 32 * wave + 8 * c), n1 = *(LAS const f32x4*)(Fa + F_NV + 32 * wave + 8 * c + 4);
              s += bflo(w.x) * n0.x + bfhi(w.x) * n0.y + bflo(w.y) * n0.z + bfhi(w.y) * n0.w + bflo(w.z) * n1.x + bfhi(w.z) * n1.y + bflo(w.w) * n1.z + bfhi(w.w) * n1.w; }
          Fa[F_QNP + wave * 64 + lane] = s; }
        __syncthreads();
        if (wave >= 4) {
            { const int t = 32 * ta + l31;
              const float den = Fa[F_WIN + t] * (((Fa[F_QNP + t] + Fa[F_QNP + 64 + t]) + (Fa[F_QNP + 128 + t] + Fa[F_QNP + 192 + t])) + ((Fa[F_QNP + 256 + t] + Fa[F_QNP + 320 + t]) + (Fa[F_QNP + 384 + t] + Fa[F_QNP + 448 + t])))
                                + Fa[F_RSP + t] + Fa[F_RSP + 64 + t];
              if (hi == 0) Fa[F_CW + 32 * (wave - 4) + l31] = 1.0f / fmaxf(fabsf(den), Fa[F_EDEN + t]); }
#pragma unroll
            for (int g = 0; g < 4; ++g) { const f32x4 w4 = *(LAS const f32x4*)(Fa + F_WIN + 32 * ta + 8 * g + 4 * hi); acc[4 * g] *= w4.x; acc[4 * g + 1] *= w4.y; acc[4 * g + 2] *= w4.z; acc[4 * g + 3] *= w4.w; }
            { bf16x8 fa[4], fb[4];
#pragma unroll
              for (int ks = 0; ks < 4; ++ks) { fa[ks] = frag_row<144, 0>(base + O_PI, 32 * ta, ks, lo); fb[ks] = frag_tr<144, 0>(base + O_VI, 0, ks, 32 * tb, lo); }
              __builtin_amdgcn_sched_barrier(0);
#pragma unroll
              for (int ks = 0; ks < 4; ++ks) acc = __builtin_amdgcn_mfma_f32_32x32x16_bf16(fa[ks], fb[ks], acc, 0, 0, 0); }
            bf16* dst = F.YB() + (rowb + t0 + 32 * ta) * D + hh * 256 + 64 * sl + 32 * tb + l31;
#pragma unroll
            for (int g = 0; g < 4; ++g) { const f32x4 r4 = *(LAS const f32x4*)(Fa + F_CW + 32 * (wave - 4) + 8 * g + 4 * hi);
#pragma unroll
                for (int i = 0; i < 4; ++i) dst[(size_t)(8 * g + 4 * hi + i) * D] = (bf16)pk2(acc[4 * g + i] * r4[i], 0.f); }
        }
#pragma unroll
        for (int r = 0; r < 16; ++r) { C0[r] *= decay; C1[r] *= decay; C2[r] *= decay; }
        { bf16x8 bk[4], v0[4], v1[4], v2[4];
#pragma unroll
          for (int ks = 0; ks < 4; ++ks) { bk[ks] = frag_tr<528, 0>(base + O_KI, 0, ks, 32 * wave, lo); v0[ks] = frag_tr<144, 0>(base + O_VW, 0, ks, 0, lo); v1[ks] = frag_tr<144, 0>(base + O_VW, 0, ks, 32, lo); v2[ks] = frag_tr<144, 0>(base + O_VW, 0, ks, 64, lo); }
          __builtin_amdgcn_sched_barrier(0);
#pragma unroll
          for (int ks = 0; ks < 4; ++ks) { C0 = __builtin_amdgcn_mfma_f32_32x32x16_bf16(v0[ks], bk[ks], C0, 0, 0, 0); C1 = __builtin_amdgcn_mfma_f32_32x32x16_bf16(v1[ks], bk[ks], C1, 0, 0, 0); C2 = __builtin_amdgcn_mfma_f32_32x32x16_bf16(v2[ks], bk[ks], C2, 0, 0, 0); }
          __builtin_amdgcn_sched_barrier(0); }
        { const int d = 32 * wave + l31;
#pragma unroll
          for (int g = 0; g < 4; ++g) { const int e0 = 8 * g + 4 * hi;
              *(LAS unsigned long long*)(base + O_CB + ioff<136, 0>(d, e0 >> 3) + 2 * (e0 & 7)) = (unsigned long long)pk2(C0[4 * g], C0[4 * g + 1]) | ((unsigned long long)pk2(C0[4 * g + 2], C0[4 * g + 3]) << 32);
              *(LAS unsigned long long*)(base + O_CB + ioff<136, 0>(d, (32 + e0) >> 3) + 2 * (e0 & 7)) = (unsigned long long)pk2(C1[4 * g], C1[4 * g + 1]) | ((unsigned long long)pk2(C1[4 * g + 2], C1[4 * g + 3]) << 32); }
          if (hi == 0) Fa[F_NV + d] = C2[0];
        }
        __syncthreads();
      }
    }
#undef ML_PREFETCH
}
}


__device__ __forceinline__ void mlstm_gates(Frame& F, int job) {
    const int lane = opq(F.lane); const float LOG2E = 1.4426950408889634f;
    const float lf2 = F.lf()[(size_t)job * ml::L + lane] * LOG2E, ii2 = F.ipre()[(size_t)job * ml::L + lane] * LOG2E;
    float bb = lf2;
#pragma unroll
    for (int o = 1; o < 64; o <<= 1) { const float v = __shfl_up(bb, o); bb += (lane >= o) ? v : 0.f; }
    const float u = ii2 - bb; float pm = u;
#pragma unroll
    for (int o = 1; o < 64; o <<= 1) { const float v = __shfl_up(pm, o); pm = (lane >= o) ? fmaxf(pm, v) : pm; }
    float* gt = F.gt() + (size_t)job * 3 * 64 + lane;
    gt[0] = bb; gt[64] = u; gt[128] = pm;
}

__device__ __forceinline__ void mlstm_conv_rows(Frame& F) {
    const int tid = opq(F.tid), cg = tid & 255, z = cg >> 7, c0 = (cg & 127) * 8, r0 = F.vcu * 128 + 64 * (tid >> 8);
    const bf16* src = F.PROJ() + (size_t)(3 + z) * (SEG / 2) + c0; bf16* dst = (bf16*)F.out() + (size_t)z * T * D + c0;
    float w[4][8], bs[8];
#pragma unroll
    for (int tap = 0; tap < 4; ++tap) { const f32x4 a0 = *(const f32x4*)(F.conv_w() + tap * 2048 + cg * 8), a1 = *(const f32x4*)(F.conv_w() + tap * 2048 + cg * 8 + 4);
        w[tap][0] = a0.x; w[tap][1] = a0.y; w[tap][2] = a0.z; w[tap][3] = a0.w; w[tap][4] = a1.x; w[tap][5] = a1.y; w[tap][6] = a1.z; w[tap][7] = a1.w; }
    { const f32x4 a0 = *(const f32x4*)(F.conv_b() + cg * 8), a1 = *(const f32x4*)(F.conv_b() + cg * 8 + 4);
      bs[0] = a0.x; bs[1] = a0.y; bs[2] = a0.z; bs[3] = a0.w; bs[4] = a1.x; bs[5] = a1.y; bs[6] = a1.z; bs[7] = a1.w; }
    const float osc = z ? 0.0625f : 1.0f;
    const bool seq_start = (r0 % SEQ) == 0;
    v4u x0, x1, x2;
    { const v4u zero = {0u, 0u, 0u, 0u};
      x0 = seq_start ? zero : *(const v4u*)(src + (size_t)(r0 - 3 + (seq_start ? 3 : 0)) * D);
      x1 = seq_start ? zero : *(const v4u*)(src + (size_t)(r0 - 2 + (seq_start ? 2 : 0)) * D);
      x2 = seq_start ? zero : *(const v4u*)(src + (size_t)(r0 - 1 + (seq_start ? 1 : 0)) * D); }
    v4u nxs[8];
#pragma unroll
    for (int i = 0; i < 8; ++i) nxs[i] = *(const v4u*)(src + (size_t)(r0 + i) * D);
    for (int rr = 0; rr < 64; rr += 8) {
        v4u xs[8];
#pragma unroll
        for (int i = 0; i < 8; ++i) xs[i] = nxs[i];
        if (rr + 8 < 64) {
#pragma unroll
            for (int i = 0; i < 8; ++i) nxs[i] = *(const v4u*)(src + (size_t)(r0 + rr + 8 + i) * D); }
#pragma unroll
        for (int i = 0; i < 8; ++i) {
            const v4u x3 = xs[i]; float y[8];
#pragma unroll
            for (int c = 0; c < 8; ++c) y[c] = bs[c];
#define MK_TAP(tap, X) do { y[0] += w[tap][0] * bflo(X.x); y[1] += w[tap][1] * bfhi(X.x); y[2] += w[tap][2] * bflo(X.y); y[3] += w[tap][3] * bfhi(X.y); \
                           y[4] += w[tap][4] * bflo(X.z); y[5] += w[tap][5] * bfhi(X.z); y[6] += w[tap][6] * bflo(X.w); y[7] += w[tap][7] * bfhi(X.w); } while (0)
            MK_TAP(0, x0); MK_TAP(1, x1); MK_TAP(2, x2); MK_TAP(3, x3);
#undef MK_TAP
#pragma unroll
            for (int c = 0; c < 8; ++c) y[c] = ml::silu_f(y[c]) * osc;
            v4u o; o.x = pk2(y[0], y[1]); o.y = pk2(y[2], y[3]); o.z = pk2(y[4], y[5]); o.w = pk2(y[6], y[7]);
            *(v4u*)(dst + (size_t)(r0 + rr + i) * D) = o;
            x0 = x1; x1 = x2; x2 = x3;
        }
    }
}

__device__ __forceinline__ void mlstm_norm_rows(Frame& F) {
    const int row0 = F.vcu * 128, lane = opq(F.lane);
    const bf16* MLO = F.PROJ() + 6 * (SEG / 2);
    f32x4 G[4];
#pragma unroll
    for (int j = 0; j < 4; ++j) G[j] = *(const f32x4*)(F.ml_norm_g() + 256 * j + 4 * lane);
    unsigned long long nh[4], no[4];
#define NR_LOAD(ROW) do { const size_t row_ = (ROW); const GAS unsigned long long* hp_ = (const GAS unsigned long long*)(F.YB() + row_ * D) + lane; const GAS unsigned long long* op_ = (const GAS unsigned long long*)(MLO + row_ * D) + lane; \
        _Pragma("unroll") for (int j = 0; j < 4; ++j) { nh[j] = hp_[64 * j]; no[j] = op_[64 * j]; } } while (0)
    NR_LOAD((size_t)row0 + 16 * F.wave);
    for (int r = 0; r < 16; ++r) {
        const size_t row = (size_t)row0 + 16 * F.wave + r;
        GAS unsigned* hp = (GAS unsigned*)((unsigned char*)F.YB8() + row * D) + lane;
        unsigned long long ch[4], co[4];
#pragma unroll
        for (int j = 0; j < 4; ++j) { ch[j] = nh[j]; co[j] = no[j]; }
        if (r < 15) NR_LOAD(row + 1);
#pragma unroll
        for (int j = 0; j < 4; ++j) { const unsigned long long hw = ch[j], ow = co[j];
            const float h0 = bflo((unsigned)hw), h1 = bfhi((unsigned)hw), h2 = bflo((unsigned)(hw >> 32)), h3 = bfhi((unsigned)(hw >> 32));
            const float ss = wave_sum((h0 * h0 + h1 * h1) + (h2 * h2 + h3 * h3)); const float rstd = 1.0f / sqrtf(ss * (1.0f / 256.0f) + EPS);
            const float o0 = bflo((unsigned)ow), o1 = bfhi((unsigned)ow), o2 = bflo((unsigned)(ow >> 32)), o3 = bfhi((unsigned)(ow >> 32));
            const float y0 = h0 * rstd * G[j].x / (1.0f + __expf(-o0)), y1 = h1 * rstd * G[j].y / (1.0f + __expf(-o1)), y2 = h2 * rstd * G[j].z / (1.0f + __expf(-o2)), y3 = h3 * rstd * G[j].w / (1.0f + __expf(-o3));
            hp[64 * j] = pg8::pk4_fp8(y0, y1, y2, y3); }
    }
#undef NR_LOAD
}

namespace at {
using ml::bf16x8; using ml::s16x4; using ml::f32x16; using ml::ioff; using ml::frag_row; using ml::lcp; using ml::lp_t;
typedef _Float16 f16x8 __attribute__((ext_vector_type(8)));
typedef _Float16 f16x2 __attribute__((ext_vector_type(2)));
typedef float f32x2 __attribute__((ext_vector_type(2)));
constexpr int O_KI = 0, O_VI = 8192, O_FLAG = 16384;
template <int PITCH, int XM> __device__ __forceinline__ bf16x8 frag_trp(lcp img, int ks, int col0, int lane) {
    const int h = lane >> 5, blk = (lane >> 4) & 1, q = (lane & 15) >> 2, p = lane & 3;
    const int r0 = 16 * ks + 4 * h + q, ch = (col0 >> 3) + 2 * blk + (p >> 1);
    typedef short v4i16_t __attribute__((ext_vector_type(4)));
    const s16x4 a = __builtin_bit_cast(s16x4, __builtin_amdgcn_ds_read_tr16_b64_v4i16((LAS v4i16_t*)(img + ioff<PITCH, XM>(r0, ch) + 8 * (p & 1))));
    const s16x4 b = __builtin_bit_cast(s16x4, __builtin_amdgcn_ds_read_tr16_b64_v4i16((LAS v4i16_t*)(img + ioff<PITCH, XM>(r0 + 8, ch) + 8 * (p & 1))));
    return (bf16x8){a[0], a[1], a[2], a[3], b[0], b[1], b[2], b[3]};
}
__device__ __forceinline__ unsigned pkh(float a, float b) { const f32x2 v = {a, b}; return __builtin_bit_cast(unsigned, __builtin_convertvector(v, f16x2)); }
__device__ __forceinline__ f16x8 h8(unsigned a, unsigned b, unsigned c, unsigned d) { const v4u v = {a, b, c, d}; return __builtin_bit_cast(f16x8, v); }
__device__ __forceinline__ bf16x8 b8(unsigned a, unsigned b, unsigned c, unsigned d) { const v4u v = {a, b, c, d}; return __builtin_bit_cast(bf16x8, v); }

__device__ __forceinline__ void attn_ring(Frame& F, int bh) {
    const int b = bh >> 4, hd = bh & 15, tid = opq(F.tid), lane = opq(F.lane), wave = F.wave, hi = lane >> 5, l31 = lane & 31, pr = wave & 3, rw = 2 * (wave & 3) + (wave >> 2), tp = 64 * (wave >> 2) + lane;
    const bf16* Q = F.PROJ(); const bf16* K = F.PROJ() + SEG / 2; const bf16* V = F.PROJ() + SEG;
    const lp_t lds0 = (lp_t)F.lds;
    LAS volatile int* dflag = (LAS volatile int*)(lds0 + 131072);
    const size_t rowb = (size_t)b * SEQ;
#define AT_DMA(KT) do { const int kt_ = (KT); if (kt_ >= 0) { const lp_t sl_ = lds0 + (kt_ & 7) * 16384 + 1024 * wave; const int dl_ = opq(F.lane); \
        const size_t dg0 = (rowb + 8 * wave + (dl_ >> 3)) * D + hd * 64 + ((dl_ & 7) ^ (dl_ >> 3)) * 8;     \
        __builtin_amdgcn_global_load_lds((const unsigned*)(K + dg0 + (size_t)kt_ * 64 * D), (LAS unsigned*)(sl_ + O_KI), 16, 0, 0); \
        __builtin_amdgcn_global_load_lds((const unsigned*)(V + dg0 + (size_t)kt_ * 64 * D), (LAS unsigned*)(sl_ + O_VI), 16, 0, 0); } } while (0)
    unsigned uw[2][4];
#pragma unroll
    for (int sp = 0; sp < 2; ++sp)
#pragma unroll
        for (int jj = 0; jj < 4; ++jj) { const int j0 = 2 * jj, j1 = 2 * jj + 1;
            const int k0 = 16 * sp + 8 * (j0 >> 2) + 4 * hi + (j0 & 3), k1 = 16 * sp + 8 * (j1 >> 2) + 4 * hi + (j1 & 3);
            uw[sp][jj] = (k0 > l31 ? 0x3C00u : 0u) | (k1 > l31 ? 0x3C000000u : 0u); }
    const f16x8 U0 = h8(uw[0][0], uw[0][1], uw[0][2], uw[0][3]), U1 = h8(uw[1][0], uw[1][1], uw[1][2], uw[1][3]), ONES = h8(0x3C003C00u, 0x3C003C00u, 0x3C003C00u, 0x3C003C00u);
    bool ring_ok = false;
    bf16x8 qr[4];
#pragma unroll
    for (int ks = 0; ks < 4; ++ks) qr[ks] = *(const bf16x8*)(Q + (rowb + (SEQ - 256) + 32 * rw + l31) * D + hd * 64 + 16 * ks + 8 * hi);
    __syncthreads();
    for (int qb = SEQ / 256 - 1; qb >= 0; --qb) {
        const int q0 = qb * 256, tw0 = q0 + 32 * rw, t = tw0 + l31, kt0 = qb * 4 + pr;
        if (ring_ok) { AT_DMA(4 * qb - 3); AT_DMA(4 * qb - 4); }
        else {
#pragma unroll
            for (int s = 3; s >= -4; --s) AT_DMA(4 * qb + s);
            asm volatile("s_waitcnt vmcnt(0)" ::: "memory");
            __syncthreads(); }
        LAS volatile int* dfl = dflag + 8 * (qb & 1);
        if (lane == 0) dfl[wave] = 0;
        f32x16 O0, O1;
#pragma unroll
        for (int r = 0; r < 16; ++r) { O0[r] = 0.f; O1[r] = 0.f; }
        float R = 0.f; bool wdone = false;
        const bool has_next = qb > 0;
        ring_ok = has_next;
        bool closed = false;
        for (int it = 0; it <= qb * 4 + 3; ++it) {
            const int kt = kt0 - it;
            lp_t base = lds0 + (kt & 7) * 16384;
            if (it == 2) {
                asm volatile("s_waitcnt vmcnt(0)" ::: "memory");
                __syncthreads();
                if (has_next) { AT_DMA(4 * qb - 5); AT_DMA(4 * qb - 6); }
            }
            if (it >= 5) {
                base = lds0 + pr * 16384;
                asm volatile("s_waitcnt vmcnt(0)" ::: "memory");
                __syncthreads();
                { int nd = 0;
#pragma unroll
                  for (int w = 0; w < 8; ++w) nd += dfl[w];
                  if (nd == 8) { closed = true; break; } }
                ring_ok = false;
                if (kt >= 0) {
#pragma unroll
                    for (int j = 0; j < 4; ++j) { const size_t g = (rowb + kt * 64 + (tp >> 3) + 16 * j) * D + hd * 64 + (tp & 7) * 8; const v4u kv = *(const v4u*)(K + g), vv = *(const v4u*)(V + g);
                        *(LAS v4u*)(base + O_KI + ioff<128, 7>((tp >> 3) + 16 * j, tp & 7)) = kv; *(LAS v4u*)(base + O_VI + ioff<128, 7>((tp >> 3) + 16 * j, tp & 7)) = vv; } }
                __syncthreads();
            }
            if (kt < 0) { if (!wdone) { wdone = true; if (lane == 0) dfl[wave] = 1; } continue; }
            if (wdone) continue;
            int lo = lane; asm volatile("" : "+v"(lo));
            f32x16 p0, p1;
#pragma unroll
            for (int r = 0; r < 16; ++r) { p0[r] = 0.f; p1[r] = 0.f; }
#pragma unroll
            for (int ks = 0; ks < 4; ++ks) { p0 = __builtin_amdgcn_mfma_f32_32x32x16_bf16(frag_row<128, 7>(base + O_KI, 0, ks, lo), qr[ks], p0, 0, 0, 0);
                                             p1 = __builtin_amdgcn_mfma_f32_32x32x16_bf16(frag_row<128, 7>(base + O_KI, 32, ks, lo), qr[ks], p1, 0, 0, 0); }
            const bool diag = (it == 0);
            const int trel = t - 64 * kt;
            float lk00 = 0.f;
            unsigned lkw0[8], lkw1[8];
#pragma unroll
            for (int r = 0; r < 16; ++r) {
                const int key0 = ml::crow(r, hi);
                { const float z = __builtin_amdgcn_fmed3f(p0[r], -80.f, 80.f), l = __builtin_amdgcn_logf(1.0f + __builtin_amdgcn_exp2f(-z)); float lk = -l - z; if (diag && !(key0 < trel)) lk = 0.f; p0[r] = l; if (r == 0) lk00 = lk;
                  if (r & 1) lkw0[r >> 1] = pkh(__builtin_bit_cast(float, lkw0[r >> 1]), lk); else lkw0[r >> 1] = __builtin_bit_cast(unsigned, lk); }
                { const float z = __builtin_amdgcn_fmed3f(p1[r], -80.f, 80.f), l = __builtin_amdgcn_logf(1.0f + __builtin_amdgcn_exp2f(-z)); float lk = -l - z; if (diag && !(key0 + 32 < trel)) lk = 0.f; p1[r] = l;
                  if (r & 1) lkw1[r >> 1] = pkh(__builtin_bit_cast(float, lkw1[r >> 1]), lk); else lkw1[r >> 1] = __builtin_bit_cast(unsigned, lk); }
            }
            f32x16 bt1, bt0;
#pragma unroll
            for (int r = 0; r < 16; ++r) { bt1[r] = R; bt0[r] = R; }
            const f16x8 L10 = h8(lkw1[0], lkw1[1], lkw1[2], lkw1[3]), L11 = h8(lkw1[4], lkw1[5], lkw1[6], lkw1[7]), L00 = h8(lkw0[0], lkw0[1], lkw0[2], lkw0[3]), L01 = h8(lkw0[4], lkw0[5], lkw0[6], lkw0[7]);
            bt1 = __builtin_amdgcn_mfma_f32_32x32x16_f16(U0, L10, bt1, 0, 0, 0); bt1 = __builtin_amdgcn_mfma_f32_32x32x16_f16(U1, L11, bt1, 0, 0, 0);
            bt0 = __builtin_amdgcn_mfma_f32_32x32x16_f16(ONES, L10, bt0, 0, 0, 0); bt0 = __builtin_amdgcn_mfma_f32_32x32x16_f16(ONES, L11, bt0, 0, 0, 0);
            bt0 = __builtin_amdgcn_mfma_f32_32x32x16_f16(U0, L00, bt0, 0, 0, 0); bt0 = __builtin_amdgcn_mfma_f32_32x32x16_f16(U1, L01, bt0, 0, 0, 0);
            { const float v = bt0[0] + lk00;
              const auto rr = __builtin_amdgcn_permlane32_swap(__builtin_bit_cast(unsigned, v), __builtin_bit_cast(unsigned, v), false, false);
              R = __builtin_bit_cast(float, rr[0]); }
            unsigned aw0[8], aw1[8];
#pragma unroll
            for (int r = 0; r < 16; r += 2) {
                const int key0 = ml::crow(r, hi);
                float a00 = __builtin_amdgcn_exp2f(bt0[r] - p0[r]), a01 = __builtin_amdgcn_exp2f(bt0[r + 1] - p0[r + 1]), a10 = __builtin_amdgcn_exp2f(bt1[r] - p1[r]), a11 = __builtin_amdgcn_exp2f(bt1[r + 1] - p1[r + 1]);
                if (diag) { if (!(key0 < trel)) a00 = 0.f; if (!(key0 + 1 < trel)) a01 = 0.f; if (!(key0 + 32 < trel)) a10 = 0.f; if (!(key0 + 33 < trel)) a11 = 0.f; }
                aw0[r >> 1] = pk2(a00, a01); aw1[r >> 1] = pk2(a10, a11);
            }
            const bf16x8 A00 = b8(aw0[0], aw0[1], aw0[2], aw0[3]), A01 = b8(aw0[4], aw0[5], aw0[6], aw0[7]), A10 = b8(aw1[0], aw1[1], aw1[2], aw1[3]), A11 = b8(aw1[4], aw1[5], aw1[6], aw1[7]);
            O0 = __builtin_amdgcn_mfma_f32_32x32x16_bf16(A00, frag_trp<128, 7>(base + O_VI, 0, 0, lo), O0, 0, 0, 0);  O1 = __builtin_amdgcn_mfma_f32_32x32x16_bf16(A00, frag_trp<128, 7>(base + O_VI, 0, 32, lo), O1, 0, 0, 0);
            O0 = __builtin_amdgcn_mfma_f32_32x32x16_bf16(A01, frag_trp<128, 7>(base + O_VI, 1, 0, lo), O0, 0, 0, 0);  O1 = __builtin_amdgcn_mfma_f32_32x32x16_bf16(A01, frag_trp<128, 7>(base + O_VI, 1, 32, lo), O1, 0, 0, 0);
            O0 = __builtin_amdgcn_mfma_f32_32x32x16_bf16(A10, frag_trp<128, 7>(base + O_VI, 2, 0, lo), O0, 0, 0, 0);  O1 = __builtin_amdgcn_mfma_f32_32x32x16_bf16(A10, frag_trp<128, 7>(base + O_VI, 2, 32, lo), O1, 0, 0, 0);
            O0 = __builtin_amdgcn_mfma_f32_32x32x16_bf16(A11, frag_trp<128, 7>(base + O_VI, 3, 0, lo), O0, 0, 0, 0);  O1 = __builtin_amdgcn_mfma_f32_32x32x16_bf16(A11, frag_trp<128, 7>(base + O_VI, 3, 32, lo), O1, 0, 0, 0);
            if (__all(R < ATT_RTHR)) { wdone = true; if (lane == 0) dfl[wave] = 1; }
        }
        if (!closed) {
            asm volatile("s_waitcnt vmcnt(0)" ::: "memory");
            __syncthreads(); }
        if (has_next) {
#pragma unroll
            for (int ks = 0; ks < 4; ++ks) qr[ks] = *(const bf16x8*)(Q + (rowb + t - 256) * D + hd * 64 + 16 * ks + 8 * hi); }
        unsigned char* dst = (unsigned char*)F.YA() + (rowb + tw0) * D + hd * 64 + l31;
#pragma unroll
        for (int r = 0; r < 16; ++r) { const int q = ml::crow(r, hi); dst[(size_t)q * D] = (unsigned char)pg8::pk4_fp8(O0[r], 0.f, 0.f, 0.f); dst[(size_t)q * D + 32] = (unsigned char)pg8::pk4_fp8(O1[r], 0.f, 0.f, 0.f); }
    }
#undef AT_DMA
}
}

__device__ __forceinline__ void p5a_route(Frame& F) {
    const int row0 = F.vcu * 128, b = row0 / SEQ, lane = opq(F.lane), tid = opq(F.tid);
    LAS float* wr = (LAS float*)F.lds;
    LAS int* le = (LAS int*)(F.lds + 131584); LAS int* lp = le + 512;
    LAS int* lcnt = (LAS int*)(F.LC + LC_LCNT); LAS int* gbase = (LAS int*)(F.LC + LC_GBASE);
    for (int idx = tid; idx < 32768; idx += 512) wr[(idx & 31) * 1028 + (idx >> 5)] = F.router_w()[idx];
    if (tid < 32) lcnt[tid] = 0;
    f32x4 Av[4], Bv[4];
#pragma unroll
    for (int j = 0; j < 4; ++j) { const int col = 4 * lane + 256 * j; const float* mb = F.mod() + (size_t)b * NMOD;
        const f32x4 g = *(const f32x4*)(F.norm2_g() + col); Av[j] = g * (*(const f32x4*)(mb + 4 * D + col) + 1.0f); Bv[j] = *(const f32x4*)(mb + 3 * D + col); }
    float rb[32];
#pragma unroll
    for (int e = 0; e < 32; ++e) rb[e] = F.router_b()[e];
    __syncthreads();
    f32x4 nx[4];
    { const GAS f32x4* xr = (const GAS f32x4*)(F.out() + (size_t)(row0 + 16 * F.wave) * D) + lane;
#pragma unroll
      for (int j = 0; j < 4; ++j) nx[j] = xr[64 * j]; }
    for (int r = 0; r < 16; ++r) {
        const int rl = 16 * F.wave + r, row = row0 + rl;
        f32x4 v[4]; float ss = 0.f;
#pragma unroll
        for (int j = 0; j < 4; ++j) { v[j] = nx[j]; ss += (v[j].x * v[j].x + v[j].y * v[j].y) + (v[j].z * v[j].z + v[j].w * v[j].w); }
        if (r < 15) { const GAS f32x4* xr = (const GAS f32x4*)(F.out() + (size_t)(row + 1) * D) + lane;
#pragma unroll
            for (int j = 0; j < 4; ++j) nx[j] = xr[64 * j]; }
        const float rstd = 1.0f / sqrtf(wave_sum(ss) * (1.0f / D) + EPS);
        { GAS unsigned* o4 = (GAS unsigned*)((unsigned char*)F.H2() + (size_t)row * D) + lane;
#pragma unroll
          for (int j = 0; j < 4; ++j) { v[j] = v[j] * rstd * Av[j] + Bv[j]; o4[64 * j] = pg8::pk4_fp8(v[j].x, v[j].y, v[j].z, v[j].w); } }
        float p[32];
#pragma unroll
        for (int e = 0; e < 32; ++e) { float s = 0.f;
#pragma unroll
            for (int j = 0; j < 4; ++j) { const f32x4 w = *(const LAS f32x4*)(wr + e * 1028 + 4 * lane + 256 * j); s += (v[j].x * w.x + v[j].y * w.y) + (v[j].z * w.z + v[j].w * w.w); }
            p[e] = s; }
#pragma unroll
        for (int i = 0; i < 16; ++i) { const bool up = (lane & 32) != 0; const float send = up ? p[i] : p[i + 16], keep = up ? p[i + 16] : p[i]; p[i] = keep + __shfl_xor(send, 32); }
#pragma unroll
        for (int i = 0; i < 8; ++i) { const bool up = (lane & 16) != 0; const float send = up ? p[i] : p[i + 8], keep = up ? p[i + 8] : p[i]; p[i] = keep + __shfl_xor(send, 16); }
#pragma unroll
        for (int i = 0; i < 4; ++i) { const bool up = (lane & 8) != 0; const float send = up ? p[i] : p[i + 4], keep = up ? p[i + 4] : p[i]; p[i] = keep + __shfl_xor(send, 8); }
#pragma unroll
        for (int i = 0; i < 2; ++i) { const bool up = (lane & 4) != 0; const float send = up ? p[i] : p[i + 2], keep = up ? p[i + 2] : p[i]; p[i] = keep + __shfl_xor(send, 4); }
        { const bool up = (lane & 2) != 0; const float send = up ? p[0] : p[1], keep = up ? p[1] : p[0]; p[0] = keep + __shfl_xor(send, 2); }
        p[0] += __shfl_xor(p[0], 1);
        { LAS float* lg = (LAS float*)(F.lds + 135680) + F.wave * 32;
          if ((lane & 1) == 0) lg[lane >> 1] = p[0];
#pragma unroll
          for (int q = 0; q < 8; ++q) { const f32x4 t4 = *(const LAS f32x4*)(lg + 4 * q); p[4 * q] = t4.x + rb[4 * q]; p[4 * q + 1] = t4.y + rb[4 * q + 1]; p[4 * q + 2] = t4.z + rb[4 * q + 2]; p[4 * q + 3] = t4.w + rb[4 * q + 3]; } }
        int sel[4]; float sv[4]; unsigned used = 0u;
#pragma unroll
        for (int k = 0; k < 4; ++k) { float best = -3.0e38f; int bi = 0;
#pragma unroll
            for (int e = 0; e < 32; ++e) { const bool cnd = (((used >> e) & 1u) == 0u) && (p[e] > best); best = cnd ? p[e] : best; bi = cnd ? e : bi; }
            sel[k] = bi; sv[k] = best; used |= 1u << bi; }
        const float e1 = __expf(sv[1] - sv[0]), e2 = __expf(sv[2] - sv[0]), e3 = __expf(sv[3] - sv[0]), inv = 1.0f / (1.0f + e1 + e2 + e3);
        if (lane < 4) { const int ek = lane == 0 ? sel[0] : lane == 1 ? sel[1] : lane == 2 ? sel[2] : sel[3];
            const float wk = (lane == 0 ? 1.0f : lane == 1 ? e1 : lane == 2 ? e2 : e3) * inv;
            const int pos = __hip_atomic_fetch_add(lcnt + ek, 1, __ATOMIC_RELAXED, __HIP_MEMORY_SCOPE_WORKGROUP);
            le[rl * 4 + lane] = ek; lp[rl * 4 + lane] = pos; F.tokw()[(size_t)row * 4 + lane] = wk; }
        if (lane == 0) F.rstd2()[row] = rstd;
    }
    __syncthreads();
    if (tid < 32) gbase[tid] = (int)__hip_atomic_fetch_add(F.ctl + CW_ECNT + 64 * tid, (unsigned)lcnt[tid], __ATOMIC_RELAXED, __HIP_MEMORY_SCOPE_AGENT);
    __syncthreads();
    { const int ek = le[tid]; F.toke()[(size_t)row0 * 4 + tid] = ek; F.tokp()[(size_t)row0 * 4 + tid] = lp[tid] + gbase[ek]; }
}

__device__ __forceinline__ void p5b_tables(Frame& F) {
    const int row0 = F.vcu * 128, tid = opq(F.tid);
    LAS int* ts = (LAS int*)(F.LC + LC_TS); LAS int* ps = (LAS int*)(F.LC + LC_PS); LAS int* cn = (LAS int*)(F.LC + LC_CNT);
    if (tid < 32) cn[tid] = (int)__hip_atomic_load(F.ctl + CW_ECNT + 64 * tid, RLX_AGENT);
    __syncthreads();
    if (tid == 0) { int run = 0, trun = 0; for (int e = 0; e < 32; ++e) { ps[e] = run; ts[e] = trun; const int nt = (cn[e] + 255) >> 8; run += nt * 256; trun += nt; } ts[32] = trun; }
    __syncthreads();
    { const size_t idx = (size_t)row0 * 4 + tid; const int ek = F.toke()[idx], dst = ps[ek] + F.tokp()[idx]; F.tokrow()[idx] = dst; F.row2tok()[dst] = row0 + (tid >> 2); }
    if (F.vcu < 32) { const int e = F.vcu, start = ps[e] + cn[e], end = ps[e] + (((cn[e] + 255) >> 8) << 8); for (int r = start + tid; r < end; r += 512) F.row2tok()[r] = 0; }
}

__device__ __forceinline__ void p8_combine(Frame& F, bool poison) {
    const int row0 = F.vcu * 128, b = row0 / SEQ, lane = opq(F.lane);
    f32x4 G2[4], FG[4];
#pragma unroll
    for (int j = 0; j < 4; ++j) { const int col = 4 * lane + 256 * j; G2[j] = *(const f32x4*)(F.mod() + (size_t)b * NMOD + 5 * D + col); FG[j] = *(const f32x4*)(F.final_g() + col); }
    f32x4 nx[4]; unsigned long long ng[4][4]; float nw[4];
#define P8_LOAD(ROW) do { const size_t row_ = (ROW); const GAS f32x4* xr_ = (const GAS f32x4*)(F.out() + row_ * D) + lane; \
        _Pragma("unroll") for (int j = 0; j < 4; ++j) nx[j] = xr_[64 * j]; \
        _Pragma("unroll") for (int k = 0; k < 4; ++k) { const int src_ = F.tokrow()[row_ * 4 + k]; nw[k] = F.tokw()[row_ * 4 + k]; \
            const GAS unsigned long long* s8_ = (const GAS unsigned long long*)(F.OUTR() + (size_t)src_ * D) + lane; \
            _Pragma("unroll") for (int j = 0; j < 4; ++j) ng[k][j] = s8_[64 * j]; } } while (0)
    P8_LOAD((size_t)row0 + 16 * F.wave);
    for (int r = 0; r < 16; ++r) {
        const int row = row0 + 16 * F.wave + r;
        GAS f32x4* xr = (GAS f32x4*)(F.out() + (size_t)row * D) + lane;
        f32x4 y[4], xv[4];
#pragma unroll
        for (int j = 0; j < 4; ++j) { y[j] = (f32x4){0.f, 0.f, 0.f, 0.f}; xv[j] = nx[j]; }
#pragma unroll
        for (int k = 0; k < 4; ++k) { const float wk = nw[k];
#pragma unroll
            for (int j = 0; j < 4; ++j) { const unsigned long long w = ng[k][j]; y[j].x += wk * bflo((unsigned)w); y[j].y += wk * bfhi((unsigned)w); y[j].z += wk * bflo((unsigned)(w >> 32)); y[j].w += wk * bfhi((unsigned)(w >> 32)); } }
        if (r < 15) P8_LOAD((size_t)row + 1);
        f32x4 v[4]; float ss = 0.f;
#pragma unroll
        for (int j = 0; j < 4; ++j) { v[j] = xv[j] + G2[j] * y[j]; ss += (v[j].x * v[j].x + v[j].y * v[j].y) + (v[j].z * v[j].z + v[j].w * v[j].w); }
        const float rstd = 1.0f / sqrtf(wave_sum(ss) * (1.0f / D) + EPS);
        const float qn = __builtin_nanf("");
#pragma unroll
        for (int j = 0; j < 4; ++j) { f32x4 o = v[j] * rstd * FG[j]; if (poison) o = (f32x4){qn, qn, qn, qn}; xr[64 * j] = o; }
    }
#undef P8_LOAD
}

#ifndef MK_REP_G2
#define MK_REP_G2 1
#endif
#ifndef MK_REP_G4A
#define MK_REP_G4A 1
#endif
#ifndef MK_REP_G4B
#define MK_REP_G4B 1
#endif
#ifndef MK_REP_G4C
#define MK_REP_G4C 1
#endif
#ifndef MK_REP_G6
#define MK_REP_G6 1
#endif
#ifndef MK_REP_G7
#define MK_REP_G7 1
#endif
#ifndef MK_REP_P0
#define MK_REP_P0 1
#endif
#ifndef MK_REP_P3
#define MK_REP_P3 1
#endif
struct Args { const float* in[22]; float* out; unsigned char* ws; };
__global__ void __launch_bounds__(NWAVES * 64, 2) mk_fwd(Args args) {
    extern __shared__ __attribute__((aligned(16))) unsigned char lds[];
    Frame F;
    F.lds = (LAS unsigned char*)lds; F.LC = (volatile LAS unsigned*)(F.lds + LDSCTL_OFF);
    F.tid = threadIdx.x; F.lane = F.tid & 63; F.wave = __builtin_amdgcn_readfirstlane(F.tid >> 6);
    F.G = gridDim.x; { const int bx = blockIdx.x; F.vcu = (F.G % 8 == 0) ? (bx % 8) * (F.G / 8) + bx / 8 : bx; }
    F.ws = (unsigned char*)(GAS unsigned char*)karg(23);
    F.ctl = (gu32*)(F.ws + WS_CTL);
    for (int u = F.tid; u < (LDS_BYTES - LDSCTL_OFF) / 4; u += NWAVES * 64) ((LAS unsigned*)(F.lds + LDSCTL_OFF))[u] = 0u;
    __syncthreads();
    XcdBarrier bar = xcd_barrier_post((unsigned*)(F.ctl + CW_BAR), F.LC + LC_BAR);
#define GRID_BAR() xcd_barrier(bar)
    const int G = F.G, cid = (int)blockIdx.x;

    for (int rep_ = 0; rep_ < MK_REP_P0; ++rep_) p0_prologue(F);
    GRID_BAR();
    p1_rows(F);
    GRID_BAR();
    { pg8::Gemm g{F.H1(), F.WIN_T(), T, NPROJ, D / 2}; pg8::StaticOrder S; S.init(T, NPROJ, G, cid);
      pg8::EpiBf16<0> E{F.PROJ(), D, nullptr, D, SEG / 2, QSCALE, 1.0f / W8SCALE};
      for (int rep_ = 0; rep_ < MK_REP_G2; ++rep_) pg8::gemm_phase<pg8::EpiBf16<0>, pg8::StaticOrder, true, true, false, true>(F.lds, g, S, E); }
    GRID_BAR();
    for (int job = F.vcu * NWAVES + F.wave; job < BATCH * 4 * (SEQ / 64); job += G * NWAVES) mlstm_gates(F, job);
    mlstm_conv_rows(F);
    GRID_BAR();
#if defined(MK_NAIVE_MLSTM)
    for (int it = F.vcu; it < 1024; it += G) attn_naive_item(F, it & 255, it >> 8);
    __syncthreads();
    for (int it = F.vcu; it < 64; it += G) mlstm_naive_item(F, it);
#else
    for (int rep_ = 0; rep_ < MK_REP_P3; ++rep_) {
    for (int it = F.vcu; it < 256; it += G) ml::mlstm_unit(F, it);
    __syncthreads();
#if defined(MK_NAIVE_ATTN)
    for (int it = F.vcu; it < 1024; it += G) attn_naive_item(F, it & 255, it >> 8);
#else
    for (int bh = F.vcu; bh < 256; bh += G) at::attn_ring(F, bh);
#endif
    }
#endif
    GRID_BAR();
    { pg8::Gemm g{F.YA(), F.WA_T(), T, D, D / 2}; pg8::StaticOrder S; S.init(T, D, G, cid);
      pg8::EpiGate<false> E{F.PROJ() + 7 * (SEG / 2), nullptr, F.M1(), 1.0f / W8SCALE};
      for (int rep_ = 0; rep_ < MK_REP_G4A; ++rep_) pg8::gemm_phase<pg8::EpiGate<false>, pg8::StaticOrder, true, true, false, true>(F.lds, g, S, E); }
#if defined(MK_NAIVE_MLSTM)
    VM_WAIT(); __syncthreads();
#else
    __syncthreads();
    mlstm_norm_rows(F);
    GRID_BAR();
#endif
    { pg8::Gemm g{F.YB8(), F.WB_T(), T, D, D / 2}; pg8::StaticOrder S; S.init(T, D, G, cid);
      pg8::EpiGate<true, true> E{F.PROJ() + 8 * (SEG / 2), F.M1(), F.MERGED(), 1.0f / W8SCALE};
      for (int rep_ = 0; rep_ < MK_REP_G4B; ++rep_) pg8::gemm_phase<pg8::EpiGate<true, true>, pg8::StaticOrder, true, true, false, true>(F.lds, g, S, E); }
    GRID_BAR();
    { pg8::Gemm g{F.MERGED(), F.WOUT_T(), T, D, D / 2}; pg8::StaticOrder S; S.init(T, D, G, cid);
      pg8::EpiResid E{F.x(), F.mod() + 2 * D, F.out(), SEQ, NMOD, 1.0f / W8SCALE};
      for (int rep_ = 0; rep_ < MK_REP_G4C; ++rep_) pg8::gemm_phase<pg8::EpiResid, pg8::StaticOrder, true, true, false, true>(F.lds, g, S, E); }
    GRID_BAR();
    p5a_route(F);
    GRID_BAR();
    p5b_tables(F);
    GRID_BAR();
    { pg8::Gemm g{F.H2(), F.W1_T(), T, NE * 2048, D / 2}; pg8::GroupedOrder S{(const LAS int*)(F.LC + LC_TS), 8, G, cid, F.row2tok()};
      pg8::EpiSwiglu<true> E{F.b1(), F.ACT(), 1.0f / W8SCALE};
      for (int rep_ = 0; rep_ < MK_REP_G6; ++rep_) pg8::gemm_phase<pg8::EpiSwiglu<true>, pg8::GroupedOrder, true, true, true, true>(F.lds, g, S, E); }
    GRID_BAR();
    { pg8::Gemm g{F.ACT(), F.W2_T(), XS_ROWS, NE * 1024, D / 2}; pg8::GroupedOrder S{(const LAS int*)(F.LC + LC_TS), 4, G, cid, nullptr};
      pg8::EpiOutS E{F.OUTR(), F.b2(), 1.0f / W8SCALE};
      for (int rep_ = 0; rep_ < MK_REP_G7; ++rep_) pg8::gemm_phase<pg8::EpiOutS, pg8::GroupedOrder, true, true, false, true>(F.lds, g, S, E); }
    GRID_BAR();
    { const bool poison = __hip_atomic_load(F.ctl + CW_BAR + XB_TMO, RLX_AGENT) != 0u;
      p8_combine(F, poison); }
}

extern "C" void kernel_launch(void* const* d_in, const int* in_sizes, int n_in, void* d_out, int out_size, void* d_ws, size_t ws_size, hipStream_t stream) {
    static int grid = 0;
    if (grid == 0) {
        if (n_in != 22 || in_sizes[0] != T * D || out_size != T * D || ws_size < WS_END) { fprintf(stderr, "kernel_launch: unexpected shapes (n_in %d, in0 %d, out %d, ws %zu)\n", n_in, n_in > 0 ? in_sizes[0] : -1, out_size, ws_size); grid = -1; return; }
        int dev = 0, cus = 0, per_cu = 0;
        if (hipGetDevice(&dev) != hipSuccess || hipDeviceGetAttribute(&cus, hipDeviceAttributeMultiprocessorCount, dev) != hipSuccess) { grid = -1; return; }
        if (hipFuncSetAttribute((const void*)mk_fwd, hipFuncAttributeMaxDynamicSharedMemorySize, LDS_BYTES) != hipSuccess) { fprintf(stderr, "kernel_launch: hipFuncSetAttribute failed\n"); grid = -1; return; }
        if (hipOccupancyMaxActiveBlocksPerMultiprocessor(&per_cu, (const void*)mk_fwd, NWAVES * 64, LDS_BYTES) != hipSuccess || per_cu < 1) { fprintf(stderr, "kernel_launch: occupancy query says %d blocks per CU\n", per_cu); }
        (void)hipGetLastError();
        if (cus < 256) { fprintf(stderr, "kernel_launch: built for a 256-CU device, found %d CUs\n", cus); grid = -1; return; }
        grid = 256;
    }
    if (grid < 0) return;
    if (hipMemsetAsync((char*)d_ws + WS_CTL, 0, CTL_ZERO_BYTES, stream) != hipSuccess) return;
    Args a{};
    for (int i = 0; i < 22; ++i) a.in[i] = (const float*)d_in[i];
    a.out = (float*)d_out; a.ws = (unsigned char*)d_ws;
    hipLaunchKernelGGL(mk_fwd, dim3(grid), dim3(NWAVES * 64), LDS_BYTES, stream, a);
}
```

```cpp
#include <hip/hip_runtime.h>
#include <cstdio>
#include <cstdint>
namespace pg8 {
#define PG8_LAS __attribute__((address_space(3)))
typedef unsigned short bf16_t;
typedef short bf16x8 __attribute__((ext_vector_type(8)));
typedef float f32x4 __attribute__((ext_vector_type(4)));
typedef unsigned u32x4 __attribute__((ext_vector_type(4)));
typedef int i32x4_ __attribute__((ext_vector_type(4))); typedef int i32x8_ __attribute__((ext_vector_type(8)));
constexpr int BM = 256, BK = 64, HALF = 128, HTB = HALF * BK * 2  , STAGE_BYTES = 8 * HTB, NXCD = 8, WGM = 8;

__host__ __device__ __forceinline__ int lds_byte(int r, int c) { const int st = (r >> 4) * 2 + (c >> 5), rr = r & 15, cc = c & 31, ob = rr * 64 + cc * 2; return st * 1024 + (ob ^ (((ob >> 9) & 1) << 5)); }
__host__ __device__ __forceinline__ void stage_rc(int b, int& R, int& C) { const int st = b / 1024, sb = b % 1024, swz = sb ^ (((sb >> 9) & 1) << 5); R = (st >> 1) * 16 + swz / 64; C = (st & 1) * 32 + (swz % 64) / 2; }
__host__ __device__ __forceinline__ int perm32(int rho) { const int n = rho >> 4, i = rho & 15; return 8 * (i >> 2) + 4 * n + (i & 3); }

struct Unit { int pm, pn; };
struct Gemm { const bf16_t* A; const bf16_t* Bt; int M, N, K; };

struct StaticOrder {
    int nM, nN, nwg, G, c;
    __host__ __device__ void init(int M, int N, int G_, int c_) { nM = M / BM; nN = N / BM; nwg = nM * nN; G = G_; c = c_; }
    __host__ __device__ bool next(int i, Unit& u) const {
        const long L = (long)i * G + c; if (L >= nwg) return false;
        int wgid = (int)L; { const int q = nwg / NXCD, r = nwg % NXCD, xcd = wgid % NXCD, off = wgid / NXCD; wgid = (xcd < r ? xcd * (q + 1) : r * (q + 1) + (xcd - r) * q) + off; }
        const int nig = WGM * nN, gid = wgid / nig, fm = gid * WGM, gsz = (nM - fm) < WGM ? (nM - fm) : WGM;
        u.pm = fm + ((wgid % nig) % gsz); u.pn = (wgid % nig) / gsz; return true;
    }
    __device__ __forceinline__ void a_ready(const Unit&) const {}
    __device__ __forceinline__ void done(const Unit&) const {}
};

__device__ __forceinline__ unsigned cvt_pk_bf16(float lo, float hi) { unsigned r; asm volatile("v_cvt_pk_bf16_f32 %0, %1, %2" : "=v"(r) : "v"(lo), "v"(hi)); return r; }
typedef float f32x2 __attribute__((ext_vector_type(2)));
__device__ __forceinline__ f32x2 gelu_pk(f32x2 v) {
    const f32x2 av = __builtin_elementwise_abs(v), d = av * 0.2316418882f + 1.0f;
    f32x2 t; t.x = __builtin_amdgcn_rcpf(d.x); t.y = __builtin_amdgcn_rcpf(d.y);
    f32x2 q = t * 0.5307027145f + (-0.7265760135f); q = q * t + 0.7107068705f; q = q * t + (-0.142248368f); q = q * t + 0.127414796f; q = q * t;
    const f32x2 s = (v * v) * (-0.72134752044f);
    f32x2 e; e.x = __builtin_amdgcn_exp2f(s.x); e.y = __builtin_amdgcn_exp2f(s.y);
    const f32x2 m = v * (q * e), r = v - m;
    f32x2 o; o.x = v.x < 0.f ? m.x : r.x; o.y = v.y < 0.f ? m.y : r.y; return o;
}

__device__ __forceinline__ void xchg8(const u32x4& w0, const u32x4& w1, u32x4& d1, u32x4& d2) {
#pragma unroll
    for (int i = 0; i < 4; ++i) {
        d1[i] = (unsigned)__builtin_amdgcn_update_dpp((int)w0[i], (int)w1[i], 0x128, 0xf, 0xc, false);
        d2[i] = (unsigned)__builtin_amdgcn_update_dpp((int)w1[i], (int)w0[i], 0x128, 0xf, 0x3, false);
    }
}
template <int ACT  > struct EpiBf16 {
    static constexpr bool PERM = true, PERM2 = true, AFTER_DRAIN = false; static_assert(ACT == 0 || ACT == 1, "EpiBf16: ACT is 0 (none) or 1 (gelu_pk)");
    bf16_t* O; int ldc; const float* bias; int split_cols; size_t split_stride; float scale0; float ascale;
    __device__ __forceinline__ void operator()(const f32x4 (&acc)[2][2][4][2], const Unit& u, int wr, int wc, int fr, int fq) const {
        int colt = u.pn * BM; bf16_t* base = O;
        float sc = ascale; if (split_cols) { const int t = colt / split_cols; base += (size_t)t * split_stride; colt -= t * split_cols; if (t == 0) sc = scale0 * ascale; }
        const int bcol0 = u.pn * BM + wc * 64 + 16 * fq;
        f32x4 bv[2][2];
#pragma unroll
        for (int bj = 0; bj < 2; ++bj)
#pragma unroll
            for (int n = 0; n < 2; ++n) bv[bj][n] = bias ? *(const f32x4*)(bias + bcol0 + 8 * bj + 4 * n) : (f32x4){0.f, 0.f, 0.f, 0.f};
        bf16_t* lp = base + (size_t)(u.pm * BM + wr * 64 + (fr & 7)) * ldc + colt + wc * 64 + 16 * fq + 8 * (fr >> 3);
#pragma unroll
        for (int ai = 0; ai < 2; ++ai)
#pragma unroll
            for (int m = 0; m < 4; ++m) { u32x4 w[2];
#pragma unroll
                for (int bj = 0; bj < 2; ++bj) { f32x4 v0 = acc[ai][bj][m][0] + bv[bj][0], v1 = acc[ai][bj][m][1] + bv[bj][1];
                    if (ACT == 1) { f32x2 a = gelu_pk((f32x2){v0[0], v0[1]}), b = gelu_pk((f32x2){v0[2], v0[3]}), c = gelu_pk((f32x2){v1[0], v1[1]}), d = gelu_pk((f32x2){v1[2], v1[3]});
                        v0 = (f32x4){a.x, a.y, b.x, b.y}; v1 = (f32x4){c.x, c.y, d.x, d.y}; }
                    v0 = v0 * sc; v1 = v1 * sc; w[bj].x = cvt_pk_bf16(v0[0], v0[1]); w[bj].y = cvt_pk_bf16(v0[2], v0[3]); w[bj].z = cvt_pk_bf16(v1[0], v1[1]); w[bj].w = cvt_pk_bf16(v1[2], v1[3]); }
                u32x4 d1, d2; xchg8(w[0], w[1], d1, d2);
                bf16_t* rowp = lp + (size_t)(ai * HALF + m * 16) * ldc;
                __builtin_nontemporal_store(d1, (u32x4*)rowp); __builtin_nontemporal_store(d2, (u32x4*)(rowp + (size_t)8 * ldc)); }
    }
};
template <class Epi, class Sched, bool ALIGN_EPI = false, bool SP2 = false, bool GATHER = false, bool FP8 = false>
__device__ __forceinline__ void gemm_phase(PG8_LAS unsigned char* lds, const Gemm g, const Sched& S, const Epi& E) {
    int tid_ = threadIdx.x; asm volatile("" : "+v"(tid_));
    const int tid = tid_, wid = __builtin_amdgcn_readfirstlane(tid >> 6), lane = tid & 63, wr = wid >> 2, wc = wid & 3, fr = lane & 15, fq = lane >> 4;
    const int K = g.K, nt = K / BK;
    unsigned voffA[2], voffB[2], vA0[2], vA1[2], vN0[2], vN1[2]; int Rr_[2], Cc_[2];
#pragma unroll
    for (int i = 0; i < 2; ++i) { int R, C; stage_rc(tid * 16 + i * 8192, R, C); const int Rb = Epi::PERM2 ? (64 * (R >> 5) + 16 * ((R >> 2) & 3) + 4 * ((R >> 4) & 1) + (R & 3)) : (Epi::PERM ? ((R & ~31) + perm32(R & 31)) : R);
        voffA[i] = (unsigned)(R * K + C) * 2u; voffB[i] = (unsigned)(Rb * K + C) * 2u; Rr_[i] = R; Cc_[i] = C; }
    const size_t kstep = (size_t)(BK * 2);
    const size_t hstep = (size_t)HALF * K * 2;
    const size_t tstep = 2 * hstep;
    const size_t bhstep = Epi::PERM2 ? (size_t)8 * K * 2 : hstep;
#pragma unroll
    for (int i = 0; i < 2; ++i) { vA0[i] = voffA[i]; vA1[i] = voffA[i] + (unsigned)hstep; vN0[i] = vA0[i]; vN1[i] = vA1[i]; }
#define PG8_GLOAD(u, v0, v1) do { _Pragma("unroll") for (int _i = 0; _i < 2; ++_i) { const int _t0 = S.rowtok[(u).pm * BM + Rr_[_i]], _t1 = S.rowtok[(u).pm * BM + HALF + Rr_[_i]]; \
        (v0)[_i] = (unsigned)_t0 * (unsigned)(K * 2) + (unsigned)(Cc_[_i] * 2); (v1)[_i] = (unsigned)_t1 * (unsigned)(K * 2) + (unsigned)(Cc_[_i] * 2); } } while (0)
    const unsigned ldsw = (unsigned)wid * 1024u;
    const int aoff = lds_byte(wr * 64 + fr, fq * 8), boff = lds_byte(wc * 32 + fr, fq * 8);
#define PG8_SA(b, h) (((b) * 2 + (h)) * HTB)
#define PG8_SB(b, h) ((4 + (b) * 2 + (h)) * HTB)
#define PG8_STAGE(bufoff, gbase, voff) do { _Pragma("unroll") for (int _i = 0; _i < 2; ++_i) \
        __builtin_amdgcn_global_load_lds((const unsigned*)((const char*)(gbase) + (voff)[_i]), (PG8_LAS unsigned*)(lds + (bufoff) + ldsw + _i * 8192), 16, 0, 0); } while (0)
#define PG8_LDA(dst, b, h) do { _Pragma("unroll") for (int m = 0; m < 4; ++m) _Pragma("unroll") for (int k = 0; k < 2; ++k) dst[m][k] = *(const PG8_LAS bf16x8*)(lds + PG8_SA(b, h) + aoff + m * 2048 + k * 1024); } while (0)
#define PG8_LDB(dst, b, h) do { _Pragma("unroll") for (int n = 0; n < 2; ++n) _Pragma("unroll") for (int k = 0; k < 2; ++k) dst[n][k] = *(const PG8_LAS bf16x8*)(lds + PG8_SB(b, h) + boff + n * 2048 + k * 1024); } while (0)
#define PG8_MMA(ai, bj, At, Bt) do { __builtin_amdgcn_s_setprio(1); _Pragma("unroll") for (int m = 0; m < 4; ++m) _Pragma("unroll") for (int n = 0; n < 2; ++n) _Pragma("unroll") for (int k = 0; k < 2; ++k) \
        acc[ai][bj][m][n] = __builtin_amdgcn_mfma_f32_16x16x32_bf16(Bt[n][k], At[m][k], acc[ai][bj][m][n], 0, 0, 0); __builtin_amdgcn_s_setprio(0); } while (0)
#define PG8_CAT8(x0, x1) __builtin_shufflevector(__builtin_bit_cast(i32x4_, x0), __builtin_bit_cast(i32x4_, x1), 0, 1, 2, 3, 4, 5, 6, 7)
#define PG8_MFMA8(ACC, B8, A8) asm volatile("s_nop 1\n\tv_mfma_scale_f32_16x16x128_f8f6f4 %0, %1, %2, %0, %3, %3 op_sel_hi:[0,0,0]" : "+v"(ACC) : "v"(B8), "v"(A8), "v"(sc8_))
#define PG8_MMA8(ai, bj, At, Bt) do { i32x8_ a8_[4], b8_[2]; _Pragma("unroll") for (int m = 0; m < 4; ++m) a8_[m] = PG8_CAT8(At[m][0], At[m][1]); _Pragma("unroll") for (int n = 0; n < 2; ++n) b8_[n] = PG8_CAT8(Bt[n][0], Bt[n][1]); \
        __builtin_amdgcn_s_setprio(1); _Pragma("unroll") for (int m = 0; m < 4; ++m) _Pragma("unroll") for (int n = 0; n < 2; ++n) PG8_MFMA8(acc[ai][bj][m][n], b8_[n], a8_[m]); __builtin_amdgcn_s_setprio(0); } while (0)
#define PG8_MM(ai, bj, At, Bt) do { if constexpr (FP8) PG8_MMA8(ai, bj, At, Bt); else PG8_MMA(ai, bj, At, Bt); } while (0)
#define PG8_WAIT_V(n) asm volatile("s_waitcnt vmcnt(" #n ")" ::: "memory")
#define PG8_WAIT_L(n) asm volatile("s_waitcnt lgkmcnt(" #n ")" ::: "memory")
#define PG8_BAR __builtin_amdgcn_s_barrier()
#define PG8_SCHED __builtin_amdgcn_sched_barrier(0)
    const int sc8_ = 0x7F7F7F7F;
    Unit cur, nxt; int ui = 0;
    if (!S.next(0, cur)) return;
    f32x4 acc[2][2][4][2];
#pragma unroll
    for (int a = 0; a < 2; ++a)
#pragma unroll
        for (int b = 0; b < 2; ++b)
#pragma unroll
            for (int m = 0; m < 4; ++m)
#pragma unroll
                for (int n = 0; n < 2; ++n) acc[a][b][m][n] = (f32x4){0.f, 0.f, 0.f, 0.f};
    bf16x8 At[4][2], B0[2][2], B1[2][2];
    if constexpr (GATHER) PG8_GLOAD(cur, vA0, vA1);
    const char* cA = GATHER ? (const char*)g.A : (const char*)g.A + (size_t)cur.pm * tstep; const char* cB = (const char*)g.Bt + (size_t)cur.pn * tstep;
    S.a_ready(cur);
    if constexpr (SP2) {
        PG8_STAGE(PG8_SB(0, 0), cB, voffB); PG8_STAGE(PG8_SB(0, 1), cB + bhstep, voffB); PG8_STAGE(PG8_SA(0, 0), cA, vA0); PG8_STAGE(PG8_SA(0, 1), cA, vA1);
        if (wr == 1) PG8_BAR;
        PG8_WAIT_V(2); PG8_BAR;
        PG8_STAGE(PG8_SB(1, 0), cB + kstep, voffB); PG8_STAGE(PG8_SA(1, 0), cA + kstep, vA0); PG8_STAGE(PG8_SB(1, 1), cB + bhstep + kstep, voffB);
        PG8_WAIT_V(6); PG8_BAR;
    } else {
        PG8_STAGE(PG8_SB(0, 0), cB, voffB); PG8_STAGE(PG8_SA(0, 0), cA, vA0); PG8_STAGE(PG8_SB(0, 1), cB + bhstep, voffB); PG8_STAGE(PG8_SA(0, 1), cA, vA1);
        if (wr == 1) PG8_BAR;
        PG8_WAIT_V(4); PG8_BAR;
        PG8_STAGE(PG8_SB(1, 0), cB + kstep, voffB); PG8_STAGE(PG8_SA(1, 0), cA + kstep, vA0); PG8_STAGE(PG8_SB(1, 1), cB + bhstep + kstep, voffB);
        PG8_WAIT_V(6); PG8_BAR;
    }
    for (;;) {
        const bool has_next = S.next(ui + 1, nxt);
        if constexpr (GATHER) { if (has_next) PG8_GLOAD(nxt, vN0, vN1); else { _Pragma("unroll") for (int i = 0; i < 2; ++i) { vN0[i] = vA0[i]; vN1[i] = vA1[i]; } } }
        const char* nA = GATHER ? (const char*)g.A : (has_next ? (const char*)g.A + (size_t)nxt.pm * tstep : cA); const char* nB = has_next ? (const char*)g.Bt + (size_t)nxt.pn * tstep : cB;
        for (int t = 0; t < nt; t += 2) {
            const bool last = (t == nt - 2);
            const char* a1 = cA + (size_t)(t + 1) * kstep;
            const char* a2 = last ? nA : cA + (size_t)(t + 2) * kstep; const char* b2 = last ? nB : cB + (size_t)(t + 2) * kstep;
            const char* a3 = a2 + kstep; const char* b3 = b2 + kstep;
            unsigned vX0[2], vX1[2];
#pragma unroll
            for (int i = 0; i < 2; ++i) { vX0[i] = (GATHER && last) ? vN0[i] : vA0[i]; vX1[i] = (GATHER && last) ? vN1[i] : vA1[i]; }
            if (last && has_next) S.a_ready(nxt);
            if constexpr (SP2) {
            PG8_LDB(B0, 0, 0); PG8_LDB(B1, 0, 1); PG8_SCHED; PG8_LDA(At, 0, 0); PG8_STAGE(PG8_SA(1, 1), a1, vA1);
            PG8_WAIT_V(8); PG8_WAIT_L(0); PG8_BAR; PG8_MM(0, 0, At, B0); PG8_MM(0, 1, At, B1); PG8_BAR; PG8_SCHED;
            PG8_LDA(At, 0, 1); PG8_STAGE(PG8_SB(0, 0), b2, voffB); PG8_STAGE(PG8_SB(0, 1), b2 + bhstep, voffB); PG8_STAGE(PG8_SA(0, 0), a2, vX0);
            PG8_WAIT_V(8); PG8_WAIT_L(0); PG8_BAR; PG8_MM(1, 0, At, B0); PG8_MM(1, 1, At, B1); PG8_BAR; PG8_SCHED;
            PG8_LDB(B0, 1, 0); PG8_LDB(B1, 1, 1); PG8_SCHED; PG8_LDA(At, 1, 0); PG8_STAGE(PG8_SA(0, 1), a2, vX1);
            PG8_WAIT_V(8); PG8_WAIT_L(0); PG8_BAR; PG8_MM(0, 0, At, B0); PG8_MM(0, 1, At, B1); PG8_BAR; PG8_SCHED;
            PG8_LDA(At, 1, 1); PG8_STAGE(PG8_SB(1, 0), b3, voffB); PG8_STAGE(PG8_SB(1, 1), b3 + bhstep, voffB); PG8_STAGE(PG8_SA(1, 0), a3, vX0);
            PG8_WAIT_V(8); PG8_WAIT_L(0); PG8_BAR; PG8_MM(1, 0, At, B0); PG8_MM(1, 1, At, B1); PG8_BAR; PG8_SCHED;
            } else {
            PG8_LDB(B0, 0, 0); PG8_SCHED; PG8_LDA(At, 0, 0); PG8_STAGE(PG8_SA(1, 1), a1, vA1);
            PG8_WAIT_L(8); PG8_BAR; PG8_WAIT_L(0); PG8_MM(0, 0, At, B0); PG8_BAR; PG8_SCHED;
            PG8_LDB(B1, 0, 1); PG8_STAGE(PG8_SB(0, 0), b2, voffB);
            PG8_BAR; PG8_WAIT_L(0); PG8_MM(0, 1, At, B1); PG8_BAR;
            PG8_LDA(At, 0, 1); PG8_STAGE(PG8_SA(0, 0), a2, vX0);
            PG8_BAR; PG8_WAIT_L(0); PG8_MM(1, 0, At, B0); PG8_BAR; PG8_SCHED;
            PG8_STAGE(PG8_SB(0, 1), b2 + bhstep, voffB);
            PG8_WAIT_V(6); PG8_BAR; PG8_MM(1, 1, At, B1); PG8_BAR;
            PG8_LDB(B0, 1, 0); PG8_SCHED; PG8_LDA(At, 1, 0); PG8_STAGE(PG8_SA(0, 1), a2, vX1);
            PG8_WAIT_L(8); PG8_BAR; PG8_WAIT_L(0); PG8_MM(0, 0, At, B0); PG8_BAR; PG8_SCHED;
            PG8_LDB(B1, 1, 1); PG8_STAGE(PG8_SB(1, 0), b3, voffB);
            PG8_BAR; PG8_WAIT_L(0); PG8_MM(0, 1, At, B1); PG8_BAR;
            PG8_LDA(At, 1, 1); PG8_STAGE(PG8_SA(1, 0), a3, vX0);
            PG8_BAR; PG8_WAIT_L(0); PG8_MM(1, 0, At, B0); PG8_BAR; PG8_SCHED;
            PG8_STAGE(PG8_SB(1, 1), b3 + bhstep, voffB);
            PG8_WAIT_V(6); PG8_BAR; PG8_MM(1, 1, At, B1); PG8_BAR;
            }
        }
        if constexpr (ALIGN_EPI) { if (wr == 0) PG8_BAR; }
        if constexpr (FP8) asm volatile("s_nop 15\n\ts_nop 15" ::: "memory");
        if constexpr (!Epi::AFTER_DRAIN) { E(acc, cur, wr, wc, fr, fq); S.done(cur); }
        if (!has_next) break;
#pragma unroll
        for (int a = 0; a < 2; ++a)
#pragma unroll
            for (int b = 0; b < 2; ++b)
#pragma unroll
                for (int m = 0; m < 4; ++m)
#pragma unroll
                    for (int n = 0; n < 2; ++n) acc[a][b][m][n] = (f32x4){0.f, 0.f, 0.f, 0.f};
        cur = nxt; cA = nA; cB = nB; ++ui;
        if constexpr (GATHER) { _Pragma("unroll") for (int i = 0; i < 2; ++i) { vA0[i] = vN0[i]; vA1[i] = vN1[i]; } }
        if constexpr (ALIGN_EPI) { if (wr == 1) PG8_BAR; }
    }
    PG8_WAIT_V(0);
    if constexpr (!ALIGN_EPI) { if (wr == 0) PG8_BAR; }
    PG8_BAR;
    if constexpr (Epi::AFTER_DRAIN) { E.fused(acc, cur, wr, wc, fr, fq, lds, wid, lane); S.done(cur); }
#undef PG8_SA
#undef PG8_SB
#undef PG8_STAGE
#undef PG8_GLOAD
#undef PG8_LDA
#undef PG8_LDB
#undef PG8_MMA
#undef PG8_MMA8
#undef PG8_MFMA8
#undef PG8_MM
#undef PG8_CAT8
#undef PG8_WAIT_V
#undef PG8_WAIT_L
#undef PG8_BAR
#undef PG8_SCHED
}
}
namespace pg8 {
__device__ __forceinline__ float bf_lo(unsigned w) { return __builtin_bit_cast(float, w << 16); }
__device__ __forceinline__ float bf_hi(unsigned w) { return __builtin_bit_cast(float, w & 0xffff0000u); }
__device__ __forceinline__ unsigned pk4_fp8(float a, float b, float c, float d) { int r = 0; r = __builtin_amdgcn_cvt_pk_fp8_f32(a, b, r, false); r = __builtin_amdgcn_cvt_pk_fp8_f32(c, d, r, true); return (unsigned)r; }
__device__ __forceinline__ float sigmoid_f(float x) { return __builtin_amdgcn_rcpf(1.0f + __expf(-x)); }

template <bool ADD, bool OUT8 = false> struct EpiGate {
    static constexpr bool PERM = true, PERM2 = true, AFTER_DRAIN = false;
    const bf16_t* G; const bf16_t* Min; bf16_t* O; float ascale;
    __device__ __forceinline__ void operator()(const f32x4 (&acc)[2][2][4][2], const Unit& u, int wr, int wc, int fr, int fq) const {
        const int row0 = u.pm * BM + wr * 64 + fr, col0 = u.pn * BM + wc * 64 + 16 * fq;
        bf16_t* lp = O + (size_t)(u.pm * BM + wr * 64 + (fr & 7)) * 1024 + col0 + 8 * (fr >> 3);
#pragma unroll
        for (int ai = 0; ai < 2; ++ai)
#pragma unroll
            for (int m = 0; m < 4; ++m) { const size_t off = (size_t)(row0 + ai * HALF + m * 16) * 1024 + col0; u32x4 w[2]; unsigned w8[4];
#pragma unroll
                for (int bj = 0; bj < 2; ++bj) {
                    const u32x4 g = *(const u32x4*)(G + off + 8 * bj);
                    f32x4 v0 = acc[ai][bj][m][0] * ascale, v1 = acc[ai][bj][m][1] * ascale;
                    v0[0] *= sigmoid_f(bf_lo(g.x)); v0[1] *= sigmoid_f(bf_hi(g.x)); v0[2] *= sigmoid_f(bf_lo(g.y)); v0[3] *= sigmoid_f(bf_hi(g.y));
                    v1[0] *= sigmoid_f(bf_lo(g.z)); v1[1] *= sigmoid_f(bf_hi(g.z)); v1[2] *= sigmoid_f(bf_lo(g.w)); v1[3] *= sigmoid_f(bf_hi(g.w));
                    if (ADD) { const u32x4 p = *(const u32x4*)(Min + off + 8 * bj);
                        v0[0] += bf_lo(p.x); v0[1] += bf_hi(p.x); v0[2] += bf_lo(p.y); v0[3] += bf_hi(p.y);
                        v1[0] += bf_lo(p.z); v1[1] += bf_hi(p.z); v1[2] += bf_lo(p.w); v1[3] += bf_hi(p.w); }
                    if constexpr (OUT8) { w8[2 * bj] = pk4_fp8(v0[0], v0[1], v0[2], v0[3]); w8[2 * bj + 1] = pk4_fp8(v1[0], v1[1], v1[2], v1[3]); }
                    else { w[bj].x = cvt_pk_bf16(v0[0], v0[1]); w[bj].y = cvt_pk_bf16(v0[2], v0[3]); w[bj].z = cvt_pk_bf16(v1[0], v1[1]); w[bj].w = cvt_pk_bf16(v1[2], v1[3]); } }
                if constexpr (OUT8) { const u32x4 o = {w8[0], w8[1], w8[2], w8[3]}; __builtin_nontemporal_store(o, (u32x4*)((unsigned char*)O + off)); }
                else { u32x4 d1, d2; xchg8(w[0], w[1], d1, d2); bf16_t* rowp = lp + (size_t)(ai * HALF + m * 16) * 1024;
                    __builtin_nontemporal_store(d1, (u32x4*)rowp); __builtin_nontemporal_store(d2, (u32x4*)(rowp + 8 * 1024)); } }
    }
};

struct EpiResid {
    static constexpr bool PERM = false, PERM2 = false, AFTER_DRAIN = false;
    const float* X; const float* gate; float* out; int rows_per_batch; int gstride; float ascale;
    __device__ __forceinline__ void operator()(const f32x4 (&acc)[2][2][4][2], const Unit& u, int wr, int wc, int fr, int fq) const {
        const int col0 = u.pn * BM + wc * 32 + 4 * fq;
#pragma unroll
        for (int ai = 0; ai < 2; ++ai)
#pragma unroll
            for (int m = 0; m < 4; ++m) { const int row = u.pm * BM + ai * HALF + wr * 64 + m * 16 + fr; const size_t off = (size_t)row * 1024 + col0;
                const float* gp = gate + (size_t)(row / rows_per_batch) * gstride + col0;
#pragma unroll
                for (int bj = 0; bj < 2; ++bj)
#pragma unroll
                    for (int n = 0; n < 2; ++n) { const f32x4 xv = *(const f32x4*)(X + off + bj * HALF + n * 16); const f32x4 gv = *(const f32x4*)(gp + bj * HALF + n * 16);
                        *(f32x4*)(out + off + bj * HALF + n * 16) = xv + gv * (acc[ai][bj][m][n] * ascale); } }
    }
};

__device__ __forceinline__ float swiglu1(float g, float l) {
    g = fminf(g, 7.0f); l = fminf(fmaxf(l, -7.0f), 7.0f);
    return (l + 1.0f) * (g * __builtin_amdgcn_rcpf(1.0f + __expf(-1.702f * g)));
}
template <bool OUT8> struct EpiSwiglu {
    static constexpr bool PERM = true, PERM2 = false, AFTER_DRAIN = false;
    const float* b1; bf16_t* O; float ascale;
    __device__ __forceinline__ void operator()(const f32x4 (&acc)[2][2][4][2], const Unit& u, int wr, int wc, int fr, int fq) const {
        const int e = u.pn >> 3, pl = u.pn & 7, jc = wc * 32 + 8 * fq;
        const float* bg = b1 + (size_t)e * 2048 + 128 * pl + jc; const float* bl = bg + 1024;
        const f32x4 bg0 = *(const f32x4*)bg, bg1 = *(const f32x4*)(bg + 4), bl0 = *(const f32x4*)bl, bl1 = *(const f32x4*)(bl + 4);
        const int row0 = u.pm * BM + wr * 64 + fr;
#pragma unroll
        for (int ai = 0; ai < 2; ++ai)
#pragma unroll
            for (int m = 0; m < 4; ++m) {
                const f32x4 g0 = acc[ai][0][m][0] * ascale + bg0, g1 = acc[ai][0][m][1] * ascale + bg1, l0 = acc[ai][1][m][0] * ascale + bl0, l1 = acc[ai][1][m][1] * ascale + bl1;
                if constexpr (OUT8) { typedef unsigned u32x2_ __attribute__((ext_vector_type(2))); u32x2_ w;
                    w.x = pk4_fp8(swiglu1(g0[0], l0[0]), swiglu1(g0[1], l0[1]), swiglu1(g0[2], l0[2]), swiglu1(g0[3], l0[3])); w.y = pk4_fp8(swiglu1(g1[0], l1[0]), swiglu1(g1[1], l1[1]), swiglu1(g1[2], l1[2]), swiglu1(g1[3], l1[3]));
                    __builtin_nontemporal_store(w, (u32x2_*)((unsigned char*)O + (size_t)(row0 + ai * HALF + m * 16) * 1024 + 128 * pl + jc)); }
                else { u32x4 w; w.x = cvt_pk_bf16(swiglu1(g0[0], l0[0]), swiglu1(g0[1], l0[1])); w.y = cvt_pk_bf16(swiglu1(g0[2], l0[2]), swiglu1(g0[3], l0[3]));
                    w.z = cvt_pk_bf16(swiglu1(g1[0], l1[0]), swiglu1(g1[1], l1[1])); w.w = cvt_pk_bf16(swiglu1(g1[2], l1[2]), swiglu1(g1[3], l1[3]));
                    __builtin_nontemporal_store(w, (u32x4*)(O + (size_t)(row0 + ai * HALF + m * 16) * 1024 + 128 * pl + jc)); } }
    }
};

struct EpiOutS {
    static constexpr bool PERM = true, PERM2 = true, AFTER_DRAIN = false;
    bf16_t* O; const float* bias; float ascale;
    __device__ __forceinline__ void operator()(const f32x4 (&acc)[2][2][4][2], const Unit& u, int wr, int wc, int fr, int fq) const {
        const int bcol0 = u.pn * BM + wc * 64 + 16 * fq;
        f32x4 bv[2][2];
#pragma unroll
        for (int bj = 0; bj < 2; ++bj)
#pragma unroll
            for (int n = 0; n < 2; ++n) bv[bj][n] = *(const f32x4*)(bias + bcol0 + 8 * bj + 4 * n);
        bf16_t* lp = O + (size_t)(u.pm * BM + wr * 64 + (fr & 7)) * 1024 + (u.pn & 3) * BM + wc * 64 + 16 * fq + 8 * (fr >> 3);
#pragma unroll
        for (int ai = 0; ai < 2; ++ai)
#pragma unroll
            for (int m = 0; m < 4; ++m) { u32x4 w[2];
#pragma unroll
                for (int bj = 0; bj < 2; ++bj) { const f32x4 v0 = acc[ai][bj][m][0] * ascale + bv[bj][0], v1 = acc[ai][bj][m][1] * ascale + bv[bj][1];
                    w[bj].x = cvt_pk_bf16(v0[0], v0[1]); w[bj].y = cvt_pk_bf16(v0[2], v0[3]); w[bj].z = cvt_pk_bf16(v1[0], v1[1]); w[bj].w = cvt_pk_bf16(v1[2], v1[3]); }
                u32x4 d1, d2; xchg8(w[0], w[1], d1, d2);
                bf16_t* rowp = lp + (size_t)(ai * HALF + m * 16) * 1024;
                __builtin_nontemporal_store(d1, (u32x4*)rowp); __builtin_nontemporal_store(d2, (u32x4*)(rowp + 8 * 1024)); }
    }
};

struct GroupedOrder {
    const PG8_LAS int* ts; int NT, G, c; const int* rowtok;
    __device__ __forceinline__ bool next(int i, Unit& u) const {
        const int total = __builtin_amdgcn_readfirstlane(ts[32]) * NT; const long L = (long)i * G + c; if (L >= total) return false;
        const int pm = (int)L / NT, pl = (int)L % NT; int e = 0;
#pragma unroll 1
        for (int j = 1; j < 32; ++j) e += (pm >= ts[j]) ? 1 : 0;
        u.pm = __builtin_amdgcn_readfirstlane(pm); u.pn = __builtin_amdgcn_readfirstlane(e * NT + pl); return true;
    }
    __device__ __forceinline__ void a_ready(const Unit&) const {}
    __device__ __forceinline__ void done(const Unit&) const {}
};
}
#define GAS __attribute__((address_space(1)))
#define LAS __attribute__((address_space(3)))
typedef unsigned short bf16;
typedef unsigned v4u __attribute__((ext_vector_type(4)));
typedef float f32x4 __attribute__((ext_vector_type(4)));
typedef short bf16x8 __attribute__((ext_vector_type(8)));
typedef GAS unsigned gu32;
typedef GAS unsigned long long gu64;
#define RLX_AGENT __ATOMIC_RELAXED, __HIP_MEMORY_SCOPE_AGENT
#define LDS_WAIT() asm volatile("s_waitcnt lgkmcnt(0)" ::: "memory")
#define VM_WAIT() asm volatile("s_waitcnt vmcnt(0)" ::: "memory")
__device__ __forceinline__ unsigned long long rt() { return __builtin_amdgcn_s_memrealtime(); }
__device__ __forceinline__ unsigned f2bf(float f) { unsigned u = __builtin_bit_cast(unsigned, f); return (u + 0x7fffu + ((u >> 16) & 1u)) >> 16; }
typedef float f32x2_pk __attribute__((ext_vector_type(2))); typedef __bf16 bf16x2_pk __attribute__((ext_vector_type(2)));
__device__ __forceinline__ unsigned pk2(float lo, float hi) { const f32x2_pk v = {lo, hi}; return __builtin_bit_cast(unsigned, __builtin_convertvector(v, bf16x2_pk)); }

#define XB_TMO      128
#define XB_XCNT(j)  (256  + 64 * (j))
#define XB_XSUB(j)  (1280 + 64 * (j))
#define XB_XGEN(j)  (2304 + 64 * (j))
#define XB_TOP      3328
#define XB_TOPGEN   3392
#define XCD_BAR_WORDS 3456
#define XB_SPIN_CAP (1u << 18)

__device__ __forceinline__ unsigned xb_ld(unsigned* p)              { return __hip_atomic_load(p, __ATOMIC_RELAXED, __HIP_MEMORY_SCOPE_AGENT); }
__device__ __forceinline__ unsigned xb_add(unsigned* p, unsigned v) { return __hip_atomic_fetch_add(p, v, __ATOMIC_RELAXED, __HIP_MEMORY_SCOPE_AGENT); }
__device__ __forceinline__ unsigned xb_xcc_id() { return (unsigned)__builtin_amdgcn_s_getreg((3 << 11) | 20) & 0xFu; }
#define XB_SPIN(cond, bar) do { unsigned _sp = 0; while (cond) { __builtin_amdgcn_s_sleep(1); \
    if ((++_sp & 255u) == 0u) { if (xb_ld(&(bar)[XB_TMO])) break; if (_sp > XB_SPIN_CAP) { atomicAdd(&(bar)[XB_TMO], 1u); break; } } } } while (0)

struct XcdBarrier {
    unsigned* bar; unsigned x;
    volatile LAS unsigned* st;
};

__device__ __forceinline__ XcdBarrier xcd_barrier_post(unsigned* bar, volatile LAS unsigned* st) {
    XcdBarrier b; b.bar = bar; b.x = xb_xcc_id(); b.st = st;
    if (threadIdx.x == 0) (void)xb_add(&bar[XB_XCNT(b.x)], 1u);
    return b;
}
__device__ __forceinline__ void xcd_barrier_complete(unsigned* bar, unsigned x, unsigned& nloc, unsigned& nx) {
    const unsigned G = gridDim.x * gridDim.y * gridDim.z;
    unsigned sum, cnt, mine, sp = 0u;
    for (;;) {
        sum = 0u; cnt = 0u; mine = 0u;
#pragma unroll
        for (unsigned j = 0; j < 16; ++j) { const unsigned c = xb_ld(&bar[XB_XCNT(j)]); sum += c; cnt += (c > 0u) ? 1u : 0u; mine = (j == x) ? c : mine; }
        if (sum == G) break;
        __builtin_amdgcn_s_sleep(1);
        if ((++sp & 255u) == 0u) { if (xb_ld(&bar[XB_TMO])) break; if (sp > XB_SPIN_CAP) { atomicAdd(&bar[XB_TMO], 1u); break; } }
    }
    nloc = mine > 0u ? mine : 1u; nx = cnt > 0u ? cnt : 1u;
}

__device__ __forceinline__ void xcd_barrier(const XcdBarrier& b) {
    asm volatile("s_waitcnt vmcnt(0)" ::: "memory");
    __syncthreads();
    if (threadIdx.x == 0) {
        unsigned* bar = b.bar;
        __builtin_amdgcn_s_waitcnt(0);
        unsigned nloc = b.st[0], nx = b.st[1];
        if (nloc == 0u) { xcd_barrier_complete(bar, b.x, nloc, nx); b.st[0] = nloc; b.st[1] = nx; }
        const unsigned old = xb_add(&bar[XB_XSUB(b.x)], 1u);
        const unsigned gen = old / nloc;
        if (old + 1u == (gen + 1u) * nloc) {
            __builtin_amdgcn_fence(__ATOMIC_RELEASE, "agent");
            asm volatile("s_waitcnt vmcnt(0)" ::: "memory");
            const unsigned og = xb_add(&bar[XB_TOP], 1u);
            const unsigned tg = og / nx;
            if (og + 1u == (tg + 1u) * nx) xb_add(&bar[XB_TOPGEN], 1u);
            else XB_SPIN(xb_ld(&bar[XB_TOPGEN]) == tg, bar);
            __builtin_amdgcn_fence(__ATOMIC_ACQUIRE, "agent");
            xb_add(&bar[XB_XGEN(b.x)], 1u);
            asm volatile("s_waitcnt vmcnt(0)" ::: "memory");
        } else {
            XB_SPIN(xb_ld(&bar[XB_XGEN(b.x)]) == gen, bar);
            __builtin_amdgcn_fence(__ATOMIC_ACQUIRE, "agent");
            asm volatile("s_waitcnt vmcnt(0)" ::: "memory");
        }
    }
    __syncthreads();
}

constexpr int NWAVES = 8;
constexpr int BATCH = 16, SEQ = 2048, D = 1024, T = BATCH * SEQ;
constexpr int NIN = 9224, NPROJ = 9216, NMOD = 6 * D;
constexpr int NE = 32, TOPK = 4;
constexpr int XS_ROWS = T * TOPK + NE * 256;
constexpr float EPS = 1e-6f;
constexpr float ATT_RTHR = -120.0f;
constexpr float W8SCALE = 64.0f;
constexpr float QSCALE = 0.125f * 1.4426950408889634f;

constexpr size_t MiB = 1u << 20;
constexpr size_t WS_CTL = 0, CTL_ZERO_BYTES = 1 * MiB;
constexpr size_t WS_MODP = 1 * MiB;
constexpr size_t WS_MOD = 3 * MiB;
constexpr size_t WS_IPRE = 4 * MiB, WS_LF = 4 * MiB + 512 * 1024;
constexpr size_t WS_TOKE = 5 * MiB, WS_TOKP = 5 * MiB + 512 * 1024, WS_TOKW = 6 * MiB, WS_TOKROW = 6 * MiB + 512 * 1024, WS_RSTD = 7 * MiB;
constexpr size_t WS_WIN = 8 * MiB, WS_WA = 26 * MiB, WS_WB = 28 * MiB, WS_WOUT = 30 * MiB, WS_W1 = 32 * MiB, WS_W2 = 160 * MiB;
constexpr size_t WS_H1 = 224 * MiB;
constexpr size_t WS_PROJ = 288 * MiB, SEG = 64 * MiB;
constexpr size_t WS_YB = 864 * MiB;
constexpr size_t WS_XS = 288 * MiB, WS_ACT = 560 * MiB;
constexpr size_t WS_ROW2TOK = 7 * MiB + 128 * 1024;
constexpr size_t WS_GT = 928 * MiB;
constexpr size_t WS_END = 932 * MiB;
static_assert(WS_XS + (size_t)XS_ROWS * 2048 <= WS_ACT && WS_ACT + (size_t)XS_ROWS * 2048 <= WS_YB, "ws map");
constexpr int CW_TMO = 0, CW_BAR = 4096, CW_ECNT = 8192;

constexpr int RING_BYTES = 131072, LDS_BYTES = 147456, LDSCTL_OFF = 146432;
constexpr int LC_BAR = 0, LC_TS = 16, LC_LCNT = 64, LC_GBASE = 96, LC_PS = 128, LC_CNT = 160;

__device__ __forceinline__ unsigned long long karg(int i) { return ((const __attribute__((address_space(4))) unsigned long long*)__builtin_amdgcn_kernarg_segment_ptr())[i]; }
struct Frame {
    LAS unsigned char* lds; volatile LAS unsigned* LC;
    gu32* ctl; unsigned char* ws; int tid, lane, wave, vcu, G;
    __device__ __forceinline__ const float* x() const { return (const float*)(const GAS float*)karg(0); }
    __device__ __forceinline__ const float* c() const { return (const float*)(const GAS float*)karg(1); }
    __device__ __forceinline__ const float* ada_w() const { return (const float*)(const GAS float*)karg(2); }
    __device__ __forceinline__ const float* ada_b() const { return (const float*)(const GAS float*)karg(3); }
    __device__ __forceinline__ const float* norm1_g() const { return (const float*)(const GAS float*)karg(4); }
    __device__ __forceinline__ const float* w_in() const { return (const float*)(const GAS float*)karg(5); }
    __device__ __forceinline__ const float* conv_w() const { return (const float*)(const GAS float*)karg(6); }
    __device__ __forceinline__ const float* conv_b() const { return (const float*)(const GAS float*)karg(7); }
    __device__ __forceinline__ const float* b_i() const { return (const float*)(const GAS float*)karg(8); }
    __device__ __forceinline__ const float* b_f() const { return (const float*)(const GAS float*)karg(9); }
    __device__ __forceinline__ const float* ml_norm_g() const { return (const float*)(const GAS float*)karg(10); }
    __device__ __forceinline__ const float* w_a() const { return (const float*)(const GAS float*)karg(11); }
    __device__ __forceinline__ const float* w_b() const { return (const float*)(const GAS float*)karg(12); }
    __device__ __forceinline__ const float* w_out() const { return (const float*)(const GAS float*)karg(13); }
    __device__ __forceinline__ const float* norm2_g() const { return (const float*)(const GAS float*)karg(14); }
    __device__ __forceinline__ const float* router_w() const { return (const float*)(const GAS float*)karg(15); }
    __device__ __forceinline__ const float* router_b() const { return (const float*)(const GAS float*)karg(16); }
    __device__ __forceinline__ const float* w1() const { return (const float*)(const GAS float*)karg(17); }
    __device__ __forceinline__ const float* b1() const { return (const float*)(const GAS float*)karg(18); }
    __device__ __forceinline__ const float* w2() const { return (const float*)(const GAS float*)karg(19); }
    __device__ __forceinline__ const float* b2() const { return (const float*)(const GAS float*)karg(20); }
    __device__ __forceinline__ const float* final_g() const { return (const float*)(const GAS float*)karg(21); }
    __device__ __forceinline__ float* out() const { return (float*)(GAS float*)karg(22); }
    __device__ __forceinline__ float* modp() const { return (float*)(ws + WS_MODP); }
    __device__ __forceinline__ float* mod() const { return (float*)(ws + WS_MOD); }
    __device__ __forceinline__ float* ipre() const { return (float*)(ws + WS_IPRE); }
    __device__ __forceinline__ float* lf() const { return (float*)(ws + WS_LF); }
    __device__ __forceinline__ float* tokw() const { return (float*)(ws + WS_TOKW); }
    __device__ __forceinline__ float* rstd2() const { return (float*)(ws + WS_RSTD); }
    __device__ __forceinline__ int* toke() const { return (int*)(ws + WS_TOKE); }
    __device__ __forceinline__ int* tokp() const { return (int*)(ws + WS_TOKP); }
    __device__ __forceinline__ int* tokrow() const { return (int*)(ws + WS_TOKROW); }
    __device__ __forceinline__ bf16* WIN_T() const { return (bf16*)(ws + WS_WIN); }
    __device__ __forceinline__ bf16* WA_T() const { return (bf16*)(ws + WS_WA); }
    __device__ __forceinline__ bf16* WB_T() const { return (bf16*)(ws + WS_WB); }
    __device__ __forceinline__ bf16* WOUT_T() const { return (bf16*)(ws + WS_WOUT); }
    __device__ __forceinline__ bf16* W1_T() const { return (bf16*)(ws + WS_W1); }
    __device__ __forceinline__ bf16* W2_T() const { return (bf16*)(ws + WS_W2); }
    __device__ __forceinline__ bf16* H1() const { return (bf16*)(ws + WS_H1); }
    __device__ __forceinline__ bf16* PROJ() const { return (bf16*)(ws + WS_PROJ); }
    __device__ __forceinline__ bf16* YA() const { return (bf16*)(ws + WS_H1); }
    __device__ __forceinline__ bf16* YB() const { return (bf16*)(ws + WS_YB); }
    __device__ __forceinline__ bf16* YB8() const { return (bf16*)(ws + WS_H1 + 32 * MiB); }
    __device__ __forceinline__ bf16* M1() const { return (bf16*)(ws + WS_PROJ); }
    __device__ __forceinline__ bf16* MERGED() const { return (bf16*)(ws + WS_PROJ + SEG); }
    __device__ __forceinline__ bf16* XS() const { return (bf16*)(ws + WS_XS); }
    __device__ __forceinline__ bf16* ACT() const { return (bf16*)(ws + WS_ACT); }
    __device__ __forceinline__ bf16* OUTR() const { return (bf16*)(ws + WS_XS); }
    __device__ __forceinline__ bf16* H2() const { return (bf16*)(ws + WS_XS); }
    __device__ __forceinline__ int* row2tok() const { return (int*)(ws + WS_ROW2TOK); }
    __device__ __forceinline__ float* gt() const { return (float*)(ws + WS_GT); }
};

__device__ __forceinline__ int opq(int v) { asm volatile("" : "+v"(v)); return v; }
__device__ __forceinline__ float wave_sum(float v) {
#pragma unroll
    for (int o = 1; o < 64; o <<= 1) v += __shfl_xor(v, o);
    return v;
}
__device__ __forceinline__ float bf2f(unsigned short b) { return __builtin_bit_cast(float, (unsigned)b << 16); }
__device__ __forceinline__ float bflo(unsigned w) { return __builtin_bit_cast(float, w << 16); }
__device__ __forceinline__ float bfhi(unsigned w) { return __builtin_bit_cast(float, w & 0xffff0000u); }
__device__ __forceinline__ float log_sigmoid_f(float x) { return fminf(x, 0.f) - log1pf(expf(-fabsf(x))); }

struct MapIn { __device__ __forceinline__ long operator()(int n) const { return n < 7168 ? (long)n : (n < 7176 ? -1L : (n < NIN ? (long)(n - 8) : -1L)); } };
struct MapId { long off; __device__ __forceinline__ long operator()(int n) const { return off + n; } };
struct MapW1 { int e; __device__ __forceinline__ long operator()(int n) const { return (long)e * 2048 + ((n & 1023) >> 7) * 256 + (n >> 10) * 128 + (n & 127); } };

template <class Map> __device__ __forceinline__ void transpose_item(const float* W, int K, int N, bf16* WT, LAS float* scr, int item, int lane, Map map, float scale8) {
    const int nblk = (N + 31) / 32, kb = item / nblk, nb = item % nblk, k0 = 128 * kb, n0 = 32 * nb;
    const int n4 = 4 * (lane & 7), kr = lane >> 3;
    const bool ok = (n0 + n4 + 3) < N;
    f32x4 v[16];
#pragma unroll
    for (int i = 0; i < 16; ++i) v[i] = ok ? *(const f32x4*)(W + (size_t)(k0 + 8 * i + kr) * N + n0 + n4) : (f32x4){0.f, 0.f, 0.f, 0.f};
#pragma unroll
    for (int i = 0; i < 16; ++i) { LAS float* d = scr + (8 * i + kr) * 33 + n4; d[0] = v[i].x; d[1] = v[i].y; d[2] = v[i].z; d[3] = v[i].w; }
    LDS_WAIT(); asm volatile("" ::: "memory");
    const int c = lane & 7;
#pragma unroll
    for (int j = 0; j < 4; ++j) { const int n = (lane >> 3) + 8 * j; const LAS float* s = scr + (16 * c) * 33 + n;
        const long dr = map(n0 + n); v4u o;
        o.x = pg8::pk4_fp8(s[0 * 33] * scale8, s[1 * 33] * scale8, s[2 * 33] * scale8, s[3 * 33] * scale8);     o.y = pg8::pk4_fp8(s[4 * 33] * scale8, s[5 * 33] * scale8, s[6 * 33] * scale8, s[7 * 33] * scale8);
        o.z = pg8::pk4_fp8(s[8 * 33] * scale8, s[9 * 33] * scale8, s[10 * 33] * scale8, s[11 * 33] * scale8);   o.w = pg8::pk4_fp8(s[12 * 33] * scale8, s[13 * 33] * scale8, s[14 * 33] * scale8, s[15 * 33] * scale8);
        if (dr >= 0) *(GAS v4u*)((unsigned char*)WT + (size_t)dr * K + k0 + 16 * c) = o; }
    LDS_WAIT(); asm volatile("" ::: "memory");
}
__device__ __forceinline__ void mod_item(Frame& F, const LAS float* sil, int it) {
    const int j = it % 96, kq = it / 96, n = 64 * j + F.lane, k0 = 256 * kq;
    float acc[16];
#pragma unroll
    for (int b = 0; b < 16; ++b) acc[b] = 0.f;
    const float* w = F.ada_w() + (size_t)k0 * NMOD + n;
    const LAS f32x4* s = (const LAS f32x4*)sil + k0 * 4;
    for (int kk = 0; kk < 256; kk += 8) {
        float wv[8];
#pragma unroll
        for (int u = 0; u < 8; ++u) wv[u] = w[(size_t)(kk + u) * NMOD];
#pragma unroll
        for (int u = 0; u < 8; ++u) {
#pragma unroll
            for (int q = 0; q < 4; ++q) { const f32x4 sv = s[(kk + u) * 4 + q]; acc[4 * q + 0] += sv.x * wv[u]; acc[4 * q + 1] += sv.y * wv[u]; acc[4 * q + 2] += sv.z * wv[u]; acc[4 * q + 3] += sv.w * wv[u]; }
        }
    }
    float* o = F.modp() + (size_t)kq * 16 * NMOD + n;
#pragma unroll
    for (int b = 0; b < 16; ++b) o[(size_t)b * NMOD] = acc[b];
}
__device__ __forceinline__ void p0_prologue(Frame& F) {
    LAS float* sil = (LAS float*)F.lds;
    for (int idx = F.tid; idx < 16384; idx += 512) { const int b = idx >> 10, k = idx & 1023; const float v = F.c()[idx]; sil[k * 16 + b] = v / (1.0f + __expf(-v)); }
    __syncthreads();
    const int gw = F.vcu * NWAVES + F.wave, NGW = F.G * NWAVES;
    constexpr int I_MOD = 384, I_IN = 8 * 289, I_SQ = 8 * 32, I_W1 = 32 * 8 * 64, I_W2 = 32 * 8 * 32;
    constexpr int NITEMS = I_IN + 3 * I_SQ + I_W1 + I_W2;
    if (gw < I_MOD) mod_item(F, sil, gw);
    __syncthreads();
    LAS float* scr = (LAS float*)(F.lds + F.wave * 16896);
    const int ow = (gw + NGW - I_MOD) % NGW;
    for (int it = ow; it < NITEMS; it += NGW) {
        int r = it;
        if (r < I_IN) { transpose_item(F.w_in(), D, NIN, F.WIN_T(), scr, r, F.lane, MapIn{}, W8SCALE); continue; } r -= I_IN;
        if (r < I_SQ) { transpose_item(F.w_a(), D, D, F.WA_T(), scr, r, F.lane, MapId{0}, W8SCALE); continue; } r -= I_SQ;
        if (r < I_SQ) { transpose_item(F.w_b(), D, D, F.WB_T(), scr, r, F.lane, MapId{0}, W8SCALE); continue; } r -= I_SQ;
        if (r < I_SQ) { transpose_item(F.w_out(), D, D, F.WOUT_T(), scr, r, F.lane, MapId{0}, W8SCALE); continue; } r -= I_SQ;
        if (r < I_W1) { const int e = r >> 9; transpose_item(F.w1() + (size_t)e * D * 2048, D, 2048, F.W1_T(), scr, r & 511, F.lane, MapW1{e}, W8SCALE); continue; } r -= I_W1;
        { const int e = r >> 8; transpose_item(F.w2() + (size_t)e * D * D, D, D, F.W2_T(), scr, r & 255, F.lane, MapId{(long)e * 1024}, W8SCALE); }
    }
}

__device__ __forceinline__ void p1_rows(Frame& F) {
    const int row0 = F.vcu * 128, b = row0 / SEQ, lane = opq(F.lane);
    LAS float* wif = (LAS float*)F.lds;
    for (int idx = F.tid; idx < 8192; idx += 512) wif[idx] = F.w_in()[(size_t)(idx >> 3) * NIN + 7168 + (idx & 7)];
    for (int idx = F.vcu * 512 + F.tid; idx < 16 * NMOD; idx += F.G * 512) { float s = F.ada_b()[idx % NMOD];
#pragma unroll
        for (int kq = 0; kq < 4; ++kq) s += F.modp()[(size_t)kq * 16 * NMOD + idx];
        F.mod()[idx] = s; }
    f32x4 Av[4], Bv[4];
#pragma unroll
    for (int j = 0; j < 4; ++j) { const int col = 4 * lane + 256 * j;
        f32x4 sh = *(const f32x4*)(F.ada_b() + col), sc = *(const f32x4*)(F.ada_b() + D + col);
#pragma unroll
        for (int kq = 0; kq < 4; ++kq) { sh += *(const f32x4*)(F.modp() + ((size_t)kq * 16 + b) * NMOD + col); sc += *(const f32x4*)(F.modp() + ((size_t)kq * 16 + b) * NMOD + D + col); }
        const f32x4 g = *(const f32x4*)(F.norm1_g() + col); Av[j] = g * (sc + 1.0f); Bv[j] = sh; }
    __syncthreads();
    f32x4 nx[4];
    { const GAS f32x4* xr = (const GAS f32x4*)(F.x() + (size_t)(row0 + 16 * F.wave) * D) + lane;
#pragma unroll
      for (int j = 0; j < 4; ++j) nx[j] = xr[64 * j]; }
    for (int r = 0; r < 16; ++r) {
        const int row = row0 + 16 * F.wave + r;
        f32x4 v[4]; float ss = 0.f;
#pragma unroll
        for (int j = 0; j < 4; ++j) { v[j] = nx[j]; ss += (v[j].x * v[j].x + v[j].y * v[j].y) + (v[j].z * v[j].z + v[j].w * v[j].w); }
        if (r < 15) { const GAS f32x4* xr = (const GAS f32x4*)(F.x() + (size_t)(row + 1) * D) + lane;
#pragma unroll
            for (int j = 0; j < 4; ++j) nx[j] = xr[64 * j]; }
        const float rstd = 1.0f / sqrtf(wave_sum(ss) * (1.0f / D) + EPS);
        GAS unsigned* o4 = (GAS unsigned*)((unsigned char*)F.H1() + (size_t)row * D) + lane;
        float p[8];
#pragma unroll
        for (int q = 0; q < 8; ++q) p[q] = 0.f;
#pragma unroll
        for (int j = 0; j < 4; ++j) { v[j] = v[j] * rstd * Av[j] + Bv[j];
            o4[64 * j] = pg8::pk4_fp8(v[j].x, v[j].y, v[j].z, v[j].w);
#pragma unroll
            for (int i = 0; i < 4; ++i) { const LAS f32x4* wp = (const LAS f32x4*)(wif + (4 * lane + 256 * j + i) * 8); const f32x4 w0 = wp[0], w1 = wp[1]; const float hv = v[j][i];
                p[0] += hv * w0.x; p[1] += hv * w0.y; p[2] += hv * w0.z; p[3] += hv * w0.w; p[4] += hv * w1.x; p[5] += hv * w1.y; p[6] += hv * w1.z; p[7] += hv * w1.w; } }
#pragma unroll
        for (int q = 0; q < 8; ++q) p[q] = wave_sum(p[q]);
        if (lane == 0) { const int t = row % SEQ;
#pragma unroll
            for (int hh = 0; hh < 4; ++hh) { F.ipre()[((size_t)b * 4 + hh) * SEQ + t] = p[hh] + F.b_i()[hh]; F.lf()[((size_t)b * 4 + hh) * SEQ + t] = log_sigmoid_f(p[4 + hh] + F.b_f()[hh]); } }
    }
}

__device__ __forceinline__ void attn_naive_item(Frame& F, int bh, int qblk) {
    const int b = bh >> 4, hd = bh & 15, t = qblk * 512 + F.tid;
    const bf16* Q = F.PROJ(); const bf16* K = F.PROJ() + SEG / 2; const bf16* V = F.PROJ() + SEG;
    const size_t rowb = (size_t)b * SEQ;
    float q[64], o[64];
    { const v4u* qp = (const v4u*)(Q + (rowb + t) * D + hd * 64);
#pragma unroll
      for (int i = 0; i < 8; ++i) { const v4u w = qp[i]; q[8 * i + 0] = bflo(w.x); q[8 * i + 1] = bfhi(w.x); q[8 * i + 2] = bflo(w.y); q[8 * i + 3] = bfhi(w.y); q[8 * i + 4] = bflo(w.z); q[8 * i + 5] = bfhi(w.z); q[8 * i + 6] = bflo(w.w); q[8 * i + 7] = bfhi(w.w); } }
#pragma unroll
    for (int i = 0; i < 64; ++i) o[i] = 0.f;
    float R = 0.f;
    LAS v4u* kt = (LAS v4u*)F.lds; LAS v4u* vt = (LAS v4u*)(F.lds + 8192);
    const int tmax_wave = qblk * 512 + F.wave * 64 + 63;
    bool wdone = false;
    LAS volatile int* dflag = (LAS volatile int*)(F.lds + 16384);
    if (F.tid < 8) dflag[F.tid] = 0;
    for (int tile = qblk * 8 + 7; tile >= 0; --tile) {
        __syncthreads();
        { int nd = 0;
#pragma unroll
          for (int w = 0; w < 8; ++w) nd += dflag[w];
          if (nd == 8) break; }
        { const int kr = F.tid >> 3, ch = F.tid & 7; const size_t g = (rowb + tile * 64 + kr) * D + hd * 64 + ch * 8;
          kt[F.tid] = *(const v4u*)(K + g); vt[F.tid] = *(const v4u*)(V + g); }
        __syncthreads();
        if (tile * 64 >= tmax_wave) continue;
        if (wdone) continue;
        for (int s = 63; s >= 0; --s) {
            const int key = tile * 64 + s;
            float z = 0.f;
#pragma unroll
            for (int i = 0; i < 8; ++i) { const v4u w = kt[s * 8 + i]; z += q[8 * i + 0] * bflo(w.x) + q[8 * i + 1] * bfhi(w.x) + q[8 * i + 2] * bflo(w.y) + q[8 * i + 3] * bfhi(w.y) + q[8 * i + 4] * bflo(w.z) + q[8 * i + 5] * bfhi(w.z) + q[8 * i + 6] * bflo(w.w) + q[8 * i + 7] * bfhi(w.w); }
            const float lb = fminf(z, 0.f) - __builtin_amdgcn_logf(1.0f + __builtin_amdgcn_exp2f(-fabsf(z)));
            const bool act = key < t;
            const float a = act ? __builtin_amdgcn_exp2f(lb + R) : 0.f;
            R += act ? (lb - z) : 0.f;
#pragma unroll
            for (int i = 0; i < 8; ++i) { const v4u w = vt[s * 8 + i]; o[8 * i + 0] += a * bflo(w.x); o[8 * i + 1] += a * bfhi(w.x); o[8 * i + 2] += a * bflo(w.y); o[8 * i + 3] += a * bfhi(w.y); o[8 * i + 4] += a * bflo(w.z); o[8 * i + 5] += a * bfhi(w.z); o[8 * i + 6] += a * bflo(w.w); o[8 * i + 7] += a * bfhi(w.w); }
        }
        if (__all(R < ATT_RTHR) && !wdone) { wdone = true; if (F.lane == 0) dflag[F.wave] = 1; }
    }
    __syncthreads();
    v4u* op = (v4u*)(F.YA() + (rowb + t) * D + hd * 64);
#pragma unroll
    for (int i = 0; i < 8; ++i) { v4u w; w.x = pk2(o[8 * i + 0], o[8 * i + 1]); w.y = pk2(o[8 * i + 2], o[8 * i + 3]); w.z = pk2(o[8 * i + 4], o[8 * i + 5]); w.w = pk2(o[8 * i + 6], o[8 * i + 7]); op[i] = w; }
}

__device__ __forceinline__ void mlstm_naive_item(Frame& F, int bh) {
    const int b = bh >> 2, hh = bh & 3, tid = opq(F.tid), e = tid & 255, half = tid >> 8;
    const bf16* MLQ = F.PROJ() + 3 * (SEG / 2); const bf16* MLK = F.PROJ() + 4 * (SEG / 2); const bf16* MLV = F.PROJ() + 5 * (SEG / 2); const bf16* MLO = F.PROJ() + 6 * (SEG / 2);
    LAS float* ql = (LAS float*)F.lds; LAS float* kl = ql + 8192; LAS float* vl = kl + 8192; LAS float* hl = vl + 8192;
    LAS float* part = hl + 8192;
    LAS float* red = part + 512;
    LAS float* il = red + 8; LAS float* fl = il + 32;
    const size_t rowb = (size_t)b * SEQ;
    float C[128];
#pragma unroll
    for (int i = 0; i < 128; ++i) C[i] = 0.f;
    float nreg = 0.f, m = 0.f;
    float cw[2][4], cb[2];
    { const int c = tid & 255;
#pragma unroll
      for (int z = 0; z < 2; ++z) { const int ch = z * 1024 + hh * 256 + c; cb[z] = F.conv_b()[ch];
#pragma unroll
          for (int tap = 0; tap < 4; ++tap) cw[z][tap] = F.conv_w()[tap * 2048 + ch]; } }
    for (int chunk = 0; chunk < SEQ / 32; ++chunk) {
        const int t0 = chunk * 32;
        __syncthreads();
        { const int c = tid & 255;
          for (int u = 0; u < 16; ++u) { const int tt = (tid >> 8) + 2 * u, t = t0 + tt; float yq = cb[0], yk = cb[1];
#pragma unroll
              for (int tap = 0; tap < 4; ++tap) { const int ts = t - 3 + tap; if (ts >= 0) { const size_t g = (rowb + ts) * D + hh * 256 + c; yq += cw[0][tap] * bf2f(MLQ[g]); yk += cw[1][tap] * bf2f(MLK[g]); } }
              ql[tt * 256 + c] = yq / (1.0f + __expf(-yq)); kl[tt * 256 + c] = (yk / (1.0f + __expf(-yk))) * 0.0625f;
              vl[tt * 256 + c] = bf2f(MLV[(rowb + t) * D + hh * 256 + c]); }
          if (tid < 32) { il[tid] = F.ipre()[((size_t)b * 4 + hh) * SEQ + t0 + tid]; fl[tid] = F.lf()[((size_t)b * 4 + hh) * SEQ + t0 + tid]; } }
        __syncthreads();
        for (int tt = 0; tt < 32; ++tt) {
            const float lfv = fl[tt], iv = il[tt];
            const float mn = fmaxf(lfv + m, iv), fp = __expf(lfv + m - mn), ip = __expf(iv - mn); m = mn;
            const float vv = vl[tt * 256 + e] * ip;
            const LAS f32x4* kq = (const LAS f32x4*)(kl + tt * 256 + 128 * half); const LAS f32x4* qq = (const LAS f32x4*)(ql + tt * 256 + 128 * half);
            float num = 0.f;
#pragma unroll
            for (int i = 0; i < 32; ++i) { const f32x4 kv = kq[i], qv = qq[i];
                C[4 * i + 0] = fp * C[4 * i + 0] + kv.x * vv; C[4 * i + 1] = fp * C[4 * i + 1] + kv.y * vv; C[4 * i + 2] = fp * C[4 * i + 2] + kv.z * vv; C[4 * i + 3] = fp * C[4 * i + 3] + kv.w * vv;
                num += (qv.x * C[4 * i + 0] + qv.y * C[4 * i + 1]) + (qv.z * C[4 * i + 2] + qv.w * C[4 * i + 3]); }
            const int buf = tt & 1;
            if (tid < 256) { nreg = fp * nreg + ip * kl[tt * 256 + tid]; const float pd = wave_sum(ql[tt * 256 + tid] * nreg); if (F.lane == 0) red[buf * 4 + F.wave] = pd; }
            else part[buf * 256 + e] = num;
            __syncthreads();
            if (tid < 256) { num += part[buf * 256 + e]; const float den = (red[buf * 4 + 0] + red[buf * 4 + 1]) + (red[buf * 4 + 2] + red[buf * 4 + 3]);
                hl[tt * 256 + e] = num / fmaxf(fabsf(den), __expf(-m)); }
        }
        __syncthreads();
        for (int r = 0; r < 4; ++r) { const int tt = 4 * F.wave + r; const size_t row = rowb + t0 + tt;
            const f32x4 hv = *(const LAS f32x4*)(hl + tt * 256 + 4 * F.lane);
            const float ss = wave_sum((hv.x * hv.x + hv.y * hv.y) + (hv.z * hv.z + hv.w * hv.w));
            const float rstd = 1.0f / sqrtf(ss * (1.0f / 256.0f) + EPS);
            const int col = hh * 256 + 4 * F.lane; const f32x4 g = *(const f32x4*)(F.ml_norm_g() + col);
            const unsigned long long ow = *(const unsigned long long*)(MLO + row * D + col);
            const float o0 = bflo((unsigned)ow), o1 = bfhi((unsigned)ow), o2 = bflo((unsigned)(ow >> 32)), o3 = bfhi((unsigned)(ow >> 32));
            const float y0 = hv.x * rstd * g.x / (1.0f + __expf(-o0)), y1 = hv.y * rstd * g.y / (1.0f + __expf(-o1)), y2 = hv.z * rstd * g.z / (1.0f + __expf(-o2)), y3 = hv.w * rstd * g.w / (1.0f + __expf(-o3));
            *(unsigned long long*)(F.YB() + row * D + col) = (unsigned long long)pk2(y0, y1) | ((unsigned long long)pk2(y2, y3) << 32); }
    }
}


namespace ml {
typedef short bf16x8 __attribute__((ext_vector_type(8)));
typedef short s16x4 __attribute__((ext_vector_type(4)));
typedef float f32x16 __attribute__((ext_vector_type(16)));
typedef LAS const char* lcp;
typedef LAS char* lp_t;
constexpr int L = 64;
constexpr int O_QI = 0, O_KI = 33792, O_CB = 67584, O_VI = 102400, O_VW = 111616, O_PI = 120832, O_F = 130048;
constexpr int F_NV = 0, F_QNP = 256, F_RSP = 768, F_AT = 896, F_US = 960, F_WIN = 1024, F_EDEN = 1088, F_WST = 1152, F_RDEN = 1216, F_CW = 1280, F_CBIAS = 3328;
__device__ __forceinline__ int crow(int r, int hi) { return (r & 3) + 8 * (r >> 2) + 4 * hi; }
template <int PITCH, int XM> __device__ __forceinline__ int ioff(int row, int ch) { return XM ? PITCH * row + 16 * (ch ^ (row & XM)) : PITCH * row + 16 * ch; }
template <int PITCH, int XM> __device__ __forceinline__ bf16x8 frag_row(lcp img, int row0, int s, int lane) {
    return *(LAS const bf16x8*)(img + ioff<PITCH, XM>(row0 + (lane & 31), 2 * s + (lane >> 5)));
}
template <int PITCH, int XM> __device__ __forceinline__ bf16x8 frag_tr(lcp img, int k0, int ks, int col0, int lane) {
    const int h = lane >> 5, blk = (lane >> 4) & 1, q = (lane & 15) >> 2, p = lane & 3;
    const int r0 = k0 + 16 * ks + 8 * h + q, ch = (col0 >> 3) + 2 * blk + (p >> 1);
    typedef short v4i16_t __attribute__((ext_vector_type(4)));
    const s16x4 a = __builtin_bit_cast(s16x4, __builtin_amdgcn_ds_read_tr16_b64_v4i16((LAS v4i16_t*)(img + ioff<PITCH, XM>(r0, ch) + 8 * (p & 1))));
    const s16x4 b = __builtin_bit_cast(s16x4, __builtin_amdgcn_ds_read_tr16_b64_v4i16((LAS v4i16_t*)(img + ioff<PITCH, XM>(r0 + 4, ch) + 8 * (p & 1))));
    return (bf16x8){a[0], a[1], a[2], a[3], b[0], b[1], b[2], b[3]};
}
__device__ __forceinline__ float half_sum(float v) {
    const auto rr = __builtin_amdgcn_permlane32_swap(__builtin_bit_cast(unsigned, v), __builtin_bit_cast(unsigned, v), false, false);
    return __builtin_bit_cast(float, rr[0]) + __builtin_bit_cast(float, rr[1]);
}
__device__ __forceinline__ float silu_f(float y) { return y * __builtin_amdgcn_rcpf(1.0f + __expf(-y)); }

__device__ __forceinline__ void mlstm_unit(Frame& F, int unit) {
    const int bh = unit >> 2, sl = unit & 3, b = bh >> 2, hh = bh & 3, tid = opq(F.tid), lane = opq(F.lane), wave = F.wave, hi = lane >> 5, l31 = lane & 31;
    const bf16* MLQ = (const bf16*)F.out(); const bf16* MLK = MLQ + (size_t)T * D; const bf16* MLV = F.PROJ() + 5 * (SEG / 2);
    lp_t base = (lp_t)F.lds;
    LAS float* Fa = (LAS float*)(base + O_F);
    const size_t rowb = (size_t)b * SEQ;
    const float LOG2E = 1.4426950408889634f;
    __syncthreads();
    for (int i = tid; i < 34816 / 16; i += 512) ((LAS v4u*)(base + O_CB))[i] = (v4u){0u, 0u, 0u, 0u};
    if (tid < 256) Fa[F_NV + tid] = 0.f;
    f32x16 C0, C1, C2;
#pragma unroll
    for (int r = 0; r < 16; ++r) { C0[r] = 0.f; C1[r] = 0.f; C2[r] = 0.f; }
    if (tid < 64) *(LAS v4u*)(base + O_VW + 144 * tid + 128) = (v4u){0u, 0u, 0u, 0u};
    const int cg = tid & 31, rb = tid >> 5;
    v4u rawq[2][4], rawk[2][4], rawv[2]; float g_bb[2], g_us[2], g_pm[2]; float m_prev = 0.f;
#define ML_PREFETCH(T0, P) do { const int t0_ = (T0); \
        _Pragma("unroll") for (int i = 0; i < 4; ++i) { const unsigned g_ = (unsigned)(((int)rowb + t0_ + 4 * rb + i) * D + hh * 256 + cg * 8); \
            rawq[P][i] = *(const v4u*)(MLQ + g_); rawk[P][i] = *(const v4u*)(MLK + g_); } \
        rawv[P] = *(const v4u*)(MLV + (unsigned)(((int)rowb + t0_ + (tid >> 3)) * D + hh * 256 + 64 * sl + (tid & 7) * 8)); \
        { const float* gt_ = F.gt() + (unsigned)(((bh * (SEQ / L) + t0_ / L) * 3) * 64 + lane); g_bb[P] = gt_[0]; g_us[P] = gt_[64]; g_pm[P] = gt_[128]; } } while (0)
    ML_PREFETCH(0, 0); ML_PREFETCH(L, 1);
    __syncthreads();
    for (int chunk2 = 0; chunk2 < SEQ / L; chunk2 += 2) {
#pragma unroll
      for (int par = 0; par < 2; ++par) {
        const int chunk = chunk2 + par, t0 = chunk * L;
        const int tid = opq(F.tid), lane = tid & 63, hi = lane >> 5, l31 = lane & 31, cg = tid & 31, rb = tid >> 5, lo = lane;
        const float u = g_us[par], mm = g_bb[par] + fmaxf(m_prev, g_pm[par]), winter = __builtin_amdgcn_exp2f(g_bb[par] + m_prev - mm), at = g_bb[par] - mm, eden = __builtin_amdgcn_exp2f(-mm);
        const float bb63 = __builtin_bit_cast(float, __builtin_amdgcn_readlane(__builtin_bit_cast(int, g_bb[par]), 63)), mnew = __builtin_bit_cast(float, __builtin_amdgcn_readlane(__builtin_bit_cast(int, mm), 63));
        const float decay = __builtin_amdgcn_exp2f(bb63 + m_prev - mnew), wstate = __builtin_amdgcn_exp2f(bb63 - mnew + u); m_prev = mnew;
        if (wave == 0) { Fa[F_AT + lane] = at; Fa[F_US + lane] = u; Fa[F_WIN + lane] = winter; Fa[F_EDEN + lane] = eden; Fa[F_WST + lane] = wstate; }
#pragma unroll
        for (int j = 0; j < 4; ++j) { *(LAS v4u*)(base + O_QI + ioff<528, 0>(4 * rb + j, cg)) = rawq[par][j]; *(LAS v4u*)(base + O_KI + ioff<528, 0>(4 * rb + j, cg)) = rawk[par][j]; }
        { const int s = tid >> 3, ch = tid & 7; const v4u w = rawv[par];
          *(LAS v4u*)(base + O_VI + ioff<144, 0>(s, ch)) = w;
          const float ws = __shfl(wstate, s);
          v4u o; o.x = pk2(bflo(w.x) * ws, bfhi(w.x) * ws); o.y = pk2(bflo(w.y) * ws, bfhi(w.y) * ws); o.z = pk2(bflo(w.z) * ws, bfhi(w.z) * ws); o.w = pk2(bflo(w.w) * ws, bfhi(w.w) * ws);
          *(LAS v4u*)(base + O_VW + ioff<144, 0>(s, ch)) = o;
          if (ch == 0) *(LAS unsigned short*)(base + O_VW + 144 * s + 128) = (unsigned short)pk2(ws, 0.f); }
        __syncthreads();
        if (chunk + 2 < SEQ / L) ML_PREFETCH(t0 + 2 * L, par);
        __builtin_amdgcn_sched_barrier(0);
        f32x16 acc;
#pragma unroll
        for (int r = 0; r < 16; ++r) acc[r] = 0.f;
        const int wq = wave & 3, ta = wq >> 1, tb = wq & 1;
        if (wave < 4) {
#pragma unroll
            for (int kh = 0; kh < 2; ++kh) { bf16x8 fa[8], fb[8];
#pragma unroll
                for (int ks = 0; ks < 8; ++ks) { fa[ks] = frag_row<528, 0>(base + O_KI, 32 * tb, 8 * kh + ks, lo); fb[ks] = frag_row<528, 0>(base + O_QI, 32 * ta, 8 * kh + ks, lo); }
                __builtin_amdgcn_sched_barrier(0);
#pragma unroll
                for (int ks = 0; ks < 8; ++ks) acc = __builtin_amdgcn_mfma_f32_32x32x16_bf16(fa[ks], fb[ks], acc, 0, 0, 0);
                __builtin_amdgcn_sched_barrier(0); }
            const float at_l = __shfl(at, 32 * ta + l31); const int t = 32 * ta + l31; float rsum = 0.f;
#pragma unroll
            for (int g = 0; g < 4; ++g) { const int s0 = 32 * tb + 8 * g + 4 * hi; const f32x4 us4 = *(LAS const f32x4*)(Fa + F_US + s0); float p[4];
#pragma unroll
                for (int i = 0; i < 4; ++i) { p[i] = (s0 + i <= t) ? acc[4 * g + i] * __builtin_amdgcn_exp2f(at_l + us4[i]) : 0.f; rsum += p[i]; }
                *(LAS unsigned long long*)(base + O_PI + ioff<144, 0>(t, s0 >> 3) + 2 * (s0 & 7)) = (unsigned long long)pk2(p[0], p[1]) | ((unsigned long long)pk2(p[2], p[3]) << 32); }
            rsum = half_sum(rsum);
            if (hi == 0) Fa[F_RSP + tb * 64 + t] = rsum;
        } else {
#pragma unroll
            for (int kh = 0; kh < 2; ++kh) { bf16x8 fa[8], fb[8];
#pragma unroll
                for (int ks = 0; ks < 8; ++ks) { fa[ks] = frag_row<528, 0>(base + O_QI, 32 * ta, 8 * kh + ks, lo); fb[ks] = frag_tr<136, 0>(base + O_CB, 0, 8 * kh + ks, 32 * tb, lo); }
                __builtin_amdgcn_sched_barrier(0);
#pragma unroll
                for (int ks = 0; ks < 8; ++ks) acc = __builtin_amdgcn_mfma_f32_32x32x16_bf16(fa[ks], fb[ks], acc, 0, 0, 0);
                __builtin_amdgcn_sched_barrier(0); }
        }
        { float s = 0.f;
#pragma unroll
          for (int c = 0; c < 4; ++c) { const v4u w = *(LAS const v4u*)(base + O_QI + ioff<528, 0>(lane, 4 * wave + c)); const f32x4 n0 = *(LAS const f32x4*)(Fa + F_NV + 32 * wave + 8 * c), n1 = *(LAS const f32x4*)(Fa + F_NV + 32 * wave + 8 * c + 4);
              s += bflo(w.x) * n0.x + bfhi(w.x) * n0.y + bflo(w.y) * n0.z + bfhi(w.y) * n0.w + bflo(w.z) * n1.x + bfhi(w.z) * n1.y + bflo(w.w) * n1.z + bfhi(w.w) * n1.w; }
          Fa[F_QNP + wave * 64 + lane] = s; }
        __syncthreads();
        if (wave >= 4) {
            { const int t = 32 * ta + l31;
              const float den = Fa[F_WIN + t] * (((Fa[F_QNP + t] + Fa[F_QNP + 64 + t]) + (Fa[F_QNP + 128 + t] + Fa[F_QNP + 192 + t])) + ((Fa[F_QNP + 256 + t] + Fa[F_QNP + 320 + t]) + (Fa[F_QNP + 384 + t] + Fa[F_QNP + 448 + t])))
                                + Fa[F_RSP + t] + Fa[F_RSP + 64 + t];
              if (hi == 0) Fa[F_CW + 32 * (wave - 4) + l31] = 1.0f / fmaxf(fabsf(den), Fa[F_EDEN + t]); }
#pragma unroll
            for (int g = 0; g < 4; ++g) { const f32x4 w4 = *(LAS const f32x4*)(Fa + F_WIN + 32 * ta + 8 * g + 4 * hi); acc[4 * g] *= w4.x; acc[4 * g + 1] *= w4.y; acc[4 * g + 2] *= w4.z; acc[4 * g + 3] *= w4.w; }
            { bf16x8 fa[4], fb[4];
#pragma unroll
              for (int ks = 0; ks < 4; ++ks) { fa[ks] = frag_row<144, 0>(base + O_PI, 32 * ta, ks, lo); fb[ks] = frag_tr<144, 0>(base + O_VI, 0, ks, 32 * tb, lo); }
              __builtin_amdgcn_sched_barrier(0);
#pragma unroll
              for (int ks = 0; ks < 4; ++ks) acc = __builtin_amdgcn_mfma_f32_32x32x16_bf16(fa[ks], fb[ks], acc, 0, 0, 0); }
            bf16* dst = F.YB() + (rowb + t0 + 32 * ta) * D + hh * 256 + 64 * sl + 32 * tb + l31;
#pragma unroll
            for (int g = 0; g < 4; ++g) { const f32x4 r4 = *(LAS const f32x4*)(Fa + F_CW + 32 * (wave - 4) + 8 * g + 4 * hi);
#pragma unroll
                for (int i = 0; i < 4; ++i) dst[(size_t)(8 * g + 4 * hi + i) * D] = (bf16)pk2(acc[4 * g + i] * r4[i], 0.f); }
        }
#pragma unroll
        for (int r = 0; r < 16; ++r) { C0[r] *= decay; C1[r] *= decay; C2[r] *= decay; }
        { bf16x8 bk[4], v0[4], v1[4], v2[4];
#pragma unroll
          for (int ks = 0; ks < 4; ++ks) { bk[ks] = frag_tr<528, 0>(base + O_KI, 0, ks, 32 * wave, lo); v0[ks] = frag_tr<144, 0>(base + O_VW, 0, ks, 0, lo); v1[ks] = frag_tr<144, 0>(base + O_VW, 0, ks, 32, lo); v2[ks] = frag_tr<144, 0>(base + O_VW, 0, ks, 64, lo); }
          __builtin_amdgcn_sched_barrier(0);
#pragma unroll
          for (int ks = 0; ks < 4; ++ks) { C0 = __builtin_amdgcn_mfma_f32_32x32x16_bf16(v0[ks], bk[ks], C0, 0, 0, 0); C1 = __builtin_amdgcn_mfma_f32_32x32x16_bf16(v1[ks], bk[ks], C1, 0, 0, 0); C2 = __builtin_amdgcn_mfma_f32_32x32x16_bf16(v2[ks], bk[ks], C2, 0, 0, 0); }
          __builtin_amdgcn_sched_barrier(0); }
        { const int d = 32 * wave + l31;
#pragma unroll
          for (int g = 0; g < 4; ++g) { const int e0 = 8 * g + 4 * hi;
              *(LAS unsigned long long*)(base + O_CB + ioff<136, 0>(d, e0 >> 3) + 2 * (e0 & 7)) = (unsigned long long)pk2(C0[4 * g], C0[4 * g + 1]) | ((unsigned long long)pk2(C0[4 * g + 2], C0[4 * g + 3]) << 32);
              *(LAS unsigned long long*)(base + O_CB + ioff<136, 0>(d, (32 + e0) >> 3) + 2 * (e0 & 7)) = (unsigned long long)pk2(C1[4 * g], C1[4 * g + 1]) | ((unsigned long long)pk2(C1[4 * g + 2], C1[4 * g + 3]) << 32); }
          if (hi == 0) Fa[F_NV + d] = C2[0];
        }
        __syncthreads();
      }
    }
#undef ML_PREFETCH
}
}


__device__ __forceinline__ void mlstm_gates(Frame& F, int job) {
    const int lane = opq(F.lane); const float LOG2E = 1.4426950408889634f;
    const float lf2 = F.lf()[(size_t)job * ml::L + lane] * LOG2E, ii2 = F.ipre()[(size_t)job * ml::L + lane] * LOG2E;
    float bb = lf2;
#pragma unroll
    for (int o = 1; o < 64; o <<= 1) { const float v = __shfl_up(bb, o); bb += (lane >= o) ? v : 0.f; }
    const float u = ii2 - bb; float pm = u;
#pragma unroll
    for (int o = 1; o < 64; o <<= 1) { const float v = __shfl_up(pm, o); pm = (lane >= o) ? fmaxf(pm, v) : pm; }
    float* gt = F.gt() + (size_t)job * 3 * 64 + lane;
    gt[0] = bb; gt[64] = u; gt[128] = pm;
}

__device__ __forceinline__ void mlstm_conv_rows(Frame& F) {
    const int tid = opq(F.tid), cg = tid & 255, z = cg >> 7, c0 = (cg & 127) * 8, r0 = F.vcu * 128 + 64 * (tid >> 8);
    const bf16* src = F.PROJ() + (size_t)(3 + z) * (SEG / 2) + c0; bf16* dst = (bf16*)F.out() + (size_t)z * T * D + c0;
    float w[4][8], bs[8];
#pragma unroll
    for (int tap = 0; tap < 4; ++tap) { const f32x4 a0 = *(const f32x4*)(F.conv_w() + tap * 2048 + cg * 8), a1 = *(const f32x4*)(F.conv_w() + tap * 2048 + cg * 8 + 4);
        w[tap][0] = a0.x; w[tap][1] = a0.y; w[tap][2] = a0.z; w[tap][3] = a0.w; w[tap][4] = a1.x; w[tap][5] = a1.y; w[tap][6] = a1.z; w[tap][7] = a1.w; }
    { const f32x4 a0 = *(const f32x4*)(F.conv_b() + cg * 8), a1 = *(const f32x4*)(F.conv_b() + cg * 8 + 4);
      bs[0] = a0.x; bs[1] = a0.y; bs[2] = a0.z; bs[3] = a0.w; bs[4] = a1.x; bs[5] = a1.y; bs[6] = a1.z; bs[7] = a1.w; }
    const float osc = z ? 0.0625f : 1.0f;
    const bool seq_start = (r0 % SEQ) == 0;
    v4u x0, x1, x2;
    { const v4u zero = {0u, 0u, 0u, 0u};
      x0 = seq_start ? zero : *(const v4u*)(src + (size_t)(r0 - 3 + (seq_start ? 3 : 0)) * D);
      x1 = seq_start ? zero : *(const v4u*)(src + (size_t)(r0 - 2 + (seq_start ? 2 : 0)) * D);
      x2 = seq_start ? zero : *(const v4u*)(src + (size_t)(r0 - 1 + (seq_start ? 1 : 0)) * D); }
    v4u nxs[8];
#pragma unroll
    for (int i = 0; i < 8; ++i) nxs[i] = *(const v4u*)(src + (size_t)(r0 + i) * D);
    for (int rr = 0; rr < 64; rr += 8) {
        v4u xs[8];
#pragma unroll
        for (int i = 0; i < 8; ++i) xs[i] = nxs[i];
        if (rr + 8 < 64) {
#pragma unroll
            for (int i = 0; i < 8; ++i) nxs[i] = *(const v4u*)(src + (size_t)(r0 + rr + 8 + i) * D); }
#pragma unroll
        for (int i = 0; i < 8; ++i) {
            const v4u x3 = xs[i]; float y[8];
#pragma unroll
            for (int c = 0; c < 8; ++c) y[c] = bs[c];
#define MK_TAP(tap, X) do { y[0] += w[tap][0] * bflo(X.x); y[1] += w[tap][1] * bfhi(X.x); y[2] += w[tap][2] * bflo(X.y); y[3] += w[tap][3] * bfhi(X.y); \
                           y[4] += w[tap][4] * bflo(X.z); y[5] += w[tap][5] * bfhi(X.z); y[6] += w[tap][6] * bflo(X.w); y[7] += w[tap][7] * bfhi(X.w); } while (0)
            MK_TAP(0, x0); MK_TAP(1, x1); MK_TAP(2, x2); MK_TAP(3, x3);
#undef MK_TAP
#pragma unroll
            for (int c = 0; c < 8; ++c) y[c] = ml::silu_f(y[c]) * osc;
            v4u o; o.x = pk2(y[0], y[1]); o.y = pk2(y[2], y[3]); o.z = pk2(y[4], y[5]); o.w = pk2(y[6], y[7]);
            *(v4u*)(dst + (size_t)(r0 + rr + i) * D) = o;
            x0 = x1; x1 = x2; x2 = x3;
        }
    }
}

__device__ __forceinline__ void mlstm_norm_rows(Frame& F) {
    const int row0 = F.vcu * 128, lane = opq(F.lane);
    const bf16* MLO = F.PROJ() + 6 * (SEG / 2);
    f32x4 G[4];
#pragma unroll
    for (int j = 0; j < 4; ++j) G[j] = *(const f32x4*)(F.ml_norm_g() + 256 * j + 4 * lane);
    unsigned long long nh[4], no[4];
#define NR_LOAD(ROW) do { const size_t row_ = (ROW); const GAS unsigned long long* hp_ = (const GAS unsigned long long*)(F.YB() + row_ * D) + lane; const GAS unsigned long long* op_ = (const GAS unsigned long long*)(MLO + row_ * D) + lane; \
        _Pragma("unroll") for (int j = 0; j < 4; ++j) { nh[j] = hp_[64 * j]; no[j] = op_[64 * j]; } } while (0)
    NR_LOAD((size_t)row0 + 16 * F.wave);
    for (int r = 0; r < 16; ++r) {
        const size_t row = (size_t)row0 + 16 * F.wave + r;
        GAS unsigned* hp = (GAS unsigned*)((unsigned char*)F.YB8() + row * D) + lane;
        unsigned long long ch[4], co[4];
#pragma unroll
        for (int j = 0; j < 4; ++j) { ch[j] = nh[j]; co[j] = no[j]; }
        if (r < 15) NR_LOAD(row + 1);
#pragma unroll
        for (int j = 0; j < 4; ++j) { const unsigned long long hw = ch[j], ow = co[j];
            const float h0 = bflo((unsigned)hw), h1 = bfhi((unsigned)hw), h2 = bflo((unsigned)(hw >> 32)), h3 = bfhi((unsigned)(hw >> 32));
            const float ss = wave_sum((h0 * h0 + h1 * h1) + (h2 * h2 + h3 * h3)); const float rstd = 1.0f / sqrtf(ss * (1.0f / 256.0f) + EPS);
            const float o0 = bflo((unsigned)ow), o1 = bfhi((unsigned)ow), o2 = bflo((unsigned)(ow >> 32)), o3 = bfhi((unsigned)(ow >> 32));
            const float y0 = h0 * rstd * G[j].x / (1.0f + __expf(-o0)), y1 = h1 * rstd * G[j].y / (1.0f + __expf(-o1)), y2 = h2 * rstd * G[j].z / (1.0f + __expf(-o2)), y3 = h3 * rstd * G[j].w / (1.0f + __expf(-o3));
            hp[64 * j] = pg8::pk4_fp8(y0, y1, y2, y3); }
    }
#undef NR_LOAD
}

namespace at {
using ml::bf16x8; using ml::s16x4; using ml::f32x16; using ml::ioff; using ml::frag_row; using ml::lcp; using ml::lp_t;
typedef _Float16 f16x8 __attribute__((ext_vector_type(8)));
typedef _Float16 f16x2 __attribute__((ext_vector_type(2)));
typedef float f32x2 __attribute__((ext_vector_type(2)));
constexpr int O_KI = 0, O_VI = 8192, O_FLAG = 16384;
template <int PITCH, int XM> __device__ __forceinline__ bf16x8 frag_trp(lcp img, int ks, int col0, int lane) {
    const int h = lane >> 5, blk = (lane >> 4) & 1, q = (lane & 15) >> 2, p = lane & 3;
    const int r0 = 16 * ks + 4 * h + q, ch = (col0 >> 3) + 2 * blk + (p >> 1);
    typedef short v4i16_t __attribute__((ext_vector_type(4)));
    const s16x4 a = __builtin_bit_cast(s16x4, __builtin_amdgcn_ds_read_tr16_b64_v4i16((LAS v4i16_t*)(img + ioff<PITCH, XM>(r0, ch) + 8 * (p & 1))));
    const s16x4 b = __builtin_bit_cast(s16x4, __builtin_amdgcn_ds_read_tr16_b64_v4i16((LAS v4i16_t*)(img + ioff<PITCH, XM>(r0 + 8, ch) + 8 * (p & 1))));
    return (bf16x8){a[0], a[1], a[2], a[3], b[0], b[1], b[2], b[3]};
}
__device__ __forceinline__ unsigned pkh(float a, float b) { const f32x2 v = {a, b}; return __builtin_bit_cast(unsigned, __builtin_convertvector(v, f16x2)); }
__device__ __forceinline__ f16x8 h8(unsigned a, unsigned b, unsigned c, unsigned d) { const v4u v = {a, b, c, d}; return __builtin_bit_cast(f16x8, v); }
__device__ __forceinline__ bf16x8 b8(unsigned a, unsigned b, unsigned c, unsigned d) { const v4u v = {a, b, c, d}; return __builtin_bit_cast(bf16x8, v); }

__device__ __forceinline__ void attn_ring(Frame& F, int bh) {
    const int b = bh >> 4, hd = bh & 15, tid = opq(F.tid), lane = opq(F.lane), wave = F.wave, hi = lane >> 5, l31 = lane & 31, pr = wave & 3, rw = 2 * (wave & 3) + (wave >> 2), tp = 64 * (wave >> 2) + lane;
    const bf16* Q = F.PROJ(); const bf16* K = F.PROJ() + SEG / 2; const bf16* V = F.PROJ() + SEG;
    const lp_t lds0 = (lp_t)F.lds;
    LAS volatile int* dflag = (LAS volatile int*)(lds0 + 131072);
    const size_t rowb = (size_t)b * SEQ;
#define AT_DMA(KT) do { const int kt_ = (KT); if (kt_ >= 0) { const lp_t sl_ = lds0 + (kt_ & 7) * 16384 + 1024 * wave; const int dl_ = opq(F.lane); \
        const size_t dg0 = (rowb + 8 * wave + (dl_ >> 3)) * D + hd * 64 + ((dl_ & 7) ^ (dl_ >> 3)) * 8;     \
        __builtin_amdgcn_global_load_lds((const unsigned*)(K + dg0 + (size_t)kt_ * 64 * D), (LAS unsigned*)(sl_ + O_KI), 16, 0, 0); \
        __builtin_amdgcn_global_load_lds((const unsigned*)(V + dg0 + (size_t)kt_ * 64 * D), (LAS unsigned*)(sl_ + O_VI), 16, 0, 0); } } while (0)
    unsigned uw[2][4];
#pragma unroll
    for (int sp = 0; sp < 2; ++sp)
#pragma unroll
        for (int jj = 0; jj < 4; ++jj) { const int j0 = 2 * jj, j1 = 2 * jj + 1;
            const int k0 = 16 * sp + 8 * (j0 >> 2) + 4 * hi + (j0 & 3), k1 = 16 * sp + 8 * (j1 >> 2) + 4 * hi + (j1 & 3);
            uw[sp][jj] = (k0 > l31 ? 0x3C00u : 0u) | (k1 > l31 ? 0x3C000000u : 0u); }
    const f16x8 U0 = h8(uw[0][0], uw[0][1], uw[0][2], uw[0][3]), U1 = h8(uw[1][0], uw[1][1], uw[1][2], uw[1][3]), ONES = h8(0x3C003C00u, 0x3C003C00u, 0x3C003C00u, 0x3C003C00u);
    bool ring_ok = false;
    bf16x8 qr[4];
#pragma unroll
    for (int ks = 0; ks < 4; ++ks) qr[ks] = *(const bf16x8*)(Q + (rowb + (SEQ - 256) + 32 * rw + l31) * D + hd * 64 + 16 * ks + 8 * hi);
    __syncthreads();
    for (int qb = SEQ / 256 - 1; qb >= 0; --qb) {
        const int q0 = qb * 256, tw0 = q0 + 32 * rw, t = tw0 + l31, kt0 = qb * 4 + pr;
        if (ring_ok) { AT_DMA(4 * qb - 3); AT_DMA(4 * qb - 4); }
        else {
#pragma unroll
            for (int s = 3; s >= -4; --s) AT_DMA(4 * qb + s);
            asm volatile("s_waitcnt vmcnt(0)" ::: "memory");
            __syncthreads(); }
        LAS volatile int* dfl = dflag + 8 * (qb & 1);
        if (lane == 0) dfl[wave] = 0;
        f32x16 O0, O1;
#pragma unroll
        for (int r = 0; r < 16; ++r) { O0[r] = 0.f; O1[r] = 0.f; }
        float R = 0.f; bool wdone = false;
        const bool has_next = qb > 0;
        ring_ok = has_next;
        bool closed = false;
        for (int it = 0; it <= qb * 4 + 3; ++it) {
            const int kt = kt0 - it;
            lp_t base = lds0 + (kt & 7) * 16384;
            if (it == 2) {
                asm volatile("s_waitcnt vmcnt(0)" ::: "memory");
                __syncthreads();
                if (has_next) { AT_DMA(4 * qb - 5); AT_DMA(4 * qb - 6); }
            }
            if (it >= 5) {
                base = lds0 + pr * 16384;
                asm volatile("s_waitcnt vmcnt(0)" ::: "memory");
                __syncthreads();
                { int nd = 0;
#pragma unroll
                  for (int w = 0; w < 8; ++w) nd += dfl[w];
                  if (nd == 8) { closed = true; break; } }
                ring_ok = false;
                if (kt >= 0) {
#pragma unroll
                    for (int j = 0; j < 4; ++j) { const size_t g = (rowb + kt * 64 + (tp >> 3) + 16 * j) * D + hd * 64 + (tp & 7) * 8; const v4u kv = *(const v4u*)(K + g), vv = *(const v4u*)(V + g);
                        *(LAS v4u*)(base + O_KI + ioff<128, 7>((tp >> 3) + 16 * j, tp & 7)) = kv; *(LAS v4u*)(base + O_VI + ioff<128, 7>((tp >> 3) + 16 * j, tp & 7)) = vv; } }
                __syncthreads();
            }
            if (kt < 0) { if (!wdone) { wdone = true; if (lane == 0) dfl[wave] = 1; } continue; }
            if (wdone) continue;
            int lo = lane; asm volatile("" : "+v"(lo));
#define AT_BLOCK(KB, MSK) do { \
                f32x16 p; \
                _Pragma("unroll") for (int r = 0; r < 16; ++r) p[r] = 0.f; \
                _Pragma("unroll") for (int ks = 0; ks < 4; ++ks) p = __builtin_amdgcn_mfma_f32_32x32x16_bf16(frag_row<128, 7>(base + O_KI, 32 * (KB), ks, lo), qr[ks], p, 0, 0, 0); \
                float lk0 = 0.f; unsigned lkw[8]; \
                _Pragma("unroll") for (int r = 0; r < 16; ++r) {     \
                    const int key0 = ml::crow(r, hi); \
                    const float z = __builtin_amdgcn_fmed3f(p[r], -80.f, 80.f), l = __builtin_amdgcn_logf(1.0f + __builtin_amdgcn_exp2f(-z)); float lk = -l - z; if ((MSK) && !(key0 < l31)) lk = 0.f; p[r] = l; if (r == 0) lk0 = lk; \
                    if (r & 1) lkw[r >> 1] = pkh(__builtin_bit_cast(float, lkw[r >> 1]), lk); else lkw[r >> 1] = __builtin_bit_cast(unsigned, lk); } \
                f32x16 bt; \
                _Pragma("unroll") for (int r = 0; r < 16; ++r) bt[r] = R; \
                const f16x8 L0 = h8(lkw[0], lkw[1], lkw[2], lkw[3]), L1 = h8(lkw[4], lkw[5], lkw[6], lkw[7]); \
                bt = __builtin_amdgcn_mfma_f32_32x32x16_f16(U0, L0, bt, 0, 0, 0); bt = __builtin_amdgcn_mfma_f32_32x32x16_f16(U1, L1, bt, 0, 0, 0); \
                { const float v = bt[0] + lk0;                                      \
                  const auto rr = __builtin_amdgcn_permlane32_swap(__builtin_bit_cast(unsigned, v), __builtin_bit_cast(unsigned, v), false, false); \
                  R = __builtin_bit_cast(float, rr[0]); } \
                unsigned aw[8]; \
                _Pragma("unroll") for (int r = 0; r < 16; r += 2) { const int key0 = ml::crow(r, hi); \
                    float a0 = __builtin_amdgcn_exp2f(bt[r] - p[r]), a1 = __builtin_amdgcn_exp2f(bt[r + 1] - p[r + 1]); \
                    if (MSK) { if (!(key0 < l31)) a0 = 0.f; if (!(key0 + 1 < l31)) a1 = 0.f; } \
                    aw[r >> 1] = pk2(a0, a1); } \
                const bf16x8 A0 = b8(aw[0], aw[1], aw[2], aw[3]), A1 = b8(aw[4], aw[5], aw[6], aw[7]); \
                O0 = __builtin_amdgcn_mfma_f32_32x32x16_bf16(A0, frag_trp<128, 7>(base + O_VI, 2 * (KB), 0, lo), O0, 0, 0, 0);      O1 = __builtin_amdgcn_mfma_f32_32x32x16_bf16(A0, frag_trp<128, 7>(base + O_VI, 2 * (KB), 32, lo), O1, 0, 0, 0); \
                O0 = __builtin_amdgcn_mfma_f32_32x32x16_bf16(A1, frag_trp<128, 7>(base + O_VI, 2 * (KB) + 1, 0, lo), O0, 0, 0, 0);  O1 = __builtin_amdgcn_mfma_f32_32x32x16_bf16(A1, frag_trp<128, 7>(base + O_VI, 2 * (KB) + 1, 32, lo), O1, 0, 0, 0); \
                if (__all(R < ATT_RTHR)) { wdone = true; if (lane == 0) dfl[wave] = 1; } } while (0)
            const int wp = wave >> 2;
            if (it == 0) {
                if (wp == 1) { AT_BLOCK(1, true); if (!wdone) AT_BLOCK(0, false); }
                else { AT_BLOCK(0, true); }
            } else { AT_BLOCK(1, false); if (!wdone) AT_BLOCK(0, false); }
#undef AT_BLOCK
        }
        if (!closed) {
            asm volatile("s_waitcnt vmcnt(0)" ::: "memory");
            __syncthreads(); }
        if (has_next) {
#pragma unroll
            for (int ks = 0; ks < 4; ++ks) qr[ks] = *(const bf16x8*)(Q + (rowb + t - 256) * D + hd * 64 + 16 * ks + 8 * hi); }
        unsigned char* dst = (unsigned char*)F.YA() + (rowb + tw0) * D + hd * 64 + l31;
#pragma unroll
        for (int r = 0; r < 16; ++r) { const int q = ml::crow(r, hi); dst[(size_t)q * D] = (unsigned char)pg8::pk4_fp8(O0[r], 0.f, 0.f, 0.f); dst[(size_t)q * D + 32] = (unsigned char)pg8::pk4_fp8(O1[r], 0.f, 0.f, 0.f); }
    }
#undef AT_DMA
}
}

__device__ __forceinline__ void p5a_route(Frame& F) {
    const int row0 = F.vcu * 128, b = row0 / SEQ, lane = opq(F.lane), tid = opq(F.tid);
    LAS float* wr = (LAS float*)F.lds;
    LAS int* le = (LAS int*)(F.lds + 131584); LAS int* lp = le + 512;
    LAS int* lcnt = (LAS int*)(F.LC + LC_LCNT); LAS int* gbase = (LAS int*)(F.LC + LC_GBASE);
    for (int idx = tid; idx < 32768; idx += 512) wr[(idx & 31) * 1028 + (idx >> 5)] = F.router_w()[idx];
    if (tid < 32) lcnt[tid] = 0;
    f32x4 Av[4], Bv[4];
#pragma unroll
    for (int j = 0; j < 4; ++j) { const int col = 4 * lane + 256 * j; const float* mb = F.mod() + (size_t)b * NMOD;
        const f32x4 g = *(const f32x4*)(F.norm2_g() + col); Av[j] = g * (*(const f32x4*)(mb + 4 * D + col) + 1.0f); Bv[j] = *(const f32x4*)(mb + 3 * D + col); }
    float rb[32];
#pragma unroll
    for (int e = 0; e < 32; ++e) rb[e] = F.router_b()[e];
    __syncthreads();
    f32x4 nx[4];
    { const GAS f32x4* xr = (const GAS f32x4*)(F.out() + (size_t)(row0 + 16 * F.wave) * D) + lane;
#pragma unroll
      for (int j = 0; j < 4; ++j) nx[j] = xr[64 * j]; }
    for (int r = 0; r < 16; ++r) {
        const int rl = 16 * F.wave + r, row = row0 + rl;
        f32x4 v[4]; float ss = 0.f;
#pragma unroll
        for (int j = 0; j < 4; ++j) { v[j] = nx[j]; ss += (v[j].x * v[j].x + v[j].y * v[j].y) + (v[j].z * v[j].z + v[j].w * v[j].w); }
        if (r < 15) { const GAS f32x4* xr = (const GAS f32x4*)(F.out() + (size_t)(row + 1) * D) + lane;
#pragma unroll
            for (int j = 0; j < 4; ++j) nx[j] = xr[64 * j]; }
        const float rstd = 1.0f / sqrtf(wave_sum(ss) * (1.0f / D) + EPS);
        { GAS unsigned* o4 = (GAS unsigned*)((unsigned char*)F.H2() + (size_t)row * D) + lane;
#pragma unroll
          for (int j = 0; j < 4; ++j) { v[j] = v[j] * rstd * Av[j] + Bv[j]; o4[64 * j] = pg8::pk4_fp8(v[j].x, v[j].y, v[j].z, v[j].w); } }
        float p[32];
#pragma unroll
        for (int e = 0; e < 32; ++e) { float s = 0.f;
#pragma unroll
            for (int j = 0; j < 4; ++j) { const f32x4 w = *(const LAS f32x4*)(wr + e * 1028 + 4 * lane + 256 * j); s += (v[j].x * w.x + v[j].y * w.y) + (v[j].z * w.z + v[j].w * w.w); }
            p[e] = s; }
#pragma unroll
        for (int i = 0; i < 16; ++i) { const bool up = (lane & 32) != 0; const float send = up ? p[i] : p[i + 16], keep = up ? p[i + 16] : p[i]; p[i] = keep + __shfl_xor(send, 32); }
#pragma unroll
        for (int i = 0; i < 8; ++i) { const bool up = (lane & 16) != 0; const float send = up ? p[i] : p[i + 8], keep = up ? p[i + 8] : p[i]; p[i] = keep + __shfl_xor(send, 16); }
#pragma unroll
        for (int i = 0; i < 4; ++i) { const bool up = (lane & 8) != 0; const float send = up ? p[i] : p[i + 4], keep = up ? p[i + 4] : p[i]; p[i] = keep + __shfl_xor(send, 8); }
#pragma unroll
        for (int i = 0; i < 2; ++i) { const bool up = (lane & 4) != 0; const float send = up ? p[i] : p[i + 2], keep = up ? p[i + 2] : p[i]; p[i] = keep + __shfl_xor(send, 4); }
        { const bool up = (lane & 2) != 0; const float send = up ? p[0] : p[1], keep = up ? p[1] : p[0]; p[0] = keep + __shfl_xor(send, 2); }
        p[0] += __shfl_xor(p[0], 1);
        { LAS float* lg = (LAS float*)(F.lds + 135680) + F.wave * 32;
          if ((lane & 1) == 0) lg[lane >> 1] = p[0];
#pragma unroll
          for (int q = 0; q < 8; ++q) { const f32x4 t4 = *(const LAS f32x4*)(lg + 4 * q); p[4 * q] = t4.x + rb[4 * q]; p[4 * q + 1] = t4.y + rb[4 * q + 1]; p[4 * q + 2] = t4.z + rb[4 * q + 2]; p[4 * q + 3] = t4.w + rb[4 * q + 3]; } }
        int sel[4]; float sv[4]; unsigned used = 0u;
#pragma unroll
        for (int k = 0; k < 4; ++k) { float best = -3.0e38f; int bi = 0;
#pragma unroll
            for (int e = 0; e < 32; ++e) { const bool cnd = (((used >> e) & 1u) == 0u) && (p[e] > best); best = cnd ? p[e] : best; bi = cnd ? e : bi; }
            sel[k] = bi; sv[k] = best; used |= 1u << bi; }
        const float e1 = __expf(sv[1] - sv[0]), e2 = __expf(sv[2] - sv[0]), e3 = __expf(sv[3] - sv[0]), inv = 1.0f / (1.0f + e1 + e2 + e3);
        if (lane < 4) { const int ek = lane == 0 ? sel[0] : lane == 1 ? sel[1] : lane == 2 ? sel[2] : sel[3];
            const float wk = (lane == 0 ? 1.0f : lane == 1 ? e1 : lane == 2 ? e2 : e3) * inv;
            const int pos = __hip_atomic_fetch_add(lcnt + ek, 1, __ATOMIC_RELAXED, __HIP_MEMORY_SCOPE_WORKGROUP);
            le[rl * 4 + lane] = ek; lp[rl * 4 + lane] = pos; F.tokw()[(size_t)row * 4 + lane] = wk; }
        if (lane == 0) F.rstd2()[row] = rstd;
    }
    __syncthreads();
    if (tid < 32) gbase[tid] = (int)__hip_atomic_fetch_add(F.ctl + CW_ECNT + 64 * tid, (unsigned)lcnt[tid], __ATOMIC_RELAXED, __HIP_MEMORY_SCOPE_AGENT);
    __syncthreads();
    { const int ek = le[tid]; F.toke()[(size_t)row0 * 4 + tid] = ek; F.tokp()[(size_t)row0 * 4 + tid] = lp[tid] + gbase[ek]; }
}

__device__ __forceinline__ void p5b_tables(Frame& F) {
    const int row0 = F.vcu * 128, tid = opq(F.tid);
    LAS int* ts = (LAS int*)(F.LC + LC_TS); LAS int* ps = (LAS int*)(F.LC + LC_PS); LAS int* cn = (LAS int*)(F.LC + LC_CNT);
    if (tid < 32) cn[tid] = (int)__hip_atomic_load(F.ctl + CW_ECNT + 64 * tid, RLX_AGENT);
    __syncthreads();
    if (tid == 0) { int run = 0, trun = 0; for (int e = 0; e < 32; ++e) { ps[e] = run; ts[e] = trun; const int nt = (cn[e] + 255) >> 8; run += nt * 256; trun += nt; } ts[32] = trun; }
    __syncthreads();
    { const size_t idx = (size_t)row0 * 4 + tid; const int ek = F.toke()[idx], dst = ps[ek] + F.tokp()[idx]; F.tokrow()[idx] = dst; F.row2tok()[dst] = row0 + (tid >> 2); }
    if (F.vcu < 32) { const int e = F.vcu, start = ps[e] + cn[e], end = ps[e] + (((cn[e] + 255) >> 8) << 8); for (int r = start + tid; r < end; r += 512) F.row2tok()[r] = 0; }
}

__device__ __forceinline__ void p8_combine(Frame& F, bool poison) {
    const int row0 = F.vcu * 128, b = row0 / SEQ, lane = opq(F.lane);
    f32x4 G2[4], FG[4];
#pragma unroll
    for (int j = 0; j < 4; ++j) { const int col = 4 * lane + 256 * j; G2[j] = *(const f32x4*)(F.mod() + (size_t)b * NMOD + 5 * D + col); FG[j] = *(const f32x4*)(F.final_g() + col); }
    f32x4 nx[4]; unsigned long long ng[4][4]; float nw[4];
#define P8_LOAD(ROW) do { const size_t row_ = (ROW); const GAS f32x4* xr_ = (const GAS f32x4*)(F.out() + row_ * D) + lane; \
        _Pragma("unroll") for (int j = 0; j < 4; ++j) nx[j] = xr_[64 * j]; \
        _Pragma("unroll") for (int k = 0; k < 4; ++k) { const int src_ = F.tokrow()[row_ * 4 + k]; nw[k] = F.tokw()[row_ * 4 + k]; \
            const GAS unsigned long long* s8_ = (const GAS unsigned long long*)(F.OUTR() + (size_t)src_ * D) + lane; \
            _Pragma("unroll") for (int j = 0; j < 4; ++j) ng[k][j] = s8_[64 * j]; } } while (0)
    P8_LOAD((size_t)row0 + 16 * F.wave);
    for (int r = 0; r < 16; ++r) {
        const int row = row0 + 16 * F.wave + r;
        GAS f32x4* xr = (GAS f32x4*)(F.out() + (size_t)row * D) + lane;
        f32x4 y[4], xv[4];
#pragma unroll
        for (int j = 0; j < 4; ++j) { y[j] = (f32x4){0.f, 0.f, 0.f, 0.f}; xv[j] = nx[j]; }
#pragma unroll
        for (int k = 0; k < 4; ++k) { const float wk = nw[k];
#pragma unroll
            for (int j = 0; j < 4; ++j) { const unsigned long long w = ng[k][j]; y[j].x += wk * bflo((unsigned)w); y[j].y += wk * bfhi((unsigned)w); y[j].z += wk * bflo((unsigned)(w >> 32)); y[j].w += wk * bfhi((unsigned)(w >> 32)); } }
        if (r < 15) P8_LOAD((size_t)row + 1);
        f32x4 v[4]; float ss = 0.f;
#pragma unroll
        for (int j = 0; j < 4; ++j) { v[j] = xv[j] + G2[j] * y[j]; ss += (v[j].x * v[j].x + v[j].y * v[j].y) + (v[j].z * v[j].z + v[j].w * v[j].w); }
        const float rstd = 1.0f / sqrtf(wave_sum(ss) * (1.0f / D) + EPS);
        const float qn = __builtin_nanf("");
#pragma unroll
        for (int j = 0; j < 4; ++j) { f32x4 o = v[j] * rstd * FG[j]; if (poison) o = (f32x4){qn, qn, qn, qn}; xr[64 * j] = o; }
    }
#undef P8_LOAD
}

#ifndef MK_REP_G2
#define MK_REP_G2 1
#endif
#ifndef MK_REP_G4A
#define MK_REP_G4A 1
#endif
#ifndef MK_REP_G4B
#define MK_REP_G4B 1
#endif
#ifndef MK_REP_G4C
#define MK_REP_G4C 1
#endif
#ifndef MK_REP_G6
#define MK_REP_G6 1
#endif
#ifndef MK_REP_G7
#define MK_REP_G7 1
#endif
#ifndef MK_REP_P0
#define MK_REP_P0 1
#endif
#ifndef MK_REP_P3
#define MK_REP_P3 1
#endif
struct Args { const float* in[22]; float* out; unsigned char* ws; };
__global__ void __launch_bounds__(NWAVES * 64, 2) mk_fwd(Args args) {
    extern __shared__ __attribute__((aligned(16))) unsigned char lds[];
    Frame F;
    F.lds = (LAS unsigned char*)lds; F.LC = (volatile LAS unsigned*)(F.lds + LDSCTL_OFF);
    F.tid = threadIdx.x; F.lane = F.tid & 63; F.wave = __builtin_amdgcn_readfirstlane(F.tid >> 6);
    F.G = gridDim.x; { const int bx = blockIdx.x; F.vcu = (F.G % 8 == 0) ? (bx % 8) * (F.G / 8) + bx / 8 : bx; }
    F.ws = (unsigned char*)(GAS unsigned char*)karg(23);
    F.ctl = (gu32*)(F.ws + WS_CTL);
    for (int u = F.tid; u < (LDS_BYTES - LDSCTL_OFF) / 4; u += NWAVES * 64) ((LAS unsigned*)(F.lds + LDSCTL_OFF))[u] = 0u;
    __syncthreads();
    XcdBarrier bar = xcd_barrier_post((unsigned*)(F.ctl + CW_BAR), F.LC + LC_BAR);
#define GRID_BAR() xcd_barrier(bar)
    const int G = F.G, cid = (int)blockIdx.x;

    for (int rep_ = 0; rep_ < MK_REP_P0; ++rep_) p0_prologue(F);
    GRID_BAR();
    p1_rows(F);
    GRID_BAR();
    { pg8::Gemm g{F.H1(), F.WIN_T(), T, NPROJ, D / 2}; pg8::StaticOrder S; S.init(T, NPROJ, G, cid);
      pg8::EpiBf16<0> E{F.PROJ(), D, nullptr, D, SEG / 2, QSCALE, 1.0f / W8SCALE};
      for (int rep_ = 0; rep_ < MK_REP_G2; ++rep_) pg8::gemm_phase<pg8::EpiBf16<0>, pg8::StaticOrder, true, true, false, true>(F.lds, g, S, E); }
    GRID_BAR();
    for (int job = F.vcu * NWAVES + F.wave; job < BATCH * 4 * (SEQ / 64); job += G * NWAVES) mlstm_gates(F, job);
    mlstm_conv_rows(F);
    GRID_BAR();
#if defined(MK_NAIVE_MLSTM)
    for (int it = F.vcu; it < 1024; it += G) attn_naive_item(F, it & 255, it >> 8);
    __syncthreads();
    for (int it = F.vcu; it < 64; it += G) mlstm_naive_item(F, it);
#else
    for (int rep_ = 0; rep_ < MK_REP_P3; ++rep_) {
    for (int it = F.vcu; it < 256; it += G) ml::mlstm_unit(F, it);
    __syncthreads();
#if defined(MK_NAIVE_ATTN)
    for (int it = F.vcu; it < 1024; it += G) attn_naive_item(F, it & 255, it >> 8);
#else
    for (int bh = F.vcu; bh < 256; bh += G) at::attn_ring(F, bh);
#endif
    }
#endif
    GRID_BAR();
    { pg8::Gemm g{F.YA(), F.WA_T(), T, D, D / 2}; pg8::StaticOrder S; S.init(T, D, G, cid);
      pg8::EpiGate<false> E{F.PROJ() + 7 * (SEG / 2), nullptr, F.M1(), 1.0f / W8SCALE};
      for (int rep_ = 0; rep_ < MK_REP_G4A; ++rep_) pg8::gemm_phase<pg8::EpiGate<false>, pg8::StaticOrder, true, true, false, true>(F.lds, g, S, E); }
#if defined(MK_NAIVE_MLSTM)
    VM_WAIT(); __syncthreads();
#else
    __syncthreads();
    mlstm_norm_rows(F);
    GRID_BAR();
#endif
    { pg8::Gemm g{F.YB8(), F.WB_T(), T, D, D / 2}; pg8::StaticOrder S; S.init(T, D, G, cid);
      pg8::EpiGate<true, true> E{F.PROJ() + 8 * (SEG / 2), F.M1(), F.MERGED(), 1.0f / W8SCALE};
      for (int rep_ = 0; rep_ < MK_REP_G4B; ++rep_) pg8::gemm_phase<pg8::EpiGate<true, true>, pg8::StaticOrder, true, true, false, true>(F.lds, g, S, E); }
    GRID_BAR();
    { pg8::Gemm g{F.MERGED(), F.WOUT_T(), T, D, D / 2}; pg8::StaticOrder S; S.init(T, D, G, cid);
      pg8::EpiResid E{F.x(), F.mod() + 2 * D, F.out(), SEQ, NMOD, 1.0f / W8SCALE};
      for (int rep_ = 0; rep_ < MK_REP_G4C; ++rep_) pg8::gemm_phase<pg8::EpiResid, pg8::StaticOrder, true, true, false, true>(F.lds, g, S, E); }
    GRID_BAR();
    p5a_route(F);
    GRID_BAR();
    p5b_tables(F);
    GRID_BAR();
    { pg8::Gemm g{F.H2(), F.W1_T(), T, NE * 2048, D / 2}; pg8::GroupedOrder S{(const LAS int*)(F.LC + LC_TS), 8, G, cid, F.row2tok()};
      pg8::EpiSwiglu<true> E{F.b1(), F.ACT(), 1.0f / W8SCALE};
      for (int rep_ = 0; rep_ < MK_REP_G6; ++rep_) pg8::gemm_phase<pg8::EpiSwiglu<true>, pg8::GroupedOrder, true, true, true, true>(F.lds, g, S, E); }
    GRID_BAR();
    { pg8::Gemm g{F.ACT(), F.W2_T(), XS_ROWS, NE * 1024, D / 2}; pg8::GroupedOrder S{(const LAS int*)(F.LC + LC_TS), 4, G, cid, nullptr};
      pg8::EpiOutS E{F.OUTR(), F.b2(), 1.0f / W8SCALE};
      for (int rep_ = 0; rep_ < MK_REP_G7; ++rep_) pg8::gemm_phase<pg8::EpiOutS, pg8::GroupedOrder, true, true, false, true>(F.lds, g, S, E); }
    GRID_BAR();
    { const bool poison = __hip_atomic_load(F.ctl + CW_BAR + XB_TMO, RLX_AGENT) != 0u;
      p8_combine(F, poison); }
}

extern "C" void kernel_launch(void* const* d_in, const int* in_sizes, int n_in, void* d_out, int out_size, void* d_ws, size_t ws_size, hipStream_t stream) {
    static int grid = 0;
    if (grid == 0) {
        if (n_in != 22 || in_sizes[0] != T * D || out_size != T * D || ws_size < WS_END) { fprintf(stderr, "kernel_launch: unexpected shapes (n_in %d, in0 %d, out %d, ws %zu)\n", n_in, n_in > 0 ? in_sizes[0] : -1, out_size, ws_size); grid = -1; return; }
        int dev = 0, cus = 0, per_cu = 0;
        if (hipGetDevice(&dev) != hipSuccess || hipDeviceGetAttribute(&cus, hipDeviceAttributeMultiprocessorCount, dev) != hipSuccess) { grid = -1; return; }
        if (hipFuncSetAttribute((const void*)mk_fwd, hipFuncAttributeMaxDynamicSharedMemorySize, LDS_BYTES) != hipSuccess) { fprintf(stderr, "kernel_launch: hipFuncSetAttribute failed\n"); grid = -1; return; }
        if (hipOccupancyMaxActiveBlocksPerMultiprocessor(&per_cu, (const void*)mk_fwd, NWAVES * 64, LDS_BYTES) != hipSuccess || per_cu < 1) { fprintf(stderr, "kernel_launch: occupancy query says %d blocks per CU\n", per_cu); }
        (void)hipGetLastError();
        if (cus < 256) { fprintf(stderr, "kernel_launch: built for a 256-CU device, found %d CUs\n", cus); grid = -1; return; }
        grid = 256;
    }
    if (grid < 0) return;
    if (hipMemsetAsync((char*)d_ws + WS_CTL, 0, CTL_ZERO_BYTES, stream) != hipSuccess) return;
    Args a{};
    for (int i = 0; i < 22; ++i) a.in[i] = (const float*)d_in[i];
    a.out = (float*)d_out; a.ws = (unsigned char*)d_ws;
    hipLaunchKernelGGL(mk_fwd, dim3(grid), dim3(NWAVES * 64), LDS_BYTES, stream, a);
}
```
